# Optimizing an MI355X kernel written in HIP

```python
import jax, jax.numpy as jnp
from jax import lax
import numpy as np

D_MODEL = 1024
BATCH = 8
SEQ = 4096
DEPTH = 4
DEC_BATCH = 32
DEC_SEQ = 16
PAST_LEN = 2048

CHUNK = 64
Q_BLOCK = 128
N_MEM = 256
EPS = 1e-6
FOX_HEADS = 16
FOX_HEAD_DIM = D_MODEL // FOX_HEADS
FOX_WIDTH = FOX_HEADS * FOX_HEAD_DIM
FOX_IN = 3 * FOX_WIDTH + FOX_HEADS + FOX_WIDTH
FOX_SCALE = FOX_HEAD_DIM ** -0.5
MLA_HEADS = 16
MLA_NOPE = 64
MLA_ROPE = 32
MLA_V = 64
MLA_Q_LORA = 384
MLA_KV_LORA = 256
MLA_DOWN = MLA_Q_LORA + MLA_KV_LORA + MLA_ROPE
MLA_SCALE = (MLA_NOPE + MLA_ROPE) ** -0.5
ROPE_THETA = 10000.0
X_HEADS = 4
X_HEAD_DIM = D_MODEL // X_HEADS
X_WIDTH = X_HEADS * X_HEAD_DIM
X_SCALE = X_HEAD_DIM ** -0.5
D_FF = ((8 * D_MODEL + 3 * 256 - 1) // (3 * 256)) * 256
N_FOX = (DEPTH + 1) // 2
N_MLA = DEPTH // 2

kernel_name = "fox_mla_streaming_encoder_step"


def rms_normalize(x):
    x32 = x.astype(jnp.float32)
    return (x32 * lax.rsqrt(jnp.mean(x32 * x32, axis=-1, keepdims=True) + EPS)).astype(x.dtype)


def rmsnorm(x, g):
    return rms_normalize(x) * g


def rope(x, pos):
    half = x.shape[-1] // 2
    inv = ROPE_THETA ** (-jnp.arange(half, dtype=jnp.float32) / half)
    ang = pos.astype(jnp.float32)[:, None] * inv[None, :]
    if x.ndim == 4:
        ang = ang[:, None, :]
    cos, sin = jnp.cos(ang), jnp.sin(ang)
    x1 = x[..., :half].astype(jnp.float32)
    x2 = x[..., half:].astype(jnp.float32)
    return jnp.concatenate([x1 * cos - x2 * sin, x1 * sin + x2 * cos], axis=-1).astype(x.dtype)


def masked_softmax(scores, mask):
    return jax.nn.softmax(jnp.where(mask, scores, -jnp.inf), axis=-1)


def sweep_query_blocks(block_fn, q_arrays, q_pos):
    t = q_pos.shape[0]
    if t <= Q_BLOCK:
        return block_fn(*q_arrays, q_pos)
    nb = t // Q_BLOCK
    blocks = tuple(jnp.moveaxis(a.reshape((a.shape[0], nb, Q_BLOCK) + a.shape[2:]), 1, 0) for a in q_arrays)
    out = lax.map(lambda args: block_fn(*args), blocks + (q_pos.reshape(nb, Q_BLOCK),))
    out = jnp.moveaxis(out, 0, 1)
    return out.reshape((out.shape[0], t) + out.shape[3:])


def fox_mixer(h, q_pos, past, w_in, b_f, w_out):
    b, t, _ = h.shape
    proj = h @ w_in
    q, k, v, f_pre, gate = jnp.split(proj, [FOX_WIDTH, 2 * FOX_WIDTH, 3 * FOX_WIDTH, 3 * FOX_WIDTH + FOX_HEADS], axis=-1)
    q = q.reshape(b, t, FOX_HEADS, FOX_HEAD_DIM)
    k = k.reshape(b, t, FOX_HEADS, FOX_HEAD_DIM)
    v = v.reshape(b, t, FOX_HEADS, FOX_HEAD_DIM)
    logf = jax.nn.log_sigmoid((f_pre + b_f).astype(jnp.float32))
    if past is None:
        k_all, v_all, lf_all, k_pos = k, v, logf, q_pos
    else:
        k_all = jnp.concatenate([past[0], k], axis=1)
        v_all = jnp.concatenate([past[1], v], axis=1)
        lf_all = jnp.concatenate([past[2].astype(jnp.float32), logf], axis=1)
        k_pos = jnp.arange(k_all.shape[1], dtype=jnp.int32)
    cum = jnp.cumsum(lf_all, axis=1)
    ck = jnp.moveaxis(cum, 1, 2)[:, :, None, :]
    cq_all = cum[:, -t:]

    def block(qb, cqb, pq):
        s = jnp.einsum('bqhd,bkhd->bhqk', qb, k_all).astype(jnp.float32) * FOX_SCALE
        s = s + jnp.moveaxis(cqb, 1, 2)[..., None] - ck
        mask = k_pos[None, :] <= pq[:, None]
        p = masked_softmax(s, mask).astype(v_all.dtype)
        return jnp.einsum('bhqk,bkhd->bqhd', p, v_all)

    o = sweep_query_blocks(block, (q, cq_all), q_pos)
    o = o.reshape(b, t, FOX_WIDTH) * jax.nn.sigmoid(gate)
    return o @ w_out, (k, v, logf.astype(h.dtype))


def mla_mixer(h, q_pos, past, w_a, g_q, g_kv, w_qb, w_kvb, w_out):
    b, t, _ = h.shape
    a = h @ w_a
    c_q, c_kv, k_r = jnp.split(a, [MLA_Q_LORA, MLA_Q_LORA + MLA_KV_LORA], axis=-1)
    q = (rmsnorm(c_q, g_q) @ w_qb).reshape(b, t, MLA_HEADS, MLA_NOPE + MLA_ROPE)
    q_nope, q_rope = jnp.split(q, [MLA_NOPE], axis=-1)
    q_rope = rope(q_rope, q_pos)
    c_kv = rmsnorm(c_kv, g_kv)
    k_r = rope(k_r, q_pos)
    if past is None:
        ckv_all, kr_all, k_pos = c_kv, k_r, q_pos
    else:
        ckv_all = jnp.concatenate([past[0], c_kv], axis=1)
        kr_all = jnp.concatenate([past[1], k_r], axis=1)
        k_pos = jnp.arange(ckv_all.shape[1], dtype=jnp.int32)
    kv = (ckv_all @ w_kvb).reshape(b, ckv_all.shape[1], MLA_HEADS, MLA_NOPE + MLA_V)
    k_nope, v = jnp.split(kv, [MLA_NOPE], axis=-1)
    k_chunk = k_pos // CHUNK

    def block(qn, qr, pq):
        s = (jnp.einsum('bqhn,bkhn->bhqk', qn, k_nope)
             + jnp.einsum('bqhr,bkr->bhqk', qr, kr_all)).astype(jnp.float32) * MLA_SCALE
        mask = k_chunk[None, :] <= (pq // CHUNK)[:, None]
        p = masked_softmax(s, mask).astype(v.dtype)
        return jnp.einsum('bhqk,bkhd->bqhd', p, v)

    o = sweep_query_blocks(block, (q_nope, q_rope), q_pos)
    return o.reshape(b, t, MLA_HEADS * MLA_V) @ w_out, (c_kv, k_r)


def memory_kv(mem, g_mem, w_x_kv):
    m_l = rms_normalize(mem)[None] * g_mem[:, None, None, :]
    kv = jnp.einsum('lbnd,lde->lbne', m_l, w_x_kv)
    k, v = jnp.split(kv, 2, axis=-1)
    shp = (DEPTH, mem.shape[0], mem.shape[1], X_HEADS, X_HEAD_DIM)
    return k.reshape(shp), v.reshape(shp)


def cross_attn(h, mk, mv, w_q, w_o):
    b, t, _ = h.shape
    q = (h @ w_q).reshape(b, t, X_HEADS, X_HEAD_DIM)
    s = jnp.einsum('bqhd,bkhd->bhqk', q, mk).astype(jnp.float32) * X_SCALE
    p = jax.nn.softmax(s, axis=-1).astype(mv.dtype)
    o = jnp.einsum('bhqk,bkhd->bqhd', p, mv).reshape(b, t, X_WIDTH)
    return o @ w_o


def swiglu(h, w_gu, w_down):
    g, u = jnp.split(h @ w_gu, 2, axis=-1)
    return (jax.nn.silu(g) * u) @ w_down


def trunk(x, q_pos, fox_past, mla_past, mem_k, mem_v,
          g_mix, g_cross, g_ffn, g_final,
          w_fox_in, b_fox_f, w_fox_out,
          w_mla_a, g_mla_q, g_mla_kv, w_mla_qb, w_mla_kvb, w_mla_out,
          w_x_q, w_x_o, w_ffn_gu, w_ffn_down):
    fox_k, fox_v, fox_lf, mla_c, mla_r = [], [], [], [], []
    for i in range(DEPTH):
        j = i // 2
        h = rmsnorm(x, g_mix[i])
        if i % 2 == 0:
            past = None if fox_past is None else (fox_past[0][j], fox_past[1][j], fox_past[2][j])
            o, st = fox_mixer(h, q_pos, past, w_fox_in[j], b_fox_f[j], w_fox_out[j])
            fox_k.append(st[0]); fox_v.append(st[1]); fox_lf.append(st[2])
        else:
            past = None if mla_past is None else (mla_past[0][j], mla_past[1][j])
            o, st = mla_mixer(h, q_pos, past, w_mla_a[j], g_mla_q[j], g_mla_kv[j],
                              w_mla_qb[j], w_mla_kvb[j], w_mla_out[j])
            mla_c.append(st[0]); mla_r.append(st[1])
        x = x + o
        x = x + cross_attn(rmsnorm(x, g_cross[i]), mem_k[i], mem_v[i], w_x_q[i], w_x_o[i])
        x = x + swiglu(rmsnorm(x, g_ffn[i]), w_ffn_gu[i], w_ffn_down[i])
    y = rmsnorm(x, g_final)
    return y, jnp.stack(fox_k), jnp.stack(fox_v), jnp.stack(fox_lf), jnp.stack(mla_c), jnp.stack(mla_r)


def setup_inputs(seed: int = 0) -> dict:
    key = jax.random.key(seed)
    ks = iter(jax.random.split(key, 40))
    f32 = jnp.float32

    def nrm(shape, scale=1.0):
        return jax.random.normal(next(ks), shape, f32) * scale

    def gain(shape):
        return 1.0 + 0.05 * nrm(shape)

    d = D_MODEL
    return {
        "x_prompt": nrm((BATCH, SEQ, d)),
        "x_sample": nrm((DEC_BATCH, DEC_SEQ, d)),
        "mem_prompt": nrm((BATCH, N_MEM, d)),
        "cache_fox_k": nrm((N_FOX, DEC_BATCH, PAST_LEN, FOX_HEADS, FOX_HEAD_DIM)),
        "cache_fox_v": nrm((N_FOX, DEC_BATCH, PAST_LEN, FOX_HEADS, FOX_HEAD_DIM)),
        "cache_fox_logf": jax.nn.log_sigmoid(3.0 + 0.5 * nrm((N_FOX, DEC_BATCH, PAST_LEN, FOX_HEADS))),
        "cache_mla_ckv": nrm((N_MLA, DEC_BATCH, PAST_LEN, MLA_KV_LORA)),
        "cache_mla_krope": nrm((N_MLA, DEC_BATCH, PAST_LEN, MLA_ROPE)),
        "cache_mem_k": nrm((DEPTH, DEC_BATCH, N_MEM, X_HEADS, X_HEAD_DIM)),
        "cache_mem_v": nrm((DEPTH, DEC_BATCH, N_MEM, X_HEADS, X_HEAD_DIM)),
        "g_mix": gain((DEPTH, d)),
        "g_cross": gain((DEPTH, d)),
        "g_mem": gain((DEPTH, d)),
        "g_ffn": gain((DEPTH, d)),
        "g_final": gain((d,)),
        "w_fox_in": nrm((N_FOX, d, FOX_IN), d ** -0.5),
        "b_fox_f": 3.0 + 0.5 * nrm((N_FOX, FOX_HEADS)),
        "w_fox_out": nrm((N_FOX, FOX_WIDTH, d), FOX_WIDTH ** -0.5),
        "w_mla_a": nrm((N_MLA, d, MLA_DOWN), d ** -0.5),
        "g_mla_q": gain((N_MLA, MLA_Q_LORA)),
        "g_mla_kv": gain((N_MLA, MLA_KV_LORA)),
        "w_mla_qb": nrm((N_MLA, MLA_Q_LORA, MLA_HEADS * (MLA_NOPE + MLA_ROPE)), MLA_Q_LORA ** -0.5),
        "w_mla_kvb": nrm((N_MLA, MLA_KV_LORA, MLA_HEADS * (MLA_NOPE + MLA_V)), MLA_KV_LORA ** -0.5),
        "w_mla_out": nrm((N_MLA, MLA_HEADS * MLA_V, d), (MLA_HEADS * MLA_V) ** -0.5),
        "w_x_q": nrm((DEPTH, d, X_WIDTH), d ** -0.5),
        "w_x_kv": nrm((DEPTH, d, 2 * X_WIDTH), d ** -0.5),
        "w_x_o": nrm((DEPTH, X_WIDTH, d), X_WIDTH ** -0.5),
        "w_ffn_gu": nrm((DEPTH, d, 2 * D_FF), d ** -0.5),
        "w_ffn_down": nrm((DEPTH, D_FF, d), D_FF ** -0.5),
    }


def reference(x_prompt, x_sample, mem_prompt, cache_fox_k, cache_fox_v, cache_fox_logf,
              cache_mla_ckv, cache_mla_krope, cache_mem_k, cache_mem_v,
              g_mix, g_cross, g_mem, g_ffn, g_final,
              w_fox_in, b_fox_f, w_fox_out,
              w_mla_a, g_mla_q, g_mla_kv, w_mla_qb, w_mla_kvb, w_mla_out,
              w_x_q, w_x_kv, w_x_o, w_ffn_gu, w_ffn_down):
    mem_k_p, mem_v_p = memory_kv(mem_prompt, g_mem, w_x_kv)
    pos_p = jnp.arange(x_prompt.shape[1], dtype=jnp.int32)
    y_prompt, fk_p, fv_p, fl_p, mc_p, mr_p = trunk(
        x_prompt, pos_p, None, None, mem_k_p, mem_v_p,
        g_mix, g_cross, g_ffn, g_final, w_fox_in, b_fox_f, w_fox_out,
        w_mla_a, g_mla_q, g_mla_kv, w_mla_qb, w_mla_kvb, w_mla_out,
        w_x_q, w_x_o, w_ffn_gu, w_ffn_down)
    past_len = cache_fox_k.shape[2]
    pos_s = past_len + jnp.arange(x_sample.shape[1], dtype=jnp.int32)
    y_sample, fk_s, fv_s, fl_s, mc_s, mr_s = trunk(
        x_sample, pos_s, (cache_fox_k, cache_fox_v, cache_fox_logf), (cache_mla_ckv, cache_mla_krope),
        cache_mem_k, cache_mem_v,
        g_mix, g_cross, g_ffn, g_final, w_fox_in, b_fox_f, w_fox_out,
        w_mla_a, g_mla_q, g_mla_kv, w_mla_qb, w_mla_kvb, w_mla_out,
        w_x_q, w_x_o, w_ffn_gu, w_ffn_down)
    return (y_prompt, y_sample,
            fk_p, fv_p, fl_p, mc_p, mr_p, mem_k_p, mem_v_p,
            fk_s, fv_s, fl_s, mc_s, mr_s)
```

```cpp
#include <hip/hip_runtime.h>
#include <cstdint>
#include <cstdio>
#include <cmath>

constexpr int D = 1024, MP = 32768, MS = 512, MT = MP + MS, SEQ = 4096, NBP = 8, NBS = 32, DSEQ = 16, PAST = 2048, NMEM = 256;
constexpr int DFF = 2816, KPAD = 2112;
constexpr float EPS = 1e-6f, LOG2E = 1.4426950408889634f;
constexpr float C2_FOX = 0.125f * LOG2E, C2_MLA = 0.10206207261596575f * LOG2E, C2_X = 0.0625f * LOG2E;

constexpr size_t O_Y = 0;
constexpr size_t O_FKP = (size_t)MT * D;
constexpr size_t O_FVP = O_FKP + (size_t)2 * MP * 1024;
constexpr size_t O_FLP = O_FVP + (size_t)2 * MP * 1024;
constexpr size_t O_MCP = O_FLP + (size_t)2 * MP * 16;
constexpr size_t O_MRP = O_MCP + (size_t)2 * MP * 256;
constexpr size_t O_MKP = O_MRP + (size_t)2 * MP * 32;
constexpr size_t O_MVP = O_MKP + (size_t)4 * 2048 * 1024;
constexpr size_t O_FKS = O_MVP + (size_t)4 * 2048 * 1024;
constexpr size_t O_FVS = O_FKS + (size_t)2 * MS * 1024;
constexpr size_t O_FLS = O_FVS + (size_t)2 * MS * 1024;
constexpr size_t O_MCS = O_FLS + (size_t)2 * MS * 16;
constexpr size_t O_MRS = O_MCS + (size_t)2 * MS * 256;
constexpr size_t O_END = O_MRS + (size_t)2 * MS * 32;

enum { I_XP = 0, I_XS, I_MEM, I_CFK, I_CFV, I_CFL, I_CCKV, I_CKR, I_CMK, I_CMV, I_GMIX, I_GCROSS, I_GMEM, I_GFFN, I_GFINAL,
       I_WFI, I_BFF, I_WFO, I_WMA, I_GMQ, I_GMKV, I_WMQB, I_WMKVB, I_WMO, I_WXQ, I_WXKV, I_WXO, I_WGU, I_WDN, N_IN };


constexpr size_t al256(size_t x) { return (x + 255) & ~(size_t)255; }
constexpr size_t WS_CTL = 0, CTL_ZERO_BYTES = 1u << 20;
constexpr size_t WS_WFI = 2u << 20;
constexpr size_t WS_WFO = WS_WFI + (size_t)2 * 4352 * 1024 * 2;
constexpr size_t WS_WMA = WS_WFO + (size_t)2 * 1024 * 1024 * 2;
constexpr size_t WS_WMQ = WS_WMA + (size_t)2 * 768 * 1024 * 2;
constexpr size_t WS_WMKV = WS_WMQ + (size_t)2 * 1536 * 384 * 2;
constexpr size_t WS_WMKVR = WS_WMKV + (size_t)2 * 2048 * 256 * 2;
constexpr size_t WS_WKN = WS_WMKVR + (size_t)2 * 2048 * 256 * 2;
constexpr size_t WS_WMO = WS_WKN + (size_t)2 * 256 * 2048 * 2;
constexpr size_t WS_WXQ = WS_WMO + (size_t)2 * 1024 * 1024 * 2;
constexpr size_t WS_WXO = WS_WXQ + (size_t)4 * 1024 * 1024 * 2;
constexpr size_t WS_WXKV = WS_WXO + (size_t)4 * 1024 * 1024 * 2;
constexpr size_t WS_WGU = WS_WXKV + (size_t)4 * 2048 * 1024 * 2;
constexpr size_t WS_WDN = WS_WGU + (size_t)4 * 5632 * 1024 * 2;
constexpr size_t WS_WFF = WS_WDN + (size_t)4 * 1024 * 2816 * 2;
constexpr size_t WS_ROPC = WS_WFF + (size_t)2 * 16 * 1024 * 4;
constexpr size_t WS_ROPS = WS_ROPC + (size_t)4096 * 16 * 4;
constexpr size_t WS_XB = WS_ROPS + (size_t)4096 * 16 * 4;
constexpr size_t WS_SSQ = WS_XB + (size_t)MT * 1024 * 2;
constexpr size_t WS_R1 = al256(WS_SSQ + (size_t)MT * 16 * 4);
constexpr size_t SZ_ACT = (size_t)MT * 1024 * 2;
constexpr size_t WS_QF = WS_R1, WS_KF = WS_R1 + SZ_ACT, WS_VF = WS_R1 + 2 * SZ_ACT, WS_GF = WS_R1 + 3 * SZ_ACT;
constexpr size_t WS_QM = WS_R1, WS_KVM = al256(WS_R1 + (size_t)MT * 1536 * 2);
static_assert(WS_KVM + (size_t)MP * 2048 * 2 <= WS_R1 + 4 * SZ_ACT, "MLA overlay fits");
constexpr size_t WS_OM = WS_R1 + 4 * SZ_ACT;
constexpr size_t WS_LFR = WS_OM + SZ_ACT;
constexpr size_t WS_CB = WS_LFR + (size_t)MT * 16 * 4;
constexpr size_t WS_CBS = WS_CB + (size_t)8 * 16 * 4096 * 4;
constexpr size_t WS_CKVU = al256(WS_CBS + (size_t)32 * 16 * 2080 * 4);
constexpr size_t WS_CKVUB = WS_CKVU + (size_t)MT * 256 * 4;
constexpr size_t WS_SSQKV = WS_CKVUB + (size_t)MT * 256 * 2;
constexpr size_t WS_CQ = WS_SSQKV + (size_t)MT * 4 * 4;
constexpr size_t WS_SSQQ = WS_CQ + (size_t)MT * 384 * 2;
constexpr size_t WS_KRB = WS_SSQQ + (size_t)MT * 8 * 4;
constexpr size_t WS_QA = al256(WS_KRB + (size_t)MT * 32 * 2);
constexpr size_t WS_PART = al256(WS_QA + (size_t)288 * 256 * 288 * 2);
constexpr size_t WS_QX = al256(WS_PART + (size_t)32 * 9 * 256 * 264 * 4);
constexpr size_t WS_MB = WS_QX + SZ_ACT;
constexpr size_t WS_MKB = WS_MB + (size_t)2048 * 1024 * 2;
constexpr size_t WS_MVB = WS_MKB + (size_t)4 * 2048 * 1024 * 2;
constexpr size_t WS_HB = WS_MVB + (size_t)4 * 2048 * 1024 * 2;
constexpr size_t WS_END = WS_HB + (size_t)MT * DFF * 2;
constexpr int CW_BAR = 4096;

namespace pg8 {
#define PG8_LAS __attribute__((address_space(3)))
typedef unsigned short bf16_t;
typedef short bf16x8 __attribute__((ext_vector_type(8)));
typedef float f32x4 __attribute__((ext_vector_type(4)));
typedef unsigned u32x4 __attribute__((ext_vector_type(4)));
constexpr int BM = 256, BK = 64, HALF = 128, HTB = HALF * BK * 2  , STAGE_BYTES = 8 * HTB, NXCD = 8, WGM = 8;

__host__ __device__ __forceinline__ int lds_byte(int r, int c) { const int st = (r >> 4) * 2 + (c >> 5), rr = r & 15, cc = c & 31, ob = rr * 64 + cc * 2; return st * 1024 + (ob ^ (((ob >> 9) & 1) << 5)); }
__host__ __device__ __forceinline__ void stage_rc(int b, int& R, int& C) { const int st = b / 1024, sb = b % 1024, swz = sb ^ (((sb >> 9) & 1) << 5); R = (st >> 1) * 16 + swz / 64; C = (st & 1) * 32 + (swz % 64) / 2; }
__host__ __device__ __forceinline__ int perm32(int rho) { const int n = rho >> 4, i = rho & 15; return 8 * (i >> 2) + 4 * n + (i & 3); }

struct Unit { int pm, pn; };
struct Gemm { const bf16_t* A; const bf16_t* Bt; int M, N, K; };

struct StaticOrder {
    int nM, nN, nwg, G, c;
    __host__ __device__ void init(int M, int N, int G_, int c_) { nM = M / BM; nN = N / BM; nwg = nM * nN; G = G_; c = c_; }
    __host__ __device__ bool next(int i, Unit& u) const {
        const long L = (long)i * G + c; if (L >= nwg) return false;
        int wgid = (int)L; { const int q = nwg / NXCD, r = nwg % NXCD, xcd = wgid % NXCD, off = wgid / NXCD; wgid = (xcd < r ? xcd * (q + 1) : r * (q + 1) + (xcd - r) * q) + off; }
        const int nig = WGM * nN, gid = wgid / nig, fm = gid * WGM, gsz = (nM - fm) < WGM ? (nM - fm) : WGM;
        u.pm = fm + ((wgid % nig) % gsz); u.pn = (wgid % nig) / gsz; return true;
    }
    __device__ __forceinline__ void a_ready(const Unit&) const {}
    __device__ __forceinline__ void done(const Unit&) const {}
};

typedef unsigned u32x2 __attribute__((ext_vector_type(2)));
typedef float f32x2v __attribute__((ext_vector_type(2)));
typedef __bf16 bf16x2_t __attribute__((ext_vector_type(2)));
__device__ __forceinline__ unsigned pk_bf16(float lo, float hi) { f32x2v v = {lo, hi}; bf16x2_t b = __builtin_convertvector(v, bf16x2_t); return __builtin_bit_cast(unsigned, b); }
__device__ __forceinline__ u32x2 pk4(f32x4 v) { u32x2 w; w.x = pk_bf16(v[0], v[1]); w.y = pk_bf16(v[2], v[3]); return w; }
__device__ __forceinline__ float dot4(f32x4 v) { return (v[0] * v[0] + v[1] * v[1]) + (v[2] * v[2] + v[3] * v[3]); }
__device__ __forceinline__ float sigm(float z) { return __builtin_amdgcn_rcpf(1.0f + __builtin_amdgcn_exp2f(-z * LOG2E)); }
#define EPI_FENCE() asm volatile("" ::: "memory")
__device__ __forceinline__ int pg8_tid() { int t = threadIdx.x; asm volatile("" : "+v"(t)); return t; }

struct RowScale { const float* p; int stride; int ngrp; float inv_n;
    __device__ __forceinline__ float get(int row, int fq) const {
        float s = 0.f; if (fq < ngrp) { const f32x4 v = *(const f32x4*)(p + (size_t)row * stride + 4 * fq); s = (v[0] + v[1]) + (v[2] + v[3]); }
        s += __shfl_xor(s, 16); s += __shfl_xor(s, 32); return rsqrtf(s * inv_n + EPS); }
    __device__ __forceinline__ void get8(int row0, int fq, float (&r)[2][4]) const {
        float s[2][4];
#pragma unroll
        for (int ai = 0; ai < 2; ++ai)
#pragma unroll
            for (int m = 0; m < 4; ++m) { s[ai][m] = 0.f; if (fq < ngrp) { const f32x4 v = *(const f32x4*)(p + (size_t)(row0 + ai * HALF + m * 16) * stride + 4 * fq); s[ai][m] = (v[0] + v[1]) + (v[2] + v[3]); } }
#pragma unroll
        for (int ai = 0; ai < 2; ++ai)
#pragma unroll
            for (int m = 0; m < 4; ++m) { float t = s[ai][m]; t += __shfl_xor(t, 16); t += __shfl_xor(t, 32); r[ai][m] = rsqrtf(t * inv_n + EPS); }
    } };
__device__ __forceinline__ int row_pos(int row) { return row < MP ? (row & (SEQ - 1)) : PAST + ((row - MP) & (DSEQ - 1)); }

struct EpiFoxIn { static constexpr bool PERM = false, AFTER_DRAIN = false;
    RowScale rs; unsigned char* ws; float* out; const float* bff; int L;
    __device__ __forceinline__ void operator()(const f32x4 (&acc)[2][2][4][2], const Unit& u, int wr, int wc, int, int) const { const int lane_ = pg8_tid() & 63, fr = lane_ & 15, fq = lane_ >> 4; float rsv[2][4]; rs.get8(u.pm * BM + wr * 64 + fr, fq, rsv);
        const int typ = u.pn >> 2, colt = (u.pn & 3) * 256 + wc * 32 + 4 * fq;
        bf16_t* QF = (bf16_t*)(ws + WS_QF); float* kp = out + O_FKP + (size_t)L * MP * 1024; float* ks = out + O_FKS + (size_t)L * MS * 1024;
#pragma unroll
        for (int ai = 0; ai < 2; ++ai)
#pragma unroll
            for (int m = 0; m < 4; ++m) { const int row = u.pm * BM + ai * HALF + wr * 64 + m * 16 + fr; float r = rsv[ai][m];
                if (typ == 0) { r *= C2_FOX;
#pragma unroll
                    for (int bj = 0; bj < 2; ++bj)
#pragma unroll
                        for (int n = 0; n < 2; ++n) *(u32x2*)(QF + (size_t)row * 1024 + colt + bj * HALF + n * 16) = pk4(acc[ai][bj][m][n] * r);
                } else if (typ == 3) {
#pragma unroll
                    for (int bj = 0; bj < 2; ++bj)
#pragma unroll
                        for (int n = 0; n < 2; ++n) { f32x4 v = acc[ai][bj][m][n] * r; v[0] = sigm(v[0]); v[1] = sigm(v[1]); v[2] = sigm(v[2]); v[3] = sigm(v[3]);
                            *(u32x2*)(QF + 3 * (SZ_ACT / 2) + (size_t)row * 1024 + colt + bj * HALF + n * 16) = pk4(v); }
                } else if (typ == 4) {
                    if (wc == 0) { const f32x4 bb = *(const f32x4*)(bff + 4 * fq); f32x4 lf;
#pragma unroll
                        for (int i = 0; i < 4; ++i) { const float z = acc[ai][0][m][0][i] * r + bb[i]; lf[i] = fminf(z, 0.f) - log1pf(expf(-fabsf(z))); }
                        *(f32x4*)((float*)(ws + WS_LFR) + (size_t)row * 16 + 4 * fq) = lf;
                        float* F = (row < MP) ? out + O_FLP + ((size_t)L * MP + row) * 16 : out + O_FLS + ((size_t)L * MS + (row - MP)) * 16;
                        *(f32x4*)(F + 4 * fq) = lf; }
                } else { bf16_t* B = QF + (size_t)typ * (SZ_ACT / 2);
                    float* F = (row < MP) ? kp + (size_t)(typ - 1) * 2 * MP * 1024 + (size_t)row * 1024 : ks + (size_t)(typ - 1) * 2 * MS * 1024 + (size_t)(row - MP) * 1024;
#pragma unroll
                    for (int bj = 0; bj < 2; ++bj)
#pragma unroll
                        for (int n = 0; n < 2; ++n) { const f32x4 v = acc[ai][bj][m][n] * r; const int c = colt + bj * HALF + n * 16;
                            *(f32x4*)(F + c) = v; *(u32x2*)(B + (size_t)row * 1024 + c) = pk4(v); }
                }
                if (m & 1) EPI_FENCE(); }
    }
};
struct EpiResid { static constexpr bool PERM = true, AFTER_DRAIN = false;
    const float* xin_p; const float* xin_s; int first; bf16_t* xb; float* ssq;
    __device__ __forceinline__ void operator()(const f32x4 (&acc)[2][2][4][2], const Unit& u, int wr, int wc, int, int) const { const int lane_ = pg8_tid() & 63, fr = lane_ & 15, fq = lane_ >> 4;
        const int col0 = u.pn * BM + wc * 32 + 8 * fq;
#pragma unroll
        for (int ai = 0; ai < 2; ++ai) {
            f32x4 xo[4][2][2];
#pragma unroll
            for (int m = 0; m < 4; ++m) { const int row = u.pm * BM + ai * HALF + wr * 64 + m * 16 + fr;
                if (first) { const float* xi = (row < MP) ? xin_p + (size_t)row * 1024 : xin_s + (size_t)(row - MP) * 1024;
#pragma unroll
                    for (int bj = 0; bj < 2; ++bj)
#pragma unroll
                        for (int n = 0; n < 2; ++n) xo[m][bj][n] = *(const f32x4*)(xi + col0 + bj * HALF + n * 4);
                } else {
#pragma unroll
                    for (int bj = 0; bj < 2; ++bj) { const u32x4 w = *(const u32x4*)(xb + (size_t)row * 1024 + col0 + bj * HALF);
                        xo[m][bj][0] = (f32x4){__builtin_bit_cast(float, w.x << 16), __builtin_bit_cast(float, w.x & 0xffff0000u), __builtin_bit_cast(float, w.y << 16), __builtin_bit_cast(float, w.y & 0xffff0000u)};
                        xo[m][bj][1] = (f32x4){__builtin_bit_cast(float, w.z << 16), __builtin_bit_cast(float, w.z & 0xffff0000u), __builtin_bit_cast(float, w.w << 16), __builtin_bit_cast(float, w.w & 0xffff0000u)}; } } }
#pragma unroll
            for (int m = 0; m < 4; ++m) { const int row = u.pm * BM + ai * HALF + wr * 64 + m * 16 + fr; float sq = 0.f;
#pragma unroll
                for (int bj = 0; bj < 2; ++bj) { const int c = col0 + bj * HALF; const f32x4 x0 = xo[m][bj][0] + acc[ai][bj][m][0], x1 = xo[m][bj][1] + acc[ai][bj][m][1];
                    sq += dot4(x0) + dot4(x1);
                    const u32x2 w0 = pk4(x0), w1 = pk4(x1); *(u32x4*)(xb + (size_t)row * 1024 + c) = (u32x4){w0.x, w0.y, w1.x, w1.y}; }
                sq += __shfl_xor(sq, 16); sq += __shfl_xor(sq, 32);
                if (fq == 0) ssq[(size_t)row * 16 + u.pn * 4 + wc] = sq; }
            EPI_FENCE(); }
    }
};
struct EpiScaleBf16 { static constexpr bool PERM = true, AFTER_DRAIN = false;
    RowScale rs; bf16_t* O; int ldc; float scale;
    __device__ __forceinline__ void operator()(const f32x4 (&acc)[2][2][4][2], const Unit& u, int wr, int wc, int, int) const { const int lane_ = pg8_tid() & 63, fr = lane_ & 15, fq = lane_ >> 4; float rsv[2][4]; rs.get8(u.pm * BM + wr * 64 + fr, fq, rsv);
        const int col0 = u.pn * BM + wc * 32 + 8 * fq;
#pragma unroll
        for (int ai = 0; ai < 2; ++ai)
#pragma unroll
            for (int m = 0; m < 4; ++m) { const int row = u.pm * BM + ai * HALF + wr * 64 + m * 16 + fr; const float r = rsv[ai][m] * scale;
#pragma unroll
                for (int bj = 0; bj < 2; ++bj) { const u32x2 w0 = pk4(acc[ai][bj][m][0] * r), w1 = pk4(acc[ai][bj][m][1] * r);
                    *(u32x4*)(O + (size_t)row * ldc + col0 + bj * HALF) = (u32x4){w0.x, w0.y, w1.x, w1.y}; }
                if (m & 1) EPI_FENCE(); }
    }
};
struct EpiSwiglu { static constexpr bool PERM = true, AFTER_DRAIN = false;
    RowScale rs; bf16_t* HB;
    __device__ __forceinline__ void operator()(const f32x4 (&acc)[2][2][4][2], const Unit& u, int wr, int wc, int, int) const { const int lane_ = pg8_tid() & 63, fr = lane_ & 15, fq = lane_ >> 4; float rsv[2][4]; rs.get8(u.pm * BM + wr * 64 + fr, fq, rsv);
        const int col0 = u.pn * HALF + wc * 32 + 8 * fq;
#pragma unroll
        for (int ai = 0; ai < 2; ++ai)
#pragma unroll
            for (int m = 0; m < 4; ++m) { const int row = u.pm * BM + ai * HALF + wr * 64 + m * 16 + fr; const float r = rsv[ai][m]; u32x4 w;
#pragma unroll
                for (int n = 0; n < 2; ++n) { const f32x4 g = acc[ai][0][m][n] * r, uu = acc[ai][1][m][n] * r; f32x4 h;
#pragma unroll
                    for (int i = 0; i < 4; ++i) h[i] = g[i] * sigm(g[i]) * uu[i];
                    const u32x2 hw = pk4(h); if (n == 0) { w.x = hw.x; w.y = hw.y; } else { w.z = hw.x; w.w = hw.y; } }
                *(u32x4*)(HB + (size_t)row * DFF + col0) = w;
                if (m & 1) EPI_FENCE(); }
    }
};
struct EpiMlaA { static constexpr bool PERM = false, AFTER_DRAIN = false;
    RowScale rs; float* ckvu; bf16_t* ckvub; float* ssqkv; bf16_t* cq; float* ssqq; bf16_t* krb; float *mrp, *mrs; const float *ropc, *rops;
    __device__ __forceinline__ void operator()(const f32x4 (&acc)[2][2][4][2], const Unit& u, int wr, int wc, int, int) const { const int lane_ = pg8_tid() & 63, fr = lane_ & 15, fq = lane_ >> 4; float rsv[2][4]; rs.get8(u.pm * BM + wr * 64 + fr, fq, rsv);
        const int cw = wc * 32 + 4 * fq;
#pragma unroll
        for (int ai = 0; ai < 2; ++ai)
#pragma unroll
            for (int m = 0; m < 4; ++m) { const int row = u.pm * BM + ai * HALF + wr * 64 + m * 16 + fr; const float r = rsv[ai][m];
                if (u.pn == 0) { float sq = 0.f;
#pragma unroll
                    for (int bj = 0; bj < 2; ++bj)
#pragma unroll
                        for (int n = 0; n < 2; ++n) { const int c = cw + bj * HALF + n * 16; const f32x4 v = acc[ai][bj][m][n] * r;
                            *(f32x4*)(ckvu + (size_t)row * 256 + c) = v; *(u32x2*)(ckvub + (size_t)row * 256 + c) = pk4(v); sq += dot4(v); }
                    sq += __shfl_xor(sq, 16); sq += __shfl_xor(sq, 32); if (fq == 0) ssqkv[(size_t)row * 4 + wc] = sq;
                } else if (u.pn == 1) { float sq = 0.f;
#pragma unroll
                    for (int bj = 0; bj < 2; ++bj)
#pragma unroll
                        for (int n = 0; n < 2; ++n) { const int c = cw + bj * HALF + n * 16; const f32x4 v = acc[ai][bj][m][n] * r;
                            *(u32x2*)(cq + (size_t)row * 384 + c) = pk4(v); sq += dot4(v); }
                    sq += __shfl_xor(sq, 16); sq += __shfl_xor(sq, 32); if (fq == 0) ssqq[(size_t)row * 8 + wc] = sq;
                } else { float sq = 0.f;
#pragma unroll
                    for (int n = 0; n < 2; ++n) { const int c = 256 + cw + n * 16; const f32x4 v = acc[ai][0][m][n] * r;
                        *(u32x2*)(cq + (size_t)row * 384 + c) = pk4(v); sq += dot4(v); }
                    sq += __shfl_xor(sq, 16); sq += __shfl_xor(sq, 32); if (fq == 0) ssqq[(size_t)row * 8 + 4 + wc] = sq;
                    if (wc == 0) { const int pos = row_pos(row); const f32x4 cs = *(const f32x4*)(ropc + pos * 16 + 4 * fq), sn = *(const f32x4*)(rops + pos * 16 + 4 * fq);
                        const f32x4 x1 = acc[ai][1][m][0] * r, x2 = acc[ai][1][m][1] * r; const f32x4 o1 = x1 * cs - x2 * sn, o2 = x1 * sn + x2 * cs;
                        *(u32x2*)(krb + (size_t)row * 32 + 4 * fq) = pk4(o1); *(u32x2*)(krb + (size_t)row * 32 + 16 + 4 * fq) = pk4(o2);
                        float* F = (row < MP) ? mrp + (size_t)row * 32 : mrs + (size_t)(row - MP) * 32;
                        *(f32x4*)(F + 4 * fq) = o1; *(f32x4*)(F + 16 + 4 * fq) = o2; }
                }
                if (m & 1) EPI_FENCE(); }
    }
};
struct EpiMlaQ { static constexpr bool PERM = false, AFTER_DRAIN = false;
    RowScale rs; bf16_t* QM; const float *ropc, *rops;
    __device__ __forceinline__ void operator()(const f32x4 (&acc)[2][2][4][2], const Unit& u, int wr, int wc, int, int) const { const int lane_ = pg8_tid() & 63, fr = lane_ & 15, fq = lane_ >> 4; float rsv[2][4]; rs.get8(u.pm * BM + wr * 64 + fr, fq, rsv);
#pragma unroll
        for (int ai = 0; ai < 2; ++ai)
#pragma unroll
            for (int m = 0; m < 4; ++m) { const int row = u.pm * BM + ai * HALF + wr * 64 + m * 16 + fr; const float r = rsv[ai][m] * C2_MLA;
                const int pos = row_pos(row);
#pragma unroll
                for (int bj = 0; bj < 2; ++bj) { const int g32 = u.pn * 8 + bj * 4 + wc; const int c = g32 * 32 + 4 * fq; bf16_t* o = QM + (size_t)row * 1536 + c;
                    if ((g32 % 3) == 2) { const f32x4 cs = *(const f32x4*)(ropc + pos * 16 + 4 * fq), sn = *(const f32x4*)(rops + pos * 16 + 4 * fq);
                        const f32x4 x1 = acc[ai][bj][m][0] * r, x2 = acc[ai][bj][m][1] * r;
                        *(u32x2*)(o) = pk4(x1 * cs - x2 * sn); *(u32x2*)(o + 16) = pk4(x1 * sn + x2 * cs);
                    } else { *(u32x2*)(o) = pk4(acc[ai][bj][m][0] * r); *(u32x2*)(o + 16) = pk4(acc[ai][bj][m][1] * r); } }
                EPI_FENCE(); }
    }
};
struct EpiMemKV { static constexpr bool PERM = false, AFTER_DRAIN = false;
    float* outk; float* outv; bf16_t* MKB; bf16_t* MVB;
    __device__ __forceinline__ void operator()(const f32x4 (&acc)[2][2][4][2], const Unit& u, int wr, int wc, int, int) const { const int lane_ = pg8_tid() & 63, fr = lane_ & 15, fq = lane_ >> 4;
        const int l = u.pn >> 3, cw0 = (u.pn & 7) * 256; const bool isv = cw0 >= 1024; const int cbase = (cw0 & 1023) + wc * 32 + 4 * fq;
#pragma unroll
        for (int ai = 0; ai < 2; ++ai)
#pragma unroll
            for (int m = 0; m < 4; ++m) { const int row = u.pm * BM + ai * HALF + wr * 64 + m * 16 + fr; const int b = row >> 8, nn = row & 255;
#pragma unroll
                for (int bj = 0; bj < 2; ++bj)
#pragma unroll
                    for (int n = 0; n < 2; ++n) { const int c = cbase + bj * HALF + n * 16; const f32x4 v = acc[ai][bj][m][n]; const size_t o = ((size_t)l * 2048 + row) * 1024 + c;
                        if (!isv) { *(f32x4*)(outk + o) = v; *(u32x2*)(MKB + o) = pk4(v); } else { *(f32x4*)(outv + o) = v; *(u32x2*)(MVB + o) = pk4(v); } }
                if (m & 1) EPI_FENCE(); }
    }
};

template <class Epi, class Sched, bool ALIGN_EPI = false, bool SP2 = false>
__device__ __forceinline__ void gemm_phase(PG8_LAS unsigned char* lds, const Gemm g, const Sched& S, const Epi& E) {
    const int tid = pg8_tid(), wid = __builtin_amdgcn_readfirstlane(tid >> 6), lane = tid & 63, wr = wid >> 2, wc = wid & 3, fr = lane & 15, fq = lane >> 4;
    const int K = g.K, nt = K / BK;
    unsigned voffA[2], voffB[2];
#pragma unroll
    for (int i = 0; i < 2; ++i) { int R, C; stage_rc(tid * 16 + i * 8192, R, C); const int Rb = Epi::PERM ? ((R & ~31) + perm32(R & 31)) : R;
        voffA[i] = (unsigned)(R * K + C) * 2u; voffB[i] = (unsigned)(Rb * K + C) * 2u; }
    const size_t kstep = (size_t)(BK * 2);
    const size_t hstep = (size_t)HALF * K * 2;
    const size_t tstep = 2 * hstep;
    const unsigned ldsw = (unsigned)wid * 1024u;
    const int aoff = lds_byte(wr * 64 + fr, fq * 8), boff = lds_byte(wc * 32 + fr, fq * 8);
#define PG8_SA(b, h) (((b) * 2 + (h)) * HTB)
#define PG8_SB(b, h) ((4 + (b) * 2 + (h)) * HTB)
#define PG8_STAGE(bufoff, gbase, voff) do { _Pragma("unroll") for (int _i = 0; _i < 2; ++_i) \
        __builtin_amdgcn_global_load_lds((const unsigned*)((const char*)(gbase) + (voff)[_i]), (PG8_LAS unsigned*)(lds + (bufoff) + ldsw + _i * 8192), 16, 0, 0); } while (0)
#define PG8_LDA(dst, b, h) do { _Pragma("unroll") for (int m = 0; m < 4; ++m) _Pragma("unroll") for (int k = 0; k < 2; ++k) dst[m][k] = *(const PG8_LAS bf16x8*)(lds + PG8_SA(b, h) + aoff + m * 2048 + k * 1024); } while (0)
#define PG8_LDB(dst, b, h) do { _Pragma("unroll") for (int n = 0; n < 2; ++n) _Pragma("unroll") for (int k = 0; k < 2; ++k) dst[n][k] = *(const PG8_LAS bf16x8*)(lds + PG8_SB(b, h) + boff + n * 2048 + k * 1024); } while (0)
#define PG8_MMA(ai, bj, At, Bt) do { __builtin_amdgcn_s_setprio(1); _Pragma("unroll") for (int m = 0; m < 4; ++m) _Pragma("unroll") for (int n = 0; n < 2; ++n) _Pragma("unroll") for (int k = 0; k < 2; ++k) \
        acc[ai][bj][m][n] = __builtin_amdgcn_mfma_f32_16x16x32_bf16(Bt[n][k], At[m][k], acc[ai][bj][m][n], 0, 0, 0); __builtin_amdgcn_s_setprio(0); } while (0)
#define PG8_WAIT_V(n) asm volatile("s_waitcnt vmcnt(" #n ")" ::: "memory")
#define PG8_WAIT_L(n) asm volatile("s_waitcnt lgkmcnt(" #n ")" ::: "memory")
#define PG8_BAR __builtin_amdgcn_s_barrier()
#define PG8_SCHED __builtin_amdgcn_sched_barrier(0)
    Unit cur, nxt; int ui = 0;
    if (!S.next(0, cur)) return;
    f32x4 acc[2][2][4][2];
#pragma unroll
    for (int a = 0; a < 2; ++a)
#pragma unroll
        for (int b = 0; b < 2; ++b)
#pragma unroll
            for (int m = 0; m < 4; ++m)
#pragma unroll
                for (int n = 0; n < 2; ++n) acc[a][b][m][n] = (f32x4){0.f, 0.f, 0.f, 0.f};
    bf16x8 At[4][2], B0[2][2], B1[2][2];
    const char* cA = (const char*)g.A + (size_t)cur.pm * tstep; const char* cB = (const char*)g.Bt + (size_t)cur.pn * tstep;
    S.a_ready(cur);
    if constexpr (SP2) {
        PG8_STAGE(PG8_SB(0, 0), cB, voffB); PG8_STAGE(PG8_SB(0, 1), cB + hstep, voffB); PG8_STAGE(PG8_SA(0, 0), cA, voffA); PG8_STAGE(PG8_SA(0, 1), cA + hstep, voffA);
        if (wr == 1) PG8_BAR;
        PG8_WAIT_V(2); PG8_BAR;
        PG8_STAGE(PG8_SB(1, 0), cB + kstep, voffB); PG8_STAGE(PG8_SA(1, 0), cA + kstep, voffA); PG8_STAGE(PG8_SB(1, 1), cB + hstep + kstep, voffB);
        PG8_WAIT_V(6); PG8_BAR;
    } else {
        PG8_STAGE(PG8_SB(0, 0), cB, voffB); PG8_STAGE(PG8_SA(0, 0), cA, voffA); PG8_STAGE(PG8_SB(0, 1), cB + hstep, voffB); PG8_STAGE(PG8_SA(0, 1), cA + hstep, voffA);
        if (wr == 1) PG8_BAR;
        PG8_WAIT_V(4); PG8_BAR;
        PG8_STAGE(PG8_SB(1, 0), cB + kstep, voffB); PG8_STAGE(PG8_SA(1, 0), cA + kstep, voffA); PG8_STAGE(PG8_SB(1, 1), cB + hstep + kstep, voffB);
        PG8_WAIT_V(6); PG8_BAR;
    }
    for (;;) {
        const bool has_next = S.next(ui + 1, nxt);
        const char* nA = has_next ? (const char*)g.A + (size_t)nxt.pm * tstep : cA; const char* nB = has_next ? (const char*)g.Bt + (size_t)nxt.pn * tstep : cB;
        for (int t = 0; t < nt; t += 2) {
            const bool last = (t == nt - 2);
            const char* a1 = cA + (size_t)(t + 1) * kstep;
            const char* a2 = last ? nA : cA + (size_t)(t + 2) * kstep; const char* b2 = last ? nB : cB + (size_t)(t + 2) * kstep;
            const char* a3 = a2 + kstep; const char* b3 = b2 + kstep;
            if (last && has_next) S.a_ready(nxt);
            if constexpr (SP2) {
            PG8_LDB(B0, 0, 0); PG8_LDB(B1, 0, 1); PG8_SCHED; PG8_LDA(At, 0, 0); PG8_STAGE(PG8_SA(1, 1), a1 + hstep, voffA);
            PG8_WAIT_V(8); PG8_WAIT_L(0); PG8_BAR; PG8_MMA(0, 0, At, B0); PG8_MMA(0, 1, At, B1); PG8_BAR; PG8_SCHED;
            PG8_LDA(At, 0, 1); PG8_STAGE(PG8_SB(0, 0), b2, voffB); PG8_STAGE(PG8_SB(0, 1), b2 + hstep, voffB); PG8_STAGE(PG8_SA(0, 0), a2, voffA);
            PG8_WAIT_V(8); PG8_WAIT_L(0); PG8_BAR; PG8_MMA(1, 0, At, B0); PG8_MMA(1, 1, At, B1); PG8_BAR; PG8_SCHED;
            PG8_LDB(B0, 1, 0); PG8_LDB(B1, 1, 1); PG8_SCHED; PG8_LDA(At, 1, 0); PG8_STAGE(PG8_SA(0, 1), a2 + hstep, voffA);
            PG8_WAIT_V(8); PG8_WAIT_L(0); PG8_BAR; PG8_MMA(0, 0, At, B0); PG8_MMA(0, 1, At, B1); PG8_BAR; PG8_SCHED;
            PG8_LDA(At, 1, 1); PG8_STAGE(PG8_SB(1, 0), b3, voffB); PG8_STAGE(PG8_SB(1, 1), b3 + hstep, voffB); PG8_STAGE(PG8_SA(1, 0), a3, voffA);
            PG8_WAIT_V(8); PG8_WAIT_L(0); PG8_BAR; PG8_MMA(1, 0, At, B0); PG8_MMA(1, 1, At, B1); PG8_BAR; PG8_SCHED;
            } else {
            PG8_LDB(B0, 0, 0); PG8_SCHED; PG8_LDA(At, 0, 0); PG8_STAGE(PG8_SA(1, 1), a1 + hstep, voffA);
            PG8_WAIT_L(8); PG8_BAR; PG8_WAIT_L(0); PG8_MMA(0, 0, At, B0); PG8_BAR; PG8_SCHED;
            PG8_LDB(B1, 0, 1); PG8_STAGE(PG8_SB(0, 0), b2, voffB);
            PG8_BAR; PG8_WAIT_L(0); PG8_MMA(0, 1, At, B1); PG8_BAR;
            PG8_LDA(At, 0, 1); PG8_STAGE(PG8_SA(0, 0), a2, voffA);
            PG8_BAR; PG8_WAIT_L(0); PG8_MMA(1, 0, At, B0); PG8_BAR; PG8_SCHED;
            PG8_STAGE(PG8_SB(0, 1), b2 + hstep, voffB);
            PG8_WAIT_V(6); PG8_BAR; PG8_MMA(1, 1, At, B1); PG8_BAR;
            PG8_LDB(B0, 1, 0); PG8_SCHED; PG8_LDA(At, 1, 0); PG8_STAGE(PG8_SA(0, 1), a2 + hstep, voffA);
            PG8_WAIT_L(8); PG8_BAR; PG8_WAIT_L(0); PG8_MMA(0, 0, At, B0); PG8_BAR; PG8_SCHED;
            PG8_LDB(B1, 1, 1); PG8_STAGE(PG8_SB(1, 0), b3, voffB);
            PG8_BAR; PG8_WAIT_L(0); PG8_MMA(0, 1, At, B1); PG8_BAR;
            PG8_LDA(At, 1, 1); PG8_STAGE(PG8_SA(1, 0), a3, voffA);
            PG8_BAR; PG8_WAIT_L(0); PG8_MMA(1, 0, At, B0); PG8_BAR; PG8_SCHED;
            PG8_STAGE(PG8_SB(1, 1), b3 + hstep, voffB);
            PG8_WAIT_V(6); PG8_BAR; PG8_MMA(1, 1, At, B1); PG8_BAR;
            }
        }
        if constexpr (ALIGN_EPI) { if (wr == 0) PG8_BAR; }
        if constexpr (!Epi::AFTER_DRAIN) { E(acc, cur, wr, wc, fr, fq); S.done(cur); }
        if (!has_next) break;
#pragma unroll
        for (int a = 0; a < 2; ++a)
#pragma unroll
            for (int b = 0; b < 2; ++b)
#pragma unroll
                for (int m = 0; m < 4; ++m)
#pragma unroll
                    for (int n = 0; n < 2; ++n) acc[a][b][m][n] = (f32x4){0.f, 0.f, 0.f, 0.f};
        cur = nxt; cA = nA; cB = nB; ++ui;
        if constexpr (ALIGN_EPI) { if (wr == 1) PG8_BAR; }
    }
    PG8_WAIT_V(0);
    if constexpr (!ALIGN_EPI) { if (wr == 0) PG8_BAR; }
    PG8_BAR;
    if constexpr (Epi::AFTER_DRAIN) { E.fused(acc, cur, wr, wc, fr, fq, lds, wid, lane); S.done(cur); }
#undef PG8_SA
#undef PG8_SB
#undef PG8_STAGE
#undef PG8_LDA
#undef PG8_LDB
#undef PG8_MMA
#undef PG8_WAIT_V
#undef PG8_WAIT_L
#undef PG8_BAR
#undef PG8_SCHED
}
}

#define GAS __attribute__((address_space(1)))
#define LAS __attribute__((address_space(3)))
typedef unsigned short bf16;
typedef float f32x4 __attribute__((ext_vector_type(4)));
typedef float f32x16 __attribute__((ext_vector_type(16)));
typedef short bf16x8 __attribute__((ext_vector_type(8)));
typedef short s16x4 __attribute__((ext_vector_type(4)));
typedef unsigned u32x4 __attribute__((ext_vector_type(4)));
typedef unsigned u32x2 __attribute__((ext_vector_type(2)));
typedef GAS unsigned gu32;
#define RLX_AGENT __ATOMIC_RELAXED, __HIP_MEMORY_SCOPE_AGENT
#define LDS_WAIT() asm volatile("s_waitcnt lgkmcnt(0)" ::: "memory")
#define VM_WAIT() asm volatile("s_waitcnt vmcnt(0)" ::: "memory")
__device__ __forceinline__ unsigned pk2(float lo, float hi) { return pg8::pk_bf16(lo, hi); }
__device__ __forceinline__ float bf2f(unsigned short b) { return __builtin_bit_cast(float, (unsigned)b << 16); }
__device__ __forceinline__ float ex2(float x) { return __builtin_amdgcn_exp2f(x); }
__device__ __forceinline__ float wave_sum(float v) {
#pragma unroll
    for (int o = 1; o < 64; o <<= 1) v += __shfl_xor(v, o);
    return v;
}

namespace fa {
constexpr int KSLOT = 12288, VSLOT = 8192;
constexpr int L_K = 0, L_V = 2 * KSLOT, L_WS = L_V + 2 * VSLOT, L_OST = L_WS + 8 * 64 * 4, L_BYTES = L_OST + 8 * 32 * 64 * 4;
constexpr int L_WS2 = L_V + 3 * VSLOT, L_CB2 = L_WS2 + 8 * 128 * 4, L_OST2 = L_CB2 + 512, L_QR2 = L_OST2 + 8 * 4096, L_BYTES2 = L_QR2 + 8 * 4096;
__device__ __forceinline__ int crow(int r, int hi) { return (r & 3) + 8 * (r >> 2) + 4 * hi; }
__device__ __forceinline__ void glds16(const void* gsrc, unsigned lds_dst) { unsigned keep;
    asm volatile("s_mov_b32 %0, m0\n\ts_mov_b32 m0, %2\n\ts_nop 0\n\tglobal_load_lds_dwordx4 %1, off\n\ts_mov_b32 m0, %0" : "=&s"(keep) : "v"(gsrc), "s"(lds_dst) : "memory"); }
#define FA_WAIT_BAR() asm volatile("s_waitcnt vmcnt(0) lgkmcnt(0)\n\ts_barrier" ::: "memory")
#define FA_SBAR() __builtin_amdgcn_sched_barrier(0)
template <int ND0> __device__ __forceinline__ void qkt(f32x16& p0, f32x16& p1, const LAS char* kp, const bf16x8* qr) {
    p0 = f32x16{}; p1 = f32x16{};
#pragma unroll
    for (int d0 = 0; d0 < ND0; ++d0) {
        const bf16x8 b0 = *(const LAS bf16x8*)(kp + d0 * 2048);
        const bf16x8 b1 = *(const LAS bf16x8*)(kp + d0 * 2048 + 512);
        p0 = __builtin_amdgcn_mfma_f32_32x32x16_bf16(b0, qr[d0], p0, 0, 0, 0); p1 = __builtin_amdgcn_mfma_f32_32x32x16_bf16(b1, qr[d0], p1, 0, 0, 0); }
}
__device__ __forceinline__ float max3f(float a, float b, float c) { float r; asm("v_max3_f32 %0, %1, %2, %3" : "=v"(r) : "v"(a), "v"(b), "v"(c)); return r; }
__device__ __forceinline__ float max2f(float a, float b) { float r; asm("v_max_f32_e32 %0, %1, %2" : "=v"(r) : "v"(a), "v"(b)); return r; }
__device__ __forceinline__ float rowmax_a(const f32x16& p0, const f32x16& p1) {
    float a = max3f(p0[0], p0[1], p1[0]), b = max3f(p0[2], p0[3], p1[1]); a = max3f(a, p1[2], p1[3]);
#pragma unroll
    for (int r = 4; r < 16; r += 4) { a = max3f(a, p0[r], p0[r + 1]); b = max3f(b, p0[r + 2], p0[r + 3]); a = max3f(a, p1[r], p1[r + 1]); b = max3f(b, p1[r + 2], p1[r + 3]); }
    const float m = max2f(a, b);
    auto rr = __builtin_amdgcn_permlane32_swap(__float_as_uint(m), __float_as_uint(m), false, false);
    return max2f(__uint_as_float(rr[0]), __uint_as_float(rr[1]));
}
__device__ __forceinline__ float rowmax(const f32x16& p0, const f32x16& p1) {
    float a = __builtin_fmaxf(p0[0], p1[0]);
#pragma unroll
    for (int r = 1; r < 16; ++r) a = __builtin_fmaxf(a, __builtin_fmaxf(p0[r], p1[r]));
    auto rr = __builtin_amdgcn_permlane32_swap(__float_as_uint(a), __float_as_uint(a), false, false);
    return __builtin_fmaxf(__uint_as_float(rr[0]), __uint_as_float(rr[1]));
}
__device__ __forceinline__ void pv(f32x16* o, int vb, bf16x8 pa0, bf16x8 pa1, bf16x8 pa2, bf16x8 pa3) {
#pragma unroll
    for (int d0 = 0; d0 < 2; ++d0) { s16x4 lo[4], hi[4];
#pragma unroll
        for (int ks = 0; ks < 4; ++ks) {
            asm volatile("ds_read_b64_tr_b16 %0,%1 offset:%c2" : "=&v"(lo[ks]) : "v"(vb), "i"(d0 * 4096 + ks * 1024) : "memory");
            asm volatile("ds_read_b64_tr_b16 %0,%1 offset:%c2" : "=&v"(hi[ks]) : "v"(vb), "i"(d0 * 4096 + ks * 1024 + 512) : "memory"); }
        asm volatile("s_waitcnt lgkmcnt(0)" ::: "memory"); FA_SBAR();
#define FA_PK(k) (bf16x8){lo[k][0], lo[k][1], lo[k][2], lo[k][3], hi[k][0], hi[k][1], hi[k][2], hi[k][3]}
        o[d0] = __builtin_amdgcn_mfma_f32_32x32x16_bf16(pa0, FA_PK(0), o[d0], 0, 0, 0);
        o[d0] = __builtin_amdgcn_mfma_f32_32x32x16_bf16(pa1, FA_PK(1), o[d0], 0, 0, 0);
        o[d0] = __builtin_amdgcn_mfma_f32_32x32x16_bf16(pa2, FA_PK(2), o[d0], 0, 0, 0);
        o[d0] = __builtin_amdgcn_mfma_f32_32x32x16_bf16(pa3, FA_PK(3), o[d0], 0, 0, 0);
#undef FA_PK
    }
}
struct Args { const bf16* Q; int qpitch, qcol; const bf16* K; int kpitch, kcol; const bf16* K2; const bf16* V; int vpitch, vcol; bf16* O; int ocol; const bf16* G; const float* CB; };
template <int MODE> __device__ __forceinline__ void unit(const Args& A, long rowbase, int qb, LAS char* lds, unsigned lds0) {
    constexpr int ND0 = MODE ? 6 : 4;
    const int tid = pg8::pg8_tid(), lane = tid & 63, r32 = lane & 31, hi = lane >> 5; const int wid = __builtin_amdgcn_readfirstlane(tid >> 6);
    const int q0 = qb * 256, NT = q0 / 64 + 4, nt_w = MODE ? (q0 / 64 + (wid >> 1) + 1) : NT;
    const bf16* Qw = A.Q + (rowbase + q0 + wid * 32 + r32) * A.qpitch + A.qcol + hi * 8;
    bf16x8 qr[ND0];
#pragma unroll
    for (int d0 = 0; d0 < ND0; ++d0) qr[d0] = *(const bf16x8*)(Qw + d0 * 16);
    const bf16* ksrc = A.K + (rowbase + lane) * A.kpitch + A.kcol + wid * 8;
    const bf16* ksrc2 = MODE ? A.K2 + (rowbase + lane) * 32 + (wid & 3) * 8 : nullptr;
    const bf16* vsrc = A.V + (rowbase + 16 * (wid & 3) + (lane >> 2)) * A.vpitch + A.vcol + (wid >> 2) * 32 + (lane & 3) * 8;
#define FA_DMA(t, slot) do { \
        glds16(ksrc + (long)(t) * 64 * A.kpitch, (unsigned)__builtin_amdgcn_readfirstlane(lds0 + L_K + (slot) * KSLOT + wid * 1024)); \
        if (MODE && wid < 4) glds16(ksrc2 + (long)(t) * 64 * 32, (unsigned)__builtin_amdgcn_readfirstlane(lds0 + L_K + (slot) * KSLOT + (8 + wid) * 1024)); \
        glds16(vsrc + (long)(t) * 64 * A.vpitch, (unsigned)__builtin_amdgcn_readfirstlane(lds0 + L_V + (slot) * VSLOT + wid * 1024)); } while (0)
    LAS float* wsf = (LAS float*)(lds + L_WS) + wid * 64;
    const int vb0 = (int)(lds0 + L_V) + ((lane >> 4) & 1) * 32 + (lane & 3) * 8 + (4 * hi + ((lane & 15) >> 2)) * 64;
    float m = -1e30f, l = 0.f; f32x16 o[2]; o[0] = f32x16{}; o[1] = f32x16{};
    FA_DMA(0, 0);
    for (int t = 0; t < NT; ++t) {
        FA_WAIT_BAR();
        if (t + 1 < NT) FA_DMA(t + 1, (t + 1) & 1);
        if (t < nt_w) {
            const int slot = t & 1;
            f32x16 p0, p1; qkt<ND0>(p0, p1, lds + L_K + slot * KSLOT + hi * 1024 + r32 * 16, qr);
            if (MODE == 0) {
                const float* cb = A.CB + t * 64 + 4 * hi;
#pragma unroll
                for (int g4 = 0; g4 < 4; ++g4) { const f32x4 b0 = *(const f32x4*)(cb + 8 * g4), b1 = *(const f32x4*)(cb + 32 + 8 * g4);
#pragma unroll
                    for (int i = 0; i < 4; ++i) { p0[4 * g4 + i] += b0[i]; p1[4 * g4 + i] += b1[i]; } }
                const int jb = t - (NT - 4);
                if (jb >= 0) { const int qrel = wid * 32 + r32, kb = 64 * jb + 4 * hi;
#pragma unroll
                    for (int r = 0; r < 16; ++r) { const int kv = kb + (r & 3) + 8 * (r >> 2); if (kv > qrel) p0[r] = -INFINITY; if (kv + 32 > qrel) p1[r] = -INFINITY; } }
            }
            const float rm = rowmax(p0, p1);
            const float mn = __builtin_fmaxf(m, rm), alpha = ex2(m - mn); m = mn;
            float sacc = 0.f;
#pragma unroll
            for (int r = 0; r < 16; ++r) { p0[r] = ex2(p0[r] - mn); p1[r] = ex2(p1[r] - mn); sacc += p0[r] + p1[r]; }
            l = l * alpha + sacc;
            if (hi == 0) wsf[r32] = alpha;
#pragma unroll
            for (int r = 0; r < 16; ++r) { const float a = wsf[crow(r, hi)]; o[0][r] *= a; o[1][r] *= a; }
            u32x4 pw0, pw1, pw2, pw3;
            pw0 = (u32x4){pk2(p0[0], p0[1]), pk2(p0[2], p0[3]), pk2(p0[4], p0[5]), pk2(p0[6], p0[7])};
            pw1 = (u32x4){pk2(p0[8], p0[9]), pk2(p0[10], p0[11]), pk2(p0[12], p0[13]), pk2(p0[14], p0[15])};
            pw2 = (u32x4){pk2(p1[0], p1[1]), pk2(p1[2], p1[3]), pk2(p1[4], p1[5]), pk2(p1[6], p1[7])};
            pw3 = (u32x4){pk2(p1[8], p1[9]), pk2(p1[10], p1[11]), pk2(p1[12], p1[13]), pk2(p1[14], p1[15])};
            FA_SBAR();
            pv(o, vb0 + slot * VSLOT, __builtin_bit_cast(bf16x8, pw0), __builtin_bit_cast(bf16x8, pw1), __builtin_bit_cast(bf16x8, pw2), __builtin_bit_cast(bf16x8, pw3));
        }
    }
    { auto rr = __builtin_amdgcn_permlane32_swap(__float_as_uint(l), __float_as_uint(l), false, false); l = __uint_as_float(rr[0]) + __uint_as_float(rr[1]); }
    if (hi == 0) wsf[32 + r32] = l;
    LAS float* stg = (LAS float*)(lds + L_OST) + wid * 2048;
#pragma unroll
    for (int r = 0; r < 16; ++r) { const int orow = crow(r, hi); const float rl = __builtin_amdgcn_rcpf(wsf[32 + orow]);
        stg[orow * 64 + r32] = o[0][r] * rl; stg[orow * 64 + 32 + r32] = o[1][r] * rl; }
    LDS_WAIT();
#pragma unroll
    for (int i = 0; i < 4; ++i) { const int row = i * 8 + (lane >> 3), ch = lane & 7; const long grow = rowbase + q0 + wid * 32 + row;
        f32x4 a = *(const LAS f32x4*)(stg + row * 64 + ch * 8), b = *(const LAS f32x4*)(stg + row * 64 + ch * 8 + 4);
        if (MODE == 0) { const u32x4 g = *(const u32x4*)(A.G + grow * 1024 + A.ocol + ch * 8);
            a[0] *= __uint_as_float(g.x << 16); a[1] *= __uint_as_float(g.x & 0xffff0000u); a[2] *= __uint_as_float(g.y << 16); a[3] *= __uint_as_float(g.y & 0xffff0000u);
            b[0] *= __uint_as_float(g.z << 16); b[1] *= __uint_as_float(g.z & 0xffff0000u); b[2] *= __uint_as_float(g.w << 16); b[3] *= __uint_as_float(g.w & 0xffff0000u); }
        const u32x4 w = (u32x4){pk2(a[0], a[1]), pk2(a[2], a[3]), pk2(b[0], b[1]), pk2(b[2], b[3])};
        *(u32x4*)(A.O + grow * 1024 + A.ocol + ch * 8) = w; }
    asm volatile("s_waitcnt lgkmcnt(0)\n\ts_barrier" ::: "memory");
#undef FA_DMA
}

#ifndef FA_STAG_FOX
#define FA_STAG_FOX 1
#endif
#ifndef FA_STAG_MLA
#define FA_STAG_MLA 1
#endif
#ifndef FA_PROBE_VALU
#define FA_PROBE_VALU 0
#endif
__device__ __forceinline__ void glds4(const void* gsrc, unsigned lds_dst) { unsigned keep;
    asm volatile("s_mov_b32 %0, m0\n\ts_mov_b32 m0, %2\n\ts_nop 0\n\tglobal_load_lds_dword %1, off\n\ts_mov_b32 m0, %0" : "=&s"(keep) : "v"(gsrc), "s"(lds_dst) : "memory"); }
__device__ __forceinline__ s16x4 vtr(const LAS char* p) { typedef short v4i16_t __attribute__((ext_vector_type(4))); return __builtin_bit_cast(s16x4, __builtin_amdgcn_ds_read_tr16_b64_v4i16((LAS v4i16_t*)p)); }
template <int MODE, bool DIAG> __device__ __forceinline__ void tile_qs(const LAS char* kp, const bf16x8 (&qr)[2][4], const LAS char* qrl, const LAS float* cbl, int r32, int hi,
                                                                     float (&m)[2], float (&l)[2], f32x16 (&o)[2][2], LAS float* wsf, u32x4 (&pw)[2][4]) {
    constexpr int ND0 = MODE ? 6 : 4;
    f32x16 p[2][2];
    if (MODE == 0) {
#pragma unroll
        for (int g4 = 0; g4 < 4; ++g4) { const f32x4 b0 = *(const LAS f32x4*)(cbl + 4 * hi + 8 * g4), b1 = *(const LAS f32x4*)(cbl + 32 + 4 * hi + 8 * g4);
#pragma unroll
            for (int i = 0; i < 4; ++i) { p[0][0][4 * g4 + i] = b0[i]; p[0][1][4 * g4 + i] = b1[i]; } }
        p[1][0] = p[0][0]; p[1][1] = p[0][1];
    } else {
#pragma unroll
        for (int b2 = 0; b2 < 2; ++b2) { p[b2][0] = f32x16{}; p[b2][1] = f32x16{}; }
    }
    bf16x8 qx[2][2];
    if (MODE) {
#pragma unroll
        for (int b2 = 0; b2 < 2; ++b2) { qx[b2][0] = *(const LAS bf16x8*)(qrl + (b2 * 2) * 1024); qx[b2][1] = *(const LAS bf16x8*)(qrl + (b2 * 2 + 1) * 1024); } }
#pragma unroll
    for (int d0 = 0; d0 < ND0; ++d0) { const bf16x8 k0 = *(const LAS bf16x8*)(kp + d0 * 2048), k1 = *(const LAS bf16x8*)(kp + d0 * 2048 + 512);
#pragma unroll
        for (int b2 = 0; b2 < 2; ++b2) { const bf16x8 qv = (d0 < 4) ? qr[b2][d0 & 3] : qx[b2][d0 & 1];
            p[b2][0] = __builtin_amdgcn_mfma_f32_32x32x16_bf16(k0, qv, p[b2][0], 0, 0, 0); p[b2][1] = __builtin_amdgcn_mfma_f32_32x32x16_bf16(k1, qv, p[b2][1], 0, 0, 0); } }
    if (MODE == 0 && DIAG) {
#pragma unroll
        for (int b2 = 0; b2 < 2; ++b2) { const int qrel = 32 * b2 + r32;
#pragma unroll
            for (int r = 0; r < 16; ++r) { const int kv = 4 * hi + (r & 3) + 8 * (r >> 2); if (kv > qrel) p[b2][0][r] = -INFINITY; if (kv + 32 > qrel) p[b2][1][r] = -INFINITY; } } }
    asm volatile("s_nop 15\n\ts_nop 7" : "+v"(p[0][0]), "+v"(p[0][1]), "+v"(p[1][0]), "+v"(p[1][1]));
#if FA_PROBE_VALU
    { float dd[8];
#pragma unroll
      for (int i = 0; i < 8; ++i) dd[i] = m[0] + (float)i;
#pragma unroll
      for (int k = 0; k < FA_PROBE_VALU; ++k)
#pragma unroll
        for (int i = 0; i < 8; ++i) dd[i] = ex2(dd[i]);
#pragma unroll
      for (int i = 0; i < 8; ++i) asm volatile("" :: "v"(dd[i])); }
#endif
#pragma unroll
    for (int b2 = 0; b2 < 2; ++b2) {
        const float rm = rowmax_a(p[b2][0], p[b2][1]);
        const float mn = max2f(m[b2], rm), alpha = ex2(m[b2] - mn); m[b2] = mn;
        typedef float f32x2s __attribute__((ext_vector_type(2))); f32x2s sa2 = {0.f, 0.f};
#pragma unroll
        for (int r = 0; r < 16; ++r) { p[b2][0][r] = ex2(p[b2][0][r] - mn); p[b2][1][r] = ex2(p[b2][1][r] - mn); sa2 += (f32x2s){p[b2][0][r], p[b2][1][r]}; }
        l[b2] = l[b2] * alpha + (sa2[0] + sa2[1]);
#pragma unroll
        for (int r = 0; r < 16; ++r) { o[b2][0][r] *= alpha; o[b2][1][r] *= alpha; }
        pw[b2][0] = (u32x4){pk2(p[b2][0][0], p[b2][0][1]), pk2(p[b2][0][2], p[b2][0][3]), pk2(p[b2][0][4], p[b2][0][5]), pk2(p[b2][0][6], p[b2][0][7])};
        pw[b2][1] = (u32x4){pk2(p[b2][0][8], p[b2][0][9]), pk2(p[b2][0][10], p[b2][0][11]), pk2(p[b2][0][12], p[b2][0][13]), pk2(p[b2][0][14], p[b2][0][15])};
        pw[b2][2] = (u32x4){pk2(p[b2][1][0], p[b2][1][1]), pk2(p[b2][1][2], p[b2][1][3]), pk2(p[b2][1][4], p[b2][1][5]), pk2(p[b2][1][6], p[b2][1][7])};
        pw[b2][3] = (u32x4){pk2(p[b2][1][8], p[b2][1][9]), pk2(p[b2][1][10], p[b2][1][11]), pk2(p[b2][1][12], p[b2][1][13]), pk2(p[b2][1][14], p[b2][1][15])};
    }
}
__device__ __forceinline__ void tile_pv(const LAS char* vp, f32x16 (&o)[2][2], const u32x4 (&pw)[2][4]) {
#pragma unroll
    for (int d0 = 0; d0 < 2; ++d0)
#pragma unroll
        for (int ks = 0; ks < 4; ++ks) { const s16x4 lo = vtr(vp + d0 * 4096 + ks * 1024), hi4 = vtr(vp + d0 * 4096 + ks * 1024 + 512);
            const bf16x8 vf = (bf16x8){lo[0], lo[1], lo[2], lo[3], hi4[0], hi4[1], hi4[2], hi4[3]};
#pragma unroll
            for (int b2 = 0; b2 < 2; ++b2) o[b2][d0] = __builtin_amdgcn_mfma_f32_32x32x16_bf16(vf, __builtin_bit_cast(bf16x8, pw[b2][ks]), o[b2][d0], 0, 0, 0); }
}
template <int MODE> __device__ __forceinline__ void unit2(const Args& A, long rowbase, int qb, LAS char* lds, unsigned lds0) {
    constexpr int ND0 = MODE ? 6 : 4;
    const int tid = pg8::pg8_tid(), lane = tid & 63, r32 = lane & 31, hi = lane >> 5; const int wid = __builtin_amdgcn_readfirstlane(tid >> 6);
    const int q0 = qb * 512, NT = q0 / 64 + 8, nt_w = q0 / 64 + wid + 1;
    bf16x8 qr[2][4];
    LAS char* qrl = lds + L_QR2 + wid * 4096 + lane * 16;
#pragma unroll
    for (int b2 = 0; b2 < 2; ++b2) { const bf16* Qw = A.Q + (rowbase + q0 + wid * 64 + b2 * 32 + r32) * A.qpitch + A.qcol + hi * 8;
#pragma unroll
        for (int d0 = 0; d0 < 4; ++d0) qr[b2][d0] = *(const bf16x8*)(Qw + d0 * 16);
        if (MODE) { *(LAS bf16x8*)(qrl + (b2 * 2) * 1024) = *(const bf16x8*)(Qw + 64); *(LAS bf16x8*)(qrl + (b2 * 2 + 1) * 1024) = *(const bf16x8*)(Qw + 80); } }
    const int koff = lane * A.kpitch + A.kcol + wid * 8, k2off = lane * 32 + (wid & 3) * 8, voff = (16 * (wid & 3) + (lane >> 2)) * A.vpitch + A.vcol + (wid >> 2) * 32 + (lane & 3) * 8;
    const bf16* Kb = A.K + rowbase * A.kpitch; const bf16* K2b = MODE ? A.K2 + rowbase * 32 : nullptr; const bf16* Vb = A.V + rowbase * A.vpitch;
#define FA_DMA(t, slot) do { \
        int ko_ = koff, k2o_ = k2off, vo_ = voff; asm volatile("" : "+v"(ko_), "+v"(k2o_), "+v"(vo_)); \
        glds16(Kb + (long)(t) * 64 * A.kpitch + ko_, (unsigned)__builtin_amdgcn_readfirstlane(lds0 + L_K + (slot) * KSLOT + wid * 1024)); \
        if (MODE && wid < 4) glds16(K2b + (long)(t) * 64 * 32 + k2o_, (unsigned)__builtin_amdgcn_readfirstlane(lds0 + L_K + (slot) * KSLOT + (8 + wid) * 1024)); \
        glds16(Vb + (long)(t) * 64 * A.vpitch + vo_, (unsigned)__builtin_amdgcn_readfirstlane(lds0 + L_V + ((t) % 3) * VSLOT + wid * 1024)); \
        if (!MODE && wid == 4) glds4(A.CB + (t) * 64 + lane, (unsigned)__builtin_amdgcn_readfirstlane(lds0 + L_CB2 + (slot) * 256)); } while (0)
    LAS float* wsf = (LAS float*)(lds + L_WS2) + wid * 128;
    const LAS char* kp0 = lds + L_K + hi * 1024 + r32 * 16;
    const LAS char* vp0 = lds + L_V + ((lane >> 4) & 1) * 32 + (lane & 3) * 8 + (4 * hi + ((lane & 15) >> 2)) * 64;
    float m[2] = {-1e30f, -1e30f}, l[2] = {0.f, 0.f}; f32x16 o[2][2];
#pragma unroll
    for (int b2 = 0; b2 < 2; ++b2) { o[b2][0] = f32x16{}; o[b2][1] = f32x16{}; }
    FA_DMA(0, 0);
    u32x4 pw[2][4];
#define FA_STEP_HEAD(t) FA_WAIT_BAR(); if ((t) + 1 < NT) FA_DMA((t) + 1, ((t) + 1) & 1); const int slot = (t) & 1; const LAS float* cbl = (const LAS float*)(lds + L_CB2 + slot * 256)
    if (wid < 4 || !(MODE ? FA_STAG_MLA : FA_STAG_FOX)) {
        int t = 0;
        for (; t < nt_w - 1; ++t) { FA_STEP_HEAD(t); tile_qs<MODE, false>(kp0 + slot * KSLOT, qr, qrl, cbl, r32, hi, m, l, o, wsf, pw); tile_pv(vp0 + (t % 3) * VSLOT, o, pw); }
        { FA_STEP_HEAD(t); tile_qs<MODE, true>(kp0 + slot * KSLOT, qr, qrl, cbl, r32, hi, m, l, o, wsf, pw); tile_pv(vp0 + (t % 3) * VSLOT, o, pw); ++t; }
        for (; t < NT; ++t) { FA_STEP_HEAD(t); (void)slot; (void)cbl; }
    } else {
        int t = 0;
        if (nt_w > 1) { FA_STEP_HEAD(0); tile_qs<MODE, false>(kp0 + slot * KSLOT, qr, qrl, cbl, r32, hi, m, l, o, wsf, pw); t = 1;
            for (; t < nt_w - 1; ++t) { FA_STEP_HEAD(t); tile_pv(vp0 + ((t - 1) % 3) * VSLOT, o, pw); FA_SBAR(); tile_qs<MODE, false>(kp0 + slot * KSLOT, qr, qrl, cbl, r32, hi, m, l, o, wsf, pw); }
            { FA_STEP_HEAD(t); tile_pv(vp0 + ((t - 1) % 3) * VSLOT, o, pw); FA_SBAR(); tile_qs<MODE, true>(kp0 + slot * KSLOT, qr, qrl, cbl, r32, hi, m, l, o, wsf, pw); ++t; }
        } else { FA_STEP_HEAD(0); tile_qs<MODE, true>(kp0 + slot * KSLOT, qr, qrl, cbl, r32, hi, m, l, o, wsf, pw); t = 1; }
        if (t < NT) { FA_STEP_HEAD(t); (void)slot; (void)cbl; tile_pv(vp0 + ((t - 1) % 3) * VSLOT, o, pw); ++t;
            for (; t < NT; ++t) { FA_STEP_HEAD(t); (void)slot; (void)cbl; } }
        else tile_pv(vp0 + ((NT - 1) % 3) * VSLOT, o, pw);
    }
#undef FA_STEP_HEAD
#pragma unroll
    for (int b2 = 0; b2 < 2; ++b2) {
        float lb = l[b2];
        { auto rr = __builtin_amdgcn_permlane32_swap(__float_as_uint(lb), __float_as_uint(lb), false, false); lb = __uint_as_float(rr[0]) + __uint_as_float(rr[1]); }
        const float rl = __builtin_amdgcn_rcpf(lb); const long grow = rowbase + q0 + wid * 64 + b2 * 32 + r32;
#pragma unroll
        for (int d0 = 0; d0 < 2; ++d0)
#pragma unroll
            for (int g4 = 0; g4 < 4; ++g4) { const int dc = A.ocol + 32 * d0 + 8 * g4 + 4 * hi;
                f32x4 v = (f32x4){o[b2][d0][4 * g4], o[b2][d0][4 * g4 + 1], o[b2][d0][4 * g4 + 2], o[b2][d0][4 * g4 + 3]} * rl;
                if (MODE == 0) { const u32x2 g = *(const u32x2*)(A.G + grow * 1024 + dc);
                    v[0] *= __uint_as_float(g.x << 16); v[1] *= __uint_as_float(g.x & 0xffff0000u); v[2] *= __uint_as_float(g.y << 16); v[3] *= __uint_as_float(g.y & 0xffff0000u); }
                *(u32x2*)(A.O + grow * 1024 + dc) = (u32x2){pk2(v[0], v[1]), pk2(v[2], v[3])}; }
    }
    asm volatile("s_waitcnt lgkmcnt(0)\n\ts_barrier" ::: "memory");
#undef FA_DMA
}
}

namespace a16 {
__device__ __forceinline__ f32x4 mfma16(bf16x8 a, bf16x8 b, f32x4 c) { return __builtin_amdgcn_mfma_f32_16x16x32_bf16(a, b, c, 0, 0, 0); }
template <int NQK, int NDB, class KL, class VL, class SF>
__device__ __forceinline__ void steps(int s0, int s1, const bf16x8 (&qf)[NQK], KL kload, VL vload, SF sfix, float& m, float& l, f32x4 (&o)[NDB], int lane) {
    const int g = lane >> 4;
    for (int s = s0; s < s1; ++s) {
        f32x4 sA = {0.f, 0.f, 0.f, 0.f}, sB = {0.f, 0.f, 0.f, 0.f};
#pragma unroll
        for (int d0 = 0; d0 < NQK; ++d0) { sA = mfma16(kload(s, 0, d0), qf[d0], sA); sB = mfma16(kload(s, 1, d0), qf[d0], sB); }
        sfix(s, sA, sB);
        float mx = __builtin_fmaxf(__builtin_fmaxf(__builtin_fmaxf(sA[0], sA[1]), __builtin_fmaxf(sA[2], sA[3])), __builtin_fmaxf(__builtin_fmaxf(sB[0], sB[1]), __builtin_fmaxf(sB[2], sB[3])));
        mx = __builtin_fmaxf(mx, __shfl_xor(mx, 16)); mx = __builtin_fmaxf(mx, __shfl_xor(mx, 32));
        const float mn = __builtin_fmaxf(m, mx), alpha = ex2(m - mn); m = mn;
        f32x4 pA, pB;
#pragma unroll
        for (int r = 0; r < 4; ++r) { pA[r] = ex2(sA[r] - mn); pB[r] = ex2(sB[r] - mn); }
        float ps = ((pA[0] + pA[1]) + (pA[2] + pA[3])) + ((pB[0] + pB[1]) + (pB[2] + pB[3]));
        ps += __shfl_xor(ps, 16); ps += __shfl_xor(ps, 32);
        l = l * alpha + ps;
        const float a0 = __shfl(alpha, 4 * g), a1 = __shfl(alpha, 4 * g + 1), a2 = __shfl(alpha, 4 * g + 2), a3 = __shfl(alpha, 4 * g + 3);
#pragma unroll
        for (int db = 0; db < NDB; ++db) { o[db][0] *= a0; o[db][1] *= a1; o[db][2] *= a2; o[db][3] *= a3; }
        const u32x4 pw = (u32x4){pk2(pA[0], pA[1]), pk2(pA[2], pA[3]), pk2(pB[0], pB[1]), pk2(pB[2], pB[3])};
        const bf16x8 pf = __builtin_bit_cast(bf16x8, pw);
#pragma unroll
        for (int db = 0; db < NDB; ++db) o[db] = mfma16(pf, vload(s, db), o[db]);
    }
}
__device__ __forceinline__ bf16x8 cvt8(f32x4 a, f32x4 b) { const u32x4 w = (u32x4){pk2(a[0], a[1]), pk2(a[2], a[3]), pk2(b[0], b[1]), pk2(b[2], b[3])}; return __builtin_bit_cast(bf16x8, w); }
__device__ __forceinline__ bf16x8 join8(u32x2 a, u32x2 b) { const u32x4 w = (u32x4){a.x, a.y, b.x, b.y}; return __builtin_bit_cast(bf16x8, w); }
}


namespace xa {
constexpr int TSZ = 16384, L_T = 0, L_WS = 2 * TSZ, L_OST = L_WS + 8 * 64 * 4, L_BYTES = L_OST + 8 * 2048;
#define XA_WAIT_BAR() asm volatile("s_waitcnt vmcnt(0) lgkmcnt(0)\n\ts_barrier" ::: "memory")
template <typename T> __device__ __forceinline__ const T* src_of(const T* Kh, const T* Vh, int pitch, int i, int ci) {
    return (i < 8) ? Kh + (size_t)(32 * i + (ci & 31)) * pitch + (ci >> 5) * 8 : Vh + (size_t)(ci >> 2) * pitch + 32 * (i - 8) + (ci & 3) * 8; }
template <bool F32SRC> __device__ __forceinline__ void unit(const void* Kh_, const void* Vh_, int pitch, const bf16* Q, bf16* O, size_t row0, int hcol, int nvalid_w0, bool only_w0, LAS char* lds, unsigned lds0) {
    const int tid = pg8::pg8_tid(), lane = tid & 63, r32 = lane & 31, hi = lane >> 5; const int wid = __builtin_amdgcn_readfirstlane(tid >> 6);
    const bool active = !only_w0 || wid == 0; const int nvalid = only_w0 ? (wid == 0 ? nvalid_w0 : 0) : 32;
    bf16x8 qr[16];
    { const bf16* Qw = Q + (row0 + wid * 32 + r32) * 1024 + hcol + hi * 8;
#pragma unroll
      for (int d0 = 0; d0 < 16; ++d0) qr[d0] = active ? *(const bf16x8*)(Qw + d0 * 16) : (bf16x8){0, 0, 0, 0, 0, 0, 0, 0}; }
    LAS float* wsf = (LAS float*)(lds + L_WS) + wid * 64;
    f32x4 st[2][2];
#define XA_ISSUE(i) do { if (F32SRC) { _Pragma("unroll") for (int c2 = 0; c2 < 2; ++c2) { const float* s = src_of<float>((const float*)Kh_, (const float*)Vh_, pitch, (i), tid + 512 * c2); st[c2][0] = *(const f32x4*)s; st[c2][1] = *(const f32x4*)(s + 4); } } \
        else { _Pragma("unroll") for (int c2 = 0; c2 < 2; ++c2) fa::glds16(src_of<bf16>((const bf16*)Kh_, (const bf16*)Vh_, pitch, (i), (2 * wid + c2) * 64 + lane), (unsigned)__builtin_amdgcn_readfirstlane(lds0 + L_T + ((i) & 1) * TSZ + (2 * wid + c2) * 1024)); } } while (0)
#define XA_COMMIT(i) do { if (F32SRC) { _Pragma("unroll") for (int c2 = 0; c2 < 2; ++c2) *(LAS u32x4*)(lds + L_T + ((i) & 1) * TSZ + (tid + 512 * c2) * 16) = \
        (u32x4){pk2(st[c2][0][0], st[c2][0][1]), pk2(st[c2][0][2], st[c2][0][3]), pk2(st[c2][1][0], st[c2][1][1]), pk2(st[c2][1][2], st[c2][1][3])}; } } while (0)
    XA_ISSUE(0); XA_COMMIT(0);
    f32x16 S[8];
#pragma unroll
    for (int t = 0; t < 8; ++t) {
        XA_WAIT_BAR(); XA_ISSUE(t + 1);
        const LAS char* kp = lds + L_T + (t & 1) * TSZ + hi * 512 + r32 * 16;
        S[t] = f32x16{};
#pragma unroll
        for (int d0 = 0; d0 < 16; ++d0) S[t] = __builtin_amdgcn_mfma_f32_32x32x16_bf16(*(const LAS bf16x8*)(kp + d0 * 1024), qr[d0], S[t], 0, 0, 0);
        XA_COMMIT(t + 1);
    }
    float mx = S[0][0];
#pragma unroll
    for (int t = 0; t < 8; ++t)
#pragma unroll
        for (int r = 0; r < 16; ++r) mx = __builtin_fmaxf(mx, S[t][r]);
    { auto rr = __builtin_amdgcn_permlane32_swap(__float_as_uint(mx), __float_as_uint(mx), false, false); mx = __builtin_fmaxf(__uint_as_float(rr[0]), __uint_as_float(rr[1])); }
    float l = 0.f; u32x4 pw[16];
#pragma unroll
    for (int t = 0; t < 8; ++t) {
#pragma unroll
        for (int r = 0; r < 16; ++r) { S[t][r] = ex2(S[t][r] - mx); l += S[t][r]; }
        pw[2 * t] = (u32x4){pk2(S[t][0], S[t][1]), pk2(S[t][2], S[t][3]), pk2(S[t][4], S[t][5]), pk2(S[t][6], S[t][7])};
        pw[2 * t + 1] = (u32x4){pk2(S[t][8], S[t][9]), pk2(S[t][10], S[t][11]), pk2(S[t][12], S[t][13]), pk2(S[t][14], S[t][15])}; }
    { auto rr = __builtin_amdgcn_permlane32_swap(__float_as_uint(l), __float_as_uint(l), false, false); l = __uint_as_float(rr[0]) + __uint_as_float(rr[1]); }
    if (hi == 0) wsf[r32] = l;
    float rli[16];
#pragma unroll
    for (int r = 0; r < 16; ++r) rli[r] = __builtin_amdgcn_rcpf(wsf[fa::crow(r, hi)]);
    const int vbl = (int)(lds0 + L_T) + ((lane >> 4) & 1) * 32 + (lane & 3) * 8 + (4 * hi + ((lane & 15) >> 2)) * 64;
    LAS bf16* stg = (LAS bf16*)(lds + L_OST) + wid * 1024;
#pragma unroll
    for (int db = 0; db < 8; ++db) {
        XA_WAIT_BAR(); if (db < 7) XA_ISSUE(8 + db + 1);
        const int vb = vbl + (db & 1) * TSZ;
        f32x16 o = f32x16{};
#pragma unroll
        for (int k4 = 0; k4 < 4; ++k4) { s16x4 vlo[4], vhi[4];
#pragma unroll
            for (int kk = 0; kk < 4; ++kk) {
                asm volatile("ds_read_b64_tr_b16 %0,%1 offset:%c2" : "=&v"(vlo[kk]) : "v"(vb), "i"((k4 * 4 + kk) * 1024) : "memory");
                asm volatile("ds_read_b64_tr_b16 %0,%1 offset:%c2" : "=&v"(vhi[kk]) : "v"(vb), "i"((k4 * 4 + kk) * 1024 + 512) : "memory"); }
            asm volatile("s_waitcnt lgkmcnt(0)" ::: "memory"); __builtin_amdgcn_sched_barrier(0);
#pragma unroll
            for (int kk = 0; kk < 4; ++kk) o = __builtin_amdgcn_mfma_f32_32x32x16_bf16(__builtin_bit_cast(bf16x8, pw[k4 * 4 + kk]),
                (bf16x8){vlo[kk][0], vlo[kk][1], vlo[kk][2], vlo[kk][3], vhi[kk][0], vhi[kk][1], vhi[kk][2], vhi[kk][3]}, o, 0, 0, 0); }
        if (db < 7) XA_COMMIT(8 + db + 1);
#pragma unroll
        for (int r = 0; r < 16; ++r) stg[fa::crow(r, hi) * 32 + r32] = (bf16)(pk2(o[r] * rli[r], 0.f) & 0xffffu);
        LDS_WAIT();
#pragma unroll
        for (int ps = 0; ps < 2; ++ps) { const int row = ps * 16 + (lane >> 2), ch = lane & 3;
            const u32x4 v = *(const LAS u32x4*)(stg + row * 32 + ch * 8);
            if (row < nvalid) *(u32x4*)(O + (row0 + wid * 32 + row) * 1024 + hcol + 32 * db + ch * 8) = v; }
        LDS_WAIT();
    }
    asm volatile("s_waitcnt lgkmcnt(0)\n\ts_barrier" ::: "memory");
#undef XA_ISSUE
#undef XA_COMMIT
}
}

namespace ms {
constexpr int KSZ = 18432, L_T = 0, L_WS = 2 * KSZ, L_OST = L_WS + 8 * 64 * 4, L_BYTES = L_OST + 8 * 4096;
constexpr int PROW = 264;
#define MS_WAIT_BAR() asm volatile("s_waitcnt lgkmcnt(0)\n\ts_barrier" ::: "memory")
__device__ __forceinline__ const float* ms_ksrc(const float* ckvb, const float* krb, int key, int c) {
    const size_t o0 = (size_t)key * 256 + c * 8, o1 = (size_t)key * 32 + (c - 32) * 8; const bool lat = c < 32; return (lat ? ckvb : krb) + (lat ? o0 : o1); }
template <int NK> __device__ __forceinline__ void unit(const float* ckvb, const float* krb, int kclamp, const bf16* QA, float* P, LAS char* lds, unsigned lds0) {
    const int tid = pg8::pg8_tid(), lane = tid & 63, r32 = lane & 31, hi = lane >> 5; const int wid = __builtin_amdgcn_readfirstlane(tid >> 6);
    const bf16* Qw = QA + (size_t)(wid * 32 + r32) * 288 + hi * 8;
    f32x4 st[2][3][2];
#define MS_SRC(i, ci) (((i) < 8) ? ms_ksrc(ckvb, krb, min(32 * (i) + ((ci) & 31), kclamp), (ci) >> 5) \
                                  : ckvb + (size_t)min((ci) >> 2, kclamp) * 256 + 32 * ((i) - 8) + ((ci) & 3) * 8)
#define MS_NCH(i) (((i) < 8) ? 1152 : 1024)
#define MS_ISSUE(i, set) do { _Pragma("unroll") for (int c2 = 0; c2 < 3; ++c2) { const int ci = min(tid + 512 * c2, MS_NCH(i) - 1); const float* s = MS_SRC(i, ci); st[(set) & 1][c2][0] = *(const f32x4*)s; st[(set) & 1][c2][1] = *(const f32x4*)(s + 4); } } while (0)
#define MS_COMMIT(i, slot) do { _Pragma("unroll") for (int c2 = 0; c2 < 3; ++c2) { const int ci = min(tid + 512 * c2, MS_NCH(i) - 1); *(LAS u32x4*)(lds + L_T + ((slot) & 1) * KSZ + ci * 16) = \
        (u32x4){pk2(st[(slot) & 1][c2][0][0], st[(slot) & 1][c2][0][1]), pk2(st[(slot) & 1][c2][0][2], st[(slot) & 1][c2][0][3]), pk2(st[(slot) & 1][c2][1][0], st[(slot) & 1][c2][1][1]), pk2(st[(slot) & 1][c2][1][2], st[(slot) & 1][c2][1][3])}; } } while (0)
    constexpr int FIRSTV = 8;
#define MS_TILE(q) (((q) < NK) ? (q) : FIRSTV + (q) - NK)
    MS_ISSUE(MS_TILE(0), 0); MS_COMMIT(MS_TILE(0), 0); MS_ISSUE(MS_TILE(1), 1);
    f32x16 S[NK];
#pragma unroll
    for (int t = 0; t < NK; ++t) {
        MS_WAIT_BAR(); MS_ISSUE(MS_TILE(t + 2), t + 2);
        const LAS char* kp = lds + L_T + (t & 1) * KSZ + hi * 512 + r32 * 16;
        S[t] = f32x16{}; const bf16* Qt = Qw; asm volatile("" : "+v"(Qt));
#pragma unroll
        for (int d0 = 0; d0 < 18; ++d0) { S[t] = __builtin_amdgcn_mfma_f32_32x32x16_bf16(*(const LAS bf16x8*)(kp + d0 * 1024), *(const bf16x8*)(Qt + d0 * 16), S[t], 0, 0, 0);
            if (d0 % 6 == 5) __builtin_amdgcn_sched_barrier(0); }
        MS_COMMIT(MS_TILE(t + 1), t + 1);
    }
    constexpr int VS0 = (NK & 1);
    if (NK == 1) {
#pragma unroll
        for (int r = 8; r < 16; ++r) S[0][r] = -INFINITY; }
    float mx = S[0][0];
#pragma unroll
    for (int t = 0; t < NK; ++t)
#pragma unroll
        for (int r = 0; r < 16; ++r) mx = __builtin_fmaxf(mx, S[t][r]);
    { auto rr = __builtin_amdgcn_permlane32_swap(__float_as_uint(mx), __float_as_uint(mx), false, false); mx = __builtin_fmaxf(__uint_as_float(rr[0]), __uint_as_float(rr[1])); }
    float l = 0.f; u32x4 pw[2 * NK];
#pragma unroll
    for (int t = 0; t < NK; ++t) {
#pragma unroll
        for (int r = 0; r < 16; ++r) { S[t][r] = ex2(S[t][r] - mx); l += S[t][r]; }
        pw[2 * t] = (u32x4){pk2(S[t][0], S[t][1]), pk2(S[t][2], S[t][3]), pk2(S[t][4], S[t][5]), pk2(S[t][6], S[t][7])};
        pw[2 * t + 1] = (u32x4){pk2(S[t][8], S[t][9]), pk2(S[t][10], S[t][11]), pk2(S[t][12], S[t][13]), pk2(S[t][14], S[t][15])}; }
    { auto rr = __builtin_amdgcn_permlane32_swap(__float_as_uint(l), __float_as_uint(l), false, false); l = __uint_as_float(rr[0]) + __uint_as_float(rr[1]); }
    float* Pw = P + (size_t)(wid * 32) * PROW;
    if (hi == 0) { Pw[(size_t)r32 * PROW + 256] = mx; Pw[(size_t)r32 * PROW + 257] = l; }
    LAS float* stg = (LAS float*)(lds + L_OST) + wid * 1024;
#pragma unroll
    for (int db = 0; db < 8; ++db) {
        MS_WAIT_BAR(); if (db < 6) MS_ISSUE(FIRSTV + db + 2, NK + db + 2);
        const int vb = (int)(lds0 + L_T) + ((VS0 + db) & 1) * KSZ + ((lane >> 4) & 1) * 32 + (lane & 3) * 8 + (4 * hi + ((lane & 15) >> 2)) * 64;
        f32x16 o = f32x16{};
#pragma unroll
        for (int ks = 0; ks < 2 * NK; ++ks) { s16x4 vlo, vhi;
            asm volatile("ds_read_b64_tr_b16 %0,%1 offset:%c2" : "=&v"(vlo) : "v"(vb), "i"(ks * 1024) : "memory");
            asm volatile("ds_read_b64_tr_b16 %0,%1 offset:%c2" : "=&v"(vhi) : "v"(vb), "i"(ks * 1024 + 512) : "memory");
            asm volatile("s_waitcnt lgkmcnt(0)" ::: "memory"); __builtin_amdgcn_sched_barrier(0);
            o = __builtin_amdgcn_mfma_f32_32x32x16_bf16(__builtin_bit_cast(bf16x8, pw[ks]), (bf16x8){vlo[0], vlo[1], vlo[2], vlo[3], vhi[0], vhi[1], vhi[2], vhi[3]}, o, 0, 0, 0); }
#pragma unroll
        for (int r = 0; r < 16; ++r) stg[fa::crow(r, hi) * 32 + r32] = o[r];
        LDS_WAIT();
        { const int row = lane >> 1, cq = (lane & 1) * 16; float* dst = Pw + (size_t)row * PROW + 32 * db + cq;
#pragma unroll
          for (int k = 0; k < 4; ++k) *(f32x4*)(dst + 4 * k) = *(const LAS f32x4*)(stg + row * 32 + cq + 4 * k); }
        if (db < 7) MS_COMMIT(FIRSTV + db + 1, NK + db + 1);
        LDS_WAIT();
    }
    asm volatile("s_waitcnt lgkmcnt(0)\n\ts_barrier" ::: "memory");
#undef MS_SRC
#undef MS_ISSUE
#undef MS_COMMIT
#undef MS_NCH
#undef MS_TILE
}
}

constexpr int RING_OFF = 0, RING_BYTES = 131072;
constexpr int LDSCTL_OFF = RING_BYTES, MISC_OFF = LDSCTL_OFF + 320;
constexpr int LDS_BYTES = 147456;
constexpr int NWAVES = 8;
static_assert(fa::L_BYTES2 <= RING_BYTES && xa::L_BYTES <= RING_BYTES && ms::L_BYTES <= RING_BYTES, "attention LDS");

struct KArgs { const float* in[N_IN]; float* out; unsigned char* ws; int ph_lo, ph_hi; };
static_assert(sizeof(KArgs) == N_IN * 8 + 24, "KArgs has no padding");
typedef const __attribute__((address_space(4))) KArgs* KAP;
#define KA ((KAP)__builtin_amdgcn_kernarg_segment_ptr())

#define XB_TMO      128
#define XB_XCNT(j)  (256  + 64 * (j))
#define XB_XSUB(j)  (1280 + 64 * (j))
#define XB_XGEN(j)  (2304 + 64 * (j))
#define XB_TOP      3328
#define XB_TOPGEN   3392
#define XCD_BAR_WORDS 3456
#define XB_SPIN_CAP (1u << 18)

__device__ __forceinline__ unsigned xb_ld(unsigned* p)              { return __hip_atomic_load(p, __ATOMIC_RELAXED, __HIP_MEMORY_SCOPE_AGENT); }
__device__ __forceinline__ unsigned xb_add(unsigned* p, unsigned v) { return __hip_atomic_fetch_add(p, v, __ATOMIC_RELAXED, __HIP_MEMORY_SCOPE_AGENT); }
__device__ __forceinline__ unsigned xb_xcc_id() { return (unsigned)__builtin_amdgcn_s_getreg((3 << 11) | 20) & 0xFu; }
#define XB_SPIN(cond, bar) do { unsigned _sp = 0; while (cond) { __builtin_amdgcn_s_sleep(1); \
    if ((++_sp & 255u) == 0u) { if (xb_ld(&(bar)[XB_TMO])) break; if (_sp > XB_SPIN_CAP) { atomicAdd(&(bar)[XB_TMO], 1u); break; } } } } while (0)

struct XcdBarrier {
    unsigned* bar; unsigned x;
    volatile LAS unsigned* st;
};

__device__ __forceinline__ XcdBarrier xcd_barrier_post(unsigned* bar, volatile LAS unsigned* st) {
    XcdBarrier b; b.bar = bar; b.x = xb_xcc_id(); b.st = st;
    if (threadIdx.x == 0) (void)xb_add(&bar[XB_XCNT(b.x)], 1u);
    return b;
}
__device__ __forceinline__ void xcd_barrier_complete(unsigned* bar, unsigned x, unsigned& nloc, unsigned& nx) {
    const unsigned G = gridDim.x * gridDim.y * gridDim.z;
    unsigned sum, cnt, mine, sp = 0u;
    for (;;) {
        sum = 0u; cnt = 0u; mine = 0u;
#pragma unroll
        for (unsigned j = 0; j < 16; ++j) { const unsigned c = xb_ld(&bar[XB_XCNT(j)]); sum += c; cnt += (c > 0u) ? 1u : 0u; mine = (j == x) ? c : mine; }
        if (sum == G) break;
        __builtin_amdgcn_s_sleep(1);
        if ((++sp & 255u) == 0u) { if (xb_ld(&bar[XB_TMO])) break; if (sp > XB_SPIN_CAP) { atomicAdd(&bar[XB_TMO], 1u); break; } }
    }
    nloc = mine > 0u ? mine : 1u; nx = cnt > 0u ? cnt : 1u;
}

__device__ __forceinline__ void xcd_barrier(const XcdBarrier& b) {
    asm volatile("s_waitcnt vmcnt(0)" ::: "memory");
    __syncthreads();
    if (threadIdx.x == 0) {
        unsigned* bar = b.bar;
        __builtin_amdgcn_s_waitcnt(0);
        unsigned nloc = b.st[0], nx = b.st[1];
        if (nloc == 0u) { xcd_barrier_complete(bar, b.x, nloc, nx); b.st[0] = nloc; b.st[1] = nx; }
        const unsigned old = xb_add(&bar[XB_XSUB(b.x)], 1u);
        const unsigned gen = old / nloc;
        if (old + 1u == (gen + 1u) * nloc) {
            __builtin_amdgcn_fence(__ATOMIC_RELEASE, "agent");
            asm volatile("s_waitcnt vmcnt(0)" ::: "memory");
            const unsigned og = xb_add(&bar[XB_TOP], 1u);
            const unsigned tg = og / nx;
            if (og + 1u == (tg + 1u) * nx) xb_add(&bar[XB_TOPGEN], 1u);
            else XB_SPIN(xb_ld(&bar[XB_TOPGEN]) == tg, bar);
            __builtin_amdgcn_fence(__ATOMIC_ACQUIRE, "agent");
            xb_add(&bar[XB_XGEN(b.x)], 1u);
            asm volatile("s_waitcnt vmcnt(0)" ::: "memory");
        } else {
            XB_SPIN(xb_ld(&bar[XB_XGEN(b.x)]) == gen, bar);
            __builtin_amdgcn_fence(__ATOMIC_ACQUIRE, "agent");
            asm volatile("s_waitcnt vmcnt(0)" ::: "memory");
        }
    }
    __syncthreads();
}

struct Seg { const float* W; int ldw, c0, ncols, K; bf16* T; int ldt, r0; const float* g; };
__device__ __forceinline__ Seg get_seg(KAP a, unsigned char* ws, int idx) {
    Seg s; s.g = nullptr; s.r0 = 0; s.c0 = 0; s.ldw = 1024; s.ncols = 1024; s.K = 1024; s.ldt = 1024; s.W = nullptr; s.T = nullptr;
    if (idx < 4) { const int j = idx & 1; s.W = a->in[I_WFI] + (size_t)j * 1024 * 4112; s.ldw = 4112; s.T = (bf16*)(ws + WS_WFI) + (size_t)j * 4352 * 1024; s.g = a->in[I_GMIX] + (size_t)(2 * j) * 1024;
        if (idx < 2) { s.c0 = 0; s.ncols = 3072; s.r0 = 0; } else { s.c0 = 3088; s.ncols = 1024; s.r0 = 3072; } }
    else if (idx < 6) { const int j = idx - 4; s.W = a->in[I_WFO] + (size_t)j * 1024 * 1024; s.T = (bf16*)(ws + WS_WFO) + (size_t)j * 1024 * 1024; }
    else if (idx < 12) { const int e = idx - 6, j = e / 3, part = e % 3; s.W = a->in[I_WMA] + (size_t)j * 1024 * 672; s.ldw = 672; s.T = (bf16*)(ws + WS_WMA) + (size_t)j * 768 * 1024; s.g = a->in[I_GMIX] + (size_t)(2 * j + 1) * 1024;
        if (part == 0) { s.c0 = 384; s.ncols = 256; s.r0 = 0; } else if (part == 1) { s.c0 = 0; s.ncols = 384; s.r0 = 256; } else { s.c0 = 640; s.ncols = 32; s.r0 = 640; } }
    else if (idx < 14) { const int j = idx - 12; s.W = a->in[I_WMQB] + (size_t)j * 384 * 1536; s.ldw = 1536; s.ncols = 1536; s.K = 384; s.T = (bf16*)(ws + WS_WMQ) + (size_t)j * 1536 * 384; s.ldt = 384; s.g = a->in[I_GMQ] + (size_t)j * 384; }
    else if (idx < 18) { const int j = idx & 1; const bool raw = idx >= 16; s.W = a->in[I_WMKVB] + (size_t)j * 256 * 2048; s.ldw = 2048; s.ncols = 2048; s.K = 256; s.ldt = 256;
        s.T = (bf16*)(ws + (raw ? WS_WMKVR : WS_WMKV)) + (size_t)j * 2048 * 256; s.g = raw ? nullptr : a->in[I_GMKV] + (size_t)j * 256; }
    else if (idx < 20) { const int j = idx - 18; s.W = a->in[I_WMO] + (size_t)j * 1024 * 1024; s.T = (bf16*)(ws + WS_WMO) + (size_t)j * 1024 * 1024; }
    else if (idx < 24) { const int i = idx - 20; s.W = a->in[I_WXQ] + (size_t)i * 1024 * 1024; s.T = (bf16*)(ws + WS_WXQ) + (size_t)i * 1024 * 1024; s.g = a->in[I_GCROSS] + (size_t)i * 1024; }
    else if (idx < 28) { const int i = idx - 24; s.W = a->in[I_WXO] + (size_t)i * 1024 * 1024; s.T = (bf16*)(ws + WS_WXO) + (size_t)i * 1024 * 1024; }
    else if (idx < 32) { const int i = idx - 28; s.W = a->in[I_WXKV] + (size_t)i * 1024 * 2048; s.ldw = 2048; s.ncols = 2048; s.T = (bf16*)(ws + WS_WXKV) + (size_t)i * 2048 * 1024; s.g = a->in[I_GMEM] + (size_t)i * 1024; }
    else if (idx < 36) { const int i = idx - 32; s.W = a->in[I_WDN] + (size_t)i * 2816 * 1024; s.K = 2816; s.T = (bf16*)(ws + WS_WDN) + (size_t)i * 1024 * 2816; s.ldt = 2816; }
    else if (idx < 212) { const int e = idx - 36, i = e / 44, t = e % 44, pn = t >> 1, half = t & 1; s.W = a->in[I_WGU] + (size_t)i * 1024 * 5632; s.ldw = 5632; s.c0 = half * 2816 + 128 * pn; s.ncols = 128;
        s.T = (bf16*)(ws + WS_WGU) + (size_t)i * 5632 * 1024; s.r0 = 256 * pn + 128 * half; s.g = a->in[I_GFFN] + (size_t)i * 1024; }
    else { const int j = idx - 212; s.W = a->in[I_WFI] + (size_t)j * 1024 * 4112; s.ldw = 4112; s.c0 = 3072; s.ncols = 32; s.T = (bf16*)(ws + WS_WFI) + (size_t)j * 4352 * 1024; s.r0 = 4096; s.g = a->in[I_GMIX] + (size_t)(2 * j) * 1024; }
    return s;
}
constexpr int NSEG = 214;
__device__ __forceinline__ void tr_load(const Seg& s, int item, int lane, float (&v)[32]) {
    const int nnb = s.ncols / 32, kb = item / nnb, nb = item % nnb; const float* p = s.W + (size_t)(64 * kb + (lane >> 5)) * s.ldw + s.c0 + 32 * nb + (lane & 31);
#pragma unroll
    for (int i = 0; i < 32; ++i) v[i] = p[(size_t)(2 * i) * s.ldw];
}
__device__ __forceinline__ void tr_store(const Seg& s, int item, int lane, const float (&v)[32], LAS float* scr) {
    const int nnb = s.ncols / 32, kb = item / nnb, nb = item % nnb, k0 = 64 * kb, n0 = 32 * nb;
#pragma unroll
    for (int i = 0; i < 32; ++i) scr[(2 * i + (lane >> 5)) * 33 + (lane & 31)] = v[i];
    LDS_WAIT(); asm volatile("" ::: "memory");
    const int c = lane & 7; f32x4 g0 = (f32x4){1.f, 1.f, 1.f, 1.f}, g1 = g0;
    if (s.g) { g0 = *(const f32x4*)(s.g + k0 + 8 * c); g1 = *(const f32x4*)(s.g + k0 + 8 * c + 4); }
#pragma unroll
    for (int j = 0; j < 4; ++j) { const int n = (lane >> 3) + 8 * j; const LAS float* p = scr + (8 * c) * 33 + n;
        u32x4 o; o.x = pk2(p[0 * 33] * g0[0], p[1 * 33] * g0[1]); o.y = pk2(p[2 * 33] * g0[2], p[3 * 33] * g0[3]); o.z = pk2(p[4 * 33] * g1[0], p[5 * 33] * g1[1]); o.w = pk2(p[6 * 33] * g1[2], p[7 * 33] * g1[3]);
        *(u32x4*)(s.T + (size_t)(s.r0 + n0 + n) * s.ldt + k0 + 8 * c) = o; }
    LDS_WAIT(); asm volatile("" ::: "memory");
}
__device__ __forceinline__ void cvt_blocks(const float* src, bf16* dst, int nblk, int blk, size_t dstride, int gtid, int nthr) {
    const long total = (long)nblk * blk / 8;
    for (long v = gtid; v < total; v += nthr) { const long e = v * 8; const int b = (int)(e / blk), o = (int)(e % blk);
        const f32x4 x = *(const f32x4*)(src + e), y = *(const f32x4*)(src + e + 4);
        *(u32x4*)(dst + (size_t)b * dstride + o) = (u32x4){pk2(x[0], x[1]), pk2(x[2], x[3]), pk2(y[0], y[1]), pk2(y[2], y[3])}; }
}
__device__ __forceinline__ void p0_prologue(KAP a, LAS unsigned char* lds, int gw, int NGW, int wave, int lane, int pmask) {
    unsigned char* ws = a->ws; const int gtid = gw * 64 + lane, nthr = NGW * 64;
    LAS float* scr = (LAS float*)(lds + RING_OFF + wave * 16384);
#undef P0_PARTS
#define P0_PARTS pmask
    if (P0_PARTS & 1) {
        int total = 0;
        for (int sg = 0; sg < NSEG; ++sg) { const Seg s = get_seg(a, ws, sg); total += (s.K / 64) * (s.ncols / 32); }
        int sg = 0, base = 0; Seg sc = get_seg(a, ws, 0); int nit = (sc.K / 64) * (sc.ncols / 32);
#define P0_ADVANCE(gi) while ((gi) >= base + nit) { base += nit; ++sg; sc = get_seg(a, ws, sg); nit = (sc.K / 64) * (sc.ncols / 32); }
        float va[32], vb[32]; Seg sa = sc, sb = sc; int ia = 0, ib = 0;
        int gi = gw;
        if (gi < total) { P0_ADVANCE(gi); sa = sc; ia = gi - base; tr_load(sa, ia, lane, va); }
        while (gi < total) {
            int gn = gi + NGW;
            if (gn < total) { P0_ADVANCE(gn); sb = sc; ib = gn - base; tr_load(sb, ib, lane, vb); }
            tr_store(sa, ia, lane, va, scr);
            gi = gn; if (gi >= total) break;
            gn = gi + NGW;
            if (gn < total) { P0_ADVANCE(gn); sa = sc; ia = gn - base; tr_load(sa, ia, lane, va); }
            tr_store(sb, ib, lane, vb, scr);
            gi = gn;
        }
#undef P0_ADVANCE
    }
    if (P0_PARTS & 2) {
    cvt_blocks(a->in[I_WMKVB], (bf16*)(ws + WS_WKN), 1, 2 * 256 * 2048, 0, gtid, nthr); }
    if (P0_PARTS & 4) { const u32x4 z = (u32x4){0u, 0u, 0u, 0u};
      for (int v = gtid; v < 2 * 224 * 128; v += nthr) { const int j = v / (224 * 128), r = v % (224 * 128); *(u32x4*)((bf16*)(ws + WS_WFI) + ((size_t)j * 4352 + 4128) * 1024 + (size_t)r * 8) = z; }
      for (int v = gtid; v < 2 * 96 * 128; v += nthr) { const int j = v / (96 * 128), r = v % (96 * 128); *(u32x4*)((bf16*)(ws + WS_WMA) + ((size_t)j * 768 + 672) * 1024 + (size_t)r * 8) = z; }
    }
    if (P0_PARTS & 16) for (int v = gtid; v < 4096 * 16; v += nthr) { const int pos = v >> 4, c = v & 15; const double inv = pow(10000.0, -(double)c / 16.0), ang = (double)pos * inv;
        ((float*)(ws + WS_ROPC))[v] = (float)cos(ang); ((float*)(ws + WS_ROPS))[v] = (float)sin(ang); }
    if (P0_PARTS & 32) for (int row = gw; row < MT; row += NGW) { const float* xr = (row < MP) ? a->in[I_XP] + (size_t)row * 1024 : a->in[I_XS] + (size_t)(row - MP) * 1024;
        float sq = 0.f; bf16* o = (bf16*)(ws + WS_XB) + (size_t)row * 1024;
#pragma unroll
        for (int j = 0; j < 4; ++j) { const f32x4 v = *(const f32x4*)(xr + 256 * j + 4 * lane); sq += pg8::dot4(v); *(u32x2*)(o + 256 * j + 4 * lane) = pg8::pk4(v); }
        sq = wave_sum(sq);
        if (lane < 16) ((float*)(ws + WS_SSQ))[(size_t)row * 16 + lane] = (lane == 0) ? sq : 0.f; }
    if (P0_PARTS & 64) for (int row = gw; row < 2048; row += NGW) { const float* xr = a->in[I_MEM] + (size_t)row * 1024; f32x4 v[4]; float sq = 0.f;
#pragma unroll
        for (int j = 0; j < 4; ++j) { v[j] = *(const f32x4*)(xr + 256 * j + 4 * lane); sq += pg8::dot4(v[j]); }
        const float r = rsqrtf(wave_sum(sq) * (1.0f / 1024.0f) + EPS); bf16* o = (bf16*)(ws + WS_MB) + (size_t)row * 1024;
#pragma unroll
        for (int j = 0; j < 4; ++j) *(u32x2*)(o + 256 * j + 4 * lane) = pg8::pk4(v[j] * r); }
}

__device__ __forceinline__ float ssq_rstd16(const float* ssq, int row) {
    const f32x4 a = *(const f32x4*)(ssq + (size_t)row * 16), b = *(const f32x4*)(ssq + (size_t)row * 16 + 4), c = *(const f32x4*)(ssq + (size_t)row * 16 + 8), d = *(const f32x4*)(ssq + (size_t)row * 16 + 12);
    const float s = ((a[0] + a[1]) + (a[2] + a[3])) + ((b[0] + b[1]) + (b[2] + b[3])) + ((c[0] + c[1]) + (c[2] + c[3])) + ((d[0] + d[1]) + (d[2] + d[3]));
    return rsqrtf(s * (1.0f / 1024.0f) + EPS);
}
__device__ __forceinline__ void cum_local_prompt(KAP a, int bh, LAS float* red, int wave, int lane) {
    unsigned char* ws = a->ws; const float* lfr = (const float*)(ws + WS_LFR); const int b = bh >> 4, h = bh & 15; float* cb = (float*)(ws + WS_CB) + (size_t)bh * 4096;
    float v[8];
#pragma unroll
    for (int k = 0; k < 8; ++k) v[k] = lfr[((size_t)b * 4096 + 512 * wave + 64 * k + lane) * 16 + h];
    float carry = 0.f;
#pragma unroll
    for (int k = 0; k < 8; ++k) {
#pragma unroll
        for (int o = 1; o < 64; o <<= 1) { const float y = __shfl_up(v[k], o); if (lane >= o) v[k] += y; }
        v[k] += carry; carry = __shfl(v[k], 63); }
    if (lane == 0) red[wave] = carry;
    __syncthreads();
    float off = 0.f;
#pragma unroll
    for (int w = 0; w < 7; ++w) off += (w < wave) ? red[w] : 0.f;
#pragma unroll
    for (int k = 0; k < 8; ++k) cb[512 * wave + 64 * k + lane] = -(v[k] + off) * LOG2E;
    VM_WAIT(); __syncthreads();
}
__device__ __forceinline__ void cum_local_sample(KAP a, int L, int pair, LAS float* red, int wave, int lane) {
    unsigned char* ws = a->ws; const float* lfr = (const float*)(ws + WS_LFR); const int bs = pair >> 4, h = pair & 15;
    const float* lfc = a->in[I_CFL] + (size_t)L * 32 * 2048 * 16; float* cb = (float*)(ws + WS_CBS) + (size_t)pair * 2080;
    float x[4], v[4];
#pragma unroll
    for (int k = 0; k < 4; ++k) x[k] = lfc[((size_t)bs * 2048 + 256 * wave + 64 * k + lane) * 16 + h];
    float carry = 0.f;
#pragma unroll
    for (int k = 3; k >= 0; --k) { float t = x[k];
#pragma unroll
        for (int o = 1; o < 64; o <<= 1) { const float y = __shfl_down(t, o); if (lane + o < 64) t += y; }
        v[k] = carry + t - x[k]; carry += __shfl(t, 0); }
    if (lane == 0) red[wave] = carry;
    __syncthreads();
    float off = 0.f;
#pragma unroll
    for (int w = 1; w < 8; ++w) off += (w > wave) ? red[w] : 0.f;
#pragma unroll
    for (int k = 0; k < 4; ++k) cb[256 * wave + 64 * k + lane] = (v[k] + off) * LOG2E;
    if (wave == 0) { float t = (lane < 16) ? lfr[((size_t)MP + bs * 16 + lane) * 16 + h] : 0.f;
#pragma unroll
        for (int o = 1; o < 16; o <<= 1) { const float y = __shfl_up(t, o); if (lane >= o) t += y; }
        if (lane < 32) cb[2048 + lane] = (lane < 16) ? -t * LOG2E : 0.f; }
    VM_WAIT(); __syncthreads();
}
__device__ __forceinline__ void ckv_fixup(KAP a, int L, int gw, int NGW, int lane) {
    unsigned char* ws = a->ws; const f32x4 g = *(const f32x4*)(a->in[I_GMKV] + (size_t)L * 256 + 4 * lane);
    for (int row = gw; row < MT; row += NGW) { const f32x4 s4 = *(const f32x4*)((const float*)(ws + WS_SSQKV) + (size_t)row * 4);
        const float r = rsqrtf(((s4[0] + s4[1]) + (s4[2] + s4[3])) * (1.0f / 256.0f) + EPS);
        const f32x4 v = *(const f32x4*)((const float*)(ws + WS_CKVU) + (size_t)row * 256 + 4 * lane) * r * g;
        if (row < MP) *(f32x4*)(a->out + O_MCP + ((size_t)L * MP + row) * 256 + 4 * lane) = v;
        else { const int rs = row - MP, bs = rs >> 4, t = rs & 15; *(f32x4*)(a->out + O_MCS + ((size_t)L * MS + rs) * 256 + 4 * lane) = v;
            (void)bs; (void)t; } }
}
__device__ __forceinline__ void final_phase(KAP a, int gw, int NGW, int lane) {
    for (int row = gw; row < MT; row += NGW) { const float r = ssq_rstd16((const float*)(a->ws + WS_SSQ), row); float* y = a->out + (size_t)row * 1024; const bf16* x = (const bf16*)(a->ws + WS_XB) + (size_t)row * 1024;
#pragma unroll
        for (int j = 0; j < 4; ++j) { const f32x4 g = *(const f32x4*)(a->in[I_GFINAL] + 256 * j + 4 * lane); const u32x2 w = *(const u32x2*)(x + 256 * j + 4 * lane);
            const f32x4 xv = (f32x4){__builtin_bit_cast(float, w.x << 16), __builtin_bit_cast(float, w.x & 0xffff0000u), __builtin_bit_cast(float, w.y << 16), __builtin_bit_cast(float, w.y & 0xffff0000u)};
            *(f32x4*)(y + 256 * j + 4 * lane) = xv * r * g; } }
}

__device__ __forceinline__ void foxs_item(KAP a, int L, int it, LAS unsigned char* lds, int wid, int lane) {
    unsigned char* ws = a->ws; const int pair = it * 2 + (wid >> 2), b = pair >> 4, h = pair & 15, sp = wid & 3, g = lane >> 4, li = lane & 15;
    const float* ck = a->in[I_CFK] + (size_t)L * 32 * 2048 * 1024 + ((size_t)b * 2048 * 16 + h) * 64;
    const float* cv = a->in[I_CFV] + (size_t)L * 32 * 2048 * 1024 + ((size_t)b * 2048 * 16 + h) * 64;
    const float* cbs = (const float*)(ws + WS_CBS) + (size_t)pair * 2080;
    const bf16* QF = (const bf16*)(ws + WS_QF); const bf16* KF = (const bf16*)(ws + WS_KF); const bf16* VF = (const bf16*)(ws + WS_VF);
    const size_t srow = (size_t)MP + b * 16;
    bf16x8 qf[2];
#pragma unroll
    for (int d0 = 0; d0 < 2; ++d0) qf[d0] = *(const bf16x8*)(QF + (srow + li) * 1024 + h * 64 + 32 * d0 + 8 * g);
    float m = -1e30f, l = 0.f; f32x4 o[4];
#pragma unroll
    for (int db = 0; db < 4; ++db) o[db] = (f32x4){0.f, 0.f, 0.f, 0.f};
    const int kv0 = 512 * sp;
    auto kl = [&](int s, int blk, int d0) -> bf16x8 { const float* p = ck + (size_t)(kv0 + 32 * s + 16 * blk + li) * 1024 + 32 * d0 + 8 * g; return a16::cvt8(*(const f32x4*)p, *(const f32x4*)(p + 4)); };
    auto vl = [&](int s, int db) -> bf16x8 { const float* p = cv + (size_t)(kv0 + 32 * s + 4 * g) * 1024 + 16 * db + li;
        const f32x4 x = (f32x4){p[0], p[1024], p[2048], p[3072]}, y = (f32x4){p[16 * 1024], p[17 * 1024], p[18 * 1024], p[19 * 1024]}; return a16::cvt8(x, y); };
    auto sf = [&](int s, f32x4& sA, f32x4& sB) { const float* p = cbs + kv0 + 32 * s + 4 * g; sA += *(const f32x4*)p; sB += *(const f32x4*)(p + 16); };
    a16::steps<2, 4>(0, 16, qf, kl, vl, sf, m, l, o, lane);
    if (sp == 3) {
        auto kl2 = [&](int, int blk, int d0) -> bf16x8 { bf16x8 z = {0, 0, 0, 0, 0, 0, 0, 0}; if (blk == 0) z = *(const bf16x8*)(KF + (srow + li) * 1024 + h * 64 + 32 * d0 + 8 * g); return z; };
        auto vl2 = [&](int, int db) -> bf16x8 { const bf16* p = VF + (srow + 4 * g) * 1024 + h * 64 + 16 * db + li;
            const u32x4 w = (u32x4){(unsigned)p[0] | ((unsigned)p[1024] << 16), (unsigned)p[2048] | ((unsigned)p[3072] << 16), 0u, 0u}; return __builtin_bit_cast(bf16x8, w); };
        auto sf2 = [&](int, f32x4& sA, f32x4& sB) { const f32x4 bb = *(const f32x4*)(cbs + 2048 + 4 * g);
#pragma unroll
            for (int r = 0; r < 4; ++r) { sA[r] = (4 * g + r > li) ? -INFINITY : sA[r] + bb[r]; sB[r] = -INFINITY; } };
        a16::steps<2, 4>(0, 1, qf, kl2, vl2, sf2, m, l, o, lane);
    }
    LAS float* PO = (LAS float*)(lds + RING_OFF) + wid * 1024; LAS float* PM = (LAS float*)(lds + RING_OFF + 32768) + wid * 32;
#pragma unroll
    for (int db = 0; db < 4; ++db)
#pragma unroll
        for (int r = 0; r < 4; ++r) PO[(4 * g + r) * 64 + 16 * db + li] = o[db][r];
    if (g == 0) { PM[li] = m; PM[16 + li] = l; }
    __syncthreads();
    {
        const int w0 = (wid >> 2) * 4, db = wid & 3; const bf16* GF = (const bf16*)(ws + WS_GF); bf16* OF = (bf16*)(ws + WS_OM);
#pragma unroll
        for (int r = 0; r < 4; ++r) { const int q = 4 * g + r; float mm = -1e30f;
#pragma unroll
            for (int s2 = 0; s2 < 4; ++s2) mm = __builtin_fmaxf(mm, ((LAS float*)(lds + RING_OFF + 32768) + (w0 + s2) * 32)[q]);
            float num = 0.f, den = 0.f;
#pragma unroll
            for (int s2 = 0; s2 < 4; ++s2) { LAS float* pm = (LAS float*)(lds + RING_OFF + 32768) + (w0 + s2) * 32; const float wgt = ex2(pm[q] - mm);
                num += wgt * ((LAS float*)(lds + RING_OFF) + (w0 + s2) * 1024)[q * 64 + 16 * db + li]; den += wgt * pm[16 + q]; }
            const size_t idx = (srow + q) * 1024 + h * 64 + 16 * db + li;
            OF[idx] = (bf16)(pk2(num / den * bf2f(GF[idx]), 0.f) & 0xffffu); }
    }
    __syncthreads();
}
__device__ __forceinline__ void mlas_item(KAP a, int L, int it, LAS unsigned char* lds, unsigned lds0, int wid, int lane) {
    unsigned char* ws = a->ws; const int b = (it < 256) ? (it >> 3) : (it - 256), c = (it < 256) ? (it & 7) : 8, g = lane >> 4, li = lane & 15;
    const bf16* QM = (const bf16*)(ws + WS_QM); const bf16* WKN = (const bf16*)(ws + WS_WKN) + (size_t)L * 256 * 2048;
    bf16* QA = (bf16*)(ws + WS_QA) + (size_t)it * 256 * 288;
#ifndef DBG_QP_REP
#define DBG_QP_REP 1
#endif
    for (int rep = 0; rep < DBG_QP_REP; ++rep)
    for (int hh = 0; hh < 2; ++hh) { const int h = 2 * wid + hh; const bf16* qrow = QM + ((size_t)MP + b * 16 + li) * 1536 + h * 96; bf16* qa = QA + (size_t)(wid * 32 + hh * 16) * 288;
        const bf16x8 qn0 = *(const bf16x8*)(qrow + 8 * g), qn1 = *(const bf16x8*)(qrow + 32 + 8 * g);
#pragma unroll
        for (int cb = 0; cb < 16; ++cb) { const bf16* wp = WKN + (size_t)(16 * cb + li) * 2048 + h * 128 + 8 * g;
            f32x4 acc = a16::mfma16(qn0, *(const bf16x8*)wp, (f32x4){0.f, 0.f, 0.f, 0.f}); acc = a16::mfma16(qn1, *(const bf16x8*)(wp + 32), acc);
#pragma unroll
            for (int r = 0; r < 4; ++r) qa[(size_t)(4 * g + r) * 288 + 16 * cb + li] = (bf16)(pk2(acc[r], 0.f) & 0xffffu); }
        *(bf16x8*)(qa + (size_t)li * 288 + 256 + 8 * g) = *(const bf16x8*)(qrow + 64 + 8 * g); }
    VM_WAIT();
    float* P = (float*)(ws + WS_PART) + ((size_t)(b * 9 + c) * 256) * ms::PROW;
    if (c < 8) { const size_t jb = (size_t)L * 32 + b;
        ms::unit<8>(a->in[I_CCKV] + (jb * 2048 + 256 * c) * 256, a->in[I_CKR] + (jb * 2048 + 256 * c) * 32, 255, QA, P, (LAS char*)(lds + RING_OFF), lds0 + RING_OFF);
    } else { const size_t ro = (size_t)L * MS + b * 16;
        ms::unit<1>(a->out + O_MCS + ro * 256, a->out + O_MRS + ro * 32, 15, QA, P, (LAS char*)(lds + RING_OFF), lds0 + RING_OFF); }
}
__device__ __forceinline__ void mlas_combine(KAP a, int L, LAS unsigned char* lds, int gw, int NGW, int wid, int lane) {
    unsigned char* ws = a->ws; LAS bf16* scr = (LAS bf16*)(lds + RING_OFF + wid * 8192);
    const bf16* WV = (const bf16*)(ws + WS_WMKVR) + (size_t)L * 2048 * 256; bf16* OM = (bf16*)(ws + WS_OM); const int g = lane >> 4, li = lane & 15;
    for (int e = gw; e < 512; e += NGW) { const int b = e >> 4, h = e & 15; const int q = lane >> 2, cg = (lane & 3) * 64;
        const float* P0 = (const float*)(ws + WS_PART) + ((size_t)(b * 9) * 256 + (h >> 1) * 32 + (h & 1) * 16 + q) * ms::PROW; constexpr size_t CS = (size_t)256 * ms::PROW;
        float mm = -1e30f;
#pragma unroll
        for (int c = 0; c < 9; ++c) mm = __builtin_fmaxf(mm, P0[c * CS + 256]);
        float wgt[9], den = 0.f;
#pragma unroll
        for (int c = 0; c < 9; ++c) { wgt[c] = ex2(P0[c * CS + 256] - mm); den += wgt[c] * P0[c * CS + 257]; }
        const float id = 1.0f / den;
        for (int j = 0; j < 64; j += 4) { f32x4 acc = (f32x4){0.f, 0.f, 0.f, 0.f};
#pragma unroll
            for (int c = 0; c < 9; ++c) acc += *(const f32x4*)(P0 + c * CS + cg + j) * wgt[c];
            *(LAS u32x2*)(scr + q * 256 + cg + j) = pg8::pk4(acc * id); }
        LDS_WAIT();
        bf16x8 af[8];
#pragma unroll
        for (int d0 = 0; d0 < 8; ++d0) af[d0] = *(const LAS bf16x8*)(scr + li * 256 + 32 * d0 + 8 * g);
#pragma unroll
        for (int db = 0; db < 4; ++db) { f32x4 acc = (f32x4){0.f, 0.f, 0.f, 0.f}; const bf16* wp = WV + (size_t)(h * 128 + 64 + 16 * db + li) * 256 + 8 * g;
#pragma unroll
            for (int d0 = 0; d0 < 8; ++d0) acc = a16::mfma16(af[d0], *(const bf16x8*)(wp + 32 * d0), acc);
            bf16* O = OM + ((size_t)MP + b * 16 + 4 * g) * 1024 + h * 64 + 16 * db + li; const unsigned w0 = pk2(acc[0], acc[1]), w1 = pk2(acc[2], acc[3]);
            O[0] = (bf16)(w0 & 0xffffu); O[1024] = (bf16)(w0 >> 16); O[2048] = (bf16)(w1 & 0xffffu); O[3072] = (bf16)(w1 >> 16); }
        LDS_WAIT();
    }
}
typedef float f32x2v_t __attribute__((ext_vector_type(2)));
template <int K, class F> __device__ __forceinline__ void thin_tiles(const bf16* A, const bf16* Bt, LAS unsigned char* lds, int vcu, int G, int wave, int lane, F epi) {
    const int g = lane >> 4, li = lane & 15; constexpr int nks = K / 256;
    LAS float* part = (LAS float*)(lds + RING_OFF);
#pragma unroll 1
    for (int tt = vcu; tt < 512; tt += G) { const int rb = tt & 31, cg = tt >> 5;
        const bf16* ap = A + (size_t)(MP + 16 * rb + li) * K + wave * (K / 8) + 8 * g; const bf16* bp = Bt + (size_t)(64 * cg + li) * K + wave * (K / 8) + 8 * g;
        f32x4 acc[4];
#pragma unroll
        for (int nb = 0; nb < 4; ++nb) acc[nb] = (f32x4){0.f, 0.f, 0.f, 0.f};
#pragma unroll
        for (int s0 = 0; s0 < nks; s0 += 4) { bf16x8 a[4], b[4][4]; const bf16x8 z = {0, 0, 0, 0, 0, 0, 0, 0};
#pragma unroll
            for (int u = 0; u < 4; ++u) { const bool on = s0 + u < nks; a[u] = on ? *(const bf16x8*)(ap + 32 * (s0 + u)) : z;
#pragma unroll
                for (int nb = 0; nb < 4; ++nb) b[u][nb] = on ? *(const bf16x8*)(bp + (size_t)nb * 16 * K + 32 * (s0 + u)) : z; }
#pragma unroll
            for (int u = 0; u < 4; ++u)
#pragma unroll
                for (int nb = 0; nb < 4; ++nb) acc[nb] = a16::mfma16(a[u], b[u][nb], acc[nb]); }
#pragma unroll
        for (int nb = 0; nb < 4; ++nb)
#pragma unroll
            for (int r = 0; r < 4; ++r) part[wave * 1024 + (4 * g + r) * 64 + 16 * nb + li] = acc[nb][r];
        __syncthreads();
        const int e = (2 * wave + (lane >> 5)) * 64 + 2 * (lane & 31); float s0v = 0.f, s1v = 0.f;
#pragma unroll
        for (int w = 0; w < 8; ++w) { const f32x2v_t v = *(const LAS f32x2v_t*)(part + w * 1024 + e); s0v += v[0]; s1v += v[1]; }
        epi(MP + 16 * rb + 2 * wave + (lane >> 5), 64 * cg + 2 * (lane & 31), cg, s0v, s1v);
        __syncthreads(); }
}
template <int K> __device__ __forceinline__ void thin_resid(KAP a, const bf16* A, const bf16* Bt, int first, LAS unsigned char* lds, int vcu, int G, int wave, int lane) {
    unsigned char* ws = a->ws; const float* xs = a->in[I_XS] - (size_t)MP * 1024; bf16* XB = (bf16*)(ws + WS_XB); float* SSQ = (float*)(ws + WS_SSQ);
    thin_tiles<K>(A, Bt, lds, vcu, G, wave, lane, [&](int row, int col, int cg, float v0, float v1) {
        const size_t o = (size_t)row * 1024 + col; float x0, x1;
        if (first) { const f32x2v_t xo = *(const f32x2v_t*)(xs + o); x0 = xo[0]; x1 = xo[1]; } else { const unsigned w = *(const unsigned*)(XB + o); x0 = __builtin_bit_cast(float, w << 16); x1 = __builtin_bit_cast(float, w & 0xffff0000u); }
        x0 += v0; x1 += v1; *(unsigned*)(XB + o) = pk2(x0, x1);
        float sq = x0 * x0 + x1 * x1; sq += __shfl_xor(sq, 1); sq += __shfl_xor(sq, 2); sq += __shfl_xor(sq, 4); sq += __shfl_xor(sq, 8); sq += __shfl_xor(sq, 16);
        if ((lane & 31) == 0) SSQ[(size_t)row * 16 + cg] = sq; });
}
__device__ __forceinline__ void thin_xq(KAP a, const bf16* Bt, LAS unsigned char* lds, int vcu, int G, int wave, int lane) {
    unsigned char* ws = a->ws; const bf16* XB = (const bf16*)(ws + WS_XB); bf16* QX = (bf16*)(ws + WS_QX); const float* SSQ = (const float*)(ws + WS_SSQ);
    thin_tiles<1024>(XB, Bt, lds, vcu, G, wave, lane, [&](int row, int col, int, float v0, float v1) {
        const float rs = ssq_rstd16(SSQ, row) * C2_X; *(unsigned*)(QX + (size_t)row * 1024 + col) = pk2(v0 * rs, v1 * rs); });
}

constexpr int NPH = 41;
struct Ctx { int lane, wave, G, bx, vcu, gw, NGW; };
__device__ __forceinline__ Ctx mk_ctx() { Ctx c; const int tid = pg8::pg8_tid(); c.lane = tid & 63; c.wave = __builtin_amdgcn_readfirstlane(tid >> 6); int G_ = gridDim.x, bx_ = blockIdx.x; asm volatile("" : "+s"(G_), "+s"(bx_)); c.G = G_; c.bx = bx_;
    c.vcu = (c.G % 8 == 0) ? (c.bx % 8) * (c.G / 8) + c.bx / 8 : c.bx; c.gw = c.vcu * NWAVES + c.wave; c.NGW = c.G * NWAVES; return c; }
#define RSX(ws) pg8::RowScale{(const float*)((ws) + WS_SSQ), 16, 4, 1.0f / 1024.0f}
#define PHASE __device__ __noinline__ void
#define FATPH __device__ __forceinline__ void
__device__ __forceinline__ unsigned char* ws_ptr() { GAS unsigned char* w = (GAS unsigned char*)KA->ws; asm volatile("" : "+s"(w)); return (unsigned char*)w; }
#define WSB(off) ((const bf16*)(ws_ptr() + (off)))
__device__ __forceinline__ const float* in_ptr(int i) { GAS const float* w = (GAS const float*)KA->in[i]; asm volatile("" : "+s"(w)); return (const float*)w; }
__device__ __forceinline__ float* out_ptr() { GAS float* w = (GAS float*)KA->out; asm volatile("" : "+s"(w)); return (float*)w; }

FATPH ph_prologue(KAP a, LAS unsigned char* lds, int pmask) { const Ctx c = mk_ctx(); p0_prologue(a, lds, c.gw, c.NGW, c.wave, c.lane, pmask); __syncthreads(); }
FATPH ph_memkv(LAS unsigned char* lds) { const Ctx c = mk_ctx(); unsigned char* ws = ws_ptr(); float* out = out_ptr();
    pg8::Gemm g{WSB(WS_MB), WSB(WS_WXKV), 2048, 8192, 1024}; pg8::StaticOrder S; S.init(2048, 8192, c.G, c.bx);
    pg8::EpiMemKV E{out + O_MKP, out + O_MVP, (bf16*)(ws + WS_MKB), (bf16*)(ws + WS_MVB)};
    pg8::gemm_phase<pg8::EpiMemKV, pg8::StaticOrder, true, true>(lds + RING_OFF, g, S, E); }
FATPH ph_fox_in(LAS unsigned char* lds, int L) { const Ctx c = mk_ctx(); unsigned char* ws = ws_ptr(); float* out = out_ptr();
    pg8::Gemm g{WSB(WS_XB), WSB(WS_WFI) + (size_t)L * 4352 * 1024, MT, 4352, 1024}; pg8::StaticOrder S; S.init(MT, 4352, c.G, c.bx);
    pg8::EpiFoxIn E{RSX(ws), ws, out, in_ptr(I_BFF) + L * 16, L};
    pg8::gemm_phase<pg8::EpiFoxIn, pg8::StaticOrder, true, true>(lds + RING_OFF, g, S, E); }
FATPH ph_fox_sample(KAP a, LAS unsigned char* lds, int L) { const Ctx c = mk_ctx(); LAS float* red = (LAS float*)(lds + RING_OFF + 65536);
    for (int it = c.vcu; it < 256; it += c.G) { cum_local_sample(a, L, 2 * it, red, c.wave, c.lane); cum_local_sample(a, L, 2 * it + 1, red, c.wave, c.lane); foxs_item(a, L, it, lds, c.wave, c.lane); } }
__device__ __forceinline__ void unit2_of(int e, int& bh, int& qb) { bh = e >> 3; const int k = e & 7, s = (k >> 2) & 1, ii = k & 3, j = 2 * s + (ii >> 1); qb = (ii & 1) ? 7 - j : j; }
__device__ __forceinline__ void unit_of(int e, int& bh, int& qb) { bh = e >> 4; const int k = e & 15, s = (k >> 3) & 1, ii = k & 7, j = 2 * (ii >> 1) + s; qb = (ii & 1) ? 15 - j : j; }
FATPH ph_fox_attn(LAS unsigned char* lds, unsigned lds0) { const Ctx c = mk_ctx(); unsigned char* ws = ws_ptr();
    for (int e0 = c.vcu * 4; e0 < 1024; e0 += c.G * 4) {
        __syncthreads(); cum_local_prompt(KA, e0 >> 3, (LAS float*)(lds + RING_OFF + 65536), c.wave, c.lane);
        for (int i = 0; i < 4; ++i) { int bh, qb; unit2_of(e0 + i, bh, qb); const int b = bh >> 4, h = bh & 15;
            fa::Args A{WSB(WS_QF), 1024, h * 64, WSB(WS_KF), 1024, h * 64, nullptr, WSB(WS_VF), 1024, h * 64, (bf16*)(ws + WS_OM), h * 64,
                       WSB(WS_GF), (const float*)(ws + WS_CB) + (size_t)bh * 4096};
            fa::unit2<0>(A, (long)b * 4096, qb, (LAS char*)(lds + RING_OFF), lds0 + RING_OFF); } } }
FATPH ph_resid(LAS unsigned char* lds, const bf16* A, const bf16* Bt, int K, int first, int dummy = 0) { const Ctx c = mk_ctx(); unsigned char* ws = ws_ptr();
    pg8::Gemm g{A, Bt, MP, 1024, K}; pg8::StaticOrder S; S.init(MP, 1024, c.G, c.bx);
    pg8::EpiResid E{KA->in[I_XP], KA->in[I_XS], first, dummy ? (bf16*)(ws + WS_R1 + (size_t)MT * 4096) : (bf16*)(ws + WS_XB), dummy ? (float*)(ws + WS_R1 + (size_t)MT * 6144) : (float*)(ws + WS_SSQ)};
    pg8::gemm_phase<pg8::EpiResid, pg8::StaticOrder, true, true>(lds + RING_OFF, g, S, E); }
FATPH ph_scale_gemm(LAS unsigned char* lds, const bf16* A, const bf16* Bt, int M, int N, int K, const float* ssq, int stride, int ngrp, float inv_n, bf16* O, float scale) { const Ctx c = mk_ctx();
    pg8::Gemm g{A, Bt, M, N, K}; pg8::StaticOrder S; S.init(M, N, c.G, c.bx);
    pg8::EpiScaleBf16 E{pg8::RowScale{ssq, stride, ngrp, inv_n}, O, N, scale};
    pg8::gemm_phase<pg8::EpiScaleBf16, pg8::StaticOrder, true, true>(lds + RING_OFF, g, S, E); }
FATPH ph_cross(LAS unsigned char* lds, unsigned lds0, int layer) { const Ctx c = mk_ctx(); unsigned char* ws = ws_ptr();
    const bf16* QX = WSB(WS_QX); bf16* OX = (bf16*)(ws + WS_OM);
    const bool bal = (c.G == 256); const int nu = bal ? (c.vcu < 128 ? 1 : 3) : 2, ub = bal ? (c.vcu < 128 ? c.vcu : 128 + 3 * (c.vcu - 128)) : c.vcu * 2;
    for (int u0 = ub; u0 < 512; u0 += (bal ? 512 : c.G * 2))
        for (int i = 0; i < nu; ++i) { const int u = u0 + i, bh = u >> 4, qb = u & 15, b = bh >> 2, h = bh & 3; const size_t ko = ((size_t)layer * 2048 + b * 256) * 1024 + h * 256;
            xa::unit<false>(WSB(WS_MKB) + ko, WSB(WS_MVB) + ko, 1024, QX, OX, (size_t)b * 4096 + qb * 256, h * 256, 32, false, (LAS char*)(lds + RING_OFF), lds0 + RING_OFF); }
    for (int e = c.vcu; e < 128; e += c.G) { const int bs = e >> 2, h = e & 3; const size_t ko = ((size_t)(layer * 32 + bs) * 256) * 1024 + h * 256;
        xa::unit<true>(in_ptr(I_CMK) + ko, in_ptr(I_CMV) + ko, 1024, QX, OX, (size_t)MP + bs * 16, h * 256, 16, true, (LAS char*)(lds + RING_OFF), lds0 + RING_OFF); } }
FATPH ph_gu(LAS unsigned char* lds, int layer) { const Ctx c = mk_ctx(); unsigned char* ws = ws_ptr();
    pg8::Gemm g{WSB(WS_XB), WSB(WS_WGU) + (size_t)layer * 5632 * 1024, MT, 5632, 1024}; pg8::StaticOrder S; S.init(MT, 5632, c.G, c.bx);
    pg8::EpiSwiglu E{RSX(ws), (bf16*)(ws + WS_HB)}; pg8::gemm_phase<pg8::EpiSwiglu, pg8::StaticOrder, true, true>(lds + RING_OFF, g, S, E); }
FATPH ph_mla_a(LAS unsigned char* lds, int L) { const Ctx c = mk_ctx(); unsigned char* ws = ws_ptr(); float* out = out_ptr();
    pg8::Gemm g{WSB(WS_XB), WSB(WS_WMA) + (size_t)L * 768 * 1024, MT, 768, 1024}; pg8::StaticOrder S; S.init(MT, 768, c.G, c.bx);
    pg8::EpiMlaA E{RSX(ws), (float*)(ws + WS_CKVU), (bf16*)(ws + WS_CKVUB), (float*)(ws + WS_SSQKV), (bf16*)(ws + WS_CQ), (float*)(ws + WS_SSQQ), (bf16*)(ws + WS_KRB),
                   out + O_MRP + (size_t)L * MP * 32, out + O_MRS + (size_t)L * MS * 32, (const float*)(ws + WS_ROPC), (const float*)(ws + WS_ROPS)};
    pg8::gemm_phase<pg8::EpiMlaA, pg8::StaticOrder, true, true>(lds + RING_OFF, g, S, E); }
PHASE ph_fixup(KAP a, int L) { const Ctx c = mk_ctx(); ckv_fixup(a, L, c.gw, c.NGW, c.lane); }
FATPH ph_mla_q(LAS unsigned char* lds, int L, int kq) { const Ctx c = mk_ctx(); unsigned char* ws = ws_ptr();
    pg8::Gemm g{WSB(WS_CQ), WSB(WS_WMQ) + (size_t)L * 1536 * 384, MT, 1536, kq}; pg8::StaticOrder S; S.init(MT, 1536, c.G, c.bx);
    pg8::EpiMlaQ E{pg8::RowScale{(const float*)(ws + WS_SSQQ), 8, 2, 1.0f / 384.0f}, (bf16*)(ws + WS_QM), (const float*)(ws + WS_ROPC), (const float*)(ws + WS_ROPS)};
    pg8::gemm_phase<pg8::EpiMlaQ, pg8::StaticOrder, true, false>(lds + RING_OFF, g, S, E); }
FATPH ph_mla_sample(LAS unsigned char* lds, unsigned lds0, int L) { const Ctx c = mk_ctx(); for (int it = c.vcu; it < 288; it += c.G) mlas_item(KA, L, it, lds, lds0, c.wave, c.lane); __syncthreads(); }
FATPH ph_mla_attn(LAS unsigned char* lds, unsigned lds0) { const Ctx c = mk_ctx(); unsigned char* ws = ws_ptr();
    for (int e0 = c.vcu * 4; e0 < 1024; e0 += c.G * 4)
        for (int i = 0; i < 4; ++i) { int bh, qb; unit2_of(e0 + i, bh, qb); const int b = bh >> 4, h = bh & 15;
            fa::Args A{WSB(WS_QM), 1536, h * 96, WSB(WS_KVM), 2048, h * 128, WSB(WS_KRB), WSB(WS_KVM), 2048, h * 128 + 64, (bf16*)(ws + WS_OM), h * 64,
                       nullptr, nullptr};
            fa::unit2<1>(A, (long)b * 4096, qb, (LAS char*)(lds + RING_OFF), lds0 + RING_OFF); } }
FATPH ph_mla_comb(LAS unsigned char* lds, int L) { const Ctx c = mk_ctx(); mlas_combine(KA, L, lds, c.gw, c.NGW, c.wave, c.lane); }
PHASE ph_thin_resid(KAP a, LAS unsigned char* lds, const bf16* A, const bf16* Bt, int K, int first) { const Ctx c = mk_ctx(); if (K == 1024) thin_resid<1024>(a, A, Bt, first, lds, c.vcu, c.G, c.wave, c.lane); else thin_resid<DFF>(a, A, Bt, first, lds, c.vcu, c.G, c.wave, c.lane); }
PHASE ph_thin_xq(KAP a, LAS unsigned char* lds, const bf16* Bt) { const Ctx c = mk_ctx(); thin_xq(a, Bt, lds, c.vcu, c.G, c.wave, c.lane); }
PHASE ph_final(KAP a) { const Ctx c = mk_ctx(); final_phase(a, c.gw, c.NGW, c.lane); }
PHASE ph_grid_bar(GAS unsigned* barw, unsigned x, volatile LAS unsigned* st) { XcdBarrier b; b.bar = (unsigned*)barw; b.x = x; b.st = st; xcd_barrier(b); }

__global__ void __launch_bounds__(NWAVES * 64, 2) fwd_kernel(KArgs args) {
    extern __shared__ __attribute__((aligned(16))) unsigned char lds_raw[];
    LAS unsigned char* lds = (LAS unsigned char*)lds_raw;
    volatile LAS unsigned* MISC = (volatile LAS unsigned*)(lds + MISC_OFF);
    const int tid = threadIdx.x;
    const unsigned lds0 = (unsigned)(uintptr_t)lds_raw;
    for (int u = tid; u < (LDS_BYTES - LDSCTL_OFF) / 4; u += NWAVES * 64) ((LAS unsigned*)(lds + LDSCTL_OFF))[u] = 0u;
    __syncthreads();
    const XcdBarrier bar = xcd_barrier_post((unsigned*)(args.ws + WS_CTL) + CW_BAR, MISC + 8);
    const int lo = args.ph_lo, hi = args.ph_hi;
#ifndef DBG_DOUBLE
#define DBG_DOUBLE 0
#endif
#ifndef DBG_P0_AGAIN
#define DBG_P0_AGAIN 0
#endif
#define REP(bit) for (int rep_ = 0; rep_ < ((DBG_DOUBLE & (bit)) ? 2 : 1); ++rep_)
#define IN(k) (lo <= (k) && (k) < hi)
#define SEAM(k) do { if (IN(k) && IN((k) + 1)) { REP(256) ph_grid_bar((GAS unsigned*)bar.bar, bar.x, bar.st); } } while (0)
    if (IN(0)) { ph_prologue(KA, lds, 0x7f); if (DBG_P0_AGAIN) ph_prologue(KA, lds, DBG_P0_AGAIN); }
    SEAM(0);
    if (IN(1)) ph_memkv(lds);
    SEAM(1);
    for (int L = 0; L < 2; ++L) {
        const int pb = 2 + 19 * L;
        if (IN(pb)) { REP(8) ph_fox_in(lds, L); }
        SEAM(pb);
        if (IN(pb + 2)) { REP(64) ph_fox_sample(KA, lds, L); REP(32) ph_fox_attn(lds, lds0); }
        SEAM(pb + 2);
        if (IN(pb + 3)) { ph_thin_resid(KA, lds, WSB(WS_OM), WSB(WS_WFO) + (size_t)L * 1024 * 1024, 1024, L == 0); if (DBG_DOUBLE & 512) ph_resid(lds, WSB(WS_OM), WSB(WS_WFO) + (size_t)L * 1024 * 1024, 1024, L == 0, 1); ph_resid(lds, WSB(WS_OM), WSB(WS_WFO) + (size_t)L * 1024 * 1024, 1024, L == 0); }
        SEAM(pb + 3);
        for (int sub = 0; sub < 2; ++sub) {
            const int layer = 2 * L + sub, cb = pb + 4 + 10 * sub;
            if (sub == 1) {
                if (IN(pb + 9)) ph_mla_a(lds, L);
                SEAM(pb + 9);
                if (IN(pb + 10)) { ph_fixup(KA, L); ph_mla_q(lds, L, 384);
                    ph_scale_gemm(lds, WSB(WS_CKVUB), WSB(WS_WMKV) + (size_t)L * 2048 * 256, MP, 2048, 256, (const float*)(ws_ptr() + WS_SSQKV), 4, 1, 1.0f / 256.0f, (bf16*)(ws_ptr() + WS_KVM), 1.0f); }
                SEAM(pb + 10);
                if (IN(pb + 11)) { REP(128) ph_mla_sample(lds, lds0, L); REP(32) ph_mla_attn(lds, lds0); }
                SEAM(pb + 11);
                if (IN(pb + 12)) REP(16) ph_mla_comb(lds, L);
                SEAM(pb + 12);
                if (IN(pb + 13)) { ph_thin_resid(KA, lds, WSB(WS_OM), WSB(WS_WMO) + (size_t)L * 1024 * 1024, 1024, 0); if (DBG_DOUBLE & 512) ph_resid(lds, WSB(WS_OM), WSB(WS_WMO) + (size_t)L * 1024 * 1024, 1024, 0, 1); ph_resid(lds, WSB(WS_OM), WSB(WS_WMO) + (size_t)L * 1024 * 1024, 1024, 0); }
                SEAM(pb + 13);
            }
            if (IN(cb)) { ph_thin_xq(KA, lds, WSB(WS_WXQ) + (size_t)layer * 1024 * 1024); ph_scale_gemm(lds, WSB(WS_XB), WSB(WS_WXQ) + (size_t)layer * 1024 * 1024, MP, 1024, 1024, (const float*)(ws_ptr() + WS_SSQ), 16, 4, 1.0f / 1024.0f, (bf16*)(ws_ptr() + WS_QX), C2_X); }
            SEAM(cb);
            if (IN(cb + 1)) REP(2) ph_cross(lds, lds0, layer);
            SEAM(cb + 1);
            if (IN(cb + 2)) { ph_thin_resid(KA, lds, WSB(WS_OM), WSB(WS_WXO) + (size_t)layer * 1024 * 1024, 1024, 0); if (DBG_DOUBLE & 512) ph_resid(lds, WSB(WS_OM), WSB(WS_WXO) + (size_t)layer * 1024 * 1024, 1024, 0, 1); ph_resid(lds, WSB(WS_OM), WSB(WS_WXO) + (size_t)layer * 1024 * 1024, 1024, 0); }
            SEAM(cb + 2);
            if (IN(cb + 3)) REP(8) ph_gu(lds, layer);
            SEAM(cb + 3);
            if (IN(cb + 4)) { ph_thin_resid(KA, lds, WSB(WS_HB), WSB(WS_WDN) + (size_t)layer * 1024 * 2816, DFF, 0); if (DBG_DOUBLE & 512) ph_resid(lds, WSB(WS_HB), WSB(WS_WDN) + (size_t)layer * 1024 * 2816, DFF, 0, 1); ph_resid(lds, WSB(WS_HB), WSB(WS_WDN) + (size_t)layer * 1024 * 2816, DFF, 0); }
            SEAM(cb + 4);
        }
    }
    if (IN(40)) ph_final(KA);
#undef IN
#undef SEAM
}

#ifndef DBG_PH_HI
#define DBG_PH_HI NPH
#endif
#ifndef MK_PER_PHASE
#define MK_PER_PHASE 0
#endif
extern "C" void kernel_launch(void* const* d_in, const int* in_sizes, int n_in, void* d_out, int out_size, void* d_ws, size_t ws_size, hipStream_t stream) {
    static int grid = 0;
    if (grid == 0) {
        if (n_in != N_IN || (size_t)out_size != O_END || ws_size < WS_END) { fprintf(stderr, "kernel_launch: unexpected shapes (n_in %d, out %d, ws %zu; need %d, %zu, %zu)\n", n_in, out_size, ws_size, (int)N_IN, (size_t)O_END, (size_t)WS_END); grid = -1; return; }
        int dev = 0, cus = 0, per_cu = 0;
        if (hipGetDevice(&dev) != hipSuccess || hipDeviceGetAttribute(&cus, hipDeviceAttributeMultiprocessorCount, dev) != hipSuccess) { grid = -1; return; }
        if (hipFuncSetAttribute((const void*)fwd_kernel, hipFuncAttributeMaxDynamicSharedMemorySize, LDS_BYTES) != hipSuccess) { fprintf(stderr, "kernel_launch: hipFuncSetAttribute failed\n"); grid = -1; return; }
        if (hipOccupancyMaxActiveBlocksPerMultiprocessor(&per_cu, (const void*)fwd_kernel, NWAVES * 64, LDS_BYTES) != hipSuccess || per_cu < 1) { fprintf(stderr, "kernel_launch: occupancy query reports %d\n", per_cu); }
        (void)hipGetLastError();
        grid = cus;
    }
    if (grid < 0) return;
    if (hipMemsetAsync((char*)d_ws + WS_CTL, 0, CTL_ZERO_BYTES, stream) != hipSuccess) return;
    KArgs a{};
    for (int i = 0; i < N_IN; ++i) a.in[i] = (const float*)d_in[i];
    a.out = (float*)d_out; a.ws = (unsigned char*)d_ws;
#if MK_PER_PHASE
    for (int p = 0; p < NPH; ++p) { a.ph_lo = p; a.ph_hi = p + 1; hipLaunchKernelGGL(fwd_kernel, dim3(grid), dim3(NWAVES * 64), LDS_BYTES, stream, a); }
#else
    a.ph_lo = 0; a.ph_hi = DBG_PH_HI; hipLaunchKernelGGL(fwd_kernel, dim3(grid), dim3(NWAVES * 64), LDS_BYTES, stream, a);
#endif
}
```

```cpp
#include <hip/hip_runtime.h>
#include <cstdint>
#include <cstdio>
#include <cmath>

constexpr int D = 1024, MP = 32768, MS = 512, MT = MP + MS, SEQ = 4096, NBP = 8, NBS = 32, DSEQ = 16, PAST = 2048, NMEM = 256;
constexpr int DFF = 2816, KPAD = 2112;
constexpr float EPS = 1e-6f, LOG2E = 1.4426950408889634f;
constexpr float C2_FOX = 0.125f * LOG2E, C2_MLA = 0.10206207261596575f * LOG2E, C2_X = 0.0625f * LOG2E;

constexpr size_t O_Y = 0;
constexpr size_t O_FKP = (size_t)MT * D;
constexpr size_t O_FVP = O_FKP + (size_t)2 * MP * 1024;
constexpr size_t O_FLP = O_FVP + (size_t)2 * MP * 1024;
constexpr size_t O_MCP = O_FLP + (size_t)2 * MP * 16;
constexpr size_t O_MRP = O_MCP + (size_t)2 * MP * 256;
constexpr size_t O_MKP = O_MRP + (size_t)2 * MP * 32;
constexpr size_t O_MVP = O_MKP + (size_t)4 * 2048 * 1024;
constexpr size_t O_FKS = O_MVP + (size_t)4 * 2048 * 1024;
constexpr size_t O_FVS = O_FKS + (size_t)2 * MS * 1024;
constexpr size_t O_FLS = O_FVS + (size_t)2 * MS * 1024;
constexpr size_t O_MCS = O_FLS + (size_t)2 * MS * 16;
constexpr size_t O_MRS = O_MCS + (size_t)2 * MS * 256;
constexpr size_t O_END = O_MRS + (size_t)2 * MS * 32;

enum { I_XP = 0, I_XS, I_MEM, I_CFK, I_CFV, I_CFL, I_CCKV, I_CKR, I_CMK, I_CMV, I_GMIX, I_GCROSS, I_GMEM, I_GFFN, I_GFINAL,
       I_WFI, I_BFF, I_WFO, I_WMA, I_GMQ, I_GMKV, I_WMQB, I_WMKVB, I_WMO, I_WXQ, I_WXKV, I_WXO, I_WGU, I_WDN, N_IN };


constexpr size_t al256(size_t x) { return (x + 255) & ~(size_t)255; }
constexpr size_t WS_CTL = 0, CTL_ZERO_BYTES = 1u << 20;
constexpr size_t WS_WFI = 2u << 20;
constexpr size_t WS_WFO = WS_WFI + (size_t)2 * 4352 * 1024 * 2;
constexpr size_t WS_WMA = WS_WFO + (size_t)2 * 1024 * 1024 * 2;
constexpr size_t WS_WMQ = WS_WMA + (size_t)2 * 768 * 1024 * 2;
constexpr size_t WS_WMKV = WS_WMQ + (size_t)2 * 1536 * 384 * 2;
constexpr size_t WS_WMKVR = WS_WMKV + (size_t)2 * 2048 * 256 * 2;
constexpr size_t WS_WKN = WS_WMKVR + (size_t)2 * 2048 * 256 * 2;
constexpr size_t WS_WMO = WS_WKN + (size_t)2 * 256 * 2048 * 2;
constexpr size_t WS_WXQ = WS_WMO + (size_t)2 * 1024 * 1024 * 2;
constexpr size_t WS_WXO = WS_WXQ + (size_t)4 * 1024 * 1024 * 2;
constexpr size_t WS_WXKV = WS_WXO + (size_t)4 * 1024 * 1024 * 2;
constexpr size_t WS_WGU = WS_WXKV + (size_t)4 * 2048 * 1024 * 2;
constexpr size_t WS_WDN = WS_WGU + (size_t)4 * 5632 * 1024 * 2;
constexpr size_t WS_WFF = WS_WDN + (size_t)4 * 1024 * 2816 * 2;
constexpr size_t WS_ROPC = WS_WFF + (size_t)2 * 16 * 1024 * 4;
constexpr size_t WS_ROPS = WS_ROPC + (size_t)4096 * 16 * 4;
constexpr size_t WS_XB = WS_ROPS + (size_t)4096 * 16 * 4;
constexpr size_t WS_SSQ = WS_XB + (size_t)MT * 1024 * 2;
constexpr size_t WS_R1 = al256(WS_SSQ + (size_t)MT * 16 * 4);
constexpr size_t SZ_ACT = (size_t)MT * 1024 * 2;
constexpr size_t WS_QF = WS_R1, WS_KF = WS_R1 + SZ_ACT, WS_VF = WS_R1 + 2 * SZ_ACT, WS_GF = WS_R1 + 3 * SZ_ACT;
constexpr size_t WS_QM = WS_R1, WS_KVM = al256(WS_R1 + (size_t)MT * 1536 * 2);
static_assert(WS_KVM + (size_t)MP * 2048 * 2 <= WS_R1 + 4 * SZ_ACT, "MLA overlay fits");
constexpr size_t WS_OM = WS_R1 + 4 * SZ_ACT;
constexpr size_t WS_LFR = WS_OM + SZ_ACT;
constexpr size_t WS_CB = WS_LFR + (size_t)MT * 16 * 4;
constexpr size_t WS_CBS = WS_CB + (size_t)8 * 16 * 4096 * 4;
constexpr size_t WS_CKVU = al256(WS_CBS + (size_t)32 * 16 * 2080 * 4);
constexpr size_t WS_CKVUB = WS_CKVU + (size_t)MT * 256 * 4;
constexpr size_t WS_SSQKV = WS_CKVUB + (size_t)MT * 256 * 2;
constexpr size_t WS_CQ = WS_SSQKV + (size_t)MT * 4 * 4;
constexpr size_t WS_SSQQ = WS_CQ + (size_t)MT * 384 * 2;
constexpr size_t WS_KRB = WS_SSQQ + (size_t)MT * 8 * 4;
constexpr size_t WS_QA = al256(WS_KRB + (size_t)MT * 32 * 2);
constexpr size_t WS_PART = al256(WS_QA + (size_t)288 * 256 * 288 * 2);
constexpr size_t WS_QX = al256(WS_PART + (size_t)32 * 9 * 256 * 264 * 4);
constexpr size_t WS_MB = WS_QX + SZ_ACT;
constexpr size_t WS_MKB = WS_MB + (size_t)2048 * 1024 * 2;
constexpr size_t WS_MVB = WS_MKB + (size_t)4 * 2048 * 1024 * 2;
constexpr size_t WS_HB = WS_MVB + (size_t)4 * 2048 * 1024 * 2;
constexpr size_t WS_END = WS_HB + (size_t)MT * DFF * 2;
constexpr int CW_BAR = 4096;

namespace pg8 {
#define PG8_LAS __attribute__((address_space(3)))
typedef unsigned short bf16_t;
typedef short bf16x8 __attribute__((ext_vector_type(8)));
typedef float f32x4 __attribute__((ext_vector_type(4)));
typedef unsigned u32x4 __attribute__((ext_vector_type(4)));
constexpr int BM = 256, BK = 64, HALF = 128, HTB = HALF * BK * 2  , STAGE_BYTES = 8 * HTB, NXCD = 8, WGM = 8;

__host__ __device__ __forceinline__ int lds_byte(int r, int c) { const int st = (r >> 4) * 2 + (c >> 5), rr = r & 15, cc = c & 31, ob = rr * 64 + cc * 2; return st * 1024 + (ob ^ (((ob >> 9) & 1) << 5)); }
__host__ __device__ __forceinline__ void stage_rc(int b, int& R, int& C) { const int st = b / 1024, sb = b % 1024, swz = sb ^ (((sb >> 9) & 1) << 5); R = (st >> 1) * 16 + swz / 64; C = (st & 1) * 32 + (swz % 64) / 2; }
__host__ __device__ __forceinline__ int perm32(int rho) { const int n = rho >> 4, i = rho & 15; return 8 * (i >> 2) + 4 * n + (i & 3); }

struct Unit { int pm, pn; };
struct Gemm { const bf16_t* A; const bf16_t* Bt; int M, N, K; };

struct StaticOrder {
    int nM, nN, nwg, G, c;
    __host__ __device__ void init(int M, int N, int G_, int c_) { nM = M / BM; nN = N / BM; nwg = nM * nN; G = G_; c = c_; }
    __host__ __device__ bool next(int i, Unit& u) const {
        const long L = (long)i * G + c; if (L >= nwg) return false;
        int wgid = (int)L; { const int q = nwg / NXCD, r = nwg % NXCD, xcd = wgid % NXCD, off = wgid / NXCD; wgid = (xcd < r ? xcd * (q + 1) : r * (q + 1) + (xcd - r) * q) + off; }
        const int nig = WGM * nN, gid = wgid / nig, fm = gid * WGM, gsz = (nM - fm) < WGM ? (nM - fm) : WGM;
        u.pm = fm + ((wgid % nig) % gsz); u.pn = (wgid % nig) / gsz; return true;
    }
    __device__ __forceinline__ void a_ready(const Unit&) const {}
    __device__ __forceinline__ void done(const Unit&) const {}
};

typedef unsigned u32x2 __attribute__((ext_vector_type(2)));
typedef float f32x2v __attribute__((ext_vector_type(2)));
typedef __bf16 bf16x2_t __attribute__((ext_vector_type(2)));
__device__ __forceinline__ unsigned pk_bf16(float lo, float hi) { f32x2v v = {lo, hi}; bf16x2_t b = __builtin_convertvector(v, bf16x2_t); return __builtin_bit_cast(unsigned, b); }
__device__ __forceinline__ u32x2 pk4(f32x4 v) { u32x2 w; w.x = pk_bf16(v[0], v[1]); w.y = pk_bf16(v[2], v[3]); return w; }
__device__ __forceinline__ float dot4(f32x4 v) { return (v[0] * v[0] + v[1] * v[1]) + (v[2] * v[2] + v[3] * v[3]); }
__device__ __forceinline__ float sigm(float z) { return __builtin_amdgcn_rcpf(1.0f + __builtin_amdgcn_exp2f(-z * LOG2E)); }
#define EPI_FENCE() asm volatile("" ::: "memory")
__device__ __forceinline__ int pg8_tid() { int t = threadIdx.x; asm volatile("" : "+v"(t)); return t; }

struct RowScale { const float* p; int stride; int ngrp; float inv_n;
    __device__ __forceinline__ float get(int row, int fq) const {
        float s = 0.f; if (fq < ngrp) { const f32x4 v = *(const f32x4*)(p + (size_t)row * stride + 4 * fq); s = (v[0] + v[1]) + (v[2] + v[3]); }
        s += __shfl_xor(s, 16); s += __shfl_xor(s, 32); return rsqrtf(s * inv_n + EPS); }
    __device__ __forceinline__ void get8(int row0, int fq, float (&r)[2][4]) const {
        float s[2][4];
#pragma unroll
        for (int ai = 0; ai < 2; ++ai)
#pragma unroll
            for (int m = 0; m < 4; ++m) { s[ai][m] = 0.f; if (fq < ngrp) { const f32x4 v = *(const f32x4*)(p + (size_t)(row0 + ai * HALF + m * 16) * stride + 4 * fq); s[ai][m] = (v[0] + v[1]) + (v[2] + v[3]); } }
#pragma unroll
        for (int ai = 0; ai < 2; ++ai)
#pragma unroll
            for (int m = 0; m < 4; ++m) { float t = s[ai][m]; t += __shfl_xor(t, 16); t += __shfl_xor(t, 32); r[ai][m] = rsqrtf(t * inv_n + EPS); }
    } };
__device__ __forceinline__ int row_pos(int row) { return row < MP ? (row & (SEQ - 1)) : PAST + ((row - MP) & (DSEQ - 1)); }

struct EpiFoxIn { static constexpr bool PERM = false, AFTER_DRAIN = false;
    RowScale rs; unsigned char* ws; float* out; const float* bff; int L;
    __device__ __forceinline__ void operator()(const f32x4 (&acc)[2][2][4][2], const Unit& u, int wr, int wc, int, int) const { const int lane_ = pg8_tid() & 63, fr = lane_ & 15, fq = lane_ >> 4; float rsv[2][4]; rs.get8(u.pm * BM + wr * 64 + fr, fq, rsv);
        const int typ = u.pn >> 2, colt = (u.pn & 3) * 256 + wc * 32 + 4 * fq;
        bf16_t* QF = (bf16_t*)(ws + WS_QF); float* kp = out + O_FKP + (size_t)L * MP * 1024; float* ks = out + O_FKS + (size_t)L * MS * 1024;
#pragma unroll
        for (int ai = 0; ai < 2; ++ai)
#pragma unroll
            for (int m = 0; m < 4; ++m) { const int row = u.pm * BM + ai * HALF + wr * 64 + m * 16 + fr; float r = rsv[ai][m];
                if (typ == 0) { r *= C2_FOX;
#pragma unroll
                    for (int bj = 0; bj < 2; ++bj)
#pragma unroll
                        for (int n = 0; n < 2; ++n) *(u32x2*)(QF + (size_t)row * 1024 + colt + bj * HALF + n * 16) = pk4(acc[ai][bj][m][n] * r);
                } else if (typ == 3) {
#pragma unroll
                    for (int bj = 0; bj < 2; ++bj)
#pragma unroll
                        for (int n = 0; n < 2; ++n) { f32x4 v = acc[ai][bj][m][n] * r; v[0] = sigm(v[0]); v[1] = sigm(v[1]); v[2] = sigm(v[2]); v[3] = sigm(v[3]);
                            *(u32x2*)(QF + 3 * (SZ_ACT / 2) + (size_t)row * 1024 + colt + bj * HALF + n * 16) = pk4(v); }
                } else if (typ == 4) {
                    if (wc == 0) { const f32x4 bb = *(const f32x4*)(bff + 4 * fq); f32x4 lf;
#pragma unroll
                        for (int i = 0; i < 4; ++i) { const float z = acc[ai][0][m][0][i] * r + bb[i]; lf[i] = fminf(z, 0.f) - log1pf(expf(-fabsf(z))); }
                        *(f32x4*)((float*)(ws + WS_LFR) + (size_t)row * 16 + 4 * fq) = lf;
                        float* F = (row < MP) ? out + O_FLP + ((size_t)L * MP + row) * 16 : out + O_FLS + ((size_t)L * MS + (row - MP)) * 16;
                        *(f32x4*)(F + 4 * fq) = lf; }
                } else { bf16_t* B = QF + (size_t)typ * (SZ_ACT / 2);
                    float* F = (row < MP) ? kp + (size_t)(typ - 1) * 2 * MP * 1024 + (size_t)row * 1024 : ks + (size_t)(typ - 1) * 2 * MS * 1024 + (size_t)(row - MP) * 1024;
#pragma unroll
                    for (int bj = 0; bj < 2; ++bj)
#pragma unroll
                        for (int n = 0; n < 2; ++n) { const f32x4 v = acc[ai][bj][m][n] * r; const int c = colt + bj * HALF + n * 16;
                            *(f32x4*)(F + c) = v; *(u32x2*)(B + (size_t)row * 1024 + c) = pk4(v); }
                }
                if (m & 1) EPI_FENCE(); }
    }
};
struct EpiResid { static constexpr bool PERM = true, AFTER_DRAIN = false;
    const float* xin_p; const float* xin_s; int first; bf16_t* xb; float* ssq;
    __device__ __forceinline__ void operator()(const f32x4 (&acc)[2][2][4][2], const Unit& u, int wr, int wc, int, int) const { const int lane_ = pg8_tid() & 63, fr = lane_ & 15, fq = lane_ >> 4;
        const int col0 = u.pn * BM + wc * 32 + 8 * fq;
        if (first) {
#pragma unroll
        for (int ai = 0; ai < 2; ++ai) {
            f32x4 xo[4][2][2];
#pragma unroll
            for (int m = 0; m < 4; ++m) { const int row = u.pm * BM + ai * HALF + wr * 64 + m * 16 + fr;
                const float* xi = (row < MP) ? xin_p + (size_t)row * 1024 : xin_s + (size_t)(row - MP) * 1024;
#pragma unroll
                for (int bj = 0; bj < 2; ++bj)
#pragma unroll
                    for (int n = 0; n < 2; ++n) xo[m][bj][n] = *(const f32x4*)(xi + col0 + bj * HALF + n * 4); }
#pragma unroll
            for (int m = 0; m < 4; ++m) { const int row = u.pm * BM + ai * HALF + wr * 64 + m * 16 + fr; float sq = 0.f;
#pragma unroll
                for (int bj = 0; bj < 2; ++bj) { const int c = col0 + bj * HALF; const f32x4 x0 = xo[m][bj][0] + acc[ai][bj][m][0], x1 = xo[m][bj][1] + acc[ai][bj][m][1];
                    sq += dot4(x0) + dot4(x1);
                    const u32x2 w0 = pk4(x0), w1 = pk4(x1); *(u32x4*)(xb + (size_t)row * 1024 + c) = (u32x4){w0.x, w0.y, w1.x, w1.y}; }
                sq += __shfl_xor(sq, 16); sq += __shfl_xor(sq, 32);
                if (fq == 0) ssq[(size_t)row * 16 + u.pn * 4 + wc] = sq; }
            EPI_FENCE(); }
        } else {
            u32x4 raw[2][4][2];
#pragma unroll
            for (int ai = 0; ai < 2; ++ai)
#pragma unroll
                for (int m = 0; m < 4; ++m) { const int row = u.pm * BM + ai * HALF + wr * 64 + m * 16 + fr;
#pragma unroll
                    for (int bj = 0; bj < 2; ++bj) raw[ai][m][bj] = *(const u32x4*)(xb + (size_t)row * 1024 + col0 + bj * HALF); }
            EPI_FENCE();
#pragma unroll
            for (int ai = 0; ai < 2; ++ai) {
#pragma unroll
                for (int m = 0; m < 4; ++m) { const int row = u.pm * BM + ai * HALF + wr * 64 + m * 16 + fr; float sq = 0.f;
#pragma unroll
                    for (int bj = 0; bj < 2; ++bj) { const int c = col0 + bj * HALF; const u32x4 w = raw[ai][m][bj];
                        const f32x4 x0 = (f32x4){__builtin_bit_cast(float, w.x << 16), __builtin_bit_cast(float, w.x & 0xffff0000u), __builtin_bit_cast(float, w.y << 16), __builtin_bit_cast(float, w.y & 0xffff0000u)} + acc[ai][bj][m][0];
                        const f32x4 x1 = (f32x4){__builtin_bit_cast(float, w.z << 16), __builtin_bit_cast(float, w.z & 0xffff0000u), __builtin_bit_cast(float, w.w << 16), __builtin_bit_cast(float, w.w & 0xffff0000u)} + acc[ai][bj][m][1];
                        sq += dot4(x0) + dot4(x1);
                        const u32x2 w0 = pk4(x0), w1 = pk4(x1); *(u32x4*)(xb + (size_t)row * 1024 + c) = (u32x4){w0.x, w0.y, w1.x, w1.y}; }
                    sq += __shfl_xor(sq, 16); sq += __shfl_xor(sq, 32);
                    if (fq == 0) ssq[(size_t)row * 16 + u.pn * 4 + wc] = sq; }
                EPI_FENCE(); } }
    }
};
struct EpiScaleBf16 { static constexpr bool PERM = true, AFTER_DRAIN = false;
    RowScale rs; bf16_t* O; int ldc; float scale;
    __device__ __forceinline__ void operator()(const f32x4 (&acc)[2][2][4][2], const Unit& u, int wr, int wc, int, int) const { const int lane_ = pg8_tid() & 63, fr = lane_ & 15, fq = lane_ >> 4; float rsv[2][4]; rs.get8(u.pm * BM + wr * 64 + fr, fq, rsv);
        const int col0 = u.pn * BM + wc * 32 + 8 * fq;
#pragma unroll
        for (int ai = 0; ai < 2; ++ai)
#pragma unroll
            for (int m = 0; m < 4; ++m) { const int row = u.pm * BM + ai * HALF + wr * 64 + m * 16 + fr; const float r = rsv[ai][m] * scale;
#pragma unroll
                for (int bj = 0; bj < 2; ++bj) { const u32x2 w0 = pk4(acc[ai][bj][m][0] * r), w1 = pk4(acc[ai][bj][m][1] * r);
                    *(u32x4*)(O + (size_t)row * ldc + col0 + bj * HALF) = (u32x4){w0.x, w0.y, w1.x, w1.y}; }
                if (m & 1) EPI_FENCE(); }
    }
};
struct EpiSwiglu { static constexpr bool PERM = true, AFTER_DRAIN = false;
    RowScale rs; bf16_t* HB;
    __device__ __forceinline__ void operator()(const f32x4 (&acc)[2][2][4][2], const Unit& u, int wr, int wc, int, int) const { const int lane_ = pg8_tid() & 63, fr = lane_ & 15, fq = lane_ >> 4; float rsv[2][4]; rs.get8(u.pm * BM + wr * 64 + fr, fq, rsv);
        const int col0 = u.pn * HALF + wc * 32 + 8 * fq;
        const bool blk = u.pm < MP / BM; const int rstr = blk ? 128 : DFF * 2;
        const size_t hb0 = blk ? ((size_t)(u.pm * (DFF / 64) + (col0 >> 6)) * 32768 + (size_t)(col0 & 63) * 2) : ((size_t)u.pm * BM * DFF + col0) * 2;
#pragma unroll
        for (int ai = 0; ai < 2; ++ai)
#pragma unroll
            for (int m = 0; m < 4; ++m) { const int row = u.pm * BM + ai * HALF + wr * 64 + m * 16 + fr; const float r = rsv[ai][m]; u32x4 w;
#pragma unroll
                for (int n = 0; n < 2; ++n) { const f32x4 g = acc[ai][0][m][n] * r, uu = acc[ai][1][m][n] * r; f32x4 h;
#pragma unroll
                    for (int i = 0; i < 4; ++i) h[i] = g[i] * sigm(g[i]) * uu[i];
                    const u32x2 hw = pk4(h); if (n == 0) { w.x = hw.x; w.y = hw.y; } else { w.z = hw.x; w.w = hw.y; } }
                *(u32x4*)((char*)HB + hb0 + (size_t)(row - u.pm * BM) * rstr) = w;
                if (m & 1) EPI_FENCE(); }
    }
};
struct EpiMlaA { static constexpr bool PERM = false, AFTER_DRAIN = false;
    RowScale rs; float* ckvu; bf16_t* ckvub; float* ssqkv; bf16_t* cq; float* ssqq; bf16_t* krb; float *mrp, *mrs; const float *ropc, *rops;
    __device__ __forceinline__ void operator()(const f32x4 (&acc)[2][2][4][2], const Unit& u, int wr, int wc, int, int) const { const int lane_ = pg8_tid() & 63, fr = lane_ & 15, fq = lane_ >> 4; float rsv[2][4]; rs.get8(u.pm * BM + wr * 64 + fr, fq, rsv);
        const int cw = wc * 32 + 4 * fq;
#pragma unroll
        for (int ai = 0; ai < 2; ++ai)
#pragma unroll
            for (int m = 0; m < 4; ++m) { const int row = u.pm * BM + ai * HALF + wr * 64 + m * 16 + fr; const float r = rsv[ai][m];
                if (u.pn == 0) { float sq = 0.f;
#pragma unroll
                    for (int bj = 0; bj < 2; ++bj)
#pragma unroll
                        for (int n = 0; n < 2; ++n) { const int c = cw + bj * HALF + n * 16; const f32x4 v = acc[ai][bj][m][n] * r;
                            *(f32x4*)(ckvu + (size_t)row * 256 + c) = v; *(u32x2*)(ckvub + (size_t)row * 256 + c) = pk4(v); sq += dot4(v); }
                    sq += __shfl_xor(sq, 16); sq += __shfl_xor(sq, 32); if (fq == 0) ssqkv[(size_t)row * 4 + wc] = sq;
                } else if (u.pn == 1) { float sq = 0.f;
#pragma unroll
                    for (int bj = 0; bj < 2; ++bj)
#pragma unroll
                        for (int n = 0; n < 2; ++n) { const int c = cw + bj * HALF + n * 16; const f32x4 v = acc[ai][bj][m][n] * r;
                            *(u32x2*)(cq + (size_t)row * 384 + c) = pk4(v); sq += dot4(v); }
                    sq += __shfl_xor(sq, 16); sq += __shfl_xor(sq, 32); if (fq == 0) ssqq[(size_t)row * 8 + wc] = sq;
                } else { float sq = 0.f;
#pragma unroll
                    for (int n = 0; n < 2; ++n) { const int c = 256 + cw + n * 16; const f32x4 v = acc[ai][0][m][n] * r;
                        *(u32x2*)(cq + (size_t)row * 384 + c) = pk4(v); sq += dot4(v); }
                    sq += __shfl_xor(sq, 16); sq += __shfl_xor(sq, 32); if (fq == 0) ssqq[(size_t)row * 8 + 4 + wc] = sq;
                    if (wc == 0) { const int pos = row_pos(row); const f32x4 cs = *(const f32x4*)(ropc + pos * 16 + 4 * fq), sn = *(const f32x4*)(rops + pos * 16 + 4 * fq);
                        const f32x4 x1 = acc[ai][1][m][0] * r, x2 = acc[ai][1][m][1] * r; const f32x4 o1 = x1 * cs - x2 * sn, o2 = x1 * sn + x2 * cs;
                        *(u32x2*)(krb + (size_t)row * 32 + 4 * fq) = pk4(o1); *(u32x2*)(krb + (size_t)row * 32 + 16 + 4 * fq) = pk4(o2);
                        float* F = (row < MP) ? mrp + (size_t)row * 32 : mrs + (size_t)(row - MP) * 32;
                        *(f32x4*)(F + 4 * fq) = o1; *(f32x4*)(F + 16 + 4 * fq) = o2; }
                }
                if (m & 1) EPI_FENCE(); }
    }
};
struct EpiMlaQ { static constexpr bool PERM = false, AFTER_DRAIN = false;
    RowScale rs; bf16_t* QM; const float *ropc, *rops;
    __device__ __forceinline__ void operator()(const f32x4 (&acc)[2][2][4][2], const Unit& u, int wr, int wc, int, int) const { const int lane_ = pg8_tid() & 63, fr = lane_ & 15, fq = lane_ >> 4; float rsv[2][4]; rs.get8(u.pm * BM + wr * 64 + fr, fq, rsv);
#pragma unroll
        for (int ai = 0; ai < 2; ++ai)
#pragma unroll
            for (int m = 0; m < 4; ++m) { const int row = u.pm * BM + ai * HALF + wr * 64 + m * 16 + fr; const float r = rsv[ai][m] * C2_MLA;
                const int pos = row_pos(row);
#pragma unroll
                for (int bj = 0; bj < 2; ++bj) { const int g32 = u.pn * 8 + bj * 4 + wc; const int c = g32 * 32 + 4 * fq; bf16_t* o = QM + (size_t)row * 1536 + c;
                    if ((g32 % 3) == 2) { const f32x4 cs = *(const f32x4*)(ropc + pos * 16 + 4 * fq), sn = *(const f32x4*)(rops + pos * 16 + 4 * fq);
                        const f32x4 x1 = acc[ai][bj][m][0] * r, x2 = acc[ai][bj][m][1] * r;
                        *(u32x2*)(o) = pk4(x1 * cs - x2 * sn); *(u32x2*)(o + 16) = pk4(x1 * sn + x2 * cs);
                    } else { *(u32x2*)(o) = pk4(acc[ai][bj][m][0] * r); *(u32x2*)(o + 16) = pk4(acc[ai][bj][m][1] * r); } }
                EPI_FENCE(); }
    }
};
struct EpiNull { static constexpr bool PERM = true, AFTER_DRAIN = false;
    __device__ __forceinline__ void operator()(const f32x4 (&acc)[2][2][4][2], const Unit&, int, int, int, int) const {
#pragma unroll
        for (int ai = 0; ai < 2; ++ai)
#pragma unroll
            for (int bj = 0; bj < 2; ++bj)
#pragma unroll
                for (int m = 0; m < 4; ++m)
#pragma unroll
                    for (int n = 0; n < 2; ++n) asm volatile("" :: "v"(acc[ai][bj][m][n])); }
};
struct EpiMemKV { static constexpr bool PERM = false, AFTER_DRAIN = false;
    float* outk; float* outv; bf16_t* MKB; bf16_t* MVB;
    __device__ __forceinline__ void operator()(const f32x4 (&acc)[2][2][4][2], const Unit& u, int wr, int wc, int, int) const { const int lane_ = pg8_tid() & 63, fr = lane_ & 15, fq = lane_ >> 4;
        const int l = u.pn >> 3, cw0 = (u.pn & 7) * 256; const bool isv = cw0 >= 1024; const int cbase = (cw0 & 1023) + wc * 32 + 4 * fq;
#pragma unroll
        for (int ai = 0; ai < 2; ++ai)
#pragma unroll
            for (int m = 0; m < 4; ++m) { const int row = u.pm * BM + ai * HALF + wr * 64 + m * 16 + fr; const int b = row >> 8, nn = row & 255;
#pragma unroll
                for (int bj = 0; bj < 2; ++bj)
#pragma unroll
                    for (int n = 0; n < 2; ++n) { const int c = cbase + bj * HALF + n * 16; const f32x4 v = acc[ai][bj][m][n]; const size_t o = ((size_t)l * 2048 + row) * 1024 + c;
                        if (!isv) { *(f32x4*)(outk + o) = v; *(u32x2*)(MKB + o) = pk4(v); } else { *(f32x4*)(outv + o) = v; *(u32x2*)(MVB + o) = pk4(v); } }
                if (m & 1) EPI_FENCE(); }
    }
};

template <class Epi, class Sched, bool ALIGN_EPI = false, bool SP2 = false, bool ABLK = false>
__device__ __forceinline__ void gemm_phase(PG8_LAS unsigned char* lds, const Gemm g, const Sched& S, const Epi& E) {
    const int tid = pg8_tid(), wid = __builtin_amdgcn_readfirstlane(tid >> 6), lane = tid & 63, wr = wid >> 2, wc = wid & 3, fr = lane & 15, fq = lane >> 4;
    const int K = g.K, nt = K / BK;
    unsigned voffA[2], voffB[2];
#pragma unroll
    for (int i = 0; i < 2; ++i) { int R, C; stage_rc(tid * 16 + i * 8192, R, C); const int Rb = Epi::PERM ? ((R & ~31) + perm32(R & 31)) : R;
        voffA[i] = ABLK ? (unsigned)(R * BK + C) * 2u : (unsigned)(R * K + C) * 2u; voffB[i] = (unsigned)(Rb * K + C) * 2u; }
    const size_t kstep = (size_t)(BK * 2);
    const size_t hstep = (size_t)HALF * K * 2;
    const size_t tstep = 2 * hstep;
    const size_t kstepA = ABLK ? (size_t)BM * BK * 2 : kstep, hstepA = ABLK ? (size_t)HALF * BK * 2 : hstep, tstepA = ABLK ? (size_t)nt * BM * BK * 2 : tstep;
    const unsigned ldsw = (unsigned)wid * 1024u;
    const int aoff = lds_byte(wr * 64 + fr, fq * 8), boff = lds_byte(wc * 32 + fr, fq * 8);
#define PG8_SA(b, h) (((b) * 2 + (h)) * HTB)
#define PG8_SB(b, h) ((4 + (b) * 2 + (h)) * HTB)
#define PG8_STAGE(bufoff, gbase, voff) do { _Pragma("unroll") for (int _i = 0; _i < 2; ++_i) \
        __builtin_amdgcn_global_load_lds((const unsigned*)((const char*)(gbase) + (voff)[_i]), (PG8_LAS unsigned*)(lds + (bufoff) + ldsw + _i * 8192), 16, 0, 0); } while (0)
#define PG8_LDA(dst, b, h) do { _Pragma("unroll") for (int m = 0; m < 4; ++m) _Pragma("unroll") for (int k = 0; k < 2; ++k) dst[m][k] = *(const PG8_LAS bf16x8*)(lds + PG8_SA(b, h) + aoff + m * 2048 + k * 1024); } while (0)
#define PG8_LDB(dst, b, h) do { _Pragma("unroll") for (int n = 0; n < 2; ++n) _Pragma("unroll") for (int k = 0; k < 2; ++k) dst[n][k] = *(const PG8_LAS bf16x8*)(lds + PG8_SB(b, h) + boff + n * 2048 + k * 1024); } while (0)
#define PG8_MMA(ai, bj, At, Bt) do { __builtin_amdgcn_s_setprio(1); _Pragma("unroll") for (int m = 0; m < 4; ++m) _Pragma("unroll") for (int n = 0; n < 2; ++n) _Pragma("unroll") for (int k = 0; k < 2; ++k) \
        acc[ai][bj][m][n] = __builtin_amdgcn_mfma_f32_16x16x32_bf16(Bt[n][k], At[m][k], acc[ai][bj][m][n], 0, 0, 0); __builtin_amdgcn_s_setprio(0); } while (0)
#define PG8_WAIT_V(n) asm volatile("s_waitcnt vmcnt(" #n ")" ::: "memory")
#define PG8_WAIT_L(n) asm volatile("s_waitcnt lgkmcnt(" #n ")" ::: "memory")
#define PG8_BAR __builtin_amdgcn_s_barrier()
#define PG8_SCHED __builtin_amdgcn_sched_barrier(0)
    Unit cur, nxt; int ui = 0;
    if (!S.next(0, cur)) return;
    f32x4 acc[2][2][4][2];
#pragma unroll
    for (int a = 0; a < 2; ++a)
#pragma unroll
        for (int b = 0; b < 2; ++b)
#pragma unroll
            for (int m = 0; m < 4; ++m)
#pragma unroll
                for (int n = 0; n < 2; ++n) acc[a][b][m][n] = (f32x4){0.f, 0.f, 0.f, 0.f};
    bf16x8 At[4][2], B0[2][2], B1[2][2];
    const char* cA = (const char*)g.A + (size_t)cur.pm * tstepA; const char* cB = (const char*)g.Bt + (size_t)cur.pn * tstep;
    S.a_ready(cur);
    if constexpr (SP2) {
        PG8_STAGE(PG8_SB(0, 0), cB, voffB); PG8_STAGE(PG8_SB(0, 1), cB + hstep, voffB); PG8_STAGE(PG8_SA(0, 0), cA, voffA); PG8_STAGE(PG8_SA(0, 1), cA + hstepA, voffA);
        if (wr == 1) PG8_BAR;
        PG8_WAIT_V(2); PG8_BAR;
        PG8_STAGE(PG8_SB(1, 0), cB + kstep, voffB); PG8_STAGE(PG8_SA(1, 0), cA + kstepA, voffA); PG8_STAGE(PG8_SB(1, 1), cB + hstep + kstep, voffB);
        PG8_WAIT_V(6); PG8_BAR;
    } else {
        PG8_STAGE(PG8_SB(0, 0), cB, voffB); PG8_STAGE(PG8_SA(0, 0), cA, voffA); PG8_STAGE(PG8_SB(0, 1), cB + hstep, voffB); PG8_STAGE(PG8_SA(0, 1), cA + hstepA, voffA);
        if (wr == 1) PG8_BAR;
        PG8_WAIT_V(4); PG8_BAR;
        PG8_STAGE(PG8_SB(1, 0), cB + kstep, voffB); PG8_STAGE(PG8_SA(1, 0), cA + kstepA, voffA); PG8_STAGE(PG8_SB(1, 1), cB + hstep + kstep, voffB);
        PG8_WAIT_V(6); PG8_BAR;
    }
    for (;;) {
        const bool has_next = S.next(ui + 1, nxt);
        const char* nA = has_next ? (const char*)g.A + (size_t)nxt.pm * tstepA : cA; const char* nB = has_next ? (const char*)g.Bt + (size_t)nxt.pn * tstep : cB;
        for (int t = 0; t < nt; t += 2) {
            const bool last = (t == nt - 2);
            const char* a1 = cA + (size_t)(t + 1) * kstepA;
            const char* a2 = last ? nA : cA + (size_t)(t + 2) * kstepA; const char* b2 = last ? nB : cB + (size_t)(t + 2) * kstep;
            const char* a3 = a2 + kstepA; const char* b3 = b2 + kstep;
            if (last && has_next) S.a_ready(nxt);
            if constexpr (SP2) {
            PG8_LDB(B0, 0, 0); PG8_LDB(B1, 0, 1); PG8_SCHED; PG8_LDA(At, 0, 0); PG8_STAGE(PG8_SA(1, 1), a1 + hstepA, voffA);
            PG8_WAIT_V(8); PG8_WAIT_L(0); PG8_BAR; PG8_MMA(0, 0, At, B0); PG8_MMA(0, 1, At, B1); PG8_BAR; PG8_SCHED;
            PG8_LDA(At, 0, 1); PG8_STAGE(PG8_SB(0, 0), b2, voffB); PG8_STAGE(PG8_SB(0, 1), b2 + hstep, voffB); PG8_STAGE(PG8_SA(0, 0), a2, voffA);
            PG8_WAIT_V(8); PG8_WAIT_L(0); PG8_BAR; PG8_MMA(1, 0, At, B0); PG8_MMA(1, 1, At, B1); PG8_BAR; PG8_SCHED;
            PG8_LDB(B0, 1, 0); PG8_LDB(B1, 1, 1); PG8_SCHED; PG8_LDA(At, 1, 0); PG8_STAGE(PG8_SA(0, 1), a2 + hstepA, voffA);
            PG8_WAIT_V(8); PG8_WAIT_L(0); PG8_BAR; PG8_MMA(0, 0, At, B0); PG8_MMA(0, 1, At, B1); PG8_BAR; PG8_SCHED;
            PG8_LDA(At, 1, 1); PG8_STAGE(PG8_SB(1, 0), b3, voffB); PG8_STAGE(PG8_SB(1, 1), b3 + hstep, voffB); PG8_STAGE(PG8_SA(1, 0), a3, voffA);
            PG8_WAIT_V(8); PG8_WAIT_L(0); PG8_BAR; PG8_MMA(1, 0, At, B0); PG8_MMA(1, 1, At, B1); PG8_BAR; PG8_SCHED;
            } else {
            PG8_LDB(B0, 0, 0); PG8_SCHED; PG8_LDA(At, 0, 0); PG8_STAGE(PG8_SA(1, 1), a1 + hstepA, voffA);
            PG8_WAIT_L(8); PG8_BAR; PG8_WAIT_L(0); PG8_MMA(0, 0, At, B0); PG8_BAR; PG8_SCHED;
            PG8_LDB(B1, 0, 1); PG8_STAGE(PG8_SB(0, 0), b2, voffB);
            PG8_BAR; PG8_WAIT_L(0); PG8_MMA(0, 1, At, B1); PG8_BAR;
            PG8_LDA(At, 0, 1); PG8_STAGE(PG8_SA(0, 0), a2, voffA);
            PG8_BAR; PG8_WAIT_L(0); PG8_MMA(1, 0, At, B0); PG8_BAR; PG8_SCHED;
            PG8_STAGE(PG8_SB(0, 1), b2 + hstep, voffB);
            PG8_WAIT_V(6); PG8_BAR; PG8_MMA(1, 1, At, B1); PG8_BAR;
            PG8_LDB(B0, 1, 0); PG8_SCHED; PG8_LDA(At, 1, 0); PG8_STAGE(PG8_SA(0, 1), a2 + hstepA, voffA);
            PG8_WAIT_L(8); PG8_BAR; PG8_WAIT_L(0); PG8_MMA(0, 0, At, B0); PG8_BAR; PG8_SCHED;
            PG8_LDB(B1, 1, 1); PG8_STAGE(PG8_SB(1, 0), b3, voffB);
            PG8_BAR; PG8_WAIT_L(0); PG8_MMA(0, 1, At, B1); PG8_BAR;
            PG8_LDA(At, 1, 1); PG8_STAGE(PG8_SA(1, 0), a3, voffA);
            PG8_BAR; PG8_WAIT_L(0); PG8_MMA(1, 0, At, B0); PG8_BAR; PG8_SCHED;
            PG8_STAGE(PG8_SB(1, 1), b3 + hstep, voffB);
            PG8_WAIT_V(6); PG8_BAR; PG8_MMA(1, 1, At, B1); PG8_BAR;
            }
        }
        if constexpr (ALIGN_EPI) { if (wr == 0) PG8_BAR; }
        if constexpr (!Epi::AFTER_DRAIN) { E(acc, cur, wr, wc, fr, fq); S.done(cur); }
        if (!has_next) break;
#pragma unroll
        for (int a = 0; a < 2; ++a)
#pragma unroll
            for (int b = 0; b < 2; ++b)
#pragma unroll
                for (int m = 0; m < 4; ++m)
#pragma unroll
                    for (int n = 0; n < 2; ++n) acc[a][b][m][n] = (f32x4){0.f, 0.f, 0.f, 0.f};
        cur = nxt; cA = nA; cB = nB; ++ui;
        if constexpr (ALIGN_EPI) { if (wr == 1) PG8_BAR; }
    }
    PG8_WAIT_V(0);
    if constexpr (!ALIGN_EPI) { if (wr == 0) PG8_BAR; }
    PG8_BAR;
    if constexpr (Epi::AFTER_DRAIN) { E.fused(acc, cur, wr, wc, fr, fq, lds, wid, lane); S.done(cur); }
#undef PG8_SA
#undef PG8_SB
#undef PG8_STAGE
#undef PG8_LDA
#undef PG8_LDB
#undef PG8_MMA
#undef PG8_WAIT_V
#undef PG8_WAIT_L
#undef PG8_BAR
#undef PG8_SCHED
}
}

#define GAS __attribute__((address_space(1)))
#define LAS __attribute__((address_space(3)))
typedef unsigned short bf16;
typedef float f32x4 __attribute__((ext_vector_type(4)));
typedef float f32x16 __attribute__((ext_vector_type(16)));
typedef short bf16x8 __attribute__((ext_vector_type(8)));
typedef short s16x4 __attribute__((ext_vector_type(4)));
typedef unsigned u32x4 __attribute__((ext_vector_type(4)));
typedef unsigned u32x2 __attribute__((ext_vector_type(2)));
typedef GAS unsigned gu32;
#define RLX_AGENT __ATOMIC_RELAXED, __HIP_MEMORY_SCOPE_AGENT
#define LDS_WAIT() asm volatile("s_waitcnt lgkmcnt(0)" ::: "memory")
#define VM_WAIT() asm volatile("s_waitcnt vmcnt(0)" ::: "memory")
__device__ __forceinline__ unsigned pk2(float lo, float hi) { return pg8::pk_bf16(lo, hi); }
__device__ __forceinline__ float bf2f(unsigned short b) { return __builtin_bit_cast(float, (unsigned)b << 16); }
__device__ __forceinline__ float ex2(float x) { return __builtin_amdgcn_exp2f(x); }
__device__ __forceinline__ float wave_sum(float v) {
#pragma unroll
    for (int o = 1; o < 64; o <<= 1) v += __shfl_xor(v, o);
    return v;
}

namespace fa {
constexpr int KSLOT = 12288, VSLOT = 8192;
constexpr int L_K = 0, L_V = 2 * KSLOT, L_WS = L_V + 2 * VSLOT, L_OST = L_WS + 8 * 64 * 4, L_BYTES = L_OST + 8 * 32 * 64 * 4;
constexpr int L_WS2 = L_V + 3 * VSLOT, L_CB2 = L_WS2 + 8 * 128 * 4, L_OST2 = L_CB2 + 512, L_QR2 = L_OST2 + 8 * 4096, L_BYTES2 = L_QR2 + 8 * 4096;
__device__ __forceinline__ int crow(int r, int hi) { return (r & 3) + 8 * (r >> 2) + 4 * hi; }
__device__ __forceinline__ void glds16(const void* gsrc, unsigned lds_dst) { unsigned keep;
    asm volatile("s_mov_b32 %0, m0\n\ts_mov_b32 m0, %2\n\ts_nop 0\n\tglobal_load_lds_dwordx4 %1, off\n\ts_mov_b32 m0, %0" : "=&s"(keep) : "v"(gsrc), "s"(lds_dst) : "memory"); }
#define FA_WAIT_BAR() asm volatile("s_waitcnt vmcnt(0) lgkmcnt(0)\n\ts_barrier" ::: "memory")
#define FA_SBAR() __builtin_amdgcn_sched_barrier(0)
template <int ND0> __device__ __forceinline__ void qkt(f32x16& p0, f32x16& p1, const LAS char* kp, const bf16x8* qr) {
    p0 = f32x16{}; p1 = f32x16{};
#pragma unroll
    for (int d0 = 0; d0 < ND0; ++d0) {
        const bf16x8 b0 = *(const LAS bf16x8*)(kp + d0 * 2048);
        const bf16x8 b1 = *(const LAS bf16x8*)(kp + d0 * 2048 + 512);
        p0 = __builtin_amdgcn_mfma_f32_32x32x16_bf16(b0, qr[d0], p0, 0, 0, 0); p1 = __builtin_amdgcn_mfma_f32_32x32x16_bf16(b1, qr[d0], p1, 0, 0, 0); }
}
__device__ __forceinline__ float max3f(float a, float b, float c) { float r; asm("v_max3_f32 %0, %1, %2, %3" : "=v"(r) : "v"(a), "v"(b), "v"(c)); return r; }
__device__ __forceinline__ float max2f(float a, float b) { float r; asm("v_max_f32_e32 %0, %1, %2" : "=v"(r) : "v"(a), "v"(b)); return r; }
__device__ __forceinline__ float rowmax_a(const f32x16& p0, const f32x16& p1) {
    float a = max3f(p0[0], p0[1], p1[0]), b = max3f(p0[2], p0[3], p1[1]); a = max3f(a, p1[2], p1[3]);
#pragma unroll
    for (int r = 4; r < 16; r += 4) { a = max3f(a, p0[r], p0[r + 1]); b = max3f(b, p0[r + 2], p0[r + 3]); a = max3f(a, p1[r], p1[r + 1]); b = max3f(b, p1[r + 2], p1[r + 3]); }
    const float m = max2f(a, b);
    auto rr = __builtin_amdgcn_permlane32_swap(__float_as_uint(m), __float_as_uint(m), false, false);
    return max2f(__uint_as_float(rr[0]), __uint_as_float(rr[1]));
}
__device__ __forceinline__ float rowmax(const f32x16& p0, const f32x16& p1) {
    float a = __builtin_fmaxf(p0[0], p1[0]);
#pragma unroll
    for (int r = 1; r < 16; ++r) a = __builtin_fmaxf(a, __builtin_fmaxf(p0[r], p1[r]));
    auto rr = __builtin_amdgcn_permlane32_swap(__float_as_uint(a), __float_as_uint(a), false, false);
    return __builtin_fmaxf(__uint_as_float(rr[0]), __uint_as_float(rr[1]));
}
__device__ __forceinline__ void pv(f32x16* o, int vb, bf16x8 pa0, bf16x8 pa1, bf16x8 pa2, bf16x8 pa3) {
#pragma unroll
    for (int d0 = 0; d0 < 2; ++d0) { s16x4 lo[4], hi[4];
#pragma unroll
        for (int ks = 0; ks < 4; ++ks) {
            asm volatile("ds_read_b64_tr_b16 %0,%1 offset:%c2" : "=&v"(lo[ks]) : "v"(vb), "i"(d0 * 4096 + ks * 1024) : "memory");
            asm volatile("ds_read_b64_tr_b16 %0,%1 offset:%c2" : "=&v"(hi[ks]) : "v"(vb), "i"(d0 * 4096 + ks * 1024 + 512) : "memory"); }
        asm volatile("s_waitcnt lgkmcnt(0)" ::: "memory"); FA_SBAR();
#define FA_PK(k) (bf16x8){lo[k][0], lo[k][1], lo[k][2], lo[k][3], hi[k][0], hi[k][1], hi[k][2], hi[k][3]}
        o[d0] = __builtin_amdgcn_mfma_f32_32x32x16_bf16(pa0, FA_PK(0), o[d0], 0, 0, 0);
        o[d0] = __builtin_amdgcn_mfma_f32_32x32x16_bf16(pa1, FA_PK(1), o[d0], 0, 0, 0);
        o[d0] = __builtin_amdgcn_mfma_f32_32x32x16_bf16(pa2, FA_PK(2), o[d0], 0, 0, 0);
        o[d0] = __builtin_amdgcn_mfma_f32_32x32x16_bf16(pa3, FA_PK(3), o[d0], 0, 0, 0);
#undef FA_PK
    }
}
struct Args { const bf16* Q; int qpitch, qcol; const bf16* K; int kpitch, kcol; const bf16* K2; const bf16* V; int vpitch, vcol; bf16* O; int ocol; const bf16* G; const float* CB; };
template <int MODE> __device__ __forceinline__ void unit(const Args& A, long rowbase, int qb, LAS char* lds, unsigned lds0) {
    constexpr int ND0 = MODE ? 6 : 4;
    const int tid = pg8::pg8_tid(), lane = tid & 63, r32 = lane & 31, hi = lane >> 5; const int wid = __builtin_amdgcn_readfirstlane(tid >> 6);
    const int q0 = qb * 256, NT = q0 / 64 + 4, nt_w = MODE ? (q0 / 64 + (wid >> 1) + 1) : NT;
    const bf16* Qw = A.Q + (rowbase + q0 + wid * 32 + r32) * A.qpitch + A.qcol + hi * 8;
    bf16x8 qr[ND0];
#pragma unroll
    for (int d0 = 0; d0 < ND0; ++d0) qr[d0] = *(const bf16x8*)(Qw + d0 * 16);
    const bf16* ksrc = A.K + (rowbase + lane) * A.kpitch + A.kcol + wid * 8;
    const bf16* ksrc2 = MODE ? A.K2 + (rowbase + lane) * 32 + (wid & 3) * 8 : nullptr;
    const bf16* vsrc = A.V + (rowbase + 16 * (wid & 3) + (lane >> 2)) * A.vpitch + A.vcol + (wid >> 2) * 32 + (lane & 3) * 8;
#define FA_DMA(t, slot) do { \
        glds16(ksrc + (long)(t) * 64 * A.kpitch, (unsigned)__builtin_amdgcn_readfirstlane(lds0 + L_K + (slot) * KSLOT + wid * 1024)); \
        if (MODE && wid < 4) glds16(ksrc2 + (long)(t) * 64 * 32, (unsigned)__builtin_amdgcn_readfirstlane(lds0 + L_K + (slot) * KSLOT + (8 + wid) * 1024)); \
        glds16(vsrc + (long)(t) * 64 * A.vpitch, (unsigned)__builtin_amdgcn_readfirstlane(lds0 + L_V + (slot) * VSLOT + wid * 1024)); } while (0)
    LAS float* wsf = (LAS float*)(lds + L_WS) + wid * 64;
    const int vb0 = (int)(lds0 + L_V) + ((lane >> 4) & 1) * 32 + (lane & 3) * 8 + (4 * hi + ((lane & 15) >> 2)) * 64;
    float m = -1e30f, l = 0.f; f32x16 o[2]; o[0] = f32x16{}; o[1] = f32x16{};
    FA_DMA(0, 0);
    for (int t = 0; t < NT; ++t) {
        FA_WAIT_BAR();
        if (t + 1 < NT) FA_DMA(t + 1, (t + 1) & 1);
        if (t < nt_w) {
            const int slot = t & 1;
            f32x16 p0, p1; qkt<ND0>(p0, p1, lds + L_K + slot * KSLOT + hi * 1024 + r32 * 16, qr);
            if (MODE == 0) {
                const float* cb = A.CB + t * 64 + 4 * hi;
#pragma unroll
                for (int g4 = 0; g4 < 4; ++g4) { const f32x4 b0 = *(const f32x4*)(cb + 8 * g4), b1 = *(const f32x4*)(cb + 32 + 8 * g4);
#pragma unroll
                    for (int i = 0; i < 4; ++i) { p0[4 * g4 + i] += b0[i]; p1[4 * g4 + i] += b1[i]; } }
                const int jb = t - (NT - 4);
                if (jb >= 0) { const int qrel = wid * 32 + r32, kb = 64 * jb + 4 * hi;
#pragma unroll
                    for (int r = 0; r < 16; ++r) { const int kv = kb + (r & 3) + 8 * (r >> 2); if (kv > qrel) p0[r] = -INFINITY; if (kv + 32 > qrel) p1[r] = -INFINITY; } }
            }
            const float rm = rowmax(p0, p1);
            const float mn = __builtin_fmaxf(m, rm), alpha = ex2(m - mn); m = mn;
            float sacc = 0.f;
#pragma unroll
            for (int r = 0; r < 16; ++r) { p0[r] = ex2(p0[r] - mn); p1[r] = ex2(p1[r] - mn); sacc += p0[r] + p1[r]; }
            l = l * alpha + sacc;
            if (hi == 0) wsf[r32] = alpha;
#pragma unroll
            for (int r = 0; r < 16; ++r) { const float a = wsf[crow(r, hi)]; o[0][r] *= a; o[1][r] *= a; }
            u32x4 pw0, pw1, pw2, pw3;
            pw0 = (u32x4){pk2(p0[0], p0[1]), pk2(p0[2], p0[3]), pk2(p0[4], p0[5]), pk2(p0[6], p0[7])};
            pw1 = (u32x4){pk2(p0[8], p0[9]), pk2(p0[10], p0[11]), pk2(p0[12], p0[13]), pk2(p0[14], p0[15])};
            pw2 = (u32x4){pk2(p1[0], p1[1]), pk2(p1[2], p1[3]), pk2(p1[4], p1[5]), pk2(p1[6], p1[7])};
            pw3 = (u32x4){pk2(p1[8], p1[9]), pk2(p1[10], p1[11]), pk2(p1[12], p1[13]), pk2(p1[14], p1[15])};
            FA_SBAR();
            pv(o, vb0 + slot * VSLOT, __builtin_bit_cast(bf16x8, pw0), __builtin_bit_cast(bf16x8, pw1), __builtin_bit_cast(bf16x8, pw2), __builtin_bit_cast(bf16x8, pw3));
        }
    }
    { auto rr = __builtin_amdgcn_permlane32_swap(__float_as_uint(l), __float_as_uint(l), false, false); l = __uint_as_float(rr[0]) + __uint_as_float(rr[1]); }
    if (hi == 0) wsf[32 + r32] = l;
    LAS float* stg = (LAS float*)(lds + L_OST) + wid * 2048;
#pragma unroll
    for (int r = 0; r < 16; ++r) { const int orow = crow(r, hi); const float rl = __builtin_amdgcn_rcpf(wsf[32 + orow]);
        stg[orow * 64 + r32] = o[0][r] * rl; stg[orow * 64 + 32 + r32] = o[1][r] * rl; }
    LDS_WAIT();
#pragma unroll
    for (int i = 0; i < 4; ++i) { const int row = i * 8 + (lane >> 3), ch = lane & 7; const long grow = rowbase + q0 + wid * 32 + row;
        f32x4 a = *(const LAS f32x4*)(stg + row * 64 + ch * 8), b = *(const LAS f32x4*)(stg + row * 64 + ch * 8 + 4);
        if (MODE == 0) { const u32x4 g = *(const u32x4*)(A.G + grow * 1024 + A.ocol + ch * 8);
            a[0] *= __uint_as_float(g.x << 16); a[1] *= __uint_as_float(g.x & 0xffff0000u); a[2] *= __uint_as_float(g.y << 16); a[3] *= __uint_as_float(g.y & 0xffff0000u);
            b[0] *= __uint_as_float(g.z << 16); b[1] *= __uint_as_float(g.z & 0xffff0000u); b[2] *= __uint_as_float(g.w << 16); b[3] *= __uint_as_float(g.w & 0xffff0000u); }
        const u32x4 w = (u32x4){pk2(a[0], a[1]), pk2(a[2], a[3]), pk2(b[0], b[1]), pk2(b[2], b[3])};
        *(u32x4*)(A.O + grow * 1024 + A.ocol + ch * 8) = w; }
    asm volatile("s_waitcnt lgkmcnt(0)\n\ts_barrier" ::: "memory");
#undef FA_DMA
}

#ifndef FA_STAG_FOX
#define FA_STAG_FOX 1
#endif
#ifndef FA_STAG_MLA
#define FA_STAG_MLA 1
#endif
#ifndef FA_PROBE_VALU
#define FA_PROBE_VALU 0
#endif
__device__ __forceinline__ void glds4(const void* gsrc, unsigned lds_dst) { unsigned keep;
    asm volatile("s_mov_b32 %0, m0\n\ts_mov_b32 m0, %2\n\ts_nop 0\n\tglobal_load_lds_dword %1, off\n\ts_mov_b32 m0, %0" : "=&s"(keep) : "v"(gsrc), "s"(lds_dst) : "memory"); }
__device__ __forceinline__ s16x4 vtr(const LAS char* p) { typedef short v4i16_t __attribute__((ext_vector_type(4))); return __builtin_bit_cast(s16x4, __builtin_amdgcn_ds_read_tr16_b64_v4i16((LAS v4i16_t*)p)); }
template <int MODE, bool DIAG> __device__ __forceinline__ void tile_qs(const LAS char* kp, const bf16x8 (&qr)[2][4], const LAS char* qrl, const LAS float* cbl, int r32, int hi,
                                                                     float (&m)[2], float (&l)[2], f32x16 (&o)[2][2], LAS float* wsf, u32x4 (&pw)[2][4]) {
    constexpr int ND0 = MODE ? 6 : 4;
    f32x16 p[2][2];
    if (MODE == 0) {
#pragma unroll
        for (int g4 = 0; g4 < 4; ++g4) { const f32x4 b0 = *(const LAS f32x4*)(cbl + 4 * hi + 8 * g4), b1 = *(const LAS f32x4*)(cbl + 32 + 4 * hi + 8 * g4);
#pragma unroll
            for (int i = 0; i < 4; ++i) { p[0][0][4 * g4 + i] = b0[i]; p[0][1][4 * g4 + i] = b1[i]; } }
        p[1][0] = p[0][0]; p[1][1] = p[0][1];
    } else {
#pragma unroll
        for (int b2 = 0; b2 < 2; ++b2) { p[b2][0] = f32x16{}; p[b2][1] = f32x16{}; }
    }
    bf16x8 qx[2][2];
    if (MODE) {
#pragma unroll
        for (int b2 = 0; b2 < 2; ++b2) { qx[b2][0] = *(const LAS bf16x8*)(qrl + (b2 * 2) * 1024); qx[b2][1] = *(const LAS bf16x8*)(qrl + (b2 * 2 + 1) * 1024); } }
#pragma unroll
    for (int d0 = 0; d0 < ND0; ++d0) { const bf16x8 k0 = *(const LAS bf16x8*)(kp + d0 * 2048), k1 = *(const LAS bf16x8*)(kp + d0 * 2048 + 512);
#pragma unroll
        for (int b2 = 0; b2 < 2; ++b2) { const bf16x8 qv = (d0 < 4) ? qr[b2][d0 & 3] : qx[b2][d0 & 1];
            p[b2][0] = __builtin_amdgcn_mfma_f32_32x32x16_bf16(k0, qv, p[b2][0], 0, 0, 0); p[b2][1] = __builtin_amdgcn_mfma_f32_32x32x16_bf16(k1, qv, p[b2][1], 0, 0, 0); } }
    if (MODE == 0 && DIAG) {
#pragma unroll
        for (int b2 = 0; b2 < 2; ++b2) { const int qrel = 32 * b2 + r32;
#pragma unroll
            for (int r = 0; r < 16; ++r) { const int kv = 4 * hi + (r & 3) + 8 * (r >> 2); if (kv > qrel) p[b2][0][r] = -INFINITY; if (kv + 32 > qrel) p[b2][1][r] = -INFINITY; } } }
    asm volatile("s_nop 15\n\ts_nop 7" : "+v"(p[0][0]), "+v"(p[0][1]), "+v"(p[1][0]), "+v"(p[1][1]));
#if FA_PROBE_VALU
    { float dd[8];
#pragma unroll
      for (int i = 0; i < 8; ++i) dd[i] = m[0] + (float)i;
#pragma unroll
      for (int k = 0; k < FA_PROBE_VALU; ++k)
#pragma unroll
        for (int i = 0; i < 8; ++i) dd[i] = ex2(dd[i]);
#pragma unroll
      for (int i = 0; i < 8; ++i) asm volatile("" :: "v"(dd[i])); }
#endif
#pragma unroll
    for (int b2 = 0; b2 < 2; ++b2) {
        const float rm = rowmax_a(p[b2][0], p[b2][1]);
        const float mn = max2f(m[b2], rm), alpha = ex2(m[b2] - mn); m[b2] = mn;
        typedef float f32x2s __attribute__((ext_vector_type(2))); f32x2s sa2 = {0.f, 0.f};
#pragma unroll
        for (int r = 0; r < 16; ++r) { p[b2][0][r] = ex2(p[b2][0][r] - mn); p[b2][1][r] = ex2(p[b2][1][r] - mn); sa2 += (f32x2s){p[b2][0][r], p[b2][1][r]}; }
        l[b2] = l[b2] * alpha + (sa2[0] + sa2[1]);
#pragma unroll
        for (int r = 0; r < 16; ++r) { o[b2][0][r] *= alpha; o[b2][1][r] *= alpha; }
        pw[b2][0] = (u32x4){pk2(p[b2][0][0], p[b2][0][1]), pk2(p[b2][0][2], p[b2][0][3]), pk2(p[b2][0][4], p[b2][0][5]), pk2(p[b2][0][6], p[b2][0][7])};
        pw[b2][1] = (u32x4){pk2(p[b2][0][8], p[b2][0][9]), pk2(p[b2][0][10], p[b2][0][11]), pk2(p[b2][0][12], p[b2][0][13]), pk2(p[b2][0][14], p[b2][0][15])};
        pw[b2][2] = (u32x4){pk2(p[b2][1][0], p[b2][1][1]), pk2(p[b2][1][2], p[b2][1][3]), pk2(p[b2][1][4], p[b2][1][5]), pk2(p[b2][1][6], p[b2][1][7])};
        pw[b2][3] = (u32x4){pk2(p[b2][1][8], p[b2][1][9]), pk2(p[b2][1][10], p[b2][1][11]), pk2(p[b2][1][12], p[b2][1][13]), pk2(p[b2][1][14], p[b2][1][15])};
    }
}
__device__ __forceinline__ void tile_pv(const LAS char* vp, f32x16 (&o)[2][2], const u32x4 (&pw)[2][4]) {
#pragma unroll
    for (int d0 = 0; d0 < 2; ++d0)
#pragma unroll
        for (int ks = 0; ks < 4; ++ks) { const s16x4 lo = vtr(vp + d0 * 4096 + ks * 1024), hi4 = vtr(vp + d0 * 4096 + ks * 1024 + 512);
            const bf16x8 vf = (bf16x8){lo[0], lo[1], lo[2], lo[3], hi4[0], hi4[1], hi4[2], hi4[3]};
#pragma unroll
            for (int b2 = 0; b2 < 2; ++b2) o[b2][d0] = __builtin_amdgcn_mfma_f32_32x32x16_bf16(vf, __builtin_bit_cast(bf16x8, pw[b2][ks]), o[b2][d0], 0, 0, 0); }
}
template <int MODE> __device__ __forceinline__ void unit2(const Args& A, long rowbase, int qb, LAS char* lds, unsigned lds0) {
    constexpr int ND0 = MODE ? 6 : 4;
    const int tid = pg8::pg8_tid(), lane = tid & 63, r32 = lane & 31, hi = lane >> 5; const int wid = __builtin_amdgcn_readfirstlane(tid >> 6);
    const int q0 = qb * 512, NT = q0 / 64 + 8, nt_w = q0 / 64 + wid + 1;
    bf16x8 qr[2][4];
    LAS char* qrl = lds + L_QR2 + wid * 4096 + lane * 16;
#pragma unroll
    for (int b2 = 0; b2 < 2; ++b2) { const bf16* Qw = A.Q + (rowbase + q0 + wid * 64 + b2 * 32 + r32) * A.qpitch + A.qcol + hi * 8;
#pragma unroll
        for (int d0 = 0; d0 < 4; ++d0) qr[b2][d0] = *(const bf16x8*)(Qw + d0 * 16);
        if (MODE) { *(LAS bf16x8*)(qrl + (b2 * 2) * 1024) = *(const bf16x8*)(Qw + 64); *(LAS bf16x8*)(qrl + (b2 * 2 + 1) * 1024) = *(const bf16x8*)(Qw + 80); } }
    const int koff = lane * A.kpitch + A.kcol + wid * 8, k2off = lane * 32 + (wid & 3) * 8, voff = (16 * (wid & 3) + (lane >> 2)) * A.vpitch + A.vcol + (wid >> 2) * 32 + (lane & 3) * 8;
    const bf16* Kb = A.K + rowbase * A.kpitch; const bf16* K2b = MODE ? A.K2 + rowbase * 32 : nullptr; const bf16* Vb = A.V + rowbase * A.vpitch;
#define FA_DMA(t, slot) do { \
        int ko_ = koff, k2o_ = k2off, vo_ = voff; asm volatile("" : "+v"(ko_), "+v"(k2o_), "+v"(vo_)); \
        glds16(Kb + (long)(t) * 64 * A.kpitch + ko_, (unsigned)__builtin_amdgcn_readfirstlane(lds0 + L_K + (slot) * KSLOT + wid * 1024)); \
        if (MODE && wid < 4) glds16(K2b + (long)(t) * 64 * 32 + k2o_, (unsigned)__builtin_amdgcn_readfirstlane(lds0 + L_K + (slot) * KSLOT + (8 + wid) * 1024)); \
        glds16(Vb + (long)(t) * 64 * A.vpitch + vo_, (unsigned)__builtin_amdgcn_readfirstlane(lds0 + L_V + ((t) % 3) * VSLOT + wid * 1024)); \
        if (!MODE && wid == 4) glds4(A.CB + (t) * 64 + lane, (unsigned)__builtin_amdgcn_readfirstlane(lds0 + L_CB2 + (slot) * 256)); } while (0)
    LAS float* wsf = (LAS float*)(lds + L_WS2) + wid * 128;
    const LAS char* kp0 = lds + L_K + hi * 1024 + r32 * 16;
    const LAS char* vp0 = lds + L_V + ((lane >> 4) & 1) * 32 + (lane & 3) * 8 + (4 * hi + ((lane & 15) >> 2)) * 64;
    float m[2] = {-1e30f, -1e30f}, l[2] = {0.f, 0.f}; f32x16 o[2][2];
#pragma unroll
    for (int b2 = 0; b2 < 2; ++b2) { o[b2][0] = f32x16{}; o[b2][1] = f32x16{}; }
    FA_DMA(0, 0);
    u32x4 pw[2][4];
#define FA_STEP_HEAD(t) FA_WAIT_BAR(); if ((t) + 1 < NT) FA_DMA((t) + 1, ((t) + 1) & 1); const int slot = (t) & 1; const LAS float* cbl = (const LAS float*)(lds + L_CB2 + slot * 256)
    if (wid < 4 || !(MODE ? FA_STAG_MLA : FA_STAG_FOX)) {
        int t = 0;
        for (; t < nt_w - 1; ++t) { FA_STEP_HEAD(t); tile_qs<MODE, false>(kp0 + slot * KSLOT, qr, qrl, cbl, r32, hi, m, l, o, wsf, pw); tile_pv(vp0 + (t % 3) * VSLOT, o, pw); }
        { FA_STEP_HEAD(t); tile_qs<MODE, true>(kp0 + slot * KSLOT, qr, qrl, cbl, r32, hi, m, l, o, wsf, pw); tile_pv(vp0 + (t % 3) * VSLOT, o, pw); ++t; }
        for (; t < NT; ++t) { FA_STEP_HEAD(t); (void)slot; (void)cbl; }
    } else {
        int t = 0;
        if (nt_w > 1) { FA_STEP_HEAD(0); tile_qs<MODE, false>(kp0 + slot * KSLOT, qr, qrl, cbl, r32, hi, m, l, o, wsf, pw); t = 1;
            for (; t < nt_w - 1; ++t) { FA_STEP_HEAD(t); tile_pv(vp0 + ((t - 1) % 3) * VSLOT, o, pw); FA_SBAR(); tile_qs<MODE, false>(kp0 + slot * KSLOT, qr, qrl, cbl, r32, hi, m, l, o, wsf, pw); }
            { FA_STEP_HEAD(t); tile_pv(vp0 + ((t - 1) % 3) * VSLOT, o, pw); FA_SBAR(); tile_qs<MODE, true>(kp0 + slot * KSLOT, qr, qrl, cbl, r32, hi, m, l, o, wsf, pw); ++t; }
        } else { FA_STEP_HEAD(0); tile_qs<MODE, true>(kp0 + slot * KSLOT, qr, qrl, cbl, r32, hi, m, l, o, wsf, pw); t = 1; }
        if (t < NT) { FA_STEP_HEAD(t); (void)slot; (void)cbl; tile_pv(vp0 + ((t - 1) % 3) * VSLOT, o, pw); ++t;
            for (; t < NT; ++t) { FA_STEP_HEAD(t); (void)slot; (void)cbl; } }
        else tile_pv(vp0 + ((NT - 1) % 3) * VSLOT, o, pw);
    }
#undef FA_STEP_HEAD
#pragma unroll
    for (int b2 = 0; b2 < 2; ++b2) {
        float lb = l[b2];
        { auto rr = __builtin_amdgcn_permlane32_swap(__float_as_uint(lb), __float_as_uint(lb), false, false); lb = __uint_as_float(rr[0]) + __uint_as_float(rr[1]); }
        const float rl = __builtin_amdgcn_rcpf(lb); const long grow = rowbase + q0 + wid * 64 + b2 * 32 + r32;
#pragma unroll
        for (int d0 = 0; d0 < 2; ++d0)
#pragma unroll
            for (int g4 = 0; g4 < 4; ++g4) { const int dc = A.ocol + 32 * d0 + 8 * g4 + 4 * hi;
                f32x4 v = (f32x4){o[b2][d0][4 * g4], o[b2][d0][4 * g4 + 1], o[b2][d0][4 * g4 + 2], o[b2][d0][4 * g4 + 3]} * rl;
                if (MODE == 0) { const u32x2 g = *(const u32x2*)(A.G + grow * 1024 + dc);
                    v[0] *= __uint_as_float(g.x << 16); v[1] *= __uint_as_float(g.x & 0xffff0000u); v[2] *= __uint_as_float(g.y << 16); v[3] *= __uint_as_float(g.y & 0xffff0000u); }
                *(u32x2*)(A.O + grow * 1024 + dc) = (u32x2){pk2(v[0], v[1]), pk2(v[2], v[3])}; }
    }
    asm volatile("s_waitcnt lgkmcnt(0)\n\ts_barrier" ::: "memory");
#undef FA_DMA
}
}

namespace a16 {
__device__ __forceinline__ f32x4 mfma16(bf16x8 a, bf16x8 b, f32x4 c) { return __builtin_amdgcn_mfma_f32_16x16x32_bf16(a, b, c, 0, 0, 0); }
template <int NQK, int NDB, class KL, class VL, class SF>
__device__ __forceinline__ void steps(int s0, int s1, const bf16x8 (&qf)[NQK], KL kload, VL vload, SF sfix, float& m, float& l, f32x4 (&o)[NDB], int lane) {
    const int g = lane >> 4;
    for (int s = s0; s < s1; ++s) {
        f32x4 sA = {0.f, 0.f, 0.f, 0.f}, sB = {0.f, 0.f, 0.f, 0.f};
#pragma unroll
        for (int d0 = 0; d0 < NQK; ++d0) { sA = mfma16(kload(s, 0, d0), qf[d0], sA); sB = mfma16(kload(s, 1, d0), qf[d0], sB); }
        sfix(s, sA, sB);
        float mx = __builtin_fmaxf(__builtin_fmaxf(__builtin_fmaxf(sA[0], sA[1]), __builtin_fmaxf(sA[2], sA[3])), __builtin_fmaxf(__builtin_fmaxf(sB[0], sB[1]), __builtin_fmaxf(sB[2], sB[3])));
        mx = __builtin_fmaxf(mx, __shfl_xor(mx, 16)); mx = __builtin_fmaxf(mx, __shfl_xor(mx, 32));
        const float mn = __builtin_fmaxf(m, mx), alpha = ex2(m - mn); m = mn;
        f32x4 pA, pB;
#pragma unroll
        for (int r = 0; r < 4; ++r) { pA[r] = ex2(sA[r] - mn); pB[r] = ex2(sB[r] - mn); }
        float ps = ((pA[0] + pA[1]) + (pA[2] + pA[3])) + ((pB[0] + pB[1]) + (pB[2] + pB[3]));
        ps += __shfl_xor(ps, 16); ps += __shfl_xor(ps, 32);
        l = l * alpha + ps;
        const float a0 = __shfl(alpha, 4 * g), a1 = __shfl(alpha, 4 * g + 1), a2 = __shfl(alpha, 4 * g + 2), a3 = __shfl(alpha, 4 * g + 3);
#pragma unroll
        for (int db = 0; db < NDB; ++db) { o[db][0] *= a0; o[db][1] *= a1; o[db][2] *= a2; o[db][3] *= a3; }
        const u32x4 pw = (u32x4){pk2(pA[0], pA[1]), pk2(pA[2], pA[3]), pk2(pB[0], pB[1]), pk2(pB[2], pB[3])};
        const bf16x8 pf = __builtin_bit_cast(bf16x8, pw);
#pragma unroll
        for (int db = 0; db < NDB; ++db) o[db] = mfma16(pf, vload(s, db), o[db]);
    }
}
__device__ __forceinline__ bf16x8 cvt8(f32x4 a, f32x4 b) { const u32x4 w = (u32x4){pk2(a[0], a[1]), pk2(a[2], a[3]), pk2(b[0], b[1]), pk2(b[2], b[3])}; return __builtin_bit_cast(bf16x8, w); }
__device__ __forceinline__ bf16x8 join8(u32x2 a, u32x2 b) { const u32x4 w = (u32x4){a.x, a.y, b.x, b.y}; return __builtin_bit_cast(bf16x8, w); }
}


namespace xa {
constexpr int TSZ = 16384, L_T = 0, L_WS = 2 * TSZ, L_OST = L_WS + 8 * 64 * 4, L_BYTES = L_OST + 8 * 2048;
#define XA_WAIT_BAR() asm volatile("s_waitcnt vmcnt(0) lgkmcnt(0)\n\ts_barrier" ::: "memory")
template <typename T> __device__ __forceinline__ const T* src_of(const T* Kh, const T* Vh, int pitch, int i, int ci) {
    return (i < 8) ? Kh + (size_t)(32 * i + (ci & 31)) * pitch + (ci >> 5) * 8 : Vh + (size_t)(ci >> 2) * pitch + 32 * (i - 8) + (ci & 3) * 8; }
template <bool F32SRC> __device__ __forceinline__ void unit(const void* Kh_, const void* Vh_, int pitch, const bf16* Q, bf16* O, size_t row0, int hcol, int nvalid_w0, bool only_w0, LAS char* lds, unsigned lds0) {
    const int tid = pg8::pg8_tid(), lane = tid & 63, r32 = lane & 31, hi = lane >> 5; const int wid = __builtin_amdgcn_readfirstlane(tid >> 6);
    const bool active = !only_w0 || wid == 0; const int nvalid = only_w0 ? (wid == 0 ? nvalid_w0 : 0) : 32;
    bf16x8 qr[16];
    { const bf16* Qw = Q + (row0 + wid * 32 + r32) * 1024 + hcol + hi * 8;
#pragma unroll
      for (int d0 = 0; d0 < 16; ++d0) qr[d0] = active ? *(const bf16x8*)(Qw + d0 * 16) : (bf16x8){0, 0, 0, 0, 0, 0, 0, 0}; }
    LAS float* wsf = (LAS float*)(lds + L_WS) + wid * 64;
    f32x4 st[2][2];
#define XA_ISSUE(i) do { if (F32SRC) { _Pragma("unroll") for (int c2 = 0; c2 < 2; ++c2) { const float* s = src_of<float>((const float*)Kh_, (const float*)Vh_, pitch, (i), tid + 512 * c2); st[c2][0] = *(const f32x4*)s; st[c2][1] = *(const f32x4*)(s + 4); } } \
        else { _Pragma("unroll") for (int c2 = 0; c2 < 2; ++c2) fa::glds16(src_of<bf16>((const bf16*)Kh_, (const bf16*)Vh_, pitch, (i), (2 * wid + c2) * 64 + lane), (unsigned)__builtin_amdgcn_readfirstlane(lds0 + L_T + ((i) & 1) * TSZ + (2 * wid + c2) * 1024)); } } while (0)
#define XA_COMMIT(i) do { if (F32SRC) { _Pragma("unroll") for (int c2 = 0; c2 < 2; ++c2) *(LAS u32x4*)(lds + L_T + ((i) & 1) * TSZ + (tid + 512 * c2) * 16) = \
        (u32x4){pk2(st[c2][0][0], st[c2][0][1]), pk2(st[c2][0][2], st[c2][0][3]), pk2(st[c2][1][0], st[c2][1][1]), pk2(st[c2][1][2], st[c2][1][3])}; } } while (0)
    XA_ISSUE(0); XA_COMMIT(0);
    f32x16 S[8];
#pragma unroll
    for (int t = 0; t < 8; ++t) {
        XA_WAIT_BAR(); XA_ISSUE(t + 1);
        const LAS char* kp = lds + L_T + (t & 1) * TSZ + hi * 512 + r32 * 16;
        S[t] = f32x16{};
#pragma unroll
        for (int d0 = 0; d0 < 16; ++d0) S[t] = __builtin_amdgcn_mfma_f32_32x32x16_bf16(*(const LAS bf16x8*)(kp + d0 * 1024), qr[d0], S[t], 0, 0, 0);
        XA_COMMIT(t + 1);
    }
    float mx = S[0][0];
#pragma unroll
    for (int t = 0; t < 8; ++t)
#pragma unroll
        for (int r = 0; r < 16; ++r) mx = __builtin_fmaxf(mx, S[t][r]);
    { auto rr = __builtin_amdgcn_permlane32_swap(__float_as_uint(mx), __float_as_uint(mx), false, false); mx = __builtin_fmaxf(__uint_as_float(rr[0]), __uint_as_float(rr[1])); }
    float l = 0.f; u32x4 pw[16];
#pragma unroll
    for (int t = 0; t < 8; ++t) {
#pragma unroll
        for (int r = 0; r < 16; ++r) { S[t][r] = ex2(S[t][r] - mx); l += S[t][r]; }
        pw[2 * t] = (u32x4){pk2(S[t][0], S[t][1]), pk2(S[t][2], S[t][3]), pk2(S[t][4], S[t][5]), pk2(S[t][6], S[t][7])};
        pw[2 * t + 1] = (u32x4){pk2(S[t][8], S[t][9]), pk2(S[t][10], S[t][11]), pk2(S[t][12], S[t][13]), pk2(S[t][14], S[t][15])}; }
    { auto rr = __builtin_amdgcn_permlane32_swap(__float_as_uint(l), __float_as_uint(l), false, false); l = __uint_as_float(rr[0]) + __uint_as_float(rr[1]); }
    if (hi == 0) wsf[r32] = l;
    float rli[16];
#pragma unroll
    for (int r = 0; r < 16; ++r) rli[r] = __builtin_amdgcn_rcpf(wsf[fa::crow(r, hi)]);
    const int vbl = (int)(lds0 + L_T) + ((lane >> 4) & 1) * 32 + (lane & 3) * 8 + (4 * hi + ((lane & 15) >> 2)) * 64;
    LAS bf16* stg = (LAS bf16*)(lds + L_OST) + wid * 1024;
#pragma unroll
    for (int db = 0; db < 8; ++db) {
        XA_WAIT_BAR(); if (db < 7) XA_ISSUE(8 + db + 1);
        const int vb = vbl + (db & 1) * TSZ;
        f32x16 o = f32x16{};
#pragma unroll
        for (int k4 = 0; k4 < 4; ++k4) { s16x4 vlo[4], vhi[4];
#pragma unroll
            for (int kk = 0; kk < 4; ++kk) {
                asm volatile("ds_read_b64_tr_b16 %0,%1 offset:%c2" : "=&v"(vlo[kk]) : "v"(vb), "i"((k4 * 4 + kk) * 1024) : "memory");
                asm volatile("ds_read_b64_tr_b16 %0,%1 offset:%c2" : "=&v"(vhi[kk]) : "v"(vb), "i"((k4 * 4 + kk) * 1024 + 512) : "memory"); }
            asm volatile("s_waitcnt lgkmcnt(0)" ::: "memory"); __builtin_amdgcn_sched_barrier(0);
#pragma unroll
            for (int kk = 0; kk < 4; ++kk) o = __builtin_amdgcn_mfma_f32_32x32x16_bf16(__builtin_bit_cast(bf16x8, pw[k4 * 4 + kk]),
                (bf16x8){vlo[kk][0], vlo[kk][1], vlo[kk][2], vlo[kk][3], vhi[kk][0], vhi[kk][1], vhi[kk][2], vhi[kk][3]}, o, 0, 0, 0); }
        if (db < 7) XA_COMMIT(8 + db + 1);
#pragma unroll
        for (int r = 0; r < 16; ++r) stg[fa::crow(r, hi) * 32 + r32] = (bf16)(pk2(o[r] * rli[r], 0.f) & 0xffffu);
        LDS_WAIT();
#pragma unroll
        for (int ps = 0; ps < 2; ++ps) { const int row = ps * 16 + (lane >> 2), ch = lane & 3;
            const u32x4 v = *(const LAS u32x4*)(stg + row * 32 + ch * 8);
            if (row < nvalid) *(u32x4*)(O + (row0 + wid * 32 + row) * 1024 + hcol + 32 * db + ch * 8) = v; }
        LDS_WAIT();
    }
    asm volatile("s_waitcnt lgkmcnt(0)\n\ts_barrier" ::: "memory");
#undef XA_ISSUE
#undef XA_COMMIT
}
}

namespace ms {
constexpr int KSZ = 18432, L_T = 0, L_WS = 2 * KSZ, L_OST = L_WS + 8 * 64 * 4, L_BYTES = L_OST + 8 * 4096;
constexpr int PROW = 264;
#define MS_WAIT_BAR() asm volatile("s_waitcnt lgkmcnt(0)\n\ts_barrier" ::: "memory")
__device__ __forceinline__ const float* ms_ksrc(const float* ckvb, const float* krb, int key, int c) {
    const size_t o0 = (size_t)key * 256 + c * 8, o1 = (size_t)key * 32 + (c - 32) * 8; const bool lat = c < 32; return (lat ? ckvb : krb) + (lat ? o0 : o1); }
template <int NK> __device__ __forceinline__ void unit(const float* ckvb, const float* krb, int kclamp, const bf16* QA, float* P, LAS char* lds, unsigned lds0) {
    const int tid = pg8::pg8_tid(), lane = tid & 63, r32 = lane & 31, hi = lane >> 5; const int wid = __builtin_amdgcn_readfirstlane(tid >> 6);
    const bf16* Qw = QA + (size_t)(wid * 32 + r32) * 288 + hi * 8;
    f32x4 st[2][3][2];
#define MS_SRC(i, ci) (((i) < 8) ? ms_ksrc(ckvb, krb, min(32 * (i) + ((ci) & 31), kclamp), (ci) >> 5) \
                                  : ckvb + (size_t)min((ci) >> 2, kclamp) * 256 + 32 * ((i) - 8) + ((ci) & 3) * 8)
#define MS_NCH(i) (((i) < 8) ? 1152 : 1024)
#define MS_ISSUE(i, set) do { _Pragma("unroll") for (int c2 = 0; c2 < 3; ++c2) { const int ci = min(tid + 512 * c2, MS_NCH(i) - 1); const float* s = MS_SRC(i, ci); st[(set) & 1][c2][0] = *(const f32x4*)s; st[(set) & 1][c2][1] = *(const f32x4*)(s + 4); } } while (0)
#define MS_COMMIT(i, slot) do { _Pragma("unroll") for (int c2 = 0; c2 < 3; ++c2) { const int ci = min(tid + 512 * c2, MS_NCH(i) - 1); *(LAS u32x4*)(lds + L_T + ((slot) & 1) * KSZ + ci * 16) = \
        (u32x4){pk2(st[(slot) & 1][c2][0][0], st[(slot) & 1][c2][0][1]), pk2(st[(slot) & 1][c2][0][2], st[(slot) & 1][c2][0][3]), pk2(st[(slot) & 1][c2][1][0], st[(slot) & 1][c2][1][1]), pk2(st[(slot) & 1][c2][1][2], st[(slot) & 1][c2][1][3])}; } } while (0)
    constexpr int FIRSTV = 8;
#define MS_TILE(q) (((q) < NK) ? (q) : FIRSTV + (q) - NK)
    MS_ISSUE(MS_TILE(0), 0); MS_COMMIT(MS_TILE(0), 0); MS_ISSUE(MS_TILE(1), 1);
    f32x16 S[NK];
#pragma unroll
    for (int t = 0; t < NK; ++t) {
        MS_WAIT_BAR(); MS_ISSUE(MS_TILE(t + 2), t + 2);
        const LAS char* kp = lds + L_T + (t & 1) * KSZ + hi * 512 + r32 * 16;
        S[t] = f32x16{}; const bf16* Qt = Qw; asm volatile("" : "+v"(Qt));
#pragma unroll
        for (int d0 = 0; d0 < 18; ++d0) { S[t] = __builtin_amdgcn_mfma_f32_32x32x16_bf16(*(const LAS bf16x8*)(kp + d0 * 1024), *(const bf16x8*)(Qt + d0 * 16), S[t], 0, 0, 0);
            if (d0 % 6 == 5) __builtin_amdgcn_sched_barrier(0); }
        MS_COMMIT(MS_TILE(t + 1), t + 1);
    }
    constexpr int VS0 = (NK & 1);
    if (NK == 1) {
#pragma unroll
        for (int r = 8; r < 16; ++r) S[0][r] = -INFINITY; }
    float mx = S[0][0];
#pragma unroll
    for (int t = 0; t < NK; ++t)
#pragma unroll
        for (int r = 0; r < 16; ++r) mx = __builtin_fmaxf(mx, S[t][r]);
    { auto rr = __builtin_amdgcn_permlane32_swap(__float_as_uint(mx), __float_as_uint(mx), false, false); mx = __builtin_fmaxf(__uint_as_float(rr[0]), __uint_as_float(rr[1])); }
    float l = 0.f; u32x4 pw[2 * NK];
#pragma unroll
    for (int t = 0; t < NK; ++t) {
#pragma unroll
        for (int r = 0; r < 16; ++r) { S[t][r] = ex2(S[t][r] - mx); l += S[t][r]; }
        pw[2 * t] = (u32x4){pk2(S[t][0], S[t][1]), pk2(S[t][2], S[t][3]), pk2(S[t][4], S[t][5]), pk2(S[t][6], S[t][7])};
        pw[2 * t + 1] = (u32x4){pk2(S[t][8], S[t][9]), pk2(S[t][10], S[t][11]), pk2(S[t][12], S[t][13]), pk2(S[t][14], S[t][15])}; }
    { auto rr = __builtin_amdgcn_permlane32_swap(__float_as_uint(l), __float_as_uint(l), false, false); l = __uint_as_float(rr[0]) + __uint_as_float(rr[1]); }
    float* Pw = P + (size_t)(wid * 32) * PROW;
    if (hi == 0) { Pw[(size_t)r32 * PROW + 256] = mx; Pw[(size_t)r32 * PROW + 257] = l; }
    LAS float* stg = (LAS float*)(lds + L_OST) + wid * 1024;
#pragma unroll
    for (int db = 0; db < 8; ++db) {
        MS_WAIT_BAR(); if (db < 6) MS_ISSUE(FIRSTV + db + 2, NK + db + 2);
        const int vb = (int)(lds0 + L_T) + ((VS0 + db) & 1) * KSZ + ((lane >> 4) & 1) * 32 + (lane & 3) * 8 + (4 * hi + ((lane & 15) >> 2)) * 64;
        f32x16 o = f32x16{};
#pragma unroll
        for (int ks = 0; ks < 2 * NK; ++ks) { s16x4 vlo, vhi;
            asm volatile("ds_read_b64_tr_b16 %0,%1 offset:%c2" : "=&v"(vlo) : "v"(vb), "i"(ks * 1024) : "memory");
            asm volatile("ds_read_b64_tr_b16 %0,%1 offset:%c2" : "=&v"(vhi) : "v"(vb), "i"(ks * 1024 + 512) : "memory");
            asm volatile("s_waitcnt lgkmcnt(0)" ::: "memory"); __builtin_amdgcn_sched_barrier(0);
            o = __builtin_amdgcn_mfma_f32_32x32x16_bf16(__builtin_bit_cast(bf16x8, pw[ks]), (bf16x8){vlo[0], vlo[1], vlo[2], vlo[3], vhi[0], vhi[1], vhi[2], vhi[3]}, o, 0, 0, 0); }
#pragma unroll
        for (int r = 0; r < 16; ++r) stg[fa::crow(r, hi) * 32 + r32] = o[r];
        LDS_WAIT();
        { const int row = lane >> 1, cq = (lane & 1) * 16; float* dst = Pw + (size_t)row * PROW + 32 * db + cq;
#pragma unroll
          for (int k = 0; k < 4; ++k) *(f32x4*)(dst + 4 * k) = *(const LAS f32x4*)(stg + row * 32 + cq + 4 * k); }
        if (db < 7) MS_COMMIT(FIRSTV + db + 1, NK + db + 1);
        LDS_WAIT();
    }
    asm volatile("s_waitcnt lgkmcnt(0)\n\ts_barrier" ::: "memory");
#undef MS_SRC
#undef MS_ISSUE
#undef MS_COMMIT
#undef MS_NCH
#undef MS_TILE
}
}

constexpr int RING_OFF = 0, RING_BYTES = 131072;
constexpr int LDSCTL_OFF = RING_BYTES, MISC_OFF = LDSCTL_OFF + 320;
constexpr int LDS_BYTES = 147456;
constexpr int NWAVES = 8;
static_assert(fa::L_BYTES2 <= RING_BYTES && xa::L_BYTES <= RING_BYTES && ms::L_BYTES <= RING_BYTES, "attention LDS");

struct KArgs { const float* in[N_IN]; float* out; unsigned char* ws; int ph_lo, ph_hi; };
static_assert(sizeof(KArgs) == N_IN * 8 + 24, "KArgs has no padding");
typedef const __attribute__((address_space(4))) KArgs* KAP;
#define KA ((KAP)__builtin_amdgcn_kernarg_segment_ptr())

#define XB_TMO      128
#define XB_XCNT(j)  (256  + 64 * (j))
#define XB_XSUB(j)  (1280 + 64 * (j))
#define XB_XGEN(j)  (2304 + 64 * (j))
#define XB_TOP      3328
#define XB_TOPGEN   3392
#define XCD_BAR_WORDS 3456
#define XB_SPIN_CAP (1u << 18)

__device__ __forceinline__ unsigned xb_ld(unsigned* p)              { return __hip_atomic_load(p, __ATOMIC_RELAXED, __HIP_MEMORY_SCOPE_AGENT); }
__device__ __forceinline__ unsigned xb_add(unsigned* p, unsigned v) { return __hip_atomic_fetch_add(p, v, __ATOMIC_RELAXED, __HIP_MEMORY_SCOPE_AGENT); }
__device__ __forceinline__ unsigned xb_xcc_id() { return (unsigned)__builtin_amdgcn_s_getreg((3 << 11) | 20) & 0xFu; }
#define XB_SPIN(cond, bar) do { unsigned _sp = 0; while (cond) { __builtin_amdgcn_s_sleep(1); \
    if ((++_sp & 255u) == 0u) { if (xb_ld(&(bar)[XB_TMO])) break; if (_sp > XB_SPIN_CAP) { atomicAdd(&(bar)[XB_TMO], 1u); break; } } } } while (0)

struct XcdBarrier {
    unsigned* bar; unsigned x;
    volatile LAS unsigned* st;
};

__device__ __forceinline__ XcdBarrier xcd_barrier_post(unsigned* bar, volatile LAS unsigned* st) {
    XcdBarrier b; b.bar = bar; b.x = xb_xcc_id(); b.st = st;
    if (threadIdx.x == 0) (void)xb_add(&bar[XB_XCNT(b.x)], 1u);
    return b;
}
__device__ __forceinline__ void xcd_barrier_complete(unsigned* bar, unsigned x, unsigned& nloc, unsigned& nx) {
    const unsigned G = gridDim.x * gridDim.y * gridDim.z;
    unsigned sum, cnt, mine, sp = 0u;
    for (;;) {
        sum = 0u; cnt = 0u; mine = 0u;
#pragma unroll
        for (unsigned j = 0; j < 16; ++j) { const unsigned c = xb_ld(&bar[XB_XCNT(j)]); sum += c; cnt += (c > 0u) ? 1u : 0u; mine = (j == x) ? c : mine; }
        if (sum == G) break;
        __builtin_amdgcn_s_sleep(1);
        if ((++sp & 255u) == 0u) { if (xb_ld(&bar[XB_TMO])) break; if (sp > XB_SPIN_CAP) { atomicAdd(&bar[XB_TMO], 1u); break; } }
    }
    nloc = mine > 0u ? mine : 1u; nx = cnt > 0u ? cnt : 1u;
}

__device__ __forceinline__ void xcd_barrier(const XcdBarrier& b) {
    asm volatile("s_waitcnt vmcnt(0)" ::: "memory");
    __syncthreads();
    if (threadIdx.x == 0) {
        unsigned* bar = b.bar;
        __builtin_amdgcn_s_waitcnt(0);
        unsigned nloc = b.st[0], nx = b.st[1];
        if (nloc == 0u) { xcd_barrier_complete(bar, b.x, nloc, nx); b.st[0] = nloc; b.st[1] = nx; }
        const unsigned old = xb_add(&bar[XB_XSUB(b.x)], 1u);
        const unsigned gen = old / nloc;
        if (old + 1u == (gen + 1u) * nloc) {
            __builtin_amdgcn_fence(__ATOMIC_RELEASE, "agent");
            asm volatile("s_waitcnt vmcnt(0)" ::: "memory");
            const unsigned og = xb_add(&bar[XB_TOP], 1u);
            const unsigned tg = og / nx;
            if (og + 1u == (tg + 1u) * nx) xb_add(&bar[XB_TOPGEN], 1u);
            else XB_SPIN(xb_ld(&bar[XB_TOPGEN]) == tg, bar);
            __builtin_amdgcn_fence(__ATOMIC_ACQUIRE, "agent");
            xb_add(&bar[XB_XGEN(b.x)], 1u);
            asm volatile("s_waitcnt vmcnt(0)" ::: "memory");
        } else {
            XB_SPIN(xb_ld(&bar[XB_XGEN(b.x)]) == gen, bar);
            __builtin_amdgcn_fence(__ATOMIC_ACQUIRE, "agent");
            asm volatile("s_waitcnt vmcnt(0)" ::: "memory");
        }
    }
    __syncthreads();
}

struct Seg { const float* W; int ldw, c0, ncols, K; bf16* T; int ldt, r0; const float* g; };
__device__ __forceinline__ Seg get_seg(KAP a, unsigned char* ws, int idx) {
    Seg s; s.g = nullptr; s.r0 = 0; s.c0 = 0; s.ldw = 1024; s.ncols = 1024; s.K = 1024; s.ldt = 1024; s.W = nullptr; s.T = nullptr;
    if (idx < 4) { const int j = idx & 1; s.W = a->in[I_WFI] + (size_t)j * 1024 * 4112; s.ldw = 4112; s.T = (bf16*)(ws + WS_WFI) + (size_t)j * 4352 * 1024; s.g = a->in[I_GMIX] + (size_t)(2 * j) * 1024;
        if (idx < 2) { s.c0 = 0; s.ncols = 3072; s.r0 = 0; } else { s.c0 = 3088; s.ncols = 1024; s.r0 = 3072; } }
    else if (idx < 6) { const int j = idx - 4; s.W = a->in[I_WFO] + (size_t)j * 1024 * 1024; s.T = (bf16*)(ws + WS_WFO) + (size_t)j * 1024 * 1024; }
    else if (idx < 12) { const int e = idx - 6, j = e / 3, part = e % 3; s.W = a->in[I_WMA] + (size_t)j * 1024 * 672; s.ldw = 672; s.T = (bf16*)(ws + WS_WMA) + (size_t)j * 768 * 1024; s.g = a->in[I_GMIX] + (size_t)(2 * j + 1) * 1024;
        if (part == 0) { s.c0 = 384; s.ncols = 256; s.r0 = 0; } else if (part == 1) { s.c0 = 0; s.ncols = 384; s.r0 = 256; } else { s.c0 = 640; s.ncols = 32; s.r0 = 640; } }
    else if (idx < 14) { const int j = idx - 12; s.W = a->in[I_WMQB] + (size_t)j * 384 * 1536; s.ldw = 1536; s.ncols = 1536; s.K = 384; s.T = (bf16*)(ws + WS_WMQ) + (size_t)j * 1536 * 384; s.ldt = 384; s.g = a->in[I_GMQ] + (size_t)j * 384; }
    else if (idx < 18) { const int j = idx & 1; const bool raw = idx >= 16; s.W = a->in[I_WMKVB] + (size_t)j * 256 * 2048; s.ldw = 2048; s.ncols = 2048; s.K = 256; s.ldt = 256;
        s.T = (bf16*)(ws + (raw ? WS_WMKVR : WS_WMKV)) + (size_t)j * 2048 * 256; s.g = raw ? nullptr : a->in[I_GMKV] + (size_t)j * 256; }
    else if (idx < 20) { const int j = idx - 18; s.W = a->in[I_WMO] + (size_t)j * 1024 * 1024; s.T = (bf16*)(ws + WS_WMO) + (size_t)j * 1024 * 1024; }
    else if (idx < 24) { const int i = idx - 20; s.W = a->in[I_WXQ] + (size_t)i * 1024 * 1024; s.T = (bf16*)(ws + WS_WXQ) + (size_t)i * 1024 * 1024; s.g = a->in[I_GCROSS] + (size_t)i * 1024; }
    else if (idx < 28) { const int i = idx - 24; s.W = a->in[I_WXO] + (size_t)i * 1024 * 1024; s.T = (bf16*)(ws + WS_WXO) + (size_t)i * 1024 * 1024; }
    else if (idx < 32) { const int i = idx - 28; s.W = a->in[I_WXKV] + (size_t)i * 1024 * 2048; s.ldw = 2048; s.ncols = 2048; s.T = (bf16*)(ws + WS_WXKV) + (size_t)i * 2048 * 1024; s.g = a->in[I_GMEM] + (size_t)i * 1024; }
    else if (idx < 36) { const int i = idx - 32; s.W = a->in[I_WDN] + (size_t)i * 2816 * 1024; s.K = 2816; s.T = (bf16*)(ws + WS_WDN) + (size_t)i * 1024 * 2816; s.ldt = 2816; }
    else if (idx < 212) { const int e = idx - 36, i = e / 44, t = e % 44, pn = t >> 1, half = t & 1; s.W = a->in[I_WGU] + (size_t)i * 1024 * 5632; s.ldw = 5632; s.c0 = half * 2816 + 128 * pn; s.ncols = 128;
        s.T = (bf16*)(ws + WS_WGU) + (size_t)i * 5632 * 1024; s.r0 = 256 * pn + 128 * half; s.g = a->in[I_GFFN] + (size_t)i * 1024; }
    else { const int j = idx - 212; s.W = a->in[I_WFI] + (size_t)j * 1024 * 4112; s.ldw = 4112; s.c0 = 3072; s.ncols = 32; s.T = (bf16*)(ws + WS_WFI) + (size_t)j * 4352 * 1024; s.r0 = 4096; s.g = a->in[I_GMIX] + (size_t)(2 * j) * 1024; }
    return s;
}
constexpr int NSEG = 214;
__device__ __forceinline__ void tr_load(const Seg& s, int item, int lane, float (&v)[32]) {
    const int nnb = s.ncols / 32, kb = item / nnb, nb = item % nnb; const float* p = s.W + (size_t)(64 * kb + (lane >> 5)) * s.ldw + s.c0 + 32 * nb + (lane & 31);
#pragma unroll
    for (int i = 0; i < 32; ++i) v[i] = p[(size_t)(2 * i) * s.ldw];
}
__device__ __forceinline__ void tr_store(const Seg& s, int item, int lane, const float (&v)[32], LAS float* scr) {
    const int nnb = s.ncols / 32, kb = item / nnb, nb = item % nnb, k0 = 64 * kb, n0 = 32 * nb;
#pragma unroll
    for (int i = 0; i < 32; ++i) scr[(2 * i + (lane >> 5)) * 33 + (lane & 31)] = v[i];
    LDS_WAIT(); asm volatile("" ::: "memory");
    const int c = lane & 7; f32x4 g0 = (f32x4){1.f, 1.f, 1.f, 1.f}, g1 = g0;
    if (s.g) { g0 = *(const f32x4*)(s.g + k0 + 8 * c); g1 = *(const f32x4*)(s.g + k0 + 8 * c + 4); }
#pragma unroll
    for (int j = 0; j < 4; ++j) { const int n = (lane >> 3) + 8 * j; const LAS float* p = scr + (8 * c) * 33 + n;
        u32x4 o; o.x = pk2(p[0 * 33] * g0[0], p[1 * 33] * g0[1]); o.y = pk2(p[2 * 33] * g0[2], p[3 * 33] * g0[3]); o.z = pk2(p[4 * 33] * g1[0], p[5 * 33] * g1[1]); o.w = pk2(p[6 * 33] * g1[2], p[7 * 33] * g1[3]);
        *(u32x4*)(s.T + (size_t)(s.r0 + n0 + n) * s.ldt + k0 + 8 * c) = o; }
    LDS_WAIT(); asm volatile("" ::: "memory");
}
__device__ __forceinline__ void cvt_blocks(const float* src, bf16* dst, int nblk, int blk, size_t dstride, int gtid, int nthr) {
    const long total = (long)nblk * blk / 8;
    for (long v = gtid; v < total; v += nthr) { const long e = v * 8; const int b = (int)(e / blk), o = (int)(e % blk);
        const f32x4 x = *(const f32x4*)(src + e), y = *(const f32x4*)(src + e + 4);
        *(u32x4*)(dst + (size_t)b * dstride + o) = (u32x4){pk2(x[0], x[1]), pk2(x[2], x[3]), pk2(y[0], y[1]), pk2(y[2], y[3])}; }
}
__device__ __forceinline__ void p0_prologue(KAP a, LAS unsigned char* lds, int gw, int NGW, int wave, int lane, int pmask) {
    unsigned char* ws = a->ws; const int gtid = gw * 64 + lane, nthr = NGW * 64;
    LAS float* scr = (LAS float*)(lds + RING_OFF + wave * 16384);
#undef P0_PARTS
#define P0_PARTS pmask
    if (P0_PARTS & 1) {
        int total = 0;
        for (int sg = 0; sg < NSEG; ++sg) { const Seg s = get_seg(a, ws, sg); total += (s.K / 64) * (s.ncols / 32); }
        int sg = 0, base = 0; Seg sc = get_seg(a, ws, 0); int nit = (sc.K / 64) * (sc.ncols / 32);
#define P0_ADVANCE(gi) while ((gi) >= base + nit) { base += nit; ++sg; sc = get_seg(a, ws, sg); nit = (sc.K / 64) * (sc.ncols / 32); }
        float va[32], vb[32]; Seg sa = sc, sb = sc; int ia = 0, ib = 0;
        int gi = gw;
        if (gi < total) { P0_ADVANCE(gi); sa = sc; ia = gi - base; tr_load(sa, ia, lane, va); }
        while (gi < total) {
            int gn = gi + NGW;
            if (gn < total) { P0_ADVANCE(gn); sb = sc; ib = gn - base; tr_load(sb, ib, lane, vb); }
            tr_store(sa, ia, lane, va, scr);
            gi = gn; if (gi >= total) break;
            gn = gi + NGW;
            if (gn < total) { P0_ADVANCE(gn); sa = sc; ia = gn - base; tr_load(sa, ia, lane, va); }
            tr_store(sb, ib, lane, vb, scr);
            gi = gn;
        }
#undef P0_ADVANCE
    }
    if (P0_PARTS & 2) {
    cvt_blocks(a->in[I_WMKVB], (bf16*)(ws + WS_WKN), 1, 2 * 256 * 2048, 0, gtid, nthr); }
    if (P0_PARTS & 4) { const u32x4 z = (u32x4){0u, 0u, 0u, 0u};
      for (int v = gtid; v < 2 * 224 * 128; v += nthr) { const int j = v / (224 * 128), r = v % (224 * 128); *(u32x4*)((bf16*)(ws + WS_WFI) + ((size_t)j * 4352 + 4128) * 1024 + (size_t)r * 8) = z; }
      for (int v = gtid; v < 2 * 96 * 128; v += nthr) { const int j = v / (96 * 128), r = v % (96 * 128); *(u32x4*)((bf16*)(ws + WS_WMA) + ((size_t)j * 768 + 672) * 1024 + (size_t)r * 8) = z; }
    }
    if (P0_PARTS & 16) for (int v = gtid; v < 4096 * 16; v += nthr) { const int pos = v >> 4, c = v & 15; const double inv = pow(10000.0, -(double)c / 16.0), ang = (double)pos * inv;
        ((float*)(ws + WS_ROPC))[v] = (float)cos(ang); ((float*)(ws + WS_ROPS))[v] = (float)sin(ang); }
    if (P0_PARTS & 32) for (int row = gw; row < MT; row += NGW) { const float* xr = (row < MP) ? a->in[I_XP] + (size_t)row * 1024 : a->in[I_XS] + (size_t)(row - MP) * 1024;
        float sq = 0.f; bf16* o = (bf16*)(ws + WS_XB) + (size_t)row * 1024;
#pragma unroll
        for (int j = 0; j < 4; ++j) { const f32x4 v = *(const f32x4*)(xr + 256 * j + 4 * lane); sq += pg8::dot4(v); *(u32x2*)(o + 256 * j + 4 * lane) = pg8::pk4(v); }
        sq = wave_sum(sq);
        if (lane < 16) ((float*)(ws + WS_SSQ))[(size_t)row * 16 + lane] = (lane == 0) ? sq : 0.f; }
    if (P0_PARTS & 64) for (int row = gw; row < 2048; row += NGW) { const float* xr = a->in[I_MEM] + (size_t)row * 1024; f32x4 v[4]; float sq = 0.f;
#pragma unroll
        for (int j = 0; j < 4; ++j) { v[j] = *(const f32x4*)(xr + 256 * j + 4 * lane); sq += pg8::dot4(v[j]); }
        const float r = rsqrtf(wave_sum(sq) * (1.0f / 1024.0f) + EPS); bf16* o = (bf16*)(ws + WS_MB) + (size_t)row * 1024;
#pragma unroll
        for (int j = 0; j < 4; ++j) *(u32x2*)(o + 256 * j + 4 * lane) = pg8::pk4(v[j] * r); }
}

__device__ __forceinline__ float ssq_rstd16(const float* ssq, int row) {
    const f32x4 a = *(const f32x4*)(ssq + (size_t)row * 16), b = *(const f32x4*)(ssq + (size_t)row * 16 + 4), c = *(const f32x4*)(ssq + (size_t)row * 16 + 8), d = *(const f32x4*)(ssq + (size_t)row * 16 + 12);
    const float s = ((a[0] + a[1]) + (a[2] + a[3])) + ((b[0] + b[1]) + (b[2] + b[3])) + ((c[0] + c[1]) + (c[2] + c[3])) + ((d[0] + d[1]) + (d[2] + d[3]));
    return rsqrtf(s * (1.0f / 1024.0f) + EPS);
}
__device__ __forceinline__ void cum_local_prompt(KAP a, int bh, LAS float* red, int wave, int lane) {
    unsigned char* ws = a->ws; const float* lfr = (const float*)(ws + WS_LFR); const int b = bh >> 4, h = bh & 15; float* cb = (float*)(ws + WS_CB) + (size_t)bh * 4096;
    float v[8];
#pragma unroll
    for (int k = 0; k < 8; ++k) v[k] = lfr[((size_t)b * 4096 + 512 * wave + 64 * k + lane) * 16 + h];
    float carry = 0.f;
#pragma unroll
    for (int k = 0; k < 8; ++k) {
#pragma unroll
        for (int o = 1; o < 64; o <<= 1) { const float y = __shfl_up(v[k], o); if (lane >= o) v[k] += y; }
        v[k] += carry; carry = __shfl(v[k], 63); }
    if (lane == 0) red[wave] = carry;
    __syncthreads();
    float off = 0.f;
#pragma unroll
    for (int w = 0; w < 7; ++w) off += (w < wave) ? red[w] : 0.f;
#pragma unroll
    for (int k = 0; k < 8; ++k) cb[512 * wave + 64 * k + lane] = -(v[k] + off) * LOG2E;
    VM_WAIT(); __syncthreads();
}
__device__ __forceinline__ void cum_local_sample(KAP a, int L, int pair, LAS float* red, int wave, int lane) {
    unsigned char* ws = a->ws; const float* lfr = (const float*)(ws + WS_LFR); const int bs = pair >> 4, h = pair & 15;
    const float* lfc = a->in[I_CFL] + (size_t)L * 32 * 2048 * 16; float* cb = (float*)(ws + WS_CBS) + (size_t)pair * 2080;
    float x[4], v[4];
#pragma unroll
    for (int k = 0; k < 4; ++k) x[k] = lfc[((size_t)bs * 2048 + 256 * wave + 64 * k + lane) * 16 + h];
    float carry = 0.f;
#pragma unroll
    for (int k = 3; k >= 0; --k) { float t = x[k];
#pragma unroll
        for (int o = 1; o < 64; o <<= 1) { const float y = __shfl_down(t, o); if (lane + o < 64) t += y; }
        v[k] = carry + t - x[k]; carry += __shfl(t, 0); }
    if (lane == 0) red[wave] = carry;
    __syncthreads();
    float off = 0.f;
#pragma unroll
    for (int w = 1; w < 8; ++w) off += (w > wave) ? red[w] : 0.f;
#pragma unroll
    for (int k = 0; k < 4; ++k) cb[256 * wave + 64 * k + lane] = (v[k] + off) * LOG2E;
    if (wave == 0) { float t = (lane < 16) ? lfr[((size_t)MP + bs * 16 + lane) * 16 + h] : 0.f;
#pragma unroll
        for (int o = 1; o < 16; o <<= 1) { const float y = __shfl_up(t, o); if (lane >= o) t += y; }
        if (lane < 32) cb[2048 + lane] = (lane < 16) ? -t * LOG2E : 0.f; }
    VM_WAIT(); __syncthreads();
}
__device__ __forceinline__ void ckv_fixup(KAP a, int L, int gw, int NGW, int lane) {
    unsigned char* ws = a->ws; const f32x4 g = *(const f32x4*)(a->in[I_GMKV] + (size_t)L * 256 + 4 * lane);
    for (int row = gw; row < MT; row += NGW) { const f32x4 s4 = *(const f32x4*)((const float*)(ws + WS_SSQKV) + (size_t)row * 4);
        const float r = rsqrtf(((s4[0] + s4[1]) + (s4[2] + s4[3])) * (1.0f / 256.0f) + EPS);
        const f32x4 v = *(const f32x4*)((const float*)(ws + WS_CKVU) + (size_t)row * 256 + 4 * lane) * r * g;
        if (row < MP) *(f32x4*)(a->out + O_MCP + ((size_t)L * MP + row) * 256 + 4 * lane) = v;
        else { const int rs = row - MP, bs = rs >> 4, t = rs & 15; *(f32x4*)(a->out + O_MCS + ((size_t)L * MS + rs) * 256 + 4 * lane) = v;
            (void)bs; (void)t; } }
}
__device__ __forceinline__ void final_phase(KAP a, int gw, int NGW, int lane) {
    for (int row = gw; row < MT; row += NGW) { const float r = ssq_rstd16((const float*)(a->ws + WS_SSQ), row); float* y = a->out + (size_t)row * 1024; const bf16* x = (const bf16*)(a->ws + WS_XB) + (size_t)row * 1024;
#pragma unroll
        for (int j = 0; j < 4; ++j) { const f32x4 g = *(const f32x4*)(a->in[I_GFINAL] + 256 * j + 4 * lane); const u32x2 w = *(const u32x2*)(x + 256 * j + 4 * lane);
            const f32x4 xv = (f32x4){__builtin_bit_cast(float, w.x << 16), __builtin_bit_cast(float, w.x & 0xffff0000u), __builtin_bit_cast(float, w.y << 16), __builtin_bit_cast(float, w.y & 0xffff0000u)};
            *(f32x4*)(y + 256 * j + 4 * lane) = xv * r * g; } }
}

__device__ __forceinline__ void foxs_item(KAP a, int L, int it, LAS unsigned char* lds, int wid, int lane) {
    unsigned char* ws = a->ws; const int pair = it * 2 + (wid >> 2), b = pair >> 4, h = pair & 15, sp = wid & 3, g = lane >> 4, li = lane & 15;
    const float* ck = a->in[I_CFK] + (size_t)L * 32 * 2048 * 1024 + ((size_t)b * 2048 * 16 + h) * 64;
    const float* cv = a->in[I_CFV] + (size_t)L * 32 * 2048 * 1024 + ((size_t)b * 2048 * 16 + h) * 64;
    const float* cbs = (const float*)(ws + WS_CBS) + (size_t)pair * 2080;
    const bf16* QF = (const bf16*)(ws + WS_QF); const bf16* KF = (const bf16*)(ws + WS_KF); const bf16* VF = (const bf16*)(ws + WS_VF);
    const size_t srow = (size_t)MP + b * 16;
    bf16x8 qf[2];
#pragma unroll
    for (int d0 = 0; d0 < 2; ++d0) qf[d0] = *(const bf16x8*)(QF + (srow + li) * 1024 + h * 64 + 32 * d0 + 8 * g);
    float m = -1e30f, l = 0.f; f32x4 o[4];
#pragma unroll
    for (int db = 0; db < 4; ++db) o[db] = (f32x4){0.f, 0.f, 0.f, 0.f};
    const int kv0 = 512 * sp;
    auto kl = [&](int s, int blk, int d0) -> bf16x8 { const float* p = ck + (size_t)(kv0 + 32 * s + 16 * blk + li) * 1024 + 32 * d0 + 8 * g; return a16::cvt8(*(const f32x4*)p, *(const f32x4*)(p + 4)); };
    auto vl = [&](int s, int db) -> bf16x8 { const float* p = cv + (size_t)(kv0 + 32 * s + 4 * g) * 1024 + 16 * db + li;
        const f32x4 x = (f32x4){p[0], p[1024], p[2048], p[3072]}, y = (f32x4){p[16 * 1024], p[17 * 1024], p[18 * 1024], p[19 * 1024]}; return a16::cvt8(x, y); };
    auto sf = [&](int s, f32x4& sA, f32x4& sB) { const float* p = cbs + kv0 + 32 * s + 4 * g; sA += *(const f32x4*)p; sB += *(const f32x4*)(p + 16); };
    a16::steps<2, 4>(0, 16, qf, kl, vl, sf, m, l, o, lane);
    if (sp == 3) {
        auto kl2 = [&](int, int blk, int d0) -> bf16x8 { bf16x8 z = {0, 0, 0, 0, 0, 0, 0, 0}; if (blk == 0) z = *(const bf16x8*)(KF + (srow + li) * 1024 + h * 64 + 32 * d0 + 8 * g); return z; };
        auto vl2 = [&](int, int db) -> bf16x8 { const bf16* p = VF + (srow + 4 * g) * 1024 + h * 64 + 16 * db + li;
            const u32x4 w = (u32x4){(unsigned)p[0] | ((unsigned)p[1024] << 16), (unsigned)p[2048] | ((unsigned)p[3072] << 16), 0u, 0u}; return __builtin_bit_cast(bf16x8, w); };
        auto sf2 = [&](int, f32x4& sA, f32x4& sB) { const f32x4 bb = *(const f32x4*)(cbs + 2048 + 4 * g);
#pragma unroll
            for (int r = 0; r < 4; ++r) { sA[r] = (4 * g + r > li) ? -INFINITY : sA[r] + bb[r]; sB[r] = -INFINITY; } };
        a16::steps<2, 4>(0, 1, qf, kl2, vl2, sf2, m, l, o, lane);
    }
    LAS float* PO = (LAS float*)(lds + RING_OFF) + wid * 1024; LAS float* PM = (LAS float*)(lds + RING_OFF + 32768) + wid * 32;
#pragma unroll
    for (int db = 0; db < 4; ++db)
#pragma unroll
        for (int r = 0; r < 4; ++r) PO[(4 * g + r) * 64 + 16 * db + li] = o[db][r];
    if (g == 0) { PM[li] = m; PM[16 + li] = l; }
    __syncthreads();
    {
        const int w0 = (wid >> 2) * 4, db = wid & 3; const bf16* GF = (const bf16*)(ws + WS_GF); bf16* OF = (bf16*)(ws + WS_OM);
#pragma unroll
        for (int r = 0; r < 4; ++r) { const int q = 4 * g + r; float mm = -1e30f;
#pragma unroll
            for (int s2 = 0; s2 < 4; ++s2) mm = __builtin_fmaxf(mm, ((LAS float*)(lds + RING_OFF + 32768) + (w0 + s2) * 32)[q]);
            float num = 0.f, den = 0.f;
#pragma unroll
            for (int s2 = 0; s2 < 4; ++s2) { LAS float* pm = (LAS float*)(lds + RING_OFF + 32768) + (w0 + s2) * 32; const float wgt = ex2(pm[q] - mm);
                num += wgt * ((LAS float*)(lds + RING_OFF) + (w0 + s2) * 1024)[q * 64 + 16 * db + li]; den += wgt * pm[16 + q]; }
            const size_t idx = (srow + q) * 1024 + h * 64 + 16 * db + li;
            OF[idx] = (bf16)(pk2(num / den * bf2f(GF[idx]), 0.f) & 0xffffu); }
    }
    __syncthreads();
}
__device__ __forceinline__ void mlas_qprime(KAP a, int L, int it, LAS unsigned char* lds, int wid, int lane) {
    unsigned char* ws = a->ws; const int b = (it < 256) ? (it >> 3) : (it - 256), c = (it < 256) ? (it & 7) : 8, g = lane >> 4, li = lane & 15;
    const bf16* QM = (const bf16*)(ws + WS_QM); const bf16* WKN = (const bf16*)(ws + WS_WKN) + (size_t)L * 256 * 2048;
    bf16* QA = (bf16*)(ws + WS_QA) + (size_t)it * 256 * 288;
    LAS bf16* scr = (LAS bf16*)(lds + RING_OFF + wid * 9216);
    for (int hh = 0; hh < 2; ++hh) { const int h = 2 * wid + hh; const bf16* qrow = QM + ((size_t)MP + b * 16 + li) * 1536 + h * 96; bf16* qa = QA + (size_t)(wid * 32 + hh * 16) * 288;
        const bf16x8 qn0 = *(const bf16x8*)(qrow + 8 * g), qn1 = *(const bf16x8*)(qrow + 32 + 8 * g);
#pragma unroll
        for (int cb = 0; cb < 16; ++cb) { const bf16* wp = WKN + (size_t)(16 * cb + li) * 2048 + h * 128 + 8 * g;
            f32x4 acc = a16::mfma16(qn0, *(const bf16x8*)wp, (f32x4){0.f, 0.f, 0.f, 0.f}); acc = a16::mfma16(qn1, *(const bf16x8*)(wp + 32), acc);
#pragma unroll
            for (int r = 0; r < 4; ++r) scr[(4 * g + r) * 288 + 16 * cb + li] = (bf16)(pk2(acc[r], 0.f) & 0xffffu); }
        *(LAS bf16x8*)(scr + li * 288 + 256 + 8 * g) = *(const bf16x8*)(qrow + 64 + 8 * g);
        LDS_WAIT();
#pragma unroll
        for (int j = 0; j < 9; ++j) *(u32x4*)(qa + (size_t)(lane + 64 * j) * 8) = *(const LAS u32x4*)(scr + (lane + 64 * j) * 8);
        LDS_WAIT(); }
    VM_WAIT(); __syncthreads();
}
__device__ __forceinline__ void mlas_attn(KAP a, int L, int it, LAS unsigned char* lds, unsigned lds0) {
    unsigned char* ws = a->ws; const int b = (it < 256) ? (it >> 3) : (it - 256), c = (it < 256) ? (it & 7) : 8; const bf16* QA = (const bf16*)(ws + WS_QA) + (size_t)it * 256 * 288;
    float* P = (float*)(ws + WS_PART) + ((size_t)(b * 9 + c) * 256) * ms::PROW;
    if (c < 8) { const size_t jb = (size_t)L * 32 + b;
        ms::unit<8>(a->in[I_CCKV] + (jb * 2048 + 256 * c) * 256, a->in[I_CKR] + (jb * 2048 + 256 * c) * 32, 255, QA, P, (LAS char*)(lds + RING_OFF), lds0 + RING_OFF);
    } else { const size_t ro = (size_t)L * MS + b * 16;
        ms::unit<1>(a->out + O_MCS + ro * 256, a->out + O_MRS + ro * 32, 15, QA, P, (LAS char*)(lds + RING_OFF), lds0 + RING_OFF); }
}
__device__ __forceinline__ void mlas_combine(KAP a, int L, LAS unsigned char* lds, int gw, int NGW, int wid, int lane) {
    unsigned char* ws = a->ws; LAS bf16* scr = (LAS bf16*)(lds + RING_OFF + wid * 8192);
    const bf16* WV = (const bf16*)(ws + WS_WMKVR) + (size_t)L * 2048 * 256; bf16* OM = (bf16*)(ws + WS_OM); const int g = lane >> 4, li = lane & 15;
    for (int e = gw; e < 512; e += NGW) { const int b = e >> 4, h = e & 15; const int q = lane >> 2, cg = (lane & 3) * 64;
        const float* P0 = (const float*)(ws + WS_PART) + ((size_t)(b * 9) * 256 + (h >> 1) * 32 + (h & 1) * 16 + q) * ms::PROW; constexpr size_t CS = (size_t)256 * ms::PROW;
        float mm = -1e30f;
#pragma unroll
        for (int c = 0; c < 9; ++c) mm = __builtin_fmaxf(mm, P0[c * CS + 256]);
        float wgt[9], den = 0.f;
#pragma unroll
        for (int c = 0; c < 9; ++c) { wgt[c] = ex2(P0[c * CS + 256] - mm); den += wgt[c] * P0[c * CS + 257]; }
        const float id = 1.0f / den;
        for (int j = 0; j < 64; j += 4) { f32x4 acc = (f32x4){0.f, 0.f, 0.f, 0.f};
#pragma unroll
            for (int c = 0; c < 9; ++c) acc += *(const f32x4*)(P0 + c * CS + cg + j) * wgt[c];
            *(LAS u32x2*)(scr + q * 256 + cg + j) = pg8::pk4(acc * id); }
        LDS_WAIT();
        bf16x8 af[8];
#pragma unroll
        for (int d0 = 0; d0 < 8; ++d0) af[d0] = *(const LAS bf16x8*)(scr + li * 256 + 32 * d0 + 8 * g);
#pragma unroll
        for (int db = 0; db < 4; ++db) { f32x4 acc = (f32x4){0.f, 0.f, 0.f, 0.f}; const bf16* wp = WV + (size_t)(h * 128 + 64 + 16 * db + li) * 256 + 8 * g;
#pragma unroll
            for (int d0 = 0; d0 < 8; ++d0) acc = a16::mfma16(af[d0], *(const bf16x8*)(wp + 32 * d0), acc);
            bf16* O = OM + ((size_t)MP + b * 16 + 4 * g) * 1024 + h * 64 + 16 * db + li; const unsigned w0 = pk2(acc[0], acc[1]), w1 = pk2(acc[2], acc[3]);
            O[0] = (bf16)(w0 & 0xffffu); O[1024] = (bf16)(w0 >> 16); O[2048] = (bf16)(w1 & 0xffffu); O[3072] = (bf16)(w1 >> 16); }
        LDS_WAIT();
    }
}
typedef float f32x2v_t __attribute__((ext_vector_type(2)));
template <int K, class F> __device__ __forceinline__ void thin_tiles(const bf16* A, const bf16* Bt, LAS unsigned char* lds, int vcu, int G, int wave, int lane, F epi) {
    const int g = lane >> 4, li = lane & 15; constexpr int nks = K / 256;
    LAS float* part = (LAS float*)(lds + RING_OFF);
#pragma unroll 1
    for (int tt = vcu; tt < 512; tt += G) { const int rb = tt & 31, cg = tt >> 5;
        const bf16* ap = A + (size_t)(MP + 16 * rb + li) * K + wave * (K / 8) + 8 * g; const bf16* bp = Bt + (size_t)(64 * cg + li) * K + wave * (K / 8) + 8 * g;
        f32x4 acc[4];
#pragma unroll
        for (int nb = 0; nb < 4; ++nb) acc[nb] = (f32x4){0.f, 0.f, 0.f, 0.f};
#pragma unroll
        for (int s0 = 0; s0 < nks; s0 += 4) { bf16x8 a[4], b[4][4]; const bf16x8 z = {0, 0, 0, 0, 0, 0, 0, 0};
#pragma unroll
            for (int u = 0; u < 4; ++u) { const bool on = s0 + u < nks; a[u] = on ? *(const bf16x8*)(ap + 32 * (s0 + u)) : z;
#pragma unroll
                for (int nb = 0; nb < 4; ++nb) b[u][nb] = on ? *(const bf16x8*)(bp + (size_t)nb * 16 * K + 32 * (s0 + u)) : z; }
#pragma unroll
            for (int u = 0; u < 4; ++u)
#pragma unroll
                for (int nb = 0; nb < 4; ++nb) acc[nb] = a16::mfma16(a[u], b[u][nb], acc[nb]); }
#pragma unroll
        for (int nb = 0; nb < 4; ++nb)
#pragma unroll
            for (int r = 0; r < 4; ++r) part[wave * 1024 + (4 * g + r) * 64 + 16 * nb + li] = acc[nb][r];
        __syncthreads();
        const int e = (2 * wave + (lane >> 5)) * 64 + 2 * (lane & 31); float s0v = 0.f, s1v = 0.f;
#pragma unroll
        for (int w = 0; w < 8; ++w) { const f32x2v_t v = *(const LAS f32x2v_t*)(part + w * 1024 + e); s0v += v[0]; s1v += v[1]; }
        epi(MP + 16 * rb + 2 * wave + (lane >> 5), 64 * cg + 2 * (lane & 31), cg, s0v, s1v);
        __syncthreads(); }
}
template <int K> __device__ __forceinline__ void thin_resid(KAP a, const bf16* A, const bf16* Bt, int first, LAS unsigned char* lds, int vcu, int G, int wave, int lane) {
    unsigned char* ws = a->ws; const float* xs = a->in[I_XS] - (size_t)MP * 1024; bf16* XB = (bf16*)(ws + WS_XB); float* SSQ = (float*)(ws + WS_SSQ);
    thin_tiles<K>(A, Bt, lds, vcu, G, wave, lane, [&](int row, int col, int cg, float v0, float v1) {
        const size_t o = (size_t)row * 1024 + col; float x0, x1;
        if (first) { const f32x2v_t xo = *(const f32x2v_t*)(xs + o); x0 = xo[0]; x1 = xo[1]; } else { const unsigned w = *(const unsigned*)(XB + o); x0 = __builtin_bit_cast(float, w << 16); x1 = __builtin_bit_cast(float, w & 0xffff0000u); }
        x0 += v0; x1 += v1; *(unsigned*)(XB + o) = pk2(x0, x1);
        float sq = x0 * x0 + x1 * x1; sq += __shfl_xor(sq, 1); sq += __shfl_xor(sq, 2); sq += __shfl_xor(sq, 4); sq += __shfl_xor(sq, 8); sq += __shfl_xor(sq, 16);
        if ((lane & 31) == 0) SSQ[(size_t)row * 16 + cg] = sq; });
}
__device__ __forceinline__ void thin_xq(KAP a, const bf16* Bt, LAS unsigned char* lds, int vcu, int G, int wave, int lane) {
    unsigned char* ws = a->ws; const bf16* XB = (const bf16*)(ws + WS_XB); bf16* QX = (bf16*)(ws + WS_QX); const float* SSQ = (const float*)(ws + WS_SSQ);
    thin_tiles<1024>(XB, Bt, lds, vcu, G, wave, lane, [&](int row, int col, int, float v0, float v1) {
        const float rs = ssq_rstd16(SSQ, row) * C2_X; *(unsigned*)(QX + (size_t)row * 1024 + col) = pk2(v0 * rs, v1 * rs); });
}

constexpr int NPH = 41;
struct Ctx { int lane, wave, G, bx, vcu, gw, NGW; };
__device__ __forceinline__ Ctx mk_ctx() { Ctx c; const int tid = pg8::pg8_tid(); c.lane = tid & 63; c.wave = __builtin_amdgcn_readfirstlane(tid >> 6); int G_ = gridDim.x, bx_ = blockIdx.x; asm volatile("" : "+s"(G_), "+s"(bx_)); c.G = G_; c.bx = bx_;
    c.vcu = (c.G % 8 == 0) ? (c.bx % 8) * (c.G / 8) + c.bx / 8 : c.bx; c.gw = c.vcu * NWAVES + c.wave; c.NGW = c.G * NWAVES; return c; }
#define RSX(ws) pg8::RowScale{(const float*)((ws) + WS_SSQ), 16, 4, 1.0f / 1024.0f}
#define PHASE __device__ __noinline__ void
#define FATPH __device__ __forceinline__ void
__device__ __forceinline__ unsigned char* ws_ptr() { GAS unsigned char* w = (GAS unsigned char*)KA->ws; asm volatile("" : "+s"(w)); return (unsigned char*)w; }
#define WSB(off) ((const bf16*)(ws_ptr() + (off)))
__device__ __forceinline__ const float* in_ptr(int i) { GAS const float* w = (GAS const float*)KA->in[i]; asm volatile("" : "+s"(w)); return (const float*)w; }
__device__ __forceinline__ float* out_ptr() { GAS float* w = (GAS float*)KA->out; asm volatile("" : "+s"(w)); return (float*)w; }

FATPH ph_prologue(KAP a, LAS unsigned char* lds, int pmask) { const Ctx c = mk_ctx(); p0_prologue(a, lds, c.gw, c.NGW, c.wave, c.lane, pmask); __syncthreads(); }
FATPH ph_memkv(LAS unsigned char* lds) { const Ctx c = mk_ctx(); unsigned char* ws = ws_ptr(); float* out = out_ptr();
    pg8::Gemm g{WSB(WS_MB), WSB(WS_WXKV), 2048, 8192, 1024}; pg8::StaticOrder S; S.init(2048, 8192, c.G, c.bx);
    pg8::EpiMemKV E{out + O_MKP, out + O_MVP, (bf16*)(ws + WS_MKB), (bf16*)(ws + WS_MVB)};
    pg8::gemm_phase<pg8::EpiMemKV, pg8::StaticOrder, true, true>(lds + RING_OFF, g, S, E); }
FATPH ph_fox_in(LAS unsigned char* lds, int L) { const Ctx c = mk_ctx(); unsigned char* ws = ws_ptr(); float* out = out_ptr();
    pg8::Gemm g{WSB(WS_XB), WSB(WS_WFI) + (size_t)L * 4352 * 1024, MT, 4352, 1024}; pg8::StaticOrder S; S.init(MT, 4352, c.G, c.bx);
    pg8::EpiFoxIn E{RSX(ws), ws, out, in_ptr(I_BFF) + L * 16, L};
    pg8::gemm_phase<pg8::EpiFoxIn, pg8::StaticOrder, true, true>(lds + RING_OFF, g, S, E); }
FATPH ph_fox_sample(KAP a, LAS unsigned char* lds, int L) { const Ctx c = mk_ctx(); LAS float* red = (LAS float*)(lds + RING_OFF + 65536);
    for (int it = c.vcu; it < 256; it += c.G) { cum_local_sample(a, L, 2 * it, red, c.wave, c.lane); cum_local_sample(a, L, 2 * it + 1, red, c.wave, c.lane); foxs_item(a, L, it, lds, c.wave, c.lane); } }
__device__ __forceinline__ void unit2_of(int e, int& bh, int& qb) { bh = e >> 3; const int k = e & 7, s = (k >> 2) & 1, ii = k & 3, j = 2 * s + (ii >> 1); qb = (ii & 1) ? 7 - j : j; }
__device__ __forceinline__ void unit_of(int e, int& bh, int& qb) { bh = e >> 4; const int k = e & 15, s = (k >> 3) & 1, ii = k & 7, j = 2 * (ii >> 1) + s; qb = (ii & 1) ? 15 - j : j; }
FATPH ph_fox_attn(LAS unsigned char* lds, unsigned lds0) { const Ctx c = mk_ctx(); unsigned char* ws = ws_ptr();
    for (int e0 = c.vcu * 4; e0 < 1024; e0 += c.G * 4) {
        __syncthreads(); cum_local_prompt(KA, e0 >> 3, (LAS float*)(lds + RING_OFF + 65536), c.wave, c.lane);
        for (int i = 0; i < 4; ++i) { int bh, qb; unit2_of(e0 + i, bh, qb); const int b = bh >> 4, h = bh & 15;
            fa::Args A{WSB(WS_QF), 1024, h * 64, WSB(WS_KF), 1024, h * 64, nullptr, WSB(WS_VF), 1024, h * 64, (bf16*)(ws + WS_OM), h * 64,
                       WSB(WS_GF), (const float*)(ws + WS_CB) + (size_t)bh * 4096};
            fa::unit2<0>(A, (long)b * 4096, qb, (LAS char*)(lds + RING_OFF), lds0 + RING_OFF); } } }
template <bool ABLK = false>
FATPH ph_resid(LAS unsigned char* lds, const bf16* A, const bf16* Bt, int K, int first, int dummy = 0) { const Ctx c = mk_ctx(); unsigned char* ws = ws_ptr();
    pg8::Gemm g{A, Bt, MP, 1024, K}; pg8::StaticOrder S; S.init(MP, 1024, c.G, c.bx);
    pg8::EpiResid E{KA->in[I_XP], KA->in[I_XS], first, dummy ? (bf16*)(ws + WS_R1 + (size_t)MT * 4096) : (bf16*)(ws + WS_XB), dummy ? (float*)(ws + WS_R1 + (size_t)MT * 6144) : (float*)(ws + WS_SSQ)};
    pg8::gemm_phase<pg8::EpiResid, pg8::StaticOrder, true, true, ABLK>(lds + RING_OFF, g, S, E); }
FATPH ph_scale_gemm(LAS unsigned char* lds, const bf16* A, const bf16* Bt, int M, int N, int K, const float* ssq, int stride, int ngrp, float inv_n, bf16* O, float scale) { const Ctx c = mk_ctx();
    pg8::Gemm g{A, Bt, M, N, K}; pg8::StaticOrder S; S.init(M, N, c.G, c.bx);
    pg8::EpiScaleBf16 E{pg8::RowScale{ssq, stride, ngrp, inv_n}, O, N, scale};
    pg8::gemm_phase<pg8::EpiScaleBf16, pg8::StaticOrder, true, true>(lds + RING_OFF, g, S, E); }
FATPH ph_cross(LAS unsigned char* lds, unsigned lds0, int layer) { const Ctx c = mk_ctx(); unsigned char* ws = ws_ptr();
    const bf16* QX = WSB(WS_QX); bf16* OX = (bf16*)(ws + WS_OM);
    const bool bal = (c.G == 256); const int nu = bal ? (c.vcu < 128 ? 1 : 3) : 2, ub = bal ? (c.vcu < 128 ? c.vcu : 128 + 3 * (c.vcu - 128)) : c.vcu * 2;
    for (int u0 = ub; u0 < 512; u0 += (bal ? 512 : c.G * 2))
        for (int i = 0; i < nu; ++i) { const int u = u0 + i, bh = u >> 4, qb = u & 15, b = bh >> 2, h = bh & 3; const size_t ko = ((size_t)layer * 2048 + b * 256) * 1024 + h * 256;
            xa::unit<false>(WSB(WS_MKB) + ko, WSB(WS_MVB) + ko, 1024, QX, OX, (size_t)b * 4096 + qb * 256, h * 256, 32, false, (LAS char*)(lds + RING_OFF), lds0 + RING_OFF); }
    for (int e = c.vcu; e < 128; e += c.G) { const int bs = e >> 2, h = e & 3; const size_t ko = ((size_t)(layer * 32 + bs) * 256) * 1024 + h * 256;
        xa::unit<true>(in_ptr(I_CMK) + ko, in_ptr(I_CMV) + ko, 1024, QX, OX, (size_t)MP + bs * 16, h * 256, 16, true, (LAS char*)(lds + RING_OFF), lds0 + RING_OFF); } }
FATPH ph_gu(LAS unsigned char* lds, int layer) { const Ctx c = mk_ctx(); unsigned char* ws = ws_ptr();
    pg8::Gemm g{WSB(WS_XB), WSB(WS_WGU) + (size_t)layer * 5632 * 1024, MT, 5632, 1024}; pg8::StaticOrder S; S.init(MT, 5632, c.G, c.bx);
    pg8::EpiSwiglu E{RSX(ws), (bf16*)(ws + WS_HB)}; pg8::gemm_phase<pg8::EpiSwiglu, pg8::StaticOrder, true, true>(lds + RING_OFF, g, S, E); }
FATPH ph_gu_null(LAS unsigned char* lds, int layer) { const Ctx c = mk_ctx();
    pg8::Gemm g{WSB(WS_XB), WSB(WS_WGU) + (size_t)layer * 5632 * 1024, MT, 5632, 1024}; pg8::StaticOrder S; S.init(MT, 5632, c.G, c.bx);
    pg8::EpiNull E{}; pg8::gemm_phase<pg8::EpiNull, pg8::StaticOrder, true, true>(lds + RING_OFF, g, S, E); }
FATPH ph_mla_a(LAS unsigned char* lds, int L) { const Ctx c = mk_ctx(); unsigned char* ws = ws_ptr(); float* out = out_ptr();
    pg8::Gemm g{WSB(WS_XB), WSB(WS_WMA) + (size_t)L * 768 * 1024, MT, 768, 1024}; pg8::StaticOrder S; S.init(MT, 768, c.G, c.bx);
    pg8::EpiMlaA E{RSX(ws), (float*)(ws + WS_CKVU), (bf16*)(ws + WS_CKVUB), (float*)(ws + WS_SSQKV), (bf16*)(ws + WS_CQ), (float*)(ws + WS_SSQQ), (bf16*)(ws + WS_KRB),
                   out + O_MRP + (size_t)L * MP * 32, out + O_MRS + (size_t)L * MS * 32, (const float*)(ws + WS_ROPC), (const float*)(ws + WS_ROPS)};
    pg8::gemm_phase<pg8::EpiMlaA, pg8::StaticOrder, true, true>(lds + RING_OFF, g, S, E); }
PHASE ph_fixup(KAP a, int L) { const Ctx c = mk_ctx(); ckv_fixup(a, L, c.gw, c.NGW, c.lane); }
FATPH ph_mla_q(LAS unsigned char* lds, int L, int kq) { const Ctx c = mk_ctx(); unsigned char* ws = ws_ptr();
    pg8::Gemm g{WSB(WS_CQ), WSB(WS_WMQ) + (size_t)L * 1536 * 384, MT, 1536, kq}; pg8::StaticOrder S; S.init(MT, 1536, c.G, c.bx);
    pg8::EpiMlaQ E{pg8::RowScale{(const float*)(ws + WS_SSQQ), 8, 2, 1.0f / 384.0f}, (bf16*)(ws + WS_QM), (const float*)(ws + WS_ROPC), (const float*)(ws + WS_ROPS)};
    pg8::gemm_phase<pg8::EpiMlaQ, pg8::StaticOrder, true, false>(lds + RING_OFF, g, S, E); }
PHASE ph_mla_qprime(KAP a, LAS unsigned char* lds, int L, int it) { const Ctx c = mk_ctx(); mlas_qprime(a, L, it, lds, c.wave, c.lane); }
FATPH ph_mla_sample(LAS unsigned char* lds, unsigned lds0, int L) { const Ctx c = mk_ctx(); for (int it = c.vcu; it < 288; it += c.G) { ph_mla_qprime(KA, lds, L, it); mlas_attn(KA, L, it, lds, lds0); } __syncthreads(); }
FATPH ph_mla_attn(LAS unsigned char* lds, unsigned lds0) { const Ctx c = mk_ctx(); unsigned char* ws = ws_ptr();
    for (int e0 = c.vcu * 4; e0 < 1024; e0 += c.G * 4)
        for (int i = 0; i < 4; ++i) { int bh, qb; unit2_of(e0 + i, bh, qb); const int b = bh >> 4, h = bh & 15;
            fa::Args A{WSB(WS_QM), 1536, h * 96, WSB(WS_KVM), 2048, h * 128, WSB(WS_KRB), WSB(WS_KVM), 2048, h * 128 + 64, (bf16*)(ws + WS_OM), h * 64,
                       nullptr, nullptr};
            fa::unit2<1>(A, (long)b * 4096, qb, (LAS char*)(lds + RING_OFF), lds0 + RING_OFF); } }
FATPH ph_mla_comb(LAS unsigned char* lds, int L) { const Ctx c = mk_ctx(); mlas_combine(KA, L, lds, c.gw, c.NGW, c.wave, c.lane); }
PHASE ph_thin_resid(KAP a, LAS unsigned char* lds, const bf16* A, const bf16* Bt, int K, int first) { const Ctx c = mk_ctx(); if (K == 1024) thin_resid<1024>(a, A, Bt, first, lds, c.vcu, c.G, c.wave, c.lane); else thin_resid<DFF>(a, A, Bt, first, lds, c.vcu, c.G, c.wave, c.lane); }
PHASE ph_thin_xq(KAP a, LAS unsigned char* lds, const bf16* Bt) { const Ctx c = mk_ctx(); thin_xq(a, Bt, lds, c.vcu, c.G, c.wave, c.lane); }
PHASE ph_final(KAP a) { const Ctx c = mk_ctx(); final_phase(a, c.gw, c.NGW, c.lane); }
PHASE ph_grid_bar(GAS unsigned* barw, unsigned x, volatile LAS unsigned* st) { XcdBarrier b; b.bar = (unsigned*)barw; b.x = x; b.st = st; xcd_barrier(b); }

__global__ void __launch_bounds__(NWAVES * 64, 2) fwd_kernel(KArgs args) {
    extern __shared__ __attribute__((aligned(16))) unsigned char lds_raw[];
    LAS unsigned char* lds = (LAS unsigned char*)lds_raw;
    volatile LAS unsigned* MISC = (volatile LAS unsigned*)(lds + MISC_OFF);
    const int tid = threadIdx.x;
    const unsigned lds0 = (unsigned)(uintptr_t)lds_raw;
    for (int u = tid; u < (LDS_BYTES - LDSCTL_OFF) / 4; u += NWAVES * 64) ((LAS unsigned*)(lds + LDSCTL_OFF))[u] = 0u;
    __syncthreads();
    const XcdBarrier bar = xcd_barrier_post((unsigned*)(args.ws + WS_CTL) + CW_BAR, MISC + 8);
    const int lo = args.ph_lo, hi = args.ph_hi;
#ifndef DBG_DOUBLE
#define DBG_DOUBLE 0
#endif
#ifndef DBG_P0_AGAIN
#define DBG_P0_AGAIN 0
#endif
#define REP(bit) for (int rep_ = 0; rep_ < ((DBG_DOUBLE & (bit)) ? 2 : 1); ++rep_)
#define IN(k) (lo <= (k) && (k) < hi)
#define SEAM(k) do { if (IN(k) && IN((k) + 1)) { REP(256) ph_grid_bar((GAS unsigned*)bar.bar, bar.x, bar.st); } } while (0)
    if (IN(0)) { ph_prologue(KA, lds, 0x7f); if (DBG_P0_AGAIN) ph_prologue(KA, lds, DBG_P0_AGAIN); }
    SEAM(0);
    if (IN(1)) ph_memkv(lds);
    SEAM(1);
    for (int L = 0; L < 2; ++L) {
        const int pb = 2 + 19 * L;
        if (IN(pb)) { REP(8) ph_fox_in(lds, L); }
        SEAM(pb);
        if (IN(pb + 2)) { REP(64) ph_fox_sample(KA, lds, L); REP(32) ph_fox_attn(lds, lds0); }
        SEAM(pb + 2);
        if (IN(pb + 3)) { ph_thin_resid(KA, lds, WSB(WS_OM), WSB(WS_WFO) + (size_t)L * 1024 * 1024, 1024, L == 0); if (DBG_DOUBLE & 512) ph_resid(lds, WSB(WS_OM), WSB(WS_WFO) + (size_t)L * 1024 * 1024, 1024, L == 0, 1); ph_resid(lds, WSB(WS_OM), WSB(WS_WFO) + (size_t)L * 1024 * 1024, 1024, L == 0); }
        SEAM(pb + 3);
        for (int sub = 0; sub < 2; ++sub) {
            const int layer = 2 * L + sub, cb = pb + 4 + 10 * sub;
            if (sub == 1) {
                if (IN(pb + 9)) ph_mla_a(lds, L);
                SEAM(pb + 9);
                if (IN(pb + 10)) { ph_fixup(KA, L); ph_mla_q(lds, L, 384);
                    ph_scale_gemm(lds, WSB(WS_CKVUB), WSB(WS_WMKV) + (size_t)L * 2048 * 256, MP, 2048, 256, (const float*)(ws_ptr() + WS_SSQKV), 4, 1, 1.0f / 256.0f, (bf16*)(ws_ptr() + WS_KVM), 1.0f); }
                SEAM(pb + 10);
                if (IN(pb + 11)) { REP(128) ph_mla_sample(lds, lds0, L); REP(32) ph_mla_attn(lds, lds0); }
                SEAM(pb + 11);
                if (IN(pb + 12)) REP(16) ph_mla_comb(lds, L);
                SEAM(pb + 12);
                if (IN(pb + 13)) { ph_thin_resid(KA, lds, WSB(WS_OM), WSB(WS_WMO) + (size_t)L * 1024 * 1024, 1024, 0); if (DBG_DOUBLE & 512) ph_resid(lds, WSB(WS_OM), WSB(WS_WMO) + (size_t)L * 1024 * 1024, 1024, 0, 1); ph_resid(lds, WSB(WS_OM), WSB(WS_WMO) + (size_t)L * 1024 * 1024, 1024, 0); }
                SEAM(pb + 13);
            }
            if (IN(cb)) { ph_thin_xq(KA, lds, WSB(WS_WXQ) + (size_t)layer * 1024 * 1024); ph_scale_gemm(lds, WSB(WS_XB), WSB(WS_WXQ) + (size_t)layer * 1024 * 1024, MP, 1024, 1024, (const float*)(ws_ptr() + WS_SSQ), 16, 4, 1.0f / 1024.0f, (bf16*)(ws_ptr() + WS_QX), C2_X); }
            SEAM(cb);
            if (IN(cb + 1)) REP(2) ph_cross(lds, lds0, layer);
            SEAM(cb + 1);
            if (IN(cb + 2)) { ph_thin_resid(KA, lds, WSB(WS_OM), WSB(WS_WXO) + (size_t)layer * 1024 * 1024, 1024, 0); if (DBG_DOUBLE & 4096) ph_resid(lds, WSB(WS_OM), WSB(WS_WXO) + (size_t)layer * 1024 * 1024, 1024, 0, 1); ph_resid(lds, WSB(WS_OM), WSB(WS_WXO) + (size_t)layer * 1024 * 1024, 1024, 0); }
            SEAM(cb + 2);
            if (IN(cb + 3)) { if (DBG_DOUBLE & 1024) ph_gu_null(lds, layer); REP(8) ph_gu(lds, layer); }
            SEAM(cb + 3);
            if (IN(cb + 4)) { ph_thin_resid(KA, lds, WSB(WS_HB), WSB(WS_WDN) + (size_t)layer * 1024 * 2816, DFF, 0); if (DBG_DOUBLE & 2048) ph_resid<true>(lds, WSB(WS_HB), WSB(WS_WDN) + (size_t)layer * 1024 * 2816, DFF, 0, 1); ph_resid<true>(lds, WSB(WS_HB), WSB(WS_WDN) + (size_t)layer * 1024 * 2816, DFF, 0); }
            SEAM(cb + 4);
        }
    }
    if (IN(40)) ph_final(KA);
#undef IN
#undef SEAM
}

#ifndef DBG_PH_HI
#define DBG_PH_HI NPH
#endif
#ifndef MK_PER_PHASE
#define MK_PER_PHASE 0
#endif
extern "C" void kernel_launch(void* const* d_in, const int* in_sizes, int n_in, void* d_out, int out_size, void* d_ws, size_t ws_size, hipStream_t stream) {
    static int grid = 0;
    if (grid == 0) {
        if (n_in != N_IN || (size_t)out_size != O_END || ws_size < WS_END) { fprintf(stderr, "kernel_launch: unexpected shapes (n_in %d, out %d, ws %zu; need %d, %zu, %zu)\n", n_in, out_size, ws_size, (int)N_IN, (size_t)O_END, (size_t)WS_END); grid = -1; return; }
        int dev = 0, cus = 0, per_cu = 0;
        if (hipGetDevice(&dev) != hipSuccess || hipDeviceGetAttribute(&cus, hipDeviceAttributeMultiprocessorCount, dev) != hipSuccess) { grid = -1; return; }
        if (hipFuncSetAttribute((const void*)fwd_kernel, hipFuncAttributeMaxDynamicSharedMemorySize, LDS_BYTES) != hipSuccess) { fprintf(stderr, "kernel_launch: hipFuncSetAttribute failed\n"); grid = -1; return; }
        if (hipOccupancyMaxActiveBlocksPerMultiprocessor(&per_cu, (const void*)fwd_kernel, NWAVES * 64, LDS_BYTES) != hipSuccess || per_cu < 1) { fprintf(stderr, "kernel_launch: occupancy query reports %d\n", per_cu); }
        (void)hipGetLastError();
        grid = cus;
    }
    if (grid < 0) return;
    if (hipMemsetAsync((char*)d_ws + WS_CTL, 0, CTL_ZERO_BYTES, stream) != hipSuccess) return;
    KArgs a{};
    for (int i = 0; i < N_IN; ++i) a.in[i] = (const float*)d_in[i];
    a.out = (float*)d_out; a.ws = (unsigned char*)d_ws;
#if MK_PER_PHASE
    for (int p = 0; p < NPH; ++p) { a.ph_lo = p; a.ph_hi = p + 1; hipLaunchKernelGGL(fwd_kernel, dim3(grid), dim3(NWAVES * 64), LDS_BYTES, stream, a); }
#else
    a.ph_lo = 0; a.ph_hi = DBG_PH_HI; hipLaunchKernelGGL(fwd_kernel, dim3(grid), dim3(NWAVES * 64), LDS_BYTES, stream, a);
#endif
}
```

```cpp
#include <hip/hip_runtime.h>
#include <cstdint>
#include <cstdio>
#include <cmath>

constexpr int D = 1024, MP = 32768, MS = 512, MT = MP + MS, SEQ = 4096, NBP = 8, NBS = 32, DSEQ = 16, PAST = 2048, NMEM = 256;
constexpr int DFF = 2816, KPAD = 2112;
constexpr float EPS = 1e-6f, LOG2E = 1.4426950408889634f;
constexpr float C2_FOX = 0.125f * LOG2E, C2_MLA = 0.10206207261596575f * LOG2E, C2_X = 0.0625f * LOG2E;

constexpr size_t O_Y = 0;
constexpr size_t O_FKP = (size_t)MT * D;
constexpr size_t O_FVP = O_FKP + (size_t)2 * MP * 1024;
constexpr size_t O_FLP = O_FVP + (size_t)2 * MP * 1024;
constexpr size_t O_MCP = O_FLP + (size_t)2 * MP * 16;
constexpr size_t O_MRP = O_MCP + (size_t)2 * MP * 256;
constexpr size_t O_MKP = O_MRP + (size_t)2 * MP * 32;
constexpr size_t O_MVP = O_MKP + (size_t)4 * 2048 * 1024;
constexpr size_t O_FKS = O_MVP + (size_t)4 * 2048 * 1024;
constexpr size_t O_FVS = O_FKS + (size_t)2 * MS * 1024;
constexpr size_t O_FLS = O_FVS + (size_t)2 * MS * 1024;
constexpr size_t O_MCS = O_FLS + (size_t)2 * MS * 16;
constexpr size_t O_MRS = O_MCS + (size_t)2 * MS * 256;
constexpr size_t O_END = O_MRS + (size_t)2 * MS * 32;

enum { I_XP = 0, I_XS, I_MEM, I_CFK, I_CFV, I_CFL, I_CCKV, I_CKR, I_CMK, I_CMV, I_GMIX, I_GCROSS, I_GMEM, I_GFFN, I_GFINAL,
       I_WFI, I_BFF, I_WFO, I_WMA, I_GMQ, I_GMKV, I_WMQB, I_WMKVB, I_WMO, I_WXQ, I_WXKV, I_WXO, I_WGU, I_WDN, N_IN };


constexpr size_t al256(size_t x) { return (x + 255) & ~(size_t)255; }
constexpr size_t WS_CTL = 0, CTL_ZERO_BYTES = 1u << 20;
constexpr size_t WS_WFI = 2u << 20;
constexpr size_t WS_WFO = WS_WFI + (size_t)2 * 4352 * 1024 * 2;
constexpr size_t WS_WMA = WS_WFO + (size_t)2 * 1024 * 1024 * 2;
constexpr size_t WS_WMQ = WS_WMA + (size_t)2 * 768 * 1024 * 2;
constexpr size_t WS_WMKV = WS_WMQ + (size_t)2 * 1536 * 384 * 2;
constexpr size_t WS_WMKVR = WS_WMKV + (size_t)2 * 2048 * 256 * 2;
constexpr size_t WS_WKN = WS_WMKVR + (size_t)2 * 2048 * 256 * 2;
constexpr size_t WS_WMO = WS_WKN + (size_t)2 * 256 * 2048 * 2;
constexpr size_t WS_WXQ = WS_WMO + (size_t)2 * 1024 * 1024 * 2;
constexpr size_t WS_WXO = WS_WXQ + (size_t)4 * 1024 * 1024 * 2;
constexpr size_t WS_WXKV = WS_WXO + (size_t)4 * 1024 * 1024 * 2;
constexpr size_t WS_WGU = WS_WXKV + (size_t)4 * 2048 * 1024 * 2;
constexpr size_t WS_WDN = WS_WGU + (size_t)4 * 5632 * 1024 * 2;
constexpr size_t WS_WFF = WS_WDN + (size_t)4 * 1024 * 2816 * 2;
constexpr size_t WS_ROPC = WS_WFF + (size_t)2 * 16 * 1024 * 4;
constexpr size_t WS_ROPS = WS_ROPC + (size_t)4096 * 16 * 4;
constexpr size_t WS_XB = WS_ROPS + (size_t)4096 * 16 * 4;
constexpr size_t WS_SSQ = WS_XB + (size_t)MT * 1024 * 2;
constexpr size_t WS_R1 = al256(WS_SSQ + (size_t)MT * 16 * 4);
constexpr size_t SZ_ACT = (size_t)MT * 1024 * 2;
constexpr size_t WS_QF = WS_R1, WS_KF = WS_R1 + SZ_ACT, WS_VF = WS_R1 + 2 * SZ_ACT, WS_GF = WS_R1 + 3 * SZ_ACT;
constexpr size_t WS_QM = WS_R1, WS_KVM = al256(WS_R1 + (size_t)MT * 1536 * 2);
static_assert(WS_KVM + (size_t)MP * 2048 * 2 <= WS_R1 + 4 * SZ_ACT, "MLA overlay fits");
constexpr size_t WS_OM = WS_R1 + 4 * SZ_ACT;
constexpr size_t WS_LFR = WS_OM + SZ_ACT;
constexpr size_t WS_CB = WS_LFR + (size_t)MT * 16 * 4;
constexpr size_t WS_CBS = WS_CB + (size_t)8 * 16 * 4096 * 4;
constexpr size_t WS_CKVU = al256(WS_CBS + (size_t)32 * 16 * 2080 * 4);
constexpr size_t WS_CKVUB = WS_CKVU + (size_t)MT * 256 * 4;
constexpr size_t WS_SSQKV = WS_CKVUB + (size_t)MT * 256 * 2;
constexpr size_t WS_CQ = WS_SSQKV + (size_t)MT * 4 * 4;
constexpr size_t WS_SSQQ = WS_CQ + (size_t)MT * 384 * 2;
constexpr size_t WS_KRB = WS_SSQQ + (size_t)MT * 8 * 4;
constexpr size_t WS_QA = al256(WS_KRB + (size_t)MT * 32 * 2);
constexpr size_t WS_PART = al256(WS_QA + (size_t)288 * 256 * 288 * 2);
constexpr size_t WS_QX = al256(WS_PART + (size_t)32 * 9 * 256 * 264 * 4);
constexpr size_t WS_MB = WS_QX + SZ_ACT;
constexpr size_t WS_MKB = WS_MB + (size_t)2048 * 1024 * 2;
constexpr size_t WS_MVB = WS_MKB + (size_t)4 * 2048 * 1024 * 2;
constexpr size_t WS_HB = WS_MVB + (size_t)4 * 2048 * 1024 * 2;
constexpr size_t WS_END = WS_HB + (size_t)MT * DFF * 2;
constexpr int CW_BAR = 4096;

namespace pg8 {
#define PG8_LAS __attribute__((address_space(3)))
typedef unsigned short bf16_t;
typedef short bf16x8 __attribute__((ext_vector_type(8)));
typedef float f32x4 __attribute__((ext_vector_type(4)));
typedef unsigned u32x4 __attribute__((ext_vector_type(4)));
constexpr int BM = 256, BK = 64, HALF = 128, HTB = HALF * BK * 2  , STAGE_BYTES = 8 * HTB, NXCD = 8, WGM = 8;

__host__ __device__ __forceinline__ int lds_byte(int r, int c) { const int st = (r >> 4) * 2 + (c >> 5), rr = r & 15, cc = c & 31, ob = rr * 64 + cc * 2; return st * 1024 + (ob ^ (((ob >> 9) & 1) << 5)); }
__host__ __device__ __forceinline__ void stage_rc(int b, int& R, int& C) { const int st = b / 1024, sb = b % 1024, swz = sb ^ (((sb >> 9) & 1) << 5); R = (st >> 1) * 16 + swz / 64; C = (st & 1) * 32 + (swz % 64) / 2; }
__host__ __device__ __forceinline__ int perm32(int rho) { const int n = rho >> 4, i = rho & 15; return 8 * (i >> 2) + 4 * n + (i & 3); }

struct Unit { int pm, pn; };
struct Gemm { const bf16_t* A; const bf16_t* Bt; int M, N, K; };

struct StaticOrder {
    int nM, nN, nwg, G, c;
    __host__ __device__ void init(int M, int N, int G_, int c_) { nM = M / BM; nN = N / BM; nwg = nM * nN; G = G_; c = c_; }
    __host__ __device__ bool next(int i, Unit& u) const {
        const long L = (long)i * G + c; if (L >= nwg) return false;
        int wgid = (int)L; { const int q = nwg / NXCD, r = nwg % NXCD, xcd = wgid % NXCD, off = wgid / NXCD; wgid = (xcd < r ? xcd * (q + 1) : r * (q + 1) + (xcd - r) * q) + off; }
        const int nig = WGM * nN, gid = wgid / nig, fm = gid * WGM, gsz = (nM - fm) < WGM ? (nM - fm) : WGM;
        u.pm = fm + ((wgid % nig) % gsz); u.pn = (wgid % nig) / gsz; return true;
    }
    __device__ __forceinline__ void a_ready(const Unit&) const {}
    __device__ __forceinline__ void done(const Unit&) const {}
};

typedef unsigned u32x2 __attribute__((ext_vector_type(2)));
typedef float f32x2v __attribute__((ext_vector_type(2)));
typedef __bf16 bf16x2_t __attribute__((ext_vector_type(2)));
__device__ __forceinline__ unsigned pk_bf16(float lo, float hi) { f32x2v v = {lo, hi}; bf16x2_t b = __builtin_convertvector(v, bf16x2_t); return __builtin_bit_cast(unsigned, b); }
__device__ __forceinline__ u32x2 pk4(f32x4 v) { u32x2 w; w.x = pk_bf16(v[0], v[1]); w.y = pk_bf16(v[2], v[3]); return w; }
__device__ __forceinline__ float dot4(f32x4 v) { return (v[0] * v[0] + v[1] * v[1]) + (v[2] * v[2] + v[3] * v[3]); }
__device__ __forceinline__ float sigm(float z) { return __builtin_amdgcn_rcpf(1.0f + __builtin_amdgcn_exp2f(-z * LOG2E)); }
#define EPI_FENCE() asm volatile("" ::: "memory")
__device__ __forceinline__ int pg8_tid() { int t = threadIdx.x; asm volatile("" : "+v"(t)); return t; }

struct RowScale { const float* p; int stride; int ngrp; float inv_n;
    __device__ __forceinline__ float get(int row, int fq) const {
        float s = 0.f; if (fq < ngrp) { const f32x4 v = *(const f32x4*)(p + (size_t)row * stride + 4 * fq); s = (v[0] + v[1]) + (v[2] + v[3]); }
        s += __shfl_xor(s, 16); s += __shfl_xor(s, 32); return rsqrtf(s * inv_n + EPS); }
    __device__ __forceinline__ void get8(int row0, int fq, float (&r)[2][4]) const {
        float s[2][4];
#pragma unroll
        for (int ai = 0; ai < 2; ++ai)
#pragma unroll
            for (int m = 0; m < 4; ++m) { s[ai][m] = 0.f; if (fq < ngrp) { const f32x4 v = *(const f32x4*)(p + (size_t)(row0 + ai * HALF + m * 16) * stride + 4 * fq); s[ai][m] = (v[0] + v[1]) + (v[2] + v[3]); } }
#pragma unroll
        for (int ai = 0; ai < 2; ++ai)
#pragma unroll
            for (int m = 0; m < 4; ++m) { float t = s[ai][m]; t += __shfl_xor(t, 16); t += __shfl_xor(t, 32); r[ai][m] = rsqrtf(t * inv_n + EPS); }
    } };
__device__ __forceinline__ int row_pos(int row) { return row < MP ? (row & (SEQ - 1)) : PAST + ((row - MP) & (DSEQ - 1)); }

struct EpiFoxIn { static constexpr bool PERM = false, AFTER_DRAIN = false;
    RowScale rs; unsigned char* ws; float* out; const float* bff; int L;
    __device__ __forceinline__ void operator()(const f32x4 (&acc)[2][2][4][2], const Unit& u, int wr, int wc, int, int) const { const int lane_ = pg8_tid() & 63, fr = lane_ & 15, fq = lane_ >> 4; float rsv[2][4]; rs.get8(u.pm * BM + wr * 64 + fr, fq, rsv);
        const int typ = u.pn >> 2, colt = (u.pn & 3) * 256 + wc * 32 + 4 * fq;
        bf16_t* QF = (bf16_t*)(ws + WS_QF); float* kp = out + O_FKP + (size_t)L * MP * 1024; float* ks = out + O_FKS + (size_t)L * MS * 1024;
#pragma unroll
        for (int ai = 0; ai < 2; ++ai)
#pragma unroll
            for (int m = 0; m < 4; ++m) { const int row = u.pm * BM + ai * HALF + wr * 64 + m * 16 + fr; float r = rsv[ai][m];
                if (typ == 0) { r *= C2_FOX;
#pragma unroll
                    for (int bj = 0; bj < 2; ++bj)
#pragma unroll
                        for (int n = 0; n < 2; ++n) *(u32x2*)(QF + (size_t)row * 1024 + colt + bj * HALF + n * 16) = pk4(acc[ai][bj][m][n] * r);
                } else if (typ == 3) {
#pragma unroll
                    for (int bj = 0; bj < 2; ++bj)
#pragma unroll
                        for (int n = 0; n < 2; ++n) { f32x4 v = acc[ai][bj][m][n] * r; v[0] = sigm(v[0]); v[1] = sigm(v[1]); v[2] = sigm(v[2]); v[3] = sigm(v[3]);
                            *(u32x2*)(QF + 3 * (SZ_ACT / 2) + (size_t)row * 1024 + colt + bj * HALF + n * 16) = pk4(v); }
                } else if (typ == 4) {
                    if (wc == 0) { const f32x4 bb = *(const f32x4*)(bff + 4 * fq); f32x4 lf;
#pragma unroll
                        for (int i = 0; i < 4; ++i) { const float z = acc[ai][0][m][0][i] * r + bb[i]; lf[i] = fminf(z, 0.f) - log1pf(expf(-fabsf(z))); }
                        *(f32x4*)((float*)(ws + WS_LFR) + (size_t)row * 16 + 4 * fq) = lf;
                        float* F = (row < MP) ? out + O_FLP + ((size_t)L * MP + row) * 16 : out + O_FLS + ((size_t)L * MS + (row - MP)) * 16;
                        *(f32x4*)(F + 4 * fq) = lf; }
                } else { bf16_t* B = QF + (size_t)typ * (SZ_ACT / 2);
                    float* F = (row < MP) ? kp + (size_t)(typ - 1) * 2 * MP * 1024 + (size_t)row * 1024 : ks + (size_t)(typ - 1) * 2 * MS * 1024 + (size_t)(row - MP) * 1024;
#pragma unroll
                    for (int bj = 0; bj < 2; ++bj)
#pragma unroll
                        for (int n = 0; n < 2; ++n) { const f32x4 v = acc[ai][bj][m][n] * r; const int c = colt + bj * HALF + n * 16;
                            *(f32x4*)(F + c) = v; *(u32x2*)(B + (size_t)row * 1024 + c) = pk4(v); }
                }
                if (m & 1) EPI_FENCE(); }
    }
};
struct EpiResid { static constexpr bool PERM = true, AFTER_DRAIN = false;
    const float* xin_p; const float* xin_s; int first; bf16_t* xb; float* ssq;
    __device__ __forceinline__ void operator()(const f32x4 (&acc)[2][2][4][2], const Unit& u, int wr, int wc, int, int) const { const int lane_ = pg8_tid() & 63, fr = lane_ & 15, fq = lane_ >> 4;
        const int col0 = u.pn * BM + wc * 32 + 8 * fq;
        if (first) {
#pragma unroll
        for (int ai = 0; ai < 2; ++ai) {
            f32x4 xo[4][2][2];
#pragma unroll
            for (int m = 0; m < 4; ++m) { const int row = u.pm * BM + ai * HALF + wr * 64 + m * 16 + fr;
                const float* xi = (row < MP) ? xin_p + (size_t)row * 1024 : xin_s + (size_t)(row - MP) * 1024;
#pragma unroll
                for (int bj = 0; bj < 2; ++bj)
#pragma unroll
                    for (int n = 0; n < 2; ++n) xo[m][bj][n] = *(const f32x4*)(xi + col0 + bj * HALF + n * 4); }
#pragma unroll
            for (int m = 0; m < 4; ++m) { const int row = u.pm * BM + ai * HALF + wr * 64 + m * 16 + fr; float sq = 0.f;
#pragma unroll
                for (int bj = 0; bj < 2; ++bj) { const int c = col0 + bj * HALF; const f32x4 x0 = xo[m][bj][0] + acc[ai][bj][m][0], x1 = xo[m][bj][1] + acc[ai][bj][m][1];
                    sq += dot4(x0) + dot4(x1);
                    const u32x2 w0 = pk4(x0), w1 = pk4(x1); *(u32x4*)(xb + (size_t)row * 1024 + c) = (u32x4){w0.x, w0.y, w1.x, w1.y}; }
                sq += __shfl_xor(sq, 16); sq += __shfl_xor(sq, 32);
                if (fq == 0) ssq[(size_t)row * 16 + u.pn * 4 + wc] = sq; }
            EPI_FENCE(); }
        } else {
            u32x4 raw[2][4][2];
#pragma unroll
            for (int ai = 0; ai < 2; ++ai)
#pragma unroll
                for (int m = 0; m < 4; ++m) { const int row = u.pm * BM + ai * HALF + wr * 64 + m * 16 + fr;
#pragma unroll
                    for (int bj = 0; bj < 2; ++bj) raw[ai][m][bj] = *(const u32x4*)(xb + (size_t)row * 1024 + col0 + bj * HALF); }
            EPI_FENCE();
#pragma unroll
            for (int ai = 0; ai < 2; ++ai) {
#pragma unroll
                for (int m = 0; m < 4; ++m) { const int row = u.pm * BM + ai * HALF + wr * 64 + m * 16 + fr; float sq = 0.f;
#pragma unroll
                    for (int bj = 0; bj < 2; ++bj) { const int c = col0 + bj * HALF; const u32x4 w = raw[ai][m][bj];
                        const f32x4 x0 = (f32x4){__builtin_bit_cast(float, w.x << 16), __builtin_bit_cast(float, w.x & 0xffff0000u), __builtin_bit_cast(float, w.y << 16), __builtin_bit_cast(float, w.y & 0xffff0000u)} + acc[ai][bj][m][0];
                        const f32x4 x1 = (f32x4){__builtin_bit_cast(float, w.z << 16), __builtin_bit_cast(float, w.z & 0xffff0000u), __builtin_bit_cast(float, w.w << 16), __builtin_bit_cast(float, w.w & 0xffff0000u)} + acc[ai][bj][m][1];
                        sq += dot4(x0) + dot4(x1);
                        const u32x2 w0 = pk4(x0), w1 = pk4(x1); *(u32x4*)(xb + (size_t)row * 1024 + c) = (u32x4){w0.x, w0.y, w1.x, w1.y}; }
                    sq += __shfl_xor(sq, 16); sq += __shfl_xor(sq, 32);
                    if (fq == 0) ssq[(size_t)row * 16 + u.pn * 4 + wc] = sq; }
                EPI_FENCE(); } }
    }
};
struct EpiScaleBf16 { static constexpr bool PERM = true, AFTER_DRAIN = false;
    RowScale rs; bf16_t* O; int ldc; float scale;
    __device__ __forceinline__ void operator()(const f32x4 (&acc)[2][2][4][2], const Unit& u, int wr, int wc, int, int) const { const int lane_ = pg8_tid() & 63, fr = lane_ & 15, fq = lane_ >> 4; float rsv[2][4]; rs.get8(u.pm * BM + wr * 64 + fr, fq, rsv);
        const int col0 = u.pn * BM + wc * 32 + 8 * fq;
#pragma unroll
        for (int ai = 0; ai < 2; ++ai)
#pragma unroll
            for (int m = 0; m < 4; ++m) { const int row = u.pm * BM + ai * HALF + wr * 64 + m * 16 + fr; const float r = rsv[ai][m] * scale;
#pragma unroll
                for (int bj = 0; bj < 2; ++bj) { const u32x2 w0 = pk4(acc[ai][bj][m][0] * r), w1 = pk4(acc[ai][bj][m][1] * r);
                    *(u32x4*)(O + (size_t)row * ldc + col0 + bj * HALF) = (u32x4){w0.x, w0.y, w1.x, w1.y}; }
                if (m & 1) EPI_FENCE(); }
    }
};
struct EpiSwiglu { static constexpr bool PERM = true, AFTER_DRAIN = false;
    RowScale rs; bf16_t* HB;
    __device__ __forceinline__ void operator()(const f32x4 (&acc)[2][2][4][2], const Unit& u, int wr, int wc, int, int) const { const int lane_ = pg8_tid() & 63, fr = lane_ & 15, fq = lane_ >> 4; float rsv[2][4]; rs.get8(u.pm * BM + wr * 64 + fr, fq, rsv);
        const int col0 = u.pn * HALF + wc * 32 + 8 * fq;
        const bool blk = u.pm < MP / BM; const int rstr = blk ? 128 : DFF * 2;
        const size_t hb0 = blk ? ((size_t)(u.pm * (DFF / 64) + (col0 >> 6)) * 32768 + (size_t)(col0 & 63) * 2) : ((size_t)u.pm * BM * DFF + col0) * 2;
#pragma unroll
        for (int ai = 0; ai < 2; ++ai)
#pragma unroll
            for (int m = 0; m < 4; ++m) { const int row = u.pm * BM + ai * HALF + wr * 64 + m * 16 + fr; const float r = rsv[ai][m]; u32x4 w;
#pragma unroll
                for (int n = 0; n < 2; ++n) { const f32x4 g = acc[ai][0][m][n] * r, uu = acc[ai][1][m][n] * r; f32x4 h;
#pragma unroll
                    for (int i = 0; i < 4; ++i) h[i] = g[i] * sigm(g[i]) * uu[i];
                    const u32x2 hw = pk4(h); if (n == 0) { w.x = hw.x; w.y = hw.y; } else { w.z = hw.x; w.w = hw.y; } }
                *(u32x4*)((char*)HB + hb0 + (size_t)(row - u.pm * BM) * rstr) = w;
                if (m & 1) EPI_FENCE(); }
    }
};
struct EpiMlaA { static constexpr bool PERM = false, AFTER_DRAIN = false;
    RowScale rs; float* ckvu; bf16_t* ckvub; float* ssqkv; bf16_t* cq; float* ssqq; bf16_t* krb; float *mrp, *mrs; const float *ropc, *rops;
    __device__ __forceinline__ void operator()(const f32x4 (&acc)[2][2][4][2], const Unit& u, int wr, int wc, int, int) const { const int lane_ = pg8_tid() & 63, fr = lane_ & 15, fq = lane_ >> 4; float rsv[2][4]; rs.get8(u.pm * BM + wr * 64 + fr, fq, rsv);
        const int cw = wc * 32 + 4 * fq;
#pragma unroll
        for (int ai = 0; ai < 2; ++ai)
#pragma unroll
            for (int m = 0; m < 4; ++m) { const int row = u.pm * BM + ai * HALF + wr * 64 + m * 16 + fr; const float r = rsv[ai][m];
                if (u.pn == 0) { float sq = 0.f;
#pragma unroll
                    for (int bj = 0; bj < 2; ++bj)
#pragma unroll
                        for (int n = 0; n < 2; ++n) { const int c = cw + bj * HALF + n * 16; const f32x4 v = acc[ai][bj][m][n] * r;
                            *(f32x4*)(ckvu + (size_t)row * 256 + c) = v; *(u32x2*)(ckvub + (size_t)row * 256 + c) = pk4(v); sq += dot4(v); }
                    sq += __shfl_xor(sq, 16); sq += __shfl_xor(sq, 32); if (fq == 0) ssqkv[(size_t)row * 4 + wc] = sq;
                } else if (u.pn == 1) { float sq = 0.f;
#pragma unroll
                    for (int bj = 0; bj < 2; ++bj)
#pragma unroll
                        for (int n = 0; n < 2; ++n) { const int c = cw + bj * HALF + n * 16; const f32x4 v = acc[ai][bj][m][n] * r;
                            *(u32x2*)(cq + (size_t)row * 384 + c) = pk4(v); sq += dot4(v); }
                    sq += __shfl_xor(sq, 16); sq += __shfl_xor(sq, 32); if (fq == 0) ssqq[(size_t)row * 8 + wc] = sq;
                } else { float sq = 0.f;
#pragma unroll
                    for (int n = 0; n < 2; ++n) { const int c = 256 + cw + n * 16; const f32x4 v = acc[ai][0][m][n] * r;
                        *(u32x2*)(cq + (size_t)row * 384 + c) = pk4(v); sq += dot4(v); }
                    sq += __shfl_xor(sq, 16); sq += __shfl_xor(sq, 32); if (fq == 0) ssqq[(size_t)row * 8 + 4 + wc] = sq;
                    if (wc == 0) { const int pos = row_pos(row); const f32x4 cs = *(const f32x4*)(ropc + pos * 16 + 4 * fq), sn = *(const f32x4*)(rops + pos * 16 + 4 * fq);
                        const f32x4 x1 = acc[ai][1][m][0] * r, x2 = acc[ai][1][m][1] * r; const f32x4 o1 = x1 * cs - x2 * sn, o2 = x1 * sn + x2 * cs;
                        *(u32x2*)(krb + (size_t)row * 32 + 4 * fq) = pk4(o1); *(u32x2*)(krb + (size_t)row * 32 + 16 + 4 * fq) = pk4(o2);
                        float* F = (row < MP) ? mrp + (size_t)row * 32 : mrs + (size_t)(row - MP) * 32;
                        *(f32x4*)(F + 4 * fq) = o1; *(f32x4*)(F + 16 + 4 * fq) = o2; }
                }
                if (m & 1) EPI_FENCE(); }
    }
};
struct EpiMlaQ { static constexpr bool PERM = false, AFTER_DRAIN = false;
    RowScale rs; bf16_t* QM; const float *ropc, *rops;
    __device__ __forceinline__ void operator()(const f32x4 (&acc)[2][2][4][2], const Unit& u, int wr, int wc, int, int) const { const int lane_ = pg8_tid() & 63, fr = lane_ & 15, fq = lane_ >> 4; float rsv[2][4]; rs.get8(u.pm * BM + wr * 64 + fr, fq, rsv);
#pragma unroll
        for (int ai = 0; ai < 2; ++ai)
#pragma unroll
            for (int m = 0; m < 4; ++m) { const int row = u.pm * BM + ai * HALF + wr * 64 + m * 16 + fr; const float r = rsv[ai][m] * C2_MLA;
                const int pos = row_pos(row);
#pragma unroll
                for (int bj = 0; bj < 2; ++bj) { const int g32 = u.pn * 8 + bj * 4 + wc; const int c = g32 * 32 + 4 * fq; bf16_t* o = QM + (size_t)row * 1536 + c;
                    if ((g32 % 3) == 2) { const f32x4 cs = *(const f32x4*)(ropc + pos * 16 + 4 * fq), sn = *(const f32x4*)(rops + pos * 16 + 4 * fq);
                        const f32x4 x1 = acc[ai][bj][m][0] * r, x2 = acc[ai][bj][m][1] * r;
                        *(u32x2*)(o) = pk4(x1 * cs - x2 * sn); *(u32x2*)(o + 16) = pk4(x1 * sn + x2 * cs);
                    } else { *(u32x2*)(o) = pk4(acc[ai][bj][m][0] * r); *(u32x2*)(o + 16) = pk4(acc[ai][bj][m][1] * r); } }
                EPI_FENCE(); }
    }
};
struct EpiNull { static constexpr bool PERM = true, AFTER_DRAIN = false;
    __device__ __forceinline__ void operator()(const f32x4 (&acc)[2][2][4][2], const Unit&, int, int, int, int) const {
#pragma unroll
        for (int ai = 0; ai < 2; ++ai)
#pragma unroll
            for (int bj = 0; bj < 2; ++bj)
#pragma unroll
                for (int m = 0; m < 4; ++m)
#pragma unroll
                    for (int n = 0; n < 2; ++n) asm volatile("" :: "v"(acc[ai][bj][m][n])); }
};
struct EpiMemKV { static constexpr bool PERM = false, AFTER_DRAIN = false;
    float* outk; float* outv; bf16_t* MKB; bf16_t* MVB;
    __device__ __forceinline__ void operator()(const f32x4 (&acc)[2][2][4][2], const Unit& u, int wr, int wc, int, int) const { const int lane_ = pg8_tid() & 63, fr = lane_ & 15, fq = lane_ >> 4;
        const int l = u.pn >> 3, cw0 = (u.pn & 7) * 256; const bool isv = cw0 >= 1024; const int cbase = (cw0 & 1023) + wc * 32 + 4 * fq;
#pragma unroll
        for (int ai = 0; ai < 2; ++ai)
#pragma unroll
            for (int m = 0; m < 4; ++m) { const int row = u.pm * BM + ai * HALF + wr * 64 + m * 16 + fr; const int b = row >> 8, nn = row & 255;
#pragma unroll
                for (int bj = 0; bj < 2; ++bj)
#pragma unroll
                    for (int n = 0; n < 2; ++n) { const int c = cbase + bj * HALF + n * 16; const f32x4 v = acc[ai][bj][m][n]; const size_t o = ((size_t)l * 2048 + row) * 1024 + c;
                        if (!isv) { *(f32x4*)(outk + o) = v; *(u32x2*)(MKB + o) = pk4(v); } else { *(f32x4*)(outv + o) = v; *(u32x2*)(MVB + o) = pk4(v); } }
                if (m & 1) EPI_FENCE(); }
    }
};

template <class Epi, class Sched, bool ALIGN_EPI = false, bool SP2 = false, bool ABLK = false>
__device__ __forceinline__ void gemm_phase(PG8_LAS unsigned char* lds, const Gemm g, const Sched& S, const Epi& E) {
    const int tid = pg8_tid(), wid = __builtin_amdgcn_readfirstlane(tid >> 6), lane = tid & 63, wr = wid >> 2, wc = wid & 3, fr = lane & 15, fq = lane >> 4;
    const int K = g.K, nt = K / BK;
    unsigned voffA[2], voffB[2];
#pragma unroll
    for (int i = 0; i < 2; ++i) { int R, C; stage_rc(tid * 16 + i * 8192, R, C); const int Rb = Epi::PERM ? ((R & ~31) + perm32(R & 31)) : R;
        voffA[i] = ABLK ? (unsigned)(R * BK + C) * 2u : (unsigned)(R * K + C) * 2u; voffB[i] = (unsigned)(Rb * K + C) * 2u; }
    const size_t kstep = (size_t)(BK * 2);
    const size_t hstep = (size_t)HALF * K * 2;
    const size_t tstep = 2 * hstep;
    const size_t kstepA = ABLK ? (size_t)BM * BK * 2 : kstep, hstepA = ABLK ? (size_t)HALF * BK * 2 : hstep, tstepA = ABLK ? (size_t)nt * BM * BK * 2 : tstep;
    const unsigned ldsw = (unsigned)wid * 1024u;
    const int aoff = lds_byte(wr * 64 + fr, fq * 8), boff = lds_byte(wc * 32 + fr, fq * 8);
#define PG8_SA(b, h) (((b) * 2 + (h)) * HTB)
#define PG8_SB(b, h) ((4 + (b) * 2 + (h)) * HTB)
#define PG8_STAGE(bufoff, gbase, voff) do { _Pragma("unroll") for (int _i = 0; _i < 2; ++_i) \
        __builtin_amdgcn_global_load_lds((const unsigned*)((const char*)(gbase) + (voff)[_i]), (PG8_LAS unsigned*)(lds + (bufoff) + ldsw + _i * 8192), 16, 0, 0); } while (0)
#define PG8_LDA(dst, b, h) do { _Pragma("unroll") for (int m = 0; m < 4; ++m) _Pragma("unroll") for (int k = 0; k < 2; ++k) dst[m][k] = *(const PG8_LAS bf16x8*)(lds + PG8_SA(b, h) + aoff + m * 2048 + k * 1024); } while (0)
#define PG8_LDB(dst, b, h) do { _Pragma("unroll") for (int n = 0; n < 2; ++n) _Pragma("unroll") for (int k = 0; k < 2; ++k) dst[n][k] = *(const PG8_LAS bf16x8*)(lds + PG8_SB(b, h) + boff + n * 2048 + k * 1024); } while (0)
#define PG8_MMA(ai, bj, At, Bt) do { __builtin_amdgcn_s_setprio(1); _Pragma("unroll") for (int m = 0; m < 4; ++m) _Pragma("unroll") for (int n = 0; n < 2; ++n) _Pragma("unroll") for (int k = 0; k < 2; ++k) \
        acc[ai][bj][m][n] = __builtin_amdgcn_mfma_f32_16x16x32_bf16(Bt[n][k], At[m][k], acc[ai][bj][m][n], 0, 0, 0); __builtin_amdgcn_s_setprio(0); } while (0)
#define PG8_WAIT_V(n) asm volatile("s_waitcnt vmcnt(" #n ")" ::: "memory")
#define PG8_WAIT_L(n) asm volatile("s_waitcnt lgkmcnt(" #n ")" ::: "memory")
#define PG8_BAR __builtin_amdgcn_s_barrier()
#define PG8_SCHED __builtin_amdgcn_sched_barrier(0)
    Unit cur, nxt; int ui = 0;
    if (!S.next(0, cur)) return;
    f32x4 acc[2][2][4][2];
#pragma unroll
    for (int a = 0; a < 2; ++a)
#pragma unroll
        for (int b = 0; b < 2; ++b)
#pragma unroll
            for (int m = 0; m < 4; ++m)
#pragma unroll
                for (int n = 0; n < 2; ++n) acc[a][b][m][n] = (f32x4){0.f, 0.f, 0.f, 0.f};
    bf16x8 At[4][2], B0[2][2], B1[2][2];
    const char* cA = (const char*)g.A + (size_t)cur.pm * tstepA; const char* cB = (const char*)g.Bt + (size_t)cur.pn * tstep;
    S.a_ready(cur);
    if constexpr (SP2) {
        PG8_STAGE(PG8_SB(0, 0), cB, voffB); PG8_STAGE(PG8_SB(0, 1), cB + hstep, voffB); PG8_STAGE(PG8_SA(0, 0), cA, voffA); PG8_STAGE(PG8_SA(0, 1), cA + hstepA, voffA);
        if (wr == 1) PG8_BAR;
        PG8_WAIT_V(2); PG8_BAR;
        PG8_STAGE(PG8_SB(1, 0), cB + kstep, voffB); PG8_STAGE(PG8_SA(1, 0), cA + kstepA, voffA); PG8_STAGE(PG8_SB(1, 1), cB + hstep + kstep, voffB);
        PG8_WAIT_V(6); PG8_BAR;
    } else {
        PG8_STAGE(PG8_SB(0, 0), cB, voffB); PG8_STAGE(PG8_SA(0, 0), cA, voffA); PG8_STAGE(PG8_SB(0, 1), cB + hstep, voffB); PG8_STAGE(PG8_SA(0, 1), cA + hstepA, voffA);
        if (wr == 1) PG8_BAR;
        PG8_WAIT_V(4); PG8_BAR;
        PG8_STAGE(PG8_SB(1, 0), cB + kstep, voffB); PG8_STAGE(PG8_SA(1, 0), cA + kstepA, voffA); PG8_STAGE(PG8_SB(1, 1), cB + hstep + kstep, voffB);
        PG8_WAIT_V(6); PG8_BAR;
    }
    for (;;) {
        const bool has_next = S.next(ui + 1, nxt);
        const char* nA = has_next ? (const char*)g.A + (size_t)nxt.pm * tstepA : cA; const char* nB = has_next ? (const char*)g.Bt + (size_t)nxt.pn * tstep : cB;
        for (int t = 0; t < nt; t += 2) {
            const bool last = (t == nt - 2);
            const char* a1 = cA + (size_t)(t + 1) * kstepA;
            const char* a2 = last ? nA : cA + (size_t)(t + 2) * kstepA; const char* b2 = last ? nB : cB + (size_t)(t + 2) * kstep;
            const char* a3 = a2 + kstepA; const char* b3 = b2 + kstep;
            if (last && has_next) S.a_ready(nxt);
            if constexpr (SP2) {
            PG8_LDB(B0, 0, 0); PG8_LDB(B1, 0, 1); PG8_SCHED; PG8_LDA(At, 0, 0); PG8_STAGE(PG8_SA(1, 1), a1 + hstepA, voffA);
            PG8_WAIT_V(8); PG8_WAIT_L(0); PG8_BAR; PG8_MMA(0, 0, At, B0); PG8_MMA(0, 1, At, B1); PG8_BAR; PG8_SCHED;
            PG8_LDA(At, 0, 1); PG8_STAGE(PG8_SB(0, 0), b2, voffB); PG8_STAGE(PG8_SB(0, 1), b2 + hstep, voffB); PG8_STAGE(PG8_SA(0, 0), a2, voffA);
            PG8_WAIT_V(8); PG8_WAIT_L(0); PG8_BAR; PG8_MMA(1, 0, At, B0); PG8_MMA(1, 1, At, B1); PG8_BAR; PG8_SCHED;
            PG8_LDB(B0, 1, 0); PG8_LDB(B1, 1, 1); PG8_SCHED; PG8_LDA(At, 1, 0); PG8_STAGE(PG8_SA(0, 1), a2 + hstepA, voffA);
            PG8_WAIT_V(8); PG8_WAIT_L(0); PG8_BAR; PG8_MMA(0, 0, At, B0); PG8_MMA(0, 1, At, B1); PG8_BAR; PG8_SCHED;
            PG8_LDA(At, 1, 1); PG8_STAGE(PG8_SB(1, 0), b3, voffB); PG8_STAGE(PG8_SB(1, 1), b3 + hstep, voffB); PG8_STAGE(PG8_SA(1, 0), a3, voffA);
            PG8_WAIT_V(8); PG8_WAIT_L(0); PG8_BAR; PG8_MMA(1, 0, At, B0); PG8_MMA(1, 1, At, B1); PG8_BAR; PG8_SCHED;
            } else {
            PG8_LDB(B0, 0, 0); PG8_SCHED; PG8_LDA(At, 0, 0); PG8_STAGE(PG8_SA(1, 1), a1 + hstepA, voffA);
            PG8_WAIT_L(8); PG8_BAR; PG8_WAIT_L(0); PG8_MMA(0, 0, At, B0); PG8_BAR; PG8_SCHED;
            PG8_LDB(B1, 0, 1); PG8_STAGE(PG8_SB(0, 0), b2, voffB);
            PG8_BAR; PG8_WAIT_L(0); PG8_MMA(0, 1, At, B1); PG8_BAR;
            PG8_LDA(At, 0, 1); PG8_STAGE(PG8_SA(0, 0), a2, voffA);
            PG8_BAR; PG8_WAIT_L(0); PG8_MMA(1, 0, At, B0); PG8_BAR; PG8_SCHED;
            PG8_STAGE(PG8_SB(0, 1), b2 + hstep, voffB);
            PG8_WAIT_V(6); PG8_BAR; PG8_MMA(1, 1, At, B1); PG8_BAR;
            PG8_LDB(B0, 1, 0); PG8_SCHED; PG8_LDA(At, 1, 0); PG8_STAGE(PG8_SA(0, 1), a2 + hstepA, voffA);
            PG8_WAIT_L(8); PG8_BAR; PG8_WAIT_L(0); PG8_MMA(0, 0, At, B0); PG8_BAR; PG8_SCHED;
            PG8_LDB(B1, 1, 1); PG8_STAGE(PG8_SB(1, 0), b3, voffB);
            PG8_BAR; PG8_WAIT_L(0); PG8_MMA(0, 1, At, B1); PG8_BAR;
            PG8_LDA(At, 1, 1); PG8_STAGE(PG8_SA(1, 0), a3, voffA);
            PG8_BAR; PG8_WAIT_L(0); PG8_MMA(1, 0, At, B0); PG8_BAR; PG8_SCHED;
            PG8_STAGE(PG8_SB(1, 1), b3 + hstep, voffB);
            PG8_WAIT_V(6); PG8_BAR; PG8_MMA(1, 1, At, B1); PG8_BAR;
            }
        }
        if constexpr (ALIGN_EPI) { if (wr == 0) PG8_BAR; }
        if constexpr (!Epi::AFTER_DRAIN) { E(acc, cur, wr, wc, fr, fq); S.done(cur); }
        if (!has_next) break;
#pragma unroll
        for (int a = 0; a < 2; ++a)
#pragma unroll
            for (int b = 0; b < 2; ++b)
#pragma unroll
                for (int m = 0; m < 4; ++m)
#pragma unroll
                    for (int n = 0; n < 2; ++n) acc[a][b][m][n] = (f32x4){0.f, 0.f, 0.f, 0.f};
        cur = nxt; cA = nA; cB = nB; ++ui;
        if constexpr (ALIGN_EPI) { if (wr == 1) PG8_BAR; }
    }
    PG8_WAIT_V(0);
    if constexpr (!ALIGN_EPI) { if (wr == 0) PG8_BAR; }
    PG8_BAR;
    if constexpr (Epi::AFTER_DRAIN) { E.fused(acc, cur, wr, wc, fr, fq, lds, wid, lane); S.done(cur); }
#undef PG8_SA
#undef PG8_SB
#undef PG8_STAGE
#undef PG8_LDA
#undef PG8_LDB
#undef PG8_MMA
#undef PG8_WAIT_V
#undef PG8_WAIT_L
#undef PG8_BAR
#undef PG8_SCHED
}
}

#define GAS __attribute__((address_space(1)))
#define LAS __attribute__((address_space(3)))
typedef unsigned short bf16;
typedef float f32x4 __attribute__((ext_vector_type(4)));
typedef float f32x16 __attribute__((ext_vector_type(16)));
typedef short bf16x8 __attribute__((ext_vector_type(8)));
typedef short s16x4 __attribute__((ext_vector_type(4)));
typedef unsigned u32x4 __attribute__((ext_vector_type(4)));
typedef unsigned u32x2 __attribute__((ext_vector_type(2)));
typedef GAS unsigned gu32;
#define RLX_AGENT __ATOMIC_RELAXED, __HIP_MEMORY_SCOPE_AGENT
#define LDS_WAIT() asm volatile("s_waitcnt lgkmcnt(0)" ::: "memory")
#define VM_WAIT() asm volatile("s_waitcnt vmcnt(0)" ::: "memory")
__device__ __forceinline__ unsigned pk2(float lo, float hi) { return pg8::pk_bf16(lo, hi); }
__device__ __forceinline__ float bf2f(unsigned short b) { return __builtin_bit_cast(float, (unsigned)b << 16); }
__device__ __forceinline__ float ex2(float x) { return __builtin_amdgcn_exp2f(x); }
__device__ __forceinline__ float wave_sum(float v) {
#pragma unroll
    for (int o = 1; o < 64; o <<= 1) v += __shfl_xor(v, o);
    return v;
}

namespace fa {
constexpr int KSLOT = 12288, VSLOT = 8192;
constexpr int L_K = 0, L_V = 2 * KSLOT, L_WS = L_V + 2 * VSLOT, L_OST = L_WS + 8 * 64 * 4, L_BYTES = L_OST + 8 * 32 * 64 * 4;
constexpr int L_WS2 = L_V + 3 * VSLOT, L_CB2 = L_WS2 + 8 * 128 * 4, L_OST2 = L_CB2 + 512, L_QR2 = L_OST2 + 8 * 4096, L_BYTES2 = L_QR2 + 8 * 4096;
__device__ __forceinline__ int crow(int r, int hi) { return (r & 3) + 8 * (r >> 2) + 4 * hi; }
__device__ __forceinline__ void glds16(const void* gsrc, unsigned lds_dst) { unsigned keep;
    asm volatile("s_mov_b32 %0, m0\n\ts_mov_b32 m0, %2\n\ts_nop 0\n\tglobal_load_lds_dwordx4 %1, off\n\ts_mov_b32 m0, %0" : "=&s"(keep) : "v"(gsrc), "s"(lds_dst) : "memory"); }
#define FA_WAIT_BAR() asm volatile("s_waitcnt vmcnt(0) lgkmcnt(0)\n\ts_barrier" ::: "memory")
#define FA_SBAR() __builtin_amdgcn_sched_barrier(0)
template <int ND0> __device__ __forceinline__ void qkt(f32x16& p0, f32x16& p1, const LAS char* kp, const bf16x8* qr) {
    p0 = f32x16{}; p1 = f32x16{};
#pragma unroll
    for (int d0 = 0; d0 < ND0; ++d0) {
        const bf16x8 b0 = *(const LAS bf16x8*)(kp + d0 * 2048);
        const bf16x8 b1 = *(const LAS bf16x8*)(kp + d0 * 2048 + 512);
        p0 = __builtin_amdgcn_mfma_f32_32x32x16_bf16(b0, qr[d0], p0, 0, 0, 0); p1 = __builtin_amdgcn_mfma_f32_32x32x16_bf16(b1, qr[d0], p1, 0, 0, 0); }
}
__device__ __forceinline__ float max3f(float a, float b, float c) { float r; asm("v_max3_f32 %0, %1, %2, %3" : "=v"(r) : "v"(a), "v"(b), "v"(c)); return r; }
__device__ __forceinline__ float max2f(float a, float b) { float r; asm("v_max_f32_e32 %0, %1, %2" : "=v"(r) : "v"(a), "v"(b)); return r; }
__device__ __forceinline__ float rowmax_a(const f32x16& p0, const f32x16& p1) {
    float a = max3f(p0[0], p0[1], p1[0]), b = max3f(p0[2], p0[3], p1[1]); a = max3f(a, p1[2], p1[3]);
#pragma unroll
    for (int r = 4; r < 16; r += 4) { a = max3f(a, p0[r], p0[r + 1]); b = max3f(b, p0[r + 2], p0[r + 3]); a = max3f(a, p1[r], p1[r + 1]); b = max3f(b, p1[r + 2], p1[r + 3]); }
    const float m = max2f(a, b);
    auto rr = __builtin_amdgcn_permlane32_swap(__float_as_uint(m), __float_as_uint(m), false, false);
    return max2f(__uint_as_float(rr[0]), __uint_as_float(rr[1]));
}
__device__ __forceinline__ float rowmax(const f32x16& p0, const f32x16& p1) {
    float a = __builtin_fmaxf(p0[0], p1[0]);
#pragma unroll
    for (int r = 1; r < 16; ++r) a = __builtin_fmaxf(a, __builtin_fmaxf(p0[r], p1[r]));
    auto rr = __builtin_amdgcn_permlane32_swap(__float_as_uint(a), __float_as_uint(a), false, false);
    return __builtin_fmaxf(__uint_as_float(rr[0]), __uint_as_float(rr[1]));
}
__device__ __forceinline__ void pv(f32x16* o, int vb, bf16x8 pa0, bf16x8 pa1, bf16x8 pa2, bf16x8 pa3) {
#pragma unroll
    for (int d0 = 0; d0 < 2; ++d0) { s16x4 lo[4], hi[4];
#pragma unroll
        for (int ks = 0; ks < 4; ++ks) {
            asm volatile("ds_read_b64_tr_b16 %0,%1 offset:%c2" : "=&v"(lo[ks]) : "v"(vb), "i"(d0 * 4096 + ks * 1024) : "memory");
            asm volatile("ds_read_b64_tr_b16 %0,%1 offset:%c2" : "=&v"(hi[ks]) : "v"(vb), "i"(d0 * 4096 + ks * 1024 + 512) : "memory"); }
        asm volatile("s_waitcnt lgkmcnt(0)" ::: "memory"); FA_SBAR();
#define FA_PK(k) (bf16x8){lo[k][0], lo[k][1], lo[k][2], lo[k][3], hi[k][0], hi[k][1], hi[k][2], hi[k][3]}
        o[d0] = __builtin_amdgcn_mfma_f32_32x32x16_bf16(pa0, FA_PK(0), o[d0], 0, 0, 0);
        o[d0] = __builtin_amdgcn_mfma_f32_32x32x16_bf16(pa1, FA_PK(1), o[d0], 0, 0, 0);
        o[d0] = __builtin_amdgcn_mfma_f32_32x32x16_bf16(pa2, FA_PK(2), o[d0], 0, 0, 0);
        o[d0] = __builtin_amdgcn_mfma_f32_32x32x16_bf16(pa3, FA_PK(3), o[d0], 0, 0, 0);
#undef FA_PK
    }
}
struct Args { const bf16* Q; int qpitch, qcol; const bf16* K; int kpitch, kcol; const bf16* K2; const bf16* V; int vpitch, vcol; bf16* O; int ocol; const bf16* G; const float* CB; };
template <int MODE> __device__ __forceinline__ void unit(const Args& A, long rowbase, int qb, LAS char* lds, unsigned lds0) {
    constexpr int ND0 = MODE ? 6 : 4;
    const int tid = pg8::pg8_tid(), lane = tid & 63, r32 = lane & 31, hi = lane >> 5; const int wid = __builtin_amdgcn_readfirstlane(tid >> 6);
    const int q0 = qb * 256, NT = q0 / 64 + 4, nt_w = MODE ? (q0 / 64 + (wid >> 1) + 1) : NT;
    const bf16* Qw = A.Q + (rowbase + q0 + wid * 32 + r32) * A.qpitch + A.qcol + hi * 8;
    bf16x8 qr[ND0];
#pragma unroll
    for (int d0 = 0; d0 < ND0; ++d0) qr[d0] = *(const bf16x8*)(Qw + d0 * 16);
    const bf16* ksrc = A.K + (rowbase + lane) * A.kpitch + A.kcol + wid * 8;
    const bf16* ksrc2 = MODE ? A.K2 + (rowbase + lane) * 32 + (wid & 3) * 8 : nullptr;
    const bf16* vsrc = A.V + (rowbase + 16 * (wid & 3) + (lane >> 2)) * A.vpitch + A.vcol + (wid >> 2) * 32 + (lane & 3) * 8;
#define FA_DMA(t, slot) do { \
        glds16(ksrc + (long)(t) * 64 * A.kpitch, (unsigned)__builtin_amdgcn_readfirstlane(lds0 + L_K + (slot) * KSLOT + wid * 1024)); \
        if (MODE && wid < 4) glds16(ksrc2 + (long)(t) * 64 * 32, (unsigned)__builtin_amdgcn_readfirstlane(lds0 + L_K + (slot) * KSLOT + (8 + wid) * 1024)); \
        glds16(vsrc + (long)(t) * 64 * A.vpitch, (unsigned)__builtin_amdgcn_readfirstlane(lds0 + L_V + (slot) * VSLOT + wid * 1024)); } while (0)
    LAS float* wsf = (LAS float*)(lds + L_WS) + wid * 64;
    const int vb0 = (int)(lds0 + L_V) + ((lane >> 4) & 1) * 32 + (lane & 3) * 8 + (4 * hi + ((lane & 15) >> 2)) * 64;
    float m = -1e30f, l = 0.f; f32x16 o[2]; o[0] = f32x16{}; o[1] = f32x16{};
    FA_DMA(0, 0);
    for (int t = 0; t < NT; ++t) {
        FA_WAIT_BAR();
        if (t + 1 < NT) FA_DMA(t + 1, (t + 1) & 1);
        if (t < nt_w) {
            const int slot = t & 1;
            f32x16 p0, p1; qkt<ND0>(p0, p1, lds + L_K + slot * KSLOT + hi * 1024 + r32 * 16, qr);
            if (MODE == 0) {
                const float* cb = A.CB + t * 64 + 4 * hi;
#pragma unroll
                for (int g4 = 0; g4 < 4; ++g4) { const f32x4 b0 = *(const f32x4*)(cb + 8 * g4), b1 = *(const f32x4*)(cb + 32 + 8 * g4);
#pragma unroll
                    for (int i = 0; i < 4; ++i) { p0[4 * g4 + i] += b0[i]; p1[4 * g4 + i] += b1[i]; } }
                const int jb = t - (NT - 4);
                if (jb >= 0) { const int qrel = wid * 32 + r32, kb = 64 * jb + 4 * hi;
#pragma unroll
                    for (int r = 0; r < 16; ++r) { const int kv = kb + (r & 3) + 8 * (r >> 2); if (kv > qrel) p0[r] = -INFINITY; if (kv + 32 > qrel) p1[r] = -INFINITY; } }
            }
            const float rm = rowmax(p0, p1);
            const float mn = __builtin_fmaxf(m, rm), alpha = ex2(m - mn); m = mn;
            float sacc = 0.f;
#pragma unroll
            for (int r = 0; r < 16; ++r) { p0[r] = ex2(p0[r] - mn); p1[r] = ex2(p1[r] - mn); sacc += p0[r] + p1[r]; }
            l = l * alpha + sacc;
            if (hi == 0) wsf[r32] = alpha;
#pragma unroll
            for (int r = 0; r < 16; ++r) { const float a = wsf[crow(r, hi)]; o[0][r] *= a; o[1][r] *= a; }
            u32x4 pw0, pw1, pw2, pw3;
            pw0 = (u32x4){pk2(p0[0], p0[1]), pk2(p0[2], p0[3]), pk2(p0[4], p0[5]), pk2(p0[6], p0[7])};
            pw1 = (u32x4){pk2(p0[8], p0[9]), pk2(p0[10], p0[11]), pk2(p0[12], p0[13]), pk2(p0[14], p0[15])};
            pw2 = (u32x4){pk2(p1[0], p1[1]), pk2(p1[2], p1[3]), pk2(p1[4], p1[5]), pk2(p1[6], p1[7])};
            pw3 = (u32x4){pk2(p1[8], p1[9]), pk2(p1[10], p1[11]), pk2(p1[12], p1[13]), pk2(p1[14], p1[15])};
            FA_SBAR();
            pv(o, vb0 + slot * VSLOT, __builtin_bit_cast(bf16x8, pw0), __builtin_bit_cast(bf16x8, pw1), __builtin_bit_cast(bf16x8, pw2), __builtin_bit_cast(bf16x8, pw3));
        }
    }
    { auto rr = __builtin_amdgcn_permlane32_swap(__float_as_uint(l), __float_as_uint(l), false, false); l = __uint_as_float(rr[0]) + __uint_as_float(rr[1]); }
    if (hi == 0) wsf[32 + r32] = l;
    LAS float* stg = (LAS float*)(lds + L_OST) + wid * 2048;
#pragma unroll
    for (int r = 0; r < 16; ++r) { const int orow = crow(r, hi); const float rl = __builtin_amdgcn_rcpf(wsf[32 + orow]);
        stg[orow * 64 + r32] = o[0][r] * rl; stg[orow * 64 + 32 + r32] = o[1][r] * rl; }
    LDS_WAIT();
#pragma unroll
    for (int i = 0; i < 4; ++i) { const int row = i * 8 + (lane >> 3), ch = lane & 7; const long grow = rowbase + q0 + wid * 32 + row;
        f32x4 a = *(const LAS f32x4*)(stg + row * 64 + ch * 8), b = *(const LAS f32x4*)(stg + row * 64 + ch * 8 + 4);
        if (MODE == 0) { const u32x4 g = *(const u32x4*)(A.G + grow * 1024 + A.ocol + ch * 8);
            a[0] *= __uint_as_float(g.x << 16); a[1] *= __uint_as_float(g.x & 0xffff0000u); a[2] *= __uint_as_float(g.y << 16); a[3] *= __uint_as_float(g.y & 0xffff0000u);
            b[0] *= __uint_as_float(g.z << 16); b[1] *= __uint_as_float(g.z & 0xffff0000u); b[2] *= __uint_as_float(g.w << 16); b[3] *= __uint_as_float(g.w & 0xffff0000u); }
        const u32x4 w = (u32x4){pk2(a[0], a[1]), pk2(a[2], a[3]), pk2(b[0], b[1]), pk2(b[2], b[3])};
        *(u32x4*)(A.O + grow * 1024 + A.ocol + ch * 8) = w; }
    asm volatile("s_waitcnt lgkmcnt(0)\n\ts_barrier" ::: "memory");
#undef FA_DMA
}

#ifndef FA_STAG_FOX
#define FA_STAG_FOX 1
#endif
#ifndef FA_STAG_MLA
#define FA_STAG_MLA 1
#endif
#ifndef FA_PROBE_VALU
#define FA_PROBE_VALU 0
#endif
__device__ __forceinline__ void glds4(const void* gsrc, unsigned lds_dst) { unsigned keep;
    asm volatile("s_mov_b32 %0, m0\n\ts_mov_b32 m0, %2\n\ts_nop 0\n\tglobal_load_lds_dword %1, off\n\ts_mov_b32 m0, %0" : "=&s"(keep) : "v"(gsrc), "s"(lds_dst) : "memory"); }
__device__ __forceinline__ s16x4 vtr(const LAS char* p) { typedef short v4i16_t __attribute__((ext_vector_type(4))); return __builtin_bit_cast(s16x4, __builtin_amdgcn_ds_read_tr16_b64_v4i16((LAS v4i16_t*)p)); }
template <int MODE, bool DIAG> __device__ __forceinline__ void tile_qs(const LAS char* kp, const bf16x8 (&qr)[2][4], const LAS char* qrl, const LAS float* cbl, int r32, int hi,
                                                                     float (&m)[2], float (&l)[2], f32x16 (&o)[2][2], LAS float* wsf, u32x4 (&pw)[2][4]) {
    constexpr int ND0 = MODE ? 6 : 4;
    f32x16 p[2][2];
    if (MODE == 0) {
#pragma unroll
        for (int g4 = 0; g4 < 4; ++g4) { const f32x4 b0 = *(const LAS f32x4*)(cbl + 4 * hi + 8 * g4), b1 = *(const LAS f32x4*)(cbl + 32 + 4 * hi + 8 * g4);
#pragma unroll
            for (int i = 0; i < 4; ++i) { p[0][0][4 * g4 + i] = b0[i]; p[0][1][4 * g4 + i] = b1[i]; } }
        p[1][0] = p[0][0]; p[1][1] = p[0][1];
    } else {
#pragma unroll
        for (int b2 = 0; b2 < 2; ++b2) { p[b2][0] = f32x16{}; p[b2][1] = f32x16{}; }
    }
    bf16x8 qx[2][2];
    if (MODE) {
#pragma unroll
        for (int b2 = 0; b2 < 2; ++b2) { qx[b2][0] = *(const LAS bf16x8*)(qrl + (b2 * 2) * 1024); qx[b2][1] = *(const LAS bf16x8*)(qrl + (b2 * 2 + 1) * 1024); } }
#pragma unroll
    for (int d0 = 0; d0 < ND0; ++d0) { const bf16x8 k0 = *(const LAS bf16x8*)(kp + d0 * 2048), k1 = *(const LAS bf16x8*)(kp + d0 * 2048 + 512);
#pragma unroll
        for (int b2 = 0; b2 < 2; ++b2) { const bf16x8 qv = (d0 < 4) ? qr[b2][d0 & 3] : qx[b2][d0 & 1];
            p[b2][0] = __builtin_amdgcn_mfma_f32_32x32x16_bf16(k0, qv, p[b2][0], 0, 0, 0); p[b2][1] = __builtin_amdgcn_mfma_f32_32x32x16_bf16(k1, qv, p[b2][1], 0, 0, 0); } }
    if (MODE == 0 && DIAG) {
#pragma unroll
        for (int b2 = 0; b2 < 2; ++b2) { const int qrel = 32 * b2 + r32;
#pragma unroll
            for (int r = 0; r < 16; ++r) { const int kv = 4 * hi + (r & 3) + 8 * (r >> 2); if (kv > qrel) p[b2][0][r] = -INFINITY; if (kv + 32 > qrel) p[b2][1][r] = -INFINITY; } } }
    asm volatile("s_nop 15\n\ts_nop 7" : "+v"(p[0][0]), "+v"(p[0][1]), "+v"(p[1][0]), "+v"(p[1][1]));
#if FA_PROBE_VALU
    { float dd[8];
#pragma unroll
      for (int i = 0; i < 8; ++i) dd[i] = m[0] + (float)i;
#pragma unroll
      for (int k = 0; k < FA_PROBE_VALU; ++k)
#pragma unroll
        for (int i = 0; i < 8; ++i) dd[i] = ex2(dd[i]);
#pragma unroll
      for (int i = 0; i < 8; ++i) asm volatile("" :: "v"(dd[i])); }
#endif
#pragma unroll
    for (int b2 = 0; b2 < 2; ++b2) {
        const float rm = rowmax_a(p[b2][0], p[b2][1]);
        const float mn = max2f(m[b2], rm); float alpha = m[b2] - mn; asm("v_exp_f32 %0, %0\n\ts_nop 0" : "+v"(alpha)); m[b2] = mn;
        float sa0 = 0.f, sa1 = 0.f;
#pragma unroll
        for (int r = 0; r < 16; r += 2) { float a = p[b2][0][r] - mn, b = p[b2][1][r] - mn, c = p[b2][0][r + 1] - mn, d = p[b2][1][r + 1] - mn;
            asm("v_exp_f32 %0, %0\n\tv_exp_f32 %1, %1\n\tv_exp_f32 %2, %2\n\tv_exp_f32 %3, %3\n\tv_add_f32 %4, %4, %0\n\tv_add_f32 %5, %5, %1\n\tv_add_f32 %4, %4, %2\n\tv_add_f32 %5, %5, %3"
                : "+v"(a), "+v"(b), "+v"(c), "+v"(d), "+v"(sa0), "+v"(sa1));
            p[b2][0][r] = a; p[b2][1][r] = b; p[b2][0][r + 1] = c; p[b2][1][r + 1] = d; }
        l[b2] = l[b2] * alpha + (sa0 + sa1);
#pragma unroll
        for (int r = 0; r < 16; ++r) { float t0 = o[b2][0][r], t1 = o[b2][1][r]; asm("v_mul_f32 %0, %0, %1" : "+v"(t0) : "v"(alpha)); asm("v_mul_f32 %0, %0, %1" : "+v"(t1) : "v"(alpha)); o[b2][0][r] = t0; o[b2][1][r] = t1; }
        pw[b2][0] = (u32x4){pk2(p[b2][0][0], p[b2][0][1]), pk2(p[b2][0][2], p[b2][0][3]), pk2(p[b2][0][4], p[b2][0][5]), pk2(p[b2][0][6], p[b2][0][7])};
        pw[b2][1] = (u32x4){pk2(p[b2][0][8], p[b2][0][9]), pk2(p[b2][0][10], p[b2][0][11]), pk2(p[b2][0][12], p[b2][0][13]), pk2(p[b2][0][14], p[b2][0][15])};
        pw[b2][2] = (u32x4){pk2(p[b2][1][0], p[b2][1][1]), pk2(p[b2][1][2], p[b2][1][3]), pk2(p[b2][1][4], p[b2][1][5]), pk2(p[b2][1][6], p[b2][1][7])};
        pw[b2][3] = (u32x4){pk2(p[b2][1][8], p[b2][1][9]), pk2(p[b2][1][10], p[b2][1][11]), pk2(p[b2][1][12], p[b2][1][13]), pk2(p[b2][1][14], p[b2][1][15])};
    }
    asm volatile("s_nop 1" : "+v"(o[0][0]), "+v"(o[0][1]), "+v"(o[1][0]), "+v"(o[1][1]));
}
__device__ __forceinline__ void tile_pv(const LAS char* vp, f32x16 (&o)[2][2], const u32x4 (&pw)[2][4]) {
#pragma unroll
    for (int d0 = 0; d0 < 2; ++d0)
#pragma unroll
        for (int ks = 0; ks < 4; ++ks) { const s16x4 lo = vtr(vp + d0 * 4096 + ks * 1024), hi4 = vtr(vp + d0 * 4096 + ks * 1024 + 512);
            const bf16x8 vf = (bf16x8){lo[0], lo[1], lo[2], lo[3], hi4[0], hi4[1], hi4[2], hi4[3]};
#pragma unroll
            for (int b2 = 0; b2 < 2; ++b2) o[b2][d0] = __builtin_amdgcn_mfma_f32_32x32x16_bf16(vf, __builtin_bit_cast(bf16x8, pw[b2][ks]), o[b2][d0], 0, 0, 0); }
}
template <int MODE> __device__ __forceinline__ void unit2(const Args& A, long rowbase, int qb, LAS char* lds, unsigned lds0) {
    constexpr int ND0 = MODE ? 6 : 4;
    const int tid = pg8::pg8_tid(), lane = tid & 63, r32 = lane & 31, hi = lane >> 5; const int wid = __builtin_amdgcn_readfirstlane(tid >> 6);
    const int q0 = qb * 512, NT = q0 / 64 + 8, nt_w = q0 / 64 + wid + 1;
    bf16x8 qr[2][4];
    LAS char* qrl = lds + L_QR2 + wid * 4096 + lane * 16;
#pragma unroll
    for (int b2 = 0; b2 < 2; ++b2) { const bf16* Qw = A.Q + (rowbase + q0 + wid * 64 + b2 * 32 + r32) * A.qpitch + A.qcol + hi * 8;
#pragma unroll
        for (int d0 = 0; d0 < 4; ++d0) qr[b2][d0] = *(const bf16x8*)(Qw + d0 * 16);
        if (MODE) { *(LAS bf16x8*)(qrl + (b2 * 2) * 1024) = *(const bf16x8*)(Qw + 64); *(LAS bf16x8*)(qrl + (b2 * 2 + 1) * 1024) = *(const bf16x8*)(Qw + 80); } }
    const int koff = lane * A.kpitch + A.kcol + wid * 8, k2off = lane * 32 + (wid & 3) * 8, voff = (16 * (wid & 3) + (lane >> 2)) * A.vpitch + A.vcol + (wid >> 2) * 32 + (lane & 3) * 8;
    const bf16* Kb = A.K + rowbase * A.kpitch; const bf16* K2b = MODE ? A.K2 + rowbase * 32 : nullptr; const bf16* Vb = A.V + rowbase * A.vpitch;
#define FA_DMA(t, slot) do { \
        int ko_ = koff, k2o_ = k2off, vo_ = voff; asm volatile("" : "+v"(ko_), "+v"(k2o_), "+v"(vo_)); \
        glds16(Kb + (long)(t) * 64 * A.kpitch + ko_, (unsigned)__builtin_amdgcn_readfirstlane(lds0 + L_K + (slot) * KSLOT + wid * 1024)); \
        if (MODE && wid < 4) glds16(K2b + (long)(t) * 64 * 32 + k2o_, (unsigned)__builtin_amdgcn_readfirstlane(lds0 + L_K + (slot) * KSLOT + (8 + wid) * 1024)); \
        glds16(Vb + (long)(t) * 64 * A.vpitch + vo_, (unsigned)__builtin_amdgcn_readfirstlane(lds0 + L_V + ((t) % 3) * VSLOT + wid * 1024)); \
        if (!MODE && wid == 4) glds4(A.CB + (t) * 64 + lane, (unsigned)__builtin_amdgcn_readfirstlane(lds0 + L_CB2 + (slot) * 256)); } while (0)
    LAS float* wsf = (LAS float*)(lds + L_WS2) + wid * 128;
    const LAS char* kp0 = lds + L_K + hi * 1024 + r32 * 16;
    const LAS char* vp0 = lds + L_V + ((lane >> 4) & 1) * 32 + (lane & 3) * 8 + (4 * hi + ((lane & 15) >> 2)) * 64;
    float m[2] = {-1e30f, -1e30f}, l[2] = {0.f, 0.f}; f32x16 o[2][2];
#pragma unroll
    for (int b2 = 0; b2 < 2; ++b2) { o[b2][0] = f32x16{}; o[b2][1] = f32x16{}; }
    FA_DMA(0, 0);
    u32x4 pw[2][4];
#define FA_STEP_HEAD(t) FA_WAIT_BAR(); if ((t) + 1 < NT) FA_DMA((t) + 1, ((t) + 1) & 1); const int slot = (t) & 1; const LAS float* cbl = (const LAS float*)(lds + L_CB2 + slot * 256)
    if (wid < 4 || !(MODE ? FA_STAG_MLA : FA_STAG_FOX)) {
        int t = 0;
        for (; t < nt_w - 1; ++t) { FA_STEP_HEAD(t); tile_qs<MODE, false>(kp0 + slot * KSLOT, qr, qrl, cbl, r32, hi, m, l, o, wsf, pw); tile_pv(vp0 + (t % 3) * VSLOT, o, pw); }
        { FA_STEP_HEAD(t); tile_qs<MODE, true>(kp0 + slot * KSLOT, qr, qrl, cbl, r32, hi, m, l, o, wsf, pw); tile_pv(vp0 + (t % 3) * VSLOT, o, pw); ++t; }
        for (; t < NT; ++t) { FA_STEP_HEAD(t); (void)slot; (void)cbl; }
    } else {
        int t = 0;
        if (nt_w > 1) { FA_STEP_HEAD(0); tile_qs<MODE, false>(kp0 + slot * KSLOT, qr, qrl, cbl, r32, hi, m, l, o, wsf, pw); t = 1;
            for (; t < nt_w - 1; ++t) { FA_STEP_HEAD(t); tile_pv(vp0 + ((t - 1) % 3) * VSLOT, o, pw); FA_SBAR(); tile_qs<MODE, false>(kp0 + slot * KSLOT, qr, qrl, cbl, r32, hi, m, l, o, wsf, pw); }
            { FA_STEP_HEAD(t); tile_pv(vp0 + ((t - 1) % 3) * VSLOT, o, pw); FA_SBAR(); tile_qs<MODE, true>(kp0 + slot * KSLOT, qr, qrl, cbl, r32, hi, m, l, o, wsf, pw); ++t; }
        } else { FA_STEP_HEAD(0); tile_qs<MODE, true>(kp0 + slot * KSLOT, qr, qrl, cbl, r32, hi, m, l, o, wsf, pw); t = 1; }
        if (t < NT) { FA_STEP_HEAD(t); (void)slot; (void)cbl; tile_pv(vp0 + ((t - 1) % 3) * VSLOT, o, pw); ++t;
            for (; t < NT; ++t) { FA_STEP_HEAD(t); (void)slot; (void)cbl; } }
        else tile_pv(vp0 + ((NT - 1) % 3) * VSLOT, o, pw);
    }
#undef FA_STEP_HEAD
#pragma unroll
    for (int b2 = 0; b2 < 2; ++b2) {
        float lb = l[b2];
        { auto rr = __builtin_amdgcn_permlane32_swap(__float_as_uint(lb), __float_as_uint(lb), false, false); lb = __uint_as_float(rr[0]) + __uint_as_float(rr[1]); }
        const float rl = __builtin_amdgcn_rcpf(lb); const long grow = rowbase + q0 + wid * 64 + b2 * 32 + r32;
#pragma unroll
        for (int d0 = 0; d0 < 2; ++d0)
#pragma unroll
            for (int g4 = 0; g4 < 4; ++g4) { const int dc = A.ocol + 32 * d0 + 8 * g4 + 4 * hi;
                f32x4 v = (f32x4){o[b2][d0][4 * g4], o[b2][d0][4 * g4 + 1], o[b2][d0][4 * g4 + 2], o[b2][d0][4 * g4 + 3]} * rl;
                if (MODE == 0) { const u32x2 g = *(const u32x2*)(A.G + grow * 1024 + dc);
                    v[0] *= __uint_as_float(g.x << 16); v[1] *= __uint_as_float(g.x & 0xffff0000u); v[2] *= __uint_as_float(g.y << 16); v[3] *= __uint_as_float(g.y & 0xffff0000u); }
                *(u32x2*)(A.O + grow * 1024 + dc) = (u32x2){pk2(v[0], v[1]), pk2(v[2], v[3])}; }
    }
    asm volatile("s_waitcnt lgkmcnt(0)\n\ts_barrier" ::: "memory");
#undef FA_DMA
}
}

namespace a16 {
__device__ __forceinline__ f32x4 mfma16(bf16x8 a, bf16x8 b, f32x4 c) { return __builtin_amdgcn_mfma_f32_16x16x32_bf16(a, b, c, 0, 0, 0); }
template <int NQK, int NDB, class KL, class VL, class SF>
__device__ __forceinline__ void steps(int s0, int s1, const bf16x8 (&qf)[NQK], KL kload, VL vload, SF sfix, float& m, float& l, f32x4 (&o)[NDB], int lane) {
    const int g = lane >> 4;
    for (int s = s0; s < s1; ++s) {
        f32x4 sA = {0.f, 0.f, 0.f, 0.f}, sB = {0.f, 0.f, 0.f, 0.f};
#pragma unroll
        for (int d0 = 0; d0 < NQK; ++d0) { sA = mfma16(kload(s, 0, d0), qf[d0], sA); sB = mfma16(kload(s, 1, d0), qf[d0], sB); }
        sfix(s, sA, sB);
        float mx = __builtin_fmaxf(__builtin_fmaxf(__builtin_fmaxf(sA[0], sA[1]), __builtin_fmaxf(sA[2], sA[3])), __builtin_fmaxf(__builtin_fmaxf(sB[0], sB[1]), __builtin_fmaxf(sB[2], sB[3])));
        mx = __builtin_fmaxf(mx, __shfl_xor(mx, 16)); mx = __builtin_fmaxf(mx, __shfl_xor(mx, 32));
        const float mn = __builtin_fmaxf(m, mx), alpha = ex2(m - mn); m = mn;
        f32x4 pA, pB;
#pragma unroll
        for (int r = 0; r < 4; ++r) { pA[r] = ex2(sA[r] - mn); pB[r] = ex2(sB[r] - mn); }
        float ps = ((pA[0] + pA[1]) + (pA[2] + pA[3])) + ((pB[0] + pB[1]) + (pB[2] + pB[3]));
        ps += __shfl_xor(ps, 16); ps += __shfl_xor(ps, 32);
        l = l * alpha + ps;
        const float a0 = __shfl(alpha, 4 * g), a1 = __shfl(alpha, 4 * g + 1), a2 = __shfl(alpha, 4 * g + 2), a3 = __shfl(alpha, 4 * g + 3);
#pragma unroll
        for (int db = 0; db < NDB; ++db) { o[db][0] *= a0; o[db][1] *= a1; o[db][2] *= a2; o[db][3] *= a3; }
        const u32x4 pw = (u32x4){pk2(pA[0], pA[1]), pk2(pA[2], pA[3]), pk2(pB[0], pB[1]), pk2(pB[2], pB[3])};
        const bf16x8 pf = __builtin_bit_cast(bf16x8, pw);
#pragma unroll
        for (int db = 0; db < NDB; ++db) o[db] = mfma16(pf, vload(s, db), o[db]);
    }
}
__device__ __forceinline__ bf16x8 cvt8(f32x4 a, f32x4 b) { const u32x4 w = (u32x4){pk2(a[0], a[1]), pk2(a[2], a[3]), pk2(b[0], b[1]), pk2(b[2], b[3])}; return __builtin_bit_cast(bf16x8, w); }
__device__ __forceinline__ bf16x8 join8(u32x2 a, u32x2 b) { const u32x4 w = (u32x4){a.x, a.y, b.x, b.y}; return __builtin_bit_cast(bf16x8, w); }
}


namespace xa {
constexpr int TSZ = 16384, L_T = 0, L_WS = 2 * TSZ, L_OST = L_WS + 8 * 64 * 4, L_BYTES = L_OST + 8 * 2048;
#define XA_WAIT_BAR() asm volatile("s_waitcnt vmcnt(0) lgkmcnt(0)\n\ts_barrier" ::: "memory")
template <typename T> __device__ __forceinline__ const T* src_of(const T* Kh, const T* Vh, int pitch, int i, int ci) {
    return (i < 8) ? Kh + (size_t)(32 * i + (ci & 31)) * pitch + (ci >> 5) * 8 : Vh + (size_t)(ci >> 2) * pitch + 32 * (i - 8) + (ci & 3) * 8; }
template <bool F32SRC> __device__ __forceinline__ void unit(const void* Kh_, const void* Vh_, int pitch, const bf16* Q, bf16* O, size_t row0, int hcol, int nvalid_w0, bool only_w0, LAS char* lds, unsigned lds0) {
    const int tid = pg8::pg8_tid(), lane = tid & 63, r32 = lane & 31, hi = lane >> 5; const int wid = __builtin_amdgcn_readfirstlane(tid >> 6);
    const bool active = !only_w0 || wid == 0; const int nvalid = only_w0 ? (wid == 0 ? nvalid_w0 : 0) : 32;
    bf16x8 qr[16];
    { const bf16* Qw = Q + (row0 + wid * 32 + r32) * 1024 + hcol + hi * 8;
#pragma unroll
      for (int d0 = 0; d0 < 16; ++d0) qr[d0] = active ? *(const bf16x8*)(Qw + d0 * 16) : (bf16x8){0, 0, 0, 0, 0, 0, 0, 0}; }
    LAS float* wsf = (LAS float*)(lds + L_WS) + wid * 64;
    f32x4 st[2][2];
#define XA_ISSUE(i) do { if (F32SRC) { _Pragma("unroll") for (int c2 = 0; c2 < 2; ++c2) { const float* s = src_of<float>((const float*)Kh_, (const float*)Vh_, pitch, (i), tid + 512 * c2); st[c2][0] = *(const f32x4*)s; st[c2][1] = *(const f32x4*)(s + 4); } } \
        else { _Pragma("unroll") for (int c2 = 0; c2 < 2; ++c2) fa::glds16(src_of<bf16>((const bf16*)Kh_, (const bf16*)Vh_, pitch, (i), (2 * wid + c2) * 64 + lane), (unsigned)__builtin_amdgcn_readfirstlane(lds0 + L_T + ((i) & 1) * TSZ + (2 * wid + c2) * 1024)); } } while (0)
#define XA_COMMIT(i) do { if (F32SRC) { _Pragma("unroll") for (int c2 = 0; c2 < 2; ++c2) *(LAS u32x4*)(lds + L_T + ((i) & 1) * TSZ + (tid + 512 * c2) * 16) = \
        (u32x4){pk2(st[c2][0][0], st[c2][0][1]), pk2(st[c2][0][2], st[c2][0][3]), pk2(st[c2][1][0], st[c2][1][1]), pk2(st[c2][1][2], st[c2][1][3])}; } } while (0)
    XA_ISSUE(0); XA_COMMIT(0);
    f32x16 S[8];
#pragma unroll
    for (int t = 0; t < 8; ++t) {
        XA_WAIT_BAR(); XA_ISSUE(t + 1);
        const LAS char* kp = lds + L_T + (t & 1) * TSZ + hi * 512 + r32 * 16;
        S[t] = f32x16{};
#pragma unroll
        for (int d0 = 0; d0 < 16; ++d0) S[t] = __builtin_amdgcn_mfma_f32_32x32x16_bf16(*(const LAS bf16x8*)(kp + d0 * 1024), qr[d0], S[t], 0, 0, 0);
        XA_COMMIT(t + 1);
    }
    float mx = S[0][0];
#pragma unroll
    for (int t = 0; t < 8; ++t)
#pragma unroll
        for (int r = 0; r < 16; ++r) mx = __builtin_fmaxf(mx, S[t][r]);
    { auto rr = __builtin_amdgcn_permlane32_swap(__float_as_uint(mx), __float_as_uint(mx), false, false); mx = __builtin_fmaxf(__uint_as_float(rr[0]), __uint_as_float(rr[1])); }
    float l = 0.f; u32x4 pw[16];
#pragma unroll
    for (int t = 0; t < 8; ++t) {
#pragma unroll
        for (int r = 0; r < 16; ++r) { S[t][r] = ex2(S[t][r] - mx); l += S[t][r]; }
        pw[2 * t] = (u32x4){pk2(S[t][0], S[t][1]), pk2(S[t][2], S[t][3]), pk2(S[t][4], S[t][5]), pk2(S[t][6], S[t][7])};
        pw[2 * t + 1] = (u32x4){pk2(S[t][8], S[t][9]), pk2(S[t][10], S[t][11]), pk2(S[t][12], S[t][13]), pk2(S[t][14], S[t][15])}; }
    { auto rr = __builtin_amdgcn_permlane32_swap(__float_as_uint(l), __float_as_uint(l), false, false); l = __uint_as_float(rr[0]) + __uint_as_float(rr[1]); }
    if (hi == 0) wsf[r32] = l;
    float rli[16];
#pragma unroll
    for (int r = 0; r < 16; ++r) rli[r] = __builtin_amdgcn_rcpf(wsf[fa::crow(r, hi)]);
    const int vbl = (int)(lds0 + L_T) + ((lane >> 4) & 1) * 32 + (lane & 3) * 8 + (4 * hi + ((lane & 15) >> 2)) * 64;
    LAS bf16* stg = (LAS bf16*)(lds + L_OST) + wid * 1024;
#pragma unroll
    for (int db = 0; db < 8; ++db) {
        XA_WAIT_BAR(); if (db < 7) XA_ISSUE(8 + db + 1);
        const int vb = vbl + (db & 1) * TSZ;
        f32x16 o = f32x16{};
#pragma unroll
        for (int k4 = 0; k4 < 4; ++k4) { s16x4 vlo[4], vhi[4];
#pragma unroll
            for (int kk = 0; kk < 4; ++kk) {
                asm volatile("ds_read_b64_tr_b16 %0,%1 offset:%c2" : "=&v"(vlo[kk]) : "v"(vb), "i"((k4 * 4 + kk) * 1024) : "memory");
                asm volatile("ds_read_b64_tr_b16 %0,%1 offset:%c2" : "=&v"(vhi[kk]) : "v"(vb), "i"((k4 * 4 + kk) * 1024 + 512) : "memory"); }
            asm volatile("s_waitcnt lgkmcnt(0)" ::: "memory"); __builtin_amdgcn_sched_barrier(0);
#pragma unroll
            for (int kk = 0; kk < 4; ++kk) o = __builtin_amdgcn_mfma_f32_32x32x16_bf16(__builtin_bit_cast(bf16x8, pw[k4 * 4 + kk]),
                (bf16x8){vlo[kk][0], vlo[kk][1], vlo[kk][2], vlo[kk][3], vhi[kk][0], vhi[kk][1], vhi[kk][2], vhi[kk][3]}, o, 0, 0, 0); }
        if (db < 7) XA_COMMIT(8 + db + 1);
#pragma unroll
        for (int r = 0; r < 16; ++r) stg[fa::crow(r, hi) * 32 + r32] = (bf16)(pk2(o[r] * rli[r], 0.f) & 0xffffu);
        LDS_WAIT();
#pragma unroll
        for (int ps = 0; ps < 2; ++ps) { const int row = ps * 16 + (lane >> 2), ch = lane & 3;
            const u32x4 v = *(const LAS u32x4*)(stg + row * 32 + ch * 8);
            if (row < nvalid) *(u32x4*)(O + (row0 + wid * 32 + row) * 1024 + hcol + 32 * db + ch * 8) = v; }
        LDS_WAIT();
    }
    asm volatile("s_waitcnt lgkmcnt(0)\n\ts_barrier" ::: "memory");
#undef XA_ISSUE
#undef XA_COMMIT
}
}

namespace ms {
constexpr int KSZ = 18432, L_T = 0, L_WS = 2 * KSZ, L_OST = L_WS + 8 * 64 * 4, L_BYTES = L_OST + 8 * 4096;
constexpr int PROW = 264;
#define MS_WAIT_BAR() asm volatile("s_waitcnt lgkmcnt(0)\n\ts_barrier" ::: "memory")
__device__ __forceinline__ const float* ms_ksrc(const float* ckvb, const float* krb, int key, int c) {
    const size_t o0 = (size_t)key * 256 + c * 8, o1 = (size_t)key * 32 + (c - 32) * 8; const bool lat = c < 32; return (lat ? ckvb : krb) + (lat ? o0 : o1); }
template <int NK> __device__ __forceinline__ void unit(const float* ckvb, const float* krb, int kclamp, const bf16* QA, float* P, LAS char* lds, unsigned lds0) {
    const int tid = pg8::pg8_tid(), lane = tid & 63, r32 = lane & 31, hi = lane >> 5; const int wid = __builtin_amdgcn_readfirstlane(tid >> 6);
    const bf16* Qw = QA + (size_t)(wid * 32 + r32) * 288 + hi * 8;
    f32x4 st[2][3][2];
#define MS_SRC(i, ci) (((i) < 8) ? ms_ksrc(ckvb, krb, min(32 * (i) + ((ci) & 31), kclamp), (ci) >> 5) \
                                  : ckvb + (size_t)min((ci) >> 2, kclamp) * 256 + 32 * ((i) - 8) + ((ci) & 3) * 8)
#define MS_NCH(i) (((i) < 8) ? 1152 : 1024)
#define MS_ISSUE(i, set) do { _Pragma("unroll") for (int c2 = 0; c2 < 3; ++c2) { const int ci = min(tid + 512 * c2, MS_NCH(i) - 1); const float* s = MS_SRC(i, ci); st[(set) & 1][c2][0] = *(const f32x4*)s; st[(set) & 1][c2][1] = *(const f32x4*)(s + 4); } } while (0)
#define MS_COMMIT(i, slot) do { _Pragma("unroll") for (int c2 = 0; c2 < 3; ++c2) { const int ci = min(tid + 512 * c2, MS_NCH(i) - 1); *(LAS u32x4*)(lds + L_T + ((slot) & 1) * KSZ + ci * 16) = \
        (u32x4){pk2(st[(slot) & 1][c2][0][0], st[(slot) & 1][c2][0][1]), pk2(st[(slot) & 1][c2][0][2], st[(slot) & 1][c2][0][3]), pk2(st[(slot) & 1][c2][1][0], st[(slot) & 1][c2][1][1]), pk2(st[(slot) & 1][c2][1][2], st[(slot) & 1][c2][1][3])}; } } while (0)
    constexpr int FIRSTV = 8;
#define MS_TILE(q) (((q) < NK) ? (q) : FIRSTV + (q) - NK)
    MS_ISSUE(MS_TILE(0), 0); MS_COMMIT(MS_TILE(0), 0); MS_ISSUE(MS_TILE(1), 1);
    f32x16 S[NK];
#pragma unroll
    for (int t = 0; t < NK; ++t) {
        MS_WAIT_BAR(); MS_ISSUE(MS_TILE(t + 2), t + 2);
        const LAS char* kp = lds + L_T + (t & 1) * KSZ + hi * 512 + r32 * 16;
        S[t] = f32x16{}; const bf16* Qt = Qw; asm volatile("" : "+v"(Qt));
#pragma unroll
        for (int d0 = 0; d0 < 18; ++d0) { S[t] = __builtin_amdgcn_mfma_f32_32x32x16_bf16(*(const LAS bf16x8*)(kp + d0 * 1024), *(const bf16x8*)(Qt + d0 * 16), S[t], 0, 0, 0);
            if (d0 % 6 == 5) __builtin_amdgcn_sched_barrier(0); }
        MS_COMMIT(MS_TILE(t + 1), t + 1);
    }
    constexpr int VS0 = (NK & 1);
    if (NK == 1) {
#pragma unroll
        for (int r = 8; r < 16; ++r) S[0][r] = -INFINITY; }
    float mx = S[0][0];
#pragma unroll
    for (int t = 0; t < NK; ++t)
#pragma unroll
        for (int r = 0; r < 16; ++r) mx = __builtin_fmaxf(mx, S[t][r]);
    { auto rr = __builtin_amdgcn_permlane32_swap(__float_as_uint(mx), __float_as_uint(mx), false, false); mx = __builtin_fmaxf(__uint_as_float(rr[0]), __uint_as_float(rr[1])); }
    float l = 0.f; u32x4 pw[2 * NK];
#pragma unroll
    for (int t = 0; t < NK; ++t) {
#pragma unroll
        for (int r = 0; r < 16; ++r) { S[t][r] = ex2(S[t][r] - mx); l += S[t][r]; }
        pw[2 * t] = (u32x4){pk2(S[t][0], S[t][1]), pk2(S[t][2], S[t][3]), pk2(S[t][4], S[t][5]), pk2(S[t][6], S[t][7])};
        pw[2 * t + 1] = (u32x4){pk2(S[t][8], S[t][9]), pk2(S[t][10], S[t][11]), pk2(S[t][12], S[t][13]), pk2(S[t][14], S[t][15])}; }
    { auto rr = __builtin_amdgcn_permlane32_swap(__float_as_uint(l), __float_as_uint(l), false, false); l = __uint_as_float(rr[0]) + __uint_as_float(rr[1]); }
    float* Pw = P + (size_t)(wid * 32) * PROW;
    if (hi == 0) { Pw[(size_t)r32 * PROW + 256] = mx; Pw[(size_t)r32 * PROW + 257] = l; }
    LAS float* stg = (LAS float*)(lds + L_OST) + wid * 1024;
#pragma unroll
    for (int db = 0; db < 8; ++db) {
        MS_WAIT_BAR(); if (db < 6) MS_ISSUE(FIRSTV + db + 2, NK + db + 2);
        const int vb = (int)(lds0 + L_T) + ((VS0 + db) & 1) * KSZ + ((lane >> 4) & 1) * 32 + (lane & 3) * 8 + (4 * hi + ((lane & 15) >> 2)) * 64;
        f32x16 o = f32x16{};
#pragma unroll
        for (int ks = 0; ks < 2 * NK; ++ks) { s16x4 vlo, vhi;
            asm volatile("ds_read_b64_tr_b16 %0,%1 offset:%c2" : "=&v"(vlo) : "v"(vb), "i"(ks * 1024) : "memory");
            asm volatile("ds_read_b64_tr_b16 %0,%1 offset:%c2" : "=&v"(vhi) : "v"(vb), "i"(ks * 1024 + 512) : "memory");
            asm volatile("s_waitcnt lgkmcnt(0)" ::: "memory"); __builtin_amdgcn_sched_barrier(0);
            o = __builtin_amdgcn_mfma_f32_32x32x16_bf16(__builtin_bit_cast(bf16x8, pw[ks]), (bf16x8){vlo[0], vlo[1], vlo[2], vlo[3], vhi[0], vhi[1], vhi[2], vhi[3]}, o, 0, 0, 0); }
#pragma unroll
        for (int r = 0; r < 16; ++r) stg[fa::crow(r, hi) * 32 + r32] = o[r];
        LDS_WAIT();
        { const int row = lane >> 1, cq = (lane & 1) * 16; float* dst = Pw + (size_t)row * PROW + 32 * db + cq;
#pragma unroll
          for (int k = 0; k < 4; ++k) *(f32x4*)(dst + 4 * k) = *(const LAS f32x4*)(stg + row * 32 + cq + 4 * k); }
        if (db < 7) MS_COMMIT(FIRSTV + db + 1, NK + db + 1);
        LDS_WAIT();
    }
    asm volatile("s_waitcnt lgkmcnt(0)\n\ts_barrier" ::: "memory");
#undef MS_SRC
#undef MS_ISSUE
#undef MS_COMMIT
#undef MS_NCH
#undef MS_TILE
}
}

constexpr int RING_OFF = 0, RING_BYTES = 131072;
constexpr int LDSCTL_OFF = RING_BYTES, MISC_OFF = LDSCTL_OFF + 320;
constexpr int LDS_BYTES = 147456;
constexpr int NWAVES = 8;
static_assert(fa::L_BYTES2 <= RING_BYTES && xa::L_BYTES <= RING_BYTES && ms::L_BYTES <= RING_BYTES, "attention LDS");

struct KArgs { const float* in[N_IN]; float* out; unsigned char* ws; int ph_lo, ph_hi; };
static_assert(sizeof(KArgs) == N_IN * 8 + 24, "KArgs has no padding");
typedef const __attribute__((address_space(4))) KArgs* KAP;
#define KA ((KAP)__builtin_amdgcn_kernarg_segment_ptr())

#define XB_TMO      128
#define XB_XCNT(j)  (256  + 64 * (j))
#define XB_XSUB(j)  (1280 + 64 * (j))
#define XB_XGEN(j)  (2304 + 64 * (j))
#define XB_TOP      3328
#define XB_TOPGEN   3392
#define XCD_BAR_WORDS 3456
#define XB_SPIN_CAP (1u << 18)

__device__ __forceinline__ unsigned xb_ld(unsigned* p)              { return __hip_atomic_load(p, __ATOMIC_RELAXED, __HIP_MEMORY_SCOPE_AGENT); }
__device__ __forceinline__ unsigned xb_add(unsigned* p, unsigned v) { return __hip_atomic_fetch_add(p, v, __ATOMIC_RELAXED, __HIP_MEMORY_SCOPE_AGENT); }
__device__ __forceinline__ unsigned xb_xcc_id() { return (unsigned)__builtin_amdgcn_s_getreg((3 << 11) | 20) & 0xFu; }
#define XB_SPIN(cond, bar) do { unsigned _sp = 0; while (cond) { __builtin_amdgcn_s_sleep(1); \
    if ((++_sp & 255u) == 0u) { if (xb_ld(&(bar)[XB_TMO])) break; if (_sp > XB_SPIN_CAP) { atomicAdd(&(bar)[XB_TMO], 1u); break; } } } } while (0)

struct XcdBarrier {
    unsigned* bar; unsigned x;
    volatile LAS unsigned* st;
};

__device__ __forceinline__ XcdBarrier xcd_barrier_post(unsigned* bar, volatile LAS unsigned* st) {
    XcdBarrier b; b.bar = bar; b.x = xb_xcc_id(); b.st = st;
    if (threadIdx.x == 0) (void)xb_add(&bar[XB_XCNT(b.x)], 1u);
    return b;
}
__device__ __forceinline__ void xcd_barrier_complete(unsigned* bar, unsigned x, unsigned& nloc, unsigned& nx) {
    const unsigned G = gridDim.x * gridDim.y * gridDim.z;
    unsigned sum, cnt, mine, sp = 0u;
    for (;;) {
        sum = 0u; cnt = 0u; mine = 0u;
#pragma unroll
        for (unsigned j = 0; j < 16; ++j) { const unsigned c = xb_ld(&bar[XB_XCNT(j)]); sum += c; cnt += (c > 0u) ? 1u : 0u; mine = (j == x) ? c : mine; }
        if (sum == G) break;
        __builtin_amdgcn_s_sleep(1);
        if ((++sp & 255u) == 0u) { if (xb_ld(&bar[XB_TMO])) break; if (sp > XB_SPIN_CAP) { atomicAdd(&bar[XB_TMO], 1u); break; } }
    }
    nloc = mine > 0u ? mine : 1u; nx = cnt > 0u ? cnt : 1u;
}

__device__ __forceinline__ void xcd_barrier(const XcdBarrier& b) {
    asm volatile("s_waitcnt vmcnt(0)" ::: "memory");
    __syncthreads();
    if (threadIdx.x == 0) {
        unsigned* bar = b.bar;
        __builtin_amdgcn_s_waitcnt(0);
        unsigned nloc = b.st[0], nx = b.st[1];
        if (nloc == 0u) { xcd_barrier_complete(bar, b.x, nloc, nx); b.st[0] = nloc; b.st[1] = nx; }
        const unsigned old = xb_add(&bar[XB_XSUB(b.x)], 1u);
        const unsigned gen = old / nloc;
        if (old + 1u == (gen + 1u) * nloc) {
            __builtin_amdgcn_fence(__ATOMIC_RELEASE, "agent");
            asm volatile("s_waitcnt vmcnt(0)" ::: "memory");
            const unsigned og = xb_add(&bar[XB_TOP], 1u);
            const unsigned tg = og / nx;
            if (og + 1u == (tg + 1u) * nx) xb_add(&bar[XB_TOPGEN], 1u);
            else XB_SPIN(xb_ld(&bar[XB_TOPGEN]) == tg, bar);
            __builtin_amdgcn_fence(__ATOMIC_ACQUIRE, "agent");
            xb_add(&bar[XB_XGEN(b.x)], 1u);
            asm volatile("s_waitcnt vmcnt(0)" ::: "memory");
        } else {
            XB_SPIN(xb_ld(&bar[XB_XGEN(b.x)]) == gen, bar);
            __builtin_amdgcn_fence(__ATOMIC_ACQUIRE, "agent");
            asm volatile("s_waitcnt vmcnt(0)" ::: "memory");
        }
    }
    __syncthreads();
}

struct Seg { const float* W; int ldw, c0, ncols, K; bf16* T; int ldt, r0; const float* g; };
__device__ __forceinline__ Seg get_seg(KAP a, unsigned char* ws, int idx) {
    Seg s; s.g = nullptr; s.r0 = 0; s.c0 = 0; s.ldw = 1024; s.ncols = 1024; s.K = 1024; s.ldt = 1024; s.W = nullptr; s.T = nullptr;
    if (idx < 4) { const int j = idx & 1; s.W = a->in[I_WFI] + (size_t)j * 1024 * 4112; s.ldw = 4112; s.T = (bf16*)(ws + WS_WFI) + (size_t)j * 4352 * 1024; s.g = a->in[I_GMIX] + (size_t)(2 * j) * 1024;
        if (idx < 2) { s.c0 = 0; s.ncols = 3072; s.r0 = 0; } else { s.c0 = 3088; s.ncols = 1024; s.r0 = 3072; } }
    else if (idx < 6) { const int j = idx - 4; s.W = a->in[I_WFO] + (size_t)j * 1024 * 1024; s.T = (bf16*)(ws + WS_WFO) + (size_t)j * 1024 * 1024; }
    else if (idx < 12) { const int e = idx - 6, j = e / 3, part = e % 3; s.W = a->in[I_WMA] + (size_t)j * 1024 * 672; s.ldw = 672; s.T = (bf16*)(ws + WS_WMA) + (size_t)j * 768 * 1024; s.g = a->in[I_GMIX] + (size_t)(2 * j + 1) * 1024;
        if (part == 0) { s.c0 = 384; s.ncols = 256; s.r0 = 0; } else if (part == 1) { s.c0 = 0; s.ncols = 384; s.r0 = 256; } else { s.c0 = 640; s.ncols = 32; s.r0 = 640; } }
    else if (idx < 14) { const int j = idx - 12; s.W = a->in[I_WMQB] + (size_t)j * 384 * 1536; s.ldw = 1536; s.ncols = 1536; s.K = 384; s.T = (bf16*)(ws + WS_WMQ) + (size_t)j * 1536 * 384; s.ldt = 384; s.g = a->in[I_GMQ] + (size_t)j * 384; }
    else if (idx < 18) { const int j = idx & 1; const bool raw = idx >= 16; s.W = a->in[I_WMKVB] + (size_t)j * 256 * 2048; s.ldw = 2048; s.ncols = 2048; s.K = 256; s.ldt = 256;
        s.T = (bf16*)(ws + (raw ? WS_WMKVR : WS_WMKV)) + (size_t)j * 2048 * 256; s.g = raw ? nullptr : a->in[I_GMKV] + (size_t)j * 256; }
    else if (idx < 20) { const int j = idx - 18; s.W = a->in[I_WMO] + (size_t)j * 1024 * 1024; s.T = (bf16*)(ws + WS_WMO) + (size_t)j * 1024 * 1024; }
    else if (idx < 24) { const int i = idx - 20; s.W = a->in[I_WXQ] + (size_t)i * 1024 * 1024; s.T = (bf16*)(ws + WS_WXQ) + (size_t)i * 1024 * 1024; s.g = a->in[I_GCROSS] + (size_t)i * 1024; }
    else if (idx < 28) { const int i = idx - 24; s.W = a->in[I_WXO] + (size_t)i * 1024 * 1024; s.T = (bf16*)(ws + WS_WXO) + (size_t)i * 1024 * 1024; }
    else if (idx < 32) { const int i = idx - 28; s.W = a->in[I_WXKV] + (size_t)i * 1024 * 2048; s.ldw = 2048; s.ncols = 2048; s.T = (bf16*)(ws + WS_WXKV) + (size_t)i * 2048 * 1024; s.g = a->in[I_GMEM] + (size_t)i * 1024; }
    else if (idx < 36) { const int i = idx - 32; s.W = a->in[I_WDN] + (size_t)i * 2816 * 1024; s.K = 2816; s.T = (bf16*)(ws + WS_WDN) + (size_t)i * 1024 * 2816; s.ldt = 2816; }
    else if (idx < 212) { const int e = idx - 36, i = e / 44, t = e % 44, pn = t >> 1, half = t & 1; s.W = a->in[I_WGU] + (size_t)i * 1024 * 5632; s.ldw = 5632; s.c0 = half * 2816 + 128 * pn; s.ncols = 128;
        s.T = (bf16*)(ws + WS_WGU) + (size_t)i * 5632 * 1024; s.r0 = 256 * pn + 128 * half; s.g = a->in[I_GFFN] + (size_t)i * 1024; }
    else { const int j = idx - 212; s.W = a->in[I_WFI] + (size_t)j * 1024 * 4112; s.ldw = 4112; s.c0 = 3072; s.ncols = 32; s.T = (bf16*)(ws + WS_WFI) + (size_t)j * 4352 * 1024; s.r0 = 4096; s.g = a->in[I_GMIX] + (size_t)(2 * j) * 1024; }
    return s;
}
constexpr int NSEG = 214;
__device__ __forceinline__ void tr_load(const Seg& s, int item, int lane, float (&v)[32]) {
    const int nnb = s.ncols / 32, kb = item / nnb, nb = item % nnb; const float* p = s.W + (size_t)(64 * kb + (lane >> 5)) * s.ldw + s.c0 + 32 * nb + (lane & 31);
#pragma unroll
    for (int i = 0; i < 32; ++i) v[i] = p[(size_t)(2 * i) * s.ldw];
}
__device__ __forceinline__ void tr_store(const Seg& s, int item, int lane, const float (&v)[32], LAS float* scr) {
    const int nnb = s.ncols / 32, kb = item / nnb, nb = item % nnb, k0 = 64 * kb, n0 = 32 * nb;
#pragma unroll
    for (int i = 0; i < 32; ++i) scr[(2 * i + (lane >> 5)) * 33 + (lane & 31)] = v[i];
    LDS_WAIT(); asm volatile("" ::: "memory");
    const int c = lane & 7; f32x4 g0 = (f32x4){1.f, 1.f, 1.f, 1.f}, g1 = g0;
    if (s.g) { g0 = *(const f32x4*)(s.g + k0 + 8 * c); g1 = *(const f32x4*)(s.g + k0 + 8 * c + 4); }
#pragma unroll
    for (int j = 0; j < 4; ++j) { const int n = (lane >> 3) + 8 * j; const LAS float* p = scr + (8 * c) * 33 + n;
        u32x4 o; o.x = pk2(p[0 * 33] * g0[0], p[1 * 33] * g0[1]); o.y = pk2(p[2 * 33] * g0[2], p[3 * 33] * g0[3]); o.z = pk2(p[4 * 33] * g1[0], p[5 * 33] * g1[1]); o.w = pk2(p[6 * 33] * g1[2], p[7 * 33] * g1[3]);
        *(u32x4*)(s.T + (size_t)(s.r0 + n0 + n) * s.ldt + k0 + 8 * c) = o; }
    LDS_WAIT(); asm volatile("" ::: "memory");
}
__device__ __forceinline__ void cvt_blocks(const float* src, bf16* dst, int nblk, int blk, size_t dstride, int gtid, int nthr) {
    const long total = (long)nblk * blk / 8;
    for (long v = gtid; v < total; v += nthr) { const long e = v * 8; const int b = (int)(e / blk), o = (int)(e % blk);
        const f32x4 x = *(const f32x4*)(src + e), y = *(const f32x4*)(src + e + 4);
        *(u32x4*)(dst + (size_t)b * dstride + o) = (u32x4){pk2(x[0], x[1]), pk2(x[2], x[3]), pk2(y[0], y[1]), pk2(y[2], y[3])}; }
}
__device__ __forceinline__ void p0_prologue(KAP a, LAS unsigned char* lds, int gw, int NGW, int wave, int lane, int pmask) {
    unsigned char* ws = a->ws; const int gtid = gw * 64 + lane, nthr = NGW * 64;
    LAS float* scr = (LAS float*)(lds + RING_OFF + wave * 16384);
#undef P0_PARTS
#define P0_PARTS pmask
    if (P0_PARTS & 1) {
        int total = 0;
        for (int sg = 0; sg < NSEG; ++sg) { const Seg s = get_seg(a, ws, sg); total += (s.K / 64) * (s.ncols / 32); }
        int sg = 0, base = 0; Seg sc = get_seg(a, ws, 0); int nit = (sc.K / 64) * (sc.ncols / 32);
#define P0_ADVANCE(gi) while ((gi) >= base + nit) { base += nit; ++sg; sc = get_seg(a, ws, sg); nit = (sc.K / 64) * (sc.ncols / 32); }
        float va[32], vb[32]; Seg sa = sc, sb = sc; int ia = 0, ib = 0;
        int gi = gw;
        if (gi < total) { P0_ADVANCE(gi); sa = sc; ia = gi - base; tr_load(sa, ia, lane, va); }
        while (gi < total) {
            int gn = gi + NGW;
            if (gn < total) { P0_ADVANCE(gn); sb = sc; ib = gn - base; tr_load(sb, ib, lane, vb); }
            tr_store(sa, ia, lane, va, scr);
            gi = gn; if (gi >= total) break;
            gn = gi + NGW;
            if (gn < total) { P0_ADVANCE(gn); sa = sc; ia = gn - base; tr_load(sa, ia, lane, va); }
            tr_store(sb, ib, lane, vb, scr);
            gi = gn;
        }
#undef P0_ADVANCE
    }
    if (P0_PARTS & 2) {
    cvt_blocks(a->in[I_WMKVB], (bf16*)(ws + WS_WKN), 1, 2 * 256 * 2048, 0, gtid, nthr); }
    if (P0_PARTS & 4) { const u32x4 z = (u32x4){0u, 0u, 0u, 0u};
      for (int v = gtid; v < 2 * 224 * 128; v += nthr) { const int j = v / (224 * 128), r = v % (224 * 128); *(u32x4*)((bf16*)(ws + WS_WFI) + ((size_t)j * 4352 + 4128) * 1024 + (size_t)r * 8) = z; }
      for (int v = gtid; v < 2 * 96 * 128; v += nthr) { const int j = v / (96 * 128), r = v % (96 * 128); *(u32x4*)((bf16*)(ws + WS_WMA) + ((size_t)j * 768 + 672) * 1024 + (size_t)r * 8) = z; }
    }
    if (P0_PARTS & 16) for (int v = gtid; v < 4096 * 16; v += nthr) { const int pos = v >> 4, c = v & 15; const double inv = pow(10000.0, -(double)c / 16.0), ang = (double)pos * inv;
        ((float*)(ws + WS_ROPC))[v] = (float)cos(ang); ((float*)(ws + WS_ROPS))[v] = (float)sin(ang); }
    if (P0_PARTS & 32) for (int row = gw; row < MT; row += NGW) { const float* xr = (row < MP) ? a->in[I_XP] + (size_t)row * 1024 : a->in[I_XS] + (size_t)(row - MP) * 1024;
        float sq = 0.f; bf16* o = (bf16*)(ws + WS_XB) + (size_t)row * 1024;
#pragma unroll
        for (int j = 0; j < 4; ++j) { const f32x4 v = *(const f32x4*)(xr + 256 * j + 4 * lane); sq += pg8::dot4(v); *(u32x2*)(o + 256 * j + 4 * lane) = pg8::pk4(v); }
        sq = wave_sum(sq);
        if (lane < 16) ((float*)(ws + WS_SSQ))[(size_t)row * 16 + lane] = (lane == 0) ? sq : 0.f; }
    if (P0_PARTS & 64) for (int row = gw; row < 2048; row += NGW) { const float* xr = a->in[I_MEM] + (size_t)row * 1024; f32x4 v[4]; float sq = 0.f;
#pragma unroll
        for (int j = 0; j < 4; ++j) { v[j] = *(const f32x4*)(xr + 256 * j + 4 * lane); sq += pg8::dot4(v[j]); }
        const float r = rsqrtf(wave_sum(sq) * (1.0f / 1024.0f) + EPS); bf16* o = (bf16*)(ws + WS_MB) + (size_t)row * 1024;
#pragma unroll
        for (int j = 0; j < 4; ++j) *(u32x2*)(o + 256 * j + 4 * lane) = pg8::pk4(v[j] * r); }
}

__device__ __forceinline__ float ssq_rstd16(const float* ssq, int row) {
    const f32x4 a = *(const f32x4*)(ssq + (size_t)row * 16), b = *(const f32x4*)(ssq + (size_t)row * 16 + 4), c = *(const f32x4*)(ssq + (size_t)row * 16 + 8), d = *(const f32x4*)(ssq + (size_t)row * 16 + 12);
    const float s = ((a[0] + a[1]) + (a[2] + a[3])) + ((b[0] + b[1]) + (b[2] + b[3])) + ((c[0] + c[1]) + (c[2] + c[3])) + ((d[0] + d[1]) + (d[2] + d[3]));
    return rsqrtf(s * (1.0f / 1024.0f) + EPS);
}
__device__ __forceinline__ void cum_local_prompt(KAP a, int bh, LAS float* red, int wave, int lane) {
    unsigned char* ws = a->ws; const float* lfr = (const float*)(ws + WS_LFR); const int b = bh >> 4, h = bh & 15; float* cb = (float*)(ws + WS_CB) + (size_t)bh * 4096;
    float v[8];
#pragma unroll
    for (int k = 0; k < 8; ++k) v[k] = lfr[((size_t)b * 4096 + 512 * wave + 64 * k + lane) * 16 + h];
    float carry = 0.f;
#pragma unroll
    for (int k = 0; k < 8; ++k) {
#pragma unroll
        for (int o = 1; o < 64; o <<= 1) { const float y = __shfl_up(v[k], o); if (lane >= o) v[k] += y; }
        v[k] += carry; carry = __shfl(v[k], 63); }
    if (lane == 0) red[wave] = carry;
    __syncthreads();
    float off = 0.f;
#pragma unroll
    for (int w = 0; w < 7; ++w) off += (w < wave) ? red[w] : 0.f;
#pragma unroll
    for (int k = 0; k < 8; ++k) cb[512 * wave + 64 * k + lane] = -(v[k] + off) * LOG2E;
    VM_WAIT(); __syncthreads();
}
__device__ __forceinline__ void cum_local_sample(KAP a, int L, int pair, LAS float* red, int wave, int lane) {
    unsigned char* ws = a->ws; const float* lfr = (const float*)(ws + WS_LFR); const int bs = pair >> 4, h = pair & 15;
    const float* lfc = a->in[I_CFL] + (size_t)L * 32 * 2048 * 16; float* cb = (float*)(ws + WS_CBS) + (size_t)pair * 2080;
    float x[4], v[4];
#pragma unroll
    for (int k = 0; k < 4; ++k) x[k] = lfc[((size_t)bs * 2048 + 256 * wave + 64 * k + lane) * 16 + h];
    float carry = 0.f;
#pragma unroll
    for (int k = 3; k >= 0; --k) { float t = x[k];
#pragma unroll
        for (int o = 1; o < 64; o <<= 1) { const float y = __shfl_down(t, o); if (lane + o < 64) t += y; }
        v[k] = carry + t - x[k]; carry += __shfl(t, 0); }
    if (lane == 0) red[wave] = carry;
    __syncthreads();
    float off = 0.f;
#pragma unroll
    for (int w = 1; w < 8; ++w) off += (w > wave) ? red[w] : 0.f;
#pragma unroll
    for (int k = 0; k < 4; ++k) cb[256 * wave + 64 * k + lane] = (v[k] + off) * LOG2E;
    if (wave == 0) { float t = (lane < 16) ? lfr[((size_t)MP + bs * 16 + lane) * 16 + h] : 0.f;
#pragma unroll
        for (int o = 1; o < 16; o <<= 1) { const float y = __shfl_up(t, o); if (lane >= o) t += y; }
        if (lane < 32) cb[2048 + lane] = (lane < 16) ? -t * LOG2E : 0.f; }
    VM_WAIT(); __syncthreads();
}
__device__ __forceinline__ void ckv_fixup(KAP a, int L, int gw, int NGW, int lane) {
    unsigned char* ws = a->ws; const f32x4 g = *(const f32x4*)(a->in[I_GMKV] + (size_t)L * 256 + 4 * lane);
    for (int row = gw; row < MT; row += NGW) { const f32x4 s4 = *(const f32x4*)((const float*)(ws + WS_SSQKV) + (size_t)row * 4);
        const float r = rsqrtf(((s4[0] + s4[1]) + (s4[2] + s4[3])) * (1.0f / 256.0f) + EPS);
        const f32x4 v = *(const f32x4*)((const float*)(ws + WS_CKVU) + (size_t)row * 256 + 4 * lane) * r * g;
        if (row < MP) *(f32x4*)(a->out + O_MCP + ((size_t)L * MP + row) * 256 + 4 * lane) = v;
        else { const int rs = row - MP, bs = rs >> 4, t = rs & 15; *(f32x4*)(a->out + O_MCS + ((size_t)L * MS + rs) * 256 + 4 * lane) = v;
            (void)bs; (void)t; } }
}
__device__ __forceinline__ void final_phase(KAP a, int gw, int NGW, int lane) {
    for (int row = gw; row < MT; row += NGW) { const float r = ssq_rstd16((const float*)(a->ws + WS_SSQ), row); float* y = a->out + (size_t)row * 1024; const bf16* x = (const bf16*)(a->ws + WS_XB) + (size_t)row * 1024;
#pragma unroll
        for (int j = 0; j < 4; ++j) { const f32x4 g = *(const f32x4*)(a->in[I_GFINAL] + 256 * j + 4 * lane); const u32x2 w = *(const u32x2*)(x + 256 * j + 4 * lane);
            const f32x4 xv = (f32x4){__builtin_bit_cast(float, w.x << 16), __builtin_bit_cast(float, w.x & 0xffff0000u), __builtin_bit_cast(float, w.y << 16), __builtin_bit_cast(float, w.y & 0xffff0000u)};
            *(f32x4*)(y + 256 * j + 4 * lane) = xv * r * g; } }
}

__device__ __forceinline__ void foxs_item(KAP a, int L, int it, LAS unsigned char* lds, int wid, int lane) {
    unsigned char* ws = a->ws; const int pair = it * 2 + (wid >> 2), b = pair >> 4, h = pair & 15, sp = wid & 3, g = lane >> 4, li = lane & 15;
    const float* ck = a->in[I_CFK] + (size_t)L * 32 * 2048 * 1024 + ((size_t)b * 2048 * 16 + h) * 64;
    const float* cv = a->in[I_CFV] + (size_t)L * 32 * 2048 * 1024 + ((size_t)b * 2048 * 16 + h) * 64;
    const float* cbs = (const float*)(ws + WS_CBS) + (size_t)pair * 2080;
    const bf16* QF = (const bf16*)(ws + WS_QF); const bf16* KF = (const bf16*)(ws + WS_KF); const bf16* VF = (const bf16*)(ws + WS_VF);
    const size_t srow = (size_t)MP + b * 16;
    bf16x8 qf[2];
#pragma unroll
    for (int d0 = 0; d0 < 2; ++d0) qf[d0] = *(const bf16x8*)(QF + (srow + li) * 1024 + h * 64 + 32 * d0 + 8 * g);
    float m = -1e30f, l = 0.f; f32x4 o[4];
#pragma unroll
    for (int db = 0; db < 4; ++db) o[db] = (f32x4){0.f, 0.f, 0.f, 0.f};
    const int kv0 = 512 * sp;
    auto kl = [&](int s, int blk, int d0) -> bf16x8 { const float* p = ck + (size_t)(kv0 + 32 * s + 16 * blk + li) * 1024 + 32 * d0 + 8 * g; return a16::cvt8(*(const f32x4*)p, *(const f32x4*)(p + 4)); };
    auto vl = [&](int s, int db) -> bf16x8 { const float* p = cv + (size_t)(kv0 + 32 * s + 4 * g) * 1024 + 16 * db + li;
        const f32x4 x = (f32x4){p[0], p[1024], p[2048], p[3072]}, y = (f32x4){p[16 * 1024], p[17 * 1024], p[18 * 1024], p[19 * 1024]}; return a16::cvt8(x, y); };
    auto sf = [&](int s, f32x4& sA, f32x4& sB) { const float* p = cbs + kv0 + 32 * s + 4 * g; sA += *(const f32x4*)p; sB += *(const f32x4*)(p + 16); };
    {
        auto kraw = [&](int s, f32x4 (&kr)[8]) {
#pragma unroll
            for (int blk = 0; blk < 2; ++blk)
#pragma unroll
                for (int d0 = 0; d0 < 2; ++d0) { const float* p = ck + (size_t)(kv0 + 32 * s + 16 * blk + li) * 1024 + 32 * d0 + 8 * g; kr[(blk * 2 + d0) * 2] = *(const f32x4*)p; kr[(blk * 2 + d0) * 2 + 1] = *(const f32x4*)(p + 4); } };
        auto vraw = [&](int s, f32x4 (&vr)[8]) {
#pragma unroll
            for (int db = 0; db < 4; ++db) { const float* p = cv + (size_t)(kv0 + 32 * s + 4 * g) * 1024 + 16 * db + li;
                vr[2 * db] = (f32x4){p[0], p[1024], p[2048], p[3072]}; vr[2 * db + 1] = (f32x4){p[16 * 1024], p[17 * 1024], p[18 * 1024], p[19 * 1024]}; } };
        auto step = [&](int s, const f32x4 (&kc)[8], const f32x4 (&vc)[8]) {
            f32x4 sA = {0.f, 0.f, 0.f, 0.f}, sB = {0.f, 0.f, 0.f, 0.f};
#pragma unroll
            for (int d0 = 0; d0 < 2; ++d0) { sA = a16::mfma16(a16::cvt8(kc[d0 * 2], kc[d0 * 2 + 1]), qf[d0], sA); sB = a16::mfma16(a16::cvt8(kc[(2 + d0) * 2], kc[(2 + d0) * 2 + 1]), qf[d0], sB); }
            sf(s, sA, sB);
            float mx = __builtin_fmaxf(__builtin_fmaxf(__builtin_fmaxf(sA[0], sA[1]), __builtin_fmaxf(sA[2], sA[3])), __builtin_fmaxf(__builtin_fmaxf(sB[0], sB[1]), __builtin_fmaxf(sB[2], sB[3])));
            mx = __builtin_fmaxf(mx, __shfl_xor(mx, 16)); mx = __builtin_fmaxf(mx, __shfl_xor(mx, 32));
            const float mn = __builtin_fmaxf(m, mx), alpha = ex2(m - mn); m = mn;
            f32x4 pA, pB;
#pragma unroll
            for (int r = 0; r < 4; ++r) { pA[r] = ex2(sA[r] - mn); pB[r] = ex2(sB[r] - mn); }
            float ps = ((pA[0] + pA[1]) + (pA[2] + pA[3])) + ((pB[0] + pB[1]) + (pB[2] + pB[3]));
            ps += __shfl_xor(ps, 16); ps += __shfl_xor(ps, 32);
            l = l * alpha + ps;
            const float a0 = __shfl(alpha, 4 * g), a1 = __shfl(alpha, 4 * g + 1), a2 = __shfl(alpha, 4 * g + 2), a3 = __shfl(alpha, 4 * g + 3);
#pragma unroll
            for (int db = 0; db < 4; ++db) { o[db][0] *= a0; o[db][1] *= a1; o[db][2] *= a2; o[db][3] *= a3; }
            const u32x4 pw = (u32x4){pk2(pA[0], pA[1]), pk2(pA[2], pA[3]), pk2(pB[0], pB[1]), pk2(pB[2], pB[3])};
            const bf16x8 pf = __builtin_bit_cast(bf16x8, pw);
#pragma unroll
            for (int db = 0; db < 4; ++db) o[db] = a16::mfma16(pf, a16::cvt8(vc[2 * db], vc[2 * db + 1]), o[db]); };
        f32x4 ka[8], va[8], kb[8], vb[8]; kraw(0, ka); vraw(0, va);
#pragma unroll 1
        for (int s = 0; s < 16; s += 2) {
            kraw(s + 1, kb); vraw(s + 1, vb);
            step(s, ka, va);
            const int sn = (s < 14) ? s + 2 : 15; kraw(sn, ka); vraw(sn, va);
            step(s + 1, kb, vb);
        }
    }
    if (sp == 3) {
        auto kl2 = [&](int, int blk, int d0) -> bf16x8 { bf16x8 z = {0, 0, 0, 0, 0, 0, 0, 0}; if (blk == 0) z = *(const bf16x8*)(KF + (srow + li) * 1024 + h * 64 + 32 * d0 + 8 * g); return z; };
        auto vl2 = [&](int, int db) -> bf16x8 { const bf16* p = VF + (srow + 4 * g) * 1024 + h * 64 + 16 * db + li;
            const u32x4 w = (u32x4){(unsigned)p[0] | ((unsigned)p[1024] << 16), (unsigned)p[2048] | ((unsigned)p[3072] << 16), 0u, 0u}; return __builtin_bit_cast(bf16x8, w); };
        auto sf2 = [&](int, f32x4& sA, f32x4& sB) { const f32x4 bb = *(const f32x4*)(cbs + 2048 + 4 * g);
#pragma unroll
            for (int r = 0; r < 4; ++r) { sA[r] = (4 * g + r > li) ? -INFINITY : sA[r] + bb[r]; sB[r] = -INFINITY; } };
        a16::steps<2, 4>(0, 1, qf, kl2, vl2, sf2, m, l, o, lane);
    }
    LAS float* PO = (LAS float*)(lds + RING_OFF) + wid * 1024; LAS float* PM = (LAS float*)(lds + RING_OFF + 32768) + wid * 32;
#pragma unroll
    for (int db = 0; db < 4; ++db)
#pragma unroll
        for (int r = 0; r < 4; ++r) PO[(4 * g + r) * 64 + 16 * db + li] = o[db][r];
    if (g == 0) { PM[li] = m; PM[16 + li] = l; }
    __syncthreads();
    {
        const int w0 = (wid >> 2) * 4, db = wid & 3; const bf16* GF = (const bf16*)(ws + WS_GF); bf16* OF = (bf16*)(ws + WS_OM);
#pragma unroll
        for (int r = 0; r < 4; ++r) { const int q = 4 * g + r; float mm = -1e30f;
#pragma unroll
            for (int s2 = 0; s2 < 4; ++s2) mm = __builtin_fmaxf(mm, ((LAS float*)(lds + RING_OFF + 32768) + (w0 + s2) * 32)[q]);
            float num = 0.f, den = 0.f;
#pragma unroll
            for (int s2 = 0; s2 < 4; ++s2) { LAS float* pm = (LAS float*)(lds + RING_OFF + 32768) + (w0 + s2) * 32; const float wgt = ex2(pm[q] - mm);
                num += wgt * ((LAS float*)(lds + RING_OFF) + (w0 + s2) * 1024)[q * 64 + 16 * db + li]; den += wgt * pm[16 + q]; }
            const size_t idx = (srow + q) * 1024 + h * 64 + 16 * db + li;
            OF[idx] = (bf16)(pk2(num / den * bf2f(GF[idx]), 0.f) & 0xffffu); }
    }
    __syncthreads();
}
__device__ __forceinline__ void mlas_qprime(KAP a, int L, int it, LAS unsigned char* lds, int wid, int lane) {
    unsigned char* ws = a->ws; const int b = (it < 256) ? (it >> 3) : (it - 256), c = (it < 256) ? (it & 7) : 8, g = lane >> 4, li = lane & 15;
    const bf16* QM = (const bf16*)(ws + WS_QM); const bf16* WKN = (const bf16*)(ws + WS_WKN) + (size_t)L * 256 * 2048;
    bf16* QA = (bf16*)(ws + WS_QA) + (size_t)it * 256 * 288;
    LAS bf16* scr = (LAS bf16*)(lds + RING_OFF + wid * 9216);
    for (int hh = 0; hh < 2; ++hh) { const int h = 2 * wid + hh; const bf16* qrow = QM + ((size_t)MP + b * 16 + li) * 1536 + h * 96; bf16* qa = QA + (size_t)(wid * 32 + hh * 16) * 288;
        const bf16x8 qn0 = *(const bf16x8*)(qrow + 8 * g), qn1 = *(const bf16x8*)(qrow + 32 + 8 * g);
#pragma unroll
        for (int cb = 0; cb < 16; ++cb) { const bf16* wp = WKN + (size_t)(16 * cb + li) * 2048 + h * 128 + 8 * g;
            f32x4 acc = a16::mfma16(qn0, *(const bf16x8*)wp, (f32x4){0.f, 0.f, 0.f, 0.f}); acc = a16::mfma16(qn1, *(const bf16x8*)(wp + 32), acc);
#pragma unroll
            for (int r = 0; r < 4; ++r) scr[(4 * g + r) * 288 + 16 * cb + li] = (bf16)(pk2(acc[r], 0.f) & 0xffffu); }
        *(LAS bf16x8*)(scr + li * 288 + 256 + 8 * g) = *(const bf16x8*)(qrow + 64 + 8 * g);
        LDS_WAIT();
#pragma unroll
        for (int j = 0; j < 9; ++j) *(u32x4*)(qa + (size_t)(lane + 64 * j) * 8) = *(const LAS u32x4*)(scr + (lane + 64 * j) * 8);
        LDS_WAIT(); }
    VM_WAIT(); __syncthreads();
}
__device__ __forceinline__ void mlas_attn(KAP a, int L, int it, LAS unsigned char* lds, unsigned lds0) {
    unsigned char* ws = a->ws; const int b = (it < 256) ? (it >> 3) : (it - 256), c = (it < 256) ? (it & 7) : 8; const bf16* QA = (const bf16*)(ws + WS_QA) + (size_t)it * 256 * 288;
    float* P = (float*)(ws + WS_PART) + ((size_t)(b * 9 + c) * 256) * ms::PROW;
    if (c < 8) { const size_t jb = (size_t)L * 32 + b;
        ms::unit<8>(a->in[I_CCKV] + (jb * 2048 + 256 * c) * 256, a->in[I_CKR] + (jb * 2048 + 256 * c) * 32, 255, QA, P, (LAS char*)(lds + RING_OFF), lds0 + RING_OFF);
    } else { const size_t ro = (size_t)L * MS + b * 16;
        ms::unit<1>(a->out + O_MCS + ro * 256, a->out + O_MRS + ro * 32, 15, QA, P, (LAS char*)(lds + RING_OFF), lds0 + RING_OFF); }
}
__device__ __forceinline__ void mlas_combine(KAP a, int L, LAS unsigned char* lds, int gw, int NGW, int wid, int lane) {
    unsigned char* ws = a->ws; LAS bf16* scr = (LAS bf16*)(lds + RING_OFF + wid * 8192);
    const bf16* WV = (const bf16*)(ws + WS_WMKVR) + (size_t)L * 2048 * 256; bf16* OM = (bf16*)(ws + WS_OM); const int g = lane >> 4, li = lane & 15;
    for (int e = gw; e < 512; e += NGW) { const int b = e >> 4, h = e & 15; const int q = lane >> 2, cg = (lane & 3) * 64;
        const float* P0 = (const float*)(ws + WS_PART) + ((size_t)(b * 9) * 256 + (h >> 1) * 32 + (h & 1) * 16 + q) * ms::PROW; constexpr size_t CS = (size_t)256 * ms::PROW;
        float mm = -1e30f;
#pragma unroll
        for (int c = 0; c < 9; ++c) mm = __builtin_fmaxf(mm, P0[c * CS + 256]);
        float wgt[9], den = 0.f;
#pragma unroll
        for (int c = 0; c < 9; ++c) { wgt[c] = ex2(P0[c * CS + 256] - mm); den += wgt[c] * P0[c * CS + 257]; }
        const float id = 1.0f / den;
        for (int j = 0; j < 64; j += 4) { f32x4 acc = (f32x4){0.f, 0.f, 0.f, 0.f};
#pragma unroll
            for (int c = 0; c < 9; ++c) acc += *(const f32x4*)(P0 + c * CS + cg + j) * wgt[c];
            *(LAS u32x2*)(scr + q * 256 + cg + j) = pg8::pk4(acc * id); }
        LDS_WAIT();
        bf16x8 af[8];
#pragma unroll
        for (int d0 = 0; d0 < 8; ++d0) af[d0] = *(const LAS bf16x8*)(scr + li * 256 + 32 * d0 + 8 * g);
#pragma unroll
        for (int db = 0; db < 4; ++db) { f32x4 acc = (f32x4){0.f, 0.f, 0.f, 0.f}; const bf16* wp = WV + (size_t)(h * 128 + 64 + 16 * db + li) * 256 + 8 * g;
#pragma unroll
            for (int d0 = 0; d0 < 8; ++d0) acc = a16::mfma16(af[d0], *(const bf16x8*)(wp + 32 * d0), acc);
            bf16* O = OM + ((size_t)MP + b * 16 + 4 * g) * 1024 + h * 64 + 16 * db + li; const unsigned w0 = pk2(acc[0], acc[1]), w1 = pk2(acc[2], acc[3]);
            O[0] = (bf16)(w0 & 0xffffu); O[1024] = (bf16)(w0 >> 16); O[2048] = (bf16)(w1 & 0xffffu); O[3072] = (bf16)(w1 >> 16); }
        LDS_WAIT();
    }
}
typedef float f32x2v_t __attribute__((ext_vector_type(2)));
template <int K, class F> __device__ __forceinline__ void thin_tiles(const bf16* A, const bf16* Bt, LAS unsigned char* lds, int vcu, int G, int wave, int lane, F epi) {
    const int g = lane >> 4, li = lane & 15; constexpr int nks = K / 256;
    LAS float* part = (LAS float*)(lds + RING_OFF);
#pragma unroll 1
    for (int tt = vcu; tt < 512; tt += G) { const int rb = tt & 31, cg = tt >> 5;
        const bf16* ap = A + (size_t)(MP + 16 * rb + li) * K + wave * (K / 8) + 8 * g; const bf16* bp = Bt + (size_t)(64 * cg + li) * K + wave * (K / 8) + 8 * g;
        f32x4 acc[4];
#pragma unroll
        for (int nb = 0; nb < 4; ++nb) acc[nb] = (f32x4){0.f, 0.f, 0.f, 0.f};
#pragma unroll
        for (int s0 = 0; s0 < nks; s0 += 4) { bf16x8 a[4], b[4][4]; const bf16x8 z = {0, 0, 0, 0, 0, 0, 0, 0};
#pragma unroll
            for (int u = 0; u < 4; ++u) { const bool on = s0 + u < nks; a[u] = on ? *(const bf16x8*)(ap + 32 * (s0 + u)) : z;
#pragma unroll
                for (int nb = 0; nb < 4; ++nb) b[u][nb] = on ? *(const bf16x8*)(bp + (size_t)nb * 16 * K + 32 * (s0 + u)) : z; }
#pragma unroll
            for (int u = 0; u < 4; ++u)
#pragma unroll
                for (int nb = 0; nb < 4; ++nb) acc[nb] = a16::mfma16(a[u], b[u][nb], acc[nb]); }
#pragma unroll
        for (int nb = 0; nb < 4; ++nb)
#pragma unroll
            for (int r = 0; r < 4; ++r) part[wave * 1024 + (4 * g + r) * 64 + 16 * nb + li] = acc[nb][r];
        __syncthreads();
        const int e = (2 * wave + (lane >> 5)) * 64 + 2 * (lane & 31); float s0v = 0.f, s1v = 0.f;
#pragma unroll
        for (int w = 0; w < 8; ++w) { const f32x2v_t v = *(const LAS f32x2v_t*)(part + w * 1024 + e); s0v += v[0]; s1v += v[1]; }
        epi(MP + 16 * rb + 2 * wave + (lane >> 5), 64 * cg + 2 * (lane & 31), cg, s0v, s1v);
        __syncthreads(); }
}
template <int K> __device__ __forceinline__ void thin_resid(KAP a, const bf16* A, const bf16* Bt, int first, LAS unsigned char* lds, int vcu, int G, int wave, int lane) {
    unsigned char* ws = a->ws; const float* xs = a->in[I_XS] - (size_t)MP * 1024; bf16* XB = (bf16*)(ws + WS_XB); float* SSQ = (float*)(ws + WS_SSQ);
    thin_tiles<K>(A, Bt, lds, vcu, G, wave, lane, [&](int row, int col, int cg, float v0, float v1) {
        const size_t o = (size_t)row * 1024 + col; float x0, x1;
        if (first) { const f32x2v_t xo = *(const f32x2v_t*)(xs + o); x0 = xo[0]; x1 = xo[1]; } else { const unsigned w = *(const unsigned*)(XB + o); x0 = __builtin_bit_cast(float, w << 16); x1 = __builtin_bit_cast(float, w & 0xffff0000u); }
        x0 += v0; x1 += v1; *(unsigned*)(XB + o) = pk2(x0, x1);
        float sq = x0 * x0 + x1 * x1; sq += __shfl_xor(sq, 1); sq += __shfl_xor(sq, 2); sq += __shfl_xor(sq, 4); sq += __shfl_xor(sq, 8); sq += __shfl_xor(sq, 16);
        if ((lane & 31) == 0) SSQ[(size_t)row * 16 + cg] = sq; });
}
__device__ __forceinline__ void thin_xq(KAP a, const bf16* Bt, LAS unsigned char* lds, int vcu, int G, int wave, int lane) {
    unsigned char* ws = a->ws; const bf16* XB = (const bf16*)(ws + WS_XB); bf16* QX = (bf16*)(ws + WS_QX); const float* SSQ = (const float*)(ws + WS_SSQ);
    thin_tiles<1024>(XB, Bt, lds, vcu, G, wave, lane, [&](int row, int col, int, float v0, float v1) {
        const float rs = ssq_rstd16(SSQ, row) * C2_X; *(unsigned*)(QX + (size_t)row * 1024 + col) = pk2(v0 * rs, v1 * rs); });
}
#ifndef DBG_DOUBLE
#define DBG_DOUBLE 0
#endif

constexpr int NPH = 41;
struct Ctx { int lane, wave, G, bx, vcu, gw, NGW; };
__device__ __forceinline__ Ctx mk_ctx() { Ctx c; const int tid = pg8::pg8_tid(); c.lane = tid & 63; c.wave = __builtin_amdgcn_readfirstlane(tid >> 6); int G_ = gridDim.x, bx_ = blockIdx.x; asm volatile("" : "+s"(G_), "+s"(bx_)); c.G = G_; c.bx = bx_;
    c.vcu = (c.G % 8 == 0) ? (c.bx % 8) * (c.G / 8) + c.bx / 8 : c.bx; c.gw = c.vcu * NWAVES + c.wave; c.NGW = c.G * NWAVES; return c; }
#define RSX(ws) pg8::RowScale{(const float*)((ws) + WS_SSQ), 16, 4, 1.0f / 1024.0f}
#define PHASE __device__ __noinline__ void
#define FATPH __device__ __forceinline__ void
__device__ __forceinline__ unsigned char* ws_ptr() { GAS unsigned char* w = (GAS unsigned char*)KA->ws; asm volatile("" : "+s"(w)); return (unsigned char*)w; }
#define WSB(off) ((const bf16*)(ws_ptr() + (off)))
__device__ __forceinline__ const float* in_ptr(int i) { GAS const float* w = (GAS const float*)KA->in[i]; asm volatile("" : "+s"(w)); return (const float*)w; }
__device__ __forceinline__ float* out_ptr() { GAS float* w = (GAS float*)KA->out; asm volatile("" : "+s"(w)); return (float*)w; }

FATPH ph_prologue(KAP a, LAS unsigned char* lds, int pmask) { const Ctx c = mk_ctx(); p0_prologue(a, lds, c.gw, c.NGW, c.wave, c.lane, pmask); __syncthreads(); }
FATPH ph_memkv(LAS unsigned char* lds) { const Ctx c = mk_ctx(); unsigned char* ws = ws_ptr(); float* out = out_ptr();
    pg8::Gemm g{WSB(WS_MB), WSB(WS_WXKV), 2048, 8192, 1024}; pg8::StaticOrder S; S.init(2048, 8192, c.G, c.bx);
    pg8::EpiMemKV E{out + O_MKP, out + O_MVP, (bf16*)(ws + WS_MKB), (bf16*)(ws + WS_MVB)};
    pg8::gemm_phase<pg8::EpiMemKV, pg8::StaticOrder, true, true>(lds + RING_OFF, g, S, E); }
FATPH ph_fox_in(LAS unsigned char* lds, int L) { const Ctx c = mk_ctx(); unsigned char* ws = ws_ptr(); float* out = out_ptr();
    pg8::Gemm g{WSB(WS_XB), WSB(WS_WFI) + (size_t)L * 4352 * 1024, MT, 4352, 1024}; pg8::StaticOrder S; S.init(MT, 4352, c.G, c.bx);
    pg8::EpiFoxIn E{RSX(ws), ws, out, in_ptr(I_BFF) + L * 16, L};
    pg8::gemm_phase<pg8::EpiFoxIn, pg8::StaticOrder, true, true>(lds + RING_OFF, g, S, E); }
FATPH ph_fox_sample(KAP a, LAS unsigned char* lds, int L) { const Ctx c = mk_ctx(); LAS float* red = (LAS float*)(lds + RING_OFF + 65536);
    for (int it = c.vcu; it < 256; it += c.G) { cum_local_sample(a, L, 2 * it, red, c.wave, c.lane); cum_local_sample(a, L, 2 * it + 1, red, c.wave, c.lane); foxs_item(a, L, it, lds, c.wave, c.lane); } }
__device__ __forceinline__ void unit2_of(int e, int& bh, int& qb) { bh = e >> 3; const int k = e & 7, s = (k >> 2) & 1, ii = k & 3, j = 2 * s + (ii >> 1); qb = (ii & 1) ? 7 - j : j; }
__device__ __forceinline__ void unit_of(int e, int& bh, int& qb) { bh = e >> 4; const int k = e & 15, s = (k >> 3) & 1, ii = k & 7, j = 2 * (ii >> 1) + s; qb = (ii & 1) ? 15 - j : j; }
FATPH ph_fox_attn(LAS unsigned char* lds, unsigned lds0) { const Ctx c = mk_ctx(); unsigned char* ws = ws_ptr();
    for (int e0 = c.vcu * 4; e0 < 1024; e0 += c.G * 4) {
        __syncthreads(); cum_local_prompt(KA, e0 >> 3, (LAS float*)(lds + RING_OFF + 65536), c.wave, c.lane);
        for (int i = 0; i < 4; ++i) { int bh, qb; unit2_of(e0 + i, bh, qb); const int b = bh >> 4, h = bh & 15;
            fa::Args A{WSB(WS_QF), 1024, h * 64, WSB(WS_KF), 1024, h * 64, nullptr, WSB(WS_VF), 1024, h * 64, (bf16*)(ws + WS_OM), h * 64,
                       WSB(WS_GF), (const float*)(ws + WS_CB) + (size_t)bh * 4096};
            fa::unit2<0>(A, (long)b * 4096, qb, (LAS char*)(lds + RING_OFF), lds0 + RING_OFF); } } }
FATPH ph_fox_mix(KAP a, LAS unsigned char* lds, unsigned lds0, int L) { const Ctx c = mk_ctx(); unsigned char* ws = ws_ptr(); LAS float* red = (LAS float*)(lds + RING_OFF + 65536);
    const int pos = (c.vcu >> 1) % 5;
    for (int e0 = c.vcu * 4, it = c.vcu; e0 < 1024 || it < 256; e0 += c.G * 4, it += c.G) {
        if (e0 < 1024) { __syncthreads(); cum_local_prompt(a, e0 >> 3, red, c.wave, c.lane); }
#pragma unroll 1
        for (int i = 0; i < 5; ++i) {
            if (i == pos && it < 256) { const Ctx c2 = mk_ctx(); int itv = it; asm volatile("" : "+s"(itv));
                __syncthreads(); cum_local_sample(a, L, 2 * itv, red, c2.wave, c2.lane); cum_local_sample(a, L, 2 * itv + 1, red, c2.wave, c2.lane); foxs_item(a, L, itv, lds, c2.wave, c2.lane); __syncthreads(); }
            if (i < 4 && e0 < 1024) { int ev = e0 + i; asm volatile("" : "+s"(ev)); int bh, qb; unit2_of(ev, bh, qb); const int b = bh >> 4, h = bh & 15;
                fa::Args A{WSB(WS_QF), 1024, h * 64, WSB(WS_KF), 1024, h * 64, nullptr, WSB(WS_VF), 1024, h * 64, (bf16*)(ws + WS_OM), h * 64,
                           WSB(WS_GF), (const float*)(ws + WS_CB) + (size_t)bh * 4096};
                fa::unit2<0>(A, (long)b * 4096, qb, (LAS char*)(lds + RING_OFF), lds0 + RING_OFF); } } } }
template <bool ABLK = false>
FATPH ph_resid(LAS unsigned char* lds, const bf16* A, const bf16* Bt, int K, int first, int dummy = 0) { const Ctx c = mk_ctx(); unsigned char* ws = ws_ptr();
    pg8::Gemm g{A, Bt, MP, 1024, K}; pg8::StaticOrder S; S.init(MP, 1024, c.G, c.bx);
    pg8::EpiResid E{KA->in[I_XP], KA->in[I_XS], first, dummy ? (bf16*)(ws + WS_R1 + (size_t)MT * 4096) : (bf16*)(ws + WS_XB), dummy ? (float*)(ws + WS_R1 + (size_t)MT * 6144) : (float*)(ws + WS_SSQ)};
    pg8::gemm_phase<pg8::EpiResid, pg8::StaticOrder, true, true, ABLK>(lds + RING_OFF, g, S, E); }
FATPH ph_scale_gemm(LAS unsigned char* lds, const bf16* A, const bf16* Bt, int M, int N, int K, const float* ssq, int stride, int ngrp, float inv_n, bf16* O, float scale) { const Ctx c = mk_ctx();
    pg8::Gemm g{A, Bt, M, N, K}; pg8::StaticOrder S; S.init(M, N, c.G, c.bx);
    pg8::EpiScaleBf16 E{pg8::RowScale{ssq, stride, ngrp, inv_n}, O, N, scale};
    pg8::gemm_phase<pg8::EpiScaleBf16, pg8::StaticOrder, true, true>(lds + RING_OFF, g, S, E); }
FATPH ph_cross(LAS unsigned char* lds, unsigned lds0, int layer) { const Ctx c = mk_ctx(); unsigned char* ws = ws_ptr();
    const bf16* QX = WSB(WS_QX); bf16* OX = (bf16*)(ws + WS_OM);
    const bool bal = (c.G == 256); const int nu = bal ? (c.vcu < 128 ? 1 : 3) : 2, ub = bal ? (c.vcu < 128 ? c.vcu : 128 + 3 * (c.vcu - 128)) : c.vcu * 2;
    for (int u0 = ub; u0 < 512; u0 += (bal ? 512 : c.G * 2))
        for (int i = 0; i < nu; ++i) { const int u = u0 + i, bh = u >> 4, qb = u & 15, b = bh >> 2, h = bh & 3; const size_t ko = ((size_t)layer * 2048 + b * 256) * 1024 + h * 256;
            xa::unit<false>(WSB(WS_MKB) + ko, WSB(WS_MVB) + ko, 1024, QX, OX, (size_t)b * 4096 + qb * 256, h * 256, 32, false, (LAS char*)(lds + RING_OFF), lds0 + RING_OFF); }
    for (int e = c.vcu; e < 128; e += c.G) { const int bs = e >> 2, h = e & 3; const size_t ko = ((size_t)(layer * 32 + bs) * 256) * 1024 + h * 256;
        xa::unit<true>(in_ptr(I_CMK) + ko, in_ptr(I_CMV) + ko, 1024, QX, OX, (size_t)MP + bs * 16, h * 256, 16, true, (LAS char*)(lds + RING_OFF), lds0 + RING_OFF); } }
FATPH ph_gu(LAS unsigned char* lds, int layer) { const Ctx c = mk_ctx(); unsigned char* ws = ws_ptr();
    pg8::Gemm g{WSB(WS_XB), WSB(WS_WGU) + (size_t)layer * 5632 * 1024, MT, 5632, 1024}; pg8::StaticOrder S; S.init(MT, 5632, c.G, c.bx);
    pg8::EpiSwiglu E{RSX(ws), (bf16*)(ws + WS_HB)}; pg8::gemm_phase<pg8::EpiSwiglu, pg8::StaticOrder, true, true>(lds + RING_OFF, g, S, E); }
FATPH ph_gu_null(LAS unsigned char* lds, int layer) { const Ctx c = mk_ctx();
    pg8::Gemm g{WSB(WS_XB), WSB(WS_WGU) + (size_t)layer * 5632 * 1024, MT, 5632, 1024}; pg8::StaticOrder S; S.init(MT, 5632, c.G, c.bx);
    pg8::EpiNull E{}; pg8::gemm_phase<pg8::EpiNull, pg8::StaticOrder, true, true>(lds + RING_OFF, g, S, E); }
FATPH ph_mla_a(LAS unsigned char* lds, int L) { const Ctx c = mk_ctx(); unsigned char* ws = ws_ptr(); float* out = out_ptr();
    pg8::Gemm g{WSB(WS_XB), WSB(WS_WMA) + (size_t)L * 768 * 1024, MT, 768, 1024}; pg8::StaticOrder S; S.init(MT, 768, c.G, c.bx);
    pg8::EpiMlaA E{RSX(ws), (float*)(ws + WS_CKVU), (bf16*)(ws + WS_CKVUB), (float*)(ws + WS_SSQKV), (bf16*)(ws + WS_CQ), (float*)(ws + WS_SSQQ), (bf16*)(ws + WS_KRB),
                   out + O_MRP + (size_t)L * MP * 32, out + O_MRS + (size_t)L * MS * 32, (const float*)(ws + WS_ROPC), (const float*)(ws + WS_ROPS)};
    pg8::gemm_phase<pg8::EpiMlaA, pg8::StaticOrder, true, true>(lds + RING_OFF, g, S, E); }
PHASE ph_fixup(KAP a, int L) { const Ctx c = mk_ctx(); ckv_fixup(a, L, c.gw, c.NGW, c.lane); }
FATPH ph_mla_q(LAS unsigned char* lds, int L, int kq) { const Ctx c = mk_ctx(); unsigned char* ws = ws_ptr();
    pg8::Gemm g{WSB(WS_CQ), WSB(WS_WMQ) + (size_t)L * 1536 * 384, MT, 1536, kq}; pg8::StaticOrder S; S.init(MT, 1536, c.G, c.bx);
    pg8::EpiMlaQ E{pg8::RowScale{(const float*)(ws + WS_SSQQ), 8, 2, 1.0f / 384.0f}, (bf16*)(ws + WS_QM), (const float*)(ws + WS_ROPC), (const float*)(ws + WS_ROPS)};
    pg8::gemm_phase<pg8::EpiMlaQ, pg8::StaticOrder, true, false>(lds + RING_OFF, g, S, E); }
PHASE ph_mla_qprime(KAP a, LAS unsigned char* lds, int L, int it) { const Ctx c = mk_ctx(); mlas_qprime(a, L, it, lds, c.wave, c.lane); }
FATPH ph_mla_sample(LAS unsigned char* lds, unsigned lds0, int L) { const Ctx c = mk_ctx(); for (int it = c.vcu; it < 288; it += c.G) { ph_mla_qprime(KA, lds, L, it); mlas_attn(KA, L, it, lds, lds0); } __syncthreads(); }
FATPH ph_mla_attn(LAS unsigned char* lds, unsigned lds0) { const Ctx c = mk_ctx(); unsigned char* ws = ws_ptr();
    for (int e0 = c.vcu * 4; e0 < 1024; e0 += c.G * 4)
        for (int i = 0; i < 4; ++i) { int bh, qb; unit2_of(e0 + i, bh, qb); const int b = bh >> 4, h = bh & 15;
            fa::Args A{WSB(WS_QM), 1536, h * 96, WSB(WS_KVM), 2048, h * 128, WSB(WS_KRB), WSB(WS_KVM), 2048, h * 128 + 64, (bf16*)(ws + WS_OM), h * 64,
                       nullptr, nullptr};
            fa::unit2<1>(A, (long)b * 4096, qb, (LAS char*)(lds + RING_OFF), lds0 + RING_OFF); } }
FATPH ph_mla_comb(LAS unsigned char* lds, int L) { const Ctx c = mk_ctx(); mlas_combine(KA, L, lds, c.gw, c.NGW, c.wave, c.lane); }
PHASE ph_thin_resid(KAP a, LAS unsigned char* lds, const bf16* A, const bf16* Bt, int K, int first) { const Ctx c = mk_ctx(); if (K == 1024) thin_resid<1024>(a, A, Bt, first, lds, c.vcu, c.G, c.wave, c.lane); else thin_resid<DFF>(a, A, Bt, first, lds, c.vcu, c.G, c.wave, c.lane); }
PHASE ph_thin_xq(KAP a, LAS unsigned char* lds, const bf16* Bt) { const Ctx c = mk_ctx(); thin_xq(a, Bt, lds, c.vcu, c.G, c.wave, c.lane); }
PHASE ph_final(KAP a) { const Ctx c = mk_ctx(); final_phase(a, c.gw, c.NGW, c.lane); }
PHASE ph_grid_bar(GAS unsigned* barw, unsigned x, volatile LAS unsigned* st) { XcdBarrier b; b.bar = (unsigned*)barw; b.x = x; b.st = st; xcd_barrier(b); }

__global__ void __launch_bounds__(NWAVES * 64, 2) fwd_kernel(KArgs args) {
    extern __shared__ __attribute__((aligned(16))) unsigned char lds_raw[];
    LAS unsigned char* lds = (LAS unsigned char*)lds_raw;
    volatile LAS unsigned* MISC = (volatile LAS unsigned*)(lds + MISC_OFF);
    const int tid = threadIdx.x;
    const unsigned lds0 = (unsigned)(uintptr_t)lds_raw;
    for (int u = tid; u < (LDS_BYTES - LDSCTL_OFF) / 4; u += NWAVES * 64) ((LAS unsigned*)(lds + LDSCTL_OFF))[u] = 0u;
    __syncthreads();
    const XcdBarrier bar = xcd_barrier_post((unsigned*)(args.ws + WS_CTL) + CW_BAR, MISC + 8);
    const int lo = args.ph_lo, hi = args.ph_hi;
#ifndef DBG_DOUBLE
#define DBG_DOUBLE 0
#endif
#ifndef DBG_P0_AGAIN
#define DBG_P0_AGAIN 0
#endif
#define REP(bit) for (int rep_ = 0; rep_ < ((DBG_DOUBLE & (bit)) ? 2 : 1); ++rep_)
#define IN(k) (lo <= (k) && (k) < hi)
#define SEAM(k) do { if (IN(k) && IN((k) + 1)) { REP(256) ph_grid_bar((GAS unsigned*)bar.bar, bar.x, bar.st); } } while (0)
    if (IN(0)) { ph_prologue(KA, lds, 0x7f); if (DBG_P0_AGAIN) ph_prologue(KA, lds, DBG_P0_AGAIN); }
    SEAM(0);
    if (IN(1)) ph_memkv(lds);
    SEAM(1);
    for (int L = 0; L < 2; ++L) {
        const int pb = 2 + 19 * L;
        if (IN(pb)) { REP(8) ph_fox_in(lds, L); }
        SEAM(pb);
        if (IN(pb + 2)) { if (DBG_DOUBLE & 96) { REP(64) ph_fox_sample(KA, lds, L); REP(32) ph_fox_attn(lds, lds0); } else ph_fox_mix(KA, lds, lds0, L); }
        SEAM(pb + 2);
        if (IN(pb + 3)) { ph_thin_resid(KA, lds, WSB(WS_OM), WSB(WS_WFO) + (size_t)L * 1024 * 1024, 1024, L == 0); if (DBG_DOUBLE & 512) ph_resid(lds, WSB(WS_OM), WSB(WS_WFO) + (size_t)L * 1024 * 1024, 1024, L == 0, 1); ph_resid(lds, WSB(WS_OM), WSB(WS_WFO) + (size_t)L * 1024 * 1024, 1024, L == 0); }
        SEAM(pb + 3);
        for (int sub = 0; sub < 2; ++sub) {
            const int layer = 2 * L + sub, cb = pb + 4 + 10 * sub;
            if (sub == 1) {
                if (IN(pb + 9)) ph_mla_a(lds, L);
                SEAM(pb + 9);
                if (IN(pb + 10)) { ph_fixup(KA, L); ph_mla_q(lds, L, 384);
                    ph_scale_gemm(lds, WSB(WS_CKVUB), WSB(WS_WMKV) + (size_t)L * 2048 * 256, MP, 2048, 256, (const float*)(ws_ptr() + WS_SSQKV), 4, 1, 1.0f / 256.0f, (bf16*)(ws_ptr() + WS_KVM), 1.0f); }
                SEAM(pb + 10);
                if (IN(pb + 11)) { REP(128) ph_mla_sample(lds, lds0, L); REP(32) ph_mla_attn(lds, lds0); }
                SEAM(pb + 11);
                if (IN(pb + 12)) REP(16) ph_mla_comb(lds, L);
                SEAM(pb + 12);
                if (IN(pb + 13)) { ph_thin_resid(KA, lds, WSB(WS_OM), WSB(WS_WMO) + (size_t)L * 1024 * 1024, 1024, 0); if (DBG_DOUBLE & 512) ph_resid(lds, WSB(WS_OM), WSB(WS_WMO) + (size_t)L * 1024 * 1024, 1024, 0, 1); ph_resid(lds, WSB(WS_OM), WSB(WS_WMO) + (size_t)L * 1024 * 1024, 1024, 0); }
                SEAM(pb + 13);
            }
            if (IN(cb)) { ph_thin_xq(KA, lds, WSB(WS_WXQ) + (size_t)layer * 1024 * 1024); ph_scale_gemm(lds, WSB(WS_XB), WSB(WS_WXQ) + (size_t)layer * 1024 * 1024, MP, 1024, 1024, (const float*)(ws_ptr() + WS_SSQ), 16, 4, 1.0f / 1024.0f, (bf16*)(ws_ptr() + WS_QX), C2_X); }
            SEAM(cb);
            if (IN(cb + 1)) REP(2) ph_cross(lds, lds0, layer);
            SEAM(cb + 1);
            if (IN(cb + 2)) { ph_thin_resid(KA, lds, WSB(WS_OM), WSB(WS_WXO) + (size_t)layer * 1024 * 1024, 1024, 0); if (DBG_DOUBLE & 4096) ph_resid(lds, WSB(WS_OM), WSB(WS_WXO) + (size_t)layer * 1024 * 1024, 1024, 0, 1); ph_resid(lds, WSB(WS_OM), WSB(WS_WXO) + (size_t)layer * 1024 * 1024, 1024, 0); }
            SEAM(cb + 2);
            if (IN(cb + 3)) { if (DBG_DOUBLE & 1024) ph_gu_null(lds, layer); REP(8) ph_gu(lds, layer); }
            SEAM(cb + 3);
            if (IN(cb + 4)) { ph_thin_resid(KA, lds, WSB(WS_HB), WSB(WS_WDN) + (size_t)layer * 1024 * 2816, DFF, 0); if (DBG_DOUBLE & 2048) ph_resid<true>(lds, WSB(WS_HB), WSB(WS_WDN) + (size_t)layer * 1024 * 2816, DFF, 0, 1); ph_resid<true>(lds, WSB(WS_HB), WSB(WS_WDN) + (size_t)layer * 1024 * 2816, DFF, 0); }
            SEAM(cb + 4);
        }
    }
    if (IN(40)) ph_final(KA);
#undef IN
#undef SEAM
}

#ifndef DBG_PH_HI
#define DBG_PH_HI NPH
#endif
#ifndef MK_PER_PHASE
#define MK_PER_PHASE 0
#endif
extern "C" void kernel_launch(void* const* d_in, const int* in_sizes, int n_in, void* d_out, int out_size, void* d_ws, size_t ws_size, hipStream_t stream) {
    static int grid = 0;
    if (grid == 0) {
        if (n_in != N_IN || (size_t)out_size != O_END || ws_size < WS_END) { fprintf(stderr, "kernel_launch: unexpected shapes (n_in %d, out %d, ws %zu; need %d, %zu, %zu)\n", n_in, out_size, ws_size, (int)N_IN, (size_t)O_END, (size_t)WS_END); grid = -1; return; }
        int dev = 0, cus = 0, per_cu = 0;
        if (hipGetDevice(&dev) != hipSuccess || hipDeviceGetAttribute(&cus, hipDeviceAttributeMultiprocessorCount, dev) != hipSuccess) { grid = -1; return; }
        if (hipFuncSetAttribute((const void*)fwd_kernel, hipFuncAttributeMaxDynamicSharedMemorySize, LDS_BYTES) != hipSuccess) { fprintf(stderr, "kernel_launch: hipFuncSetAttribute failed\n"); grid = -1; return; }
        if (hipOccupancyMaxActiveBlocksPerMultiprocessor(&per_cu, (const void*)fwd_kernel, NWAVES * 64, LDS_BYTES) != hipSuccess || per_cu < 1) { fprintf(stderr, "kernel_launch: occupancy query reports %d\n", per_cu); }
        (void)hipGetLastError();
        grid = cus;
    }
    if (grid < 0) return;
    if (hipMemsetAsync((char*)d_ws + WS_CTL, 0, CTL_ZERO_BYTES, stream) != hipSuccess) return;
    KArgs a{};
    for (int i = 0; i < N_IN; ++i) a.in[i] = (const float*)d_in[i];
    a.out = (float*)d_out; a.ws = (unsigned char*)d_ws;
#if MK_PER_PHASE
    for (int p = 0; p < NPH; ++p) { a.ph_lo = p; a.ph_hi = p + 1; hipLaunchKernelGGL(fwd_kernel, dim3(grid), dim3(NWAVES * 64), LDS_BYTES, stream, a); }
#else
    a.ph_lo = 0; a.ph_hi = DBG_PH_HI; hipLaunchKernelGGL(fwd_kernel, dim3(grid), dim3(NWAVES * 64), LDS_BYTES, stream, a);
#endif
}
```

```cpp
#include <hip/hip_runtime.h>
#include <cstdint>
#include <cstdio>
#include <cmath>

constexpr int D = 1024, MP = 32768, MS = 512, MT = MP + MS, SEQ = 4096, NBP = 8, NBS = 32, DSEQ = 16, PAST = 2048, NMEM = 256;
constexpr int DFF = 2816, KPAD = 2112;
constexpr float EPS = 1e-6f, LOG2E = 1.4426950408889634f;
constexpr float C2_FOX = 0.125f * LOG2E, C2_MLA = 0.10206207261596575f * LOG2E, C2_X = 0.0625f * LOG2E;

constexpr size_t O_Y = 0;
constexpr size_t O_FKP = (size_t)MT * D;
constexpr size_t O_FVP = O_FKP + (size_t)2 * MP * 1024;
constexpr size_t O_FLP = O_FVP + (size_t)2 * MP * 1024;
constexpr size_t O_MCP = O_FLP + (size_t)2 * MP * 16;
constexpr size_t O_MRP = O_MCP + (size_t)2 * MP * 256;
constexpr size_t O_MKP = O_MRP + (size_t)2 * MP * 32;
constexpr size_t O_MVP = O_MKP + (size_t)4 * 2048 * 1024;
constexpr size_t O_FKS = O_MVP + (size_t)4 * 2048 * 1024;
constexpr size_t O_FVS = O_FKS + (size_t)2 * MS * 1024;
constexpr size_t O_FLS = O_FVS + (size_t)2 * MS * 1024;
constexpr size_t O_MCS = O_FLS + (size_t)2 * MS * 16;
constexpr size_t O_MRS = O_MCS + (size_t)2 * MS * 256;
constexpr size_t O_END = O_MRS + (size_t)2 * MS * 32;

enum { I_XP = 0, I_XS, I_MEM, I_CFK, I_CFV, I_CFL, I_CCKV, I_CKR, I_CMK, I_CMV, I_GMIX, I_GCROSS, I_GMEM, I_GFFN, I_GFINAL,
       I_WFI, I_BFF, I_WFO, I_WMA, I_GMQ, I_GMKV, I_WMQB, I_WMKVB, I_WMO, I_WXQ, I_WXKV, I_WXO, I_WGU, I_WDN, N_IN };


constexpr size_t al256(size_t x) { return (x + 255) & ~(size_t)255; }
constexpr size_t WS_CTL = 0, CTL_ZERO_BYTES = 1u << 20;
constexpr size_t WS_WFI = 2u << 20;
constexpr size_t WS_WFO = WS_WFI + (size_t)2 * 4352 * 1024 * 2;
constexpr size_t WS_WMA = WS_WFO + (size_t)2 * 1024 * 1024 * 2;
constexpr size_t WS_WMQ = WS_WMA + (size_t)2 * 768 * 1024 * 2;
constexpr size_t WS_WMKV = WS_WMQ + (size_t)2 * 1536 * 384 * 2;
constexpr size_t WS_WMKVR = WS_WMKV + (size_t)2 * 2048 * 256 * 2;
constexpr size_t WS_WKN = WS_WMKVR + (size_t)2 * 2048 * 256 * 2;
constexpr size_t WS_WMO = WS_WKN + (size_t)2 * 256 * 2048 * 2;
constexpr size_t WS_WXQ = WS_WMO + (size_t)2 * 1024 * 1024 * 2;
constexpr size_t WS_WXO = WS_WXQ + (size_t)4 * 1024 * 1024 * 2;
constexpr size_t WS_WXKV = WS_WXO + (size_t)4 * 1024 * 1024 * 2;
constexpr size_t WS_WGU = WS_WXKV + (size_t)4 * 2048 * 1024 * 2;
constexpr size_t WS_WDN = WS_WGU + (size_t)4 * 5632 * 1024 * 2;
constexpr size_t WS_WFF = WS_WDN + (size_t)4 * 1024 * 2816 * 2;
constexpr size_t WS_ROPC = WS_WFF + (size_t)2 * 16 * 1024 * 4;
constexpr size_t WS_ROPS = WS_ROPC + (size_t)4096 * 16 * 4;
constexpr size_t WS_XB = WS_ROPS + (size_t)4096 * 16 * 4;
constexpr size_t WS_SSQ = WS_XB + (size_t)MT * 1024 * 2;
constexpr size_t WS_R1 = al256(WS_SSQ + (size_t)MT * 16 * 4);
constexpr size_t SZ_ACT = (size_t)MT * 1024 * 2;
constexpr size_t WS_QF = WS_R1, WS_KF = WS_R1 + SZ_ACT, WS_VF = WS_R1 + 2 * SZ_ACT, WS_GF = WS_R1 + 3 * SZ_ACT;
constexpr size_t WS_QM = WS_R1, WS_KVM = al256(WS_R1 + (size_t)MT * 1536 * 2);
static_assert(WS_KVM + (size_t)MP * 2048 * 2 <= WS_R1 + 4 * SZ_ACT, "MLA overlay fits");
constexpr size_t WS_OM = WS_R1 + 4 * SZ_ACT;
constexpr size_t WS_LFR = WS_OM + SZ_ACT;
constexpr size_t WS_CB = WS_LFR + (size_t)MT * 16 * 4;
constexpr size_t WS_CBS = WS_CB + (size_t)8 * 16 * 4096 * 4;
constexpr size_t WS_CKVU = al256(WS_CBS + (size_t)32 * 16 * 2080 * 4);
constexpr size_t WS_CKVUB = WS_CKVU + (size_t)MT * 256 * 4;
constexpr size_t WS_SSQKV = WS_CKVUB + (size_t)MT * 256 * 2;
constexpr size_t WS_CQ = WS_SSQKV + (size_t)MT * 4 * 4;
constexpr size_t WS_SSQQ = WS_CQ + (size_t)MT * 384 * 2;
constexpr size_t WS_KRB = WS_SSQQ + (size_t)MT * 8 * 4;
constexpr size_t WS_QA = al256(WS_KRB + (size_t)MT * 32 * 2);
constexpr size_t WS_PART = al256(WS_QA + (size_t)288 * 256 * 288 * 2);
constexpr size_t WS_QX = al256(WS_PART + (size_t)32 * 9 * 256 * 264 * 4);
constexpr size_t WS_MB = WS_QX + SZ_ACT;
constexpr size_t WS_MKB = WS_MB + (size_t)2048 * 1024 * 2;
constexpr size_t WS_MVB = WS_MKB + (size_t)4 * 2048 * 1024 * 2;
constexpr size_t WS_HB = WS_MVB + (size_t)4 * 2048 * 1024 * 2;
constexpr size_t WS_END = WS_HB + (size_t)MT * DFF * 2;
constexpr int CW_BAR = 4096;

namespace pg8 {
#define PG8_LAS __attribute__((address_space(3)))
typedef unsigned short bf16_t;
typedef short bf16x8 __attribute__((ext_vector_type(8)));
typedef float f32x4 __attribute__((ext_vector_type(4)));
typedef unsigned u32x4 __attribute__((ext_vector_type(4)));
constexpr int BM = 256, BK = 64, HALF = 128, HTB = HALF * BK * 2  , STAGE_BYTES = 8 * HTB, NXCD = 8, WGM = 8;

__host__ __device__ __forceinline__ int lds_byte(int r, int c) { const int st = (r >> 4) * 2 + (c >> 5), rr = r & 15, cc = c & 31, ob = rr * 64 + cc * 2; return st * 1024 + (ob ^ (((ob >> 9) & 1) << 5)); }
__host__ __device__ __forceinline__ void stage_rc(int b, int& R, int& C) { const int st = b / 1024, sb = b % 1024, swz = sb ^ (((sb >> 9) & 1) << 5); R = (st >> 1) * 16 + swz / 64; C = (st & 1) * 32 + (swz % 64) / 2; }
__host__ __device__ __forceinline__ int perm32(int rho) { const int n = rho >> 4, i = rho & 15; return 8 * (i >> 2) + 4 * n + (i & 3); }

struct Unit { int pm, pn; };
struct Gemm { const bf16_t* A; const bf16_t* Bt; int M, N, K; };

struct StaticOrder {
    int nM, nN, nwg, G, c;
    __host__ __device__ void init(int M, int N, int G_, int c_) { nM = M / BM; nN = N / BM; nwg = nM * nN; G = G_; c = c_; }
    __host__ __device__ bool next(int i, Unit& u) const {
        const long L = (long)i * G + c; if (L >= nwg) return false;
        int wgid = (int)L; { const int q = nwg / NXCD, r = nwg % NXCD, xcd = wgid % NXCD, off = wgid / NXCD; wgid = (xcd < r ? xcd * (q + 1) : r * (q + 1) + (xcd - r) * q) + off; }
        const int nig = WGM * nN, gid = wgid / nig, fm = gid * WGM, gsz = (nM - fm) < WGM ? (nM - fm) : WGM;
        u.pm = fm + ((wgid % nig) % gsz); u.pn = (wgid % nig) / gsz; return true;
    }
    __device__ __forceinline__ void a_ready(const Unit&) const {}
    __device__ __forceinline__ void done(const Unit&) const {}
};

typedef unsigned u32x2 __attribute__((ext_vector_type(2)));
typedef float f32x2v __attribute__((ext_vector_type(2)));
typedef __bf16 bf16x2_t __attribute__((ext_vector_type(2)));
__device__ __forceinline__ unsigned pk_bf16(float lo, float hi) { f32x2v v = {lo, hi}; bf16x2_t b = __builtin_convertvector(v, bf16x2_t); return __builtin_bit_cast(unsigned, b); }
__device__ __forceinline__ u32x2 pk4(f32x4 v) { u32x2 w; w.x = pk_bf16(v[0], v[1]); w.y = pk_bf16(v[2], v[3]); return w; }
__device__ __forceinline__ float dot4(f32x4 v) { return (v[0] * v[0] + v[1] * v[1]) + (v[2] * v[2] + v[3] * v[3]); }
__device__ __forceinline__ float sigm(float z) { return __builtin_amdgcn_rcpf(1.0f + __builtin_amdgcn_exp2f(-z * LOG2E)); }
#define EPI_FENCE() asm volatile("" ::: "memory")
__device__ __forceinline__ int pg8_tid() { int t = threadIdx.x; asm volatile("" : "+v"(t)); return t; }

struct RowScale { const float* p; int stride; int ngrp; float inv_n;
    __device__ __forceinline__ float get(int row, int fq) const {
        float s = 0.f; if (fq < ngrp) { const f32x4 v = *(const f32x4*)(p + (size_t)row * stride + 4 * fq); s = (v[0] + v[1]) + (v[2] + v[3]); }
        s += __shfl_xor(s, 16); s += __shfl_xor(s, 32); return rsqrtf(s * inv_n + EPS); }
    __device__ __forceinline__ void get8(int row0, int fq, float (&r)[2][4]) const {
        float s[2][4];
#pragma unroll
        for (int ai = 0; ai < 2; ++ai)
#pragma unroll
            for (int m = 0; m < 4; ++m) { s[ai][m] = 0.f; if (fq < ngrp) { const f32x4 v = *(const f32x4*)(p + (size_t)(row0 + ai * HALF + m * 16) * stride + 4 * fq); s[ai][m] = (v[0] + v[1]) + (v[2] + v[3]); } }
#pragma unroll
        for (int ai = 0; ai < 2; ++ai)
#pragma unroll
            for (int m = 0; m < 4; ++m) { float t = s[ai][m]; t += __shfl_xor(t, 16); t += __shfl_xor(t, 32); r[ai][m] = rsqrtf(t * inv_n + EPS); }
    } };
__device__ __forceinline__ int row_pos(int row) { return row < MP ? (row & (SEQ - 1)) : PAST + ((row - MP) & (DSEQ - 1)); }

struct EpiFoxIn { static constexpr bool PERM = false, AFTER_DRAIN = false;
    RowScale rs; unsigned char* ws; float* out; const float* bff; int L;
    __device__ __forceinline__ void operator()(const f32x4 (&acc)[2][2][4][2], const Unit& u, int wr, int wc, int, int) const { const int lane_ = pg8_tid() & 63, fr = lane_ & 15, fq = lane_ >> 4; float rsv[2][4]; rs.get8(u.pm * BM + wr * 64 + fr, fq, rsv);
        const int typ = u.pn >> 2, colt = (u.pn & 3) * 256 + wc * 32 + 4 * fq;
        bf16_t* QF = (bf16_t*)(ws + WS_QF); float* kp = out + O_FKP + (size_t)L * MP * 1024; float* ks = out + O_FKS + (size_t)L * MS * 1024;
#pragma unroll
        for (int ai = 0; ai < 2; ++ai)
#pragma unroll
            for (int m = 0; m < 4; ++m) { const int row = u.pm * BM + ai * HALF + wr * 64 + m * 16 + fr; float r = rsv[ai][m];
                if (typ == 0) { r *= C2_FOX;
#pragma unroll
                    for (int bj = 0; bj < 2; ++bj)
#pragma unroll
                        for (int n = 0; n < 2; ++n) *(u32x2*)(QF + (size_t)row * 1024 + colt + bj * HALF + n * 16) = pk4(acc[ai][bj][m][n] * r);
                } else if (typ == 3) {
#pragma unroll
                    for (int bj = 0; bj < 2; ++bj)
#pragma unroll
                        for (int n = 0; n < 2; ++n) { f32x4 v = acc[ai][bj][m][n] * r; v[0] = sigm(v[0]); v[1] = sigm(v[1]); v[2] = sigm(v[2]); v[3] = sigm(v[3]);
                            *(u32x2*)(QF + 3 * (SZ_ACT / 2) + (size_t)row * 1024 + colt + bj * HALF + n * 16) = pk4(v); }
                } else if (typ == 4) {
                    if (wc == 0) { const f32x4 bb = *(const f32x4*)(bff + 4 * fq); f32x4 lf;
#pragma unroll
                        for (int i = 0; i < 4; ++i) { const float z = acc[ai][0][m][0][i] * r + bb[i]; lf[i] = fminf(z, 0.f) - log1pf(expf(-fabsf(z))); }
                        *(f32x4*)((float*)(ws + WS_LFR) + (size_t)row * 16 + 4 * fq) = lf;
                        float* F = (row < MP) ? out + O_FLP + ((size_t)L * MP + row) * 16 : out + O_FLS + ((size_t)L * MS + (row - MP)) * 16;
                        *(f32x4*)(F + 4 * fq) = lf; }
                } else { bf16_t* B = QF + (size_t)typ * (SZ_ACT / 2);
                    float* F = (row < MP) ? kp + (size_t)(typ - 1) * 2 * MP * 1024 + (size_t)row * 1024 : ks + (size_t)(typ - 1) * 2 * MS * 1024 + (size_t)(row - MP) * 1024;
#pragma unroll
                    for (int bj = 0; bj < 2; ++bj)
#pragma unroll
                        for (int n = 0; n < 2; ++n) { const f32x4 v = acc[ai][bj][m][n] * r; const int c = colt + bj * HALF + n * 16;
                            *(f32x4*)(F + c) = v; *(u32x2*)(B + (size_t)row * 1024 + c) = pk4(v); }
                }
                if (m & 1) EPI_FENCE(); }
    }
};
struct EpiResid { static constexpr bool PERM = true, AFTER_DRAIN = false;
    const float* xin_p; const float* xin_s; int first; bf16_t* xb; float* ssq;
    __device__ __forceinline__ void operator()(const f32x4 (&acc)[2][2][4][2], const Unit& u, int wr, int wc, int, int) const { const int lane_ = pg8_tid() & 63, fr = lane_ & 15, fq = lane_ >> 4;
        const int col0 = u.pn * BM + wc * 32 + 8 * fq;
        if (first) {
#pragma unroll
        for (int ai = 0; ai < 2; ++ai) {
            f32x4 xo[4][2][2];
#pragma unroll
            for (int m = 0; m < 4; ++m) { const int row = u.pm * BM + ai * HALF + wr * 64 + m * 16 + fr;
                const float* xi = (row < MP) ? xin_p + (size_t)row * 1024 : xin_s + (size_t)(row - MP) * 1024;
#pragma unroll
                for (int bj = 0; bj < 2; ++bj)
#pragma unroll
                    for (int n = 0; n < 2; ++n) xo[m][bj][n] = *(const f32x4*)(xi + col0 + bj * HALF + n * 4); }
#pragma unroll
            for (int m = 0; m < 4; ++m) { const int row = u.pm * BM + ai * HALF + wr * 64 + m * 16 + fr; float sq = 0.f;
#pragma unroll
                for (int bj = 0; bj < 2; ++bj) { const int c = col0 + bj * HALF; const f32x4 x0 = xo[m][bj][0] + acc[ai][bj][m][0], x1 = xo[m][bj][1] + acc[ai][bj][m][1];
                    sq += dot4(x0) + dot4(x1);
                    const u32x2 w0 = pk4(x0), w1 = pk4(x1); *(u32x4*)(xb + (size_t)row * 1024 + c) = (u32x4){w0.x, w0.y, w1.x, w1.y}; }
                sq += __shfl_xor(sq, 16); sq += __shfl_xor(sq, 32);
                if (fq == 0) ssq[(size_t)row * 16 + u.pn * 4 + wc] = sq; }
            EPI_FENCE(); }
        } else {
            u32x4 raw[2][4][2];
#pragma unroll
            for (int ai = 0; ai < 2; ++ai)
#pragma unroll
                for (int m = 0; m < 4; ++m) { const int row = u.pm * BM + ai * HALF + wr * 64 + m * 16 + fr;
#pragma unroll
                    for (int bj = 0; bj < 2; ++bj) raw[ai][m][bj] = *(const u32x4*)(xb + (size_t)row * 1024 + col0 + bj * HALF); }
            EPI_FENCE();
#pragma unroll
            for (int ai = 0; ai < 2; ++ai) {
#pragma unroll
                for (int m = 0; m < 4; ++m) { const int row = u.pm * BM + ai * HALF + wr * 64 + m * 16 + fr; float sq = 0.f;
#pragma unroll
                    for (int bj = 0; bj < 2; ++bj) { const int c = col0 + bj * HALF; const u32x4 w = raw[ai][m][bj];
                        const f32x4 x0 = (f32x4){__builtin_bit_cast(float, w.x << 16), __builtin_bit_cast(float, w.x & 0xffff0000u), __builtin_bit_cast(float, w.y << 16), __builtin_bit_cast(float, w.y & 0xffff0000u)} + acc[ai][bj][m][0];
                        const f32x4 x1 = (f32x4){__builtin_bit_cast(float, w.z << 16), __builtin_bit_cast(float, w.z & 0xffff0000u), __builtin_bit_cast(float, w.w << 16), __builtin_bit_cast(float, w.w & 0xffff0000u)} + acc[ai][bj][m][1];
                        sq += dot4(x0) + dot4(x1);
                        const u32x2 w0 = pk4(x0), w1 = pk4(x1); *(u32x4*)(xb + (size_t)row * 1024 + c) = (u32x4){w0.x, w0.y, w1.x, w1.y}; }
                    sq += __shfl_xor(sq, 16); sq += __shfl_xor(sq, 32);
                    if (fq == 0) ssq[(size_t)row * 16 + u.pn * 4 + wc] = sq; }
                EPI_FENCE(); } }
    }
};
struct EpiScaleBf16 { static constexpr bool PERM = true, AFTER_DRAIN = false;
    RowScale rs; bf16_t* O; int ldc; float scale;
    __device__ __forceinline__ void operator()(const f32x4 (&acc)[2][2][4][2], const Unit& u, int wr, int wc, int, int) const { const int lane_ = pg8_tid() & 63, fr = lane_ & 15, fq = lane_ >> 4; float rsv[2][4]; rs.get8(u.pm * BM + wr * 64 + fr, fq, rsv);
        const int col0 = u.pn * BM + wc * 32 + 8 * fq;
#pragma unroll
        for (int ai = 0; ai < 2; ++ai)
#pragma unroll
            for (int m = 0; m < 4; ++m) { const int row = u.pm * BM + ai * HALF + wr * 64 + m * 16 + fr; const float r = rsv[ai][m] * scale;
#pragma unroll
                for (int bj = 0; bj < 2; ++bj) { const u32x2 w0 = pk4(acc[ai][bj][m][0] * r), w1 = pk4(acc[ai][bj][m][1] * r);
                    *(u32x4*)(O + (size_t)row * ldc + col0 + bj * HALF) = (u32x4){w0.x, w0.y, w1.x, w1.y}; }
                if (m & 1) EPI_FENCE(); }
    }
};
struct EpiSwiglu { static constexpr bool PERM = true, AFTER_DRAIN = false;
    RowScale rs; bf16_t* HB;
    __device__ __forceinline__ void operator()(const f32x4 (&acc)[2][2][4][2], const Unit& u, int wr, int wc, int, int) const { const int lane_ = pg8_tid() & 63, fr = lane_ & 15, fq = lane_ >> 4; float rsv[2][4]; rs.get8(u.pm * BM + wr * 64 + fr, fq, rsv);
        const int col0 = u.pn * HALF + wc * 32 + 8 * fq;
        const bool blk = u.pm < MP / BM; const int rstr = blk ? 128 : DFF * 2;
        const size_t hb0 = blk ? ((size_t)(u.pm * (DFF / 64) + (col0 >> 6)) * 32768 + (size_t)(col0 & 63) * 2) : ((size_t)u.pm * BM * DFF + col0) * 2;
#pragma unroll
        for (int ai = 0; ai < 2; ++ai)
#pragma unroll
            for (int m = 0; m < 4; ++m) { const int row = u.pm * BM + ai * HALF + wr * 64 + m * 16 + fr; const float r = rsv[ai][m]; u32x4 w;
#pragma unroll
                for (int n = 0; n < 2; ++n) { const f32x4 g = acc[ai][0][m][n] * r, uu = acc[ai][1][m][n] * r; f32x4 h;
#pragma unroll
                    for (int i = 0; i < 4; ++i) h[i] = g[i] * sigm(g[i]) * uu[i];
                    const u32x2 hw = pk4(h); if (n == 0) { w.x = hw.x; w.y = hw.y; } else { w.z = hw.x; w.w = hw.y; } }
                *(u32x4*)((char*)HB + hb0 + (size_t)(row - u.pm * BM) * rstr) = w;
                if (m & 1) EPI_FENCE(); }
    }
};
struct EpiMlaA { static constexpr bool PERM = false, AFTER_DRAIN = false;
    RowScale rs; float* ckvu; bf16_t* ckvub; float* ssqkv; bf16_t* cq; float* ssqq; bf16_t* krb; float *mrp, *mrs; const float *ropc, *rops;
    __device__ __forceinline__ void operator()(const f32x4 (&acc)[2][2][4][2], const Unit& u, int wr, int wc, int, int) const { const int lane_ = pg8_tid() & 63, fr = lane_ & 15, fq = lane_ >> 4; float rsv[2][4]; rs.get8(u.pm * BM + wr * 64 + fr, fq, rsv);
        const int cw = wc * 32 + 4 * fq;
#pragma unroll
        for (int ai = 0; ai < 2; ++ai)
#pragma unroll
            for (int m = 0; m < 4; ++m) { const int row = u.pm * BM + ai * HALF + wr * 64 + m * 16 + fr; const float r = rsv[ai][m];
                if (u.pn == 0) { float sq = 0.f;
#pragma unroll
                    for (int bj = 0; bj < 2; ++bj)
#pragma unroll
                        for (int n = 0; n < 2; ++n) { const int c = cw + bj * HALF + n * 16; const f32x4 v = acc[ai][bj][m][n] * r;
                            *(f32x4*)(ckvu + (size_t)row * 256 + c) = v; *(u32x2*)(ckvub + (size_t)row * 256 + c) = pk4(v); sq += dot4(v); }
                    sq += __shfl_xor(sq, 16); sq += __shfl_xor(sq, 32); if (fq == 0) ssqkv[(size_t)row * 4 + wc] = sq;
                } else if (u.pn == 1) { float sq = 0.f;
#pragma unroll
                    for (int bj = 0; bj < 2; ++bj)
#pragma unroll
                        for (int n = 0; n < 2; ++n) { const int c = cw + bj * HALF + n * 16; const f32x4 v = acc[ai][bj][m][n] * r;
                            *(u32x2*)(cq + (size_t)row * 384 + c) = pk4(v); sq += dot4(v); }
                    sq += __shfl_xor(sq, 16); sq += __shfl_xor(sq, 32); if (fq == 0) ssqq[(size_t)row * 8 + wc] = sq;
                } else { float sq = 0.f;
#pragma unroll
                    for (int n = 0; n < 2; ++n) { const int c = 256 + cw + n * 16; const f32x4 v = acc[ai][0][m][n] * r;
                        *(u32x2*)(cq + (size_t)row * 384 + c) = pk4(v); sq += dot4(v); }
                    sq += __shfl_xor(sq, 16); sq += __shfl_xor(sq, 32); if (fq == 0) ssqq[(size_t)row * 8 + 4 + wc] = sq;
                    if (wc == 0) { const int pos = row_pos(row); const f32x4 cs = *(const f32x4*)(ropc + pos * 16 + 4 * fq), sn = *(const f32x4*)(rops + pos * 16 + 4 * fq);
                        const f32x4 x1 = acc[ai][1][m][0] * r, x2 = acc[ai][1][m][1] * r; const f32x4 o1 = x1 * cs - x2 * sn, o2 = x1 * sn + x2 * cs;
                        *(u32x2*)(krb + (size_t)row * 32 + 4 * fq) = pk4(o1); *(u32x2*)(krb + (size_t)row * 32 + 16 + 4 * fq) = pk4(o2);
                        float* F = (row < MP) ? mrp + (size_t)row * 32 : mrs + (size_t)(row - MP) * 32;
                        *(f32x4*)(F + 4 * fq) = o1; *(f32x4*)(F + 16 + 4 * fq) = o2; }
                }
                if (m & 1) EPI_FENCE(); }
    }
};
struct EpiMlaQ { static constexpr bool PERM = false, AFTER_DRAIN = false;
    RowScale rs; bf16_t* QM; const float *ropc, *rops;
    __device__ __forceinline__ void operator()(const f32x4 (&acc)[2][2][4][2], const Unit& u, int wr, int wc, int, int) const { const int lane_ = pg8_tid() & 63, fr = lane_ & 15, fq = lane_ >> 4; float rsv[2][4]; rs.get8(u.pm * BM + wr * 64 + fr, fq, rsv);
#pragma unroll
        for (int ai = 0; ai < 2; ++ai)
#pragma unroll
            for (int m = 0; m < 4; ++m) { const int row = u.pm * BM + ai * HALF + wr * 64 + m * 16 + fr; const float r = rsv[ai][m] * C2_MLA;
                const int pos = row_pos(row);
#pragma unroll
                for (int bj = 0; bj < 2; ++bj) { const int g32 = u.pn * 8 + bj * 4 + wc; const int c = g32 * 32 + 4 * fq; bf16_t* o = QM + (size_t)row * 1536 + c;
                    if ((g32 % 3) == 2) { const f32x4 cs = *(const f32x4*)(ropc + pos * 16 + 4 * fq), sn = *(const f32x4*)(rops + pos * 16 + 4 * fq);
                        const f32x4 x1 = acc[ai][bj][m][0] * r, x2 = acc[ai][bj][m][1] * r;
                        *(u32x2*)(o) = pk4(x1 * cs - x2 * sn); *(u32x2*)(o + 16) = pk4(x1 * sn + x2 * cs);
                    } else { *(u32x2*)(o) = pk4(acc[ai][bj][m][0] * r); *(u32x2*)(o + 16) = pk4(acc[ai][bj][m][1] * r); } }
                EPI_FENCE(); }
    }
};
struct EpiNull { static constexpr bool PERM = true, AFTER_DRAIN = false;
    __device__ __forceinline__ void operator()(const f32x4 (&acc)[2][2][4][2], const Unit&, int, int, int, int) const {
#pragma unroll
        for (int ai = 0; ai < 2; ++ai)
#pragma unroll
            for (int bj = 0; bj < 2; ++bj)
#pragma unroll
                for (int m = 0; m < 4; ++m)
#pragma unroll
                    for (int n = 0; n < 2; ++n) asm volatile("" :: "v"(acc[ai][bj][m][n])); }
};
struct EpiMemKV { static constexpr bool PERM = false, AFTER_DRAIN = false;
    float* outk; float* outv; bf16_t* MKB; bf16_t* MVB;
    __device__ __forceinline__ void operator()(const f32x4 (&acc)[2][2][4][2], const Unit& u, int wr, int wc, int, int) const { const int lane_ = pg8_tid() & 63, fr = lane_ & 15, fq = lane_ >> 4;
        const int l = u.pn >> 3, cw0 = (u.pn & 7) * 256; const bool isv = cw0 >= 1024; const int cbase = (cw0 & 1023) + wc * 32 + 4 * fq;
#pragma unroll
        for (int ai = 0; ai < 2; ++ai)
#pragma unroll
            for (int m = 0; m < 4; ++m) { const int row = u.pm * BM + ai * HALF + wr * 64 + m * 16 + fr; const int b = row >> 8, nn = row & 255;
#pragma unroll
                for (int bj = 0; bj < 2; ++bj)
#pragma unroll
                    for (int n = 0; n < 2; ++n) { const int c = cbase + bj * HALF + n * 16; const f32x4 v = acc[ai][bj][m][n]; const size_t o = ((size_t)l * 2048 + row) * 1024 + c;
                        if (!isv) { *(f32x4*)(outk + o) = v; *(u32x2*)(MKB + o) = pk4(v); } else { *(f32x4*)(outv + o) = v; *(u32x2*)(MVB + o) = pk4(v); } }
                if (m & 1) EPI_FENCE(); }
    }
};

template <class Epi, class Sched, bool ALIGN_EPI = false, bool SP2 = false, bool ABLK = false>
__device__ __forceinline__ void gemm_phase(PG8_LAS unsigned char* lds, const Gemm g, const Sched& S, const Epi& E) {
    const int tid = pg8_tid(), wid = __builtin_amdgcn_readfirstlane(tid >> 6), lane = tid & 63, wr = wid >> 2, wc = wid & 3, fr = lane & 15, fq = lane >> 4;
    const int K = g.K, nt = K / BK;
    unsigned voffA[2], voffB[2];
#pragma unroll
    for (int i = 0; i < 2; ++i) { int R, C; stage_rc(tid * 16 + i * 8192, R, C); const int Rb = Epi::PERM ? ((R & ~31) + perm32(R & 31)) : R;
        voffA[i] = ABLK ? (unsigned)(R * BK + C) * 2u : (unsigned)(R * K + C) * 2u; voffB[i] = (unsigned)(Rb * K + C) * 2u; }
    const size_t kstep = (size_t)(BK * 2);
    const size_t hstep = (size_t)HALF * K * 2;
    const size_t tstep = 2 * hstep;
    const size_t kstepA = ABLK ? (size_t)BM * BK * 2 : kstep, hstepA = ABLK ? (size_t)HALF * BK * 2 : hstep, tstepA = ABLK ? (size_t)nt * BM * BK * 2 : tstep;
    const unsigned ldsw = (unsigned)wid * 1024u;
    const int aoff = lds_byte(wr * 64 + fr, fq * 8), boff = lds_byte(wc * 32 + fr, fq * 8);
#define PG8_SA(b, h) (((b) * 2 + (h)) * HTB)
#define PG8_SB(b, h) ((4 + (b) * 2 + (h)) * HTB)
#define PG8_STAGE(bufoff, gbase, voff) do { _Pragma("unroll") for (int _i = 0; _i < 2; ++_i) \
        __builtin_amdgcn_global_load_lds((const unsigned*)((const char*)(gbase) + (voff)[_i]), (PG8_LAS unsigned*)(lds + (bufoff) + ldsw + _i * 8192), 16, 0, 0); } while (0)
#define PG8_LDA(dst, b, h) do { _Pragma("unroll") for (int m = 0; m < 4; ++m) _Pragma("unroll") for (int k = 0; k < 2; ++k) dst[m][k] = *(const PG8_LAS bf16x8*)(lds + PG8_SA(b, h) + aoff + m * 2048 + k * 1024); } while (0)
#define PG8_LDB(dst, b, h) do { _Pragma("unroll") for (int n = 0; n < 2; ++n) _Pragma("unroll") for (int k = 0; k < 2; ++k) dst[n][k] = *(const PG8_LAS bf16x8*)(lds + PG8_SB(b, h) + boff + n * 2048 + k * 1024); } while (0)
#define PG8_MMA(ai, bj, At, Bt) do { __builtin_amdgcn_s_setprio(1); _Pragma("unroll") for (int m = 0; m < 4; ++m) _Pragma("unroll") for (int n = 0; n < 2; ++n) _Pragma("unroll") for (int k = 0; k < 2; ++k) \
        acc[ai][bj][m][n] = __builtin_amdgcn_mfma_f32_16x16x32_bf16(Bt[n][k], At[m][k], acc[ai][bj][m][n], 0, 0, 0); __builtin_amdgcn_s_setprio(0); } while (0)
#define PG8_WAIT_V(n) asm volatile("s_waitcnt vmcnt(" #n ")" ::: "memory")
#define PG8_WAIT_L(n) asm volatile("s_waitcnt lgkmcnt(" #n ")" ::: "memory")
#define PG8_BAR __builtin_amdgcn_s_barrier()
#define PG8_SCHED __builtin_amdgcn_sched_barrier(0)
    Unit cur, nxt; int ui = 0;
    if (!S.next(0, cur)) return;
    f32x4 acc[2][2][4][2];
#pragma unroll
    for (int a = 0; a < 2; ++a)
#pragma unroll
        for (int b = 0; b < 2; ++b)
#pragma unroll
            for (int m = 0; m < 4; ++m)
#pragma unroll
                for (int n = 0; n < 2; ++n) acc[a][b][m][n] = (f32x4){0.f, 0.f, 0.f, 0.f};
    bf16x8 At[4][2], B0[2][2], B1[2][2];
    const char* cA = (const char*)g.A + (size_t)cur.pm * tstepA; const char* cB = (const char*)g.Bt + (size_t)cur.pn * tstep;
    S.a_ready(cur);
    if constexpr (SP2) {
        PG8_STAGE(PG8_SB(0, 0), cB, voffB); PG8_STAGE(PG8_SB(0, 1), cB + hstep, voffB); PG8_STAGE(PG8_SA(0, 0), cA, voffA); PG8_STAGE(PG8_SA(0, 1), cA + hstepA, voffA);
        if (wr == 1) PG8_BAR;
        PG8_WAIT_V(2); PG8_BAR;
        PG8_STAGE(PG8_SB(1, 0), cB + kstep, voffB); PG8_STAGE(PG8_SA(1, 0), cA + kstepA, voffA); PG8_STAGE(PG8_SB(1, 1), cB + hstep + kstep, voffB);
        PG8_WAIT_V(6); PG8_BAR;
    } else {
        PG8_STAGE(PG8_SB(0, 0), cB, voffB); PG8_STAGE(PG8_SA(0, 0), cA, voffA); PG8_STAGE(PG8_SB(0, 1), cB + hstep, voffB); PG8_STAGE(PG8_SA(0, 1), cA + hstepA, voffA);
        if (wr == 1) PG8_BAR;
        PG8_WAIT_V(4); PG8_BAR;
        PG8_STAGE(PG8_SB(1, 0), cB + kstep, voffB); PG8_STAGE(PG8_SA(1, 0), cA + kstepA, voffA); PG8_STAGE(PG8_SB(1, 1), cB + hstep + kstep, voffB);
        PG8_WAIT_V(6); PG8_BAR;
    }
    for (;;) {
        const bool has_next = S.next(ui + 1, nxt);
        const char* nA = has_next ? (const char*)g.A + (size_t)nxt.pm * tstepA : cA; const char* nB = has_next ? (const char*)g.Bt + (size_t)nxt.pn * tstep : cB;
        for (int t = 0; t < nt; t += 2) {
            const bool last = (t == nt - 2);
            const char* a1 = cA + (size_t)(t + 1) * kstepA;
            const char* a2 = last ? nA : cA + (size_t)(t + 2) * kstepA; const char* b2 = last ? nB : cB + (size_t)(t + 2) * kstep;
            const char* a3 = a2 + kstepA; const char* b3 = b2 + kstep;
            if (last && has_next) S.a_ready(nxt);
            if constexpr (SP2) {
            PG8_LDB(B0, 0, 0); PG8_LDB(B1, 0, 1); PG8_SCHED; PG8_LDA(At, 0, 0); PG8_STAGE(PG8_SA(1, 1), a1 + hstepA, voffA);
            PG8_WAIT_V(8); PG8_WAIT_L(0); PG8_BAR; PG8_MMA(0, 0, At, B0); PG8_MMA(0, 1, At, B1); PG8_BAR; PG8_SCHED;
            PG8_LDA(At, 0, 1); PG8_STAGE(PG8_SB(0, 0), b2, voffB); PG8_STAGE(PG8_SB(0, 1), b2 + hstep, voffB); PG8_STAGE(PG8_SA(0, 0), a2, voffA);
            PG8_WAIT_V(8); PG8_WAIT_L(0); PG8_BAR; PG8_MMA(1, 0, At, B0); PG8_MMA(1, 1, At, B1); PG8_BAR; PG8_SCHED;
            PG8_LDB(B0, 1, 0); PG8_LDB(B1, 1, 1); PG8_SCHED; PG8_LDA(At, 1, 0); PG8_STAGE(PG8_SA(0, 1), a2 + hstepA, voffA);
            PG8_WAIT_V(8); PG8_WAIT_L(0); PG8_BAR; PG8_MMA(0, 0, At, B0); PG8_MMA(0, 1, At, B1); PG8_BAR; PG8_SCHED;
            PG8_LDA(At, 1, 1); PG8_STAGE(PG8_SB(1, 0), b3, voffB); PG8_STAGE(PG8_SB(1, 1), b3 + hstep, voffB); PG8_STAGE(PG8_SA(1, 0), a3, voffA);
            PG8_WAIT_V(8); PG8_WAIT_L(0); PG8_BAR; PG8_MMA(1, 0, At, B0); PG8_MMA(1, 1, At, B1); PG8_BAR; PG8_SCHED;
            } else {
            PG8_LDB(B0, 0, 0); PG8_SCHED; PG8_LDA(At, 0, 0); PG8_STAGE(PG8_SA(1, 1), a1 + hstepA, voffA);
            PG8_WAIT_L(8); PG8_BAR; PG8_WAIT_L(0); PG8_MMA(0, 0, At, B0); PG8_BAR; PG8_SCHED;
            PG8_LDB(B1, 0, 1); PG8_STAGE(PG8_SB(0, 0), b2, voffB);
            PG8_BAR; PG8_WAIT_L(0); PG8_MMA(0, 1, At, B1); PG8_BAR;
            PG8_LDA(At, 0, 1); PG8_STAGE(PG8_SA(0, 0), a2, voffA);
            PG8_BAR; PG8_WAIT_L(0); PG8_MMA(1, 0, At, B0); PG8_BAR; PG8_SCHED;
            PG8_STAGE(PG8_SB(0, 1), b2 + hstep, voffB);
            PG8_WAIT_V(6); PG8_BAR; PG8_MMA(1, 1, At, B1); PG8_BAR;
            PG8_LDB(B0, 1, 0); PG8_SCHED; PG8_LDA(At, 1, 0); PG8_STAGE(PG8_SA(0, 1), a2 + hstepA, voffA);
            PG8_WAIT_L(8); PG8_BAR; PG8_WAIT_L(0); PG8_MMA(0, 0, At, B0); PG8_BAR; PG8_SCHED;
            PG8_LDB(B1, 1, 1); PG8_STAGE(PG8_SB(1, 0), b3, voffB);
            PG8_BAR; PG8_WAIT_L(0); PG8_MMA(0, 1, At, B1); PG8_BAR;
            PG8_LDA(At, 1, 1); PG8_STAGE(PG8_SA(1, 0), a3, voffA);
            PG8_BAR; PG8_WAIT_L(0); PG8_MMA(1, 0, At, B0); PG8_BAR; PG8_SCHED;
            PG8_STAGE(PG8_SB(1, 1), b3 + hstep, voffB);
            PG8_WAIT_V(6); PG8_BAR; PG8_MMA(1, 1, At, B1); PG8_BAR;
            }
        }
        if constexpr (ALIGN_EPI) { if (wr == 0) PG8_BAR; }
        if constexpr (!Epi::AFTER_DRAIN) { E(acc, cur, wr, wc, fr, fq); S.done(cur); }
        if (!has_next) break;
#pragma unroll
        for (int a = 0; a < 2; ++a)
#pragma unroll
            for (int b = 0; b < 2; ++b)
#pragma unroll
                for (int m = 0; m < 4; ++m)
#pragma unroll
                    for (int n = 0; n < 2; ++n) acc[a][b][m][n] = (f32x4){0.f, 0.f, 0.f, 0.f};
        cur = nxt; cA = nA; cB = nB; ++ui;
        if constexpr (ALIGN_EPI) { if (wr == 1) PG8_BAR; }
    }
    PG8_WAIT_V(0);
    if constexpr (!ALIGN_EPI) { if (wr == 0) PG8_BAR; }
    PG8_BAR;
    if constexpr (Epi::AFTER_DRAIN) { E.fused(acc, cur, wr, wc, fr, fq, lds, wid, lane); S.done(cur); }
#undef PG8_SA
#undef PG8_SB
#undef PG8_STAGE
#undef PG8_LDA
#undef PG8_LDB
#undef PG8_MMA
#undef PG8_WAIT_V
#undef PG8_WAIT_L
#undef PG8_BAR
#undef PG8_SCHED
}
}

#define GAS __attribute__((address_space(1)))
#define LAS __attribute__((address_space(3)))
typedef unsigned short bf16;
typedef float f32x4 __attribute__((ext_vector_type(4)));
typedef float f32x16 __attribute__((ext_vector_type(16)));
typedef short bf16x8 __attribute__((ext_vector_type(8)));
typedef short s16x4 __attribute__((ext_vector_type(4)));
typedef unsigned u32x4 __attribute__((ext_vector_type(4)));
typedef unsigned u32x2 __attribute__((ext_vector_type(2)));
typedef GAS unsigned gu32;
#define RLX_AGENT __ATOMIC_RELAXED, __HIP_MEMORY_SCOPE_AGENT
#define LDS_WAIT() asm volatile("s_waitcnt lgkmcnt(0)" ::: "memory")
#define VM_WAIT() asm volatile("s_waitcnt vmcnt(0)" ::: "memory")
__device__ __forceinline__ unsigned pk2(float lo, float hi) { return pg8::pk_bf16(lo, hi); }
__device__ __forceinline__ float bf2f(unsigned short b) { return __builtin_bit_cast(float, (unsigned)b << 16); }
__device__ __forceinline__ float ex2(float x) { return __builtin_amdgcn_exp2f(x); }
__device__ __forceinline__ float wave_sum(float v) {
#pragma unroll
    for (int o = 1; o < 64; o <<= 1) v += __shfl_xor(v, o);
    return v;
}

namespace fa {
constexpr int KSLOT = 12288, VSLOT = 8192;
constexpr int L_K = 0, L_V = 2 * KSLOT, L_WS = L_V + 2 * VSLOT, L_OST = L_WS + 8 * 64 * 4, L_BYTES = L_OST + 8 * 32 * 64 * 4;
constexpr int L_WS2 = L_V + 3 * VSLOT, L_CB2 = L_WS2 + 8 * 128 * 4, L_OST2 = L_CB2 + 512, L_QR2 = L_OST2 + 8 * 4096, L_BYTES2 = L_QR2 + 8 * 4096;
__device__ __forceinline__ int crow(int r, int hi) { return (r & 3) + 8 * (r >> 2) + 4 * hi; }
__device__ __forceinline__ void glds16(const void* gsrc, unsigned lds_dst) { unsigned keep;
    asm volatile("s_mov_b32 %0, m0\n\ts_mov_b32 m0, %2\n\ts_nop 0\n\tglobal_load_lds_dwordx4 %1, off\n\ts_mov_b32 m0, %0" : "=&s"(keep) : "v"(gsrc), "s"(lds_dst) : "memory"); }
#define FA_WAIT_BAR() asm volatile("s_waitcnt vmcnt(0) lgkmcnt(0)\n\ts_barrier" ::: "memory")
#define FA_SBAR() __builtin_amdgcn_sched_barrier(0)
template <int ND0> __device__ __forceinline__ void qkt(f32x16& p0, f32x16& p1, const LAS char* kp, const bf16x8* qr) {
    p0 = f32x16{}; p1 = f32x16{};
#pragma unroll
    for (int d0 = 0; d0 < ND0; ++d0) {
        const bf16x8 b0 = *(const LAS bf16x8*)(kp + d0 * 2048);
        const bf16x8 b1 = *(const LAS bf16x8*)(kp + d0 * 2048 + 512);
        p0 = __builtin_amdgcn_mfma_f32_32x32x16_bf16(b0, qr[d0], p0, 0, 0, 0); p1 = __builtin_amdgcn_mfma_f32_32x32x16_bf16(b1, qr[d0], p1, 0, 0, 0); }
}
__device__ __forceinline__ float max3f(float a, float b, float c) { float r; asm("v_max3_f32 %0, %1, %2, %3" : "=v"(r) : "v"(a), "v"(b), "v"(c)); return r; }
__device__ __forceinline__ float max2f(float a, float b) { float r; asm("v_max_f32_e32 %0, %1, %2" : "=v"(r) : "v"(a), "v"(b)); return r; }
__device__ __forceinline__ float rowmax_a(const f32x16& p0, const f32x16& p1) {
    float a = max3f(p0[0], p0[1], p1[0]), b = max3f(p0[2], p0[3], p1[1]); a = max3f(a, p1[2], p1[3]);
#pragma unroll
    for (int r = 4; r < 16; r += 4) { a = max3f(a, p0[r], p0[r + 1]); b = max3f(b, p0[r + 2], p0[r + 3]); a = max3f(a, p1[r], p1[r + 1]); b = max3f(b, p1[r + 2], p1[r + 3]); }
    const float m = max2f(a, b);
    auto rr = __builtin_amdgcn_permlane32_swap(__float_as_uint(m), __float_as_uint(m), false, false);
    return max2f(__uint_as_float(rr[0]), __uint_as_float(rr[1]));
}
__device__ __forceinline__ float rowmax(const f32x16& p0, const f32x16& p1) {
    float a = __builtin_fmaxf(p0[0], p1[0]);
#pragma unroll
    for (int r = 1; r < 16; ++r) a = __builtin_fmaxf(a, __builtin_fmaxf(p0[r], p1[r]));
    auto rr = __builtin_amdgcn_permlane32_swap(__float_as_uint(a), __float_as_uint(a), false, false);
    return __builtin_fmaxf(__uint_as_float(rr[0]), __uint_as_float(rr[1]));
}
__device__ __forceinline__ void pv(f32x16* o, int vb, bf16x8 pa0, bf16x8 pa1, bf16x8 pa2, bf16x8 pa3) {
#pragma unroll
    for (int d0 = 0; d0 < 2; ++d0) { s16x4 lo[4], hi[4];
#pragma unroll
        for (int ks = 0; ks < 4; ++ks) {
            asm volatile("ds_read_b64_tr_b16 %0,%1 offset:%c2" : "=&v"(lo[ks]) : "v"(vb), "i"(d0 * 4096 + ks * 1024) : "memory");
            asm volatile("ds_read_b64_tr_b16 %0,%1 offset:%c2" : "=&v"(hi[ks]) : "v"(vb), "i"(d0 * 4096 + ks * 1024 + 512) : "memory"); }
        asm volatile("s_waitcnt lgkmcnt(0)" ::: "memory"); FA_SBAR();
#define FA_PK(k) (bf16x8){lo[k][0], lo[k][1], lo[k][2], lo[k][3], hi[k][0], hi[k][1], hi[k][2], hi[k][3]}
        o[d0] = __builtin_amdgcn_mfma_f32_32x32x16_bf16(pa0, FA_PK(0), o[d0], 0, 0, 0);
        o[d0] = __builtin_amdgcn_mfma_f32_32x32x16_bf16(pa1, FA_PK(1), o[d0], 0, 0, 0);
        o[d0] = __builtin_amdgcn_mfma_f32_32x32x16_bf16(pa2, FA_PK(2), o[d0], 0, 0, 0);
        o[d0] = __builtin_amdgcn_mfma_f32_32x32x16_bf16(pa3, FA_PK(3), o[d0], 0, 0, 0);
#undef FA_PK
    }
}
struct Args { const bf16* Q; int qpitch, qcol; const bf16* K; int kpitch, kcol; const bf16* K2; const bf16* V; int vpitch, vcol; bf16* O; int ocol; const bf16* G; const float* CB; };
template <int MODE> __device__ __forceinline__ void unit(const Args& A, long rowbase, int qb, LAS char* lds, unsigned lds0) {
    constexpr int ND0 = MODE ? 6 : 4;
    const int tid = pg8::pg8_tid(), lane = tid & 63, r32 = lane & 31, hi = lane >> 5; const int wid = __builtin_amdgcn_readfirstlane(tid >> 6);
    const int q0 = qb * 256, NT = q0 / 64 + 4, nt_w = MODE ? (q0 / 64 + (wid >> 1) + 1) : NT;
    const bf16* Qw = A.Q + (rowbase + q0 + wid * 32 + r32) * A.qpitch + A.qcol + hi * 8;
    bf16x8 qr[ND0];
#pragma unroll
    for (int d0 = 0; d0 < ND0; ++d0) qr[d0] = *(const bf16x8*)(Qw + d0 * 16);
    const bf16* ksrc = A.K + (rowbase + lane) * A.kpitch + A.kcol + wid * 8;
    const bf16* ksrc2 = MODE ? A.K2 + (rowbase + lane) * 32 + (wid & 3) * 8 : nullptr;
    const bf16* vsrc = A.V + (rowbase + 16 * (wid & 3) + (lane >> 2)) * A.vpitch + A.vcol + (wid >> 2) * 32 + (lane & 3) * 8;
#define FA_DMA(t, slot) do { \
        glds16(ksrc + (long)(t) * 64 * A.kpitch, (unsigned)__builtin_amdgcn_readfirstlane(lds0 + L_K + (slot) * KSLOT + wid * 1024)); \
        if (MODE && wid < 4) glds16(ksrc2 + (long)(t) * 64 * 32, (unsigned)__builtin_amdgcn_readfirstlane(lds0 + L_K + (slot) * KSLOT + (8 + wid) * 1024)); \
        glds16(vsrc + (long)(t) * 64 * A.vpitch, (unsigned)__builtin_amdgcn_readfirstlane(lds0 + L_V + (slot) * VSLOT + wid * 1024)); } while (0)
    LAS float* wsf = (LAS float*)(lds + L_WS) + wid * 64;
    const int vb0 = (int)(lds0 + L_V) + ((lane >> 4) & 1) * 32 + (lane & 3) * 8 + (4 * hi + ((lane & 15) >> 2)) * 64;
    float m = -1e30f, l = 0.f; f32x16 o[2]; o[0] = f32x16{}; o[1] = f32x16{};
    FA_DMA(0, 0);
    for (int t = 0; t < NT; ++t) {
        FA_WAIT_BAR();
        if (t + 1 < NT) FA_DMA(t + 1, (t + 1) & 1);
        if (t < nt_w) {
            const int slot = t & 1;
            f32x16 p0, p1; qkt<ND0>(p0, p1, lds + L_K + slot * KSLOT + hi * 1024 + r32 * 16, qr);
            if (MODE == 0) {
                const float* cb = A.CB + t * 64 + 4 * hi;
#pragma unroll
                for (int g4 = 0; g4 < 4; ++g4) { const f32x4 b0 = *(const f32x4*)(cb + 8 * g4), b1 = *(const f32x4*)(cb + 32 + 8 * g4);
#pragma unroll
                    for (int i = 0; i < 4; ++i) { p0[4 * g4 + i] += b0[i]; p1[4 * g4 + i] += b1[i]; } }
                const int jb = t - (NT - 4);
                if (jb >= 0) { const int qrel = wid * 32 + r32, kb = 64 * jb + 4 * hi;
#pragma unroll
                    for (int r = 0; r < 16; ++r) { const int kv = kb + (r & 3) + 8 * (r >> 2); if (kv > qrel) p0[r] = -INFINITY; if (kv + 32 > qrel) p1[r] = -INFINITY; } }
            }
            const float rm = rowmax(p0, p1);
            const float mn = __builtin_fmaxf(m, rm), alpha = ex2(m - mn); m = mn;
            float sacc = 0.f;
#pragma unroll
            for (int r = 0; r < 16; ++r) { p0[r] = ex2(p0[r] - mn); p1[r] = ex2(p1[r] - mn); sacc += p0[r] + p1[r]; }
            l = l * alpha + sacc;
            if (hi == 0) wsf[r32] = alpha;
#pragma unroll
            for (int r = 0; r < 16; ++r) { const float a = wsf[crow(r, hi)]; o[0][r] *= a; o[1][r] *= a; }
            u32x4 pw0, pw1, pw2, pw3;
            pw0 = (u32x4){pk2(p0[0], p0[1]), pk2(p0[2], p0[3]), pk2(p0[4], p0[5]), pk2(p0[6], p0[7])};
            pw1 = (u32x4){pk2(p0[8], p0[9]), pk2(p0[10], p0[11]), pk2(p0[12], p0[13]), pk2(p0[14], p0[15])};
            pw2 = (u32x4){pk2(p1[0], p1[1]), pk2(p1[2], p1[3]), pk2(p1[4], p1[5]), pk2(p1[6], p1[7])};
            pw3 = (u32x4){pk2(p1[8], p1[9]), pk2(p1[10], p1[11]), pk2(p1[12], p1[13]), pk2(p1[14], p1[15])};
            FA_SBAR();
            pv(o, vb0 + slot * VSLOT, __builtin_bit_cast(bf16x8, pw0), __builtin_bit_cast(bf16x8, pw1), __builtin_bit_cast(bf16x8, pw2), __builtin_bit_cast(bf16x8, pw3));
        }
    }
    { auto rr = __builtin_amdgcn_permlane32_swap(__float_as_uint(l), __float_as_uint(l), false, false); l = __uint_as_float(rr[0]) + __uint_as_float(rr[1]); }
    if (hi == 0) wsf[32 + r32] = l;
    LAS float* stg = (LAS float*)(lds + L_OST) + wid * 2048;
#pragma unroll
    for (int r = 0; r < 16; ++r) { const int orow = crow(r, hi); const float rl = __builtin_amdgcn_rcpf(wsf[32 + orow]);
        stg[orow * 64 + r32] = o[0][r] * rl; stg[orow * 64 + 32 + r32] = o[1][r] * rl; }
    LDS_WAIT();
#pragma unroll
    for (int i = 0; i < 4; ++i) { const int row = i * 8 + (lane >> 3), ch = lane & 7; const long grow = rowbase + q0 + wid * 32 + row;
        f32x4 a = *(const LAS f32x4*)(stg + row * 64 + ch * 8), b = *(const LAS f32x4*)(stg + row * 64 + ch * 8 + 4);
        if (MODE == 0) { const u32x4 g = *(const u32x4*)(A.G + grow * 1024 + A.ocol + ch * 8);
            a[0] *= __uint_as_float(g.x << 16); a[1] *= __uint_as_float(g.x & 0xffff0000u); a[2] *= __uint_as_float(g.y << 16); a[3] *= __uint_as_float(g.y & 0xffff0000u);
            b[0] *= __uint_as_float(g.z << 16); b[1] *= __uint_as_float(g.z & 0xffff0000u); b[2] *= __uint_as_float(g.w << 16); b[3] *= __uint_as_float(g.w & 0xffff0000u); }
        const u32x4 w = (u32x4){pk2(a[0], a[1]), pk2(a[2], a[3]), pk2(b[0], b[1]), pk2(b[2], b[3])};
        *(u32x4*)(A.O + grow * 1024 + A.ocol + ch * 8) = w; }
    asm volatile("s_waitcnt lgkmcnt(0)\n\ts_barrier" ::: "memory");
#undef FA_DMA
}

#ifndef FA_STAG_FOX
#define FA_STAG_FOX 1
#endif
#ifndef FA_STAG_MLA
#define FA_STAG_MLA 1
#endif
#ifndef FA_PROBE_VALU
#define FA_PROBE_VALU 0
#endif
__device__ __forceinline__ void glds4(const void* gsrc, unsigned lds_dst) { unsigned keep;
    asm volatile("s_mov_b32 %0, m0\n\ts_mov_b32 m0, %2\n\ts_nop 0\n\tglobal_load_lds_dword %1, off\n\ts_mov_b32 m0, %0" : "=&s"(keep) : "v"(gsrc), "s"(lds_dst) : "memory"); }
__device__ __forceinline__ s16x4 vtr(const LAS char* p) { typedef short v4i16_t __attribute__((ext_vector_type(4))); return __builtin_bit_cast(s16x4, __builtin_amdgcn_ds_read_tr16_b64_v4i16((LAS v4i16_t*)p)); }
template <int MODE, bool DIAG> __device__ __forceinline__ void tile_qs(const LAS char* kp, const bf16x8 (&qr)[2][4], const LAS char* qrl, const LAS float* cbl, int r32, int hi,
                                                                     float (&m)[2], float (&l)[2], f32x16 (&o)[2][2], LAS float* wsf, u32x4 (&pw)[2][4]) {
    constexpr int ND0 = MODE ? 6 : 4;
    f32x16 p[2][2];
    if (MODE == 0) {
#pragma unroll
        for (int g4 = 0; g4 < 4; ++g4) { const f32x4 b0 = *(const LAS f32x4*)(cbl + 4 * hi + 8 * g4), b1 = *(const LAS f32x4*)(cbl + 32 + 4 * hi + 8 * g4);
#pragma unroll
            for (int i = 0; i < 4; ++i) { p[0][0][4 * g4 + i] = b0[i]; p[0][1][4 * g4 + i] = b1[i]; } }
        p[1][0] = p[0][0]; p[1][1] = p[0][1];
    } else {
#pragma unroll
        for (int b2 = 0; b2 < 2; ++b2) { p[b2][0] = f32x16{}; p[b2][1] = f32x16{}; }
    }
    bf16x8 qx[2][2];
    if (MODE) {
#pragma unroll
        for (int b2 = 0; b2 < 2; ++b2) { qx[b2][0] = *(const LAS bf16x8*)(qrl + (b2 * 2) * 1024); qx[b2][1] = *(const LAS bf16x8*)(qrl + (b2 * 2 + 1) * 1024); } }
#pragma unroll
    for (int d0 = 0; d0 < ND0; ++d0) { const bf16x8 k0 = *(const LAS bf16x8*)(kp + d0 * 2048), k1 = *(const LAS bf16x8*)(kp + d0 * 2048 + 512);
#pragma unroll
        for (int b2 = 0; b2 < 2; ++b2) { const bf16x8 qv = (d0 < 4) ? qr[b2][d0 & 3] : qx[b2][d0 & 1];
            p[b2][0] = __builtin_amdgcn_mfma_f32_32x32x16_bf16(k0, qv, p[b2][0], 0, 0, 0); p[b2][1] = __builtin_amdgcn_mfma_f32_32x32x16_bf16(k1, qv, p[b2][1], 0, 0, 0); } }
    if (MODE == 0 && DIAG) {
#pragma unroll
        for (int b2 = 0; b2 < 2; ++b2) { const int qrel = 32 * b2 + r32;
#pragma unroll
            for (int r = 0; r < 16; ++r) { const int kv = 4 * hi + (r & 3) + 8 * (r >> 2); if (kv > qrel) p[b2][0][r] = -INFINITY; if (kv + 32 > qrel) p[b2][1][r] = -INFINITY; } } }
    asm volatile("s_nop 15\n\ts_nop 7" : "+v"(p[0][0]), "+v"(p[0][1]), "+v"(p[1][0]), "+v"(p[1][1]));
#if FA_PROBE_VALU
    { float dd[8];
#pragma unroll
      for (int i = 0; i < 8; ++i) dd[i] = m[0] + (float)i;
#pragma unroll
      for (int k = 0; k < FA_PROBE_VALU; ++k)
#pragma unroll
        for (int i = 0; i < 8; ++i) dd[i] = ex2(dd[i]);
#pragma unroll
      for (int i = 0; i < 8; ++i) asm volatile("" :: "v"(dd[i])); }
#endif
#pragma unroll
    for (int b2 = 0; b2 < 2; ++b2) {
        const float rm = rowmax_a(p[b2][0], p[b2][1]);
        const float mn = max2f(m[b2], rm); float alpha = m[b2] - mn; asm("v_exp_f32 %0, %0\n\ts_nop 0" : "+v"(alpha)); m[b2] = mn;
        float sa0 = 0.f, sa1 = 0.f;
#pragma unroll
        for (int r = 0; r < 16; r += 2) { float a = p[b2][0][r] - mn, b = p[b2][1][r] - mn, c = p[b2][0][r + 1] - mn, d = p[b2][1][r + 1] - mn;
            asm("v_exp_f32 %0, %0\n\tv_exp_f32 %1, %1\n\tv_exp_f32 %2, %2\n\tv_exp_f32 %3, %3\n\tv_add_f32 %4, %4, %0\n\tv_add_f32 %5, %5, %1\n\tv_add_f32 %4, %4, %2\n\tv_add_f32 %5, %5, %3"
                : "+v"(a), "+v"(b), "+v"(c), "+v"(d), "+v"(sa0), "+v"(sa1));
            p[b2][0][r] = a; p[b2][1][r] = b; p[b2][0][r + 1] = c; p[b2][1][r + 1] = d; }
        l[b2] = l[b2] * alpha + (sa0 + sa1);
#pragma unroll
        for (int r = 0; r < 16; ++r) { float t0 = o[b2][0][r], t1 = o[b2][1][r]; asm("v_mul_f32 %0, %0, %1" : "+v"(t0) : "v"(alpha)); asm("v_mul_f32 %0, %0, %1" : "+v"(t1) : "v"(alpha)); o[b2][0][r] = t0; o[b2][1][r] = t1; }
        pw[b2][0] = (u32x4){pk2(p[b2][0][0], p[b2][0][1]), pk2(p[b2][0][2], p[b2][0][3]), pk2(p[b2][0][4], p[b2][0][5]), pk2(p[b2][0][6], p[b2][0][7])};
        pw[b2][1] = (u32x4){pk2(p[b2][0][8], p[b2][0][9]), pk2(p[b2][0][10], p[b2][0][11]), pk2(p[b2][0][12], p[b2][0][13]), pk2(p[b2][0][14], p[b2][0][15])};
        pw[b2][2] = (u32x4){pk2(p[b2][1][0], p[b2][1][1]), pk2(p[b2][1][2], p[b2][1][3]), pk2(p[b2][1][4], p[b2][1][5]), pk2(p[b2][1][6], p[b2][1][7])};
        pw[b2][3] = (u32x4){pk2(p[b2][1][8], p[b2][1][9]), pk2(p[b2][1][10], p[b2][1][11]), pk2(p[b2][1][12], p[b2][1][13]), pk2(p[b2][1][14], p[b2][1][15])};
    }
    asm volatile("s_nop 1" : "+v"(o[0][0]), "+v"(o[0][1]), "+v"(o[1][0]), "+v"(o[1][1]));
}
__device__ __forceinline__ void tile_pv(const LAS char* vp, f32x16 (&o)[2][2], const u32x4 (&pw)[2][4]) {
#pragma unroll
    for (int d0 = 0; d0 < 2; ++d0)
#pragma unroll
        for (int ks = 0; ks < 4; ++ks) { const s16x4 lo = vtr(vp + d0 * 4096 + ks * 1024), hi4 = vtr(vp + d0 * 4096 + ks * 1024 + 512);
            const bf16x8 vf = (bf16x8){lo[0], lo[1], lo[2], lo[3], hi4[0], hi4[1], hi4[2], hi4[3]};
#pragma unroll
            for (int b2 = 0; b2 < 2; ++b2) o[b2][d0] = __builtin_amdgcn_mfma_f32_32x32x16_bf16(vf, __builtin_bit_cast(bf16x8, pw[b2][ks]), o[b2][d0], 0, 0, 0); }
}
template <int MODE> __device__ __forceinline__ void unit2(const Args& A, long rowbase, int qb, LAS char* lds, unsigned lds0) {
    constexpr int ND0 = MODE ? 6 : 4;
    const int tid = pg8::pg8_tid(), lane = tid & 63, r32 = lane & 31, hi = lane >> 5; const int wid = __builtin_amdgcn_readfirstlane(tid >> 6);
    const int q0 = qb * 512, NT = q0 / 64 + 8, nt_w = q0 / 64 + wid + 1;
    bf16x8 qr[2][4];
    LAS char* qrl = lds + L_QR2 + wid * 4096 + lane * 16;
#pragma unroll
    for (int b2 = 0; b2 < 2; ++b2) { const bf16* Qw = A.Q + (rowbase + q0 + wid * 64 + b2 * 32 + r32) * A.qpitch + A.qcol + hi * 8;
#pragma unroll
        for (int d0 = 0; d0 < 4; ++d0) qr[b2][d0] = *(const bf16x8*)(Qw + d0 * 16);
        if (MODE) { *(LAS bf16x8*)(qrl + (b2 * 2) * 1024) = *(const bf16x8*)(Qw + 64); *(LAS bf16x8*)(qrl + (b2 * 2 + 1) * 1024) = *(const bf16x8*)(Qw + 80); } }
    const int koff = lane * A.kpitch + A.kcol + wid * 8, k2off = lane * 32 + (wid & 3) * 8, voff = (16 * (wid & 3) + (lane >> 2)) * A.vpitch + A.vcol + (wid >> 2) * 32 + (lane & 3) * 8;
    const bf16* Kb = A.K + rowbase * A.kpitch; const bf16* K2b = MODE ? A.K2 + rowbase * 32 : nullptr; const bf16* Vb = A.V + rowbase * A.vpitch;
#define FA_DMA(t, slot) do { \
        int ko_ = koff, k2o_ = k2off, vo_ = voff; asm volatile("" : "+v"(ko_), "+v"(k2o_), "+v"(vo_)); \
        glds16(Kb + (long)(t) * 64 * A.kpitch + ko_, (unsigned)__builtin_amdgcn_readfirstlane(lds0 + L_K + (slot) * KSLOT + wid * 1024)); \
        if (MODE && wid < 4) glds16(K2b + (long)(t) * 64 * 32 + k2o_, (unsigned)__builtin_amdgcn_readfirstlane(lds0 + L_K + (slot) * KSLOT + (8 + wid) * 1024)); \
        glds16(Vb + (long)(t) * 64 * A.vpitch + vo_, (unsigned)__builtin_amdgcn_readfirstlane(lds0 + L_V + ((t) % 3) * VSLOT + wid * 1024)); \
        if (!MODE && wid == 4) glds4(A.CB + (t) * 64 + lane, (unsigned)__builtin_amdgcn_readfirstlane(lds0 + L_CB2 + (slot) * 256)); } while (0)
    LAS float* wsf = (LAS float*)(lds + L_WS2) + wid * 128;
    const LAS char* kp0 = lds + L_K + hi * 1024 + r32 * 16;
    const LAS char* vp0 = lds + L_V + ((lane >> 4) & 1) * 32 + (lane & 3) * 8 + (4 * hi + ((lane & 15) >> 2)) * 64;
    float m[2] = {-1e30f, -1e30f}, l[2] = {0.f, 0.f}; f32x16 o[2][2];
#pragma unroll
    for (int b2 = 0; b2 < 2; ++b2) { o[b2][0] = f32x16{}; o[b2][1] = f32x16{}; }
    FA_DMA(0, 0);
    u32x4 pw[2][4];
#define FA_STEP_HEAD(t) FA_WAIT_BAR(); if ((t) + 1 < NT) FA_DMA((t) + 1, ((t) + 1) & 1); const int slot = (t) & 1; const LAS float* cbl = (const LAS float*)(lds + L_CB2 + slot * 256)
    if (wid < 4 || !(MODE ? FA_STAG_MLA : FA_STAG_FOX)) {
        int t = 0;
        for (; t < nt_w - 1; ++t) { FA_STEP_HEAD(t); tile_qs<MODE, false>(kp0 + slot * KSLOT, qr, qrl, cbl, r32, hi, m, l, o, wsf, pw); tile_pv(vp0 + (t % 3) * VSLOT, o, pw); }
        { FA_STEP_HEAD(t); tile_qs<MODE, true>(kp0 + slot * KSLOT, qr, qrl, cbl, r32, hi, m, l, o, wsf, pw); tile_pv(vp0 + (t % 3) * VSLOT, o, pw); ++t; }
        for (; t < NT; ++t) { FA_STEP_HEAD(t); (void)slot; (void)cbl; }
    } else {
        int t = 0;
        if (nt_w > 1) { FA_STEP_HEAD(0); tile_qs<MODE, false>(kp0 + slot * KSLOT, qr, qrl, cbl, r32, hi, m, l, o, wsf, pw); t = 1;
            for (; t < nt_w - 1; ++t) { FA_STEP_HEAD(t); tile_pv(vp0 + ((t - 1) % 3) * VSLOT, o, pw); FA_SBAR(); tile_qs<MODE, false>(kp0 + slot * KSLOT, qr, qrl, cbl, r32, hi, m, l, o, wsf, pw); }
            { FA_STEP_HEAD(t); tile_pv(vp0 + ((t - 1) % 3) * VSLOT, o, pw); FA_SBAR(); tile_qs<MODE, true>(kp0 + slot * KSLOT, qr, qrl, cbl, r32, hi, m, l, o, wsf, pw); ++t; }
        } else { FA_STEP_HEAD(0); tile_qs<MODE, true>(kp0 + slot * KSLOT, qr, qrl, cbl, r32, hi, m, l, o, wsf, pw); t = 1; }
        if (t < NT) { FA_STEP_HEAD(t); (void)slot; (void)cbl; tile_pv(vp0 + ((t - 1) % 3) * VSLOT, o, pw); ++t;
            for (; t < NT; ++t) { FA_STEP_HEAD(t); (void)slot; (void)cbl; } }
        else tile_pv(vp0 + ((NT - 1) % 3) * VSLOT, o, pw);
    }
#undef FA_STEP_HEAD
#pragma unroll
    for (int b2 = 0; b2 < 2; ++b2) {
        float lb = l[b2];
        { auto rr = __builtin_amdgcn_permlane32_swap(__float_as_uint(lb), __float_as_uint(lb), false, false); lb = __uint_as_float(rr[0]) + __uint_as_float(rr[1]); }
        const float rl = __builtin_amdgcn_rcpf(lb); const long grow = rowbase + q0 + wid * 64 + b2 * 32 + r32;
#pragma unroll
        for (int d0 = 0; d0 < 2; ++d0)
#pragma unroll
            for (int g4 = 0; g4 < 4; ++g4) { const int dc = A.ocol + 32 * d0 + 8 * g4 + 4 * hi;
                f32x4 v = (f32x4){o[b2][d0][4 * g4], o[b2][d0][4 * g4 + 1], o[b2][d0][4 * g4 + 2], o[b2][d0][4 * g4 + 3]} * rl;
                if (MODE == 0) { const u32x2 g = *(const u32x2*)(A.G + grow * 1024 + dc);
                    v[0] *= __uint_as_float(g.x << 16); v[1] *= __uint_as_float(g.x & 0xffff0000u); v[2] *= __uint_as_float(g.y << 16); v[3] *= __uint_as_float(g.y & 0xffff0000u); }
                *(u32x2*)(A.O + grow * 1024 + dc) = (u32x2){pk2(v[0], v[1]), pk2(v[2], v[3])}; }
    }
    asm volatile("s_waitcnt lgkmcnt(0)\n\ts_barrier" ::: "memory");
#undef FA_DMA
}
}

namespace a16 {
__device__ __forceinline__ f32x4 mfma16(bf16x8 a, bf16x8 b, f32x4 c) { return __builtin_amdgcn_mfma_f32_16x16x32_bf16(a, b, c, 0, 0, 0); }
template <int NQK, int NDB, class KL, class VL, class SF>
__device__ __forceinline__ void steps(int s0, int s1, const bf16x8 (&qf)[NQK], KL kload, VL vload, SF sfix, float& m, float& l, f32x4 (&o)[NDB], int lane) {
    const int g = lane >> 4;
    for (int s = s0; s < s1; ++s) {
        f32x4 sA = {0.f, 0.f, 0.f, 0.f}, sB = {0.f, 0.f, 0.f, 0.f};
#pragma unroll
        for (int d0 = 0; d0 < NQK; ++d0) { sA = mfma16(kload(s, 0, d0), qf[d0], sA); sB = mfma16(kload(s, 1, d0), qf[d0], sB); }
        sfix(s, sA, sB);
        float mx = __builtin_fmaxf(__builtin_fmaxf(__builtin_fmaxf(sA[0], sA[1]), __builtin_fmaxf(sA[2], sA[3])), __builtin_fmaxf(__builtin_fmaxf(sB[0], sB[1]), __builtin_fmaxf(sB[2], sB[3])));
        mx = __builtin_fmaxf(mx, __shfl_xor(mx, 16)); mx = __builtin_fmaxf(mx, __shfl_xor(mx, 32));
        const float mn = __builtin_fmaxf(m, mx), alpha = ex2(m - mn); m = mn;
        f32x4 pA, pB;
#pragma unroll
        for (int r = 0; r < 4; ++r) { pA[r] = ex2(sA[r] - mn); pB[r] = ex2(sB[r] - mn); }
        float ps = ((pA[0] + pA[1]) + (pA[2] + pA[3])) + ((pB[0] + pB[1]) + (pB[2] + pB[3]));
        ps += __shfl_xor(ps, 16); ps += __shfl_xor(ps, 32);
        l = l * alpha + ps;
        const float a0 = __shfl(alpha, 4 * g), a1 = __shfl(alpha, 4 * g + 1), a2 = __shfl(alpha, 4 * g + 2), a3 = __shfl(alpha, 4 * g + 3);
#pragma unroll
        for (int db = 0; db < NDB; ++db) { o[db][0] *= a0; o[db][1] *= a1; o[db][2] *= a2; o[db][3] *= a3; }
        const u32x4 pw = (u32x4){pk2(pA[0], pA[1]), pk2(pA[2], pA[3]), pk2(pB[0], pB[1]), pk2(pB[2], pB[3])};
        const bf16x8 pf = __builtin_bit_cast(bf16x8, pw);
#pragma unroll
        for (int db = 0; db < NDB; ++db) o[db] = mfma16(pf, vload(s, db), o[db]);
    }
}
__device__ __forceinline__ bf16x8 cvt8(f32x4 a, f32x4 b) { const u32x4 w = (u32x4){pk2(a[0], a[1]), pk2(a[2], a[3]), pk2(b[0], b[1]), pk2(b[2], b[3])}; return __builtin_bit_cast(bf16x8, w); }
__device__ __forceinline__ bf16x8 join8(u32x2 a, u32x2 b) { const u32x4 w = (u32x4){a.x, a.y, b.x, b.y}; return __builtin_bit_cast(bf16x8, w); }
}


namespace xa {
constexpr int TSZ = 16384, L_T = 0, L_WS = 2 * TSZ, L_OST = L_WS + 8 * 64 * 4, L_BYTES = L_OST + 8 * 2048;
#define XA_WAIT_BAR() asm volatile("s_waitcnt vmcnt(0) lgkmcnt(0)\n\ts_barrier" ::: "memory")
template <typename T> __device__ __forceinline__ const T* src_of(const T* Kh, const T* Vh, int pitch, int i, int ci) {
    return (i < 8) ? Kh + (size_t)(32 * i + (ci & 31)) * pitch + (ci >> 5) * 8 : Vh + (size_t)(ci >> 2) * pitch + 32 * (i - 8) + (ci & 3) * 8; }
template <bool F32SRC> __device__ __forceinline__ void unit(const void* Kh_, const void* Vh_, int pitch, const bf16* Q, bf16* O, size_t row0, int hcol, int nvalid_w0, bool only_w0, LAS char* lds, unsigned lds0) {
    const int tid = pg8::pg8_tid(), lane = tid & 63, r32 = lane & 31, hi = lane >> 5; const int wid = __builtin_amdgcn_readfirstlane(tid >> 6);
    const bool active = !only_w0 || wid == 0; const int nvalid = only_w0 ? (wid == 0 ? nvalid_w0 : 0) : 32;
    bf16x8 qr[16];
    { const bf16* Qw = Q + (row0 + wid * 32 + r32) * 1024 + hcol + hi * 8;
#pragma unroll
      for (int d0 = 0; d0 < 16; ++d0) qr[d0] = active ? *(const bf16x8*)(Qw + d0 * 16) : (bf16x8){0, 0, 0, 0, 0, 0, 0, 0}; }
    LAS float* wsf = (LAS float*)(lds + L_WS) + wid * 64;
    f32x4 st[2][2];
#define XA_ISSUE(i) do { if (F32SRC) { _Pragma("unroll") for (int c2 = 0; c2 < 2; ++c2) { const float* s = src_of<float>((const float*)Kh_, (const float*)Vh_, pitch, (i), tid + 512 * c2); st[c2][0] = *(const f32x4*)s; st[c2][1] = *(const f32x4*)(s + 4); } } \
        else { _Pragma("unroll") for (int c2 = 0; c2 < 2; ++c2) fa::glds16(src_of<bf16>((const bf16*)Kh_, (const bf16*)Vh_, pitch, (i), (2 * wid + c2) * 64 + lane), (unsigned)__builtin_amdgcn_readfirstlane(lds0 + L_T + ((i) & 1) * TSZ + (2 * wid + c2) * 1024)); } } while (0)
#define XA_COMMIT(i) do { if (F32SRC) { _Pragma("unroll") for (int c2 = 0; c2 < 2; ++c2) *(LAS u32x4*)(lds + L_T + ((i) & 1) * TSZ + (tid + 512 * c2) * 16) = \
        (u32x4){pk2(st[c2][0][0], st[c2][0][1]), pk2(st[c2][0][2], st[c2][0][3]), pk2(st[c2][1][0], st[c2][1][1]), pk2(st[c2][1][2], st[c2][1][3])}; } } while (0)
    XA_ISSUE(0); XA_COMMIT(0);
    f32x16 S[8];
#pragma unroll
    for (int t = 0; t < 8; ++t) {
        XA_WAIT_BAR(); XA_ISSUE(t + 1);
        const LAS char* kp = lds + L_T + (t & 1) * TSZ + hi * 512 + r32 * 16;
        S[t] = f32x16{};
#pragma unroll
        for (int d0 = 0; d0 < 16; ++d0) S[t] = __builtin_amdgcn_mfma_f32_32x32x16_bf16(*(const LAS bf16x8*)(kp + d0 * 1024), qr[d0], S[t], 0, 0, 0);
        XA_COMMIT(t + 1);
    }
    float mx = S[0][0];
#pragma unroll
    for (int t = 0; t < 8; ++t)
#pragma unroll
        for (int r = 0; r < 16; ++r) mx = __builtin_fmaxf(mx, S[t][r]);
    { auto rr = __builtin_amdgcn_permlane32_swap(__float_as_uint(mx), __float_as_uint(mx), false, false); mx = __builtin_fmaxf(__uint_as_float(rr[0]), __uint_as_float(rr[1])); }
    float l = 0.f; u32x4 pw[16];
#pragma unroll
    for (int t = 0; t < 8; ++t) {
#pragma unroll
        for (int r = 0; r < 16; ++r) { S[t][r] = ex2(S[t][r] - mx); l += S[t][r]; }
        pw[2 * t] = (u32x4){pk2(S[t][0], S[t][1]), pk2(S[t][2], S[t][3]), pk2(S[t][4], S[t][5]), pk2(S[t][6], S[t][7])};
        pw[2 * t + 1] = (u32x4){pk2(S[t][8], S[t][9]), pk2(S[t][10], S[t][11]), pk2(S[t][12], S[t][13]), pk2(S[t][14], S[t][15])}; }
    { auto rr = __builtin_amdgcn_permlane32_swap(__float_as_uint(l), __float_as_uint(l), false, false); l = __uint_as_float(rr[0]) + __uint_as_float(rr[1]); }
    if (hi == 0) wsf[r32] = l;
    float rli[16];
#pragma unroll
    for (int r = 0; r < 16; ++r) rli[r] = __builtin_amdgcn_rcpf(wsf[fa::crow(r, hi)]);
    const int vbl = (int)(lds0 + L_T) + ((lane >> 4) & 1) * 32 + (lane & 3) * 8 + (4 * hi + ((lane & 15) >> 2)) * 64;
    LAS bf16* stg = (LAS bf16*)(lds + L_OST) + wid * 1024;
#pragma unroll
    for (int db = 0; db < 8; ++db) {
        XA_WAIT_BAR(); if (db < 7) XA_ISSUE(8 + db + 1);
        const int vb = vbl + (db & 1) * TSZ;
        f32x16 o = f32x16{};
#pragma unroll
        for (int k4 = 0; k4 < 4; ++k4) { s16x4 vlo[4], vhi[4];
#pragma unroll
            for (int kk = 0; kk < 4; ++kk) {
                asm volatile("ds_read_b64_tr_b16 %0,%1 offset:%c2" : "=&v"(vlo[kk]) : "v"(vb), "i"((k4 * 4 + kk) * 1024) : "memory");
                asm volatile("ds_read_b64_tr_b16 %0,%1 offset:%c2" : "=&v"(vhi[kk]) : "v"(vb), "i"((k4 * 4 + kk) * 1024 + 512) : "memory"); }
            asm volatile("s_waitcnt lgkmcnt(0)" ::: "memory"); __builtin_amdgcn_sched_barrier(0);
#pragma unroll
            for (int kk = 0; kk < 4; ++kk) o = __builtin_amdgcn_mfma_f32_32x32x16_bf16(__builtin_bit_cast(bf16x8, pw[k4 * 4 + kk]),
                (bf16x8){vlo[kk][0], vlo[kk][1], vlo[kk][2], vlo[kk][3], vhi[kk][0], vhi[kk][1], vhi[kk][2], vhi[kk][3]}, o, 0, 0, 0); }
        if (db < 7) XA_COMMIT(8 + db + 1);
#pragma unroll
        for (int r = 0; r < 16; ++r) stg[fa::crow(r, hi) * 32 + r32] = (bf16)(pk2(o[r] * rli[r], 0.f) & 0xffffu);
        LDS_WAIT();
#pragma unroll
        for (int ps = 0; ps < 2; ++ps) { const int row = ps * 16 + (lane >> 2), ch = lane & 3;
            const u32x4 v = *(const LAS u32x4*)(stg + row * 32 + ch * 8);
            if (row < nvalid) *(u32x4*)(O + (row0 + wid * 32 + row) * 1024 + hcol + 32 * db + ch * 8) = v; }
        LDS_WAIT();
    }
    asm volatile("s_waitcnt lgkmcnt(0)\n\ts_barrier" ::: "memory");
#undef XA_ISSUE
#undef XA_COMMIT
}
}

namespace ms {
constexpr int KSZ = 18432, L_T = 0, L_WS = 2 * KSZ, L_OST = L_WS + 8 * 64 * 4, L_BYTES = L_OST + 8 * 4096;
constexpr int PROW = 264;
#define MS_WAIT_BAR() asm volatile("s_waitcnt lgkmcnt(0)\n\ts_barrier" ::: "memory")
__device__ __forceinline__ const float* ms_ksrc(const float* ckvb, const float* krb, int key, int c) {
    const size_t o0 = (size_t)key * 256 + c * 8, o1 = (size_t)key * 32 + (c - 32) * 8; const bool lat = c < 32; return (lat ? ckvb : krb) + (lat ? o0 : o1); }
template <int NK> __device__ __forceinline__ void unit(const float* ckvb, const float* krb, int kclamp, const bf16* QA, float* P, LAS char* lds, unsigned lds0) {
    const int tid = pg8::pg8_tid(), lane = tid & 63, r32 = lane & 31, hi = lane >> 5; const int wid = __builtin_amdgcn_readfirstlane(tid >> 6);
    const bf16* Qw = QA + (size_t)(wid * 32 + r32) * 288 + hi * 8;
    f32x4 st[2][3][2];
#define MS_SRC(i, ci) (((i) < 8) ? ms_ksrc(ckvb, krb, min(32 * (i) + ((ci) & 31), kclamp), (ci) >> 5) \
                                  : ckvb + (size_t)min((ci) >> 2, kclamp) * 256 + 32 * ((i) - 8) + ((ci) & 3) * 8)
#define MS_NCH(i) (((i) < 8) ? 1152 : 1024)
#define MS_ISSUE(i, set) do { _Pragma("unroll") for (int c2 = 0; c2 < 3; ++c2) { const int ci = min(tid + 512 * c2, MS_NCH(i) - 1); const float* s = MS_SRC(i, ci); st[(set) & 1][c2][0] = *(const f32x4*)s; st[(set) & 1][c2][1] = *(const f32x4*)(s + 4); } } while (0)
#define MS_COMMIT(i, slot) do { _Pragma("unroll") for (int c2 = 0; c2 < 3; ++c2) { const int ci = min(tid + 512 * c2, MS_NCH(i) - 1); *(LAS u32x4*)(lds + L_T + ((slot) & 1) * KSZ + ci * 16) = \
        (u32x4){pk2(st[(slot) & 1][c2][0][0], st[(slot) & 1][c2][0][1]), pk2(st[(slot) & 1][c2][0][2], st[(slot) & 1][c2][0][3]), pk2(st[(slot) & 1][c2][1][0], st[(slot) & 1][c2][1][1]), pk2(st[(slot) & 1][c2][1][2], st[(slot) & 1][c2][1][3])}; } } while (0)
    constexpr int FIRSTV = 8;
#define MS_TILE(q) (((q) < NK) ? (q) : FIRSTV + (q) - NK)
    MS_ISSUE(MS_TILE(0), 0); MS_COMMIT(MS_TILE(0), 0); MS_ISSUE(MS_TILE(1), 1);
    f32x16 S[NK];
#pragma unroll
    for (int t = 0; t < NK; ++t) {
        MS_WAIT_BAR(); MS_ISSUE(MS_TILE(t + 2), t + 2);
        const LAS char* kp = lds + L_T + (t & 1) * KSZ + hi * 512 + r32 * 16;
        S[t] = f32x16{}; const bf16* Qt = Qw; asm volatile("" : "+v"(Qt));
#pragma unroll
        for (int d0 = 0; d0 < 18; ++d0) { S[t] = __builtin_amdgcn_mfma_f32_32x32x16_bf16(*(const LAS bf16x8*)(kp + d0 * 1024), *(const bf16x8*)(Qt + d0 * 16), S[t], 0, 0, 0);
            if (d0 % 6 == 5) __builtin_amdgcn_sched_barrier(0); }
        MS_COMMIT(MS_TILE(t + 1), t + 1);
    }
    constexpr int VS0 = (NK & 1);
    if (NK == 1) {
#pragma unroll
        for (int r = 8; r < 16; ++r) S[0][r] = -INFINITY; }
    float mx = S[0][0];
#pragma unroll
    for (int t = 0; t < NK; ++t)
#pragma unroll
        for (int r = 0; r < 16; ++r) mx = __builtin_fmaxf(mx, S[t][r]);
    { auto rr = __builtin_amdgcn_permlane32_swap(__float_as_uint(mx), __float_as_uint(mx), false, false); mx = __builtin_fmaxf(__uint_as_float(rr[0]), __uint_as_float(rr[1])); }
    float l = 0.f; u32x4 pw[2 * NK];
#pragma unroll
    for (int t = 0; t < NK; ++t) {
#pragma unroll
        for (int r = 0; r < 16; ++r) { S[t][r] = ex2(S[t][r] - mx); l += S[t][r]; }
        pw[2 * t] = (u32x4){pk2(S[t][0], S[t][1]), pk2(S[t][2], S[t][3]), pk2(S[t][4], S[t][5]), pk2(S[t][6], S[t][7])};
        pw[2 * t + 1] = (u32x4){pk2(S[t][8], S[t][9]), pk2(S[t][10], S[t][11]), pk2(S[t][12], S[t][13]), pk2(S[t][14], S[t][15])}; }
    { auto rr = __builtin_amdgcn_permlane32_swap(__float_as_uint(l), __float_as_uint(l), false, false); l = __uint_as_float(rr[0]) + __uint_as_float(rr[1]); }
    float* Pw = P + (size_t)(wid * 32) * PROW;
    if (hi == 0) { Pw[(size_t)r32 * PROW + 256] = mx; Pw[(size_t)r32 * PROW + 257] = l; }
    LAS float* stg = (LAS float*)(lds + L_OST) + wid * 1024;
#pragma unroll
    for (int db = 0; db < 8; ++db) {
        MS_WAIT_BAR(); if (db < 6) MS_ISSUE(FIRSTV + db + 2, NK + db + 2);
        const int vb = (int)(lds0 + L_T) + ((VS0 + db) & 1) * KSZ + ((lane >> 4) & 1) * 32 + (lane & 3) * 8 + (4 * hi + ((lane & 15) >> 2)) * 64;
        f32x16 o = f32x16{};
#pragma unroll
        for (int ks = 0; ks < 2 * NK; ++ks) { s16x4 vlo, vhi;
            asm volatile("ds_read_b64_tr_b16 %0,%1 offset:%c2" : "=&v"(vlo) : "v"(vb), "i"(ks * 1024) : "memory");
            asm volatile("ds_read_b64_tr_b16 %0,%1 offset:%c2" : "=&v"(vhi) : "v"(vb), "i"(ks * 1024 + 512) : "memory");
            asm volatile("s_waitcnt lgkmcnt(0)" ::: "memory"); __builtin_amdgcn_sched_barrier(0);
            o = __builtin_amdgcn_mfma_f32_32x32x16_bf16(__builtin_bit_cast(bf16x8, pw[ks]), (bf16x8){vlo[0], vlo[1], vlo[2], vlo[3], vhi[0], vhi[1], vhi[2], vhi[3]}, o, 0, 0, 0); }
#pragma unroll
        for (int r = 0; r < 16; ++r) stg[fa::crow(r, hi) * 32 + r32] = o[r];
        LDS_WAIT();
        { const int row = lane >> 1, cq = (lane & 1) * 16; float* dst = Pw + (size_t)row * PROW + 32 * db + cq;
#pragma unroll
          for (int k = 0; k < 4; ++k) *(f32x4*)(dst + 4 * k) = *(const LAS f32x4*)(stg + row * 32 + cq + 4 * k); }
        if (db < 7) MS_COMMIT(FIRSTV + db + 1, NK + db + 1);
        LDS_WAIT();
    }
    asm volatile("s_waitcnt lgkmcnt(0)\n\ts_barrier" ::: "memory");
#undef MS_SRC
#undef MS_ISSUE
#undef MS_COMMIT
#undef MS_NCH
#undef MS_TILE
}
}

constexpr int RING_OFF = 0, RING_BYTES = 131072;
constexpr int LDSCTL_OFF = RING_BYTES, MISC_OFF = LDSCTL_OFF + 320;
constexpr int LDS_BYTES = 147456;
constexpr int NWAVES = 8;
static_assert(fa::L_BYTES2 <= RING_BYTES && xa::L_BYTES <= RING_BYTES && ms::L_BYTES <= RING_BYTES, "attention LDS");

struct KArgs { const float* in[N_IN]; float* out; unsigned char* ws; int ph_lo, ph_hi; };
static_assert(sizeof(KArgs) == N_IN * 8 + 24, "KArgs has no padding");
typedef const __attribute__((address_space(4))) KArgs* KAP;
#define KA ((KAP)__builtin_amdgcn_kernarg_segment_ptr())

#define XB_TMO      128
#define XB_XCNT(j)  (256  + 64 * (j))
#define XB_XSUB(j)  (1280 + 64 * (j))
#define XB_XGEN(j)  (2304 + 64 * (j))
#define XB_TOP      3328
#define XB_TOPGEN   3392
#define XCD_BAR_WORDS 3456
#define XB_SPIN_CAP (1u << 18)

__device__ __forceinline__ unsigned xb_ld(unsigned* p)              { return __hip_atomic_load(p, __ATOMIC_RELAXED, __HIP_MEMORY_SCOPE_AGENT); }
__device__ __forceinline__ unsigned xb_add(unsigned* p, unsigned v) { return __hip_atomic_fetch_add(p, v, __ATOMIC_RELAXED, __HIP_MEMORY_SCOPE_AGENT); }
__device__ __forceinline__ unsigned xb_xcc_id() { return (unsigned)__builtin_amdgcn_s_getreg((3 << 11) | 20) & 0xFu; }
#define XB_SPIN(cond, bar) do { unsigned _sp = 0; while (cond) { __builtin_amdgcn_s_sleep(1); \
    if ((++_sp & 255u) == 0u) { if (xb_ld(&(bar)[XB_TMO])) break; if (_sp > XB_SPIN_CAP) { atomicAdd(&(bar)[XB_TMO], 1u); break; } } } } while (0)

struct XcdBarrier {
    unsigned* bar; unsigned x;
    volatile LAS unsigned* st;
};

__device__ __forceinline__ XcdBarrier xcd_barrier_post(unsigned* bar, volatile LAS unsigned* st) {
    XcdBarrier b; b.bar = bar; b.x = xb_xcc_id(); b.st = st;
    if (threadIdx.x == 0) (void)xb_add(&bar[XB_XCNT(b.x)], 1u);
    return b;
}
__device__ __forceinline__ void xcd_barrier_complete(unsigned* bar, unsigned x, unsigned& nloc, unsigned& nx) {
    const unsigned G = gridDim.x * gridDim.y * gridDim.z;
    unsigned sum, cnt, mine, sp = 0u;
    for (;;) {
        sum = 0u; cnt = 0u; mine = 0u;
#pragma unroll
        for (unsigned j = 0; j < 16; ++j) { const unsigned c = xb_ld(&bar[XB_XCNT(j)]); sum += c; cnt += (c > 0u) ? 1u : 0u; mine = (j == x) ? c : mine; }
        if (sum == G) break;
        __builtin_amdgcn_s_sleep(1);
        if ((++sp & 255u) == 0u) { if (xb_ld(&bar[XB_TMO])) break; if (sp > XB_SPIN_CAP) { atomicAdd(&bar[XB_TMO], 1u); break; } }
    }
    nloc = mine > 0u ? mine : 1u; nx = cnt > 0u ? cnt : 1u;
}

__device__ __forceinline__ void xcd_barrier(const XcdBarrier& b) {
    asm volatile("s_waitcnt vmcnt(0)" ::: "memory");
    __syncthreads();
    if (threadIdx.x == 0) {
        unsigned* bar = b.bar;
        __builtin_amdgcn_s_waitcnt(0);
        unsigned nloc = b.st[0], nx = b.st[1];
        if (nloc == 0u) { xcd_barrier_complete(bar, b.x, nloc, nx); b.st[0] = nloc; b.st[1] = nx; }
        const unsigned old = xb_add(&bar[XB_XSUB(b.x)], 1u);
        const unsigned gen = old / nloc;
        if (old + 1u == (gen + 1u) * nloc) {
            __builtin_amdgcn_fence(__ATOMIC_RELEASE, "agent");
            asm volatile("s_waitcnt vmcnt(0)" ::: "memory");
            const unsigned og = xb_add(&bar[XB_TOP], 1u);
            const unsigned tg = og / nx;
            if (og + 1u == (tg + 1u) * nx) xb_add(&bar[XB_TOPGEN], 1u);
            else XB_SPIN(xb_ld(&bar[XB_TOPGEN]) == tg, bar);
            __builtin_amdgcn_fence(__ATOMIC_ACQUIRE, "agent");
            xb_add(&bar[XB_XGEN(b.x)], 1u);
            asm volatile("s_waitcnt vmcnt(0)" ::: "memory");
        } else {
            XB_SPIN(xb_ld(&bar[XB_XGEN(b.x)]) == gen, bar);
            __builtin_amdgcn_fence(__ATOMIC_ACQUIRE, "agent");
            asm volatile("s_waitcnt vmcnt(0)" ::: "memory");
        }
    }
    __syncthreads();
}

struct Seg { const float* W; int ldw, c0, ncols, K; bf16* T; int ldt, r0; const float* g; };
__device__ __forceinline__ Seg get_seg(KAP a, unsigned char* ws, int idx) {
    Seg s; s.g = nullptr; s.r0 = 0; s.c0 = 0; s.ldw = 1024; s.ncols = 1024; s.K = 1024; s.ldt = 1024; s.W = nullptr; s.T = nullptr;
    if (idx < 4) { const int j = idx & 1; s.W = a->in[I_WFI] + (size_t)j * 1024 * 4112; s.ldw = 4112; s.T = (bf16*)(ws + WS_WFI) + (size_t)j * 4352 * 1024; s.g = a->in[I_GMIX] + (size_t)(2 * j) * 1024;
        if (idx < 2) { s.c0 = 0; s.ncols = 3072; s.r0 = 0; } else { s.c0 = 3088; s.ncols = 1024; s.r0 = 3072; } }
    else if (idx < 6) { const int j = idx - 4; s.W = a->in[I_WFO] + (size_t)j * 1024 * 1024; s.T = (bf16*)(ws + WS_WFO) + (size_t)j * 1024 * 1024; }
    else if (idx < 12) { const int e = idx - 6, j = e / 3, part = e % 3; s.W = a->in[I_WMA] + (size_t)j * 1024 * 672; s.ldw = 672; s.T = (bf16*)(ws + WS_WMA) + (size_t)j * 768 * 1024; s.g = a->in[I_GMIX] + (size_t)(2 * j + 1) * 1024;
        if (part == 0) { s.c0 = 384; s.ncols = 256; s.r0 = 0; } else if (part == 1) { s.c0 = 0; s.ncols = 384; s.r0 = 256; } else { s.c0 = 640; s.ncols = 32; s.r0 = 640; } }
    else if (idx < 14) { const int j = idx - 12; s.W = a->in[I_WMQB] + (size_t)j * 384 * 1536; s.ldw = 1536; s.ncols = 1536; s.K = 384; s.T = (bf16*)(ws + WS_WMQ) + (size_t)j * 1536 * 384; s.ldt = 384; s.g = a->in[I_GMQ] + (size_t)j * 384; }
    else if (idx < 18) { const int j = idx & 1; const bool raw = idx >= 16; s.W = a->in[I_WMKVB] + (size_t)j * 256 * 2048; s.ldw = 2048; s.ncols = 2048; s.K = 256; s.ldt = 256;
        s.T = (bf16*)(ws + (raw ? WS_WMKVR : WS_WMKV)) + (size_t)j * 2048 * 256; s.g = raw ? nullptr : a->in[I_GMKV] + (size_t)j * 256; }
    else if (idx < 20) { const int j = idx - 18; s.W = a->in[I_WMO] + (size_t)j * 1024 * 1024; s.T = (bf16*)(ws + WS_WMO) + (size_t)j * 1024 * 1024; }
    else if (idx < 24) { const int i = idx - 20; s.W = a->in[I_WXQ] + (size_t)i * 1024 * 1024; s.T = (bf16*)(ws + WS_WXQ) + (size_t)i * 1024 * 1024; s.g = a->in[I_GCROSS] + (size_t)i * 1024; }
    else if (idx < 28) { const int i = idx - 24; s.W = a->in[I_WXO] + (size_t)i * 1024 * 1024; s.T = (bf16*)(ws + WS_WXO) + (size_t)i * 1024 * 1024; }
    else if (idx < 32) { const int i = idx - 28; s.W = a->in[I_WXKV] + (size_t)i * 1024 * 2048; s.ldw = 2048; s.ncols = 2048; s.T = (bf16*)(ws + WS_WXKV) + (size_t)i * 2048 * 1024; s.g = a->in[I_GMEM] + (size_t)i * 1024; }
    else if (idx < 36) { const int i = idx - 32; s.W = a->in[I_WDN] + (size_t)i * 2816 * 1024; s.K = 2816; s.T = (bf16*)(ws + WS_WDN) + (size_t)i * 1024 * 2816; s.ldt = 2816; }
    else if (idx < 212) { const int e = idx - 36, i = e / 44, t = e % 44, pn = t >> 1, half = t & 1; s.W = a->in[I_WGU] + (size_t)i * 1024 * 5632; s.ldw = 5632; s.c0 = half * 2816 + 128 * pn; s.ncols = 128;
        s.T = (bf16*)(ws + WS_WGU) + (size_t)i * 5632 * 1024; s.r0 = 256 * pn + 128 * half; s.g = a->in[I_GFFN] + (size_t)i * 1024; }
    else { const int j = idx - 212; s.W = a->in[I_WFI] + (size_t)j * 1024 * 4112; s.ldw = 4112; s.c0 = 3072; s.ncols = 32; s.T = (bf16*)(ws + WS_WFI) + (size_t)j * 4352 * 1024; s.r0 = 4096; s.g = a->in[I_GMIX] + (size_t)(2 * j) * 1024; }
    return s;
}
constexpr int NSEG = 214;
__device__ __forceinline__ void tr_load(const Seg& s, int item, int lane, float (&v)[32]) {
    const int nnb = s.ncols / 32, kb = item / nnb, nb = item % nnb; const float* p = s.W + (size_t)(64 * kb + (lane >> 5)) * s.ldw + s.c0 + 32 * nb + (lane & 31);
#pragma unroll
    for (int i = 0; i < 32; ++i) v[i] = p[(size_t)(2 * i) * s.ldw];
}
__device__ __forceinline__ void tr_store(const Seg& s, int item, int lane, const float (&v)[32], LAS float* scr) {
    const int nnb = s.ncols / 32, kb = item / nnb, nb = item % nnb, k0 = 64 * kb, n0 = 32 * nb;
#pragma unroll
    for (int i = 0; i < 32; ++i) scr[(2 * i + (lane >> 5)) * 33 + (lane & 31)] = v[i];
    LDS_WAIT(); asm volatile("" ::: "memory");
    const int c = lane & 7; f32x4 g0 = (f32x4){1.f, 1.f, 1.f, 1.f}, g1 = g0;
    if (s.g) { g0 = *(const f32x4*)(s.g + k0 + 8 * c); g1 = *(const f32x4*)(s.g + k0 + 8 * c + 4); }
#pragma unroll
    for (int j = 0; j < 4; ++j) { const int n = (lane >> 3) + 8 * j; const LAS float* p = scr + (8 * c) * 33 + n;
        u32x4 o; o.x = pk2(p[0 * 33] * g0[0], p[1 * 33] * g0[1]); o.y = pk2(p[2 * 33] * g0[2], p[3 * 33] * g0[3]); o.z = pk2(p[4 * 33] * g1[0], p[5 * 33] * g1[1]); o.w = pk2(p[6 * 33] * g1[2], p[7 * 33] * g1[3]);
        *(u32x4*)(s.T + (size_t)(s.r0 + n0 + n) * s.ldt + k0 + 8 * c) = o; }
    LDS_WAIT(); asm volatile("" ::: "memory");
}
__device__ __forceinline__ void cvt_blocks(const float* src, bf16* dst, int nblk, int blk, size_t dstride, int gtid, int nthr) {
    const long total = (long)nblk * blk / 8;
    for (long v = gtid; v < total; v += nthr) { const long e = v * 8; const int b = (int)(e / blk), o = (int)(e % blk);
        const f32x4 x = *(const f32x4*)(src + e), y = *(const f32x4*)(src + e + 4);
        *(u32x4*)(dst + (size_t)b * dstride + o) = (u32x4){pk2(x[0], x[1]), pk2(x[2], x[3]), pk2(y[0], y[1]), pk2(y[2], y[3])}; }
}
__device__ __forceinline__ void p0_prologue(KAP a, LAS unsigned char* lds, int gw, int NGW, int wave, int lane, int pmask) {
    unsigned char* ws = a->ws; const int gtid = gw * 64 + lane, nthr = NGW * 64;
    LAS float* scr = (LAS float*)(lds + RING_OFF + wave * 16384);
#undef P0_PARTS
#define P0_PARTS pmask
    if (P0_PARTS & 1) {
        int total = 0;
        for (int sg = 0; sg < NSEG; ++sg) { const Seg s = get_seg(a, ws, sg); total += (s.K / 64) * (s.ncols / 32); }
        int sg = 0, base = 0; Seg sc = get_seg(a, ws, 0); int nit = (sc.K / 64) * (sc.ncols / 32);
#define P0_ADVANCE(gi) while ((gi) >= base + nit) { base += nit; ++sg; sc = get_seg(a, ws, sg); nit = (sc.K / 64) * (sc.ncols / 32); }
        float va[32], vb[32]; Seg sa = sc, sb = sc; int ia = 0, ib = 0;
        int gi = gw;
        if (gi < total) { P0_ADVANCE(gi); sa = sc; ia = gi - base; tr_load(sa, ia, lane, va); }
        while (gi < total) {
            int gn = gi + NGW;
            if (gn < total) { P0_ADVANCE(gn); sb = sc; ib = gn - base; tr_load(sb, ib, lane, vb); }
            tr_store(sa, ia, lane, va, scr);
            gi = gn; if (gi >= total) break;
            gn = gi + NGW;
            if (gn < total) { P0_ADVANCE(gn); sa = sc; ia = gn - base; tr_load(sa, ia, lane, va); }
            tr_store(sb, ib, lane, vb, scr);
            gi = gn;
        }
#undef P0_ADVANCE
    }
    if (P0_PARTS & 2) {
    cvt_blocks(a->in[I_WMKVB], (bf16*)(ws + WS_WKN), 1, 2 * 256 * 2048, 0, gtid, nthr); }
    if (P0_PARTS & 4) { const u32x4 z = (u32x4){0u, 0u, 0u, 0u};
      for (int v = gtid; v < 2 * 224 * 128; v += nthr) { const int j = v / (224 * 128), r = v % (224 * 128); *(u32x4*)((bf16*)(ws + WS_WFI) + ((size_t)j * 4352 + 4128) * 1024 + (size_t)r * 8) = z; }
      for (int v = gtid; v < 2 * 96 * 128; v += nthr) { const int j = v / (96 * 128), r = v % (96 * 128); *(u32x4*)((bf16*)(ws + WS_WMA) + ((size_t)j * 768 + 672) * 1024 + (size_t)r * 8) = z; }
    }
    if (P0_PARTS & 16) for (int v = gtid; v < 4096 * 16; v += nthr) { const int pos = v >> 4, c = v & 15; const double inv = pow(10000.0, -(double)c / 16.0), ang = (double)pos * inv;
        ((float*)(ws + WS_ROPC))[v] = (float)cos(ang); ((float*)(ws + WS_ROPS))[v] = (float)sin(ang); }
    if (P0_PARTS & 32) for (int row = gw; row < MT; row += NGW) { const float* xr = (row < MP) ? a->in[I_XP] + (size_t)row * 1024 : a->in[I_XS] + (size_t)(row - MP) * 1024;
        float sq = 0.f; bf16* o = (bf16*)(ws + WS_XB) + (size_t)row * 1024;
#pragma unroll
        for (int j = 0; j < 4; ++j) { const f32x4 v = *(const f32x4*)(xr + 256 * j + 4 * lane); sq += pg8::dot4(v); *(u32x2*)(o + 256 * j + 4 * lane) = pg8::pk4(v); }
        sq = wave_sum(sq);
        if (lane < 16) ((float*)(ws + WS_SSQ))[(size_t)row * 16 + lane] = (lane == 0) ? sq : 0.f; }
    if (P0_PARTS & 64) for (int row = gw; row < 2048; row += NGW) { const float* xr = a->in[I_MEM] + (size_t)row * 1024; f32x4 v[4]; float sq = 0.f;
#pragma unroll
        for (int j = 0; j < 4; ++j) { v[j] = *(const f32x4*)(xr + 256 * j + 4 * lane); sq += pg8::dot4(v[j]); }
        const float r = rsqrtf(wave_sum(sq) * (1.0f / 1024.0f) + EPS); bf16* o = (bf16*)(ws + WS_MB) + (size_t)row * 1024;
#pragma unroll
        for (int j = 0; j < 4; ++j) *(u32x2*)(o + 256 * j + 4 * lane) = pg8::pk4(v[j] * r); }
}

__device__ __forceinline__ float ssq_rstd16(const float* ssq, int row) {
    const f32x4 a = *(const f32x4*)(ssq + (size_t)row * 16), b = *(const f32x4*)(ssq + (size_t)row * 16 + 4), c = *(const f32x4*)(ssq + (size_t)row * 16 + 8), d = *(const f32x4*)(ssq + (size_t)row * 16 + 12);
    const float s = ((a[0] + a[1]) + (a[2] + a[3])) + ((b[0] + b[1]) + (b[2] + b[3])) + ((c[0] + c[1]) + (c[2] + c[3])) + ((d[0] + d[1]) + (d[2] + d[3]));
    return rsqrtf(s * (1.0f / 1024.0f) + EPS);
}
__device__ __forceinline__ void cum_local_prompt(KAP a, int bh, LAS float* red, int wave, int lane) {
    unsigned char* ws = a->ws; const float* lfr = (const float*)(ws + WS_LFR); const int b = bh >> 4, h = bh & 15; float* cb = (float*)(ws + WS_CB) + (size_t)bh * 4096;
    float v[8];
#pragma unroll
    for (int k = 0; k < 8; ++k) v[k] = lfr[((size_t)b * 4096 + 512 * wave + 64 * k + lane) * 16 + h];
    float carry = 0.f;
#pragma unroll
    for (int k = 0; k < 8; ++k) {
#pragma unroll
        for (int o = 1; o < 64; o <<= 1) { const float y = __shfl_up(v[k], o); if (lane >= o) v[k] += y; }
        v[k] += carry; carry = __shfl(v[k], 63); }
    if (lane == 0) red[wave] = carry;
    __syncthreads();
    float off = 0.f;
#pragma unroll
    for (int w = 0; w < 7; ++w) off += (w < wave) ? red[w] : 0.f;
#pragma unroll
    for (int k = 0; k < 8; ++k) cb[512 * wave + 64 * k + lane] = -(v[k] + off) * LOG2E;
    VM_WAIT(); __syncthreads();
}
__device__ __forceinline__ void cum_local_sample(KAP a, int L, int pair, LAS float* red, int wave, int lane) {
    unsigned char* ws = a->ws; const float* lfr = (const float*)(ws + WS_LFR); const int bs = pair >> 4, h = pair & 15;
    const float* lfc = a->in[I_CFL] + (size_t)L * 32 * 2048 * 16; float* cb = (float*)(ws + WS_CBS) + (size_t)pair * 2080;
    float x[4], v[4];
#pragma unroll
    for (int k = 0; k < 4; ++k) x[k] = lfc[((size_t)bs * 2048 + 256 * wave + 64 * k + lane) * 16 + h];
    float carry = 0.f;
#pragma unroll
    for (int k = 3; k >= 0; --k) { float t = x[k];
#pragma unroll
        for (int o = 1; o < 64; o <<= 1) { const float y = __shfl_down(t, o); if (lane + o < 64) t += y; }
        v[k] = carry + t - x[k]; carry += __shfl(t, 0); }
    if (lane == 0) red[wave] = carry;
    __syncthreads();
    float off = 0.f;
#pragma unroll
    for (int w = 1; w < 8; ++w) off += (w > wave) ? red[w] : 0.f;
#pragma unroll
    for (int k = 0; k < 4; ++k) cb[256 * wave + 64 * k + lane] = (v[k] + off) * LOG2E;
    if (wave == 0) { float t = (lane < 16) ? lfr[((size_t)MP + bs * 16 + lane) * 16 + h] : 0.f;
#pragma unroll
        for (int o = 1; o < 16; o <<= 1) { const float y = __shfl_up(t, o); if (lane >= o) t += y; }
        if (lane < 32) cb[2048 + lane] = (lane < 16) ? -t * LOG2E : 0.f; }
    VM_WAIT(); __syncthreads();
}
__device__ __forceinline__ void ckv_fixup(KAP a, int L, int gw, int NGW, int lane) {
    unsigned char* ws = a->ws; const f32x4 g = *(const f32x4*)(a->in[I_GMKV] + (size_t)L * 256 + 4 * lane);
    for (int row = gw; row < MT; row += NGW) { const f32x4 s4 = *(const f32x4*)((const float*)(ws + WS_SSQKV) + (size_t)row * 4);
        const float r = rsqrtf(((s4[0] + s4[1]) + (s4[2] + s4[3])) * (1.0f / 256.0f) + EPS);
        const f32x4 v = *(const f32x4*)((const float*)(ws + WS_CKVU) + (size_t)row * 256 + 4 * lane) * r * g;
        if (row < MP) *(f32x4*)(a->out + O_MCP + ((size_t)L * MP + row) * 256 + 4 * lane) = v;
        else { const int rs = row - MP, bs = rs >> 4, t = rs & 15; *(f32x4*)(a->out + O_MCS + ((size_t)L * MS + rs) * 256 + 4 * lane) = v;
            (void)bs; (void)t; } }
}
__device__ __forceinline__ void final_phase(KAP a, int gw, int NGW, int lane) {
    for (int row = gw; row < MT; row += NGW) { const float r = ssq_rstd16((const float*)(a->ws + WS_SSQ), row); float* y = a->out + (size_t)row * 1024; const bf16* x = (const bf16*)(a->ws + WS_XB) + (size_t)row * 1024;
#pragma unroll
        for (int j = 0; j < 4; ++j) { const f32x4 g = *(const f32x4*)(a->in[I_GFINAL] + 256 * j + 4 * lane); const u32x2 w = *(const u32x2*)(x + 256 * j + 4 * lane);
            const f32x4 xv = (f32x4){__builtin_bit_cast(float, w.x << 16), __builtin_bit_cast(float, w.x & 0xffff0000u), __builtin_bit_cast(float, w.y << 16), __builtin_bit_cast(float, w.y & 0xffff0000u)};
            *(f32x4*)(y + 256 * j + 4 * lane) = xv * r * g; } }
}

__device__ __forceinline__ void foxs_item(KAP a, int L, int it, LAS unsigned char* lds, int wid, int lane) {
    unsigned char* ws = a->ws; const int pair = it * 2 + (wid >> 2), b = pair >> 4, h = pair & 15, sp = wid & 3, g = lane >> 4, li = lane & 15;
    const float* ck = a->in[I_CFK] + (size_t)L * 32 * 2048 * 1024 + ((size_t)b * 2048 * 16 + h) * 64;
    const float* cv = a->in[I_CFV] + (size_t)L * 32 * 2048 * 1024 + ((size_t)b * 2048 * 16 + h) * 64;
    const float* cbs = (const float*)(ws + WS_CBS) + (size_t)pair * 2080;
    const bf16* QF = (const bf16*)(ws + WS_QF); const bf16* KF = (const bf16*)(ws + WS_KF); const bf16* VF = (const bf16*)(ws + WS_VF);
    const size_t srow = (size_t)MP + b * 16;
    bf16x8 qf[2];
#pragma unroll
    for (int d0 = 0; d0 < 2; ++d0) qf[d0] = *(const bf16x8*)(QF + (srow + li) * 1024 + h * 64 + 32 * d0 + 8 * g);
    float m = -1e30f, l = 0.f; f32x4 o[4];
#pragma unroll
    for (int db = 0; db < 4; ++db) o[db] = (f32x4){0.f, 0.f, 0.f, 0.f};
    const int kv0 = 512 * sp;
    auto kl = [&](int s, int blk, int d0) -> bf16x8 { const float* p = ck + (size_t)(kv0 + 32 * s + 16 * blk + li) * 1024 + 32 * d0 + 8 * g; return a16::cvt8(*(const f32x4*)p, *(const f32x4*)(p + 4)); };
    auto vl = [&](int s, int db) -> bf16x8 { const float* p = cv + (size_t)(kv0 + 32 * s + 4 * g) * 1024 + 16 * db + li;
        const f32x4 x = (f32x4){p[0], p[1024], p[2048], p[3072]}, y = (f32x4){p[16 * 1024], p[17 * 1024], p[18 * 1024], p[19 * 1024]}; return a16::cvt8(x, y); };
    auto sf = [&](int s, f32x4& sA, f32x4& sB) { const float* p = cbs + kv0 + 32 * s + 4 * g; sA += *(const f32x4*)p; sB += *(const f32x4*)(p + 16); };
    {
        auto kraw = [&](int s, f32x4 (&kr)[8]) {
#pragma unroll
            for (int blk = 0; blk < 2; ++blk)
#pragma unroll
                for (int d0 = 0; d0 < 2; ++d0) { const float* p = ck + (size_t)(kv0 + 32 * s + 16 * blk + li) * 1024 + 32 * d0 + 8 * g; kr[(blk * 2 + d0) * 2] = *(const f32x4*)p; kr[(blk * 2 + d0) * 2 + 1] = *(const f32x4*)(p + 4); } };
        auto vraw = [&](int s, f32x4 (&vr)[8]) {
#pragma unroll
            for (int db = 0; db < 4; ++db) { const float* p = cv + (size_t)(kv0 + 32 * s + 4 * g) * 1024 + 16 * db + li;
                vr[2 * db] = (f32x4){p[0], p[1024], p[2048], p[3072]}; vr[2 * db + 1] = (f32x4){p[16 * 1024], p[17 * 1024], p[18 * 1024], p[19 * 1024]}; } };
        auto step = [&](int s, const f32x4 (&kc)[8], const f32x4 (&vc)[8]) {
            f32x4 sA = {0.f, 0.f, 0.f, 0.f}, sB = {0.f, 0.f, 0.f, 0.f};
#pragma unroll
            for (int d0 = 0; d0 < 2; ++d0) { sA = a16::mfma16(a16::cvt8(kc[d0 * 2], kc[d0 * 2 + 1]), qf[d0], sA); sB = a16::mfma16(a16::cvt8(kc[(2 + d0) * 2], kc[(2 + d0) * 2 + 1]), qf[d0], sB); }
            sf(s, sA, sB);
            float mx = __builtin_fmaxf(__builtin_fmaxf(__builtin_fmaxf(sA[0], sA[1]), __builtin_fmaxf(sA[2], sA[3])), __builtin_fmaxf(__builtin_fmaxf(sB[0], sB[1]), __builtin_fmaxf(sB[2], sB[3])));
            mx = __builtin_fmaxf(mx, __shfl_xor(mx, 16)); mx = __builtin_fmaxf(mx, __shfl_xor(mx, 32));
            const float mn = __builtin_fmaxf(m, mx), alpha = ex2(m - mn); m = mn;
            f32x4 pA, pB;
#pragma unroll
            for (int r = 0; r < 4; ++r) { pA[r] = ex2(sA[r] - mn); pB[r] = ex2(sB[r] - mn); }
            float ps = ((pA[0] + pA[1]) + (pA[2] + pA[3])) + ((pB[0] + pB[1]) + (pB[2] + pB[3]));
            ps += __shfl_xor(ps, 16); ps += __shfl_xor(ps, 32);
            l = l * alpha + ps;
            const float a0 = __shfl(alpha, 4 * g), a1 = __shfl(alpha, 4 * g + 1), a2 = __shfl(alpha, 4 * g + 2), a3 = __shfl(alpha, 4 * g + 3);
#pragma unroll
            for (int db = 0; db < 4; ++db) { o[db][0] *= a0; o[db][1] *= a1; o[db][2] *= a2; o[db][3] *= a3; }
            const u32x4 pw = (u32x4){pk2(pA[0], pA[1]), pk2(pA[2], pA[3]), pk2(pB[0], pB[1]), pk2(pB[2], pB[3])};
            const bf16x8 pf = __builtin_bit_cast(bf16x8, pw);
#pragma unroll
            for (int db = 0; db < 4; ++db) o[db] = a16::mfma16(pf, a16::cvt8(vc[2 * db], vc[2 * db + 1]), o[db]); };
        f32x4 ka[8], va[8], kb[8], vb[8]; kraw(0, ka); vraw(0, va);
#pragma unroll 1
        for (int s = 0; s < 16; s += 2) {
            kraw(s + 1, kb); vraw(s + 1, vb);
            step(s, ka, va);
            const int sn = (s < 14) ? s + 2 : 15; kraw(sn, ka); vraw(sn, va);
            step(s + 1, kb, vb);
        }
    }
    if (sp == 3) {
        auto kl2 = [&](int, int blk, int d0) -> bf16x8 { bf16x8 z = {0, 0, 0, 0, 0, 0, 0, 0}; if (blk == 0) z = *(const bf16x8*)(KF + (srow + li) * 1024 + h * 64 + 32 * d0 + 8 * g); return z; };
        auto vl2 = [&](int, int db) -> bf16x8 { const bf16* p = VF + (srow + 4 * g) * 1024 + h * 64 + 16 * db + li;
            const u32x4 w = (u32x4){(unsigned)p[0] | ((unsigned)p[1024] << 16), (unsigned)p[2048] | ((unsigned)p[3072] << 16), 0u, 0u}; return __builtin_bit_cast(bf16x8, w); };
        auto sf2 = [&](int, f32x4& sA, f32x4& sB) { const f32x4 bb = *(const f32x4*)(cbs + 2048 + 4 * g);
#pragma unroll
            for (int r = 0; r < 4; ++r) { sA[r] = (4 * g + r > li) ? -INFINITY : sA[r] + bb[r]; sB[r] = -INFINITY; } };
        a16::steps<2, 4>(0, 1, qf, kl2, vl2, sf2, m, l, o, lane);
    }
    LAS float* PO = (LAS float*)(lds + RING_OFF) + wid * 1024; LAS float* PM = (LAS float*)(lds + RING_OFF + 32768) + wid * 32;
#pragma unroll
    for (int db = 0; db < 4; ++db)
#pragma unroll
        for (int r = 0; r < 4; ++r) PO[(4 * g + r) * 64 + 16 * db + li] = o[db][r];
    if (g == 0) { PM[li] = m; PM[16 + li] = l; }
    __syncthreads();
    {
        const int w0 = (wid >> 2) * 4, db = wid & 3; const bf16* GF = (const bf16*)(ws + WS_GF); bf16* OF = (bf16*)(ws + WS_OM);
#pragma unroll
        for (int r = 0; r < 4; ++r) { const int q = 4 * g + r; float mm = -1e30f;
#pragma unroll
            for (int s2 = 0; s2 < 4; ++s2) mm = __builtin_fmaxf(mm, ((LAS float*)(lds + RING_OFF + 32768) + (w0 + s2) * 32)[q]);
            float num = 0.f, den = 0.f;
#pragma unroll
            for (int s2 = 0; s2 < 4; ++s2) { LAS float* pm = (LAS float*)(lds + RING_OFF + 32768) + (w0 + s2) * 32; const float wgt = ex2(pm[q] - mm);
                num += wgt * ((LAS float*)(lds + RING_OFF) + (w0 + s2) * 1024)[q * 64 + 16 * db + li]; den += wgt * pm[16 + q]; }
            const size_t idx = (srow + q) * 1024 + h * 64 + 16 * db + li;
            OF[idx] = (bf16)(pk2(num / den * bf2f(GF[idx]), 0.f) & 0xffffu); }
    }
    __syncthreads();
}
__device__ __forceinline__ void mlas_qprime(KAP a, int L, int it, LAS unsigned char* lds, int wid, int lane) {
    unsigned char* ws = a->ws; const int b = (it < 256) ? (it >> 3) : (it - 256), c = (it < 256) ? (it & 7) : 8, g = lane >> 4, li = lane & 15;
    const bf16* QM = (const bf16*)(ws + WS_QM); const bf16* WKN = (const bf16*)(ws + WS_WKN) + (size_t)L * 256 * 2048;
    bf16* QA = (bf16*)(ws + WS_QA) + (size_t)it * 256 * 288;
    LAS bf16* scr = (LAS bf16*)(lds + RING_OFF + wid * 9216);
    for (int hh = 0; hh < 2; ++hh) { const int h = 2 * wid + hh; const bf16* qrow = QM + ((size_t)MP + b * 16 + li) * 1536 + h * 96; bf16* qa = QA + (size_t)(wid * 32 + hh * 16) * 288;
        const bf16x8 qn0 = *(const bf16x8*)(qrow + 8 * g), qn1 = *(const bf16x8*)(qrow + 32 + 8 * g);
#pragma unroll
        for (int cb = 0; cb < 16; ++cb) { const bf16* wp = WKN + (size_t)(16 * cb + li) * 2048 + h * 128 + 8 * g;
            f32x4 acc = a16::mfma16(qn0, *(const bf16x8*)wp, (f32x4){0.f, 0.f, 0.f, 0.f}); acc = a16::mfma16(qn1, *(const bf16x8*)(wp + 32), acc);
#pragma unroll
            for (int r = 0; r < 4; ++r) scr[(4 * g + r) * 288 + 16 * cb + li] = (bf16)(pk2(acc[r], 0.f) & 0xffffu); }
        *(LAS bf16x8*)(scr + li * 288 + 256 + 8 * g) = *(const bf16x8*)(qrow + 64 + 8 * g);
        LDS_WAIT();
#pragma unroll
        for (int j = 0; j < 9; ++j) *(u32x4*)(qa + (size_t)(lane + 64 * j) * 8) = *(const LAS u32x4*)(scr + (lane + 64 * j) * 8);
        LDS_WAIT(); }
    VM_WAIT(); __syncthreads();
}
__device__ __forceinline__ void mlas_attn(KAP a, int L, int it, LAS unsigned char* lds, unsigned lds0) {
    unsigned char* ws = a->ws; const int b = (it < 256) ? (it >> 3) : (it - 256), c = (it < 256) ? (it & 7) : 8; const bf16* QA = (const bf16*)(ws + WS_QA) + (size_t)it * 256 * 288;
    float* P = (float*)(ws + WS_PART) + ((size_t)(b * 9 + c) * 256) * ms::PROW;
    if (c < 8) { const size_t jb = (size_t)L * 32 + b;
        ms::unit<8>(a->in[I_CCKV] + (jb * 2048 + 256 * c) * 256, a->in[I_CKR] + (jb * 2048 + 256 * c) * 32, 255, QA, P, (LAS char*)(lds + RING_OFF), lds0 + RING_OFF);
    } else { const size_t ro = (size_t)L * MS + b * 16;
        ms::unit<1>(a->out + O_MCS + ro * 256, a->out + O_MRS + ro * 32, 15, QA, P, (LAS char*)(lds + RING_OFF), lds0 + RING_OFF); }
}
__device__ __forceinline__ void mlas_combine(KAP a, int L, LAS unsigned char* lds, int gw, int NGW, int wid, int lane) {
    unsigned char* ws = a->ws; LAS bf16* scr = (LAS bf16*)(lds + RING_OFF + wid * 8192);
    const bf16* WV = (const bf16*)(ws + WS_WMKVR) + (size_t)L * 2048 * 256; bf16* OM = (bf16*)(ws + WS_OM); const int g = lane >> 4, li = lane & 15;
    for (int e = gw; e < 512; e += NGW) { const int b = e >> 4, h = e & 15; const int q = lane >> 2, cg = (lane & 3) * 64;
        const float* P0 = (const float*)(ws + WS_PART) + ((size_t)(b * 9) * 256 + (h >> 1) * 32 + (h & 1) * 16 + q) * ms::PROW; constexpr size_t CS = (size_t)256 * ms::PROW;
        float mm = -1e30f;
#pragma unroll
        for (int c = 0; c < 9; ++c) mm = __builtin_fmaxf(mm, P0[c * CS + 256]);
        float wgt[9], den = 0.f;
#pragma unroll
        for (int c = 0; c < 9; ++c) { wgt[c] = ex2(P0[c * CS + 256] - mm); den += wgt[c] * P0[c * CS + 257]; }
        const float id = 1.0f / den;
        for (int j = 0; j < 64; j += 4) { f32x4 acc = (f32x4){0.f, 0.f, 0.f, 0.f};
#pragma unroll
            for (int c = 0; c < 9; ++c) acc += *(const f32x4*)(P0 + c * CS + cg + j) * wgt[c];
            *(LAS u32x2*)(scr + q * 256 + cg + j) = pg8::pk4(acc * id); }
        LDS_WAIT();
        bf16x8 af[8];
#pragma unroll
        for (int d0 = 0; d0 < 8; ++d0) af[d0] = *(const LAS bf16x8*)(scr + li * 256 + 32 * d0 + 8 * g);
#pragma unroll
        for (int db = 0; db < 4; ++db) { f32x4 acc = (f32x4){0.f, 0.f, 0.f, 0.f}; const bf16* wp = WV + (size_t)(h * 128 + 64 + 16 * db + li) * 256 + 8 * g;
#pragma unroll
            for (int d0 = 0; d0 < 8; ++d0) acc = a16::mfma16(af[d0], *(const bf16x8*)(wp + 32 * d0), acc);
            bf16* O = OM + ((size_t)MP + b * 16 + 4 * g) * 1024 + h * 64 + 16 * db + li; const unsigned w0 = pk2(acc[0], acc[1]), w1 = pk2(acc[2], acc[3]);
            O[0] = (bf16)(w0 & 0xffffu); O[1024] = (bf16)(w0 >> 16); O[2048] = (bf16)(w1 & 0xffffu); O[3072] = (bf16)(w1 >> 16); }
        LDS_WAIT();
    }
}
typedef float f32x2v_t __attribute__((ext_vector_type(2)));
template <int K, class F> __device__ __forceinline__ void thin_tiles(const bf16* A, const bf16* Bt, LAS unsigned char* lds, int vcu, int G, int wave, int lane, F epi) {
    const int g = lane >> 4, li = lane & 15; constexpr int nks = K / 256;
    LAS float* part = (LAS float*)(lds + RING_OFF);
#pragma unroll 1
    for (int tt = vcu; tt < 256; tt += G) { const int rb = tt & 31, cgp = tt >> 5;
        const bf16* ap = A + (size_t)(MP + 16 * rb + li) * K + wave * (K / 8) + 8 * g; const bf16* bp = Bt + (size_t)(128 * cgp + li) * K + wave * (K / 8) + 8 * g;
        f32x4 acc[8];
#pragma unroll
        for (int nb = 0; nb < 8; ++nb) acc[nb] = (f32x4){0.f, 0.f, 0.f, 0.f};
#pragma unroll
        for (int s0 = 0; s0 < nks; s0 += 4) { bf16x8 a[4], b[4][8]; const bf16x8 z = {0, 0, 0, 0, 0, 0, 0, 0};
#pragma unroll
            for (int u = 0; u < 4; ++u) { const bool on = s0 + u < nks; a[u] = on ? *(const bf16x8*)(ap + 32 * (s0 + u)) : z;
#pragma unroll
                for (int nb = 0; nb < 8; ++nb) b[u][nb] = on ? *(const bf16x8*)(bp + (size_t)nb * 16 * K + 32 * (s0 + u)) : z; }
#pragma unroll
            for (int u = 0; u < 4; ++u) if (s0 + u < nks)
#pragma unroll
                for (int nb = 0; nb < 8; ++nb) acc[nb] = a16::mfma16(a[u], b[u][nb], acc[nb]); }
#pragma unroll
        for (int nb = 0; nb < 8; ++nb)
#pragma unroll
            for (int r = 0; r < 4; ++r) part[wave * 2048 + (4 * g + r) * 128 + 16 * nb + li] = acc[nb][r];
        __syncthreads();
        const int e = (2 * wave + (lane >> 5)) * 128 + 4 * (lane & 31); f32x4 sv = (f32x4){0.f, 0.f, 0.f, 0.f};
#pragma unroll
        for (int w = 0; w < 8; ++w) sv += *(const LAS f32x4*)(part + w * 2048 + e);
        epi(MP + 16 * rb + 2 * wave + (lane >> 5), 128 * cgp + 4 * (lane & 31), sv);
        __syncthreads(); }
}
template <int K> __device__ __forceinline__ void thin_resid(KAP a, const bf16* A, const bf16* Bt, int first, LAS unsigned char* lds, int vcu, int G, int wave, int lane) {
    unsigned char* ws = a->ws; const float* xs = a->in[I_XS] - (size_t)MP * 1024; bf16* XB = (bf16*)(ws + WS_XB); float* SSQ = (float*)(ws + WS_SSQ);
    thin_tiles<K>(A, Bt, lds, vcu, G, wave, lane, [&](int row, int col, f32x4 v) {
        const size_t o = (size_t)row * 1024 + col; f32x4 x;
        if (first) x = *(const f32x4*)(xs + o);
        else { const u32x2 w = *(const u32x2*)(XB + o); x = (f32x4){__builtin_bit_cast(float, w.x << 16), __builtin_bit_cast(float, w.x & 0xffff0000u), __builtin_bit_cast(float, w.y << 16), __builtin_bit_cast(float, w.y & 0xffff0000u)}; }
        x += v; *(u32x2*)(XB + o) = (u32x2){pk2(x[0], x[1]), pk2(x[2], x[3])};
        float sq = (x[0] * x[0] + x[1] * x[1]) + (x[2] * x[2] + x[3] * x[3]); sq += __shfl_xor(sq, 1); sq += __shfl_xor(sq, 2); sq += __shfl_xor(sq, 4); sq += __shfl_xor(sq, 8);
        if ((lane & 15) == 0) SSQ[(size_t)row * 16 + (col >> 6)] = sq; });
}
__device__ __forceinline__ void thin_xq(KAP a, const bf16* Bt, LAS unsigned char* lds, int vcu, int G, int wave, int lane) {
    unsigned char* ws = a->ws; const bf16* XB = (const bf16*)(ws + WS_XB); bf16* QX = (bf16*)(ws + WS_QX); const float* SSQ = (const float*)(ws + WS_SSQ);
    thin_tiles<1024>(XB, Bt, lds, vcu, G, wave, lane, [&](int row, int col, f32x4 v) {
        const float rs = ssq_rstd16(SSQ, row) * C2_X; *(u32x2*)(QX + (size_t)row * 1024 + col) = (u32x2){pk2(v[0] * rs, v[1] * rs), pk2(v[2] * rs, v[3] * rs)}; });
}
#ifndef DBG_DOUBLE
#define DBG_DOUBLE 0
#endif

constexpr int NPH = 41;
struct Ctx { int lane, wave, G, bx, vcu, gw, NGW; };
__device__ __forceinline__ Ctx mk_ctx() { Ctx c; const int tid = pg8::pg8_tid(); c.lane = tid & 63; c.wave = __builtin_amdgcn_readfirstlane(tid >> 6); int G_ = gridDim.x, bx_ = blockIdx.x; asm volatile("" : "+s"(G_), "+s"(bx_)); c.G = G_; c.bx = bx_;
    c.vcu = (c.G % 8 == 0) ? (c.bx % 8) * (c.G / 8) + c.bx / 8 : c.bx; c.gw = c.vcu * NWAVES + c.wave; c.NGW = c.G * NWAVES; return c; }
#define RSX(ws) pg8::RowScale{(const float*)((ws) + WS_SSQ), 16, 4, 1.0f / 1024.0f}
#define PHASE __device__ __noinline__ void
#define FATPH __device__ __forceinline__ void
__device__ __forceinline__ unsigned char* ws_ptr() { GAS unsigned char* w = (GAS unsigned char*)KA->ws; asm volatile("" : "+s"(w)); return (unsigned char*)w; }
#define WSB(off) ((const bf16*)(ws_ptr() + (off)))
__device__ __forceinline__ const float* in_ptr(int i) { GAS const float* w = (GAS const float*)KA->in[i]; asm volatile("" : "+s"(w)); return (const float*)w; }
__device__ __forceinline__ float* out_ptr() { GAS float* w = (GAS float*)KA->out; asm volatile("" : "+s"(w)); return (float*)w; }

FATPH ph_prologue(KAP a, LAS unsigned char* lds, int pmask) { const Ctx c = mk_ctx(); p0_prologue(a, lds, c.gw, c.NGW, c.wave, c.lane, pmask); __syncthreads(); }
FATPH ph_memkv(LAS unsigned char* lds) { const Ctx c = mk_ctx(); unsigned char* ws = ws_ptr(); float* out = out_ptr();
    pg8::Gemm g{WSB(WS_MB), WSB(WS_WXKV), 2048, 8192, 1024}; pg8::StaticOrder S; S.init(2048, 8192, c.G, c.bx);
    pg8::EpiMemKV E{out + O_MKP, out + O_MVP, (bf16*)(ws + WS_MKB), (bf16*)(ws + WS_MVB)};
    pg8::gemm_phase<pg8::EpiMemKV, pg8::StaticOrder, true, true>(lds + RING_OFF, g, S, E); }
FATPH ph_fox_in(LAS unsigned char* lds, int L) { const Ctx c = mk_ctx(); unsigned char* ws = ws_ptr(); float* out = out_ptr();
    pg8::Gemm g{WSB(WS_XB), WSB(WS_WFI) + (size_t)L * 4352 * 1024, MT, 4352, 1024}; pg8::StaticOrder S; S.init(MT, 4352, c.G, c.bx);
    pg8::EpiFoxIn E{RSX(ws), ws, out, in_ptr(I_BFF) + L * 16, L};
    pg8::gemm_phase<pg8::EpiFoxIn, pg8::StaticOrder, true, true>(lds + RING_OFF, g, S, E); }
FATPH ph_fox_sample(KAP a, LAS unsigned char* lds, int L) { const Ctx c = mk_ctx(); LAS float* red = (LAS float*)(lds + RING_OFF + 65536);
    for (int it = c.vcu; it < 256; it += c.G) { cum_local_sample(a, L, 2 * it, red, c.wave, c.lane); cum_local_sample(a, L, 2 * it + 1, red, c.wave, c.lane); foxs_item(a, L, it, lds, c.wave, c.lane); } }
__device__ __forceinline__ void unit2_of(int e, int& bh, int& qb) { bh = e >> 3; const int k = e & 7, s = (k >> 2) & 1, ii = k & 3, j = 2 * s + (ii >> 1); qb = (ii & 1) ? 7 - j : j; }
__device__ __forceinline__ void unit_of(int e, int& bh, int& qb) { bh = e >> 4; const int k = e & 15, s = (k >> 3) & 1, ii = k & 7, j = 2 * (ii >> 1) + s; qb = (ii & 1) ? 15 - j : j; }
FATPH ph_fox_attn(LAS unsigned char* lds, unsigned lds0) { const Ctx c = mk_ctx(); unsigned char* ws = ws_ptr();
    for (int e0 = c.vcu * 4; e0 < 1024; e0 += c.G * 4) {
        __syncthreads(); cum_local_prompt(KA, e0 >> 3, (LAS float*)(lds + RING_OFF + 65536), c.wave, c.lane);
        for (int i = 0; i < 4; ++i) { int bh, qb; unit2_of(e0 + i, bh, qb); const int b = bh >> 4, h = bh & 15;
            fa::Args A{WSB(WS_QF), 1024, h * 64, WSB(WS_KF), 1024, h * 64, nullptr, WSB(WS_VF), 1024, h * 64, (bf16*)(ws + WS_OM), h * 64,
                       WSB(WS_GF), (const float*)(ws + WS_CB) + (size_t)bh * 4096};
            fa::unit2<0>(A, (long)b * 4096, qb, (LAS char*)(lds + RING_OFF), lds0 + RING_OFF); } } }
FATPH ph_fox_mix(KAP a, LAS unsigned char* lds, unsigned lds0, int L) { const Ctx c = mk_ctx(); unsigned char* ws = ws_ptr(); LAS float* red = (LAS float*)(lds + RING_OFF + 65536);
    const int pos = (c.vcu >> 1) % 5;
    for (int e0 = c.vcu * 4, it = c.vcu; e0 < 1024 || it < 256; e0 += c.G * 4, it += c.G) {
        if (e0 < 1024) { __syncthreads(); cum_local_prompt(a, e0 >> 3, red, c.wave, c.lane); }
#pragma unroll 1
        for (int i = 0; i < 5; ++i) {
            if (i == pos && it < 256) { const Ctx c2 = mk_ctx(); int itv = it; asm volatile("" : "+s"(itv));
                __syncthreads(); cum_local_sample(a, L, 2 * itv, red, c2.wave, c2.lane); cum_local_sample(a, L, 2 * itv + 1, red, c2.wave, c2.lane); foxs_item(a, L, itv, lds, c2.wave, c2.lane); __syncthreads(); }
            if (i < 4 && e0 < 1024) { int ev = e0 + i; asm volatile("" : "+s"(ev)); int bh, qb; unit2_of(ev, bh, qb); const int b = bh >> 4, h = bh & 15;
                fa::Args A{WSB(WS_QF), 1024, h * 64, WSB(WS_KF), 1024, h * 64, nullptr, WSB(WS_VF), 1024, h * 64, (bf16*)(ws + WS_OM), h * 64,
                           WSB(WS_GF), (const float*)(ws + WS_CB) + (size_t)bh * 4096};
                fa::unit2<0>(A, (long)b * 4096, qb, (LAS char*)(lds + RING_OFF), lds0 + RING_OFF); } } } }
template <bool ABLK = false>
FATPH ph_resid(LAS unsigned char* lds, const bf16* A, const bf16* Bt, int K, int first, int dummy = 0) { const Ctx c = mk_ctx(); unsigned char* ws = ws_ptr();
    pg8::Gemm g{A, Bt, MP, 1024, K}; pg8::StaticOrder S; S.init(MP, 1024, c.G, c.bx);
    pg8::EpiResid E{KA->in[I_XP], KA->in[I_XS], first, dummy ? (bf16*)(ws + WS_R1 + (size_t)MT * 4096) : (bf16*)(ws + WS_XB), dummy ? (float*)(ws + WS_R1 + (size_t)MT * 6144) : (float*)(ws + WS_SSQ)};
    pg8::gemm_phase<pg8::EpiResid, pg8::StaticOrder, true, true, ABLK>(lds + RING_OFF, g, S, E); }
FATPH ph_scale_gemm(LAS unsigned char* lds, const bf16* A, const bf16* Bt, int M, int N, int K, const float* ssq, int stride, int ngrp, float inv_n, bf16* O, float scale) { const Ctx c = mk_ctx();
    pg8::Gemm g{A, Bt, M, N, K}; pg8::StaticOrder S; S.init(M, N, c.G, c.bx);
    pg8::EpiScaleBf16 E{pg8::RowScale{ssq, stride, ngrp, inv_n}, O, N, scale};
    pg8::gemm_phase<pg8::EpiScaleBf16, pg8::StaticOrder, true, true>(lds + RING_OFF, g, S, E); }
FATPH ph_cross(LAS unsigned char* lds, unsigned lds0, int layer) { const Ctx c = mk_ctx(); unsigned char* ws = ws_ptr();
    const bf16* QX = WSB(WS_QX); bf16* OX = (bf16*)(ws + WS_OM);
    const bool bal = (c.G == 256); const int nu = bal ? (c.vcu < 128 ? 1 : 3) : 2, ub = bal ? (c.vcu < 128 ? c.vcu : 128 + 3 * (c.vcu - 128)) : c.vcu * 2;
    for (int u0 = ub; u0 < 512; u0 += (bal ? 512 : c.G * 2))
        for (int i = 0; i < nu; ++i) { const int u = u0 + i, bh = u >> 4, qb = u & 15, b = bh >> 2, h = bh & 3; const size_t ko = ((size_t)layer * 2048 + b * 256) * 1024 + h * 256;
            xa::unit<false>(WSB(WS_MKB) + ko, WSB(WS_MVB) + ko, 1024, QX, OX, (size_t)b * 4096 + qb * 256, h * 256, 32, false, (LAS char*)(lds + RING_OFF), lds0 + RING_OFF); }
    for (int e = c.vcu; e < 128; e += c.G) { const int bs = e >> 2, h = e & 3; const size_t ko = ((size_t)(layer * 32 + bs) * 256) * 1024 + h * 256;
        xa::unit<true>(in_ptr(I_CMK) + ko, in_ptr(I_CMV) + ko, 1024, QX, OX, (size_t)MP + bs * 16, h * 256, 16, true, (LAS char*)(lds + RING_OFF), lds0 + RING_OFF); } }
FATPH ph_gu(LAS unsigned char* lds, int layer) { const Ctx c = mk_ctx(); unsigned char* ws = ws_ptr();
    pg8::Gemm g{WSB(WS_XB), WSB(WS_WGU) + (size_t)layer * 5632 * 1024, MT, 5632, 1024}; pg8::StaticOrder S; S.init(MT, 5632, c.G, c.bx);
    pg8::EpiSwiglu E{RSX(ws), (bf16*)(ws + WS_HB)}; pg8::gemm_phase<pg8::EpiSwiglu, pg8::StaticOrder, true, true>(lds + RING_OFF, g, S, E); }
FATPH ph_gu_null(LAS unsigned char* lds, int layer) { const Ctx c = mk_ctx();
    pg8::Gemm g{WSB(WS_XB), WSB(WS_WGU) + (size_t)layer * 5632 * 1024, MT, 5632, 1024}; pg8::StaticOrder S; S.init(MT, 5632, c.G, c.bx);
    pg8::EpiNull E{}; pg8::gemm_phase<pg8::EpiNull, pg8::StaticOrder, true, true>(lds + RING_OFF, g, S, E); }
FATPH ph_mla_a(LAS unsigned char* lds, int L) { const Ctx c = mk_ctx(); unsigned char* ws = ws_ptr(); float* out = out_ptr();
    pg8::Gemm g{WSB(WS_XB), WSB(WS_WMA) + (size_t)L * 768 * 1024, MT, 768, 1024}; pg8::StaticOrder S; S.init(MT, 768, c.G, c.bx);
    pg8::EpiMlaA E{RSX(ws), (float*)(ws + WS_CKVU), (bf16*)(ws + WS_CKVUB), (float*)(ws + WS_SSQKV), (bf16*)(ws + WS_CQ), (float*)(ws + WS_SSQQ), (bf16*)(ws + WS_KRB),
                   out + O_MRP + (size_t)L * MP * 32, out + O_MRS + (size_t)L * MS * 32, (const float*)(ws + WS_ROPC), (const float*)(ws + WS_ROPS)};
    pg8::gemm_phase<pg8::EpiMlaA, pg8::StaticOrder, true, true>(lds + RING_OFF, g, S, E); }
PHASE ph_fixup(KAP a, int L) { const Ctx c = mk_ctx(); ckv_fixup(a, L, c.gw, c.NGW, c.lane); }
FATPH ph_mla_q(LAS unsigned char* lds, int L, int kq) { const Ctx c = mk_ctx(); unsigned char* ws = ws_ptr();
    pg8::Gemm g{WSB(WS_CQ), WSB(WS_WMQ) + (size_t)L * 1536 * 384, MT, 1536, kq}; pg8::StaticOrder S; S.init(MT, 1536, c.G, c.bx);
    pg8::EpiMlaQ E{pg8::RowScale{(const float*)(ws + WS_SSQQ), 8, 2, 1.0f / 384.0f}, (bf16*)(ws + WS_QM), (const float*)(ws + WS_ROPC), (const float*)(ws + WS_ROPS)};
    pg8::gemm_phase<pg8::EpiMlaQ, pg8::StaticOrder, true, false>(lds + RING_OFF, g, S, E); }
PHASE ph_mla_qprime(KAP a, LAS unsigned char* lds, int L, int it) { const Ctx c = mk_ctx(); mlas_qprime(a, L, it, lds, c.wave, c.lane); }
FATPH ph_mla_sample(LAS unsigned char* lds, unsigned lds0, int L) { const Ctx c = mk_ctx(); for (int it = c.vcu; it < 288; it += c.G) { ph_mla_qprime(KA, lds, L, it); mlas_attn(KA, L, it, lds, lds0); } __syncthreads(); }
FATPH ph_mla_attn(LAS unsigned char* lds, unsigned lds0) { const Ctx c = mk_ctx(); unsigned char* ws = ws_ptr();
    for (int e0 = c.vcu * 4; e0 < 1024; e0 += c.G * 4)
        for (int i = 0; i < 4; ++i) { int bh, qb; unit2_of(e0 + i, bh, qb); const int b = bh >> 4, h = bh & 15;
            fa::Args A{WSB(WS_QM), 1536, h * 96, WSB(WS_KVM), 2048, h * 128, WSB(WS_KRB), WSB(WS_KVM), 2048, h * 128 + 64, (bf16*)(ws + WS_OM), h * 64,
                       nullptr, nullptr};
            fa::unit2<1>(A, (long)b * 4096, qb, (LAS char*)(lds + RING_OFF), lds0 + RING_OFF); } }
FATPH ph_mla_comb(LAS unsigned char* lds, int L) { const Ctx c = mk_ctx(); mlas_combine(KA, L, lds, c.gw, c.NGW, c.wave, c.lane); }
template <int K> FATPH ph_thin_resid(KAP a, LAS unsigned char* lds, const bf16* A, const bf16* Bt, int first) { const Ctx c = mk_ctx(); thin_resid<K>(a, A, Bt, first, lds, c.vcu, c.G, c.wave, c.lane); }
FATPH ph_thin_xq(KAP a, LAS unsigned char* lds, const bf16* Bt) { const Ctx c = mk_ctx(); thin_xq(a, Bt, lds, c.vcu, c.G, c.wave, c.lane); }
PHASE ph_final(KAP a) { const Ctx c = mk_ctx(); final_phase(a, c.gw, c.NGW, c.lane); }
PHASE ph_grid_bar(GAS unsigned* barw, unsigned x, volatile LAS unsigned* st) { XcdBarrier b; b.bar = (unsigned*)barw; b.x = x; b.st = st; xcd_barrier(b); }

__global__ void __launch_bounds__(NWAVES * 64, 2) fwd_kernel(KArgs args) {
    extern __shared__ __attribute__((aligned(16))) unsigned char lds_raw[];
    LAS unsigned char* lds = (LAS unsigned char*)lds_raw;
    volatile LAS unsigned* MISC = (volatile LAS unsigned*)(lds + MISC_OFF);
    const int tid = threadIdx.x;
    const unsigned lds0 = (unsigned)(uintptr_t)lds_raw;
    for (int u = tid; u < (LDS_BYTES - LDSCTL_OFF) / 4; u += NWAVES * 64) ((LAS unsigned*)(lds + LDSCTL_OFF))[u] = 0u;
    __syncthreads();
    const XcdBarrier bar = xcd_barrier_post((unsigned*)(args.ws + WS_CTL) + CW_BAR, MISC + 8);
    const int lo = args.ph_lo, hi = args.ph_hi;
#ifndef DBG_DOUBLE
#define DBG_DOUBLE 0
#endif
#ifndef DBG_P0_AGAIN
#define DBG_P0_AGAIN 0
#endif
#define REP(bit) for (int rep_ = 0; rep_ < ((DBG_DOUBLE & (bit)) ? 2 : 1); ++rep_)
#define IN(k) (lo <= (k) && (k) < hi)
#define SEAM(k) do { if (IN(k) && IN((k) + 1)) { REP(256) ph_grid_bar((GAS unsigned*)bar.bar, bar.x, bar.st); } } while (0)
    if (IN(0)) { ph_prologue(KA, lds, 0x7f); if (DBG_P0_AGAIN) ph_prologue(KA, lds, DBG_P0_AGAIN); }
    SEAM(0);
    if (IN(1)) REP(65536) ph_memkv(lds);
    SEAM(1);
    for (int L = 0; L < 2; ++L) {
        const int pb = 2 + 19 * L;
        if (IN(pb)) { REP(8) ph_fox_in(lds, L); }
        SEAM(pb);
        if (IN(pb + 2)) { if (DBG_DOUBLE & 96) { REP(64) ph_fox_sample(KA, lds, L); REP(32) ph_fox_attn(lds, lds0); } else ph_fox_mix(KA, lds, lds0, L); }
        SEAM(pb + 2);
        if (IN(pb + 3)) { ph_thin_resid<1024>(KA, lds, WSB(WS_OM), WSB(WS_WFO) + (size_t)L * 1024 * 1024, L == 0); if (DBG_DOUBLE & 512) ph_resid(lds, WSB(WS_OM), WSB(WS_WFO) + (size_t)L * 1024 * 1024, 1024, L == 0, 1); ph_resid(lds, WSB(WS_OM), WSB(WS_WFO) + (size_t)L * 1024 * 1024, 1024, L == 0); }
        SEAM(pb + 3);
        for (int sub = 0; sub < 2; ++sub) {
            const int layer = 2 * L + sub, cb = pb + 4 + 10 * sub;
            if (sub == 1) {
                if (IN(pb + 9)) REP(32768) ph_mla_a(lds, L);
                SEAM(pb + 9);
                if (IN(pb + 10)) { ph_fixup(KA, L); REP(32768) ph_mla_q(lds, L, 384);
                    REP(32768)
                    ph_scale_gemm(lds, WSB(WS_CKVUB), WSB(WS_WMKV) + (size_t)L * 2048 * 256, MP, 2048, 256, (const float*)(ws_ptr() + WS_SSQKV), 4, 1, 1.0f / 256.0f, (bf16*)(ws_ptr() + WS_KVM), 1.0f); }
                SEAM(pb + 10);
                if (IN(pb + 11)) { REP(128) ph_mla_sample(lds, lds0, L); REP(32) ph_mla_attn(lds, lds0); }
                SEAM(pb + 11);
                if (IN(pb + 12)) REP(16) ph_mla_comb(lds, L);
                SEAM(pb + 12);
                if (IN(pb + 13)) { ph_thin_resid<1024>(KA, lds, WSB(WS_OM), WSB(WS_WMO) + (size_t)L * 1024 * 1024, 0); if (DBG_DOUBLE & 512) ph_resid(lds, WSB(WS_OM), WSB(WS_WMO) + (size_t)L * 1024 * 1024, 1024, 0, 1); ph_resid(lds, WSB(WS_OM), WSB(WS_WMO) + (size_t)L * 1024 * 1024, 1024, 0); }
                SEAM(pb + 13);
            }
            if (IN(cb)) { REP(131072) ph_thin_xq(KA, lds, WSB(WS_WXQ) + (size_t)layer * 1024 * 1024); REP(16384) ph_scale_gemm(lds, WSB(WS_XB), WSB(WS_WXQ) + (size_t)layer * 1024 * 1024, MP, 1024, 1024, (const float*)(ws_ptr() + WS_SSQ), 16, 4, 1.0f / 1024.0f, (bf16*)(ws_ptr() + WS_QX), C2_X); }
            SEAM(cb);
            if (IN(cb + 1)) REP(2) ph_cross(lds, lds0, layer);
            SEAM(cb + 1);
            if (IN(cb + 2)) { ph_thin_resid<1024>(KA, lds, WSB(WS_OM), WSB(WS_WXO) + (size_t)layer * 1024 * 1024, 0); if (DBG_DOUBLE & 4096) ph_resid(lds, WSB(WS_OM), WSB(WS_WXO) + (size_t)layer * 1024 * 1024, 1024, 0, 1); ph_resid(lds, WSB(WS_OM), WSB(WS_WXO) + (size_t)layer * 1024 * 1024, 1024, 0); }
            SEAM(cb + 2);
            if (IN(cb + 3)) { if (DBG_DOUBLE & 1024) ph_gu_null(lds, layer); REP(8) ph_gu(lds, layer); }
            SEAM(cb + 3);
            if (IN(cb + 4)) { ph_thin_resid<DFF>(KA, lds, WSB(WS_HB), WSB(WS_WDN) + (size_t)layer * 1024 * 2816, 0); if (DBG_DOUBLE & 2048) ph_resid<true>(lds, WSB(WS_HB), WSB(WS_WDN) + (size_t)layer * 1024 * 2816, DFF, 0, 1); ph_resid<true>(lds, WSB(WS_HB), WSB(WS_WDN) + (size_t)layer * 1024 * 2816, DFF, 0); }
            SEAM(cb + 4);
        }
    }
    if (IN(40)) REP(262144) ph_final(KA);
#undef IN
#undef SEAM
}

#ifndef DBG_PH_HI
#define DBG_PH_HI NPH
#endif
#ifndef MK_PER_PHASE
#define MK_PER_PHASE 0
#endif
extern "C" void kernel_launch(void* const* d_in, const int* in_sizes, int n_in, void* d_out, int out_size, void* d_ws, size_t ws_size, hipStream_t stream) {
    static int grid = 0;
    if (grid == 0) {
        if (n_in != N_IN || (size_t)out_size != O_END || ws_size < WS_END) { fprintf(stderr, "kernel_launch: unexpected shapes (n_in %d, out %d, ws %zu; need %d, %zu, %zu)\n", n_in, out_size, ws_size, (int)N_IN, (size_t)O_END, (size_t)WS_END); grid = -1; return; }
        int dev = 0, cus = 0, per_cu = 0;
        if (hipGetDevice(&dev) != hipSuccess || hipDeviceGetAttribute(&cus, hipDeviceAttributeMultiprocessorCount, dev) != hipSuccess) { grid = -1; return; }
        if (hipFuncSetAttribute((const void*)fwd_kernel, hipFuncAttributeMaxDynamicSharedMemorySize, LDS_BYTES) != hipSuccess) { fprintf(stderr, "kernel_launch: hipFuncSetAttribute failed\n"); grid = -1; return; }
        if (hipOccupancyMaxActiveBlocksPerMultiprocessor(&per_cu, (const void*)fwd_kernel, NWAVES * 64, LDS_BYTES) != hipSuccess || per_cu < 1) { fprintf(stderr, "kernel_launch: occupancy query reports %d\n", per_cu); }
        (void)hipGetLastError();
        grid = cus;
    }
    if (grid < 0) return;
    if (hipMemsetAsync((char*)d_ws + WS_CTL, 0, CTL_ZERO_BYTES, stream) != hipSuccess) return;
    KArgs a{};
    for (int i = 0; i < N_IN; ++i) a.in[i] = (const float*)d_in[i];
    a.out = (float*)d_out; a.ws = (unsigned char*)d_ws;
#if MK_PER_PHASE
    for (int p = 0; p < NPH; ++p) { a.ph_lo = p; a.ph_hi = p + 1; hipLaunchKernelGGL(fwd_kernel, dim3(grid), dim3(NWAVES * 64), LDS_BYTES, stream, a); }
#else
    a.ph_lo = 0; a.ph_hi = DBG_PH_HI; hipLaunchKernelGGL(fwd_kernel, dim3(grid), dim3(NWAVES * 64), LDS_BYTES, stream, a);
#endif
}
```

```cpp
#include <hip/hip_runtime.h>
#include <cstdint>
#include <cstdio>
#include <cmath>

constexpr int D = 1024, MP = 32768, MS = 512, MT = MP + MS, SEQ = 4096, NBP = 8, NBS = 32, DSEQ = 16, PAST = 2048, NMEM = 256;
constexpr int DFF = 2816, KPAD = 2112;
constexpr float EPS = 1e-6f, LOG2E = 1.4426950408889634f;
constexpr float C2_FOX = 0.125f * LOG2E, C2_MLA = 0.10206207261596575f * LOG2E, C2_X = 0.0625f * LOG2E;

constexpr size_t O_Y = 0;
constexpr size_t O_FKP = (size_t)MT * D;
constexpr size_t O_FVP = O_FKP + (size_t)2 * MP * 1024;
constexpr size_t O_FLP = O_FVP + (size_t)2 * MP * 1024;
constexpr size_t O_MCP = O_FLP + (size_t)2 * MP * 16;
constexpr size_t O_MRP = O_MCP + (size_t)2 * MP * 256;
constexpr size_t O_MKP = O_MRP + (size_t)2 * MP * 32;
constexpr size_t O_MVP = O_MKP + (size_t)4 * 2048 * 1024;
constexpr size_t O_FKS = O_MVP + (size_t)4 * 2048 * 1024;
constexpr size_t O_FVS = O_FKS + (size_t)2 * MS * 1024;
constexpr size_t O_FLS = O_FVS + (size_t)2 * MS * 1024;
constexpr size_t O_MCS = O_FLS + (size_t)2 * MS * 16;
constexpr size_t O_MRS = O_MCS + (size_t)2 * MS * 256;
constexpr size_t O_END = O_MRS + (size_t)2 * MS * 32;

enum { I_XP = 0, I_XS, I_MEM, I_CFK, I_CFV, I_CFL, I_CCKV, I_CKR, I_CMK, I_CMV, I_GMIX, I_GCROSS, I_GMEM, I_GFFN, I_GFINAL,
       I_WFI, I_BFF, I_WFO, I_WMA, I_GMQ, I_GMKV, I_WMQB, I_WMKVB, I_WMO, I_WXQ, I_WXKV, I_WXO, I_WGU, I_WDN, N_IN };


constexpr size_t al256(size_t x) { return (x + 255) & ~(size_t)255; }
constexpr size_t WS_CTL = 0, CTL_ZERO_BYTES = 1u << 20;
constexpr size_t WS_WFI = 2u << 20;
constexpr size_t WS_WFO = WS_WFI + (size_t)2 * 4352 * 1024 * 2;
constexpr size_t WS_WMA = WS_WFO + (size_t)2 * 1024 * 1024 * 2;
constexpr size_t WS_WMQ = WS_WMA + (size_t)2 * 768 * 1024 * 2;
constexpr size_t WS_WMKV = WS_WMQ + (size_t)2 * 1536 * 384 * 2;
constexpr size_t WS_WMKVR = WS_WMKV + (size_t)2 * 2048 * 256 * 2;
constexpr size_t WS_WKN = WS_WMKVR + (size_t)2 * 2048 * 256 * 2;
constexpr size_t WS_WMO = WS_WKN + (size_t)2 * 256 * 2048 * 2;
constexpr size_t WS_WXQ = WS_WMO + (size_t)2 * 1024 * 1024 * 2;
constexpr size_t WS_WXO = WS_WXQ + (size_t)4 * 1024 * 1024 * 2;
constexpr size_t WS_WXKV = WS_WXO + (size_t)4 * 1024 * 1024 * 2;
constexpr size_t WS_WGU = WS_WXKV + (size_t)4 * 2048 * 1024 * 2;
constexpr size_t WS_WDN = WS_WGU + (size_t)4 * 5632 * 1024 * 2;
constexpr size_t WS_WFF = WS_WDN + (size_t)4 * 1024 * 2816 * 2;
constexpr size_t WS_ROPC = WS_WFF + (size_t)2 * 16 * 1024 * 4;
constexpr size_t WS_ROPS = WS_ROPC + (size_t)4096 * 16 * 4;
constexpr size_t WS_XB = WS_ROPS + (size_t)4096 * 16 * 4;
constexpr size_t WS_SSQ = WS_XB + (size_t)MT * 1024 * 2;
constexpr size_t WS_R1 = al256(WS_SSQ + (size_t)MT * 16 * 4);
constexpr size_t SZ_ACT = (size_t)MT * 1024 * 2;
constexpr size_t WS_QF = WS_R1, WS_KF = WS_R1 + SZ_ACT, WS_VF = WS_R1 + 2 * SZ_ACT, WS_GF = WS_R1 + 3 * SZ_ACT;
constexpr size_t WS_QM = WS_R1, WS_KVM = al256(WS_R1 + (size_t)MT * 1536 * 2);
static_assert(WS_KVM + (size_t)MP * 2048 * 2 <= WS_R1 + 4 * SZ_ACT, "MLA overlay fits");
constexpr size_t WS_OM = WS_R1 + 4 * SZ_ACT;
constexpr size_t WS_LFR = WS_OM + SZ_ACT;
constexpr size_t WS_CB = WS_LFR + (size_t)MT * 16 * 4;
constexpr size_t WS_CBS = WS_CB + (size_t)8 * 16 * 4096 * 4;
constexpr size_t WS_CKVU = al256(WS_CBS + (size_t)32 * 16 * 2080 * 4);
constexpr size_t WS_CKVUB = WS_CKVU + (size_t)MT * 256 * 4;
constexpr size_t WS_SSQKV = WS_CKVUB + (size_t)MT * 256 * 2;
constexpr size_t WS_CQ = WS_SSQKV + (size_t)MT * 4 * 4;
constexpr size_t WS_SSQQ = WS_CQ + (size_t)MT * 384 * 2;
constexpr size_t WS_KRB = WS_SSQQ + (size_t)MT * 8 * 4;
constexpr size_t WS_QA = al256(WS_KRB + (size_t)MT * 32 * 2);
constexpr size_t WS_PART = al256(WS_QA + (size_t)288 * 256 * 288 * 2);
constexpr size_t WS_QX = al256(WS_PART + (size_t)32 * 9 * 256 * 264 * 4);
constexpr size_t WS_MB = WS_QX + SZ_ACT;
constexpr size_t WS_MKB = WS_MB + (size_t)2048 * 1024 * 2;
constexpr size_t WS_MVB = WS_MKB + (size_t)4 * 2048 * 1024 * 2;
constexpr size_t WS_HB = WS_MVB + (size_t)4 * 2048 * 1024 * 2;
constexpr size_t WS_END = WS_HB + (size_t)MT * DFF * 2;
constexpr int CW_BAR = 4096;

namespace pg8 {
#define PG8_LAS __attribute__((address_space(3)))
typedef unsigned short bf16_t;
typedef short bf16x8 __attribute__((ext_vector_type(8)));
typedef float f32x4 __attribute__((ext_vector_type(4)));
typedef unsigned u32x4 __attribute__((ext_vector_type(4)));
constexpr int BM = 256, BK = 64, HALF = 128, HTB = HALF * BK * 2  , STAGE_BYTES = 8 * HTB, NXCD = 8, WGM = 8;

__host__ __device__ __forceinline__ int lds_byte(int r, int c) { const int st = (r >> 4) * 2 + (c >> 5), rr = r & 15, cc = c & 31, ob = rr * 64 + cc * 2; return st * 1024 + (ob ^ (((ob >> 9) & 1) << 5)); }
__host__ __device__ __forceinline__ void stage_rc(int b, int& R, int& C) { const int st = b / 1024, sb = b % 1024, swz = sb ^ (((sb >> 9) & 1) << 5); R = (st >> 1) * 16 + swz / 64; C = (st & 1) * 32 + (swz % 64) / 2; }
__host__ __device__ __forceinline__ int perm32(int rho) { const int n = rho >> 4, i = rho & 15; return 8 * (i >> 2) + 4 * n + (i & 3); }

struct Unit { int pm, pn; };
struct Gemm { const bf16_t* A; const bf16_t* Bt; int M, N, K; };

struct StaticOrder {
    int nM, nN, nwg, G, c;
    __host__ __device__ void init(int M, int N, int G_, int c_) { nM = M / BM; nN = N / BM; nwg = nM * nN; G = G_; c = c_; }
    __host__ __device__ bool next(int i, Unit& u) const {
        const long L = (long)i * G + c; if (L >= nwg) return false;
        int wgid = (int)L; { const int q = nwg / NXCD, r = nwg % NXCD, xcd = wgid % NXCD, off = wgid / NXCD; wgid = (xcd < r ? xcd * (q + 1) : r * (q + 1) + (xcd - r) * q) + off; }
        const int nig = WGM * nN, gid = wgid / nig, fm = gid * WGM, gsz = (nM - fm) < WGM ? (nM - fm) : WGM;
        u.pm = fm + ((wgid % nig) % gsz); u.pn = (wgid % nig) / gsz; return true;
    }
    __device__ __forceinline__ void a_ready(const Unit&) const {}
    __device__ __forceinline__ void done(const Unit&) const {}
};

typedef unsigned u32x2 __attribute__((ext_vector_type(2)));
typedef float f32x2v __attribute__((ext_vector_type(2)));
typedef __bf16 bf16x2_t __attribute__((ext_vector_type(2)));
__device__ __forceinline__ unsigned pk_bf16(float lo, float hi) { f32x2v v = {lo, hi}; bf16x2_t b = __builtin_convertvector(v, bf16x2_t); return __builtin_bit_cast(unsigned, b); }
__device__ __forceinline__ u32x2 pk4(f32x4 v) { u32x2 w; w.x = pk_bf16(v[0], v[1]); w.y = pk_bf16(v[2], v[3]); return w; }
__device__ __forceinline__ float dot4(f32x4 v) { return (v[0] * v[0] + v[1] * v[1]) + (v[2] * v[2] + v[3] * v[3]); }
__device__ __forceinline__ float sigm(float z) { return __builtin_amdgcn_rcpf(1.0f + __builtin_amdgcn_exp2f(-z * LOG2E)); }
#define EPI_FENCE() asm volatile("" ::: "memory")
__device__ __forceinline__ int pg8_tid() { int t = threadIdx.x; asm volatile("" : "+v"(t)); return t; }

struct RowScale { const float* p; int stride; int ngrp; float inv_n;
    __device__ __forceinline__ float get(int row, int fq) const {
        float s = 0.f; if (fq < ngrp) { const f32x4 v = *(const f32x4*)(p + (size_t)row * stride + 4 * fq); s = (v[0] + v[1]) + (v[2] + v[3]); }
        s += __shfl_xor(s, 16); s += __shfl_xor(s, 32); return rsqrtf(s * inv_n + EPS); }
    __device__ __forceinline__ void get8(int row0, int fq, float (&r)[2][4]) const {
        float s[2][4];
#pragma unroll
        for (int ai = 0; ai < 2; ++ai)
#pragma unroll
            for (int m = 0; m < 4; ++m) { s[ai][m] = 0.f; if (fq < ngrp) { const f32x4 v = *(const f32x4*)(p + (size_t)(row0 + ai * HALF + m * 16) * stride + 4 * fq); s[ai][m] = (v[0] + v[1]) + (v[2] + v[3]); } }
#pragma unroll
        for (int ai = 0; ai < 2; ++ai)
#pragma unroll
            for (int m = 0; m < 4; ++m) { float t = s[ai][m]; t += __shfl_xor(t, 16); t += __shfl_xor(t, 32); r[ai][m] = rsqrtf(t * inv_n + EPS); }
    } };
__device__ __forceinline__ int row_pos(int row) { return row < MP ? (row & (SEQ - 1)) : PAST + ((row - MP) & (DSEQ - 1)); }

struct EpiFoxIn { static constexpr bool PERM = false, AFTER_DRAIN = false;
    RowScale rs; unsigned char* ws; float* out; const float* bff; int L;
    __device__ __forceinline__ void operator()(const f32x4 (&acc)[2][2][4][2], const Unit& u, int wr, int wc, int, int) const { const int lane_ = pg8_tid() & 63, fr = lane_ & 15, fq = lane_ >> 4; float rsv[2][4]; rs.get8(u.pm * BM + wr * 64 + fr, fq, rsv);
        const int typ = u.pn >> 2, colt = (u.pn & 3) * 256 + wc * 32 + 4 * fq;
        bf16_t* QF = (bf16_t*)(ws + WS_QF); float* kp = out + O_FKP + (size_t)L * MP * 1024; float* ks = out + O_FKS + (size_t)L * MS * 1024;
#pragma unroll
        for (int ai = 0; ai < 2; ++ai)
#pragma unroll
            for (int m = 0; m < 4; ++m) { const int row = u.pm * BM + ai * HALF + wr * 64 + m * 16 + fr; float r = rsv[ai][m];
                if (typ == 0) { r *= C2_FOX;
#pragma unroll
                    for (int bj = 0; bj < 2; ++bj)
#pragma unroll
                        for (int n = 0; n < 2; ++n) *(u32x2*)(QF + (size_t)row * 1024 + colt + bj * HALF + n * 16) = pk4(acc[ai][bj][m][n] * r);
                } else if (typ == 3) {
#pragma unroll
                    for (int bj = 0; bj < 2; ++bj)
#pragma unroll
                        for (int n = 0; n < 2; ++n) { f32x4 v = acc[ai][bj][m][n] * r; v[0] = sigm(v[0]); v[1] = sigm(v[1]); v[2] = sigm(v[2]); v[3] = sigm(v[3]);
                            *(u32x2*)(QF + 3 * (SZ_ACT / 2) + (size_t)row * 1024 + colt + bj * HALF + n * 16) = pk4(v); }
                } else if (typ == 4) {
                    if (wc == 0) { const f32x4 bb = *(const f32x4*)(bff + 4 * fq); f32x4 lf;
#pragma unroll
                        for (int i = 0; i < 4; ++i) { const float z = acc[ai][0][m][0][i] * r + bb[i]; lf[i] = fminf(z, 0.f) - log1pf(expf(-fabsf(z))); }
                        *(f32x4*)((float*)(ws + WS_LFR) + (size_t)row * 16 + 4 * fq) = lf;
                        float* F = (row < MP) ? out + O_FLP + ((size_t)L * MP + row) * 16 : out + O_FLS + ((size_t)L * MS + (row - MP)) * 16;
                        *(f32x4*)(F + 4 * fq) = lf; }
                } else { bf16_t* B = QF + (size_t)typ * (SZ_ACT / 2);
                    float* F = (row < MP) ? kp + (size_t)(typ - 1) * 2 * MP * 1024 + (size_t)row * 1024 : ks + (size_t)(typ - 1) * 2 * MS * 1024 + (size_t)(row - MP) * 1024;
#pragma unroll
                    for (int bj = 0; bj < 2; ++bj)
#pragma unroll
                        for (int n = 0; n < 2; ++n) { const f32x4 v = acc[ai][bj][m][n] * r; const int c = colt + bj * HALF + n * 16;
                            *(f32x4*)(F + c) = v; *(u32x2*)(B + (size_t)row * 1024 + c) = pk4(v); }
                }
                if (m & 1) EPI_FENCE(); }
    }
};
struct EpiResid { static constexpr bool PERM = true, AFTER_DRAIN = false;
    const float* xin_p; const float* xin_s; int first; bf16_t* xb; float* ssq;
    __device__ __forceinline__ void operator()(const f32x4 (&acc)[2][2][4][2], const Unit& u, int wr, int wc, int, int) const { const int lane_ = pg8_tid() & 63, fr = lane_ & 15, fq = lane_ >> 4;
        const int col0 = u.pn * BM + wc * 32 + 8 * fq;
        if (first) {
#pragma unroll
        for (int ai = 0; ai < 2; ++ai) {
            f32x4 xo[4][2][2];
#pragma unroll
            for (int m = 0; m < 4; ++m) { const int row = u.pm * BM + ai * HALF + wr * 64 + m * 16 + fr;
                const float* xi = (row < MP) ? xin_p + (size_t)row * 1024 : xin_s + (size_t)(row - MP) * 1024;
#pragma unroll
                for (int bj = 0; bj < 2; ++bj)
#pragma unroll
                    for (int n = 0; n < 2; ++n) xo[m][bj][n] = *(const f32x4*)(xi + col0 + bj * HALF + n * 4); }
#pragma unroll
            for (int m = 0; m < 4; ++m) { const int row = u.pm * BM + ai * HALF + wr * 64 + m * 16 + fr; float sq = 0.f;
#pragma unroll
                for (int bj = 0; bj < 2; ++bj) { const int c = col0 + bj * HALF; const f32x4 x0 = xo[m][bj][0] + acc[ai][bj][m][0], x1 = xo[m][bj][1] + acc[ai][bj][m][1];
                    sq += dot4(x0) + dot4(x1);
                    const u32x2 w0 = pk4(x0), w1 = pk4(x1); *(u32x4*)(xb + (size_t)row * 1024 + c) = (u32x4){w0.x, w0.y, w1.x, w1.y}; }
                sq += __shfl_xor(sq, 16); sq += __shfl_xor(sq, 32);
                if (fq == 0) ssq[(size_t)row * 16 + u.pn * 4 + wc] = sq; }
            EPI_FENCE(); }
        } else {
            u32x4 raw[2][4][2];
#pragma unroll
            for (int ai = 0; ai < 2; ++ai)
#pragma unroll
                for (int m = 0; m < 4; ++m) { const int row = u.pm * BM + ai * HALF + wr * 64 + m * 16 + fr;
#pragma unroll
                    for (int bj = 0; bj < 2; ++bj) raw[ai][m][bj] = *(const u32x4*)(xb + (size_t)row * 1024 + col0 + bj * HALF); }
            EPI_FENCE();
#pragma unroll
            for (int ai = 0; ai < 2; ++ai) {
#pragma unroll
                for (int m = 0; m < 4; ++m) { const int row = u.pm * BM + ai * HALF + wr * 64 + m * 16 + fr; float sq = 0.f;
#pragma unroll
                    for (int bj = 0; bj < 2; ++bj) { const int c = col0 + bj * HALF; const u32x4 w = raw[ai][m][bj];
                        const f32x4 x0 = (f32x4){__builtin_bit_cast(float, w.x << 16), __builtin_bit_cast(float, w.x & 0xffff0000u), __builtin_bit_cast(float, w.y << 16), __builtin_bit_cast(float, w.y & 0xffff0000u)} + acc[ai][bj][m][0];
                        const f32x4 x1 = (f32x4){__builtin_bit_cast(float, w.z << 16), __builtin_bit_cast(float, w.z & 0xffff0000u), __builtin_bit_cast(float, w.w << 16), __builtin_bit_cast(float, w.w & 0xffff0000u)} + acc[ai][bj][m][1];
                        sq += dot4(x0) + dot4(x1);
                        const u32x2 w0 = pk4(x0), w1 = pk4(x1); *(u32x4*)(xb + (size_t)row * 1024 + c) = (u32x4){w0.x, w0.y, w1.x, w1.y}; }
                    sq += __shfl_xor(sq, 16); sq += __shfl_xor(sq, 32);
                    if (fq == 0) ssq[(size_t)row * 16 + u.pn * 4 + wc] = sq; }
                EPI_FENCE(); } }
    }
};
struct EpiScaleBf16 { static constexpr bool PERM = true, AFTER_DRAIN = false;
    RowScale rs; bf16_t* O; int ldc; float scale;
    __device__ __forceinline__ void operator()(const f32x4 (&acc)[2][2][4][2], const Unit& u, int wr, int wc, int, int) const { const int lane_ = pg8_tid() & 63, fr = lane_ & 15, fq = lane_ >> 4; float rsv[2][4]; rs.get8(u.pm * BM + wr * 64 + fr, fq, rsv);
        const int col0 = u.pn * BM + wc * 32 + 8 * fq;
#pragma unroll
        for (int ai = 0; ai < 2; ++ai)
#pragma unroll
            for (int m = 0; m < 4; ++m) { const int row = u.pm * BM + ai * HALF + wr * 64 + m * 16 + fr; const float r = rsv[ai][m] * scale;
#pragma unroll
                for (int bj = 0; bj < 2; ++bj) { const u32x2 w0 = pk4(acc[ai][bj][m][0] * r), w1 = pk4(acc[ai][bj][m][1] * r);
                    *(u32x4*)(O + (size_t)row * ldc + col0 + bj * HALF) = (u32x4){w0.x, w0.y, w1.x, w1.y}; }
                if (m & 1) EPI_FENCE(); }
    }
};
struct EpiSwiglu { static constexpr bool PERM = true, AFTER_DRAIN = false;
    RowScale rs; bf16_t* HB;
    __device__ __forceinline__ void operator()(const f32x4 (&acc)[2][2][4][2], const Unit& u, int wr, int wc, int, int) const { const int lane_ = pg8_tid() & 63, fr = lane_ & 15, fq = lane_ >> 4; float rsv[2][4]; rs.get8(u.pm * BM + wr * 64 + fr, fq, rsv);
        const int col0 = u.pn * HALF + wc * 32 + 8 * fq;
        const bool blk = u.pm < MP / BM; const int rstr = blk ? 128 : DFF * 2;
        const size_t hb0 = blk ? ((size_t)(u.pm * (DFF / 64) + (col0 >> 6)) * 32768 + (size_t)(col0 & 63) * 2) : ((size_t)u.pm * BM * DFF + col0) * 2;
#pragma unroll
        for (int ai = 0; ai < 2; ++ai)
#pragma unroll
            for (int m = 0; m < 4; ++m) { const int row = u.pm * BM + ai * HALF + wr * 64 + m * 16 + fr; const float r = rsv[ai][m]; u32x4 w;
#pragma unroll
                for (int n = 0; n < 2; ++n) { const f32x4 g = acc[ai][0][m][n] * r, uu = acc[ai][1][m][n] * r; f32x4 h;
#pragma unroll
                    for (int i = 0; i < 4; ++i) h[i] = g[i] * sigm(g[i]) * uu[i];
                    const u32x2 hw = pk4(h); if (n == 0) { w.x = hw.x; w.y = hw.y; } else { w.z = hw.x; w.w = hw.y; } }
                *(u32x4*)((char*)HB + hb0 + (size_t)(row - u.pm * BM) * rstr) = w;
                if (m & 1) EPI_FENCE(); }
    }
};
struct EpiMlaA { static constexpr bool PERM = false, AFTER_DRAIN = false;
    RowScale rs; float* ckvu; bf16_t* ckvub; float* ssqkv; bf16_t* cq; float* ssqq; bf16_t* krb; float *mrp, *mrs; const float *ropc, *rops;
    __device__ __forceinline__ void operator()(const f32x4 (&acc)[2][2][4][2], const Unit& u, int wr, int wc, int, int) const { const int lane_ = pg8_tid() & 63, fr = lane_ & 15, fq = lane_ >> 4; float rsv[2][4]; rs.get8(u.pm * BM + wr * 64 + fr, fq, rsv);
        const int cw = wc * 32 + 4 * fq;
#pragma unroll
        for (int ai = 0; ai < 2; ++ai)
#pragma unroll
            for (int m = 0; m < 4; ++m) { const int row = u.pm * BM + ai * HALF + wr * 64 + m * 16 + fr; const float r = rsv[ai][m];
                if (u.pn == 0) { float sq = 0.f;
#pragma unroll
                    for (int bj = 0; bj < 2; ++bj)
#pragma unroll
                        for (int n = 0; n < 2; ++n) { const int c = cw + bj * HALF + n * 16; const f32x4 v = acc[ai][bj][m][n] * r;
                            *(f32x4*)(ckvu + (size_t)row * 256 + c) = v; *(u32x2*)(ckvub + (size_t)row * 256 + c) = pk4(v); sq += dot4(v); }
                    sq += __shfl_xor(sq, 16); sq += __shfl_xor(sq, 32); if (fq == 0) ssqkv[(size_t)row * 4 + wc] = sq;
                } else if (u.pn == 1) { float sq = 0.f;
#pragma unroll
                    for (int bj = 0; bj < 2; ++bj)
#pragma unroll
                        for (int n = 0; n < 2; ++n) { const int c = cw + bj * HALF + n * 16; const f32x4 v = acc[ai][bj][m][n] * r;
                            *(u32x2*)(cq + (size_t)row * 384 + c) = pk4(v); sq += dot4(v); }
                    sq += __shfl_xor(sq, 16); sq += __shfl_xor(sq, 32); if (fq == 0) ssqq[(size_t)row * 8 + wc] = sq;
                } else { float sq = 0.f;
#pragma unroll
                    for (int n = 0; n < 2; ++n) { const int c = 256 + cw + n * 16; const f32x4 v = acc[ai][0][m][n] * r;
                        *(u32x2*)(cq + (size_t)row * 384 + c) = pk4(v); sq += dot4(v); }
                    sq += __shfl_xor(sq, 16); sq += __shfl_xor(sq, 32); if (fq == 0) ssqq[(size_t)row * 8 + 4 + wc] = sq;
                    if (wc == 0) { const int pos = row_pos(row); const f32x4 cs = *(const f32x4*)(ropc + pos * 16 + 4 * fq), sn = *(const f32x4*)(rops + pos * 16 + 4 * fq);
                        const f32x4 x1 = acc[ai][1][m][0] * r, x2 = acc[ai][1][m][1] * r; const f32x4 o1 = x1 * cs - x2 * sn, o2 = x1 * sn + x2 * cs;
                        *(u32x2*)(krb + (size_t)row * 32 + 4 * fq) = pk4(o1); *(u32x2*)(krb + (size_t)row * 32 + 16 + 4 * fq) = pk4(o2);
                        float* F = (row < MP) ? mrp + (size_t)row * 32 : mrs + (size_t)(row - MP) * 32;
                        *(f32x4*)(F + 4 * fq) = o1; *(f32x4*)(F + 16 + 4 * fq) = o2; }
                }
                if (m & 1) EPI_FENCE(); }
    }
};
struct EpiMlaQ { static constexpr bool PERM = false, AFTER_DRAIN = false;
    RowScale rs; bf16_t* QM; const float *ropc, *rops;
    __device__ __forceinline__ void operator()(const f32x4 (&acc)[2][2][4][2], const Unit& u, int wr, int wc, int, int) const { const int lane_ = pg8_tid() & 63, fr = lane_ & 15, fq = lane_ >> 4; float rsv[2][4]; rs.get8(u.pm * BM + wr * 64 + fr, fq, rsv);
#pragma unroll
        for (int ai = 0; ai < 2; ++ai)
#pragma unroll
            for (int m = 0; m < 4; ++m) { const int row = u.pm * BM + ai * HALF + wr * 64 + m * 16 + fr; const float r = rsv[ai][m] * C2_MLA;
                const int pos = row_pos(row);
#pragma unroll
                for (int bj = 0; bj < 2; ++bj) { const int g32 = u.pn * 8 + bj * 4 + wc; const int c = g32 * 32 + 4 * fq; bf16_t* o = QM + (size_t)row * 1536 + c;
                    if ((g32 % 3) == 2) { const f32x4 cs = *(const f32x4*)(ropc + pos * 16 + 4 * fq), sn = *(const f32x4*)(rops + pos * 16 + 4 * fq);
                        const f32x4 x1 = acc[ai][bj][m][0] * r, x2 = acc[ai][bj][m][1] * r;
                        *(u32x2*)(o) = pk4(x1 * cs - x2 * sn); *(u32x2*)(o + 16) = pk4(x1 * sn + x2 * cs);
                    } else { *(u32x2*)(o) = pk4(acc[ai][bj][m][0] * r); *(u32x2*)(o + 16) = pk4(acc[ai][bj][m][1] * r); } }
                EPI_FENCE(); }
    }
};
struct EpiNull { static constexpr bool PERM = true, AFTER_DRAIN = false;
    __device__ __forceinline__ void operator()(const f32x4 (&acc)[2][2][4][2], const Unit&, int, int, int, int) const {
#pragma unroll
        for (int ai = 0; ai < 2; ++ai)
#pragma unroll
            for (int bj = 0; bj < 2; ++bj)
#pragma unroll
                for (int m = 0; m < 4; ++m)
#pragma unroll
                    for (int n = 0; n < 2; ++n) asm volatile("" :: "v"(acc[ai][bj][m][n])); }
};
struct EpiMemKV { static constexpr bool PERM = false, AFTER_DRAIN = false;
    float* outk; float* outv; bf16_t* MKB; bf16_t* MVB;
    __device__ __forceinline__ void operator()(const f32x4 (&acc)[2][2][4][2], const Unit& u, int wr, int wc, int, int) const { const int lane_ = pg8_tid() & 63, fr = lane_ & 15, fq = lane_ >> 4;
        const int l = u.pn >> 3, cw0 = (u.pn & 7) * 256; const bool isv = cw0 >= 1024; const int cbase = (cw0 & 1023) + wc * 32 + 4 * fq;
#pragma unroll
        for (int ai = 0; ai < 2; ++ai)
#pragma unroll
            for (int m = 0; m < 4; ++m) { const int row = u.pm * BM + ai * HALF + wr * 64 + m * 16 + fr; const int b = row >> 8, nn = row & 255;
#pragma unroll
                for (int bj = 0; bj < 2; ++bj)
#pragma unroll
                    for (int n = 0; n < 2; ++n) { const int c = cbase + bj * HALF + n * 16; const f32x4 v = acc[ai][bj][m][n]; const size_t o = ((size_t)l * 2048 + row) * 1024 + c;
                        if (!isv) { *(f32x4*)(outk + o) = v; *(u32x2*)(MKB + o) = pk4(v); } else { *(f32x4*)(outv + o) = v; *(u32x2*)(MVB + o) = pk4(v); } }
                if (m & 1) EPI_FENCE(); }
    }
};

template <class Epi, class Sched, bool ALIGN_EPI = false, bool SP2 = false, bool ABLK = false>
__device__ __forceinline__ void gemm_phase(PG8_LAS unsigned char* lds, const Gemm g, const Sched& S, const Epi& E) {
    const int tid = pg8_tid(), wid = __builtin_amdgcn_readfirstlane(tid >> 6), lane = tid & 63, wr = wid >> 2, wc = wid & 3, fr = lane & 15, fq = lane >> 4;
    const int K = g.K, nt = K / BK;
    unsigned voffA[2], voffB[2];
#pragma unroll
    for (int i = 0; i < 2; ++i) { int R, C; stage_rc(tid * 16 + i * 8192, R, C); const int Rb = Epi::PERM ? ((R & ~31) + perm32(R & 31)) : R;
        voffA[i] = ABLK ? (unsigned)(R * BK + C) * 2u : (unsigned)(R * K + C) * 2u; voffB[i] = (unsigned)(Rb * K + C) * 2u; }
    const size_t kstep = (size_t)(BK * 2);
    const size_t hstep = (size_t)HALF * K * 2;
    const size_t tstep = 2 * hstep;
    const size_t kstepA = ABLK ? (size_t)BM * BK * 2 : kstep, hstepA = ABLK ? (size_t)HALF * BK * 2 : hstep, tstepA = ABLK ? (size_t)nt * BM * BK * 2 : tstep;
    const unsigned ldsw = (unsigned)wid * 1024u;
    const int aoff = lds_byte(wr * 64 + fr, fq * 8), boff = lds_byte(wc * 32 + fr, fq * 8);
#define PG8_SA(b, h) (((b) * 2 + (h)) * HTB)
#define PG8_SB(b, h) ((4 + (b) * 2 + (h)) * HTB)
#define PG8_STAGE(bufoff, gbase, voff) do { _Pragma("unroll") for (int _i = 0; _i < 2; ++_i) \
        __builtin_amdgcn_global_load_lds((const unsigned*)((const char*)(gbase) + (voff)[_i]), (PG8_LAS unsigned*)(lds + (bufoff) + ldsw + _i * 8192), 16, 0, 0); } while (0)
#define PG8_LDA(dst, b, h) do { _Pragma("unroll") for (int m = 0; m < 4; ++m) _Pragma("unroll") for (int k = 0; k < 2; ++k) dst[m][k] = *(const PG8_LAS bf16x8*)(lds + PG8_SA(b, h) + aoff + m * 2048 + k * 1024); } while (0)
#define PG8_LDB(dst, b, h) do { _Pragma("unroll") for (int n = 0; n < 2; ++n) _Pragma("unroll") for (int k = 0; k < 2; ++k) dst[n][k] = *(const PG8_LAS bf16x8*)(lds + PG8_SB(b, h) + boff + n * 2048 + k * 1024); } while (0)
#define PG8_MMA(ai, bj, At, Bt) do { __builtin_amdgcn_s_setprio(1); _Pragma("unroll") for (int m = 0; m < 4; ++m) _Pragma("unroll") for (int n = 0; n < 2; ++n) _Pragma("unroll") for (int k = 0; k < 2; ++k) \
        acc[ai][bj][m][n] = __builtin_amdgcn_mfma_f32_16x16x32_bf16(Bt[n][k], At[m][k], acc[ai][bj][m][n], 0, 0, 0); __builtin_amdgcn_s_setprio(0); } while (0)
#define PG8_WAIT_V(n) asm volatile("s_waitcnt vmcnt(" #n ")" ::: "memory")
#define PG8_WAIT_L(n) asm volatile("s_waitcnt lgkmcnt(" #n ")" ::: "memory")
#define PG8_BAR __builtin_amdgcn_s_barrier()
#define PG8_SCHED __builtin_amdgcn_sched_barrier(0)
    Unit cur, nxt; int ui = 0;
    if (!S.next(0, cur)) return;
    f32x4 acc[2][2][4][2];
#pragma unroll
    for (int a = 0; a < 2; ++a)
#pragma unroll
        for (int b = 0; b < 2; ++b)
#pragma unroll
            for (int m = 0; m < 4; ++m)
#pragma unroll
                for (int n = 0; n < 2; ++n) acc[a][b][m][n] = (f32x4){0.f, 0.f, 0.f, 0.f};
    bf16x8 At[4][2], B0[2][2], B1[2][2];
    const char* cA = (const char*)g.A + (size_t)cur.pm * tstepA; const char* cB = (const char*)g.Bt + (size_t)cur.pn * tstep;
    S.a_ready(cur);
    if constexpr (SP2) {
        PG8_STAGE(PG8_SB(0, 0), cB, voffB); PG8_STAGE(PG8_SB(0, 1), cB + hstep, voffB); PG8_STAGE(PG8_SA(0, 0), cA, voffA); PG8_STAGE(PG8_SA(0, 1), cA + hstepA, voffA);
        if (wr == 1) PG8_BAR;
        PG8_WAIT_V(2); PG8_BAR;
        PG8_STAGE(PG8_SB(1, 0), cB + kstep, voffB); PG8_STAGE(PG8_SA(1, 0), cA + kstepA, voffA); PG8_STAGE(PG8_SB(1, 1), cB + hstep + kstep, voffB);
        PG8_WAIT_V(6); PG8_BAR;
    } else {
        PG8_STAGE(PG8_SB(0, 0), cB, voffB); PG8_STAGE(PG8_SA(0, 0), cA, voffA); PG8_STAGE(PG8_SB(0, 1), cB + hstep, voffB); PG8_STAGE(PG8_SA(0, 1), cA + hstepA, voffA);
        if (wr == 1) PG8_BAR;
        PG8_WAIT_V(4); PG8_BAR;
        PG8_STAGE(PG8_SB(1, 0), cB + kstep, voffB); PG8_STAGE(PG8_SA(1, 0), cA + kstepA, voffA); PG8_STAGE(PG8_SB(1, 1), cB + hstep + kstep, voffB);
        PG8_WAIT_V(6); PG8_BAR;
    }
    for (;;) {
        const bool has_next = S.next(ui + 1, nxt);
        const char* nA = has_next ? (const char*)g.A + (size_t)nxt.pm * tstepA : cA; const char* nB = has_next ? (const char*)g.Bt + (size_t)nxt.pn * tstep : cB;
        for (int t = 0; t < nt; t += 2) {
            const bool last = (t == nt - 2);
            const char* a1 = cA + (size_t)(t + 1) * kstepA;
            const char* a2 = last ? nA : cA + (size_t)(t + 2) * kstepA; const char* b2 = last ? nB : cB + (size_t)(t + 2) * kstep;
            const char* a3 = a2 + kstepA; const char* b3 = b2 + kstep;
            if (last && has_next) S.a_ready(nxt);
            if constexpr (SP2) {
            PG8_LDB(B0, 0, 0); PG8_LDB(B1, 0, 1); PG8_SCHED; PG8_LDA(At, 0, 0); PG8_STAGE(PG8_SA(1, 1), a1 + hstepA, voffA);
            PG8_WAIT_V(8); PG8_WAIT_L(0); PG8_BAR; PG8_MMA(0, 0, At, B0); PG8_MMA(0, 1, At, B1); PG8_BAR; PG8_SCHED;
            PG8_LDA(At, 0, 1); PG8_STAGE(PG8_SB(0, 0), b2, voffB); PG8_STAGE(PG8_SB(0, 1), b2 + hstep, voffB); PG8_STAGE(PG8_SA(0, 0), a2, voffA);
            PG8_WAIT_V(8); PG8_WAIT_L(0); PG8_BAR; PG8_MMA(1, 0, At, B0); PG8_MMA(1, 1, At, B1); PG8_BAR; PG8_SCHED;
            PG8_LDB(B0, 1, 0); PG8_LDB(B1, 1, 1); PG8_SCHED; PG8_LDA(At, 1, 0); PG8_STAGE(PG8_SA(0, 1), a2 + hstepA, voffA);
            PG8_WAIT_V(8); PG8_WAIT_L(0); PG8_BAR; PG8_MMA(0, 0, At, B0); PG8_MMA(0, 1, At, B1); PG8_BAR; PG8_SCHED;
            PG8_LDA(At, 1, 1); PG8_STAGE(PG8_SB(1, 0), b3, voffB); PG8_STAGE(PG8_SB(1, 1), b3 + hstep, voffB); PG8_STAGE(PG8_SA(1, 0), a3, voffA);
            PG8_WAIT_V(8); PG8_WAIT_L(0); PG8_BAR; PG8_MMA(1, 0, At, B0); PG8_MMA(1, 1, At, B1); PG8_BAR; PG8_SCHED;
            } else {
            PG8_LDB(B0, 0, 0); PG8_SCHED; PG8_LDA(At, 0, 0); PG8_STAGE(PG8_SA(1, 1), a1 + hstepA, voffA);
            PG8_WAIT_L(8); PG8_BAR; PG8_WAIT_L(0); PG8_MMA(0, 0, At, B0); PG8_BAR; PG8_SCHED;
            PG8_LDB(B1, 0, 1); PG8_STAGE(PG8_SB(0, 0), b2, voffB);
            PG8_BAR; PG8_WAIT_L(0); PG8_MMA(0, 1, At, B1); PG8_BAR;
            PG8_LDA(At, 0, 1); PG8_STAGE(PG8_SA(0, 0), a2, voffA);
            PG8_BAR; PG8_WAIT_L(0); PG8_MMA(1, 0, At, B0); PG8_BAR; PG8_SCHED;
            PG8_STAGE(PG8_SB(0, 1), b2 + hstep, voffB);
            PG8_WAIT_V(6); PG8_BAR; PG8_MMA(1, 1, At, B1); PG8_BAR;
            PG8_LDB(B0, 1, 0); PG8_SCHED; PG8_LDA(At, 1, 0); PG8_STAGE(PG8_SA(0, 1), a2 + hstepA, voffA);
            PG8_WAIT_L(8); PG8_BAR; PG8_WAIT_L(0); PG8_MMA(0, 0, At, B0); PG8_BAR; PG8_SCHED;
            PG8_LDB(B1, 1, 1); PG8_STAGE(PG8_SB(1, 0), b3, voffB);
            PG8_BAR; PG8_WAIT_L(0); PG8_MMA(0, 1, At, B1); PG8_BAR;
            PG8_LDA(At, 1, 1); PG8_STAGE(PG8_SA(1, 0), a3, voffA);
            PG8_BAR; PG8_WAIT_L(0); PG8_MMA(1, 0, At, B0); PG8_BAR; PG8_SCHED;
            PG8_STAGE(PG8_SB(1, 1), b3 + hstep, voffB);
            PG8_WAIT_V(6); PG8_BAR; PG8_MMA(1, 1, At, B1); PG8_BAR;
            }
        }
        if constexpr (ALIGN_EPI) { if (wr == 0) PG8_BAR; }
        if constexpr (!Epi::AFTER_DRAIN) { E(acc, cur, wr, wc, fr, fq); S.done(cur); }
        if (!has_next) break;
#pragma unroll
        for (int a = 0; a < 2; ++a)
#pragma unroll
            for (int b = 0; b < 2; ++b)
#pragma unroll
                for (int m = 0; m < 4; ++m)
#pragma unroll
                    for (int n = 0; n < 2; ++n) acc[a][b][m][n] = (f32x4){0.f, 0.f, 0.f, 0.f};
        cur = nxt; cA = nA; cB = nB; ++ui;
        if constexpr (ALIGN_EPI) { if (wr == 1) PG8_BAR; }
    }
    PG8_WAIT_V(0);
    if constexpr (!ALIGN_EPI) { if (wr == 0) PG8_BAR; }
    PG8_BAR;
    if constexpr (Epi::AFTER_DRAIN) { E.fused(acc, cur, wr, wc, fr, fq, lds, wid, lane); S.done(cur); }
#undef PG8_SA
#undef PG8_SB
#undef PG8_STAGE
#undef PG8_LDA
#undef PG8_LDB
#undef PG8_MMA
#undef PG8_WAIT_V
#undef PG8_WAIT_L
#undef PG8_BAR
#undef PG8_SCHED
}
}

#define GAS __attribute__((address_space(1)))
#define LAS __attribute__((address_space(3)))
typedef unsigned short bf16;
typedef float f32x4 __attribute__((ext_vector_type(4)));
typedef float f32x16 __attribute__((ext_vector_type(16)));
typedef short bf16x8 __attribute__((ext_vector_type(8)));
typedef short s16x4 __attribute__((ext_vector_type(4)));
typedef unsigned u32x4 __attribute__((ext_vector_type(4)));
typedef unsigned u32x2 __attribute__((ext_vector_type(2)));
typedef GAS unsigned gu32;
#define RLX_AGENT __ATOMIC_RELAXED, __HIP_MEMORY_SCOPE_AGENT
#define LDS_WAIT() asm volatile("s_waitcnt lgkmcnt(0)" ::: "memory")
#define VM_WAIT() asm volatile("s_waitcnt vmcnt(0)" ::: "memory")
__device__ __forceinline__ unsigned pk2(float lo, float hi) { return pg8::pk_bf16(lo, hi); }
__device__ __forceinline__ float bf2f(unsigned short b) { return __builtin_bit_cast(float, (unsigned)b << 16); }
__device__ __forceinline__ float ex2(float x) { return __builtin_amdgcn_exp2f(x); }
__device__ __forceinline__ float wave_sum(float v) {
#pragma unroll
    for (int o = 1; o < 64; o <<= 1) v += __shfl_xor(v, o);
    return v;
}

namespace fa {
constexpr int KSLOT = 12288, VSLOT = 8192;
constexpr int L_K = 0, L_V = 2 * KSLOT, L_WS = L_V + 2 * VSLOT, L_OST = L_WS + 8 * 64 * 4, L_BYTES = L_OST + 8 * 32 * 64 * 4;
constexpr int L_WS2 = L_V + 3 * VSLOT, L_CB2 = L_WS2 + 8 * 128 * 4, L_OST2 = L_CB2 + 512, L_QR2 = L_OST2 + 8 * 4096, L_BYTES2 = L_QR2 + 8 * 4096;
__device__ __forceinline__ int crow(int r, int hi) { return (r & 3) + 8 * (r >> 2) + 4 * hi; }
__device__ __forceinline__ void glds16(const void* gsrc, unsigned lds_dst) { unsigned keep;
    asm volatile("s_mov_b32 %0, m0\n\ts_mov_b32 m0, %2\n\ts_nop 0\n\tglobal_load_lds_dwordx4 %1, off\n\ts_mov_b32 m0, %0" : "=&s"(keep) : "v"(gsrc), "s"(lds_dst) : "memory"); }
#define FA_WAIT_BAR() asm volatile("s_waitcnt vmcnt(0) lgkmcnt(0)\n\ts_barrier" ::: "memory")
#define FA_SBAR() __builtin_amdgcn_sched_barrier(0)
template <int ND0> __device__ __forceinline__ void qkt(f32x16& p0, f32x16& p1, const LAS char* kp, const bf16x8* qr) {
    p0 = f32x16{}; p1 = f32x16{};
#pragma unroll
    for (int d0 = 0; d0 < ND0; ++d0) {
        const bf16x8 b0 = *(const LAS bf16x8*)(kp + d0 * 2048);
        const bf16x8 b1 = *(const LAS bf16x8*)(kp + d0 * 2048 + 512);
        p0 = __builtin_amdgcn_mfma_f32_32x32x16_bf16(b0, qr[d0], p0, 0, 0, 0); p1 = __builtin_amdgcn_mfma_f32_32x32x16_bf16(b1, qr[d0], p1, 0, 0, 0); }
}
__device__ __forceinline__ float max3f(float a, float b, float c) { float r; asm("v_max3_f32 %0, %1, %2, %3" : "=v"(r) : "v"(a), "v"(b), "v"(c)); return r; }
__device__ __forceinline__ float max2f(float a, float b) { float r; asm("v_max_f32_e32 %0, %1, %2" : "=v"(r) : "v"(a), "v"(b)); return r; }
__device__ __forceinline__ float rowmax_a(const f32x16& p0, const f32x16& p1) {
    float a = max3f(p0[0], p0[1], p1[0]), b = max3f(p0[2], p0[3], p1[1]); a = max3f(a, p1[2], p1[3]);
#pragma unroll
    for (int r = 4; r < 16; r += 4) { a = max3f(a, p0[r], p0[r + 1]); b = max3f(b, p0[r + 2], p0[r + 3]); a = max3f(a, p1[r], p1[r + 1]); b = max3f(b, p1[r + 2], p1[r + 3]); }
    const float m = max2f(a, b);
    auto rr = __builtin_amdgcn_permlane32_swap(__float_as_uint(m), __float_as_uint(m), false, false);
    return max2f(__uint_as_float(rr[0]), __uint_as_float(rr[1]));
}
__device__ __forceinline__ float rowmax(const f32x16& p0, const f32x16& p1) {
    float a = __builtin_fmaxf(p0[0], p1[0]);
#pragma unroll
    for (int r = 1; r < 16; ++r) a = __builtin_fmaxf(a, __builtin_fmaxf(p0[r], p1[r]));
    auto rr = __builtin_amdgcn_permlane32_swap(__float_as_uint(a), __float_as_uint(a), false, false);
    return __builtin_fmaxf(__uint_as_float(rr[0]), __uint_as_float(rr[1]));
}
__device__ __forceinline__ void pv(f32x16* o, int vb, bf16x8 pa0, bf16x8 pa1, bf16x8 pa2, bf16x8 pa3) {
#pragma unroll
    for (int d0 = 0; d0 < 2; ++d0) { s16x4 lo[4], hi[4];
#pragma unroll
        for (int ks = 0; ks < 4; ++ks) {
            asm volatile("ds_read_b64_tr_b16 %0,%1 offset:%c2" : "=&v"(lo[ks]) : "v"(vb), "i"(d0 * 4096 + ks * 1024) : "memory");
            asm volatile("ds_read_b64_tr_b16 %0,%1 offset:%c2" : "=&v"(hi[ks]) : "v"(vb), "i"(d0 * 4096 + ks * 1024 + 512) : "memory"); }
        asm volatile("s_waitcnt lgkmcnt(0)" ::: "memory"); FA_SBAR();
#define FA_PK(k) (bf16x8){lo[k][0], lo[k][1], lo[k][2], lo[k][3], hi[k][0], hi[k][1], hi[k][2], hi[k][3]}
        o[d0] = __builtin_amdgcn_mfma_f32_32x32x16_bf16(pa0, FA_PK(0), o[d0], 0, 0, 0);
        o[d0] = __builtin_amdgcn_mfma_f32_32x32x16_bf16(pa1, FA_PK(1), o[d0], 0, 0, 0);
        o[d0] = __builtin_amdgcn_mfma_f32_32x32x16_bf16(pa2, FA_PK(2), o[d0], 0, 0, 0);
        o[d0] = __builtin_amdgcn_mfma_f32_32x32x16_bf16(pa3, FA_PK(3), o[d0], 0, 0, 0);
#undef FA_PK
    }
}
struct Args { const bf16* Q; int qpitch, qcol; const bf16* K; int kpitch, kcol; const bf16* K2; const bf16* V; int vpitch, vcol; bf16* O; int ocol; const bf16* G; const float* CB; };
template <int MODE> __device__ __forceinline__ void unit(const Args& A, long rowbase, int qb, LAS char* lds, unsigned lds0) {
    constexpr int ND0 = MODE ? 6 : 4;
    const int tid = pg8::pg8_tid(), lane = tid & 63, r32 = lane & 31, hi = lane >> 5; const int wid = __builtin_amdgcn_readfirstlane(tid >> 6);
    const int q0 = qb * 256, NT = q0 / 64 + 4, nt_w = MODE ? (q0 / 64 + (wid >> 1) + 1) : NT;
    const bf16* Qw = A.Q + (rowbase + q0 + wid * 32 + r32) * A.qpitch + A.qcol + hi * 8;
    bf16x8 qr[ND0];
#pragma unroll
    for (int d0 = 0; d0 < ND0; ++d0) qr[d0] = *(const bf16x8*)(Qw + d0 * 16);
    const bf16* ksrc = A.K + (rowbase + lane) * A.kpitch + A.kcol + wid * 8;
    const bf16* ksrc2 = MODE ? A.K2 + (rowbase + lane) * 32 + (wid & 3) * 8 : nullptr;
    const bf16* vsrc = A.V + (rowbase + 16 * (wid & 3) + (lane >> 2)) * A.vpitch + A.vcol + (wid >> 2) * 32 + (lane & 3) * 8;
#define FA_DMA(t, slot) do { \
        glds16(ksrc + (long)(t) * 64 * A.kpitch, (unsigned)__builtin_amdgcn_readfirstlane(lds0 + L_K + (slot) * KSLOT + wid * 1024)); \
        if (MODE && wid < 4) glds16(ksrc2 + (long)(t) * 64 * 32, (unsigned)__builtin_amdgcn_readfirstlane(lds0 + L_K + (slot) * KSLOT + (8 + wid) * 1024)); \
        glds16(vsrc + (long)(t) * 64 * A.vpitch, (unsigned)__builtin_amdgcn_readfirstlane(lds0 + L_V + (slot) * VSLOT + wid * 1024)); } while (0)
    LAS float* wsf = (LAS float*)(lds + L_WS) + wid * 64;
    const int vb0 = (int)(lds0 + L_V) + ((lane >> 4) & 1) * 32 + (lane & 3) * 8 + (4 * hi + ((lane & 15) >> 2)) * 64;
    float m = -1e30f, l = 0.f; f32x16 o[2]; o[0] = f32x16{}; o[1] = f32x16{};
    FA_DMA(0, 0);
    for (int t = 0; t < NT; ++t) {
        FA_WAIT_BAR();
        if (t + 1 < NT) FA_DMA(t + 1, (t + 1) & 1);
        if (t < nt_w) {
            const int slot = t & 1;
            f32x16 p0, p1; qkt<ND0>(p0, p1, lds + L_K + slot * KSLOT + hi * 1024 + r32 * 16, qr);
            if (MODE == 0) {
                const float* cb = A.CB + t * 64 + 4 * hi;
#pragma unroll
                for (int g4 = 0; g4 < 4; ++g4) { const f32x4 b0 = *(const f32x4*)(cb + 8 * g4), b1 = *(const f32x4*)(cb + 32 + 8 * g4);
#pragma unroll
                    for (int i = 0; i < 4; ++i) { p0[4 * g4 + i] += b0[i]; p1[4 * g4 + i] += b1[i]; } }
                const int jb = t - (NT - 4);
                if (jb >= 0) { const int qrel = wid * 32 + r32, kb = 64 * jb + 4 * hi;
#pragma unroll
                    for (int r = 0; r < 16; ++r) { const int kv = kb + (r & 3) + 8 * (r >> 2); if (kv > qrel) p0[r] = -INFINITY; if (kv + 32 > qrel) p1[r] = -INFINITY; } }
            }
            const float rm = rowmax(p0, p1);
            const float mn = __builtin_fmaxf(m, rm), alpha = ex2(m - mn); m = mn;
            float sacc = 0.f;
#pragma unroll
            for (int r = 0; r < 16; ++r) { p0[r] = ex2(p0[r] - mn); p1[r] = ex2(p1[r] - mn); sacc += p0[r] + p1[r]; }
            l = l * alpha + sacc;
            if (hi == 0) wsf[r32] = alpha;
#pragma unroll
            for (int r = 0; r < 16; ++r) { const float a = wsf[crow(r, hi)]; o[0][r] *= a; o[1][r] *= a; }
            u32x4 pw0, pw1, pw2, pw3;
            pw0 = (u32x4){pk2(p0[0], p0[1]), pk2(p0[2], p0[3]), pk2(p0[4], p0[5]), pk2(p0[6], p0[7])};
            pw1 = (u32x4){pk2(p0[8], p0[9]), pk2(p0[10], p0[11]), pk2(p0[12], p0[13]), pk2(p0[14], p0[15])};
            pw2 = (u32x4){pk2(p1[0], p1[1]), pk2(p1[2], p1[3]), pk2(p1[4], p1[5]), pk2(p1[6], p1[7])};
            pw3 = (u32x4){pk2(p1[8], p1[9]), pk2(p1[10], p1[11]), pk2(p1[12], p1[13]), pk2(p1[14], p1[15])};
            FA_SBAR();
            pv(o, vb0 + slot * VSLOT, __builtin_bit_cast(bf16x8, pw0), __builtin_bit_cast(bf16x8, pw1), __builtin_bit_cast(bf16x8, pw2), __builtin_bit_cast(bf16x8, pw3));
        }
    }
    { auto rr = __builtin_amdgcn_permlane32_swap(__float_as_uint(l), __float_as_uint(l), false, false); l = __uint_as_float(rr[0]) + __uint_as_float(rr[1]); }
    if (hi == 0) wsf[32 + r32] = l;
    LAS float* stg = (LAS float*)(lds + L_OST) + wid * 2048;
#pragma unroll
    for (int r = 0; r < 16; ++r) { const int orow = crow(r, hi); const float rl = __builtin_amdgcn_rcpf(wsf[32 + orow]);
        stg[orow * 64 + r32] = o[0][r] * rl; stg[orow * 64 + 32 + r32] = o[1][r] * rl; }
    LDS_WAIT();
#pragma unroll
    for (int i = 0; i < 4; ++i) { const int row = i * 8 + (lane >> 3), ch = lane & 7; const long grow = rowbase + q0 + wid * 32 + row;
        f32x4 a = *(const LAS f32x4*)(stg + row * 64 + ch * 8), b = *(const LAS f32x4*)(stg + row * 64 + ch * 8 + 4);
        if (MODE == 0) { const u32x4 g = *(const u32x4*)(A.G + grow * 1024 + A.ocol + ch * 8);
            a[0] *= __uint_as_float(g.x << 16); a[1] *= __uint_as_float(g.x & 0xffff0000u); a[2] *= __uint_as_float(g.y << 16); a[3] *= __uint_as_float(g.y & 0xffff0000u);
            b[0] *= __uint_as_float(g.z << 16); b[1] *= __uint_as_float(g.z & 0xffff0000u); b[2] *= __uint_as_float(g.w << 16); b[3] *= __uint_as_float(g.w & 0xffff0000u); }
        const u32x4 w = (u32x4){pk2(a[0], a[1]), pk2(a[2], a[3]), pk2(b[0], b[1]), pk2(b[2], b[3])};
        *(u32x4*)(A.O + grow * 1024 + A.ocol + ch * 8) = w; }
    asm volatile("s_waitcnt lgkmcnt(0)\n\ts_barrier" ::: "memory");
#undef FA_DMA
}

#ifndef FA_STAG_FOX
#define FA_STAG_FOX 1
#endif
#ifndef FA_STAG_MLA
#define FA_STAG_MLA 1
#endif
#ifndef FA_PROBE_VALU
#define FA_PROBE_VALU 0
#endif
__device__ __forceinline__ void glds4(const void* gsrc, unsigned lds_dst) { unsigned keep;
    asm volatile("s_mov_b32 %0, m0\n\ts_mov_b32 m0, %2\n\ts_nop 0\n\tglobal_load_lds_dword %1, off\n\ts_mov_b32 m0, %0" : "=&s"(keep) : "v"(gsrc), "s"(lds_dst) : "memory"); }
__device__ __forceinline__ s16x4 vtr(const LAS char* p) { typedef short v4i16_t __attribute__((ext_vector_type(4))); return __builtin_bit_cast(s16x4, __builtin_amdgcn_ds_read_tr16_b64_v4i16((LAS v4i16_t*)p)); }
template <int MODE, bool DIAG> __device__ __forceinline__ void tile_qs(const LAS char* kp, const bf16x8 (&qr)[2][4], const LAS char* qrl, const LAS float* cbl, int r32, int hi,
                                                                     float (&m)[2], float (&l)[2], f32x16 (&o)[2][2], LAS float* wsf, u32x4 (&pw)[2][4]) {
    constexpr int ND0 = MODE ? 6 : 4;
    f32x16 p[2][2];
    if (MODE == 0) {
#pragma unroll
        for (int g4 = 0; g4 < 4; ++g4) { const f32x4 b0 = *(const LAS f32x4*)(cbl + 4 * hi + 8 * g4), b1 = *(const LAS f32x4*)(cbl + 32 + 4 * hi + 8 * g4);
#pragma unroll
            for (int i = 0; i < 4; ++i) { p[0][0][4 * g4 + i] = b0[i]; p[0][1][4 * g4 + i] = b1[i]; } }
        p[1][0] = p[0][0]; p[1][1] = p[0][1];
    } else {
#pragma unroll
        for (int b2 = 0; b2 < 2; ++b2) { p[b2][0] = f32x16{}; p[b2][1] = f32x16{}; }
    }
    bf16x8 qx[2][2];
    if (MODE) {
#pragma unroll
        for (int b2 = 0; b2 < 2; ++b2) { qx[b2][0] = *(const LAS bf16x8*)(qrl + (b2 * 2) * 1024); qx[b2][1] = *(const LAS bf16x8*)(qrl + (b2 * 2 + 1) * 1024); } }
#pragma unroll
    for (int d0 = 0; d0 < ND0; ++d0) { const bf16x8 k0 = *(const LAS bf16x8*)(kp + d0 * 2048), k1 = *(const LAS bf16x8*)(kp + d0 * 2048 + 512);
#pragma unroll
        for (int b2 = 0; b2 < 2; ++b2) { const bf16x8 qv = (d0 < 4) ? qr[b2][d0 & 3] : qx[b2][d0 & 1];
            p[b2][0] = __builtin_amdgcn_mfma_f32_32x32x16_bf16(k0, qv, p[b2][0], 0, 0, 0); p[b2][1] = __builtin_amdgcn_mfma_f32_32x32x16_bf16(k1, qv, p[b2][1], 0, 0, 0); } }
    if (MODE == 0 && DIAG) {
#pragma unroll
        for (int b2 = 0; b2 < 2; ++b2) { const int qrel = 32 * b2 + r32;
#pragma unroll
            for (int r = 0; r < 16; ++r) { const int kv = 4 * hi + (r & 3) + 8 * (r >> 2); if (kv > qrel) p[b2][0][r] = -INFINITY; if (kv + 32 > qrel) p[b2][1][r] = -INFINITY; } } }
    asm volatile("s_nop 15\n\ts_nop 7" : "+v"(p[0][0]), "+v"(p[0][1]), "+v"(p[1][0]), "+v"(p[1][1]));
#if FA_PROBE_VALU
    { float dd[8];
#pragma unroll
      for (int i = 0; i < 8; ++i) dd[i] = m[0] + (float)i;
#pragma unroll
      for (int k = 0; k < FA_PROBE_VALU; ++k)
#pragma unroll
        for (int i = 0; i < 8; ++i) dd[i] = ex2(dd[i]);
#pragma unroll
      for (int i = 0; i < 8; ++i) asm volatile("" :: "v"(dd[i])); }
#endif
#pragma unroll
    for (int b2 = 0; b2 < 2; ++b2) {
        const float rm = rowmax_a(p[b2][0], p[b2][1]);
        const float mn = max2f(m[b2], rm); float alpha = m[b2] - mn; asm("v_exp_f32 %0, %0\n\ts_nop 0" : "+v"(alpha)); m[b2] = mn;
        float sa0 = 0.f, sa1 = 0.f;
#pragma unroll
        for (int r = 0; r < 16; r += 2) { float a = p[b2][0][r] - mn, b = p[b2][1][r] - mn, c = p[b2][0][r + 1] - mn, d = p[b2][1][r + 1] - mn;
            asm("v_exp_f32 %0, %0\n\tv_exp_f32 %1, %1\n\tv_exp_f32 %2, %2\n\tv_exp_f32 %3, %3\n\tv_add_f32 %4, %4, %0\n\tv_add_f32 %5, %5, %1\n\tv_add_f32 %4, %4, %2\n\tv_add_f32 %5, %5, %3"
                : "+v"(a), "+v"(b), "+v"(c), "+v"(d), "+v"(sa0), "+v"(sa1));
            p[b2][0][r] = a; p[b2][1][r] = b; p[b2][0][r + 1] = c; p[b2][1][r + 1] = d; }
        l[b2] = l[b2] * alpha + (sa0 + sa1);
#pragma unroll
        for (int r = 0; r < 16; ++r) { float t0 = o[b2][0][r], t1 = o[b2][1][r]; asm("v_mul_f32 %0, %0, %1" : "+v"(t0) : "v"(alpha)); asm("v_mul_f32 %0, %0, %1" : "+v"(t1) : "v"(alpha)); o[b2][0][r] = t0; o[b2][1][r] = t1; }
        pw[b2][0] = (u32x4){pk2(p[b2][0][0], p[b2][0][1]), pk2(p[b2][0][2], p[b2][0][3]), pk2(p[b2][0][4], p[b2][0][5]), pk2(p[b2][0][6], p[b2][0][7])};
        pw[b2][1] = (u32x4){pk2(p[b2][0][8], p[b2][0][9]), pk2(p[b2][0][10], p[b2][0][11]), pk2(p[b2][0][12], p[b2][0][13]), pk2(p[b2][0][14], p[b2][0][15])};
        pw[b2][2] = (u32x4){pk2(p[b2][1][0], p[b2][1][1]), pk2(p[b2][1][2], p[b2][1][3]), pk2(p[b2][1][4], p[b2][1][5]), pk2(p[b2][1][6], p[b2][1][7])};
        pw[b2][3] = (u32x4){pk2(p[b2][1][8], p[b2][1][9]), pk2(p[b2][1][10], p[b2][1][11]), pk2(p[b2][1][12], p[b2][1][13]), pk2(p[b2][1][14], p[b2][1][15])};
    }
    asm volatile("s_nop 1" : "+v"(o[0][0]), "+v"(o[0][1]), "+v"(o[1][0]), "+v"(o[1][1]));
}
__device__ __forceinline__ void tile_pv(const LAS char* vp, f32x16 (&o)[2][2], const u32x4 (&pw)[2][4]) {
#pragma unroll
    for (int d0 = 0; d0 < 2; ++d0)
#pragma unroll
        for (int ks = 0; ks < 4; ++ks) { const s16x4 lo = vtr(vp + d0 * 4096 + ks * 1024), hi4 = vtr(vp + d0 * 4096 + ks * 1024 + 512);
            const bf16x8 vf = (bf16x8){lo[0], lo[1], lo[2], lo[3], hi4[0], hi4[1], hi4[2], hi4[3]};
#pragma unroll
            for (int b2 = 0; b2 < 2; ++b2) o[b2][d0] = __builtin_amdgcn_mfma_f32_32x32x16_bf16(vf, __builtin_bit_cast(bf16x8, pw[b2][ks]), o[b2][d0], 0, 0, 0); }
}
template <int MODE> __device__ __forceinline__ void unit2(const Args& A, long rowbase, int qb, LAS char* lds, unsigned lds0) {
    constexpr int ND0 = MODE ? 6 : 4;
    const int tid = pg8::pg8_tid(), lane = tid & 63, r32 = lane & 31, hi = lane >> 5; const int wid = __builtin_amdgcn_readfirstlane(tid >> 6);
    const int q0 = qb * 512, NT = q0 / 64 + 8, nt_w = q0 / 64 + wid + 1;
    bf16x8 qr[2][4];
    LAS char* qrl = lds + L_QR2 + wid * 4096 + lane * 16;
#pragma unroll
    for (int b2 = 0; b2 < 2; ++b2) { const bf16* Qw = A.Q + (rowbase + q0 + wid * 64 + b2 * 32 + r32) * A.qpitch + A.qcol + hi * 8;
#pragma unroll
        for (int d0 = 0; d0 < 4; ++d0) qr[b2][d0] = *(const bf16x8*)(Qw + d0 * 16);
        if (MODE) { *(LAS bf16x8*)(qrl + (b2 * 2) * 1024) = *(const bf16x8*)(Qw + 64); *(LAS bf16x8*)(qrl + (b2 * 2 + 1) * 1024) = *(const bf16x8*)(Qw + 80); } }
    const int koff = lane * A.kpitch + A.kcol + wid * 8, k2off = lane * 32 + (wid & 3) * 8, voff = (16 * (wid & 3) + (lane >> 2)) * A.vpitch + A.vcol + (wid >> 2) * 32 + (lane & 3) * 8;
    const bf16* Kb = A.K + rowbase * A.kpitch; const bf16* K2b = MODE ? A.K2 + rowbase * 32 : nullptr; const bf16* Vb = A.V + rowbase * A.vpitch;
#define FA_DMA(t, slot) do { \
        int ko_ = koff, k2o_ = k2off, vo_ = voff; asm volatile("" : "+v"(ko_), "+v"(k2o_), "+v"(vo_)); \
        glds16(Kb + (long)(t) * 64 * A.kpitch + ko_, (unsigned)__builtin_amdgcn_readfirstlane(lds0 + L_K + (slot) * KSLOT + wid * 1024)); \
        if (MODE && wid < 4) glds16(K2b + (long)(t) * 64 * 32 + k2o_, (unsigned)__builtin_amdgcn_readfirstlane(lds0 + L_K + (slot) * KSLOT + (8 + wid) * 1024)); \
        glds16(Vb + (long)(t) * 64 * A.vpitch + vo_, (unsigned)__builtin_amdgcn_readfirstlane(lds0 + L_V + ((t) % 3) * VSLOT + wid * 1024)); \
        if (!MODE && wid == 4) glds4(A.CB + (t) * 64 + lane, (unsigned)__builtin_amdgcn_readfirstlane(lds0 + L_CB2 + (slot) * 256)); } while (0)
    LAS float* wsf = (LAS float*)(lds + L_WS2) + wid * 128;
    const LAS char* kp0 = lds + L_K + hi * 1024 + r32 * 16;
    const LAS char* vp0 = lds + L_V + ((lane >> 4) & 1) * 32 + (lane & 3) * 8 + (4 * hi + ((lane & 15) >> 2)) * 64;
    float m[2] = {-1e30f, -1e30f}, l[2] = {0.f, 0.f}; f32x16 o[2][2];
#pragma unroll
    for (int b2 = 0; b2 < 2; ++b2) { o[b2][0] = f32x16{}; o[b2][1] = f32x16{}; }
    FA_DMA(0, 0);
    u32x4 pw[2][4];
#define FA_STEP_HEAD(t) FA_WAIT_BAR(); if ((t) + 1 < NT) FA_DMA((t) + 1, ((t) + 1) & 1); const int slot = (t) & 1; const LAS float* cbl = (const LAS float*)(lds + L_CB2 + slot * 256)
    if (wid < 4 || !(MODE ? FA_STAG_MLA : FA_STAG_FOX)) {
        int t = 0;
        for (; t < nt_w - 1; ++t) { FA_STEP_HEAD(t); tile_qs<MODE, false>(kp0 + slot * KSLOT, qr, qrl, cbl, r32, hi, m, l, o, wsf, pw); tile_pv(vp0 + (t % 3) * VSLOT, o, pw); }
        { FA_STEP_HEAD(t); tile_qs<MODE, true>(kp0 + slot * KSLOT, qr, qrl, cbl, r32, hi, m, l, o, wsf, pw); tile_pv(vp0 + (t % 3) * VSLOT, o, pw); ++t; }
        for (; t < NT; ++t) { FA_STEP_HEAD(t); (void)slot; (void)cbl; }
    } else {
        int t = 0;
        if (nt_w > 1) { FA_STEP_HEAD(0); tile_qs<MODE, false>(kp0 + slot * KSLOT, qr, qrl, cbl, r32, hi, m, l, o, wsf, pw); t = 1;
            for (; t < nt_w - 1; ++t) { FA_STEP_HEAD(t); tile_pv(vp0 + ((t - 1) % 3) * VSLOT, o, pw); FA_SBAR(); tile_qs<MODE, false>(kp0 + slot * KSLOT, qr, qrl, cbl, r32, hi, m, l, o, wsf, pw); }
            { FA_STEP_HEAD(t); tile_pv(vp0 + ((t - 1) % 3) * VSLOT, o, pw); FA_SBAR(); tile_qs<MODE, true>(kp0 + slot * KSLOT, qr, qrl, cbl, r32, hi, m, l, o, wsf, pw); ++t; }
        } else { FA_STEP_HEAD(0); tile_qs<MODE, true>(kp0 + slot * KSLOT, qr, qrl, cbl, r32, hi, m, l, o, wsf, pw); t = 1; }
        if (t < NT) { FA_STEP_HEAD(t); (void)slot; (void)cbl; tile_pv(vp0 + ((t - 1) % 3) * VSLOT, o, pw); ++t;
            for (; t < NT; ++t) { FA_STEP_HEAD(t); (void)slot; (void)cbl; } }
        else tile_pv(vp0 + ((NT - 1) % 3) * VSLOT, o, pw);
    }
#undef FA_STEP_HEAD
#pragma unroll
    for (int b2 = 0; b2 < 2; ++b2) {
        float lb = l[b2];
        { auto rr = __builtin_amdgcn_permlane32_swap(__float_as_uint(lb), __float_as_uint(lb), false, false); lb = __uint_as_float(rr[0]) + __uint_as_float(rr[1]); }
        const float rl = __builtin_amdgcn_rcpf(lb); const long grow = rowbase + q0 + wid * 64 + b2 * 32 + r32;
#pragma unroll
        for (int d0 = 0; d0 < 2; ++d0)
#pragma unroll
            for (int g4 = 0; g4 < 4; ++g4) { const int dc = A.ocol + 32 * d0 + 8 * g4 + 4 * hi;
                f32x4 v = (f32x4){o[b2][d0][4 * g4], o[b2][d0][4 * g4 + 1], o[b2][d0][4 * g4 + 2], o[b2][d0][4 * g4 + 3]} * rl;
                if (MODE == 0) { const u32x2 g = *(const u32x2*)(A.G + grow * 1024 + dc);
                    v[0] *= __uint_as_float(g.x << 16); v[1] *= __uint_as_float(g.x & 0xffff0000u); v[2] *= __uint_as_float(g.y << 16); v[3] *= __uint_as_float(g.y & 0xffff0000u); }
                *(u32x2*)(A.O + grow * 1024 + dc) = (u32x2){pk2(v[0], v[1]), pk2(v[2], v[3])}; }
    }
    asm volatile("s_waitcnt lgkmcnt(0)\n\ts_barrier" ::: "memory");
#undef FA_DMA
}
}

namespace a16 {
__device__ __forceinline__ f32x4 mfma16(bf16x8 a, bf16x8 b, f32x4 c) { return __builtin_amdgcn_mfma_f32_16x16x32_bf16(a, b, c, 0, 0, 0); }
template <int NQK, int NDB, class KL, class VL, class SF>
__device__ __forceinline__ void steps(int s0, int s1, const bf16x8 (&qf)[NQK], KL kload, VL vload, SF sfix, float& m, float& l, f32x4 (&o)[NDB], int lane) {
    const int g = lane >> 4;
    for (int s = s0; s < s1; ++s) {
        f32x4 sA = {0.f, 0.f, 0.f, 0.f}, sB = {0.f, 0.f, 0.f, 0.f};
#pragma unroll
        for (int d0 = 0; d0 < NQK; ++d0) { sA = mfma16(kload(s, 0, d0), qf[d0], sA); sB = mfma16(kload(s, 1, d0), qf[d0], sB); }
        sfix(s, sA, sB);
        float mx = __builtin_fmaxf(__builtin_fmaxf(__builtin_fmaxf(sA[0], sA[1]), __builtin_fmaxf(sA[2], sA[3])), __builtin_fmaxf(__builtin_fmaxf(sB[0], sB[1]), __builtin_fmaxf(sB[2], sB[3])));
        mx = __builtin_fmaxf(mx, __shfl_xor(mx, 16)); mx = __builtin_fmaxf(mx, __shfl_xor(mx, 32));
        const float mn = __builtin_fmaxf(m, mx), alpha = ex2(m - mn); m = mn;
        f32x4 pA, pB;
#pragma unroll
        for (int r = 0; r < 4; ++r) { pA[r] = ex2(sA[r] - mn); pB[r] = ex2(sB[r] - mn); }
        float ps = ((pA[0] + pA[1]) + (pA[2] + pA[3])) + ((pB[0] + pB[1]) + (pB[2] + pB[3]));
        ps += __shfl_xor(ps, 16); ps += __shfl_xor(ps, 32);
        l = l * alpha + ps;
        const float a0 = __shfl(alpha, 4 * g), a1 = __shfl(alpha, 4 * g + 1), a2 = __shfl(alpha, 4 * g + 2), a3 = __shfl(alpha, 4 * g + 3);
#pragma unroll
        for (int db = 0; db < NDB; ++db) { o[db][0] *= a0; o[db][1] *= a1; o[db][2] *= a2; o[db][3] *= a3; }
        const u32x4 pw = (u32x4){pk2(pA[0], pA[1]), pk2(pA[2], pA[3]), pk2(pB[0], pB[1]), pk2(pB[2], pB[3])};
        const bf16x8 pf = __builtin_bit_cast(bf16x8, pw);
#pragma unroll
        for (int db = 0; db < NDB; ++db) o[db] = mfma16(pf, vload(s, db), o[db]);
    }
}
__device__ __forceinline__ bf16x8 cvt8(f32x4 a, f32x4 b) { const u32x4 w = (u32x4){pk2(a[0], a[1]), pk2(a[2], a[3]), pk2(b[0], b[1]), pk2(b[2], b[3])}; return __builtin_bit_cast(bf16x8, w); }
__device__ __forceinline__ bf16x8 join8(u32x2 a, u32x2 b) { const u32x4 w = (u32x4){a.x, a.y, b.x, b.y}; return __builtin_bit_cast(bf16x8, w); }
}


namespace xa {
constexpr int TSZ = 16384, L_T = 0, L_WS = 2 * TSZ, L_OST = L_WS + 8 * 64 * 4, L_BYTES = L_OST + 8 * 2048;
#define XA_WAIT_BAR() asm volatile("s_waitcnt vmcnt(0) lgkmcnt(0)\n\ts_barrier" ::: "memory")
template <typename T> __device__ __forceinline__ const T* src_of(const T* Kh, const T* Vh, int pitch, int i, int ci) {
    return (i < 8) ? Kh + (size_t)(32 * i + (ci & 31)) * pitch + (ci >> 5) * 8 : Vh + (size_t)(ci >> 2) * pitch + 32 * (i - 8) + (ci & 3) * 8; }
template <bool F32SRC> __device__ __forceinline__ void unit(const void* Kh_, const void* Vh_, int pitch, const bf16* Q, bf16* O, size_t row0, int hcol, int nvalid_w0, bool only_w0, LAS char* lds, unsigned lds0) {
    const int tid = pg8::pg8_tid(), lane = tid & 63, r32 = lane & 31, hi = lane >> 5; const int wid = __builtin_amdgcn_readfirstlane(tid >> 6);
    const bool active = !only_w0 || wid == 0; const int nvalid = only_w0 ? (wid == 0 ? nvalid_w0 : 0) : 32;
    bf16x8 qr[16];
    { const bf16* Qw = Q + (row0 + wid * 32 + r32) * 1024 + hcol + hi * 8;
#pragma unroll
      for (int d0 = 0; d0 < 16; ++d0) qr[d0] = active ? *(const bf16x8*)(Qw + d0 * 16) : (bf16x8){0, 0, 0, 0, 0, 0, 0, 0}; }
    LAS float* wsf = (LAS float*)(lds + L_WS) + wid * 64;
    f32x4 st[2][2];
#define XA_ISSUE(i) do { if (F32SRC) { _Pragma("unroll") for (int c2 = 0; c2 < 2; ++c2) { const float* s = src_of<float>((const float*)Kh_, (const float*)Vh_, pitch, (i), tid + 512 * c2); st[c2][0] = *(const f32x4*)s; st[c2][1] = *(const f32x4*)(s + 4); } } \
        else { _Pragma("unroll") for (int c2 = 0; c2 < 2; ++c2) fa::glds16(src_of<bf16>((const bf16*)Kh_, (const bf16*)Vh_, pitch, (i), (2 * wid + c2) * 64 + lane), (unsigned)__builtin_amdgcn_readfirstlane(lds0 + L_T + ((i) & 1) * TSZ + (2 * wid + c2) * 1024)); } } while (0)
#define XA_COMMIT(i) do { if (F32SRC) { _Pragma("unroll") for (int c2 = 0; c2 < 2; ++c2) *(LAS u32x4*)(lds + L_T + ((i) & 1) * TSZ + (tid + 512 * c2) * 16) = \
        (u32x4){pk2(st[c2][0][0], st[c2][0][1]), pk2(st[c2][0][2], st[c2][0][3]), pk2(st[c2][1][0], st[c2][1][1]), pk2(st[c2][1][2], st[c2][1][3])}; } } while (0)
    XA_ISSUE(0); XA_COMMIT(0);
    f32x16 S[8];
#pragma unroll
    for (int t = 0; t < 8; ++t) {
        XA_WAIT_BAR(); XA_ISSUE(t + 1);
        const LAS char* kp = lds + L_T + (t & 1) * TSZ + hi * 512 + r32 * 16;
        S[t] = f32x16{};
#pragma unroll
        for (int d0 = 0; d0 < 16; ++d0) S[t] = __builtin_amdgcn_mfma_f32_32x32x16_bf16(*(const LAS bf16x8*)(kp + d0 * 1024), qr[d0], S[t], 0, 0, 0);
        XA_COMMIT(t + 1);
    }
    float mx = S[0][0];
#pragma unroll
    for (int t = 0; t < 8; ++t)
#pragma unroll
        for (int r = 0; r < 16; ++r) mx = __builtin_fmaxf(mx, S[t][r]);
    { auto rr = __builtin_amdgcn_permlane32_swap(__float_as_uint(mx), __float_as_uint(mx), false, false); mx = __builtin_fmaxf(__uint_as_float(rr[0]), __uint_as_float(rr[1])); }
    float l = 0.f; u32x4 pw[16];
#pragma unroll
    for (int t = 0; t < 8; ++t) {
#pragma unroll
        for (int r = 0; r < 16; ++r) { S[t][r] = ex2(S[t][r] - mx); l += S[t][r]; }
        pw[2 * t] = (u32x4){pk2(S[t][0], S[t][1]), pk2(S[t][2], S[t][3]), pk2(S[t][4], S[t][5]), pk2(S[t][6], S[t][7])};
        pw[2 * t + 1] = (u32x4){pk2(S[t][8], S[t][9]), pk2(S[t][10], S[t][11]), pk2(S[t][12], S[t][13]), pk2(S[t][14], S[t][15])}; }
    { auto rr = __builtin_amdgcn_permlane32_swap(__float_as_uint(l), __float_as_uint(l), false, false); l = __uint_as_float(rr[0]) + __uint_as_float(rr[1]); }
    if (hi == 0) wsf[r32] = l;
    float rli[16];
#pragma unroll
    for (int r = 0; r < 16; ++r) rli[r] = __builtin_amdgcn_rcpf(wsf[fa::crow(r, hi)]);
    const int vbl = (int)(lds0 + L_T) + ((lane >> 4) & 1) * 32 + (lane & 3) * 8 + (4 * hi + ((lane & 15) >> 2)) * 64;
    LAS bf16* stg = (LAS bf16*)(lds + L_OST) + wid * 1024;
#pragma unroll
    for (int db = 0; db < 8; ++db) {
        XA_WAIT_BAR(); if (db < 7) XA_ISSUE(8 + db + 1);
        const int vb = vbl + (db & 1) * TSZ;
        f32x16 o = f32x16{};
#pragma unroll
        for (int k4 = 0; k4 < 4; ++k4) { s16x4 vlo[4], vhi[4];
#pragma unroll
            for (int kk = 0; kk < 4; ++kk) {
                asm volatile("ds_read_b64_tr_b16 %0,%1 offset:%c2" : "=&v"(vlo[kk]) : "v"(vb), "i"((k4 * 4 + kk) * 1024) : "memory");
                asm volatile("ds_read_b64_tr_b16 %0,%1 offset:%c2" : "=&v"(vhi[kk]) : "v"(vb), "i"((k4 * 4 + kk) * 1024 + 512) : "memory"); }
            asm volatile("s_waitcnt lgkmcnt(0)" ::: "memory"); __builtin_amdgcn_sched_barrier(0);
#pragma unroll
            for (int kk = 0; kk < 4; ++kk) o = __builtin_amdgcn_mfma_f32_32x32x16_bf16(__builtin_bit_cast(bf16x8, pw[k4 * 4 + kk]),
                (bf16x8){vlo[kk][0], vlo[kk][1], vlo[kk][2], vlo[kk][3], vhi[kk][0], vhi[kk][1], vhi[kk][2], vhi[kk][3]}, o, 0, 0, 0); }
        if (db < 7) XA_COMMIT(8 + db + 1);
#pragma unroll
        for (int r = 0; r < 16; ++r) stg[fa::crow(r, hi) * 32 + r32] = (bf16)(pk2(o[r] * rli[r], 0.f) & 0xffffu);
        LDS_WAIT();
#pragma unroll
        for (int ps = 0; ps < 2; ++ps) { const int row = ps * 16 + (lane >> 2), ch = lane & 3;
            const u32x4 v = *(const LAS u32x4*)(stg + row * 32 + ch * 8);
            if (row < nvalid) *(u32x4*)(O + (row0 + wid * 32 + row) * 1024 + hcol + 32 * db + ch * 8) = v; }
        LDS_WAIT();
    }
    asm volatile("s_waitcnt lgkmcnt(0)\n\ts_barrier" ::: "memory");
#undef XA_ISSUE
#undef XA_COMMIT
}
}

namespace ms {
constexpr int KSZ = 18432, L_T = 0, L_WS = 2 * KSZ, L_OST = L_WS + 8 * 64 * 4, L_BYTES = L_OST + 8 * 4096;
constexpr int PROW = 264;
#define MS_WAIT_BAR() asm volatile("s_waitcnt lgkmcnt(0)\n\ts_barrier" ::: "memory")
__device__ __forceinline__ const float* ms_ksrc(const float* ckvb, const float* krb, int key, int c) {
    const size_t o0 = (size_t)key * 256 + c * 8, o1 = (size_t)key * 32 + (c - 32) * 8; const bool lat = c < 32; return (lat ? ckvb : krb) + (lat ? o0 : o1); }
template <int NK> __device__ __forceinline__ void unit(const float* ckvb, const float* krb, int kclamp, const bf16* QA, float* P, LAS char* lds, unsigned lds0) {
    const int tid = pg8::pg8_tid(), lane = tid & 63, r32 = lane & 31, hi = lane >> 5; const int wid = __builtin_amdgcn_readfirstlane(tid >> 6);
    const bf16* Qw = QA + (size_t)(wid * 32 + r32) * 288 + hi * 8;
    f32x4 st[2][3][2];
#define MS_SRC(i, ci) (((i) < 8) ? ms_ksrc(ckvb, krb, min(32 * (i) + ((ci) & 31), kclamp), (ci) >> 5) \
                                  : ckvb + (size_t)min((ci) >> 2, kclamp) * 256 + 32 * ((i) - 8) + ((ci) & 3) * 8)
#define MS_NCH(i) (((i) < 8) ? 1152 : 1024)
#define MS_ISSUE(i, set) do { _Pragma("unroll") for (int c2 = 0; c2 < 3; ++c2) { const int ci = min(tid + 512 * c2, MS_NCH(i) - 1); const float* s = MS_SRC(i, ci); st[(set) & 1][c2][0] = *(const f32x4*)s; st[(set) & 1][c2][1] = *(const f32x4*)(s + 4); } } while (0)
#define MS_COMMIT(i, slot) do { _Pragma("unroll") for (int c2 = 0; c2 < 3; ++c2) { const int ci = min(tid + 512 * c2, MS_NCH(i) - 1); *(LAS u32x4*)(lds + L_T + ((slot) & 1) * KSZ + ci * 16) = \
        (u32x4){pk2(st[(slot) & 1][c2][0][0], st[(slot) & 1][c2][0][1]), pk2(st[(slot) & 1][c2][0][2], st[(slot) & 1][c2][0][3]), pk2(st[(slot) & 1][c2][1][0], st[(slot) & 1][c2][1][1]), pk2(st[(slot) & 1][c2][1][2], st[(slot) & 1][c2][1][3])}; } } while (0)
    constexpr int FIRSTV = 8;
#define MS_TILE(q) (((q) < NK) ? (q) : FIRSTV + (q) - NK)
    MS_ISSUE(MS_TILE(0), 0); MS_COMMIT(MS_TILE(0), 0); MS_ISSUE(MS_TILE(1), 1);
    f32x16 S[NK];
#pragma unroll
    for (int t = 0; t < NK; ++t) {
        MS_WAIT_BAR(); MS_ISSUE(MS_TILE(t + 2), t + 2);
        const LAS char* kp = lds + L_T + (t & 1) * KSZ + hi * 512 + r32 * 16;
        S[t] = f32x16{}; const bf16* Qt = Qw; asm volatile("" : "+v"(Qt));
#pragma unroll
        for (int d0 = 0; d0 < 18; ++d0) { S[t] = __builtin_amdgcn_mfma_f32_32x32x16_bf16(*(const LAS bf16x8*)(kp + d0 * 1024), *(const bf16x8*)(Qt + d0 * 16), S[t], 0, 0, 0);
            if (d0 % 6 == 5) __builtin_amdgcn_sched_barrier(0); }
        MS_COMMIT(MS_TILE(t + 1), t + 1);
    }
    constexpr int VS0 = (NK & 1);
    if (NK == 1) {
#pragma unroll
        for (int r = 8; r < 16; ++r) S[0][r] = -INFINITY; }
    float mx = S[0][0];
#pragma unroll
    for (int t = 0; t < NK; ++t)
#pragma unroll
        for (int r = 0; r < 16; ++r) mx = __builtin_fmaxf(mx, S[t][r]);
    { auto rr = __builtin_amdgcn_permlane32_swap(__float_as_uint(mx), __float_as_uint(mx), false, false); mx = __builtin_fmaxf(__uint_as_float(rr[0]), __uint_as_float(rr[1])); }
    float l = 0.f; u32x4 pw[2 * NK];
#pragma unroll
    for (int t = 0; t < NK; ++t) {
#pragma unroll
        for (int r = 0; r < 16; ++r) { S[t][r] = ex2(S[t][r] - mx); l += S[t][r]; }
        pw[2 * t] = (u32x4){pk2(S[t][0], S[t][1]), pk2(S[t][2], S[t][3]), pk2(S[t][4], S[t][5]), pk2(S[t][6], S[t][7])};
        pw[2 * t + 1] = (u32x4){pk2(S[t][8], S[t][9]), pk2(S[t][10], S[t][11]), pk2(S[t][12], S[t][13]), pk2(S[t][14], S[t][15])}; }
    { auto rr = __builtin_amdgcn_permlane32_swap(__float_as_uint(l), __float_as_uint(l), false, false); l = __uint_as_float(rr[0]) + __uint_as_float(rr[1]); }
    float* Pw = P + (size_t)(wid * 32) * PROW;
    if (hi == 0) { Pw[(size_t)r32 * PROW + 256] = mx; Pw[(size_t)r32 * PROW + 257] = l; }
    LAS float* stg = (LAS float*)(lds + L_OST) + wid * 1024;
#pragma unroll
    for (int db = 0; db < 8; ++db) {
        MS_WAIT_BAR(); if (db < 6) MS_ISSUE(FIRSTV + db + 2, NK + db + 2);
        const int vb = (int)(lds0 + L_T) + ((VS0 + db) & 1) * KSZ + ((lane >> 4) & 1) * 32 + (lane & 3) * 8 + (4 * hi + ((lane & 15) >> 2)) * 64;
        f32x16 o = f32x16{};
#pragma unroll
        for (int ks = 0; ks < 2 * NK; ++ks) { s16x4 vlo, vhi;
            asm volatile("ds_read_b64_tr_b16 %0,%1 offset:%c2" : "=&v"(vlo) : "v"(vb), "i"(ks * 1024) : "memory");
            asm volatile("ds_read_b64_tr_b16 %0,%1 offset:%c2" : "=&v"(vhi) : "v"(vb), "i"(ks * 1024 + 512) : "memory");
            asm volatile("s_waitcnt lgkmcnt(0)" ::: "memory"); __builtin_amdgcn_sched_barrier(0);
            o = __builtin_amdgcn_mfma_f32_32x32x16_bf16(__builtin_bit_cast(bf16x8, pw[ks]), (bf16x8){vlo[0], vlo[1], vlo[2], vlo[3], vhi[0], vhi[1], vhi[2], vhi[3]}, o, 0, 0, 0); }
#pragma unroll
        for (int r = 0; r < 16; ++r) stg[fa::crow(r, hi) * 32 + r32] = o[r];
        LDS_WAIT();
        { const int row = lane >> 1, cq = (lane & 1) * 16; float* dst = Pw + (size_t)row * PROW + 32 * db + cq;
#pragma unroll
          for (int k = 0; k < 4; ++k) *(f32x4*)(dst + 4 * k) = *(const LAS f32x4*)(stg + row * 32 + cq + 4 * k); }
        if (db < 7) MS_COMMIT(FIRSTV + db + 1, NK + db + 1);
        LDS_WAIT();
    }
    asm volatile("s_waitcnt lgkmcnt(0)\n\ts_barrier" ::: "memory");
#undef MS_SRC
#undef MS_ISSUE
#undef MS_COMMIT
#undef MS_NCH
#undef MS_TILE
}
}

constexpr int RING_OFF = 0, RING_BYTES = 131072;
constexpr int LDSCTL_OFF = RING_BYTES, MISC_OFF = LDSCTL_OFF + 320;
constexpr int LDS_BYTES = 147456;
constexpr int NWAVES = 8;
static_assert(fa::L_BYTES2 <= RING_BYTES && xa::L_BYTES <= RING_BYTES && ms::L_BYTES <= RING_BYTES, "attention LDS");

struct KArgs { const float* in[N_IN]; float* out; unsigned char* ws; int ph_lo, ph_hi; };
static_assert(sizeof(KArgs) == N_IN * 8 + 24, "KArgs has no padding");
typedef const __attribute__((address_space(4))) KArgs* KAP;
#define KA ((KAP)__builtin_amdgcn_kernarg_segment_ptr())

#define XB_TMO      128
#define XB_XCNT(j)  (256  + 64 * (j))
#define XB_XSUB(j)  (1280 + 64 * (j))
#define XB_XGEN(j)  (2304 + 64 * (j))
#define XB_TOP      3328
#define XB_TOPGEN   3392
#define XCD_BAR_WORDS 3456
#define XB_SPIN_CAP (1u << 18)

__device__ __forceinline__ unsigned xb_ld(unsigned* p)              { return __hip_atomic_load(p, __ATOMIC_RELAXED, __HIP_MEMORY_SCOPE_AGENT); }
__device__ __forceinline__ unsigned xb_add(unsigned* p, unsigned v) { return __hip_atomic_fetch_add(p, v, __ATOMIC_RELAXED, __HIP_MEMORY_SCOPE_AGENT); }
__device__ __forceinline__ unsigned xb_xcc_id() { return (unsigned)__builtin_amdgcn_s_getreg((3 << 11) | 20) & 0xFu; }
#define XB_SPIN(cond, bar) do { unsigned _sp = 0; while (cond) { __builtin_amdgcn_s_sleep(1); \
    if ((++_sp & 255u) == 0u) { if (xb_ld(&(bar)[XB_TMO])) break; if (_sp > XB_SPIN_CAP) { atomicAdd(&(bar)[XB_TMO], 1u); break; } } } } while (0)

struct XcdBarrier {
    unsigned* bar; unsigned x;
    volatile LAS unsigned* st;
};

__device__ __forceinline__ XcdBarrier xcd_barrier_post(unsigned* bar, volatile LAS unsigned* st) {
    XcdBarrier b; b.bar = bar; b.x = xb_xcc_id(); b.st = st;
    if (threadIdx.x == 0) (void)xb_add(&bar[XB_XCNT(b.x)], 1u);
    return b;
}
__device__ __forceinline__ void xcd_barrier_complete(unsigned* bar, unsigned x, unsigned& nloc, unsigned& nx) {
    const unsigned G = gridDim.x * gridDim.y * gridDim.z;
    unsigned sum, cnt, mine, sp = 0u;
    for (;;) {
        sum = 0u; cnt = 0u; mine = 0u;
#pragma unroll
        for (unsigned j = 0; j < 16; ++j) { const unsigned c = xb_ld(&bar[XB_XCNT(j)]); sum += c; cnt += (c > 0u) ? 1u : 0u; mine = (j == x) ? c : mine; }
        if (sum == G) break;
        __builtin_amdgcn_s_sleep(1);
        if ((++sp & 255u) == 0u) { if (xb_ld(&bar[XB_TMO])) break; if (sp > XB_SPIN_CAP) { atomicAdd(&bar[XB_TMO], 1u); break; } }
    }
    nloc = mine > 0u ? mine : 1u; nx = cnt > 0u ? cnt : 1u;
}

__device__ __forceinline__ void xcd_barrier(const XcdBarrier& b) {
    asm volatile("s_waitcnt vmcnt(0)" ::: "memory");
    __syncthreads();
    if (threadIdx.x == 0) {
        unsigned* bar = b.bar;
        __builtin_amdgcn_s_waitcnt(0);
        unsigned nloc = b.st[0], nx = b.st[1];
        if (nloc == 0u) { xcd_barrier_complete(bar, b.x, nloc, nx); b.st[0] = nloc; b.st[1] = nx; }
        const unsigned old = xb_add(&bar[XB_XSUB(b.x)], 1u);
        const unsigned gen = old / nloc;
        if (old + 1u == (gen + 1u) * nloc) {
            __builtin_amdgcn_fence(__ATOMIC_RELEASE, "agent");
            asm volatile("s_waitcnt vmcnt(0)" ::: "memory");
            const unsigned og = xb_add(&bar[XB_TOP], 1u);
            const unsigned tg = og / nx;
            if (og + 1u == (tg + 1u) * nx) xb_add(&bar[XB_TOPGEN], 1u);
            else XB_SPIN(xb_ld(&bar[XB_TOPGEN]) == tg, bar);
            __builtin_amdgcn_fence(__ATOMIC_ACQUIRE, "agent");
            xb_add(&bar[XB_XGEN(b.x)], 1u);
            asm volatile("s_waitcnt vmcnt(0)" ::: "memory");
        } else {
            XB_SPIN(xb_ld(&bar[XB_XGEN(b.x)]) == gen, bar);
            __builtin_amdgcn_fence(__ATOMIC_ACQUIRE, "agent");
            asm volatile("s_waitcnt vmcnt(0)" ::: "memory");
        }
    }
    __syncthreads();
}

struct Seg { const float* W; int ldw, c0, ncols, K; bf16* T; int ldt, r0; const float* g; };
__device__ __forceinline__ Seg get_seg(KAP a, unsigned char* ws, int idx) {
    Seg s; s.g = nullptr; s.r0 = 0; s.c0 = 0; s.ldw = 1024; s.ncols = 1024; s.K = 1024; s.ldt = 1024; s.W = nullptr; s.T = nullptr;
    if (idx < 4) { const int j = idx & 1; s.W = a->in[I_WFI] + (size_t)j * 1024 * 4112; s.ldw = 4112; s.T = (bf16*)(ws + WS_WFI) + (size_t)j * 4352 * 1024; s.g = a->in[I_GMIX] + (size_t)(2 * j) * 1024;
        if (idx < 2) { s.c0 = 0; s.ncols = 3072; s.r0 = 0; } else { s.c0 = 3088; s.ncols = 1024; s.r0 = 3072; } }
    else if (idx < 6) { const int j = idx - 4; s.W = a->in[I_WFO] + (size_t)j * 1024 * 1024; s.T = (bf16*)(ws + WS_WFO) + (size_t)j * 1024 * 1024; }
    else if (idx < 12) { const int e = idx - 6, j = e / 3, part = e % 3; s.W = a->in[I_WMA] + (size_t)j * 1024 * 672; s.ldw = 672; s.T = (bf16*)(ws + WS_WMA) + (size_t)j * 768 * 1024; s.g = a->in[I_GMIX] + (size_t)(2 * j + 1) * 1024;
        if (part == 0) { s.c0 = 384; s.ncols = 256; s.r0 = 0; } else if (part == 1) { s.c0 = 0; s.ncols = 384; s.r0 = 256; } else { s.c0 = 640; s.ncols = 32; s.r0 = 640; } }
    else if (idx < 14) { const int j = idx - 12; s.W = a->in[I_WMQB] + (size_t)j * 384 * 1536; s.ldw = 1536; s.ncols = 1536; s.K = 384; s.T = (bf16*)(ws + WS_WMQ) + (size_t)j * 1536 * 384; s.ldt = 384; s.g = a->in[I_GMQ] + (size_t)j * 384; }
    else if (idx < 18) { const int j = idx & 1; const bool raw = idx >= 16; s.W = a->in[I_WMKVB] + (size_t)j * 256 * 2048; s.ldw = 2048; s.ncols = 2048; s.K = 256; s.ldt = 256;
        s.T = (bf16*)(ws + (raw ? WS_WMKVR : WS_WMKV)) + (size_t)j * 2048 * 256; s.g = raw ? nullptr : a->in[I_GMKV] + (size_t)j * 256; }
    else if (idx < 20) { const int j = idx - 18; s.W = a->in[I_WMO] + (size_t)j * 1024 * 1024; s.T = (bf16*)(ws + WS_WMO) + (size_t)j * 1024 * 1024; }
    else if (idx < 24) { const int i = idx - 20; s.W = a->in[I_WXQ] + (size_t)i * 1024 * 1024; s.T = (bf16*)(ws + WS_WXQ) + (size_t)i * 1024 * 1024; s.g = a->in[I_GCROSS] + (size_t)i * 1024; }
    else if (idx < 28) { const int i = idx - 24; s.W = a->in[I_WXO] + (size_t)i * 1024 * 1024; s.T = (bf16*)(ws + WS_WXO) + (size_t)i * 1024 * 1024; }
    else if (idx < 32) { const int i = idx - 28; s.W = a->in[I_WXKV] + (size_t)i * 1024 * 2048; s.ldw = 2048; s.ncols = 2048; s.T = (bf16*)(ws + WS_WXKV) + (size_t)i * 2048 * 1024; s.g = a->in[I_GMEM] + (size_t)i * 1024; }
    else if (idx < 36) { const int i = idx - 32; s.W = a->in[I_WDN] + (size_t)i * 2816 * 1024; s.K = 2816; s.T = (bf16*)(ws + WS_WDN) + (size_t)i * 1024 * 2816; s.ldt = 2816; }
    else if (idx < 212) { const int e = idx - 36, i = e / 44, t = e % 44, pn = t >> 1, half = t & 1; s.W = a->in[I_WGU] + (size_t)i * 1024 * 5632; s.ldw = 5632; s.c0 = half * 2816 + 128 * pn; s.ncols = 128;
        s.T = (bf16*)(ws + WS_WGU) + (size_t)i * 5632 * 1024; s.r0 = 256 * pn + 128 * half; s.g = a->in[I_GFFN] + (size_t)i * 1024; }
    else { const int j = idx - 212; s.W = a->in[I_WFI] + (size_t)j * 1024 * 4112; s.ldw = 4112; s.c0 = 3072; s.ncols = 32; s.T = (bf16*)(ws + WS_WFI) + (size_t)j * 4352 * 1024; s.r0 = 4096; s.g = a->in[I_GMIX] + (size_t)(2 * j) * 1024; }
    return s;
}
constexpr int NSEG = 214;
__device__ __forceinline__ void tr_load(const Seg& s, int item, int lane, float (&v)[32]) {
    const int nnb = s.ncols / 32, kb = item / nnb, nb = item % nnb; const float* p = s.W + (size_t)(64 * kb + (lane >> 5)) * s.ldw + s.c0 + 32 * nb + (lane & 31);
#pragma unroll
    for (int i = 0; i < 32; ++i) v[i] = p[(size_t)(2 * i) * s.ldw];
}
__device__ __forceinline__ void tr_store(const Seg& s, int item, int lane, const float (&v)[32], LAS float* scr) {
    const int nnb = s.ncols / 32, kb = item / nnb, nb = item % nnb, k0 = 64 * kb, n0 = 32 * nb;
#pragma unroll
    for (int i = 0; i < 32; ++i) scr[(2 * i + (lane >> 5)) * 33 + (lane & 31)] = v[i];
    LDS_WAIT(); asm volatile("" ::: "memory");
    const int c = lane & 7; f32x4 g0 = (f32x4){1.f, 1.f, 1.f, 1.f}, g1 = g0;
    if (s.g) { g0 = *(const f32x4*)(s.g + k0 + 8 * c); g1 = *(const f32x4*)(s.g + k0 + 8 * c + 4); }
#pragma unroll
    for (int j = 0; j < 4; ++j) { const int n = (lane >> 3) + 8 * j; const LAS float* p = scr + (8 * c) * 33 + n;
        u32x4 o; o.x = pk2(p[0 * 33] * g0[0], p[1 * 33] * g0[1]); o.y = pk2(p[2 * 33] * g0[2], p[3 * 33] * g0[3]); o.z = pk2(p[4 * 33] * g1[0], p[5 * 33] * g1[1]); o.w = pk2(p[6 * 33] * g1[2], p[7 * 33] * g1[3]);
        *(u32x4*)(s.T + (size_t)(s.r0 + n0 + n) * s.ldt + k0 + 8 * c) = o; }
    LDS_WAIT(); asm volatile("" ::: "memory");
}
__device__ __forceinline__ void cvt_blocks(const float* src, bf16* dst, int nblk, int blk, size_t dstride, int gtid, int nthr) {
    const long total = (long)nblk * blk / 8;
    for (long v = gtid; v < total; v += nthr) { const long e = v * 8; const int b = (int)(e / blk), o = (int)(e % blk);
        const f32x4 x = *(const f32x4*)(src + e), y = *(const f32x4*)(src + e + 4);
        *(u32x4*)(dst + (size_t)b * dstride + o) = (u32x4){pk2(x[0], x[1]), pk2(x[2], x[3]), pk2(y[0], y[1]), pk2(y[2], y[3])}; }
}
__device__ __forceinline__ void p0_prologue(KAP a, LAS unsigned char* lds, int gw, int NGW, int wave, int lane, int pmask) {
    unsigned char* ws = a->ws; const int gtid = gw * 64 + lane, nthr = NGW * 64;
    LAS float* scr = (LAS float*)(lds + RING_OFF + wave * 16384);
#undef P0_PARTS
#define P0_PARTS pmask
    if (P0_PARTS & 1) {
        int total = 0;
        for (int sg = 0; sg < NSEG; ++sg) { const Seg s = get_seg(a, ws, sg); total += (s.K / 64) * (s.ncols / 32); }
        int sg = 0, base = 0; Seg sc = get_seg(a, ws, 0); int nit = (sc.K / 64) * (sc.ncols / 32);
#define P0_ADVANCE(gi) while ((gi) >= base + nit) { base += nit; ++sg; sc = get_seg(a, ws, sg); nit = (sc.K / 64) * (sc.ncols / 32); }
        float va[32], vb[32]; Seg sa = sc, sb = sc; int ia = 0, ib = 0;
        int gi = gw;
        if (gi < total) { P0_ADVANCE(gi); sa = sc; ia = gi - base; tr_load(sa, ia, lane, va); }
        while (gi < total) {
            int gn = gi + NGW;
            if (gn < total) { P0_ADVANCE(gn); sb = sc; ib = gn - base; tr_load(sb, ib, lane, vb); }
            tr_store(sa, ia, lane, va, scr);
            gi = gn; if (gi >= total) break;
            gn = gi + NGW;
            if (gn < total) { P0_ADVANCE(gn); sa = sc; ia = gn - base; tr_load(sa, ia, lane, va); }
            tr_store(sb, ib, lane, vb, scr);
            gi = gn;
        }
#undef P0_ADVANCE
    }
    if (P0_PARTS & 2) {
    cvt_blocks(a->in[I_WMKVB], (bf16*)(ws + WS_WKN), 1, 2 * 256 * 2048, 0, gtid, nthr); }
    if (P0_PARTS & 4) { const u32x4 z = (u32x4){0u, 0u, 0u, 0u};
      for (int v = gtid; v < 2 * 224 * 128; v += nthr) { const int j = v / (224 * 128), r = v % (224 * 128); *(u32x4*)((bf16*)(ws + WS_WFI) + ((size_t)j * 4352 + 4128) * 1024 + (size_t)r * 8) = z; }
      for (int v = gtid; v < 2 * 96 * 128; v += nthr) { const int j = v / (96 * 128), r = v % (96 * 128); *(u32x4*)((bf16*)(ws + WS_WMA) + ((size_t)j * 768 + 672) * 1024 + (size_t)r * 8) = z; }
    }
    if (P0_PARTS & 16) for (int v = gtid; v < 4096 * 16; v += nthr) { const int pos = v >> 4, c = v & 15; const double inv = pow(10000.0, -(double)c / 16.0), ang = (double)pos * inv;
        ((float*)(ws + WS_ROPC))[v] = (float)cos(ang); ((float*)(ws + WS_ROPS))[v] = (float)sin(ang); }
    if (P0_PARTS & 32) for (int row = gw; row < MT; row += NGW) { const float* xr = (row < MP) ? a->in[I_XP] + (size_t)row * 1024 : a->in[I_XS] + (size_t)(row - MP) * 1024;
        float sq = 0.f; bf16* o = (bf16*)(ws + WS_XB) + (size_t)row * 1024;
#pragma unroll
        for (int j = 0; j < 4; ++j) { const f32x4 v = *(const f32x4*)(xr + 256 * j + 4 * lane); sq += pg8::dot4(v); *(u32x2*)(o + 256 * j + 4 * lane) = pg8::pk4(v); }
        sq = wave_sum(sq);
        if (lane < 16) ((float*)(ws + WS_SSQ))[(size_t)row * 16 + lane] = (lane == 0) ? sq : 0.f; }
    if (P0_PARTS & 64) for (int row = gw; row < 2048; row += NGW) { const float* xr = a->in[I_MEM] + (size_t)row * 1024; f32x4 v[4]; float sq = 0.f;
#pragma unroll
        for (int j = 0; j < 4; ++j) { v[j] = *(const f32x4*)(xr + 256 * j + 4 * lane); sq += pg8::dot4(v[j]); }
        const float r = rsqrtf(wave_sum(sq) * (1.0f / 1024.0f) + EPS); bf16* o = (bf16*)(ws + WS_MB) + (size_t)row * 1024;
#pragma unroll
        for (int j = 0; j < 4; ++j) *(u32x2*)(o + 256 * j + 4 * lane) = pg8::pk4(v[j] * r); }
}

__device__ __forceinline__ float ssq_rstd16(const float* ssq, int row) {
    const f32x4 a = *(const f32x4*)(ssq + (size_t)row * 16), b = *(const f32x4*)(ssq + (size_t)row * 16 + 4), c = *(const f32x4*)(ssq + (size_t)row * 16 + 8), d = *(const f32x4*)(ssq + (size_t)row * 16 + 12);
    const float s = ((a[0] + a[1]) + (a[2] + a[3])) + ((b[0] + b[1]) + (b[2] + b[3])) + ((c[0] + c[1]) + (c[2] + c[3])) + ((d[0] + d[1]) + (d[2] + d[3]));
    return rsqrtf(s * (1.0f / 1024.0f) + EPS);
}
__device__ __forceinline__ void cum_local_prompt(KAP a, int bh, LAS float* red, int wave, int lane) {
    unsigned char* ws = a->ws; const float* lfr = (const float*)(ws + WS_LFR); const int b = bh >> 4, h = bh & 15; float* cb = (float*)(ws + WS_CB) + (size_t)bh * 4096;
    float v[8];
#pragma unroll
    for (int k = 0; k < 8; ++k) v[k] = lfr[((size_t)b * 4096 + 512 * wave + 64 * k + lane) * 16 + h];
    float carry = 0.f;
#pragma unroll
    for (int k = 0; k < 8; ++k) {
#pragma unroll
        for (int o = 1; o < 64; o <<= 1) { const float y = __shfl_up(v[k], o); if (lane >= o) v[k] += y; }
        v[k] += carry; carry = __shfl(v[k], 63); }
    if (lane == 0) red[wave] = carry;
    __syncthreads();
    float off = 0.f;
#pragma unroll
    for (int w = 0; w < 7; ++w) off += (w < wave) ? red[w] : 0.f;
#pragma unroll
    for (int k = 0; k < 8; ++k) cb[512 * wave + 64 * k + lane] = -(v[k] + off) * LOG2E;
    VM_WAIT(); __syncthreads();
}
__device__ __forceinline__ void cum_local_sample(KAP a, int L, int pair, LAS float* red, int wave, int lane) {
    unsigned char* ws = a->ws; const float* lfr = (const float*)(ws + WS_LFR); const int bs = pair >> 4, h = pair & 15;
    const float* lfc = a->in[I_CFL] + (size_t)L * 32 * 2048 * 16; float* cb = (float*)(ws + WS_CBS) + (size_t)pair * 2080;
    float x[4], v[4];
#pragma unroll
    for (int k = 0; k < 4; ++k) x[k] = lfc[((size_t)bs * 2048 + 256 * wave + 64 * k + lane) * 16 + h];
    float carry = 0.f;
#pragma unroll
    for (int k = 3; k >= 0; --k) { float t = x[k];
#pragma unroll
        for (int o = 1; o < 64; o <<= 1) { const float y = __shfl_down(t, o); if (lane + o < 64) t += y; }
        v[k] = carry + t - x[k]; carry += __shfl(t, 0); }
    if (lane == 0) red[wave] = carry;
    __syncthreads();
    float off = 0.f;
#pragma unroll
    for (int w = 1; w < 8; ++w) off += (w > wave) ? red[w] : 0.f;
#pragma unroll
    for (int k = 0; k < 4; ++k) cb[256 * wave + 64 * k + lane] = (v[k] + off) * LOG2E;
    if (wave == 0) { float t = (lane < 16) ? lfr[((size_t)MP + bs * 16 + lane) * 16 + h] : 0.f;
#pragma unroll
        for (int o = 1; o < 16; o <<= 1) { const float y = __shfl_up(t, o); if (lane >= o) t += y; }
        if (lane < 32) cb[2048 + lane] = (lane < 16) ? -t * LOG2E : 0.f; }
    VM_WAIT(); __syncthreads();
}
__device__ __forceinline__ void ckv_fixup(KAP a, int L, int gw, int NGW, int lane) {
    unsigned char* ws = a->ws; const f32x4 g = *(const f32x4*)(a->in[I_GMKV] + (size_t)L * 256 + 4 * lane);
    for (int row = gw; row < MT; row += NGW) { const f32x4 s4 = *(const f32x4*)((const float*)(ws + WS_SSQKV) + (size_t)row * 4);
        const float r = rsqrtf(((s4[0] + s4[1]) + (s4[2] + s4[3])) * (1.0f / 256.0f) + EPS);
        const f32x4 v = *(const f32x4*)((const float*)(ws + WS_CKVU) + (size_t)row * 256 + 4 * lane) * r * g;
        if (row < MP) *(f32x4*)(a->out + O_MCP + ((size_t)L * MP + row) * 256 + 4 * lane) = v;
        else { const int rs = row - MP, bs = rs >> 4, t = rs & 15; *(f32x4*)(a->out + O_MCS + ((size_t)L * MS + rs) * 256 + 4 * lane) = v;
            (void)bs; (void)t; } }
}
__device__ __forceinline__ void final_phase(KAP a, int gw, int NGW, int lane) {
    for (int row = gw; row < MT; row += NGW) { const float r = ssq_rstd16((const float*)(a->ws + WS_SSQ), row); float* y = a->out + (size_t)row * 1024; const bf16* x = (const bf16*)(a->ws + WS_XB) + (size_t)row * 1024;
#pragma unroll
        for (int j = 0; j < 4; ++j) { const f32x4 g = *(const f32x4*)(a->in[I_GFINAL] + 256 * j + 4 * lane); const u32x2 w = *(const u32x2*)(x + 256 * j + 4 * lane);
            const f32x4 xv = (f32x4){__builtin_bit_cast(float, w.x << 16), __builtin_bit_cast(float, w.x & 0xffff0000u), __builtin_bit_cast(float, w.y << 16), __builtin_bit_cast(float, w.y & 0xffff0000u)};
            *(f32x4*)(y + 256 * j + 4 * lane) = xv * r * g; } }
}

__device__ __forceinline__ void foxs_item(KAP a, int L, int it, LAS unsigned char* lds, int wid, int lane) {
    unsigned char* ws = a->ws; const int pair = it * 2 + (wid >> 2), b = pair >> 4, h = pair & 15, sp = wid & 3, g = lane >> 4, li = lane & 15;
    const float* ck = a->in[I_CFK] + (size_t)L * 32 * 2048 * 1024 + ((size_t)b * 2048 * 16 + h) * 64;
    const float* cv = a->in[I_CFV] + (size_t)L * 32 * 2048 * 1024 + ((size_t)b * 2048 * 16 + h) * 64;
    const float* cbs = (const float*)(ws + WS_CBS) + (size_t)pair * 2080;
    const bf16* QF = (const bf16*)(ws + WS_QF); const bf16* KF = (const bf16*)(ws + WS_KF); const bf16* VF = (const bf16*)(ws + WS_VF);
    const size_t srow = (size_t)MP + b * 16;
    bf16x8 qf[2];
#pragma unroll
    for (int d0 = 0; d0 < 2; ++d0) qf[d0] = *(const bf16x8*)(QF + (srow + li) * 1024 + h * 64 + 32 * d0 + 8 * g);
    float m = -1e30f, l = 0.f; f32x4 o[4];
#pragma unroll
    for (int db = 0; db < 4; ++db) o[db] = (f32x4){0.f, 0.f, 0.f, 0.f};
    const int kv0 = 512 * sp;
    auto kl = [&](int s, int blk, int d0) -> bf16x8 { const float* p = ck + (size_t)(kv0 + 32 * s + 16 * blk + li) * 1024 + 32 * d0 + 8 * g; return a16::cvt8(*(const f32x4*)p, *(const f32x4*)(p + 4)); };
    auto vl = [&](int s, int db) -> bf16x8 { const float* p = cv + (size_t)(kv0 + 32 * s + 4 * g) * 1024 + 16 * db + li;
        const f32x4 x = (f32x4){p[0], p[1024], p[2048], p[3072]}, y = (f32x4){p[16 * 1024], p[17 * 1024], p[18 * 1024], p[19 * 1024]}; return a16::cvt8(x, y); };
    auto sf = [&](int s, f32x4& sA, f32x4& sB) { const float* p = cbs + kv0 + 32 * s + 4 * g; sA += *(const f32x4*)p; sB += *(const f32x4*)(p + 16); };
    {
        auto kraw = [&](int s, f32x4 (&kr)[8]) {
#pragma unroll
            for (int blk = 0; blk < 2; ++blk)
#pragma unroll
                for (int d0 = 0; d0 < 2; ++d0) { const float* p = ck + (size_t)(kv0 + 32 * s + 16 * blk + li) * 1024 + 32 * d0 + 8 * g; kr[(blk * 2 + d0) * 2] = *(const f32x4*)p; kr[(blk * 2 + d0) * 2 + 1] = *(const f32x4*)(p + 4); } };
        auto vraw = [&](int s, f32x4 (&vr)[8]) {
#pragma unroll
            for (int db = 0; db < 4; ++db) { const float* p = cv + (size_t)(kv0 + 32 * s + 4 * g) * 1024 + 16 * db + li;
                vr[2 * db] = (f32x4){p[0], p[1024], p[2048], p[3072]}; vr[2 * db + 1] = (f32x4){p[16 * 1024], p[17 * 1024], p[18 * 1024], p[19 * 1024]}; } };
        auto step = [&](int s, const f32x4 (&kc)[8], const f32x4 (&vc)[8]) {
            f32x4 sA = {0.f, 0.f, 0.f, 0.f}, sB = {0.f, 0.f, 0.f, 0.f};
#pragma unroll
            for (int d0 = 0; d0 < 2; ++d0) { sA = a16::mfma16(a16::cvt8(kc[d0 * 2], kc[d0 * 2 + 1]), qf[d0], sA); sB = a16::mfma16(a16::cvt8(kc[(2 + d0) * 2], kc[(2 + d0) * 2 + 1]), qf[d0], sB); }
            sf(s, sA, sB);
            float mx = __builtin_fmaxf(__builtin_fmaxf(__builtin_fmaxf(sA[0], sA[1]), __builtin_fmaxf(sA[2], sA[3])), __builtin_fmaxf(__builtin_fmaxf(sB[0], sB[1]), __builtin_fmaxf(sB[2], sB[3])));
            mx = __builtin_fmaxf(mx, __shfl_xor(mx, 16)); mx = __builtin_fmaxf(mx, __shfl_xor(mx, 32));
            const float mn = __builtin_fmaxf(m, mx), alpha = ex2(m - mn); m = mn;
            f32x4 pA, pB;
#pragma unroll
            for (int r = 0; r < 4; ++r) { pA[r] = ex2(sA[r] - mn); pB[r] = ex2(sB[r] - mn); }
            float ps = ((pA[0] + pA[1]) + (pA[2] + pA[3])) + ((pB[0] + pB[1]) + (pB[2] + pB[3]));
            ps += __shfl_xor(ps, 16); ps += __shfl_xor(ps, 32);
            l = l * alpha + ps;
            const float a0 = __shfl(alpha, 4 * g), a1 = __shfl(alpha, 4 * g + 1), a2 = __shfl(alpha, 4 * g + 2), a3 = __shfl(alpha, 4 * g + 3);
#pragma unroll
            for (int db = 0; db < 4; ++db) { o[db][0] *= a0; o[db][1] *= a1; o[db][2] *= a2; o[db][3] *= a3; }
            const u32x4 pw = (u32x4){pk2(pA[0], pA[1]), pk2(pA[2], pA[3]), pk2(pB[0], pB[1]), pk2(pB[2], pB[3])};
            const bf16x8 pf = __builtin_bit_cast(bf16x8, pw);
#pragma unroll
            for (int db = 0; db < 4; ++db) o[db] = a16::mfma16(pf, a16::cvt8(vc[2 * db], vc[2 * db + 1]), o[db]); };
        f32x4 ka[8], va[8], kb[8], vb[8]; kraw(0, ka); vraw(0, va);
#pragma unroll 1
        for (int s = 0; s < 16; s += 2) {
            kraw(s + 1, kb); vraw(s + 1, vb);
            step(s, ka, va);
            const int sn = (s < 14) ? s + 2 : 15; kraw(sn, ka); vraw(sn, va);
            step(s + 1, kb, vb);
        }
    }
    if (sp == 3) {
        auto kl2 = [&](int, int blk, int d0) -> bf16x8 { bf16x8 z = {0, 0, 0, 0, 0, 0, 0, 0}; if (blk == 0) z = *(const bf16x8*)(KF + (srow + li) * 1024 + h * 64 + 32 * d0 + 8 * g); return z; };
        auto vl2 = [&](int, int db) -> bf16x8 { const bf16* p = VF + (srow + 4 * g) * 1024 + h * 64 + 16 * db + li;
            const u32x4 w = (u32x4){(unsigned)p[0] | ((unsigned)p[1024] << 16), (unsigned)p[2048] | ((unsigned)p[3072] << 16), 0u, 0u}; return __builtin_bit_cast(bf16x8, w); };
        auto sf2 = [&](int, f32x4& sA, f32x4& sB) { const f32x4 bb = *(const f32x4*)(cbs + 2048 + 4 * g);
#pragma unroll
            for (int r = 0; r < 4; ++r) { sA[r] = (4 * g + r > li) ? -INFINITY : sA[r] + bb[r]; sB[r] = -INFINITY; } };
        a16::steps<2, 4>(0, 1, qf, kl2, vl2, sf2, m, l, o, lane);
    }
    LAS float* PO = (LAS float*)(lds + RING_OFF) + wid * 1024; LAS float* PM = (LAS float*)(lds + RING_OFF + 32768) + wid * 32;
#pragma unroll
    for (int db = 0; db < 4; ++db)
#pragma unroll
        for (int r = 0; r < 4; ++r) PO[(4 * g + r) * 64 + 16 * db + li] = o[db][r];
    if (g == 0) { PM[li] = m; PM[16 + li] = l; }
    __syncthreads();
    {
        const int w0 = (wid >> 2) * 4, db = wid & 3; const bf16* GF = (const bf16*)(ws + WS_GF); bf16* OF = (bf16*)(ws + WS_OM);
#pragma unroll
        for (int r = 0; r < 4; ++r) { const int q = 4 * g + r; float mm = -1e30f;
#pragma unroll
            for (int s2 = 0; s2 < 4; ++s2) mm = __builtin_fmaxf(mm, ((LAS float*)(lds + RING_OFF + 32768) + (w0 + s2) * 32)[q]);
            float num = 0.f, den = 0.f;
#pragma unroll
            for (int s2 = 0; s2 < 4; ++s2) { LAS float* pm = (LAS float*)(lds + RING_OFF + 32768) + (w0 + s2) * 32; const float wgt = ex2(pm[q] - mm);
                num += wgt * ((LAS float*)(lds + RING_OFF) + (w0 + s2) * 1024)[q * 64 + 16 * db + li]; den += wgt * pm[16 + q]; }
            const size_t idx = (srow + q) * 1024 + h * 64 + 16 * db + li;
            OF[idx] = (bf16)(pk2(num / den * bf2f(GF[idx]), 0.f) & 0xffffu); }
    }
    __syncthreads();
}
__device__ __forceinline__ void mlas_qprime(KAP a, int L, int it, LAS unsigned char* lds, int wid, int lane) {
    unsigned char* ws = a->ws; const int b = (it < 256) ? (it >> 3) : (it - 256), c = (it < 256) ? (it & 7) : 8, g = lane >> 4, li = lane & 15;
    const bf16* QM = (const bf16*)(ws + WS_QM); const bf16* WKN = (const bf16*)(ws + WS_WKN) + (size_t)L * 256 * 2048;
    bf16* QA = (bf16*)(ws + WS_QA) + (size_t)it * 256 * 288;
    LAS bf16* scr = (LAS bf16*)(lds + RING_OFF + wid * 9216);
    for (int hh = 0; hh < 2; ++hh) { const int h = 2 * wid + hh; const bf16* qrow = QM + ((size_t)MP + b * 16 + li) * 1536 + h * 96; bf16* qa = QA + (size_t)(wid * 32 + hh * 16) * 288;
        const bf16x8 qn0 = *(const bf16x8*)(qrow + 8 * g), qn1 = *(const bf16x8*)(qrow + 32 + 8 * g);
#pragma unroll
        for (int cb = 0; cb < 16; ++cb) { const bf16* wp = WKN + (size_t)(16 * cb + li) * 2048 + h * 128 + 8 * g;
            f32x4 acc = a16::mfma16(qn0, *(const bf16x8*)wp, (f32x4){0.f, 0.f, 0.f, 0.f}); acc = a16::mfma16(qn1, *(const bf16x8*)(wp + 32), acc);
#pragma unroll
            for (int r = 0; r < 4; ++r) scr[(4 * g + r) * 288 + 16 * cb + li] = (bf16)(pk2(acc[r], 0.f) & 0xffffu); }
        *(LAS bf16x8*)(scr + li * 288 + 256 + 8 * g) = *(const bf16x8*)(qrow + 64 + 8 * g);
        LDS_WAIT();
#pragma unroll
        for (int j = 0; j < 9; ++j) *(u32x4*)(qa + (size_t)(lane + 64 * j) * 8) = *(const LAS u32x4*)(scr + (lane + 64 * j) * 8);
        LDS_WAIT(); }
    VM_WAIT(); __syncthreads();
}
__device__ __forceinline__ void mlas_attn(KAP a, int L, int it, int qa_it, LAS unsigned char* lds, unsigned lds0) {
    unsigned char* ws = a->ws; const int b = (it < 256) ? (it >> 3) : (it - 256), c = (it < 256) ? (it & 7) : 8; const bf16* QA = (const bf16*)(ws + WS_QA) + (size_t)qa_it * 256 * 288;
    float* P = (float*)(ws + WS_PART) + ((size_t)(b * 9 + c) * 256) * ms::PROW;
    if (c < 8) { const size_t jb = (size_t)L * 32 + b;
        ms::unit<8>(a->in[I_CCKV] + (jb * 2048 + 256 * c) * 256, a->in[I_CKR] + (jb * 2048 + 256 * c) * 32, 255, QA, P, (LAS char*)(lds + RING_OFF), lds0 + RING_OFF);
    } else { const size_t ro = (size_t)L * MS + b * 16;
        ms::unit<1>(a->out + O_MCS + ro * 256, a->out + O_MRS + ro * 32, 15, QA, P, (LAS char*)(lds + RING_OFF), lds0 + RING_OFF); }
}
__device__ __forceinline__ void mlas_combine(KAP a, int L, LAS unsigned char* lds, int gw, int NGW, int wid, int lane) {
    unsigned char* ws = a->ws; LAS bf16* scr = (LAS bf16*)(lds + RING_OFF + wid * 8192);
    const bf16* WV = (const bf16*)(ws + WS_WMKVR) + (size_t)L * 2048 * 256; bf16* OM = (bf16*)(ws + WS_OM); const int g = lane >> 4, li = lane & 15;
    for (int e = gw; e < 512; e += NGW) { const int b = e >> 4, h = e & 15; const int q = lane >> 2, cg = (lane & 3) * 64;
        const float* P0 = (const float*)(ws + WS_PART) + ((size_t)(b * 9) * 256 + (h >> 1) * 32 + (h & 1) * 16 + q) * ms::PROW; constexpr size_t CS = (size_t)256 * ms::PROW;
        float mm = -1e30f;
#pragma unroll
        for (int c = 0; c < 9; ++c) mm = __builtin_fmaxf(mm, P0[c * CS + 256]);
        float wgt[9], den = 0.f;
#pragma unroll
        for (int c = 0; c < 9; ++c) { wgt[c] = ex2(P0[c * CS + 256] - mm); den += wgt[c] * P0[c * CS + 257]; }
        const float id = 1.0f / den;
        for (int j = 0; j < 64; j += 4) { f32x4 acc = (f32x4){0.f, 0.f, 0.f, 0.f};
#pragma unroll
            for (int c = 0; c < 9; ++c) acc += *(const f32x4*)(P0 + c * CS + cg + j) * wgt[c];
            *(LAS u32x2*)(scr + q * 256 + cg + j) = pg8::pk4(acc * id); }
        LDS_WAIT();
        bf16x8 af[8];
#pragma unroll
        for (int d0 = 0; d0 < 8; ++d0) af[d0] = *(const LAS bf16x8*)(scr + li * 256 + 32 * d0 + 8 * g);
#pragma unroll
        for (int db = 0; db < 4; ++db) { f32x4 acc = (f32x4){0.f, 0.f, 0.f, 0.f}; const bf16* wp = WV + (size_t)(h * 128 + 64 + 16 * db + li) * 256 + 8 * g;
#pragma unroll
            for (int d0 = 0; d0 < 8; ++d0) acc = a16::mfma16(af[d0], *(const bf16x8*)(wp + 32 * d0), acc);
            bf16* O = OM + ((size_t)MP + b * 16 + 4 * g) * 1024 + h * 64 + 16 * db + li; const unsigned w0 = pk2(acc[0], acc[1]), w1 = pk2(acc[2], acc[3]);
            O[0] = (bf16)(w0 & 0xffffu); O[1024] = (bf16)(w0 >> 16); O[2048] = (bf16)(w1 & 0xffffu); O[3072] = (bf16)(w1 >> 16); }
        LDS_WAIT();
    }
}
typedef float f32x2v_t __attribute__((ext_vector_type(2)));
template <int K, class F> __device__ __forceinline__ void thin_tiles(const bf16* A, const bf16* Bt, LAS unsigned char* lds, int vcu, int G, int wave, int lane, F epi) {
    const int g = lane >> 4, li = lane & 15; constexpr int nks = K / 256;
    LAS float* part = (LAS float*)(lds + RING_OFF);
#pragma unroll 1
    for (int tt = vcu; tt < 256; tt += G) { const int rb = tt & 31, cgp = tt >> 5;
        const bf16* ap = A + (size_t)(MP + 16 * rb + li) * K + wave * (K / 8) + 8 * g; const bf16* bp = Bt + (size_t)(128 * cgp + li) * K + wave * (K / 8) + 8 * g;
        f32x4 acc[8];
#pragma unroll
        for (int nb = 0; nb < 8; ++nb) acc[nb] = (f32x4){0.f, 0.f, 0.f, 0.f};
#pragma unroll
        for (int s0 = 0; s0 < nks; s0 += 4) { bf16x8 a[4], b[4][8]; const bf16x8 z = {0, 0, 0, 0, 0, 0, 0, 0};
#pragma unroll
            for (int u = 0; u < 4; ++u) { const bool on = s0 + u < nks; a[u] = on ? *(const bf16x8*)(ap + 32 * (s0 + u)) : z;
#pragma unroll
                for (int nb = 0; nb < 8; ++nb) b[u][nb] = on ? *(const bf16x8*)(bp + (size_t)nb * 16 * K + 32 * (s0 + u)) : z; }
#pragma unroll
            for (int u = 0; u < 4; ++u) if (s0 + u < nks)
#pragma unroll
                for (int nb = 0; nb < 8; ++nb) acc[nb] = a16::mfma16(a[u], b[u][nb], acc[nb]); }
#pragma unroll
        for (int nb = 0; nb < 8; ++nb)
#pragma unroll
            for (int r = 0; r < 4; ++r) part[wave * 2048 + (4 * g + r) * 128 + 16 * nb + li] = acc[nb][r];
        __syncthreads();
        const int e = (2 * wave + (lane >> 5)) * 128 + 4 * (lane & 31); f32x4 sv = (f32x4){0.f, 0.f, 0.f, 0.f};
#pragma unroll
        for (int w = 0; w < 8; ++w) sv += *(const LAS f32x4*)(part + w * 2048 + e);
        epi(MP + 16 * rb + 2 * wave + (lane >> 5), 128 * cgp + 4 * (lane & 31), sv);
        __syncthreads(); }
}
template <int K> __device__ __forceinline__ void thin_resid(KAP a, const bf16* A, const bf16* Bt, int first, LAS unsigned char* lds, int vcu, int G, int wave, int lane) {
    unsigned char* ws = a->ws; const float* xs = a->in[I_XS] - (size_t)MP * 1024; bf16* XB = (bf16*)(ws + WS_XB); float* SSQ = (float*)(ws + WS_SSQ);
    thin_tiles<K>(A, Bt, lds, vcu, G, wave, lane, [&](int row, int col, f32x4 v) {
        const size_t o = (size_t)row * 1024 + col; f32x4 x;
        if (first) x = *(const f32x4*)(xs + o);
        else { const u32x2 w = *(const u32x2*)(XB + o); x = (f32x4){__builtin_bit_cast(float, w.x << 16), __builtin_bit_cast(float, w.x & 0xffff0000u), __builtin_bit_cast(float, w.y << 16), __builtin_bit_cast(float, w.y & 0xffff0000u)}; }
        x += v; *(u32x2*)(XB + o) = (u32x2){pk2(x[0], x[1]), pk2(x[2], x[3])};
        float sq = (x[0] * x[0] + x[1] * x[1]) + (x[2] * x[2] + x[3] * x[3]); sq += __shfl_xor(sq, 1); sq += __shfl_xor(sq, 2); sq += __shfl_xor(sq, 4); sq += __shfl_xor(sq, 8);
        if ((lane & 15) == 0) SSQ[(size_t)row * 16 + (col >> 6)] = sq; });
}
__device__ __forceinline__ void thin_xq(KAP a, const bf16* Bt, LAS unsigned char* lds, int vcu, int G, int wave, int lane) {
    unsigned char* ws = a->ws; const bf16* XB = (const bf16*)(ws + WS_XB); bf16* QX = (bf16*)(ws + WS_QX); const float* SSQ = (const float*)(ws + WS_SSQ);
    thin_tiles<1024>(XB, Bt, lds, vcu, G, wave, lane, [&](int row, int col, f32x4 v) {
        const float rs = ssq_rstd16(SSQ, row) * C2_X; *(u32x2*)(QX + (size_t)row * 1024 + col) = (u32x2){pk2(v[0] * rs, v[1] * rs), pk2(v[2] * rs, v[3] * rs)}; });
}
#ifndef DBG_DOUBLE
#define DBG_DOUBLE 0
#endif

constexpr int NPH = 41;
struct Ctx { int lane, wave, G, bx, vcu, gw, NGW; };
__device__ __forceinline__ Ctx mk_ctx() { Ctx c; const int tid = pg8::pg8_tid(); c.lane = tid & 63; c.wave = __builtin_amdgcn_readfirstlane(tid >> 6); int G_ = gridDim.x, bx_ = blockIdx.x; asm volatile("" : "+s"(G_), "+s"(bx_)); c.G = G_; c.bx = bx_;
    c.vcu = (c.G % 8 == 0) ? (c.bx % 8) * (c.G / 8) + c.bx / 8 : c.bx; c.gw = c.vcu * NWAVES + c.wave; c.NGW = c.G * NWAVES; return c; }
#define RSX(ws) pg8::RowScale{(const float*)((ws) + WS_SSQ), 16, 4, 1.0f / 1024.0f}
#define PHASE __device__ __noinline__ void
#define FATPH __device__ __forceinline__ void
__device__ __forceinline__ unsigned char* ws_ptr() { GAS unsigned char* w = (GAS unsigned char*)KA->ws; asm volatile("" : "+s"(w)); return (unsigned char*)w; }
#define WSB(off) ((const bf16*)(ws_ptr() + (off)))
__device__ __forceinline__ const float* in_ptr(int i) { GAS const float* w = (GAS const float*)KA->in[i]; asm volatile("" : "+s"(w)); return (const float*)w; }
__device__ __forceinline__ float* out_ptr() { GAS float* w = (GAS float*)KA->out; asm volatile("" : "+s"(w)); return (float*)w; }

FATPH ph_prologue(KAP a, LAS unsigned char* lds, int pmask) { const Ctx c = mk_ctx(); p0_prologue(a, lds, c.gw, c.NGW, c.wave, c.lane, pmask); __syncthreads(); }
FATPH ph_memkv(LAS unsigned char* lds) { const Ctx c = mk_ctx(); unsigned char* ws = ws_ptr(); float* out = out_ptr();
    pg8::Gemm g{WSB(WS_MB), WSB(WS_WXKV), 2048, 8192, 1024}; pg8::StaticOrder S; S.init(2048, 8192, c.G, c.bx);
    pg8::EpiMemKV E{out + O_MKP, out + O_MVP, (bf16*)(ws + WS_MKB), (bf16*)(ws + WS_MVB)};
    pg8::gemm_phase<pg8::EpiMemKV, pg8::StaticOrder, true, true>(lds + RING_OFF, g, S, E); }
FATPH ph_fox_in(LAS unsigned char* lds, int L) { const Ctx c = mk_ctx(); unsigned char* ws = ws_ptr(); float* out = out_ptr();
    pg8::Gemm g{WSB(WS_XB), WSB(WS_WFI) + (size_t)L * 4352 * 1024, MT, 4352, 1024}; pg8::StaticOrder S; S.init(MT, 4352, c.G, c.bx);
    pg8::EpiFoxIn E{RSX(ws), ws, out, in_ptr(I_BFF) + L * 16, L};
    pg8::gemm_phase<pg8::EpiFoxIn, pg8::StaticOrder, true, true>(lds + RING_OFF, g, S, E); }
FATPH ph_fox_sample(KAP a, LAS unsigned char* lds, int L) { const Ctx c = mk_ctx(); LAS float* red = (LAS float*)(lds + RING_OFF + 65536);
    for (int it = c.vcu; it < 256; it += c.G) { cum_local_sample(a, L, 2 * it, red, c.wave, c.lane); cum_local_sample(a, L, 2 * it + 1, red, c.wave, c.lane); foxs_item(a, L, it, lds, c.wave, c.lane); } }
__device__ __forceinline__ void unit2_of(int e, int& bh, int& qb) { bh = e >> 3; const int k = e & 7, s = (k >> 2) & 1, ii = k & 3, j = 2 * s + (ii >> 1); qb = (ii & 1) ? 7 - j : j; }
__device__ __forceinline__ void unit_of(int e, int& bh, int& qb) { bh = e >> 4; const int k = e & 15, s = (k >> 3) & 1, ii = k & 7, j = 2 * (ii >> 1) + s; qb = (ii & 1) ? 15 - j : j; }
FATPH ph_fox_attn(LAS unsigned char* lds, unsigned lds0) { const Ctx c = mk_ctx(); unsigned char* ws = ws_ptr();
    for (int e0 = c.vcu * 4; e0 < 1024; e0 += c.G * 4) {
        __syncthreads(); cum_local_prompt(KA, e0 >> 3, (LAS float*)(lds + RING_OFF + 65536), c.wave, c.lane);
        for (int i = 0; i < 4; ++i) { int bh, qb; unit2_of(e0 + i, bh, qb); const int b = bh >> 4, h = bh & 15;
            fa::Args A{WSB(WS_QF), 1024, h * 64, WSB(WS_KF), 1024, h * 64, nullptr, WSB(WS_VF), 1024, h * 64, (bf16*)(ws + WS_OM), h * 64,
                       WSB(WS_GF), (const float*)(ws + WS_CB) + (size_t)bh * 4096};
            fa::unit2<0>(A, (long)b * 4096, qb, (LAS char*)(lds + RING_OFF), lds0 + RING_OFF); } } }
FATPH ph_fox_mix(KAP a, LAS unsigned char* lds, unsigned lds0, int L) { const Ctx c = mk_ctx(); unsigned char* ws = ws_ptr(); LAS float* red = (LAS float*)(lds + RING_OFF + 65536);
    const int pos = (c.vcu >> 1) % 5;
    for (int e0 = c.vcu * 4, it = c.vcu; e0 < 1024 || it < 256; e0 += c.G * 4, it += c.G) {
        if (e0 < 1024) { __syncthreads(); cum_local_prompt(a, e0 >> 3, red, c.wave, c.lane); }
#pragma unroll 1
        for (int i = 0; i < 5; ++i) {
            if (i == pos && it < 256) { const Ctx c2 = mk_ctx(); int itv = it; asm volatile("" : "+s"(itv));
                __syncthreads(); cum_local_sample(a, L, 2 * itv, red, c2.wave, c2.lane); cum_local_sample(a, L, 2 * itv + 1, red, c2.wave, c2.lane); foxs_item(a, L, itv, lds, c2.wave, c2.lane); __syncthreads(); }
            if (i < 4 && e0 < 1024) { int ev = e0 + i; asm volatile("" : "+s"(ev)); int bh, qb; unit2_of(ev, bh, qb); const int b = bh >> 4, h = bh & 15;
                fa::Args A{WSB(WS_QF), 1024, h * 64, WSB(WS_KF), 1024, h * 64, nullptr, WSB(WS_VF), 1024, h * 64, (bf16*)(ws + WS_OM), h * 64,
                           WSB(WS_GF), (const float*)(ws + WS_CB) + (size_t)bh * 4096};
                fa::unit2<0>(A, (long)b * 4096, qb, (LAS char*)(lds + RING_OFF), lds0 + RING_OFF); } } } }
template <bool ABLK = false>
FATPH ph_resid(LAS unsigned char* lds, const bf16* A, const bf16* Bt, int K, int first, int dummy = 0) { const Ctx c = mk_ctx(); unsigned char* ws = ws_ptr();
    pg8::Gemm g{A, Bt, MP, 1024, K}; pg8::StaticOrder S; S.init(MP, 1024, c.G, c.bx);
    pg8::EpiResid E{KA->in[I_XP], KA->in[I_XS], first, dummy ? (bf16*)(ws + WS_R1 + (size_t)MT * 4096) : (bf16*)(ws + WS_XB), dummy ? (float*)(ws + WS_R1 + (size_t)MT * 6144) : (float*)(ws + WS_SSQ)};
    pg8::gemm_phase<pg8::EpiResid, pg8::StaticOrder, true, true, ABLK>(lds + RING_OFF, g, S, E); }
FATPH ph_scale_gemm(LAS unsigned char* lds, const bf16* A, const bf16* Bt, int M, int N, int K, const float* ssq, int stride, int ngrp, float inv_n, bf16* O, float scale) { const Ctx c = mk_ctx();
    pg8::Gemm g{A, Bt, M, N, K}; pg8::StaticOrder S; S.init(M, N, c.G, c.bx);
    pg8::EpiScaleBf16 E{pg8::RowScale{ssq, stride, ngrp, inv_n}, O, N, scale};
    pg8::gemm_phase<pg8::EpiScaleBf16, pg8::StaticOrder, true, true>(lds + RING_OFF, g, S, E); }
FATPH ph_cross(LAS unsigned char* lds, unsigned lds0, int layer) { const Ctx c = mk_ctx(); unsigned char* ws = ws_ptr();
    const bf16* QX = WSB(WS_QX); bf16* OX = (bf16*)(ws + WS_OM);
    const bool bal = (c.G == 256); const int nu = bal ? (c.vcu < 128 ? 1 : 3) : 2, ub = bal ? (c.vcu < 128 ? c.vcu : 128 + 3 * (c.vcu - 128)) : c.vcu * 2;
    for (int u0 = ub; u0 < 512; u0 += (bal ? 512 : c.G * 2))
        for (int i = 0; i < nu; ++i) { const int u = u0 + i, bh = u >> 4, qb = u & 15, b = bh >> 2, h = bh & 3; const size_t ko = ((size_t)layer * 2048 + b * 256) * 1024 + h * 256;
            xa::unit<false>(WSB(WS_MKB) + ko, WSB(WS_MVB) + ko, 1024, QX, OX, (size_t)b * 4096 + qb * 256, h * 256, 32, false, (LAS char*)(lds + RING_OFF), lds0 + RING_OFF); }
    for (int e = c.vcu; e < 128; e += c.G) { const int bs = e >> 2, h = e & 3; const size_t ko = ((size_t)(layer * 32 + bs) * 256) * 1024 + h * 256;
        xa::unit<true>(in_ptr(I_CMK) + ko, in_ptr(I_CMV) + ko, 1024, QX, OX, (size_t)MP + bs * 16, h * 256, 16, true, (LAS char*)(lds + RING_OFF), lds0 + RING_OFF); } }
FATPH ph_gu(LAS unsigned char* lds, int layer) { const Ctx c = mk_ctx(); unsigned char* ws = ws_ptr();
    pg8::Gemm g{WSB(WS_XB), WSB(WS_WGU) + (size_t)layer * 5632 * 1024, MT, 5632, 1024}; pg8::StaticOrder S; S.init(MT, 5632, c.G, c.bx);
    pg8::EpiSwiglu E{RSX(ws), (bf16*)(ws + WS_HB)}; pg8::gemm_phase<pg8::EpiSwiglu, pg8::StaticOrder, true, true>(lds + RING_OFF, g, S, E); }
FATPH ph_gu_null(LAS unsigned char* lds, int layer) { const Ctx c = mk_ctx();
    pg8::Gemm g{WSB(WS_XB), WSB(WS_WGU) + (size_t)layer * 5632 * 1024, MT, 5632, 1024}; pg8::StaticOrder S; S.init(MT, 5632, c.G, c.bx);
    pg8::EpiNull E{}; pg8::gemm_phase<pg8::EpiNull, pg8::StaticOrder, true, true>(lds + RING_OFF, g, S, E); }
FATPH ph_mla_a(LAS unsigned char* lds, int L) { const Ctx c = mk_ctx(); unsigned char* ws = ws_ptr(); float* out = out_ptr();
    pg8::Gemm g{WSB(WS_XB), WSB(WS_WMA) + (size_t)L * 768 * 1024, MT, 768, 1024}; pg8::StaticOrder S; S.init(MT, 768, c.G, c.bx);
    pg8::EpiMlaA E{RSX(ws), (float*)(ws + WS_CKVU), (bf16*)(ws + WS_CKVUB), (float*)(ws + WS_SSQKV), (bf16*)(ws + WS_CQ), (float*)(ws + WS_SSQQ), (bf16*)(ws + WS_KRB),
                   out + O_MRP + (size_t)L * MP * 32, out + O_MRS + (size_t)L * MS * 32, (const float*)(ws + WS_ROPC), (const float*)(ws + WS_ROPS)};
    pg8::gemm_phase<pg8::EpiMlaA, pg8::StaticOrder, true, true>(lds + RING_OFF, g, S, E); }
PHASE ph_fixup(KAP a, int L) { const Ctx c = mk_ctx(); ckv_fixup(a, L, c.gw, c.NGW, c.lane); }
FATPH ph_mla_q(LAS unsigned char* lds, int L, int kq) { const Ctx c = mk_ctx(); unsigned char* ws = ws_ptr();
    pg8::Gemm g{WSB(WS_CQ), WSB(WS_WMQ) + (size_t)L * 1536 * 384, MT, 1536, kq}; pg8::StaticOrder S; S.init(MT, 1536, c.G, c.bx);
    pg8::EpiMlaQ E{pg8::RowScale{(const float*)(ws + WS_SSQQ), 8, 2, 1.0f / 384.0f}, (bf16*)(ws + WS_QM), (const float*)(ws + WS_ROPC), (const float*)(ws + WS_ROPS)};
    pg8::gemm_phase<pg8::EpiMlaQ, pg8::StaticOrder, true, false>(lds + RING_OFF, g, S, E); }
PHASE ph_mla_qprime(KAP a, LAS unsigned char* lds, int L, int it) { const Ctx c = mk_ctx(); mlas_qprime(a, L, it, lds, c.wave, c.lane); }
FATPH ph_mla_sample(LAS unsigned char* lds, unsigned lds0, int L) { const Ctx c = mk_ctx(); for (int it = c.vcu; it < 256; it += c.G) { ph_mla_qprime(KA, lds, L, it); mlas_attn(KA, L, it, it, lds, lds0);
        if ((it & 7) == ((it >> 3) & 7)) mlas_attn(KA, L, 256 + (it >> 3), it, lds, lds0); } __syncthreads(); }
FATPH ph_mla_attn(LAS unsigned char* lds, unsigned lds0) { const Ctx c = mk_ctx(); unsigned char* ws = ws_ptr();
    for (int e0 = c.vcu * 4; e0 < 1024; e0 += c.G * 4)
        for (int i = 0; i < 4; ++i) { int bh, qb; unit2_of(e0 + i, bh, qb); const int b = bh >> 4, h = bh & 15;
            fa::Args A{WSB(WS_QM), 1536, h * 96, WSB(WS_KVM), 2048, h * 128, WSB(WS_KRB), WSB(WS_KVM), 2048, h * 128 + 64, (bf16*)(ws + WS_OM), h * 64,
                       nullptr, nullptr};
            fa::unit2<1>(A, (long)b * 4096, qb, (LAS char*)(lds + RING_OFF), lds0 + RING_OFF); } }
FATPH ph_mla_comb(LAS unsigned char* lds, int L) { const Ctx c = mk_ctx(); mlas_combine(KA, L, lds, c.gw, c.NGW, c.wave, c.lane); }
template <int K> FATPH ph_thin_resid(KAP a, LAS unsigned char* lds, const bf16* A, const bf16* Bt, int first) { const Ctx c = mk_ctx(); thin_resid<K>(a, A, Bt, first, lds, c.vcu, c.G, c.wave, c.lane); }
FATPH ph_thin_xq(KAP a, LAS unsigned char* lds, const bf16* Bt) { const Ctx c = mk_ctx(); thin_xq(a, Bt, lds, c.vcu, c.G, c.wave, c.lane); }
PHASE ph_final(KAP a) { const Ctx c = mk_ctx(); final_phase(a, c.gw, c.NGW, c.lane); }
PHASE ph_grid_bar(GAS unsigned* barw, unsigned x, volatile LAS unsigned* st) { XcdBarrier b; b.bar = (unsigned*)barw; b.x = x; b.st = st; xcd_barrier(b); }

__global__ void __launch_bounds__(NWAVES * 64, 2) fwd_kernel(KArgs args) {
    extern __shared__ __attribute__((aligned(16))) unsigned char lds_raw[];
    LAS unsigned char* lds = (LAS unsigned char*)lds_raw;
    volatile LAS unsigned* MISC = (volatile LAS unsigned*)(lds + MISC_OFF);
    const int tid = threadIdx.x;
    const unsigned lds0 = (unsigned)(uintptr_t)lds_raw;
    for (int u = tid; u < (LDS_BYTES - LDSCTL_OFF) / 4; u += NWAVES * 64) ((LAS unsigned*)(lds + LDSCTL_OFF))[u] = 0u;
    __syncthreads();
    const XcdBarrier bar = xcd_barrier_post((unsigned*)(args.ws + WS_CTL) + CW_BAR, MISC + 8);
    const int lo = args.ph_lo, hi = args.ph_hi;
#ifndef DBG_DOUBLE
#define DBG_DOUBLE 0
#endif
#ifndef DBG_P0_AGAIN
#define DBG_P0_AGAIN 0
#endif
#define REP(bit) for (int rep_ = 0; rep_ < ((DBG_DOUBLE & (bit)) ? 2 : 1); ++rep_)
#define IN(k) (lo <= (k) && (k) < hi)
#define SEAM(k) do { if (IN(k) && IN((k) + 1)) { REP(256) ph_grid_bar((GAS unsigned*)bar.bar, bar.x, bar.st); } } while (0)
    if (IN(0)) { ph_prologue(KA, lds, 0x7f); if (DBG_P0_AGAIN) ph_prologue(KA, lds, DBG_P0_AGAIN); }
    SEAM(0);
    if (IN(1)) REP(65536) ph_memkv(lds);
    SEAM(1);
    for (int L = 0; L < 2; ++L) {
        const int pb = 2 + 19 * L;
        if (IN(pb)) { REP(8) ph_fox_in(lds, L); }
        SEAM(pb);
        if (IN(pb + 2)) { if (DBG_DOUBLE & 96) { REP(64) ph_fox_sample(KA, lds, L); REP(32) ph_fox_attn(lds, lds0); } else ph_fox_mix(KA, lds, lds0, L); }
        SEAM(pb + 2);
        if (IN(pb + 3)) { ph_thin_resid<1024>(KA, lds, WSB(WS_OM), WSB(WS_WFO) + (size_t)L * 1024 * 1024, L == 0); if (DBG_DOUBLE & 512) ph_resid(lds, WSB(WS_OM), WSB(WS_WFO) + (size_t)L * 1024 * 1024, 1024, L == 0, 1); ph_resid(lds, WSB(WS_OM), WSB(WS_WFO) + (size_t)L * 1024 * 1024, 1024, L == 0); }
        SEAM(pb + 3);
        for (int sub = 0; sub < 2; ++sub) {
            const int layer = 2 * L + sub, cb = pb + 4 + 10 * sub;
            if (sub == 1) {
                if (IN(pb + 9)) REP(32768) ph_mla_a(lds, L);
                SEAM(pb + 9);
                if (IN(pb + 10)) { ph_fixup(KA, L); REP(32768) ph_mla_q(lds, L, 384);
                    REP(32768)
                    ph_scale_gemm(lds, WSB(WS_CKVUB), WSB(WS_WMKV) + (size_t)L * 2048 * 256, MP, 2048, 256, (const float*)(ws_ptr() + WS_SSQKV), 4, 1, 1.0f / 256.0f, (bf16*)(ws_ptr() + WS_KVM), 1.0f); }
                SEAM(pb + 10);
                if (IN(pb + 11)) { REP(128) ph_mla_sample(lds, lds0, L); REP(32) ph_mla_attn(lds, lds0); }
                SEAM(pb + 11);
                if (IN(pb + 12)) REP(16) ph_mla_comb(lds, L);
                SEAM(pb + 12);
                if (IN(pb + 13)) { ph_thin_resid<1024>(KA, lds, WSB(WS_OM), WSB(WS_WMO) + (size_t)L * 1024 * 1024, 0); if (DBG_DOUBLE & 512) ph_resid(lds, WSB(WS_OM), WSB(WS_WMO) + (size_t)L * 1024 * 1024, 1024, 0, 1); ph_resid(lds, WSB(WS_OM), WSB(WS_WMO) + (size_t)L * 1024 * 1024, 1024, 0); }
                SEAM(pb + 13);
            }
            if (IN(cb)) { REP(131072) ph_thin_xq(KA, lds, WSB(WS_WXQ) + (size_t)layer * 1024 * 1024); REP(16384) ph_scale_gemm(lds, WSB(WS_XB), WSB(WS_WXQ) + (size_t)layer * 1024 * 1024, MP, 1024, 1024, (const float*)(ws_ptr() + WS_SSQ), 16, 4, 1.0f / 1024.0f, (bf16*)(ws_ptr() + WS_QX), C2_X); }
            SEAM(cb);
            if (IN(cb + 1)) REP(2) ph_cross(lds, lds0, layer);
            SEAM(cb + 1);
            if (IN(cb + 2)) { ph_thin_resid<1024>(KA, lds, WSB(WS_OM), WSB(WS_WXO) + (size_t)layer * 1024 * 1024, 0); if (DBG_DOUBLE & 4096) ph_resid(lds, WSB(WS_OM), WSB(WS_WXO) + (size_t)layer * 1024 * 1024, 1024, 0, 1); ph_resid(lds, WSB(WS_OM), WSB(WS_WXO) + (size_t)layer * 1024 * 1024, 1024, 0); }
            SEAM(cb + 2);
            if (IN(cb + 3)) { if (DBG_DOUBLE & 1024) ph_gu_null(lds, layer); REP(8) ph_gu(lds, layer); }
            SEAM(cb + 3);
            if (IN(cb + 4)) { ph_thin_resid<DFF>(KA, lds, WSB(WS_HB), WSB(WS_WDN) + (size_t)layer * 1024 * 2816, 0); if (DBG_DOUBLE & 2048) ph_resid<true>(lds, WSB(WS_HB), WSB(WS_WDN) + (size_t)layer * 1024 * 2816, DFF, 0, 1); ph_resid<true>(lds, WSB(WS_HB), WSB(WS_WDN) + (size_t)layer * 1024 * 2816, DFF, 0); }
            SEAM(cb + 4);
        }
    }
    if (IN(40)) REP(262144) ph_final(KA);
#undef IN
#undef SEAM
}

#ifndef DBG_PH_HI
#define DBG_PH_HI NPH
#endif
#ifndef MK_PER_PHASE
#define MK_PER_PHASE 0
#endif
extern "C" void kernel_launch(void* const* d_in, const int* in_sizes, int n_in, void* d_out, int out_size, void* d_ws, size_t ws_size, hipStream_t stream) {
    static int grid = 0;
    if (grid == 0) {
        if (n_in != N_IN || (size_t)out_size != O_END || ws_size < WS_END) { fprintf(stderr, "kernel_launch: unexpected shapes (n_in %d, out %d, ws %zu; need %d, %zu, %zu)\n", n_in, out_size, ws_size, (int)N_IN, (size_t)O_END, (size_t)WS_END); grid = -1; return; }
        int dev = 0, cus = 0, per_cu = 0;
        if (hipGetDevice(&dev) != hipSuccess || hipDeviceGetAttribute(&cus, hipDeviceAttributeMultiprocessorCount, dev) != hipSuccess) { grid = -1; return; }
        if (hipFuncSetAttribute((const void*)fwd_kernel, hipFuncAttributeMaxDynamicSharedMemorySize, LDS_BYTES) != hipSuccess) { fprintf(stderr, "kernel_launch: hipFuncSetAttribute failed\n"); grid = -1; return; }
        if (hipOccupancyMaxActiveBlocksPerMultiprocessor(&per_cu, (const void*)fwd_kernel, NWAVES * 64, LDS_BYTES) != hipSuccess || per_cu < 1) { fprintf(stderr, "kernel_launch: occupancy query reports %d\n", per_cu); }
        (void)hipGetLastError();
        grid = cus;
    }
    if (grid < 0) return;
    if (hipMemsetAsync((char*)d_ws + WS_CTL, 0, CTL_ZERO_BYTES, stream) != hipSuccess) return;
    KArgs a{};
    for (int i = 0; i < N_IN; ++i) a.in[i] = (const float*)d_in[i];
    a.out = (float*)d_out; a.ws = (unsigned char*)d_ws;
#if MK_PER_PHASE
    for (int p = 0; p < NPH; ++p) { a.ph_lo = p; a.ph_hi = p + 1; hipLaunchKernelGGL(fwd_kernel, dim3(grid), dim3(NWAVES * 64), LDS_BYTES, stream, a); }
#else
    a.ph_lo = 0; a.ph_hi = DBG_PH_HI; hipLaunchKernelGGL(fwd_kernel, dim3(grid), dim3(NWAVES * 64), LDS_BYTES, stream, a);
#endif
}
```

```cpp
#include <hip/hip_runtime.h>
#include <cstdint>
#include <cstdio>
#include <cmath>

constexpr int D = 1024, MP = 32768, MS = 512, MT = MP + MS, SEQ = 4096, NBP = 8, NBS = 32, DSEQ = 16, PAST = 2048, NMEM = 256;
constexpr int DFF = 2816, KPAD = 2112;
constexpr float EPS = 1e-6f, LOG2E = 1.4426950408889634f;
constexpr float C2_FOX = 0.125f * LOG2E, C2_MLA = 0.10206207261596575f * LOG2E, C2_X = 0.0625f * LOG2E;

constexpr size_t O_Y = 0;
constexpr size_t O_FKP = (size_t)MT * D;
constexpr size_t O_FVP = O_FKP + (size_t)2 * MP * 1024;
constexpr size_t O_FLP = O_FVP + (size_t)2 * MP * 1024;
constexpr size_t O_MCP = O_FLP + (size_t)2 * MP * 16;
constexpr size_t O_MRP = O_MCP + (size_t)2 * MP * 256;
constexpr size_t O_MKP = O_MRP + (size_t)2 * MP * 32;
constexpr size_t O_MVP = O_MKP + (size_t)4 * 2048 * 1024;
constexpr size_t O_FKS = O_MVP + (size_t)4 * 2048 * 1024;
constexpr size_t O_FVS = O_FKS + (size_t)2 * MS * 1024;
constexpr size_t O_FLS = O_FVS + (size_t)2 * MS * 1024;
constexpr size_t O_MCS = O_FLS + (size_t)2 * MS * 16;
constexpr size_t O_MRS = O_MCS + (size_t)2 * MS * 256;
constexpr size_t O_END = O_MRS + (size_t)2 * MS * 32;

enum { I_XP = 0, I_XS, I_MEM, I_CFK, I_CFV, I_CFL, I_CCKV, I_CKR, I_CMK, I_CMV, I_GMIX, I_GCROSS, I_GMEM, I_GFFN, I_GFINAL,
       I_WFI, I_BFF, I_WFO, I_WMA, I_GMQ, I_GMKV, I_WMQB, I_WMKVB, I_WMO, I_WXQ, I_WXKV, I_WXO, I_WGU, I_WDN, N_IN };


constexpr size_t al256(size_t x) { return (x + 255) & ~(size_t)255; }
constexpr size_t WS_CTL = 0, CTL_ZERO_BYTES = 1u << 20;
constexpr size_t WS_WFI = 2u << 20;
constexpr size_t WS_WFO = WS_WFI + (size_t)2 * 4352 * 1024 * 2;
constexpr size_t WS_WMA = WS_WFO + (size_t)2 * 1024 * 1024 * 2;
constexpr size_t WS_WMQ = WS_WMA + (size_t)2 * 768 * 1024 * 2;
constexpr size_t WS_WMKV = WS_WMQ + (size_t)2 * 1536 * 384 * 2;
constexpr size_t WS_WMKVR = WS_WMKV + (size_t)2 * 2048 * 256 * 2;
constexpr size_t WS_WKN = WS_WMKVR + (size_t)2 * 2048 * 256 * 2;
constexpr size_t WS_WMO = WS_WKN + (size_t)2 * 256 * 2048 * 2;
constexpr size_t WS_WXQ = WS_WMO + (size_t)2 * 1024 * 1024 * 2;
constexpr size_t WS_WXO = WS_WXQ + (size_t)4 * 1024 * 1024 * 2;
constexpr size_t WS_WXKV = WS_WXO + (size_t)4 * 1024 * 1024 * 2;
constexpr size_t WS_WGU = WS_WXKV + (size_t)4 * 2048 * 1024 * 2;
constexpr size_t WS_WDN = WS_WGU + (size_t)4 * 5632 * 1024 * 2;
constexpr size_t WS_WFF = WS_WDN + (size_t)4 * 1024 * 2816 * 2;
constexpr size_t WS_ROPC = WS_WFF + (size_t)2 * 16 * 1024 * 4;
constexpr size_t WS_ROPS = WS_ROPC + (size_t)4096 * 16 * 4;
constexpr size_t WS_XB = WS_ROPS + (size_t)4096 * 16 * 4;
constexpr size_t WS_SSQ = WS_XB + (size_t)MT * 1024 * 2;
constexpr size_t WS_R1 = al256(WS_SSQ + (size_t)MT * 16 * 4);
constexpr size_t SZ_ACT = (size_t)MT * 1024 * 2;
constexpr size_t WS_QF = WS_R1, WS_KF = WS_R1 + SZ_ACT, WS_VF = WS_R1 + 2 * SZ_ACT, WS_GF = WS_R1 + 3 * SZ_ACT;
constexpr size_t WS_QM = WS_R1, WS_KVM = al256(WS_R1 + (size_t)MT * 1536 * 2);
static_assert(WS_KVM + (size_t)MP * 2048 * 2 <= WS_R1 + 4 * SZ_ACT, "MLA overlay fits");
constexpr size_t WS_OM = WS_R1 + 4 * SZ_ACT;
constexpr size_t WS_LFR = WS_OM + SZ_ACT;
constexpr size_t WS_CB = WS_LFR + (size_t)MT * 16 * 4;
constexpr size_t WS_CBS = WS_CB + (size_t)8 * 16 * 4096 * 4;
constexpr size_t WS_CKVU = al256(WS_CBS + (size_t)32 * 16 * 2080 * 4);
constexpr size_t WS_CKVUB = WS_CKVU + (size_t)MT * 256 * 4;
constexpr size_t WS_SSQKV = WS_CKVUB + (size_t)MT * 256 * 2;
constexpr size_t WS_CQ = WS_SSQKV + (size_t)MT * 4 * 4;
constexpr size_t WS_SSQQ = WS_CQ + (size_t)MT * 384 * 2;
constexpr size_t WS_KRB = WS_SSQQ + (size_t)MT * 8 * 4;
constexpr size_t WS_QA = al256(WS_KRB + (size_t)MT * 32 * 2);
constexpr size_t WS_PART = al256(WS_QA + (size_t)288 * 256 * 288 * 2);
constexpr size_t WS_QX = al256(WS_PART + (size_t)32 * 9 * 256 * 264 * 4);
constexpr size_t WS_MB = WS_QX + SZ_ACT;
constexpr size_t WS_MKB = WS_MB + (size_t)2048 * 1024 * 2;
constexpr size_t WS_MVB = WS_MKB + (size_t)4 * 2048 * 1024 * 2;
constexpr size_t WS_HB = WS_MVB + (size_t)4 * 2048 * 1024 * 2;
constexpr size_t WS_END = WS_HB + (size_t)MT * DFF * 2;
constexpr int CW_BAR = 4096;

namespace pg8 {
#define PG8_LAS __attribute__((address_space(3)))
typedef unsigned short bf16_t;
typedef short bf16x8 __attribute__((ext_vector_type(8)));
typedef float f32x4 __attribute__((ext_vector_type(4)));
typedef unsigned u32x4 __attribute__((ext_vector_type(4)));
constexpr int BM = 256, BK = 64, HALF = 128, HTB = HALF * BK * 2  , STAGE_BYTES = 8 * HTB, NXCD = 8, WGM = 8;

__host__ __device__ __forceinline__ int lds_byte(int r, int c) { const int st = (r >> 4) * 2 + (c >> 5), rr = r & 15, cc = c & 31, ob = rr * 64 + cc * 2; return st * 1024 + (ob ^ (((ob >> 9) & 1) << 5)); }
__host__ __device__ __forceinline__ void stage_rc(int b, int& R, int& C) { const int st = b / 1024, sb = b % 1024, swz = sb ^ (((sb >> 9) & 1) << 5); R = (st >> 1) * 16 + swz / 64; C = (st & 1) * 32 + (swz % 64) / 2; }
__host__ __device__ __forceinline__ int perm32(int rho) { const int n = rho >> 4, i = rho & 15; return 8 * (i >> 2) + 4 * n + (i & 3); }

struct Unit { int pm, pn; };
struct Gemm { const bf16_t* A; const bf16_t* Bt; int M, N, K; };

struct StaticOrder {
    int nM, nN, nwg, G, c;
    __host__ __device__ void init(int M, int N, int G_, int c_) { nM = M / BM; nN = N / BM; nwg = nM * nN; G = G_; c = c_; }
    __host__ __device__ bool next(int i, Unit& u) const {
        const long L = (long)i * G + c; if (L >= nwg) return false;
        int wgid = (int)L; { const int q = nwg / NXCD, r = nwg % NXCD, xcd = wgid % NXCD, off = wgid / NXCD; wgid = (xcd < r ? xcd * (q + 1) : r * (q + 1) + (xcd - r) * q) + off; }
        const int nig = WGM * nN, gid = wgid / nig, fm = gid * WGM, gsz = (nM - fm) < WGM ? (nM - fm) : WGM;
        u.pm = fm + ((wgid % nig) % gsz); u.pn = (wgid % nig) / gsz; return true;
    }
    __device__ __forceinline__ void a_ready(const Unit&) const {}
    __device__ __forceinline__ void done(const Unit&) const {}
};

typedef unsigned u32x2 __attribute__((ext_vector_type(2)));
typedef float f32x2v __attribute__((ext_vector_type(2)));
typedef __bf16 bf16x2_t __attribute__((ext_vector_type(2)));
__device__ __forceinline__ unsigned pk_bf16(float lo, float hi) { f32x2v v = {lo, hi}; bf16x2_t b = __builtin_convertvector(v, bf16x2_t); return __builtin_bit_cast(unsigned, b); }
__device__ __forceinline__ u32x2 pk4(f32x4 v) { u32x2 w; w.x = pk_bf16(v[0], v[1]); w.y = pk_bf16(v[2], v[3]); return w; }
__device__ __forceinline__ float dot4(f32x4 v) { return (v[0] * v[0] + v[1] * v[1]) + (v[2] * v[2] + v[3] * v[3]); }
__device__ __forceinline__ float sigm(float z) { return __builtin_amdgcn_rcpf(1.0f + __builtin_amdgcn_exp2f(-z * LOG2E)); }
#define EPI_FENCE() asm volatile("" ::: "memory")
__device__ __forceinline__ int pg8_tid() { int t = threadIdx.x; asm volatile("" : "+v"(t)); return t; }

struct RowScale { const float* p; int stride; int ngrp; float inv_n;
    __device__ __forceinline__ float get(int row, int fq) const {
        float s = 0.f; if (fq < ngrp) { const f32x4 v = *(const f32x4*)(p + (size_t)row * stride + 4 * fq); s = (v[0] + v[1]) + (v[2] + v[3]); }
        s += __shfl_xor(s, 16); s += __shfl_xor(s, 32); return rsqrtf(s * inv_n + EPS); }
    __device__ __forceinline__ void get8(int row0, int fq, float (&r)[2][4]) const {
        float s[2][4];
#pragma unroll
        for (int ai = 0; ai < 2; ++ai)
#pragma unroll
            for (int m = 0; m < 4; ++m) { s[ai][m] = 0.f; if (fq < ngrp) { const f32x4 v = *(const f32x4*)(p + (size_t)(row0 + ai * HALF + m * 16) * stride + 4 * fq); s[ai][m] = (v[0] + v[1]) + (v[2] + v[3]); } }
#pragma unroll
        for (int ai = 0; ai < 2; ++ai)
#pragma unroll
            for (int m = 0; m < 4; ++m) { float t = s[ai][m]; t += __shfl_xor(t, 16); t += __shfl_xor(t, 32); r[ai][m] = rsqrtf(t * inv_n + EPS); }
    } };
__device__ __forceinline__ int row_pos(int row) { return row < MP ? (row & (SEQ - 1)) : PAST + ((row - MP) & (DSEQ - 1)); }

struct EpiFoxIn { static constexpr bool PERM = false, AFTER_DRAIN = false;
    RowScale rs; unsigned char* ws; float* out; const float* bff; int L;
    __device__ __forceinline__ void operator()(const f32x4 (&acc)[2][2][4][2], const Unit& u, int wr, int wc, int, int) const { const int lane_ = pg8_tid() & 63, fr = lane_ & 15, fq = lane_ >> 4; float rsv[2][4]; rs.get8(u.pm * BM + wr * 64 + fr, fq, rsv);
        const int typ = u.pn >> 2, colt = (u.pn & 3) * 256 + wc * 32 + 4 * fq;
        bf16_t* QF = (bf16_t*)(ws + WS_QF); float* kp = out + O_FKP + (size_t)L * MP * 1024; float* ks = out + O_FKS + (size_t)L * MS * 1024;
#pragma unroll
        for (int ai = 0; ai < 2; ++ai)
#pragma unroll
            for (int m = 0; m < 4; ++m) { const int row = u.pm * BM + ai * HALF + wr * 64 + m * 16 + fr; float r = rsv[ai][m];
                if (typ == 0) { r *= C2_FOX;
#pragma unroll
                    for (int bj = 0; bj < 2; ++bj)
#pragma unroll
                        for (int n = 0; n < 2; ++n) *(u32x2*)(QF + (size_t)row * 1024 + colt + bj * HALF + n * 16) = pk4(acc[ai][bj][m][n] * r);
                } else if (typ == 3) {
#pragma unroll
                    for (int bj = 0; bj < 2; ++bj)
#pragma unroll
                        for (int n = 0; n < 2; ++n) { f32x4 v = acc[ai][bj][m][n] * r; v[0] = sigm(v[0]); v[1] = sigm(v[1]); v[2] = sigm(v[2]); v[3] = sigm(v[3]);
                            *(u32x2*)(QF + 3 * (SZ_ACT / 2) + (size_t)row * 1024 + colt + bj * HALF + n * 16) = pk4(v); }
                } else if (typ == 4) {
                    if (wc == 0) { const f32x4 bb = *(const f32x4*)(bff + 4 * fq); f32x4 lf;
#pragma unroll
                        for (int i = 0; i < 4; ++i) { const float z = acc[ai][0][m][0][i] * r + bb[i]; lf[i] = fminf(z, 0.f) - log1pf(expf(-fabsf(z))); }
                        *(f32x4*)((float*)(ws + WS_LFR) + (size_t)row * 16 + 4 * fq) = lf;
                        float* F = (row < MP) ? out + O_FLP + ((size_t)L * MP + row) * 16 : out + O_FLS + ((size_t)L * MS + (row - MP)) * 16;
                        *(f32x4*)(F + 4 * fq) = lf; }
                } else { bf16_t* B = QF + (size_t)typ * (SZ_ACT / 2);
                    float* F = (row < MP) ? kp + (size_t)(typ - 1) * 2 * MP * 1024 + (size_t)row * 1024 : ks + (size_t)(typ - 1) * 2 * MS * 1024 + (size_t)(row - MP) * 1024;
#pragma unroll
                    for (int bj = 0; bj < 2; ++bj)
#pragma unroll
                        for (int n = 0; n < 2; ++n) { const f32x4 v = acc[ai][bj][m][n] * r; const int c = colt + bj * HALF + n * 16;
                            *(f32x4*)(F + c) = v; *(u32x2*)(B + (size_t)row * 1024 + c) = pk4(v); }
                }
                if (m & 1) EPI_FENCE(); }
    }
};
struct EpiResid { static constexpr bool PERM = true, AFTER_DRAIN = false;
    const float* xin_p; const float* xin_s; int first; bf16_t* xb; float* ssq;
    __device__ __forceinline__ void operator()(const f32x4 (&acc)[2][2][4][2], const Unit& u, int wr, int wc, int, int) const { const int lane_ = pg8_tid() & 63, fr = lane_ & 15, fq = lane_ >> 4;
        const int col0 = u.pn * BM + wc * 32 + 8 * fq;
        if (first) {
#pragma unroll
        for (int ai = 0; ai < 2; ++ai) {
            f32x4 xo[4][2][2];
#pragma unroll
            for (int m = 0; m < 4; ++m) { const int row = u.pm * BM + ai * HALF + wr * 64 + m * 16 + fr;
                const float* xi = (row < MP) ? xin_p + (size_t)row * 1024 : xin_s + (size_t)(row - MP) * 1024;
#pragma unroll
                for (int bj = 0; bj < 2; ++bj)
#pragma unroll
                    for (int n = 0; n < 2; ++n) xo[m][bj][n] = *(const f32x4*)(xi + col0 + bj * HALF + n * 4); }
#pragma unroll
            for (int m = 0; m < 4; ++m) { const int row = u.pm * BM + ai * HALF + wr * 64 + m * 16 + fr; float sq = 0.f;
#pragma unroll
                for (int bj = 0; bj < 2; ++bj) { const int c = col0 + bj * HALF; const f32x4 x0 = xo[m][bj][0] + acc[ai][bj][m][0], x1 = xo[m][bj][1] + acc[ai][bj][m][1];
                    sq += dot4(x0) + dot4(x1);
                    const u32x2 w0 = pk4(x0), w1 = pk4(x1); *(u32x4*)(xb + (size_t)row * 1024 + c) = (u32x4){w0.x, w0.y, w1.x, w1.y}; }
                sq += __shfl_xor(sq, 16); sq += __shfl_xor(sq, 32);
                if (fq == 0) ssq[(size_t)row * 16 + u.pn * 4 + wc] = sq; }
            EPI_FENCE(); }
        } else {
            u32x4 raw[2][4][2];
#pragma unroll
            for (int ai = 0; ai < 2; ++ai)
#pragma unroll
                for (int m = 0; m < 4; ++m) { const int row = u.pm * BM + ai * HALF + wr * 64 + m * 16 + fr;
#pragma unroll
                    for (int bj = 0; bj < 2; ++bj) raw[ai][m][bj] = *(const u32x4*)(xb + (size_t)row * 1024 + col0 + bj * HALF); }
            EPI_FENCE();
#pragma unroll
            for (int ai = 0; ai < 2; ++ai) {
#pragma unroll
                for (int m = 0; m < 4; ++m) { const int row = u.pm * BM + ai * HALF + wr * 64 + m * 16 + fr; float sq = 0.f;
#pragma unroll
                    for (int bj = 0; bj < 2; ++bj) { const int c = col0 + bj * HALF; const u32x4 w = raw[ai][m][bj];
                        const f32x4 x0 = (f32x4){__builtin_bit_cast(float, w.x << 16), __builtin_bit_cast(float, w.x & 0xffff0000u), __builtin_bit_cast(float, w.y << 16), __builtin_bit_cast(float, w.y & 0xffff0000u)} + acc[ai][bj][m][0];
                        const f32x4 x1 = (f32x4){__builtin_bit_cast(float, w.z << 16), __builtin_bit_cast(float, w.z & 0xffff0000u), __builtin_bit_cast(float, w.w << 16), __builtin_bit_cast(float, w.w & 0xffff0000u)} + acc[ai][bj][m][1];
                        sq += dot4(x0) + dot4(x1);
                        const u32x2 w0 = pk4(x0), w1 = pk4(x1); *(u32x4*)(xb + (size_t)row * 1024 + c) = (u32x4){w0.x, w0.y, w1.x, w1.y}; }
                    sq += __shfl_xor(sq, 16); sq += __shfl_xor(sq, 32);
                    if (fq == 0) ssq[(size_t)row * 16 + u.pn * 4 + wc] = sq; }
                EPI_FENCE(); } }
    }
};
struct EpiScaleBf16 { static constexpr bool PERM = true, AFTER_DRAIN = false;
    RowScale rs; bf16_t* O; int ldc; float scale;
    __device__ __forceinline__ void operator()(const f32x4 (&acc)[2][2][4][2], const Unit& u, int wr, int wc, int, int) const { const int lane_ = pg8_tid() & 63, fr = lane_ & 15, fq = lane_ >> 4; float rsv[2][4]; rs.get8(u.pm * BM + wr * 64 + fr, fq, rsv);
        const int col0 = u.pn * BM + wc * 32 + 8 * fq;
#pragma unroll
        for (int ai = 0; ai < 2; ++ai)
#pragma unroll
            for (int m = 0; m < 4; ++m) { const int row = u.pm * BM + ai * HALF + wr * 64 + m * 16 + fr; const float r = rsv[ai][m] * scale;
#pragma unroll
                for (int bj = 0; bj < 2; ++bj) { const u32x2 w0 = pk4(acc[ai][bj][m][0] * r), w1 = pk4(acc[ai][bj][m][1] * r);
                    *(u32x4*)(O + (size_t)row * ldc + col0 + bj * HALF) = (u32x4){w0.x, w0.y, w1.x, w1.y}; }
                if (m & 1) EPI_FENCE(); }
    }
};
struct EpiSwiglu { static constexpr bool PERM = true, AFTER_DRAIN = false;
    RowScale rs; bf16_t* HB;
    __device__ __forceinline__ void operator()(const f32x4 (&acc)[2][2][4][2], const Unit& u, int wr, int wc, int, int) const { const int lane_ = pg8_tid() & 63, fr = lane_ & 15, fq = lane_ >> 4; float rsv[2][4]; rs.get8(u.pm * BM + wr * 64 + fr, fq, rsv);
        const int col0 = u.pn * HALF + wc * 32 + 8 * fq;
        const bool blk = u.pm < MP / BM; const int rstr = blk ? 128 : DFF * 2;
        const size_t hb0 = blk ? ((size_t)(u.pm * (DFF / 64) + (col0 >> 6)) * 32768 + (size_t)(col0 & 63) * 2) : ((size_t)u.pm * BM * DFF + col0) * 2;
#pragma unroll
        for (int ai = 0; ai < 2; ++ai)
#pragma unroll
            for (int m = 0; m < 4; ++m) { const int row = u.pm * BM + ai * HALF + wr * 64 + m * 16 + fr; const float r = rsv[ai][m]; u32x4 w;
#pragma unroll
                for (int n = 0; n < 2; ++n) { const f32x4 g = acc[ai][0][m][n] * r, uu = acc[ai][1][m][n] * r; f32x4 h;
#pragma unroll
                    for (int i = 0; i < 4; ++i) h[i] = g[i] * sigm(g[i]) * uu[i];
                    const u32x2 hw = pk4(h); if (n == 0) { w.x = hw.x; w.y = hw.y; } else { w.z = hw.x; w.w = hw.y; } }
                *(u32x4*)((char*)HB + hb0 + (size_t)(row - u.pm * BM) * rstr) = w;
                if (m & 1) EPI_FENCE(); }
    }
};
struct EpiMlaA { static constexpr bool PERM = false, AFTER_DRAIN = false;
    RowScale rs; float* ckvu; bf16_t* ckvub; float* ssqkv; bf16_t* cq; float* ssqq; bf16_t* krb; float *mrp, *mrs; const float *ropc, *rops;
    __device__ __forceinline__ void operator()(const f32x4 (&acc)[2][2][4][2], const Unit& u, int wr, int wc, int, int) const { const int lane_ = pg8_tid() & 63, fr = lane_ & 15, fq = lane_ >> 4; float rsv[2][4]; rs.get8(u.pm * BM + wr * 64 + fr, fq, rsv);
        const int cw = wc * 32 + 4 * fq;
#pragma unroll
        for (int ai = 0; ai < 2; ++ai)
#pragma unroll
            for (int m = 0; m < 4; ++m) { const int row = u.pm * BM + ai * HALF + wr * 64 + m * 16 + fr; const float r = rsv[ai][m];
                if (u.pn == 0) { float sq = 0.f;
#pragma unroll
                    for (int bj = 0; bj < 2; ++bj)
#pragma unroll
                        for (int n = 0; n < 2; ++n) { const int c = cw + bj * HALF + n * 16; const f32x4 v = acc[ai][bj][m][n] * r;
                            *(f32x4*)(ckvu + (size_t)row * 256 + c) = v; *(u32x2*)(ckvub + (size_t)row * 256 + c) = pk4(v); sq += dot4(v); }
                    sq += __shfl_xor(sq, 16); sq += __shfl_xor(sq, 32); if (fq == 0) ssqkv[(size_t)row * 4 + wc] = sq;
                } else if (u.pn == 1) { float sq = 0.f;
#pragma unroll
                    for (int bj = 0; bj < 2; ++bj)
#pragma unroll
                        for (int n = 0; n < 2; ++n) { const int c = cw + bj * HALF + n * 16; const f32x4 v = acc[ai][bj][m][n] * r;
                            *(u32x2*)(cq + (size_t)row * 384 + c) = pk4(v); sq += dot4(v); }
                    sq += __shfl_xor(sq, 16); sq += __shfl_xor(sq, 32); if (fq == 0) ssqq[(size_t)row * 8 + wc] = sq;
                } else { float sq = 0.f;
#pragma unroll
                    for (int n = 0; n < 2; ++n) { const int c = 256 + cw + n * 16; const f32x4 v = acc[ai][0][m][n] * r;
                        *(u32x2*)(cq + (size_t)row * 384 + c) = pk4(v); sq += dot4(v); }
                    sq += __shfl_xor(sq, 16); sq += __shfl_xor(sq, 32); if (fq == 0) ssqq[(size_t)row * 8 + 4 + wc] = sq;
                    if (wc == 0) { const int pos = row_pos(row); const f32x4 cs = *(const f32x4*)(ropc + pos * 16 + 4 * fq), sn = *(const f32x4*)(rops + pos * 16 + 4 * fq);
                        const f32x4 x1 = acc[ai][1][m][0] * r, x2 = acc[ai][1][m][1] * r; const f32x4 o1 = x1 * cs - x2 * sn, o2 = x1 * sn + x2 * cs;
                        *(u32x2*)(krb + (size_t)row * 32 + 4 * fq) = pk4(o1); *(u32x2*)(krb + (size_t)row * 32 + 16 + 4 * fq) = pk4(o2);
                        float* F = (row < MP) ? mrp + (size_t)row * 32 : mrs + (size_t)(row - MP) * 32;
                        *(f32x4*)(F + 4 * fq) = o1; *(f32x4*)(F + 16 + 4 * fq) = o2; }
                }
                if (m & 1) EPI_FENCE(); }
    }
};
struct EpiMlaQ { static constexpr bool PERM = false, AFTER_DRAIN = false;
    RowScale rs; bf16_t* QM; const float *ropc, *rops;
    __device__ __forceinline__ void operator()(const f32x4 (&acc)[2][2][4][2], const Unit& u, int wr, int wc, int, int) const { const int lane_ = pg8_tid() & 63, fr = lane_ & 15, fq = lane_ >> 4; float rsv[2][4]; rs.get8(u.pm * BM + wr * 64 + fr, fq, rsv);
#pragma unroll
        for (int ai = 0; ai < 2; ++ai)
#pragma unroll
            for (int m = 0; m < 4; ++m) { const int row = u.pm * BM + ai * HALF + wr * 64 + m * 16 + fr; const float r = rsv[ai][m] * C2_MLA;
                const int pos = row_pos(row);
#pragma unroll
                for (int bj = 0; bj < 2; ++bj) { const int g32 = u.pn * 8 + bj * 4 + wc; const int c = g32 * 32 + 4 * fq; bf16_t* o = QM + (size_t)row * 1536 + c;
                    if ((g32 % 3) == 2) { const f32x4 cs = *(const f32x4*)(ropc + pos * 16 + 4 * fq), sn = *(const f32x4*)(rops + pos * 16 + 4 * fq);
                        const f32x4 x1 = acc[ai][bj][m][0] * r, x2 = acc[ai][bj][m][1] * r;
                        *(u32x2*)(o) = pk4(x1 * cs - x2 * sn); *(u32x2*)(o + 16) = pk4(x1 * sn + x2 * cs);
                    } else { *(u32x2*)(o) = pk4(acc[ai][bj][m][0] * r); *(u32x2*)(o + 16) = pk4(acc[ai][bj][m][1] * r); } }
                EPI_FENCE(); }
    }
};
struct EpiNull { static constexpr bool PERM = true, AFTER_DRAIN = false;
    __device__ __forceinline__ void operator()(const f32x4 (&acc)[2][2][4][2], const Unit&, int, int, int, int) const {
#pragma unroll
        for (int ai = 0; ai < 2; ++ai)
#pragma unroll
            for (int bj = 0; bj < 2; ++bj)
#pragma unroll
                for (int m = 0; m < 4; ++m)
#pragma unroll
                    for (int n = 0; n < 2; ++n) asm volatile("" :: "v"(acc[ai][bj][m][n])); }
};
struct EpiMemKV { static constexpr bool PERM = false, AFTER_DRAIN = false;
    float* outk; float* outv; bf16_t* MKB; bf16_t* MVB;
    __device__ __forceinline__ void operator()(const f32x4 (&acc)[2][2][4][2], const Unit& u, int wr, int wc, int, int) const { const int lane_ = pg8_tid() & 63, fr = lane_ & 15, fq = lane_ >> 4;
        const int l = u.pn >> 3, cw0 = (u.pn & 7) * 256; const bool isv = cw0 >= 1024; const int cbase = (cw0 & 1023) + wc * 32 + 4 * fq;
#pragma unroll
        for (int ai = 0; ai < 2; ++ai)
#pragma unroll
            for (int m = 0; m < 4; ++m) { const int row = u.pm * BM + ai * HALF + wr * 64 + m * 16 + fr; const int b = row >> 8, nn = row & 255;
#pragma unroll
                for (int bj = 0; bj < 2; ++bj)
#pragma unroll
                    for (int n = 0; n < 2; ++n) { const int c = cbase + bj * HALF + n * 16; const f32x4 v = acc[ai][bj][m][n]; const size_t o = ((size_t)l * 2048 + row) * 1024 + c;
                        if (!isv) { *(f32x4*)(outk + o) = v; *(u32x2*)(MKB + o) = pk4(v); } else { *(f32x4*)(outv + o) = v; *(u32x2*)(MVB + o) = pk4(v); } }
                if (m & 1) EPI_FENCE(); }
    }
};

template <class Epi, class Sched, bool ALIGN_EPI = false, bool SP2 = false, bool ABLK = false>
__device__ __forceinline__ void gemm_phase(PG8_LAS unsigned char* lds, const Gemm g, const Sched& S, const Epi& E) {
    const int tid = pg8_tid(), wid = __builtin_amdgcn_readfirstlane(tid >> 6), lane = tid & 63, wr = wid >> 2, wc = wid & 3, fr = lane & 15, fq = lane >> 4;
    const int K = g.K, nt = K / BK;
    unsigned voffA[2], voffB[2];
#pragma unroll
    for (int i = 0; i < 2; ++i) { int R, C; stage_rc(tid * 16 + i * 8192, R, C); const int Rb = Epi::PERM ? ((R & ~31) + perm32(R & 31)) : R;
        voffA[i] = ABLK ? (unsigned)(R * BK + C) * 2u : (unsigned)(R * K + C) * 2u; voffB[i] = (unsigned)(Rb * K + C) * 2u; }
    const size_t kstep = (size_t)(BK * 2);
    const size_t hstep = (size_t)HALF * K * 2;
    const size_t tstep = 2 * hstep;
    const size_t kstepA = ABLK ? (size_t)BM * BK * 2 : kstep, hstepA = ABLK ? (size_t)HALF * BK * 2 : hstep, tstepA = ABLK ? (size_t)nt * BM * BK * 2 : tstep;
    const unsigned ldsw = (unsigned)wid * 1024u;
    const int aoff = lds_byte(wr * 64 + fr, fq * 8), boff = lds_byte(wc * 32 + fr, fq * 8);
#define PG8_SA(b, h) (((b) * 2 + (h)) * HTB)
#define PG8_SB(b, h) ((4 + (b) * 2 + (h)) * HTB)
#define PG8_STAGE(bufoff, gbase, voff) do { _Pragma("unroll") for (int _i = 0; _i < 2; ++_i) \
        __builtin_amdgcn_global_load_lds((const unsigned*)((const char*)(gbase) + (voff)[_i]), (PG8_LAS unsigned*)(lds + (bufoff) + ldsw + _i * 8192), 16, 0, 0); } while (0)
#define PG8_LDA(dst, b, h) do { _Pragma("unroll") for (int m = 0; m < 4; ++m) _Pragma("unroll") for (int k = 0; k < 2; ++k) dst[m][k] = *(const PG8_LAS bf16x8*)(lds + PG8_SA(b, h) + aoff + m * 2048 + k * 1024); } while (0)
#define PG8_LDB(dst, b, h) do { _Pragma("unroll") for (int n = 0; n < 2; ++n) _Pragma("unroll") for (int k = 0; k < 2; ++k) dst[n][k] = *(const PG8_LAS bf16x8*)(lds + PG8_SB(b, h) + boff + n * 2048 + k * 1024); } while (0)
#define PG8_MMA(ai, bj, At, Bt) do { __builtin_amdgcn_s_setprio(1); _Pragma("unroll") for (int m = 0; m < 4; ++m) _Pragma("unroll") for (int n = 0; n < 2; ++n) _Pragma("unroll") for (int k = 0; k < 2; ++k) \
        acc[ai][bj][m][n] = __builtin_amdgcn_mfma_f32_16x16x32_bf16(Bt[n][k], At[m][k], acc[ai][bj][m][n], 0, 0, 0); __builtin_amdgcn_s_setprio(0); } while (0)
#define PG8_WAIT_V(n) asm volatile("s_waitcnt vmcnt(" #n ")" ::: "memory")
#define PG8_WAIT_L(n) asm volatile("s_waitcnt lgkmcnt(" #n ")" ::: "memory")
#define PG8_BAR __builtin_amdgcn_s_barrier()
#define PG8_SCHED __builtin_amdgcn_sched_barrier(0)
    Unit cur, nxt; int ui = 0;
    if (!S.next(0, cur)) return;
    f32x4 acc[2][2][4][2];
#pragma unroll
    for (int a = 0; a < 2; ++a)
#pragma unroll
        for (int b = 0; b < 2; ++b)
#pragma unroll
            for (int m = 0; m < 4; ++m)
#pragma unroll
                for (int n = 0; n < 2; ++n) acc[a][b][m][n] = (f32x4){0.f, 0.f, 0.f, 0.f};
    bf16x8 At[4][2], B0[2][2], B1[2][2];
    const char* cA = (const char*)g.A + (size_t)cur.pm * tstepA; const char* cB = (const char*)g.Bt + (size_t)cur.pn * tstep;
    S.a_ready(cur);
    if constexpr (SP2) {
        PG8_STAGE(PG8_SB(0, 0), cB, voffB); PG8_STAGE(PG8_SB(0, 1), cB + hstep, voffB); PG8_STAGE(PG8_SA(0, 0), cA, voffA); PG8_STAGE(PG8_SA(0, 1), cA + hstepA, voffA);
        if (wr == 1) PG8_BAR;
        PG8_WAIT_V(2); PG8_BAR;
        PG8_STAGE(PG8_SB(1, 0), cB + kstep, voffB); PG8_STAGE(PG8_SA(1, 0), cA + kstepA, voffA); PG8_STAGE(PG8_SB(1, 1), cB + hstep + kstep, voffB);
        PG8_WAIT_V(6); PG8_BAR;
    } else {
        PG8_STAGE(PG8_SB(0, 0), cB, voffB); PG8_STAGE(PG8_SA(0, 0), cA, voffA); PG8_STAGE(PG8_SB(0, 1), cB + hstep, voffB); PG8_STAGE(PG8_SA(0, 1), cA + hstepA, voffA);
        if (wr == 1) PG8_BAR;
        PG8_WAIT_V(4); PG8_BAR;
        PG8_STAGE(PG8_SB(1, 0), cB + kstep, voffB); PG8_STAGE(PG8_SA(1, 0), cA + kstepA, voffA); PG8_STAGE(PG8_SB(1, 1), cB + hstep + kstep, voffB);
        PG8_WAIT_V(6); PG8_BAR;
    }
    for (;;) {
        const bool has_next = S.next(ui + 1, nxt);
        const char* nA = has_next ? (const char*)g.A + (size_t)nxt.pm * tstepA : cA; const char* nB = has_next ? (const char*)g.Bt + (size_t)nxt.pn * tstep : cB;
        for (int t = 0; t < nt; t += 2) {
            const bool last = (t == nt - 2);
            const char* a1 = cA + (size_t)(t + 1) * kstepA;
            const char* a2 = last ? nA : cA + (size_t)(t + 2) * kstepA; const char* b2 = last ? nB : cB + (size_t)(t + 2) * kstep;
            const char* a3 = a2 + kstepA; const char* b3 = b2 + kstep;
            if (last && has_next) S.a_ready(nxt);
            if constexpr (SP2) {
            PG8_LDB(B0, 0, 0); PG8_LDB(B1, 0, 1); PG8_SCHED; PG8_LDA(At, 0, 0); PG8_STAGE(PG8_SA(1, 1), a1 + hstepA, voffA);
            PG8_WAIT_V(8); PG8_WAIT_L(0); PG8_BAR; PG8_MMA(0, 0, At, B0); PG8_MMA(0, 1, At, B1); PG8_BAR; PG8_SCHED;
            PG8_LDA(At, 0, 1); PG8_STAGE(PG8_SB(0, 0), b2, voffB); PG8_STAGE(PG8_SB(0, 1), b2 + hstep, voffB); PG8_STAGE(PG8_SA(0, 0), a2, voffA);
            PG8_WAIT_V(8); PG8_WAIT_L(0); PG8_BAR; PG8_MMA(1, 0, At, B0); PG8_MMA(1, 1, At, B1); PG8_BAR; PG8_SCHED;
            PG8_LDB(B0, 1, 0); PG8_LDB(B1, 1, 1); PG8_SCHED; PG8_LDA(At, 1, 0); PG8_STAGE(PG8_SA(0, 1), a2 + hstepA, voffA);
            PG8_WAIT_V(8); PG8_WAIT_L(0); PG8_BAR; PG8_MMA(0, 0, At, B0); PG8_MMA(0, 1, At, B1); PG8_BAR; PG8_SCHED;
            PG8_LDA(At, 1, 1); PG8_STAGE(PG8_SB(1, 0), b3, voffB); PG8_STAGE(PG8_SB(1, 1), b3 + hstep, voffB); PG8_STAGE(PG8_SA(1, 0), a3, voffA);
            PG8_WAIT_V(8); PG8_WAIT_L(0); PG8_BAR; PG8_MMA(1, 0, At, B0); PG8_MMA(1, 1, At, B1); PG8_BAR; PG8_SCHED;
            } else {
            PG8_LDB(B0, 0, 0); PG8_SCHED; PG8_LDA(At, 0, 0); PG8_STAGE(PG8_SA(1, 1), a1 + hstepA, voffA);
            PG8_WAIT_L(8); PG8_BAR; PG8_WAIT_L(0); PG8_MMA(0, 0, At, B0); PG8_BAR; PG8_SCHED;
            PG8_LDB(B1, 0, 1); PG8_STAGE(PG8_SB(0, 0), b2, voffB);
            PG8_BAR; PG8_WAIT_L(0); PG8_MMA(0, 1, At, B1); PG8_BAR;
            PG8_LDA(At, 0, 1); PG8_STAGE(PG8_SA(0, 0), a2, voffA);
            PG8_BAR; PG8_WAIT_L(0); PG8_MMA(1, 0, At, B0); PG8_BAR; PG8_SCHED;
            PG8_STAGE(PG8_SB(0, 1), b2 + hstep, voffB);
            PG8_WAIT_V(6); PG8_BAR; PG8_MMA(1, 1, At, B1); PG8_BAR;
            PG8_LDB(B0, 1, 0); PG8_SCHED; PG8_LDA(At, 1, 0); PG8_STAGE(PG8_SA(0, 1), a2 + hstepA, voffA);
            PG8_WAIT_L(8); PG8_BAR; PG8_WAIT_L(0); PG8_MMA(0, 0, At, B0); PG8_BAR; PG8_SCHED;
            PG8_LDB(B1, 1, 1); PG8_STAGE(PG8_SB(1, 0), b3, voffB);
            PG8_BAR; PG8_WAIT_L(0); PG8_MMA(0, 1, At, B1); PG8_BAR;
            PG8_LDA(At, 1, 1); PG8_STAGE(PG8_SA(1, 0), a3, voffA);
            PG8_BAR; PG8_WAIT_L(0); PG8_MMA(1, 0, At, B0); PG8_BAR; PG8_SCHED;
            PG8_STAGE(PG8_SB(1, 1), b3 + hstep, voffB);
            PG8_WAIT_V(6); PG8_BAR; PG8_MMA(1, 1, At, B1); PG8_BAR;
            }
        }
        if constexpr (ALIGN_EPI) { if (wr == 0) PG8_BAR; }
        if constexpr (!Epi::AFTER_DRAIN) { E(acc, cur, wr, wc, fr, fq); S.done(cur); }
        if (!has_next) break;
#pragma unroll
        for (int a = 0; a < 2; ++a)
#pragma unroll
            for (int b = 0; b < 2; ++b)
#pragma unroll
                for (int m = 0; m < 4; ++m)
#pragma unroll
                    for (int n = 0; n < 2; ++n) acc[a][b][m][n] = (f32x4){0.f, 0.f, 0.f, 0.f};
        cur = nxt; cA = nA; cB = nB; ++ui;
        if constexpr (ALIGN_EPI) { if (wr == 1) PG8_BAR; }
    }
    PG8_WAIT_V(0);
    if constexpr (!ALIGN_EPI) { if (wr == 0) PG8_BAR; }
    PG8_BAR;
    if constexpr (Epi::AFTER_DRAIN) { E.fused(acc, cur, wr, wc, fr, fq, lds, wid, lane); S.done(cur); }
#undef PG8_SA
#undef PG8_SB
#undef PG8_STAGE
#undef PG8_LDA
#undef PG8_LDB
#undef PG8_MMA
#undef PG8_WAIT_V
#undef PG8_WAIT_L
#undef PG8_BAR
#undef PG8_SCHED
}
}

#define GAS __attribute__((address_space(1)))
#define LAS __attribute__((address_space(3)))
typedef unsigned short bf16;
typedef float f32x4 __attribute__((ext_vector_type(4)));
typedef float f32x16 __attribute__((ext_vector_type(16)));
typedef short bf16x8 __attribute__((ext_vector_type(8)));
typedef short s16x4 __attribute__((ext_vector_type(4)));
typedef unsigned u32x4 __attribute__((ext_vector_type(4)));
typedef unsigned u32x2 __attribute__((ext_vector_type(2)));
typedef GAS unsigned gu32;
#define RLX_AGENT __ATOMIC_RELAXED, __HIP_MEMORY_SCOPE_AGENT
#define LDS_WAIT() asm volatile("s_waitcnt lgkmcnt(0)" ::: "memory")
#define VM_WAIT() asm volatile("s_waitcnt vmcnt(0)" ::: "memory")
__device__ __forceinline__ unsigned pk2(float lo, float hi) { return pg8::pk_bf16(lo, hi); }
__device__ __forceinline__ float bf2f(unsigned short b) { return __builtin_bit_cast(float, (unsigned)b << 16); }
__device__ __forceinline__ float ex2(float x) { return __builtin_amdgcn_exp2f(x); }
__device__ __forceinline__ float wave_sum(float v) {
#pragma unroll
    for (int o = 1; o < 64; o <<= 1) v += __shfl_xor(v, o);
    return v;
}

namespace fa {
constexpr int KSLOT = 12288, VSLOT = 8192;
constexpr int L_K = 0, L_V = 2 * KSLOT, L_WS = L_V + 2 * VSLOT, L_OST = L_WS + 8 * 64 * 4, L_BYTES = L_OST + 8 * 32 * 64 * 4;
constexpr int L_WS2 = L_V + 3 * VSLOT, L_CB2 = L_WS2 + 8 * 128 * 4, L_OST2 = L_CB2 + 512, L_QR2 = L_OST2 + 8 * 4096, L_BYTES2 = L_QR2 + 8 * 4096;
__device__ __forceinline__ int crow(int r, int hi) { return (r & 3) + 8 * (r >> 2) + 4 * hi; }
__device__ __forceinline__ void glds16(const void* gsrc, unsigned lds_dst) { unsigned keep;
    asm volatile("s_mov_b32 %0, m0\n\ts_mov_b32 m0, %2\n\ts_nop 0\n\tglobal_load_lds_dwordx4 %1, off\n\ts_mov_b32 m0, %0" : "=&s"(keep) : "v"(gsrc), "s"(lds_dst) : "memory"); }
#define FA_WAIT_BAR() asm volatile("s_waitcnt vmcnt(0) lgkmcnt(0)\n\ts_barrier" ::: "memory")
#define FA_SBAR() __builtin_amdgcn_sched_barrier(0)
template <int ND0> __device__ __forceinline__ void qkt(f32x16& p0, f32x16& p1, const LAS char* kp, const bf16x8* qr) {
    p0 = f32x16{}; p1 = f32x16{};
#pragma unroll
    for (int d0 = 0; d0 < ND0; ++d0) {
        const bf16x8 b0 = *(const LAS bf16x8*)(kp + d0 * 2048);
        const bf16x8 b1 = *(const LAS bf16x8*)(kp + d0 * 2048 + 512);
        p0 = __builtin_amdgcn_mfma_f32_32x32x16_bf16(b0, qr[d0], p0, 0, 0, 0); p1 = __builtin_amdgcn_mfma_f32_32x32x16_bf16(b1, qr[d0], p1, 0, 0, 0); }
}
__device__ __forceinline__ float max3f(float a, float b, float c) { float r; asm("v_max3_f32 %0, %1, %2, %3" : "=v"(r) : "v"(a), "v"(b), "v"(c)); return r; }
__device__ __forceinline__ float max2f(float a, float b) { float r; asm("v_max_f32_e32 %0, %1, %2" : "=v"(r) : "v"(a), "v"(b)); return r; }
__device__ __forceinline__ float rowmax_a(const f32x16& p0, const f32x16& p1) {
    float a = max3f(p0[0], p0[1], p1[0]), b = max3f(p0[2], p0[3], p1[1]); a = max3f(a, p1[2], p1[3]);
#pragma unroll
    for (int r = 4; r < 16; r += 4) { a = max3f(a, p0[r], p0[r + 1]); b = max3f(b, p0[r + 2], p0[r + 3]); a = max3f(a, p1[r], p1[r + 1]); b = max3f(b, p1[r + 2], p1[r + 3]); }
    const float m = max2f(a, b);
    auto rr = __builtin_amdgcn_permlane32_swap(__float_as_uint(m), __float_as_uint(m), false, false);
    return max2f(__uint_as_float(rr[0]), __uint_as_float(rr[1]));
}
__device__ __forceinline__ float rowmax(const f32x16& p0, const f32x16& p1) {
    float a = __builtin_fmaxf(p0[0], p1[0]);
#pragma unroll
    for (int r = 1; r < 16; ++r) a = __builtin_fmaxf(a, __builtin_fmaxf(p0[r], p1[r]));
    auto rr = __builtin_amdgcn_permlane32_swap(__float_as_uint(a), __float_as_uint(a), false, false);
    return __builtin_fmaxf(__uint_as_float(rr[0]), __uint_as_float(rr[1]));
}
__device__ __forceinline__ void pv(f32x16* o, int vb, bf16x8 pa0, bf16x8 pa1, bf16x8 pa2, bf16x8 pa3) {
#pragma unroll
    for (int d0 = 0; d0 < 2; ++d0) { s16x4 lo[4], hi[4];
#pragma unroll
        for (int ks = 0; ks < 4; ++ks) {
            asm volatile("ds_read_b64_tr_b16 %0,%1 offset:%c2" : "=&v"(lo[ks]) : "v"(vb), "i"(d0 * 4096 + ks * 1024) : "memory");
            asm volatile("ds_read_b64_tr_b16 %0,%1 offset:%c2" : "=&v"(hi[ks]) : "v"(vb), "i"(d0 * 4096 + ks * 1024 + 512) : "memory"); }
        asm volatile("s_waitcnt lgkmcnt(0)" ::: "memory"); FA_SBAR();
#define FA_PK(k) (bf16x8){lo[k][0], lo[k][1], lo[k][2], lo[k][3], hi[k][0], hi[k][1], hi[k][2], hi[k][3]}
        o[d0] = __builtin_amdgcn_mfma_f32_32x32x16_bf16(pa0, FA_PK(0), o[d0], 0, 0, 0);
        o[d0] = __builtin_amdgcn_mfma_f32_32x32x16_bf16(pa1, FA_PK(1), o[d0], 0, 0, 0);
        o[d0] = __builtin_amdgcn_mfma_f32_32x32x16_bf16(pa2, FA_PK(2), o[d0], 0, 0, 0);
        o[d0] = __builtin_amdgcn_mfma_f32_32x32x16_bf16(pa3, FA_PK(3), o[d0], 0, 0, 0);
#undef FA_PK
    }
}
struct Args { const bf16* Q; int qpitch, qcol; const bf16* K; int kpitch, kcol; const bf16* K2; const bf16* V; int vpitch, vcol; bf16* O; int ocol; const bf16* G; const float* CB; };
template <int MODE> __device__ __forceinline__ void unit(const Args& A, long rowbase, int qb, LAS char* lds, unsigned lds0) {
    constexpr int ND0 = MODE ? 6 : 4;
    const int tid = pg8::pg8_tid(), lane = tid & 63, r32 = lane & 31, hi = lane >> 5; const int wid = __builtin_amdgcn_readfirstlane(tid >> 6);
    const int q0 = qb * 256, NT = q0 / 64 + 4, nt_w = MODE ? (q0 / 64 + (wid >> 1) + 1) : NT;
    const bf16* Qw = A.Q + (rowbase + q0 + wid * 32 + r32) * A.qpitch + A.qcol + hi * 8;
    bf16x8 qr[ND0];
#pragma unroll
    for (int d0 = 0; d0 < ND0; ++d0) qr[d0] = *(const bf16x8*)(Qw + d0 * 16);
    const bf16* ksrc = A.K + (rowbase + lane) * A.kpitch + A.kcol + wid * 8;
    const bf16* ksrc2 = MODE ? A.K2 + (rowbase + lane) * 32 + (wid & 3) * 8 : nullptr;
    const bf16* vsrc = A.V + (rowbase + 16 * (wid & 3) + (lane >> 2)) * A.vpitch + A.vcol + (wid >> 2) * 32 + (lane & 3) * 8;
#define FA_DMA(t, slot) do { \
        glds16(ksrc + (long)(t) * 64 * A.kpitch, (unsigned)__builtin_amdgcn_readfirstlane(lds0 + L_K + (slot) * KSLOT + wid * 1024)); \
        if (MODE && wid < 4) glds16(ksrc2 + (long)(t) * 64 * 32, (unsigned)__builtin_amdgcn_readfirstlane(lds0 + L_K + (slot) * KSLOT + (8 + wid) * 1024)); \
        glds16(vsrc + (long)(t) * 64 * A.vpitch, (unsigned)__builtin_amdgcn_readfirstlane(lds0 + L_V + (slot) * VSLOT + wid * 1024)); } while (0)
    LAS float* wsf = (LAS float*)(lds + L_WS) + wid * 64;
    const int vb0 = (int)(lds0 + L_V) + ((lane >> 4) & 1) * 32 + (lane & 3) * 8 + (4 * hi + ((lane & 15) >> 2)) * 64;
    float m = -1e30f, l = 0.f; f32x16 o[2]; o[0] = f32x16{}; o[1] = f32x16{};
    FA_DMA(0, 0);
    for (int t = 0; t < NT; ++t) {
        FA_WAIT_BAR();
        if (t + 1 < NT) FA_DMA(t + 1, (t + 1) & 1);
        if (t < nt_w) {
            const int slot = t & 1;
            f32x16 p0, p1; qkt<ND0>(p0, p1, lds + L_K + slot * KSLOT + hi * 1024 + r32 * 16, qr);
            if (MODE == 0) {
                const float* cb = A.CB + t * 64 + 4 * hi;
#pragma unroll
                for (int g4 = 0; g4 < 4; ++g4) { const f32x4 b0 = *(const f32x4*)(cb + 8 * g4), b1 = *(const f32x4*)(cb + 32 + 8 * g4);
#pragma unroll
                    for (int i = 0; i < 4; ++i) { p0[4 * g4 + i] += b0[i]; p1[4 * g4 + i] += b1[i]; } }
                const int jb = t - (NT - 4);
                if (jb >= 0) { const int qrel = wid * 32 + r32, kb = 64 * jb + 4 * hi;
#pragma unroll
                    for (int r = 0; r < 16; ++r) { const int kv = kb + (r & 3) + 8 * (r >> 2); if (kv > qrel) p0[r] = -INFINITY; if (kv + 32 > qrel) p1[r] = -INFINITY; } }
            }
            const float rm = rowmax(p0, p1);
            const float mn = __builtin_fmaxf(m, rm), alpha = ex2(m - mn); m = mn;
            float sacc = 0.f;
#pragma unroll
            for (int r = 0; r < 16; ++r) { p0[r] = ex2(p0[r] - mn); p1[r] = ex2(p1[r] - mn); sacc += p0[r] + p1[r]; }
            l = l * alpha + sacc;
            if (hi == 0) wsf[r32] = alpha;
#pragma unroll
            for (int r = 0; r < 16; ++r) { const float a = wsf[crow(r, hi)]; o[0][r] *= a; o[1][r] *= a; }
            u32x4 pw0, pw1, pw2, pw3;
            pw0 = (u32x4){pk2(p0[0], p0[1]), pk2(p0[2], p0[3]), pk2(p0[4], p0[5]), pk2(p0[6], p0[7])};
            pw1 = (u32x4){pk2(p0[8], p0[9]), pk2(p0[10], p0[11]), pk2(p0[12], p0[13]), pk2(p0[14], p0[15])};
            pw2 = (u32x4){pk2(p1[0], p1[1]), pk2(p1[2], p1[3]), pk2(p1[4], p1[5]), pk2(p1[6], p1[7])};
            pw3 = (u32x4){pk2(p1[8], p1[9]), pk2(p1[10], p1[11]), pk2(p1[12], p1[13]), pk2(p1[14], p1[15])};
            FA_SBAR();
            pv(o, vb0 + slot * VSLOT, __builtin_bit_cast(bf16x8, pw0), __builtin_bit_cast(bf16x8, pw1), __builtin_bit_cast(bf16x8, pw2), __builtin_bit_cast(bf16x8, pw3));
        }
    }
    { auto rr = __builtin_amdgcn_permlane32_swap(__float_as_uint(l), __float_as_uint(l), false, false); l = __uint_as_float(rr[0]) + __uint_as_float(rr[1]); }
    if (hi == 0) wsf[32 + r32] = l;
    LAS float* stg = (LAS float*)(lds + L_OST) + wid * 2048;
#pragma unroll
    for (int r = 0; r < 16; ++r) { const int orow = crow(r, hi); const float rl = __builtin_amdgcn_rcpf(wsf[32 + orow]);
        stg[orow * 64 + r32] = o[0][r] * rl; stg[orow * 64 + 32 + r32] = o[1][r] * rl; }
    LDS_WAIT();
#pragma unroll
    for (int i = 0; i < 4; ++i) { const int row = i * 8 + (lane >> 3), ch = lane & 7; const long grow = rowbase + q0 + wid * 32 + row;
        f32x4 a = *(const LAS f32x4*)(stg + row * 64 + ch * 8), b = *(const LAS f32x4*)(stg + row * 64 + ch * 8 + 4);
        if (MODE == 0) { const u32x4 g = *(const u32x4*)(A.G + grow * 1024 + A.ocol + ch * 8);
            a[0] *= __uint_as_float(g.x << 16); a[1] *= __uint_as_float(g.x & 0xffff0000u); a[2] *= __uint_as_float(g.y << 16); a[3] *= __uint_as_float(g.y & 0xffff0000u);
            b[0] *= __uint_as_float(g.z << 16); b[1] *= __uint_as_float(g.z & 0xffff0000u); b[2] *= __uint_as_float(g.w << 16); b[3] *= __uint_as_float(g.w & 0xffff0000u); }
        const u32x4 w = (u32x4){pk2(a[0], a[1]), pk2(a[2], a[3]), pk2(b[0], b[1]), pk2(b[2], b[3])};
        *(u32x4*)(A.O + grow * 1024 + A.ocol + ch * 8) = w; }
    asm volatile("s_waitcnt lgkmcnt(0)\n\ts_barrier" ::: "memory");
#undef FA_DMA
}

#ifndef FA_STAG_FOX
#define FA_STAG_FOX 1
#endif
#ifndef FA_STAG_MLA
#define FA_STAG_MLA 1
#endif
#ifndef FA_PROBE_VALU
#define FA_PROBE_VALU 0
#endif
__device__ __forceinline__ void glds4(const void* gsrc, unsigned lds_dst) { unsigned keep;
    asm volatile("s_mov_b32 %0, m0\n\ts_mov_b32 m0, %2\n\ts_nop 0\n\tglobal_load_lds_dword %1, off\n\ts_mov_b32 m0, %0" : "=&s"(keep) : "v"(gsrc), "s"(lds_dst) : "memory"); }
__device__ __forceinline__ s16x4 vtr(const LAS char* p) { typedef short v4i16_t __attribute__((ext_vector_type(4))); return __builtin_bit_cast(s16x4, __builtin_amdgcn_ds_read_tr16_b64_v4i16((LAS v4i16_t*)p)); }
template <int MODE, bool DIAG> __device__ __forceinline__ void tile_qs(const LAS char* kp, const bf16x8 (&qr)[2][4], const LAS char* qrl, const LAS float* cbl, int r32, int hi,
                                                                     float (&m)[2], float (&l)[2], f32x16 (&o)[2][2], LAS float* wsf, u32x4 (&pw)[2][4]) {
    constexpr int ND0 = MODE ? 6 : 4;
    f32x16 p[2][2];
    if (MODE == 0) {
#pragma unroll
        for (int g4 = 0; g4 < 4; ++g4) { const f32x4 b0 = *(const LAS f32x4*)(cbl + 4 * hi + 8 * g4), b1 = *(const LAS f32x4*)(cbl + 32 + 4 * hi + 8 * g4);
#pragma unroll
            for (int i = 0; i < 4; ++i) { p[0][0][4 * g4 + i] = b0[i]; p[0][1][4 * g4 + i] = b1[i]; } }
        p[1][0] = p[0][0]; p[1][1] = p[0][1];
    } else {
#pragma unroll
        for (int b2 = 0; b2 < 2; ++b2) { p[b2][0] = f32x16{}; p[b2][1] = f32x16{}; }
    }
    bf16x8 qx[2][2];
    if (MODE) {
#pragma unroll
        for (int b2 = 0; b2 < 2; ++b2) { qx[b2][0] = *(const LAS bf16x8*)(qrl + (b2 * 2) * 1024); qx[b2][1] = *(const LAS bf16x8*)(qrl + (b2 * 2 + 1) * 1024); } }
#pragma unroll
    for (int d0 = 0; d0 < ND0; ++d0) { const bf16x8 k0 = *(const LAS bf16x8*)(kp + d0 * 2048), k1 = *(const LAS bf16x8*)(kp + d0 * 2048 + 512);
#pragma unroll
        for (int b2 = 0; b2 < 2; ++b2) { const bf16x8 qv = (d0 < 4) ? qr[b2][d0 & 3] : qx[b2][d0 & 1];
            p[b2][0] = __builtin_amdgcn_mfma_f32_32x32x16_bf16(k0, qv, p[b2][0], 0, 0, 0); p[b2][1] = __builtin_amdgcn_mfma_f32_32x32x16_bf16(k1, qv, p[b2][1], 0, 0, 0); } }
    if (MODE == 0 && DIAG) {
#pragma unroll
        for (int b2 = 0; b2 < 2; ++b2) { const int qrel = 32 * b2 + r32;
#pragma unroll
            for (int r = 0; r < 16; ++r) { const int kv = 4 * hi + (r & 3) + 8 * (r >> 2); if (kv > qrel) p[b2][0][r] = -INFINITY; if (kv + 32 > qrel) p[b2][1][r] = -INFINITY; } } }
    asm volatile("s_nop 15\n\ts_nop 7" : "+v"(p[0][0]), "+v"(p[0][1]), "+v"(p[1][0]), "+v"(p[1][1]));
#if FA_PROBE_VALU
    { float dd[8];
#pragma unroll
      for (int i = 0; i < 8; ++i) dd[i] = m[0] + (float)i;
#pragma unroll
      for (int k = 0; k < FA_PROBE_VALU; ++k)
#pragma unroll
        for (int i = 0; i < 8; ++i) dd[i] = ex2(dd[i]);
#pragma unroll
      for (int i = 0; i < 8; ++i) asm volatile("" :: "v"(dd[i])); }
#endif
#pragma unroll
    for (int b2 = 0; b2 < 2; ++b2) {
        const float rm = rowmax_a(p[b2][0], p[b2][1]);
        const float mn = max2f(m[b2], rm); float alpha = m[b2] - mn; asm("v_exp_f32 %0, %0\n\ts_nop 0" : "+v"(alpha)); m[b2] = mn;
        float sa0 = 0.f, sa1 = 0.f;
#pragma unroll
        for (int r = 0; r < 16; r += 2) { float a = p[b2][0][r] - mn, b = p[b2][1][r] - mn, c = p[b2][0][r + 1] - mn, d = p[b2][1][r + 1] - mn;
            asm("v_exp_f32 %0, %0\n\tv_exp_f32 %1, %1\n\tv_exp_f32 %2, %2\n\tv_exp_f32 %3, %3\n\tv_add_f32 %4, %4, %0\n\tv_add_f32 %5, %5, %1\n\tv_add_f32 %4, %4, %2\n\tv_add_f32 %5, %5, %3"
                : "+v"(a), "+v"(b), "+v"(c), "+v"(d), "+v"(sa0), "+v"(sa1));
            p[b2][0][r] = a; p[b2][1][r] = b; p[b2][0][r + 1] = c; p[b2][1][r + 1] = d; }
        l[b2] = l[b2] * alpha + (sa0 + sa1);
#pragma unroll
        for (int r = 0; r < 16; ++r) { float t0 = o[b2][0][r], t1 = o[b2][1][r]; asm("v_mul_f32 %0, %0, %1" : "+v"(t0) : "v"(alpha)); asm("v_mul_f32 %0, %0, %1" : "+v"(t1) : "v"(alpha)); o[b2][0][r] = t0; o[b2][1][r] = t1; }
        pw[b2][0] = (u32x4){pk2(p[b2][0][0], p[b2][0][1]), pk2(p[b2][0][2], p[b2][0][3]), pk2(p[b2][0][4], p[b2][0][5]), pk2(p[b2][0][6], p[b2][0][7])};
        pw[b2][1] = (u32x4){pk2(p[b2][0][8], p[b2][0][9]), pk2(p[b2][0][10], p[b2][0][11]), pk2(p[b2][0][12], p[b2][0][13]), pk2(p[b2][0][14], p[b2][0][15])};
        pw[b2][2] = (u32x4){pk2(p[b2][1][0], p[b2][1][1]), pk2(p[b2][1][2], p[b2][1][3]), pk2(p[b2][1][4], p[b2][1][5]), pk2(p[b2][1][6], p[b2][1][7])};
        pw[b2][3] = (u32x4){pk2(p[b2][1][8], p[b2][1][9]), pk2(p[b2][1][10], p[b2][1][11]), pk2(p[b2][1][12], p[b2][1][13]), pk2(p[b2][1][14], p[b2][1][15])};
    }
    asm volatile("s_nop 1" : "+v"(o[0][0]), "+v"(o[0][1]), "+v"(o[1][0]), "+v"(o[1][1]));
}
__device__ __forceinline__ void tile_pv(const LAS char* vp, f32x16 (&o)[2][2], const u32x4 (&pw)[2][4]) {
#pragma unroll
    for (int d0 = 0; d0 < 2; ++d0)
#pragma unroll
        for (int ks = 0; ks < 4; ++ks) { const s16x4 lo = vtr(vp + d0 * 4096 + ks * 1024), hi4 = vtr(vp + d0 * 4096 + ks * 1024 + 512);
            const bf16x8 vf = (bf16x8){lo[0], lo[1], lo[2], lo[3], hi4[0], hi4[1], hi4[2], hi4[3]};
#pragma unroll
            for (int b2 = 0; b2 < 2; ++b2) o[b2][d0] = __builtin_amdgcn_mfma_f32_32x32x16_bf16(vf, __builtin_bit_cast(bf16x8, pw[b2][ks]), o[b2][d0], 0, 0, 0); }
}
template <int MODE> __device__ __forceinline__ void unit2(const Args& A, long rowbase, int qb, LAS char* lds, unsigned lds0) {
    constexpr int ND0 = MODE ? 6 : 4;
    const int tid = pg8::pg8_tid(), lane = tid & 63, r32 = lane & 31, hi = lane >> 5; const int wid = __builtin_amdgcn_readfirstlane(tid >> 6);
    const int q0 = qb * 512, NT = q0 / 64 + 8, nt_w = q0 / 64 + wid + 1;
    bf16x8 qr[2][4];
    LAS char* qrl = lds + L_QR2 + wid * 4096 + lane * 16;
#pragma unroll
    for (int b2 = 0; b2 < 2; ++b2) { const bf16* Qw = A.Q + (rowbase + q0 + wid * 64 + b2 * 32 + r32) * A.qpitch + A.qcol + hi * 8;
#pragma unroll
        for (int d0 = 0; d0 < 4; ++d0) qr[b2][d0] = *(const bf16x8*)(Qw + d0 * 16);
        if (MODE) { *(LAS bf16x8*)(qrl + (b2 * 2) * 1024) = *(const bf16x8*)(Qw + 64); *(LAS bf16x8*)(qrl + (b2 * 2 + 1) * 1024) = *(const bf16x8*)(Qw + 80); } }
    const int koff = lane * A.kpitch + A.kcol + wid * 8, k2off = lane * 32 + (wid & 3) * 8, voff = (16 * (wid & 3) + (lane >> 2)) * A.vpitch + A.vcol + (wid >> 2) * 32 + (lane & 3) * 8;
    const bf16* Kb = A.K + rowbase * A.kpitch; const bf16* K2b = MODE ? A.K2 + rowbase * 32 : nullptr; const bf16* Vb = A.V + rowbase * A.vpitch;
#define FA_DMA(t, slot) do { \
        int ko_ = koff, k2o_ = k2off, vo_ = voff; asm volatile("" : "+v"(ko_), "+v"(k2o_), "+v"(vo_)); \
        glds16(Kb + (long)(t) * 64 * A.kpitch + ko_, (unsigned)__builtin_amdgcn_readfirstlane(lds0 + L_K + (slot) * KSLOT + wid * 1024)); \
        if (MODE && wid < 4) glds16(K2b + (long)(t) * 64 * 32 + k2o_, (unsigned)__builtin_amdgcn_readfirstlane(lds0 + L_K + (slot) * KSLOT + (8 + wid) * 1024)); \
        glds16(Vb + (long)(t) * 64 * A.vpitch + vo_, (unsigned)__builtin_amdgcn_readfirstlane(lds0 + L_V + ((t) % 3) * VSLOT + wid * 1024)); \
        if (!MODE && wid == 4) glds4(A.CB + (t) * 64 + lane, (unsigned)__builtin_amdgcn_readfirstlane(lds0 + L_CB2 + (slot) * 256)); } while (0)
    LAS float* wsf = (LAS float*)(lds + L_WS2) + wid * 128;
    const LAS char* kp0 = lds + L_K + hi * 1024 + r32 * 16;
    const LAS char* vp0 = lds + L_V + ((lane >> 4) & 1) * 32 + (lane & 3) * 8 + (4 * hi + ((lane & 15) >> 2)) * 64;
    float m[2] = {-1e30f, -1e30f}, l[2] = {0.f, 0.f}; f32x16 o[2][2];
#pragma unroll
    for (int b2 = 0; b2 < 2; ++b2) { o[b2][0] = f32x16{}; o[b2][1] = f32x16{}; }
    FA_DMA(0, 0);
    u32x4 pw[2][4];
#define FA_STEP_HEAD(t) FA_WAIT_BAR(); if ((t) + 1 < NT) FA_DMA((t) + 1, ((t) + 1) & 1); const int slot = (t) & 1; const LAS float* cbl = (const LAS float*)(lds + L_CB2 + slot * 256)
    if (wid < 4 || !(MODE ? FA_STAG_MLA : FA_STAG_FOX)) {
        int t = 0;
        for (; t < nt_w - 1; ++t) { FA_STEP_HEAD(t); tile_qs<MODE, false>(kp0 + slot * KSLOT, qr, qrl, cbl, r32, hi, m, l, o, wsf, pw); tile_pv(vp0 + (t % 3) * VSLOT, o, pw); }
        { FA_STEP_HEAD(t); tile_qs<MODE, true>(kp0 + slot * KSLOT, qr, qrl, cbl, r32, hi, m, l, o, wsf, pw); tile_pv(vp0 + (t % 3) * VSLOT, o, pw); ++t; }
        for (; t < NT; ++t) { FA_STEP_HEAD(t); (void)slot; (void)cbl; }
    } else {
        int t = 0;
        if (nt_w > 1) { FA_STEP_HEAD(0); tile_qs<MODE, false>(kp0 + slot * KSLOT, qr, qrl, cbl, r32, hi, m, l, o, wsf, pw); t = 1;
            for (; t < nt_w - 1; ++t) { FA_STEP_HEAD(t); tile_pv(vp0 + ((t - 1) % 3) * VSLOT, o, pw); FA_SBAR(); tile_qs<MODE, false>(kp0 + slot * KSLOT, qr, qrl, cbl, r32, hi, m, l, o, wsf, pw); }
            { FA_STEP_HEAD(t); tile_pv(vp0 + ((t - 1) % 3) * VSLOT, o, pw); FA_SBAR(); tile_qs<MODE, true>(kp0 + slot * KSLOT, qr, qrl, cbl, r32, hi, m, l, o, wsf, pw); ++t; }
        } else { FA_STEP_HEAD(0); tile_qs<MODE, true>(kp0 + slot * KSLOT, qr, qrl, cbl, r32, hi, m, l, o, wsf, pw); t = 1; }
        if (t < NT) { FA_STEP_HEAD(t); (void)slot; (void)cbl; tile_pv(vp0 + ((t - 1) % 3) * VSLOT, o, pw); ++t;
            for (; t < NT; ++t) { FA_STEP_HEAD(t); (void)slot; (void)cbl; } }
        else tile_pv(vp0 + ((NT - 1) % 3) * VSLOT, o, pw);
    }
#undef FA_STEP_HEAD
#pragma unroll
    for (int b2 = 0; b2 < 2; ++b2) {
        float lb = l[b2];
        { auto rr = __builtin_amdgcn_permlane32_swap(__float_as_uint(lb), __float_as_uint(lb), false, false); lb = __uint_as_float(rr[0]) + __uint_as_float(rr[1]); }
        const float rl = __builtin_amdgcn_rcpf(lb); const long grow = rowbase + q0 + wid * 64 + b2 * 32 + r32;
#pragma unroll
        for (int d0 = 0; d0 < 2; ++d0)
#pragma unroll
            for (int g4 = 0; g4 < 4; ++g4) { const int dc = A.ocol + 32 * d0 + 8 * g4 + 4 * hi;
                f32x4 v = (f32x4){o[b2][d0][4 * g4], o[b2][d0][4 * g4 + 1], o[b2][d0][4 * g4 + 2], o[b2][d0][4 * g4 + 3]} * rl;
                if (MODE == 0) { const u32x2 g = *(const u32x2*)(A.G + grow * 1024 + dc);
                    v[0] *= __uint_as_float(g.x << 16); v[1] *= __uint_as_float(g.x & 0xffff0000u); v[2] *= __uint_as_float(g.y << 16); v[3] *= __uint_as_float(g.y & 0xffff0000u); }
                *(u32x2*)(A.O + grow * 1024 + dc) = (u32x2){pk2(v[0], v[1]), pk2(v[2], v[3])}; }
    }
    asm volatile("s_waitcnt lgkmcnt(0)\n\ts_barrier" ::: "memory");
#undef FA_DMA
}
}

namespace a16 {
__device__ __forceinline__ f32x4 mfma16(bf16x8 a, bf16x8 b, f32x4 c) { return __builtin_amdgcn_mfma_f32_16x16x32_bf16(a, b, c, 0, 0, 0); }
template <int NQK, int NDB, class KL, class VL, class SF>
__device__ __forceinline__ void steps(int s0, int s1, const bf16x8 (&qf)[NQK], KL kload, VL vload, SF sfix, float& m, float& l, f32x4 (&o)[NDB], int lane) {
    const int g = lane >> 4;
    for (int s = s0; s < s1; ++s) {
        f32x4 sA = {0.f, 0.f, 0.f, 0.f}, sB = {0.f, 0.f, 0.f, 0.f};
#pragma unroll
        for (int d0 = 0; d0 < NQK; ++d0) { sA = mfma16(kload(s, 0, d0), qf[d0], sA); sB = mfma16(kload(s, 1, d0), qf[d0], sB); }
        sfix(s, sA, sB);
        float mx = __builtin_fmaxf(__builtin_fmaxf(__builtin_fmaxf(sA[0], sA[1]), __builtin_fmaxf(sA[2], sA[3])), __builtin_fmaxf(__builtin_fmaxf(sB[0], sB[1]), __builtin_fmaxf(sB[2], sB[3])));
        mx = __builtin_fmaxf(mx, __shfl_xor(mx, 16)); mx = __builtin_fmaxf(mx, __shfl_xor(mx, 32));
        const float mn = __builtin_fmaxf(m, mx), alpha = ex2(m - mn); m = mn;
        f32x4 pA, pB;
#pragma unroll
        for (int r = 0; r < 4; ++r) { pA[r] = ex2(sA[r] - mn); pB[r] = ex2(sB[r] - mn); }
        float ps = ((pA[0] + pA[1]) + (pA[2] + pA[3])) + ((pB[0] + pB[1]) + (pB[2] + pB[3]));
        ps += __shfl_xor(ps, 16); ps += __shfl_xor(ps, 32);
        l = l * alpha + ps;
        const float a0 = __shfl(alpha, 4 * g), a1 = __shfl(alpha, 4 * g + 1), a2 = __shfl(alpha, 4 * g + 2), a3 = __shfl(alpha, 4 * g + 3);
#pragma unroll
        for (int db = 0; db < NDB; ++db) { o[db][0] *= a0; o[db][1] *= a1; o[db][2] *= a2; o[db][3] *= a3; }
        const u32x4 pw = (u32x4){pk2(pA[0], pA[1]), pk2(pA[2], pA[3]), pk2(pB[0], pB[1]), pk2(pB[2], pB[3])};
        const bf16x8 pf = __builtin_bit_cast(bf16x8, pw);
#pragma unroll
        for (int db = 0; db < NDB; ++db) o[db] = mfma16(pf, vload(s, db), o[db]);
    }
}
__device__ __forceinline__ bf16x8 cvt8(f32x4 a, f32x4 b) { const u32x4 w = (u32x4){pk2(a[0], a[1]), pk2(a[2], a[3]), pk2(b[0], b[1]), pk2(b[2], b[3])}; return __builtin_bit_cast(bf16x8, w); }
__device__ __forceinline__ bf16x8 join8(u32x2 a, u32x2 b) { const u32x4 w = (u32x4){a.x, a.y, b.x, b.y}; return __builtin_bit_cast(bf16x8, w); }
}


namespace xa {
constexpr int TSZ = 16384, L_T = 0, L_WS = 2 * TSZ, L_OST = L_WS + 8 * 64 * 4, L_BYTES = L_OST + 8 * 2048;
#define XA_WAIT_BAR() asm volatile("s_waitcnt vmcnt(0) lgkmcnt(0)\n\ts_barrier" ::: "memory")
template <typename T> __device__ __forceinline__ const T* src_of(const T* Kh, const T* Vh, int pitch, int i, int ci) {
    return (i < 8) ? Kh + (size_t)(32 * i + (ci & 31)) * pitch + (ci >> 5) * 8 : Vh + (size_t)(ci >> 2) * pitch + 32 * (i - 8) + (ci & 3) * 8; }
template <bool F32SRC> __device__ __forceinline__ void unit(const void* Kh_, const void* Vh_, int pitch, const bf16* Q, bf16* O, size_t row0, int hcol, int nvalid_w0, bool only_w0, LAS char* lds, unsigned lds0) {
    const int tid = pg8::pg8_tid(), lane = tid & 63, r32 = lane & 31, hi = lane >> 5; const int wid = __builtin_amdgcn_readfirstlane(tid >> 6);
    const bool active = !only_w0 || wid == 0; const int nvalid = only_w0 ? (wid == 0 ? nvalid_w0 : 0) : 32;
    bf16x8 qr[16];
    { const bf16* Qw = Q + (row0 + wid * 32 + r32) * 1024 + hcol + hi * 8;
#pragma unroll
      for (int d0 = 0; d0 < 16; ++d0) qr[d0] = active ? *(const bf16x8*)(Qw + d0 * 16) : (bf16x8){0, 0, 0, 0, 0, 0, 0, 0}; }
    LAS float* wsf = (LAS float*)(lds + L_WS) + wid * 64;
    f32x4 st[2][2];
#define XA_ISSUE(i) do { if (F32SRC) { _Pragma("unroll") for (int c2 = 0; c2 < 2; ++c2) { const float* s = src_of<float>((const float*)Kh_, (const float*)Vh_, pitch, (i), tid + 512 * c2); st[c2][0] = *(const f32x4*)s; st[c2][1] = *(const f32x4*)(s + 4); } } \
        else { _Pragma("unroll") for (int c2 = 0; c2 < 2; ++c2) fa::glds16(src_of<bf16>((const bf16*)Kh_, (const bf16*)Vh_, pitch, (i), (2 * wid + c2) * 64 + lane), (unsigned)__builtin_amdgcn_readfirstlane(lds0 + L_T + ((i) & 1) * TSZ + (2 * wid + c2) * 1024)); } } while (0)
#define XA_COMMIT(i) do { if (F32SRC) { _Pragma("unroll") for (int c2 = 0; c2 < 2; ++c2) *(LAS u32x4*)(lds + L_T + ((i) & 1) * TSZ + (tid + 512 * c2) * 16) = \
        (u32x4){pk2(st[c2][0][0], st[c2][0][1]), pk2(st[c2][0][2], st[c2][0][3]), pk2(st[c2][1][0], st[c2][1][1]), pk2(st[c2][1][2], st[c2][1][3])}; } } while (0)
    XA_ISSUE(0); XA_COMMIT(0);
    f32x16 S[8];
#pragma unroll
    for (int t = 0; t < 8; ++t) {
        XA_WAIT_BAR(); XA_ISSUE(t + 1);
        const LAS char* kp = lds + L_T + (t & 1) * TSZ + hi * 512 + r32 * 16;
        S[t] = f32x16{};
#pragma unroll
        for (int d0 = 0; d0 < 16; ++d0) S[t] = __builtin_amdgcn_mfma_f32_32x32x16_bf16(*(const LAS bf16x8*)(kp + d0 * 1024), qr[d0], S[t], 0, 0, 0);
        XA_COMMIT(t + 1);
    }
    float mx = S[0][0];
#pragma unroll
    for (int t = 0; t < 8; ++t)
#pragma unroll
        for (int r = 0; r < 16; ++r) mx = __builtin_fmaxf(mx, S[t][r]);
    { auto rr = __builtin_amdgcn_permlane32_swap(__float_as_uint(mx), __float_as_uint(mx), false, false); mx = __builtin_fmaxf(__uint_as_float(rr[0]), __uint_as_float(rr[1])); }
    float l = 0.f; u32x4 pw[16];
#pragma unroll
    for (int t = 0; t < 8; ++t) {
#pragma unroll
        for (int r = 0; r < 16; ++r) { S[t][r] = ex2(S[t][r] - mx); l += S[t][r]; }
        pw[2 * t] = (u32x4){pk2(S[t][0], S[t][1]), pk2(S[t][2], S[t][3]), pk2(S[t][4], S[t][5]), pk2(S[t][6], S[t][7])};
        pw[2 * t + 1] = (u32x4){pk2(S[t][8], S[t][9]), pk2(S[t][10], S[t][11]), pk2(S[t][12], S[t][13]), pk2(S[t][14], S[t][15])}; }
    { auto rr = __builtin_amdgcn_permlane32_swap(__float_as_uint(l), __float_as_uint(l), false, false); l = __uint_as_float(rr[0]) + __uint_as_float(rr[1]); }
    if (hi == 0) wsf[r32] = l;
    float rli[16];
#pragma unroll
    for (int r = 0; r < 16; ++r) rli[r] = __builtin_amdgcn_rcpf(wsf[fa::crow(r, hi)]);
    const int vbl = (int)(lds0 + L_T) + ((lane >> 4) & 1) * 32 + (lane & 3) * 8 + (4 * hi + ((lane & 15) >> 2)) * 64;
    LAS bf16* stg = (LAS bf16*)(lds + L_OST) + wid * 1024;
#pragma unroll
    for (int db = 0; db < 8; ++db) {
        XA_WAIT_BAR(); if (db < 7) XA_ISSUE(8 + db + 1);
        const int vb = vbl + (db & 1) * TSZ;
        f32x16 o = f32x16{};
#pragma unroll
        for (int k4 = 0; k4 < 4; ++k4) { s16x4 vlo[4], vhi[4];
#pragma unroll
            for (int kk = 0; kk < 4; ++kk) {
                asm volatile("ds_read_b64_tr_b16 %0,%1 offset:%c2" : "=&v"(vlo[kk]) : "v"(vb), "i"((k4 * 4 + kk) * 1024) : "memory");
                asm volatile("ds_read_b64_tr_b16 %0,%1 offset:%c2" : "=&v"(vhi[kk]) : "v"(vb), "i"((k4 * 4 + kk) * 1024 + 512) : "memory"); }
            asm volatile("s_waitcnt lgkmcnt(0)" ::: "memory"); __builtin_amdgcn_sched_barrier(0);
#pragma unroll
            for (int kk = 0; kk < 4; ++kk) o = __builtin_amdgcn_mfma_f32_32x32x16_bf16(__builtin_bit_cast(bf16x8, pw[k4 * 4 + kk]),
                (bf16x8){vlo[kk][0], vlo[kk][1], vlo[kk][2], vlo[kk][3], vhi[kk][0], vhi[kk][1], vhi[kk][2], vhi[kk][3]}, o, 0, 0, 0); }
        if (db < 7) XA_COMMIT(8 + db + 1);
#pragma unroll
        for (int r = 0; r < 16; ++r) stg[fa::crow(r, hi) * 32 + r32] = (bf16)(pk2(o[r] * rli[r], 0.f) & 0xffffu);
        LDS_WAIT();
#pragma unroll
        for (int ps = 0; ps < 2; ++ps) { const int row = ps * 16 + (lane >> 2), ch = lane & 3;
            const u32x4 v = *(const LAS u32x4*)(stg + row * 32 + ch * 8);
            if (row < nvalid) *(u32x4*)(O + (row0 + wid * 32 + row) * 1024 + hcol + 32 * db + ch * 8) = v; }
        LDS_WAIT();
    }
    asm volatile("s_waitcnt lgkmcnt(0)\n\ts_barrier" ::: "memory");
#undef XA_ISSUE
#undef XA_COMMIT
}
}

namespace ms {
constexpr int KSZ = 18432, L_T = 0, L_WS = 2 * KSZ, L_OST = L_WS + 8 * 64 * 4, L_BYTES = L_OST + 8 * 4096;
constexpr int PROW = 264;
#define MS_WAIT_BAR() asm volatile("s_waitcnt lgkmcnt(0)\n\ts_barrier" ::: "memory")
__device__ __forceinline__ const float* ms_ksrc(const float* ckvb, const float* krb, int key, int c) {
    const size_t o0 = (size_t)key * 256 + c * 8, o1 = (size_t)key * 32 + (c - 32) * 8; const bool lat = c < 32; return (lat ? ckvb : krb) + (lat ? o0 : o1); }
template <int NK> __device__ __forceinline__ void unit(const float* ckvb, const float* krb, int kclamp, const bf16* QA, float* P, LAS char* lds, unsigned lds0) {
    const int tid = pg8::pg8_tid(), lane = tid & 63, r32 = lane & 31, hi = lane >> 5; const int wid = __builtin_amdgcn_readfirstlane(tid >> 6);
    const bf16* Qw = QA + (size_t)(wid * 32 + r32) * 288 + hi * 8;
    f32x4 st[2][3][2];
#define MS_SRC(i, ci) (((i) < 8) ? ms_ksrc(ckvb, krb, min(32 * (i) + ((ci) & 31), kclamp), (ci) >> 5) \
                                  : ckvb + (size_t)min((ci) >> 2, kclamp) * 256 + 32 * ((i) - 8) + ((ci) & 3) * 8)
#define MS_NCH(i) (((i) < 8) ? 1152 : 1024)
#define MS_ISSUE(i, set) do { _Pragma("unroll") for (int c2 = 0; c2 < 3; ++c2) { const int ci = min(tid + 512 * c2, MS_NCH(i) - 1); const float* s = MS_SRC(i, ci); st[(set) & 1][c2][0] = *(const f32x4*)s; st[(set) & 1][c2][1] = *(const f32x4*)(s + 4); } } while (0)
#define MS_COMMIT(i, slot) do { _Pragma("unroll") for (int c2 = 0; c2 < 3; ++c2) { const int ci = min(tid + 512 * c2, MS_NCH(i) - 1); *(LAS u32x4*)(lds + L_T + ((slot) & 1) * KSZ + ci * 16) = \
        (u32x4){pk2(st[(slot) & 1][c2][0][0], st[(slot) & 1][c2][0][1]), pk2(st[(slot) & 1][c2][0][2], st[(slot) & 1][c2][0][3]), pk2(st[(slot) & 1][c2][1][0], st[(slot) & 1][c2][1][1]), pk2(st[(slot) & 1][c2][1][2], st[(slot) & 1][c2][1][3])}; } } while (0)
    constexpr int FIRSTV = 8;
#define MS_TILE(q) (((q) < NK) ? (q) : FIRSTV + (q) - NK)
    MS_ISSUE(MS_TILE(0), 0); MS_COMMIT(MS_TILE(0), 0); MS_ISSUE(MS_TILE(1), 1);
    f32x16 S[NK];
#pragma unroll
    for (int t = 0; t < NK; ++t) {
        MS_WAIT_BAR(); MS_ISSUE(MS_TILE(t + 2), t + 2);
        const LAS char* kp = lds + L_T + (t & 1) * KSZ + hi * 512 + r32 * 16;
        S[t] = f32x16{}; const bf16* Qt = Qw; asm volatile("" : "+v"(Qt));
#pragma unroll
        for (int d0 = 0; d0 < 18; ++d0) { S[t] = __builtin_amdgcn_mfma_f32_32x32x16_bf16(*(const LAS bf16x8*)(kp + d0 * 1024), *(const bf16x8*)(Qt + d0 * 16), S[t], 0, 0, 0);
            if (d0 % 6 == 5) __builtin_amdgcn_sched_barrier(0); }
        MS_COMMIT(MS_TILE(t + 1), t + 1);
    }
    constexpr int VS0 = (NK & 1);
    if (NK == 1) {
#pragma unroll
        for (int r = 8; r < 16; ++r) S[0][r] = -INFINITY; }
    float mx = S[0][0];
#pragma unroll
    for (int t = 0; t < NK; ++t)
#pragma unroll
        for (int r = 0; r < 16; ++r) mx = __builtin_fmaxf(mx, S[t][r]);
    { auto rr = __builtin_amdgcn_permlane32_swap(__float_as_uint(mx), __float_as_uint(mx), false, false); mx = __builtin_fmaxf(__uint_as_float(rr[0]), __uint_as_float(rr[1])); }
    float l = 0.f; u32x4 pw[2 * NK];
#pragma unroll
    for (int t = 0; t < NK; ++t) {
#pragma unroll
        for (int r = 0; r < 16; ++r) { S[t][r] = ex2(S[t][r] - mx); l += S[t][r]; }
        pw[2 * t] = (u32x4){pk2(S[t][0], S[t][1]), pk2(S[t][2], S[t][3]), pk2(S[t][4], S[t][5]), pk2(S[t][6], S[t][7])};
        pw[2 * t + 1] = (u32x4){pk2(S[t][8], S[t][9]), pk2(S[t][10], S[t][11]), pk2(S[t][12], S[t][13]), pk2(S[t][14], S[t][15])}; }
    { auto rr = __builtin_amdgcn_permlane32_swap(__float_as_uint(l), __float_as_uint(l), false, false); l = __uint_as_float(rr[0]) + __uint_as_float(rr[1]); }
    float* Pw = P + (size_t)(wid * 32) * PROW;
    if (hi == 0) { Pw[(size_t)r32 * PROW + 256] = mx; Pw[(size_t)r32 * PROW + 257] = l; }
    LAS float* stg = (LAS float*)(lds + L_OST) + wid * 1024;
#pragma unroll
    for (int db = 0; db < 8; ++db) {
        MS_WAIT_BAR(); if (db < 6) MS_ISSUE(FIRSTV + db + 2, NK + db + 2);
        const int vb = (int)(lds0 + L_T) + ((VS0 + db) & 1) * KSZ + ((lane >> 4) & 1) * 32 + (lane & 3) * 8 + (4 * hi + ((lane & 15) >> 2)) * 64;
        f32x16 o = f32x16{};
#pragma unroll
        for (int ks = 0; ks < 2 * NK; ++ks) { s16x4 vlo, vhi;
            asm volatile("ds_read_b64_tr_b16 %0,%1 offset:%c2" : "=&v"(vlo) : "v"(vb), "i"(ks * 1024) : "memory");
            asm volatile("ds_read_b64_tr_b16 %0,%1 offset:%c2" : "=&v"(vhi) : "v"(vb), "i"(ks * 1024 + 512) : "memory");
            asm volatile("s_waitcnt lgkmcnt(0)" ::: "memory"); __builtin_amdgcn_sched_barrier(0);
            o = __builtin_amdgcn_mfma_f32_32x32x16_bf16(__builtin_bit_cast(bf16x8, pw[ks]), (bf16x8){vlo[0], vlo[1], vlo[2], vlo[3], vhi[0], vhi[1], vhi[2], vhi[3]}, o, 0, 0, 0); }
#pragma unroll
        for (int r = 0; r < 16; ++r) stg[fa::crow(r, hi) * 32 + r32] = o[r];
        LDS_WAIT();
        { const int row = lane >> 1, cq = (lane & 1) * 16; float* dst = Pw + (size_t)row * PROW + 32 * db + cq;
#pragma unroll
          for (int k = 0; k < 4; ++k) *(f32x4*)(dst + 4 * k) = *(const LAS f32x4*)(stg + row * 32 + cq + 4 * k); }
        if (db < 7) MS_COMMIT(FIRSTV + db + 1, NK + db + 1);
        LDS_WAIT();
    }
    asm volatile("s_waitcnt lgkmcnt(0)\n\ts_barrier" ::: "memory");
#undef MS_SRC
#undef MS_ISSUE
#undef MS_COMMIT
#undef MS_NCH
#undef MS_TILE
}
}

constexpr int RING_OFF = 0, RING_BYTES = 131072;
constexpr int LDSCTL_OFF = RING_BYTES, MISC_OFF = LDSCTL_OFF + 320;
constexpr int LDS_BYTES = 147456;
constexpr int NWAVES = 8;
static_assert(fa::L_BYTES2 <= RING_BYTES && xa::L_BYTES <= RING_BYTES && ms::L_BYTES <= RING_BYTES, "attention LDS");

struct KArgs { const float* in[N_IN]; float* out; unsigned char* ws; int ph_lo, ph_hi; };
static_assert(sizeof(KArgs) == N_IN * 8 + 24, "KArgs has no padding");
typedef const __attribute__((address_space(4))) KArgs* KAP;
#define KA ((KAP)__builtin_amdgcn_kernarg_segment_ptr())

#define XB_TMO      128
#define XB_XCNT(j)  (256  + 64 * (j))
#define XB_XSUB(j)  (1280 + 64 * (j))
#define XB_XGEN(j)  (2304 + 64 * (j))
#define XB_TOP      3328
#define XB_TOPGEN   3392
#define XCD_BAR_WORDS 3456
#define XB_SPIN_CAP (1u << 18)

__device__ __forceinline__ unsigned xb_ld(unsigned* p)              { return __hip_atomic_load(p, __ATOMIC_RELAXED, __HIP_MEMORY_SCOPE_AGENT); }
__device__ __forceinline__ unsigned xb_add(unsigned* p, unsigned v) { return __hip_atomic_fetch_add(p, v, __ATOMIC_RELAXED, __HIP_MEMORY_SCOPE_AGENT); }
__device__ __forceinline__ unsigned xb_xcc_id() { return (unsigned)__builtin_amdgcn_s_getreg((3 << 11) | 20) & 0xFu; }
#define XB_SPIN(cond, bar) do { unsigned _sp = 0; while (cond) { __builtin_amdgcn_s_sleep(1); \
    if ((++_sp & 255u) == 0u) { if (xb_ld(&(bar)[XB_TMO])) break; if (_sp > XB_SPIN_CAP) { atomicAdd(&(bar)[XB_TMO], 1u); break; } } } } while (0)

struct XcdBarrier {
    unsigned* bar; unsigned x;
    volatile LAS unsigned* st;
};

__device__ __forceinline__ XcdBarrier xcd_barrier_post(unsigned* bar, volatile LAS unsigned* st) {
    XcdBarrier b; b.bar = bar; b.x = xb_xcc_id(); b.st = st;
    if (threadIdx.x == 0) (void)xb_add(&bar[XB_XCNT(b.x)], 1u);
    return b;
}
__device__ __forceinline__ void xcd_barrier_complete(unsigned* bar, unsigned x, unsigned& nloc, unsigned& nx) {
    const unsigned G = gridDim.x * gridDim.y * gridDim.z;
    unsigned sum, cnt, mine, sp = 0u;
    for (;;) {
        sum = 0u; cnt = 0u; mine = 0u;
#pragma unroll
        for (unsigned j = 0; j < 16; ++j) { const unsigned c = xb_ld(&bar[XB_XCNT(j)]); sum += c; cnt += (c > 0u) ? 1u : 0u; mine = (j == x) ? c : mine; }
        if (sum == G) break;
        __builtin_amdgcn_s_sleep(1);
        if ((++sp & 255u) == 0u) { if (xb_ld(&bar[XB_TMO])) break; if (sp > XB_SPIN_CAP) { atomicAdd(&bar[XB_TMO], 1u); break; } }
    }
    nloc = mine > 0u ? mine : 1u; nx = cnt > 0u ? cnt : 1u;
}

__device__ __forceinline__ void xcd_barrier(const XcdBarrier& b) {
    asm volatile("s_waitcnt vmcnt(0)" ::: "memory");
    __syncthreads();
    if (threadIdx.x == 0) {
        unsigned* bar = b.bar;
        __builtin_amdgcn_s_waitcnt(0);
        unsigned nloc = b.st[0], nx = b.st[1];
        if (nloc == 0u) { xcd_barrier_complete(bar, b.x, nloc, nx); b.st[0] = nloc; b.st[1] = nx; }
        const unsigned old = xb_add(&bar[XB_XSUB(b.x)], 1u);
        const unsigned gen = old / nloc;
        if (old + 1u == (gen + 1u) * nloc) {
            __builtin_amdgcn_fence(__ATOMIC_RELEASE, "agent");
            asm volatile("s_waitcnt vmcnt(0)" ::: "memory");
            const unsigned og = xb_add(&bar[XB_TOP], 1u);
            const unsigned tg = og / nx;
            if (og + 1u == (tg + 1u) * nx) xb_add(&bar[XB_TOPGEN], 1u);
            else XB_SPIN(xb_ld(&bar[XB_TOPGEN]) == tg, bar);
            __builtin_amdgcn_fence(__ATOMIC_ACQUIRE, "agent");
            xb_add(&bar[XB_XGEN(b.x)], 1u);
            asm volatile("s_waitcnt vmcnt(0)" ::: "memory");
        } else {
            XB_SPIN(xb_ld(&bar[XB_XGEN(b.x)]) == gen, bar);
            __builtin_amdgcn_fence(__ATOMIC_ACQUIRE, "agent");
            asm volatile("s_waitcnt vmcnt(0)" ::: "memory");
        }
    }
    __syncthreads();
}

struct Seg { const float* W; int ldw, c0, ncols, K; bf16* T; int ldt, r0; const float* g; };
__device__ __forceinline__ Seg get_seg(KAP a, unsigned char* ws, int idx) {
    Seg s; s.g = nullptr; s.r0 = 0; s.c0 = 0; s.ldw = 1024; s.ncols = 1024; s.K = 1024; s.ldt = 1024; s.W = nullptr; s.T = nullptr;
    if (idx < 4) { const int j = idx & 1; s.W = a->in[I_WFI] + (size_t)j * 1024 * 4112; s.ldw = 4112; s.T = (bf16*)(ws + WS_WFI) + (size_t)j * 4352 * 1024; s.g = a->in[I_GMIX] + (size_t)(2 * j) * 1024;
        if (idx < 2) { s.c0 = 0; s.ncols = 3072; s.r0 = 0; } else { s.c0 = 3088; s.ncols = 1024; s.r0 = 3072; } }
    else if (idx < 6) { const int j = idx - 4; s.W = a->in[I_WFO] + (size_t)j * 1024 * 1024; s.T = (bf16*)(ws + WS_WFO) + (size_t)j * 1024 * 1024; }
    else if (idx < 12) { const int e = idx - 6, j = e / 3, part = e % 3; s.W = a->in[I_WMA] + (size_t)j * 1024 * 672; s.ldw = 672; s.T = (bf16*)(ws + WS_WMA) + (size_t)j * 768 * 1024; s.g = a->in[I_GMIX] + (size_t)(2 * j + 1) * 1024;
        if (part == 0) { s.c0 = 384; s.ncols = 256; s.r0 = 0; } else if (part == 1) { s.c0 = 0; s.ncols = 384; s.r0 = 256; } else { s.c0 = 640; s.ncols = 32; s.r0 = 640; } }
    else if (idx < 14) { const int j = idx - 12; s.W = a->in[I_WMQB] + (size_t)j * 384 * 1536; s.ldw = 1536; s.ncols = 1536; s.K = 384; s.T = (bf16*)(ws + WS_WMQ) + (size_t)j * 1536 * 384; s.ldt = 384; s.g = a->in[I_GMQ] + (size_t)j * 384; }
    else if (idx < 18) { const int j = idx & 1; const bool raw = idx >= 16; s.W = a->in[I_WMKVB] + (size_t)j * 256 * 2048; s.ldw = 2048; s.ncols = 2048; s.K = 256; s.ldt = 256;
        s.T = (bf16*)(ws + (raw ? WS_WMKVR : WS_WMKV)) + (size_t)j * 2048 * 256; s.g = raw ? nullptr : a->in[I_GMKV] + (size_t)j * 256; }
    else if (idx < 20) { const int j = idx - 18; s.W = a->in[I_WMO] + (size_t)j * 1024 * 1024; s.T = (bf16*)(ws + WS_WMO) + (size_t)j * 1024 * 1024; }
    else if (idx < 24) { const int i = idx - 20; s.W = a->in[I_WXQ] + (size_t)i * 1024 * 1024; s.T = (bf16*)(ws + WS_WXQ) + (size_t)i * 1024 * 1024; s.g = a->in[I_GCROSS] + (size_t)i * 1024; }
    else if (idx < 28) { const int i = idx - 24; s.W = a->in[I_WXO] + (size_t)i * 1024 * 1024; s.T = (bf16*)(ws + WS_WXO) + (size_t)i * 1024 * 1024; }
    else if (idx < 32) { const int i = idx - 28; s.W = a->in[I_WXKV] + (size_t)i * 1024 * 2048; s.ldw = 2048; s.ncols = 2048; s.T = (bf16*)(ws + WS_WXKV) + (size_t)i * 2048 * 1024; s.g = a->in[I_GMEM] + (size_t)i * 1024; }
    else if (idx < 36) { const int i = idx - 32; s.W = a->in[I_WDN] + (size_t)i * 2816 * 1024; s.K = 2816; s.T = (bf16*)(ws + WS_WDN) + (size_t)i * 1024 * 2816; s.ldt = 2816; }
    else if (idx < 212) { const int e = idx - 36, i = e / 44, t = e % 44, pn = t >> 1, half = t & 1; s.W = a->in[I_WGU] + (size_t)i * 1024 * 5632; s.ldw = 5632; s.c0 = half * 2816 + 128 * pn; s.ncols = 128;
        s.T = (bf16*)(ws + WS_WGU) + (size_t)i * 5632 * 1024; s.r0 = 256 * pn + 128 * half; s.g = a->in[I_GFFN] + (size_t)i * 1024; }
    else { const int j = idx - 212; s.W = a->in[I_WFI] + (size_t)j * 1024 * 4112; s.ldw = 4112; s.c0 = 3072; s.ncols = 32; s.T = (bf16*)(ws + WS_WFI) + (size_t)j * 4352 * 1024; s.r0 = 4096; s.g = a->in[I_GMIX] + (size_t)(2 * j) * 1024; }
    return s;
}
constexpr int NSEG = 214;
__device__ __forceinline__ void tr_load(const Seg& s, int item, int lane, float (&v)[32]) {
    const int nnb = s.ncols / 32, kb = item / nnb, nb = item % nnb; const float* p = s.W + (size_t)(64 * kb + (lane >> 5)) * s.ldw + s.c0 + 32 * nb + (lane & 31);
#pragma unroll
    for (int i = 0; i < 32; ++i) v[i] = p[(size_t)(2 * i) * s.ldw];
}
__device__ __forceinline__ void tr_store(const Seg& s, int item, int lane, const float (&v)[32], LAS float* scr) {
    const int nnb = s.ncols / 32, kb = item / nnb, nb = item % nnb, k0 = 64 * kb, n0 = 32 * nb;
#pragma unroll
    for (int i = 0; i < 32; ++i) scr[(2 * i + (lane >> 5)) * 33 + (lane & 31)] = v[i];
    LDS_WAIT(); asm volatile("" ::: "memory");
    const int c = lane & 7; f32x4 g0 = (f32x4){1.f, 1.f, 1.f, 1.f}, g1 = g0;
    if (s.g) { g0 = *(const f32x4*)(s.g + k0 + 8 * c); g1 = *(const f32x4*)(s.g + k0 + 8 * c + 4); }
#pragma unroll
    for (int j = 0; j < 4; ++j) { const int n = (lane >> 3) + 8 * j; const LAS float* p = scr + (8 * c) * 33 + n;
        u32x4 o; o.x = pk2(p[0 * 33] * g0[0], p[1 * 33] * g0[1]); o.y = pk2(p[2 * 33] * g0[2], p[3 * 33] * g0[3]); o.z = pk2(p[4 * 33] * g1[0], p[5 * 33] * g1[1]); o.w = pk2(p[6 * 33] * g1[2], p[7 * 33] * g1[3]);
        *(u32x4*)(s.T + (size_t)(s.r0 + n0 + n) * s.ldt + k0 + 8 * c) = o; }
    LDS_WAIT(); asm volatile("" ::: "memory");
}
__device__ __forceinline__ void cvt_blocks(const float* src, bf16* dst, int nblk, int blk, size_t dstride, int gtid, int nthr) {
    const long total = (long)nblk * blk / 8;
    for (long v = gtid; v < total; v += nthr) { const long e = v * 8; const int b = (int)(e / blk), o = (int)(e % blk);
        const f32x4 x = *(const f32x4*)(src + e), y = *(const f32x4*)(src + e + 4);
        *(u32x4*)(dst + (size_t)b * dstride + o) = (u32x4){pk2(x[0], x[1]), pk2(x[2], x[3]), pk2(y[0], y[1]), pk2(y[2], y[3])}; }
}
__device__ __forceinline__ void p0_prologue(KAP a, LAS unsigned char* lds, int gw, int NGW, int wave, int lane, int pmask) {
    unsigned char* ws = a->ws; const int gtid = gw * 64 + lane, nthr = NGW * 64;
    LAS float* scr = (LAS float*)(lds + RING_OFF + wave * 16384);
#undef P0_PARTS
#define P0_PARTS pmask
    if (P0_PARTS & 1) {
        int total = 0;
        for (int sg = 0; sg < NSEG; ++sg) { const Seg s = get_seg(a, ws, sg); total += (s.K / 64) * (s.ncols / 32); }
        int sg = 0, base = 0; Seg sc = get_seg(a, ws, 0); int nit = (sc.K / 64) * (sc.ncols / 32);
#define P0_ADVANCE(gi) while ((gi) >= base + nit) { base += nit; ++sg; sc = get_seg(a, ws, sg); nit = (sc.K / 64) * (sc.ncols / 32); }
        float va[32], vb[32]; Seg sa = sc, sb = sc; int ia = 0, ib = 0;
        int gi = gw;
        if (gi < total) { P0_ADVANCE(gi); sa = sc; ia = gi - base; tr_load(sa, ia, lane, va); }
        while (gi < total) {
            int gn = gi + NGW;
            if (gn < total) { P0_ADVANCE(gn); sb = sc; ib = gn - base; tr_load(sb, ib, lane, vb); }
            tr_store(sa, ia, lane, va, scr);
            gi = gn; if (gi >= total) break;
            gn = gi + NGW;
            if (gn < total) { P0_ADVANCE(gn); sa = sc; ia = gn - base; tr_load(sa, ia, lane, va); }
            tr_store(sb, ib, lane, vb, scr);
            gi = gn;
        }
#undef P0_ADVANCE
    }
    if (P0_PARTS & 2) {
    cvt_blocks(a->in[I_WMKVB], (bf16*)(ws + WS_WKN), 1, 2 * 256 * 2048, 0, gtid, nthr); }
    if (P0_PARTS & 4) { const u32x4 z = (u32x4){0u, 0u, 0u, 0u};
      for (int v = gtid; v < 2 * 224 * 128; v += nthr) { const int j = v / (224 * 128), r = v % (224 * 128); *(u32x4*)((bf16*)(ws + WS_WFI) + ((size_t)j * 4352 + 4128) * 1024 + (size_t)r * 8) = z; }
      for (int v = gtid; v < 2 * 96 * 128; v += nthr) { const int j = v / (96 * 128), r = v % (96 * 128); *(u32x4*)((bf16*)(ws + WS_WMA) + ((size_t)j * 768 + 672) * 1024 + (size_t)r * 8) = z; }
    }
    if (P0_PARTS & 16) for (int v = gtid; v < 4096 * 16; v += nthr) { const int pos = v >> 4, c = v & 15; const double inv = pow(10000.0, -(double)c / 16.0), ang = (double)pos * inv;
        ((float*)(ws + WS_ROPC))[v] = (float)cos(ang); ((float*)(ws + WS_ROPS))[v] = (float)sin(ang); }
    if (P0_PARTS & 32) for (int row = gw; row < MT; row += NGW) { const float* xr = (row < MP) ? a->in[I_XP] + (size_t)row * 1024 : a->in[I_XS] + (size_t)(row - MP) * 1024;
        float sq = 0.f; bf16* o = (bf16*)(ws + WS_XB) + (size_t)row * 1024;
#pragma unroll
        for (int j = 0; j < 4; ++j) { const f32x4 v = *(const f32x4*)(xr + 256 * j + 4 * lane); sq += pg8::dot4(v); *(u32x2*)(o + 256 * j + 4 * lane) = pg8::pk4(v); }
        sq = wave_sum(sq);
        if (lane < 16) ((float*)(ws + WS_SSQ))[(size_t)row * 16 + lane] = (lane == 0) ? sq : 0.f; }
    if (P0_PARTS & 64) for (int row = gw; row < 2048; row += NGW) { const float* xr = a->in[I_MEM] + (size_t)row * 1024; f32x4 v[4]; float sq = 0.f;
#pragma unroll
        for (int j = 0; j < 4; ++j) { v[j] = *(const f32x4*)(xr + 256 * j + 4 * lane); sq += pg8::dot4(v[j]); }
        const float r = rsqrtf(wave_sum(sq) * (1.0f / 1024.0f) + EPS); bf16* o = (bf16*)(ws + WS_MB) + (size_t)row * 1024;
#pragma unroll
        for (int j = 0; j < 4; ++j) *(u32x2*)(o + 256 * j + 4 * lane) = pg8::pk4(v[j] * r); }
}

__device__ __forceinline__ float ssq_rstd16(const float* ssq, int row) {
    const f32x4 a = *(const f32x4*)(ssq + (size_t)row * 16), b = *(const f32x4*)(ssq + (size_t)row * 16 + 4), c = *(const f32x4*)(ssq + (size_t)row * 16 + 8), d = *(const f32x4*)(ssq + (size_t)row * 16 + 12);
    const float s = ((a[0] + a[1]) + (a[2] + a[3])) + ((b[0] + b[1]) + (b[2] + b[3])) + ((c[0] + c[1]) + (c[2] + c[3])) + ((d[0] + d[1]) + (d[2] + d[3]));
    return rsqrtf(s * (1.0f / 1024.0f) + EPS);
}
__device__ __forceinline__ void cum_local_prompt(KAP a, int bh, LAS float* red, int wave, int lane) {
    unsigned char* ws = a->ws; const float* lfr = (const float*)(ws + WS_LFR); const int b = bh >> 4, h = bh & 15; float* cb = (float*)(ws + WS_CB) + (size_t)bh * 4096;
    float v[8];
#pragma unroll
    for (int k = 0; k < 8; ++k) v[k] = lfr[((size_t)b * 4096 + 512 * wave + 64 * k + lane) * 16 + h];
    float carry = 0.f;
#pragma unroll
    for (int k = 0; k < 8; ++k) {
#pragma unroll
        for (int o = 1; o < 64; o <<= 1) { const float y = __shfl_up(v[k], o); if (lane >= o) v[k] += y; }
        v[k] += carry; carry = __shfl(v[k], 63); }
    if (lane == 0) red[wave] = carry;
    __syncthreads();
    float off = 0.f;
#pragma unroll
    for (int w = 0; w < 7; ++w) off += (w < wave) ? red[w] : 0.f;
#pragma unroll
    for (int k = 0; k < 8; ++k) cb[512 * wave + 64 * k + lane] = -(v[k] + off) * LOG2E;
    VM_WAIT(); __syncthreads();
}
__device__ __forceinline__ void cum_local_sample(KAP a, int L, int pair, LAS float* red, int wave, int lane) {
    unsigned char* ws = a->ws; const float* lfr = (const float*)(ws + WS_LFR); const int bs = pair >> 4, h = pair & 15;
    const float* lfc = a->in[I_CFL] + (size_t)L * 32 * 2048 * 16; float* cb = (float*)(ws + WS_CBS) + (size_t)pair * 2080;
    float x[4], v[4];
#pragma unroll
    for (int k = 0; k < 4; ++k) x[k] = lfc[((size_t)bs * 2048 + 256 * wave + 64 * k + lane) * 16 + h];
    float carry = 0.f;
#pragma unroll
    for (int k = 3; k >= 0; --k) { float t = x[k];
#pragma unroll
        for (int o = 1; o < 64; o <<= 1) { const float y = __shfl_down(t, o); if (lane + o < 64) t += y; }
        v[k] = carry + t - x[k]; carry += __shfl(t, 0); }
    if (lane == 0) red[wave] = carry;
    __syncthreads();
    float off = 0.f;
#pragma unroll
    for (int w = 1; w < 8; ++w) off += (w > wave) ? red[w] : 0.f;
#pragma unroll
    for (int k = 0; k < 4; ++k) cb[256 * wave + 64 * k + lane] = (v[k] + off) * LOG2E;
    if (wave == 0) { float t = (lane < 16) ? lfr[((size_t)MP + bs * 16 + lane) * 16 + h] : 0.f;
#pragma unroll
        for (int o = 1; o < 16; o <<= 1) { const float y = __shfl_up(t, o); if (lane >= o) t += y; }
        if (lane < 32) cb[2048 + lane] = (lane < 16) ? -t * LOG2E : 0.f; }
    VM_WAIT(); __syncthreads();
}
__device__ __forceinline__ void ckv_fixup(KAP a, int L, int gw, int NGW, int lane) {
    unsigned char* ws = a->ws; const f32x4 g = *(const f32x4*)(a->in[I_GMKV] + (size_t)L * 256 + 4 * lane);
    for (int row = gw; row < MT; row += NGW) { const f32x4 s4 = *(const f32x4*)((const float*)(ws + WS_SSQKV) + (size_t)row * 4);
        const float r = rsqrtf(((s4[0] + s4[1]) + (s4[2] + s4[3])) * (1.0f / 256.0f) + EPS);
        const f32x4 v = *(const f32x4*)((const float*)(ws + WS_CKVU) + (size_t)row * 256 + 4 * lane) * r * g;
        if (row < MP) *(f32x4*)(a->out + O_MCP + ((size_t)L * MP + row) * 256 + 4 * lane) = v;
        else { const int rs = row - MP, bs = rs >> 4, t = rs & 15; *(f32x4*)(a->out + O_MCS + ((size_t)L * MS + rs) * 256 + 4 * lane) = v;
            (void)bs; (void)t; } }
}
__device__ __forceinline__ void final_phase(KAP a, int gw, int NGW, int lane) {
    for (int row = gw; row < MT; row += NGW) { const float r = ssq_rstd16((const float*)(a->ws + WS_SSQ), row); float* y = a->out + (size_t)row * 1024; const bf16* x = (const bf16*)(a->ws + WS_XB) + (size_t)row * 1024;
#pragma unroll
        for (int j = 0; j < 4; ++j) { const f32x4 g = *(const f32x4*)(a->in[I_GFINAL] + 256 * j + 4 * lane); const u32x2 w = *(const u32x2*)(x + 256 * j + 4 * lane);
            const f32x4 xv = (f32x4){__builtin_bit_cast(float, w.x << 16), __builtin_bit_cast(float, w.x & 0xffff0000u), __builtin_bit_cast(float, w.y << 16), __builtin_bit_cast(float, w.y & 0xffff0000u)};
            *(f32x4*)(y + 256 * j + 4 * lane) = xv * r * g; } }
}

__device__ __forceinline__ void foxs_item(KAP a, int L, int it, LAS unsigned char* lds, int wid, int lane) {
    unsigned char* ws = a->ws; const int pair = it * 2 + (wid >> 2), b = pair >> 4, h = pair & 15, sp = wid & 3, g = lane >> 4, li = lane & 15;
    const float* ck = a->in[I_CFK] + (size_t)L * 32 * 2048 * 1024 + ((size_t)b * 2048 * 16 + h) * 64;
    const float* cv = a->in[I_CFV] + (size_t)L * 32 * 2048 * 1024 + ((size_t)b * 2048 * 16 + h) * 64;
    const float* cbs = (const float*)(ws + WS_CBS) + (size_t)pair * 2080;
    const bf16* QF = (const bf16*)(ws + WS_QF); const bf16* KF = (const bf16*)(ws + WS_KF); const bf16* VF = (const bf16*)(ws + WS_VF);
    const size_t srow = (size_t)MP + b * 16;
    bf16x8 qf[2];
#pragma unroll
    for (int d0 = 0; d0 < 2; ++d0) qf[d0] = *(const bf16x8*)(QF + (srow + li) * 1024 + h * 64 + 32 * d0 + 8 * g);
    float m = -1e30f, l = 0.f; f32x4 o[4];
#pragma unroll
    for (int db = 0; db < 4; ++db) o[db] = (f32x4){0.f, 0.f, 0.f, 0.f};
    const int kv0 = 512 * sp;
    auto kl = [&](int s, int blk, int d0) -> bf16x8 { const float* p = ck + (size_t)(kv0 + 32 * s + 16 * blk + li) * 1024 + 32 * d0 + 8 * g; return a16::cvt8(*(const f32x4*)p, *(const f32x4*)(p + 4)); };
    auto vl = [&](int s, int db) -> bf16x8 { const float* p = cv + (size_t)(kv0 + 32 * s + 4 * g) * 1024 + 16 * db + li;
        const f32x4 x = (f32x4){p[0], p[1024], p[2048], p[3072]}, y = (f32x4){p[16 * 1024], p[17 * 1024], p[18 * 1024], p[19 * 1024]}; return a16::cvt8(x, y); };
    auto sf = [&](int s, f32x4& sA, f32x4& sB) { const float* p = cbs + kv0 + 32 * s + 4 * g; sA += *(const f32x4*)p; sB += *(const f32x4*)(p + 16); };
    {
        auto kraw = [&](int s, f32x4 (&kr)[8]) {
#pragma unroll
            for (int blk = 0; blk < 2; ++blk)
#pragma unroll
                for (int d0 = 0; d0 < 2; ++d0) { const float* p = ck + (size_t)(kv0 + 32 * s + 16 * blk + li) * 1024 + 32 * d0 + 8 * g; kr[(blk * 2 + d0) * 2] = *(const f32x4*)p; kr[(blk * 2 + d0) * 2 + 1] = *(const f32x4*)(p + 4); } };
        auto vraw = [&](int s, f32x4 (&vr)[8]) {
#pragma unroll
            for (int db = 0; db < 4; ++db) { const float* p = cv + (size_t)(kv0 + 32 * s + 4 * g) * 1024 + 16 * db + li;
                vr[2 * db] = (f32x4){p[0], p[1024], p[2048], p[3072]}; vr[2 * db + 1] = (f32x4){p[16 * 1024], p[17 * 1024], p[18 * 1024], p[19 * 1024]}; } };
        auto step = [&](int s, const f32x4 (&kc)[8], const f32x4 (&vc)[8]) {
            f32x4 sA = {0.f, 0.f, 0.f, 0.f}, sB = {0.f, 0.f, 0.f, 0.f};
#pragma unroll
            for (int d0 = 0; d0 < 2; ++d0) { sA = a16::mfma16(a16::cvt8(kc[d0 * 2], kc[d0 * 2 + 1]), qf[d0], sA); sB = a16::mfma16(a16::cvt8(kc[(2 + d0) * 2], kc[(2 + d0) * 2 + 1]), qf[d0], sB); }
            sf(s, sA, sB);
            float mx = __builtin_fmaxf(__builtin_fmaxf(__builtin_fmaxf(sA[0], sA[1]), __builtin_fmaxf(sA[2], sA[3])), __builtin_fmaxf(__builtin_fmaxf(sB[0], sB[1]), __builtin_fmaxf(sB[2], sB[3])));
            mx = __builtin_fmaxf(mx, __shfl_xor(mx, 16)); mx = __builtin_fmaxf(mx, __shfl_xor(mx, 32));
            const float mn = __builtin_fmaxf(m, mx), alpha = ex2(m - mn); m = mn;
            f32x4 pA, pB;
#pragma unroll
            for (int r = 0; r < 4; ++r) { pA[r] = ex2(sA[r] - mn); pB[r] = ex2(sB[r] - mn); }
            float ps = ((pA[0] + pA[1]) + (pA[2] + pA[3])) + ((pB[0] + pB[1]) + (pB[2] + pB[3]));
            ps += __shfl_xor(ps, 16); ps += __shfl_xor(ps, 32);
            l = l * alpha + ps;
            const float a0 = __shfl(alpha, 4 * g), a1 = __shfl(alpha, 4 * g + 1), a2 = __shfl(alpha, 4 * g + 2), a3 = __shfl(alpha, 4 * g + 3);
#pragma unroll
            for (int db = 0; db < 4; ++db) { o[db][0] *= a0; o[db][1] *= a1; o[db][2] *= a2; o[db][3] *= a3; }
            const u32x4 pw = (u32x4){pk2(pA[0], pA[1]), pk2(pA[2], pA[3]), pk2(pB[0], pB[1]), pk2(pB[2], pB[3])};
            const bf16x8 pf = __builtin_bit_cast(bf16x8, pw);
#pragma unroll
            for (int db = 0; db < 4; ++db) o[db] = a16::mfma16(pf, a16::cvt8(vc[2 * db], vc[2 * db + 1]), o[db]); };
        f32x4 ka[8], va[8], kb[8], vb[8]; kraw(0, ka); vraw(0, va);
#pragma unroll 1
        for (int s = 0; s < 16; s += 2) {
            kraw(s + 1, kb); vraw(s + 1, vb);
            step(s, ka, va);
            const int sn = (s < 14) ? s + 2 : 15; kraw(sn, ka); vraw(sn, va);
            step(s + 1, kb, vb);
        }
    }
    if (sp == 3) {
        auto kl2 = [&](int, int blk, int d0) -> bf16x8 { bf16x8 z = {0, 0, 0, 0, 0, 0, 0, 0}; if (blk == 0) z = *(const bf16x8*)(KF + (srow + li) * 1024 + h * 64 + 32 * d0 + 8 * g); return z; };
        auto vl2 = [&](int, int db) -> bf16x8 { const bf16* p = VF + (srow + 4 * g) * 1024 + h * 64 + 16 * db + li;
            const u32x4 w = (u32x4){(unsigned)p[0] | ((unsigned)p[1024] << 16), (unsigned)p[2048] | ((unsigned)p[3072] << 16), 0u, 0u}; return __builtin_bit_cast(bf16x8, w); };
        auto sf2 = [&](int, f32x4& sA, f32x4& sB) { const f32x4 bb = *(const f32x4*)(cbs + 2048 + 4 * g);
#pragma unroll
            for (int r = 0; r < 4; ++r) { sA[r] = (4 * g + r > li) ? -INFINITY : sA[r] + bb[r]; sB[r] = -INFINITY; } };
        a16::steps<2, 4>(0, 1, qf, kl2, vl2, sf2, m, l, o, lane);
    }
    LAS float* PO = (LAS float*)(lds + RING_OFF) + wid * 1024; LAS float* PM = (LAS float*)(lds + RING_OFF + 32768) + wid * 32;
#pragma unroll
    for (int db = 0; db < 4; ++db)
#pragma unroll
        for (int r = 0; r < 4; ++r) PO[(4 * g + r) * 64 + 16 * db + li] = o[db][r];
    if (g == 0) { PM[li] = m; PM[16 + li] = l; }
    __syncthreads();
    {
        const int w0 = (wid >> 2) * 4, db = wid & 3; const bf16* GF = (const bf16*)(ws + WS_GF); bf16* OF = (bf16*)(ws + WS_OM);
#pragma unroll
        for (int r = 0; r < 4; ++r) { const int q = 4 * g + r; float mm = -1e30f;
#pragma unroll
            for (int s2 = 0; s2 < 4; ++s2) mm = __builtin_fmaxf(mm, ((LAS float*)(lds + RING_OFF + 32768) + (w0 + s2) * 32)[q]);
            float num = 0.f, den = 0.f;
#pragma unroll
            for (int s2 = 0; s2 < 4; ++s2) { LAS float* pm = (LAS float*)(lds + RING_OFF + 32768) + (w0 + s2) * 32; const float wgt = ex2(pm[q] - mm);
                num += wgt * ((LAS float*)(lds + RING_OFF) + (w0 + s2) * 1024)[q * 64 + 16 * db + li]; den += wgt * pm[16 + q]; }
            const size_t idx = (srow + q) * 1024 + h * 64 + 16 * db + li;
            OF[idx] = (bf16)(pk2(num / den * bf2f(GF[idx]), 0.f) & 0xffffu); }
    }
    __syncthreads();
}
__device__ __forceinline__ void mlas_qprime(KAP a, int L, int it, LAS unsigned char* lds, int wid, int lane) {
    unsigned char* ws = a->ws; const int b = (it < 256) ? (it >> 3) : (it - 256), c = (it < 256) ? (it & 7) : 8, g = lane >> 4, li = lane & 15;
    const bf16* QM = (const bf16*)(ws + WS_QM); const bf16* WKN = (const bf16*)(ws + WS_WKN) + (size_t)L * 256 * 2048;
    bf16* QA = (bf16*)(ws + WS_QA) + (size_t)it * 256 * 288;
    LAS bf16* scr = (LAS bf16*)(lds + RING_OFF + wid * 9216);
    for (int hh = 0; hh < 2; ++hh) { const int h = 2 * wid + hh; const bf16* qrow = QM + ((size_t)MP + b * 16 + li) * 1536 + h * 96; bf16* qa = QA + (size_t)(wid * 32 + hh * 16) * 288;
        const bf16x8 qn0 = *(const bf16x8*)(qrow + 8 * g), qn1 = *(const bf16x8*)(qrow + 32 + 8 * g);
#pragma unroll
        for (int cb = 0; cb < 16; ++cb) { const bf16* wp = WKN + (size_t)(16 * cb + li) * 2048 + h * 128 + 8 * g;
            f32x4 acc = a16::mfma16(qn0, *(const bf16x8*)wp, (f32x4){0.f, 0.f, 0.f, 0.f}); acc = a16::mfma16(qn1, *(const bf16x8*)(wp + 32), acc);
#pragma unroll
            for (int r = 0; r < 4; ++r) scr[(4 * g + r) * 288 + 16 * cb + li] = (bf16)(pk2(acc[r], 0.f) & 0xffffu); }
        *(LAS bf16x8*)(scr + li * 288 + 256 + 8 * g) = *(const bf16x8*)(qrow + 64 + 8 * g);
        LDS_WAIT();
#pragma unroll
        for (int j = 0; j < 9; ++j) *(u32x4*)(qa + (size_t)(lane + 64 * j) * 8) = *(const LAS u32x4*)(scr + (lane + 64 * j) * 8);
        LDS_WAIT(); }
    VM_WAIT(); __syncthreads();
}
__device__ __forceinline__ void mlas_attn(KAP a, int L, int it, int qa_it, LAS unsigned char* lds, unsigned lds0) {
    unsigned char* ws = a->ws; const int b = (it < 256) ? (it >> 3) : (it - 256), c = (it < 256) ? (it & 7) : 8; const bf16* QA = (const bf16*)(ws + WS_QA) + (size_t)qa_it * 256 * 288;
    float* P = (float*)(ws + WS_PART) + ((size_t)(b * 9 + c) * 256) * ms::PROW;
    if (c < 8) { const size_t jb = (size_t)L * 32 + b;
        ms::unit<8>(a->in[I_CCKV] + (jb * 2048 + 256 * c) * 256, a->in[I_CKR] + (jb * 2048 + 256 * c) * 32, 255, QA, P, (LAS char*)(lds + RING_OFF), lds0 + RING_OFF);
    } else { const size_t ro = (size_t)L * MS + b * 16;
        ms::unit<1>(a->out + O_MCS + ro * 256, a->out + O_MRS + ro * 32, 15, QA, P, (LAS char*)(lds + RING_OFF), lds0 + RING_OFF); }
}
__device__ __forceinline__ void mlas_combine(KAP a, int L, LAS unsigned char* lds, int vcu, int G, int wid, int lane) {
    unsigned char* ws = a->ws; const int grp = wid >> 2, k = wid & 3; LAS bf16* scr = (LAS bf16*)(lds + RING_OFF + grp * 8192);
    const bf16* WV = (const bf16*)(ws + WS_WMKVR) + (size_t)L * 2048 * 256; bf16* OM = (bf16*)(ws + WS_OM); const int g = lane >> 4, li = lane & 15;
    for (int e0 = vcu * 2; e0 < 512; e0 += G * 2) { const int e = e0 + grp, b = e >> 4, h = e & 15; const int q = lane >> 2, cg = 64 * k + (lane & 3) * 16;
        const float* P0 = (const float*)(ws + WS_PART) + ((size_t)(b * 9) * 256 + (h >> 1) * 32 + (h & 1) * 16 + q) * ms::PROW; constexpr size_t CS = (size_t)256 * ms::PROW;
        float pm[9], pl[9], mm = -1e30f;
#pragma unroll
        for (int c = 0; c < 9; ++c) { pm[c] = P0[c * CS + 256]; pl[c] = P0[c * CS + 257]; }
        f32x4 pv[4][9];
#pragma unroll
        for (int j = 0; j < 4; ++j)
#pragma unroll
            for (int c = 0; c < 9; ++c) pv[j][c] = *(const f32x4*)(P0 + c * CS + cg + 4 * j);
#pragma unroll
        for (int c = 0; c < 9; ++c) mm = __builtin_fmaxf(mm, pm[c]);
        float wgt[9], den = 0.f;
#pragma unroll
        for (int c = 0; c < 9; ++c) { wgt[c] = ex2(pm[c] - mm); den += wgt[c] * pl[c]; }
        const float id = 1.0f / den;
#pragma unroll
        for (int j = 0; j < 4; ++j) { f32x4 acc = (f32x4){0.f, 0.f, 0.f, 0.f};
#pragma unroll
            for (int c = 0; c < 9; ++c) acc += pv[j][c] * wgt[c];
            *(LAS u32x2*)(scr + q * 256 + cg + 4 * j) = pg8::pk4(acc * id); }
        __syncthreads();
        bf16x8 af[8];
#pragma unroll
        for (int d0 = 0; d0 < 8; ++d0) af[d0] = *(const LAS bf16x8*)(scr + li * 256 + 32 * d0 + 8 * g);
        { const int db = k; f32x4 acc = (f32x4){0.f, 0.f, 0.f, 0.f}; const bf16* wp = WV + (size_t)(h * 128 + 64 + 16 * db + li) * 256 + 8 * g;
#pragma unroll
            for (int d0 = 0; d0 < 8; ++d0) acc = a16::mfma16(af[d0], *(const bf16x8*)(wp + 32 * d0), acc);
            bf16* O = OM + ((size_t)MP + b * 16 + 4 * g) * 1024 + h * 64 + 16 * db + li; const unsigned w0 = pk2(acc[0], acc[1]), w1 = pk2(acc[2], acc[3]);
            O[0] = (bf16)(w0 & 0xffffu); O[1024] = (bf16)(w0 >> 16); O[2048] = (bf16)(w1 & 0xffffu); O[3072] = (bf16)(w1 >> 16); }
        __syncthreads();
    }
}
typedef float f32x2v_t __attribute__((ext_vector_type(2)));
template <int K, class F> __device__ __forceinline__ void thin_tiles(const bf16* A, const bf16* Bt, LAS unsigned char* lds, int vcu, int G, int wave, int lane, F epi) {
    const int g = lane >> 4, li = lane & 15; constexpr int nks = K / 256;
    LAS float* part = (LAS float*)(lds + RING_OFF);
#pragma unroll 1
    for (int tt = vcu; tt < 256; tt += G) { const int rb = tt & 31, cgp = tt >> 5;
        const bf16* ap = A + (size_t)(MP + 16 * rb + li) * K + wave * (K / 8) + 8 * g; const bf16* bp = Bt + (size_t)(128 * cgp + li) * K + wave * (K / 8) + 8 * g;
        f32x4 acc[8];
#pragma unroll
        for (int nb = 0; nb < 8; ++nb) acc[nb] = (f32x4){0.f, 0.f, 0.f, 0.f};
#pragma unroll
        for (int s0 = 0; s0 < nks; s0 += 4) { bf16x8 a[4], b[4][8]; const bf16x8 z = {0, 0, 0, 0, 0, 0, 0, 0};
#pragma unroll
            for (int u = 0; u < 4; ++u) { const bool on = s0 + u < nks; a[u] = on ? *(const bf16x8*)(ap + 32 * (s0 + u)) : z;
#pragma unroll
                for (int nb = 0; nb < 8; ++nb) b[u][nb] = on ? *(const bf16x8*)(bp + (size_t)nb * 16 * K + 32 * (s0 + u)) : z; }
#pragma unroll
            for (int u = 0; u < 4; ++u) if (s0 + u < nks)
#pragma unroll
                for (int nb = 0; nb < 8; ++nb) acc[nb] = a16::mfma16(a[u], b[u][nb], acc[nb]); }
#pragma unroll
        for (int nb = 0; nb < 8; ++nb)
#pragma unroll
            for (int r = 0; r < 4; ++r) part[wave * 2048 + (4 * g + r) * 128 + 16 * nb + li] = acc[nb][r];
        __syncthreads();
        const int e = (2 * wave + (lane >> 5)) * 128 + 4 * (lane & 31); f32x4 sv = (f32x4){0.f, 0.f, 0.f, 0.f};
#pragma unroll
        for (int w = 0; w < 8; ++w) sv += *(const LAS f32x4*)(part + w * 2048 + e);
        epi(MP + 16 * rb + 2 * wave + (lane >> 5), 128 * cgp + 4 * (lane & 31), sv);
        __syncthreads(); }
}
template <int K> __device__ __forceinline__ void thin_resid(KAP a, const bf16* A, const bf16* Bt, int first, LAS unsigned char* lds, int vcu, int G, int wave, int lane) {
    unsigned char* ws = a->ws; const float* xs = a->in[I_XS] - (size_t)MP * 1024; bf16* XB = (bf16*)(ws + WS_XB); float* SSQ = (float*)(ws + WS_SSQ);
    thin_tiles<K>(A, Bt, lds, vcu, G, wave, lane, [&](int row, int col, f32x4 v) {
        const size_t o = (size_t)row * 1024 + col; f32x4 x;
        if (first) x = *(const f32x4*)(xs + o);
        else { const u32x2 w = *(const u32x2*)(XB + o); x = (f32x4){__builtin_bit_cast(float, w.x << 16), __builtin_bit_cast(float, w.x & 0xffff0000u), __builtin_bit_cast(float, w.y << 16), __builtin_bit_cast(float, w.y & 0xffff0000u)}; }
        x += v; *(u32x2*)(XB + o) = (u32x2){pk2(x[0], x[1]), pk2(x[2], x[3])};
        float sq = (x[0] * x[0] + x[1] * x[1]) + (x[2] * x[2] + x[3] * x[3]); sq += __shfl_xor(sq, 1); sq += __shfl_xor(sq, 2); sq += __shfl_xor(sq, 4); sq += __shfl_xor(sq, 8);
        if ((lane & 15) == 0) SSQ[(size_t)row * 16 + (col >> 6)] = sq; });
}
__device__ __forceinline__ void thin_xq(KAP a, const bf16* Bt, LAS unsigned char* lds, int vcu, int G, int wave, int lane) {
    unsigned char* ws = a->ws; const bf16* XB = (const bf16*)(ws + WS_XB); bf16* QX = (bf16*)(ws + WS_QX); const float* SSQ = (const float*)(ws + WS_SSQ);
    thin_tiles<1024>(XB, Bt, lds, vcu, G, wave, lane, [&](int row, int col, f32x4 v) {
        const float rs = ssq_rstd16(SSQ, row) * C2_X; *(u32x2*)(QX + (size_t)row * 1024 + col) = (u32x2){pk2(v[0] * rs, v[1] * rs), pk2(v[2] * rs, v[3] * rs)}; });
}
#ifndef DBG_DOUBLE
#define DBG_DOUBLE 0
#endif

constexpr int NPH = 41;
struct Ctx { int lane, wave, G, bx, vcu, gw, NGW; };
__device__ __forceinline__ Ctx mk_ctx() { Ctx c; const int tid = pg8::pg8_tid(); c.lane = tid & 63; c.wave = __builtin_amdgcn_readfirstlane(tid >> 6); int G_ = gridDim.x, bx_ = blockIdx.x; asm volatile("" : "+s"(G_), "+s"(bx_)); c.G = G_; c.bx = bx_;
    c.vcu = (c.G % 8 == 0) ? (c.bx % 8) * (c.G / 8) + c.bx / 8 : c.bx; c.gw = c.vcu * NWAVES + c.wave; c.NGW = c.G * NWAVES; return c; }
#define RSX(ws) pg8::RowScale{(const float*)((ws) + WS_SSQ), 16, 4, 1.0f / 1024.0f}
#define PHASE __device__ __noinline__ void
#define FATPH __device__ __forceinline__ void
__device__ __forceinline__ unsigned char* ws_ptr() { GAS unsigned char* w = (GAS unsigned char*)KA->ws; asm volatile("" : "+s"(w)); return (unsigned char*)w; }
#define WSB(off) ((const bf16*)(ws_ptr() + (off)))
__device__ __forceinline__ const float* in_ptr(int i) { GAS const float* w = (GAS const float*)KA->in[i]; asm volatile("" : "+s"(w)); return (const float*)w; }
__device__ __forceinline__ float* out_ptr() { GAS float* w = (GAS float*)KA->out; asm volatile("" : "+s"(w)); return (float*)w; }

FATPH ph_prologue(KAP a, LAS unsigned char* lds, int pmask) { const Ctx c = mk_ctx(); p0_prologue(a, lds, c.gw, c.NGW, c.wave, c.lane, pmask); __syncthreads(); }
FATPH ph_memkv(LAS unsigned char* lds) { const Ctx c = mk_ctx(); unsigned char* ws = ws_ptr(); float* out = out_ptr();
    pg8::Gemm g{WSB(WS_MB), WSB(WS_WXKV), 2048, 8192, 1024}; pg8::StaticOrder S; S.init(2048, 8192, c.G, c.bx);
    pg8::EpiMemKV E{out + O_MKP, out + O_MVP, (bf16*)(ws + WS_MKB), (bf16*)(ws + WS_MVB)};
    pg8::gemm_phase<pg8::EpiMemKV, pg8::StaticOrder, true, true>(lds + RING_OFF, g, S, E); }
FATPH ph_fox_in(LAS unsigned char* lds, int L) { const Ctx c = mk_ctx(); unsigned char* ws = ws_ptr(); float* out = out_ptr();
    pg8::Gemm g{WSB(WS_XB), WSB(WS_WFI) + (size_t)L * 4352 * 1024, MT, 4352, 1024}; pg8::StaticOrder S; S.init(MT, 4352, c.G, c.bx);
    pg8::EpiFoxIn E{RSX(ws), ws, out, in_ptr(I_BFF) + L * 16, L};
    pg8::gemm_phase<pg8::EpiFoxIn, pg8::StaticOrder, true, true>(lds + RING_OFF, g, S, E); }
FATPH ph_fox_sample(KAP a, LAS unsigned char* lds, int L) { const Ctx c = mk_ctx(); LAS float* red = (LAS float*)(lds + RING_OFF + 65536);
    for (int it = c.vcu; it < 256; it += c.G) { cum_local_sample(a, L, 2 * it, red, c.wave, c.lane); cum_local_sample(a, L, 2 * it + 1, red, c.wave, c.lane); foxs_item(a, L, it, lds, c.wave, c.lane); } }
__device__ __forceinline__ void unit2_of(int e, int& bh, int& qb) { bh = e >> 3; const int k = e & 7, s = (k >> 2) & 1, ii = k & 3, j = 2 * s + (ii >> 1); qb = (ii & 1) ? 7 - j : j; }
__device__ __forceinline__ void unit_of(int e, int& bh, int& qb) { bh = e >> 4; const int k = e & 15, s = (k >> 3) & 1, ii = k & 7, j = 2 * (ii >> 1) + s; qb = (ii & 1) ? 15 - j : j; }
FATPH ph_fox_attn(LAS unsigned char* lds, unsigned lds0) { const Ctx c = mk_ctx(); unsigned char* ws = ws_ptr();
    for (int e0 = c.vcu * 4; e0 < 1024; e0 += c.G * 4) {
        __syncthreads(); cum_local_prompt(KA, e0 >> 3, (LAS float*)(lds + RING_OFF + 65536), c.wave, c.lane);
        for (int i = 0; i < 4; ++i) { int bh, qb; unit2_of(e0 + i, bh, qb); const int b = bh >> 4, h = bh & 15;
            fa::Args A{WSB(WS_QF), 1024, h * 64, WSB(WS_KF), 1024, h * 64, nullptr, WSB(WS_VF), 1024, h * 64, (bf16*)(ws + WS_OM), h * 64,
                       WSB(WS_GF), (const float*)(ws + WS_CB) + (size_t)bh * 4096};
            fa::unit2<0>(A, (long)b * 4096, qb, (LAS char*)(lds + RING_OFF), lds0 + RING_OFF); } } }
FATPH ph_fox_mix(KAP a, LAS unsigned char* lds, unsigned lds0, int L) { const Ctx c = mk_ctx(); unsigned char* ws = ws_ptr(); LAS float* red = (LAS float*)(lds + RING_OFF + 65536);
    const int pos = (c.vcu >> 1) % 5;
    for (int e0 = c.vcu * 4, it = c.vcu; e0 < 1024 || it < 256; e0 += c.G * 4, it += c.G) {
        if (e0 < 1024) { __syncthreads(); cum_local_prompt(a, e0 >> 3, red, c.wave, c.lane); }
#pragma unroll 1
        for (int i = 0; i < 5; ++i) {
            if (i == pos && it < 256) { const Ctx c2 = mk_ctx(); int itv = it; asm volatile("" : "+s"(itv));
                __syncthreads(); cum_local_sample(a, L, 2 * itv, red, c2.wave, c2.lane); cum_local_sample(a, L, 2 * itv + 1, red, c2.wave, c2.lane); foxs_item(a, L, itv, lds, c2.wave, c2.lane); __syncthreads(); }
            if (i < 4 && e0 < 1024) { int ev = e0 + i; asm volatile("" : "+s"(ev)); int bh, qb; unit2_of(ev, bh, qb); const int b = bh >> 4, h = bh & 15;
                fa::Args A{WSB(WS_QF), 1024, h * 64, WSB(WS_KF), 1024, h * 64, nullptr, WSB(WS_VF), 1024, h * 64, (bf16*)(ws + WS_OM), h * 64,
                           WSB(WS_GF), (const float*)(ws + WS_CB) + (size_t)bh * 4096};
                fa::unit2<0>(A, (long)b * 4096, qb, (LAS char*)(lds + RING_OFF), lds0 + RING_OFF); } } } }
template <bool ABLK = false>
FATPH ph_resid(LAS unsigned char* lds, const bf16* A, const bf16* Bt, int K, int first, int dummy = 0) { const Ctx c = mk_ctx(); unsigned char* ws = ws_ptr();
    pg8::Gemm g{A, Bt, MP, 1024, K}; pg8::StaticOrder S; S.init(MP, 1024, c.G, c.bx);
    pg8::EpiResid E{KA->in[I_XP], KA->in[I_XS], first, dummy ? (bf16*)(ws + WS_R1 + (size_t)MT * 4096) : (bf16*)(ws + WS_XB), dummy ? (float*)(ws + WS_R1 + (size_t)MT * 6144) : (float*)(ws + WS_SSQ)};
    pg8::gemm_phase<pg8::EpiResid, pg8::StaticOrder, true, true, ABLK>(lds + RING_OFF, g, S, E); }
FATPH ph_scale_gemm(LAS unsigned char* lds, const bf16* A, const bf16* Bt, int M, int N, int K, const float* ssq, int stride, int ngrp, float inv_n, bf16* O, float scale) { const Ctx c = mk_ctx();
    pg8::Gemm g{A, Bt, M, N, K}; pg8::StaticOrder S; S.init(M, N, c.G, c.bx);
    pg8::EpiScaleBf16 E{pg8::RowScale{ssq, stride, ngrp, inv_n}, O, N, scale};
    pg8::gemm_phase<pg8::EpiScaleBf16, pg8::StaticOrder, true, true>(lds + RING_OFF, g, S, E); }
FATPH ph_cross(LAS unsigned char* lds, unsigned lds0, int layer) { const Ctx c = mk_ctx(); unsigned char* ws = ws_ptr();
    const bf16* QX = WSB(WS_QX); bf16* OX = (bf16*)(ws + WS_OM);
    const bool bal = (c.G == 256); const int nu = bal ? (c.vcu < 128 ? 1 : 3) : 2, ub = bal ? (c.vcu < 128 ? c.vcu : 128 + 3 * (c.vcu - 128)) : c.vcu * 2;
    for (int u0 = ub; u0 < 512; u0 += (bal ? 512 : c.G * 2))
        for (int i = 0; i < nu; ++i) { const int u = u0 + i, bh = u >> 4, qb = u & 15, b = bh >> 2, h = bh & 3; const size_t ko = ((size_t)layer * 2048 + b * 256) * 1024 + h * 256;
            xa::unit<false>(WSB(WS_MKB) + ko, WSB(WS_MVB) + ko, 1024, QX, OX, (size_t)b * 4096 + qb * 256, h * 256, 32, false, (LAS char*)(lds + RING_OFF), lds0 + RING_OFF); }
    for (int e = c.vcu; e < 128; e += c.G) { const int bs = e >> 2, h = e & 3; const size_t ko = ((size_t)(layer * 32 + bs) * 256) * 1024 + h * 256;
        xa::unit<true>(in_ptr(I_CMK) + ko, in_ptr(I_CMV) + ko, 1024, QX, OX, (size_t)MP + bs * 16, h * 256, 16, true, (LAS char*)(lds + RING_OFF), lds0 + RING_OFF); } }
FATPH ph_gu(LAS unsigned char* lds, int layer) { const Ctx c = mk_ctx(); unsigned char* ws = ws_ptr();
    pg8::Gemm g{WSB(WS_XB), WSB(WS_WGU) + (size_t)layer * 5632 * 1024, MT, 5632, 1024}; pg8::StaticOrder S; S.init(MT, 5632, c.G, c.bx);
    pg8::EpiSwiglu E{RSX(ws), (bf16*)(ws + WS_HB)}; pg8::gemm_phase<pg8::EpiSwiglu, pg8::StaticOrder, true, true>(lds + RING_OFF, g, S, E); }
FATPH ph_gu_null(LAS unsigned char* lds, int layer) { const Ctx c = mk_ctx();
    pg8::Gemm g{WSB(WS_XB), WSB(WS_WGU) + (size_t)layer * 5632 * 1024, MT, 5632, 1024}; pg8::StaticOrder S; S.init(MT, 5632, c.G, c.bx);
    pg8::EpiNull E{}; pg8::gemm_phase<pg8::EpiNull, pg8::StaticOrder, true, true>(lds + RING_OFF, g, S, E); }
FATPH ph_mla_a(LAS unsigned char* lds, int L) { const Ctx c = mk_ctx(); unsigned char* ws = ws_ptr(); float* out = out_ptr();
    pg8::Gemm g{WSB(WS_XB), WSB(WS_WMA) + (size_t)L * 768 * 1024, MT, 768, 1024}; pg8::StaticOrder S; S.init(MT, 768, c.G, c.bx);
    pg8::EpiMlaA E{RSX(ws), (float*)(ws + WS_CKVU), (bf16*)(ws + WS_CKVUB), (float*)(ws + WS_SSQKV), (bf16*)(ws + WS_CQ), (float*)(ws + WS_SSQQ), (bf16*)(ws + WS_KRB),
                   out + O_MRP + (size_t)L * MP * 32, out + O_MRS + (size_t)L * MS * 32, (const float*)(ws + WS_ROPC), (const float*)(ws + WS_ROPS)};
    pg8::gemm_phase<pg8::EpiMlaA, pg8::StaticOrder, true, true>(lds + RING_OFF, g, S, E); }
PHASE ph_fixup(KAP a, int L) { const Ctx c = mk_ctx(); ckv_fixup(a, L, c.gw, c.NGW, c.lane); }
FATPH ph_mla_q(LAS unsigned char* lds, int L, int kq) { const Ctx c = mk_ctx(); unsigned char* ws = ws_ptr();
    pg8::Gemm g{WSB(WS_CQ), WSB(WS_WMQ) + (size_t)L * 1536 * 384, MT, 1536, kq}; pg8::StaticOrder S; S.init(MT, 1536, c.G, c.bx);
    pg8::EpiMlaQ E{pg8::RowScale{(const float*)(ws + WS_SSQQ), 8, 2, 1.0f / 384.0f}, (bf16*)(ws + WS_QM), (const float*)(ws + WS_ROPC), (const float*)(ws + WS_ROPS)};
    pg8::gemm_phase<pg8::EpiMlaQ, pg8::StaticOrder, true, false>(lds + RING_OFF, g, S, E); }
PHASE ph_mla_qprime(KAP a, LAS unsigned char* lds, int L, int it) { const Ctx c = mk_ctx(); mlas_qprime(a, L, it, lds, c.wave, c.lane); }
FATPH ph_mla_sample(LAS unsigned char* lds, unsigned lds0, int L) { const Ctx c = mk_ctx(); for (int it = c.vcu; it < 256; it += c.G) { ph_mla_qprime(KA, lds, L, it); mlas_attn(KA, L, it, it, lds, lds0);
        if ((it & 7) == ((it >> 3) & 7)) mlas_attn(KA, L, 256 + (it >> 3), it, lds, lds0); } __syncthreads(); }
FATPH ph_mla_attn(LAS unsigned char* lds, unsigned lds0) { const Ctx c = mk_ctx(); unsigned char* ws = ws_ptr();
    for (int e0 = c.vcu * 4; e0 < 1024; e0 += c.G * 4)
        for (int i = 0; i < 4; ++i) { int bh, qb; unit2_of(e0 + i, bh, qb); const int b = bh >> 4, h = bh & 15;
            fa::Args A{WSB(WS_QM), 1536, h * 96, WSB(WS_KVM), 2048, h * 128, WSB(WS_KRB), WSB(WS_KVM), 2048, h * 128 + 64, (bf16*)(ws + WS_OM), h * 64,
                       nullptr, nullptr};
            fa::unit2<1>(A, (long)b * 4096, qb, (LAS char*)(lds + RING_OFF), lds0 + RING_OFF); } }
FATPH ph_mla_comb(LAS unsigned char* lds, int L) { const Ctx c = mk_ctx(); mlas_combine(KA, L, lds, c.vcu, c.G, c.wave, c.lane); }
template <int K> FATPH ph_thin_resid(KAP a, LAS unsigned char* lds, const bf16* A, const bf16* Bt, int first) { const Ctx c = mk_ctx(); thin_resid<K>(a, A, Bt, first, lds, c.vcu, c.G, c.wave, c.lane); }
FATPH ph_thin_xq(KAP a, LAS unsigned char* lds, const bf16* Bt) { const Ctx c = mk_ctx(); thin_xq(a, Bt, lds, c.vcu, c.G, c.wave, c.lane); }
PHASE ph_final(KAP a) { const Ctx c = mk_ctx(); final_phase(a, c.gw, c.NGW, c.lane); }
PHASE ph_grid_bar(GAS unsigned* barw, unsigned x, volatile LAS unsigned* st) { XcdBarrier b; b.bar = (unsigned*)barw; b.x = x; b.st = st; xcd_barrier(b); }

__global__ void __launch_bounds__(NWAVES * 64, 2) fwd_kernel(KArgs args) {
    extern __shared__ __attribute__((aligned(16))) unsigned char lds_raw[];
    LAS unsigned char* lds = (LAS unsigned char*)lds_raw;
    volatile LAS unsigned* MISC = (volatile LAS unsigned*)(lds + MISC_OFF);
    const int tid = threadIdx.x;
    const unsigned lds0 = (unsigned)(uintptr_t)lds_raw;
    for (int u = tid; u < (LDS_BYTES - LDSCTL_OFF) / 4; u += NWAVES * 64) ((LAS unsigned*)(lds + LDSCTL_OFF))[u] = 0u;
    __syncthreads();
    const XcdBarrier bar = xcd_barrier_post((unsigned*)(args.ws + WS_CTL) + CW_BAR, MISC + 8);
    const int lo = args.ph_lo, hi = args.ph_hi;
#ifndef DBG_DOUBLE
#define DBG_DOUBLE 0
#endif
#ifndef DBG_P0_AGAIN
#define DBG_P0_AGAIN 0
#endif
#define REP(bit) for (int rep_ = 0; rep_ < ((DBG_DOUBLE & (bit)) ? 2 : 1); ++rep_)
#define IN(k) (lo <= (k) && (k) < hi)
#define SEAM(k) do { if (IN(k) && IN((k) + 1)) { REP(256) ph_grid_bar((GAS unsigned*)bar.bar, bar.x, bar.st); } } while (0)
    if (IN(0)) { ph_prologue(KA, lds, 0x7f); if (DBG_P0_AGAIN) ph_prologue(KA, lds, DBG_P0_AGAIN); }
    SEAM(0);
    if (IN(1)) REP(65536) ph_memkv(lds);
    SEAM(1);
    for (int L = 0; L < 2; ++L) {
        const int pb = 2 + 19 * L;
        if (IN(pb)) { REP(8) ph_fox_in(lds, L); }
        SEAM(pb);
        if (IN(pb + 2)) { if (DBG_DOUBLE & 96) { REP(64) ph_fox_sample(KA, lds, L); REP(32) ph_fox_attn(lds, lds0); } else ph_fox_mix(KA, lds, lds0, L); }
        SEAM(pb + 2);
        if (IN(pb + 3)) { ph_thin_resid<1024>(KA, lds, WSB(WS_OM), WSB(WS_WFO) + (size_t)L * 1024 * 1024, L == 0); if (DBG_DOUBLE & 512) ph_resid(lds, WSB(WS_OM), WSB(WS_WFO) + (size_t)L * 1024 * 1024, 1024, L == 0, 1); ph_resid(lds, WSB(WS_OM), WSB(WS_WFO) + (size_t)L * 1024 * 1024, 1024, L == 0); }
        SEAM(pb + 3);
        for (int sub = 0; sub < 2; ++sub) {
            const int layer = 2 * L + sub, cb = pb + 4 + 10 * sub;
            if (sub == 1) {
                if (IN(pb + 9)) REP(32768) ph_mla_a(lds, L);
                SEAM(pb + 9);
                if (IN(pb + 10)) { ph_fixup(KA, L); REP(32768) ph_mla_q(lds, L, 384);
                    REP(32768)
                    ph_scale_gemm(lds, WSB(WS_CKVUB), WSB(WS_WMKV) + (size_t)L * 2048 * 256, MP, 2048, 256, (const float*)(ws_ptr() + WS_SSQKV), 4, 1, 1.0f / 256.0f, (bf16*)(ws_ptr() + WS_KVM), 1.0f); }
                SEAM(pb + 10);
                if (IN(pb + 11)) { REP(128) ph_mla_sample(lds, lds0, L); REP(32) ph_mla_attn(lds, lds0); }
                SEAM(pb + 11);
                if (IN(pb + 12)) REP(16) ph_mla_comb(lds, L);
                SEAM(pb + 12);
                if (IN(pb + 13)) { ph_thin_resid<1024>(KA, lds, WSB(WS_OM), WSB(WS_WMO) + (size_t)L * 1024 * 1024, 0); if (DBG_DOUBLE & 512) ph_resid(lds, WSB(WS_OM), WSB(WS_WMO) + (size_t)L * 1024 * 1024, 1024, 0, 1); ph_resid(lds, WSB(WS_OM), WSB(WS_WMO) + (size_t)L * 1024 * 1024, 1024, 0); }
                SEAM(pb + 13);
            }
            if (IN(cb)) { REP(131072) ph_thin_xq(KA, lds, WSB(WS_WXQ) + (size_t)layer * 1024 * 1024); REP(16384) ph_scale_gemm(lds, WSB(WS_XB), WSB(WS_WXQ) + (size_t)layer * 1024 * 1024, MP, 1024, 1024, (const float*)(ws_ptr() + WS_SSQ), 16, 4, 1.0f / 1024.0f, (bf16*)(ws_ptr() + WS_QX), C2_X); }
            SEAM(cb);
            if (IN(cb + 1)) REP(2) ph_cross(lds, lds0, layer);
            SEAM(cb + 1);
            if (IN(cb + 2)) { ph_thin_resid<1024>(KA, lds, WSB(WS_OM), WSB(WS_WXO) + (size_t)layer * 1024 * 1024, 0); if (DBG_DOUBLE & 4096) ph_resid(lds, WSB(WS_OM), WSB(WS_WXO) + (size_t)layer * 1024 * 1024, 1024, 0, 1); ph_resid(lds, WSB(WS_OM), WSB(WS_WXO) + (size_t)layer * 1024 * 1024, 1024, 0); }
            SEAM(cb + 2);
            if (IN(cb + 3)) { if (DBG_DOUBLE & 1024) ph_gu_null(lds, layer); REP(8) ph_gu(lds, layer); }
            SEAM(cb + 3);
            if (IN(cb + 4)) { ph_thin_resid<DFF>(KA, lds, WSB(WS_HB), WSB(WS_WDN) + (size_t)layer * 1024 * 2816, 0); if (DBG_DOUBLE & 2048) ph_resid<true>(lds, WSB(WS_HB), WSB(WS_WDN) + (size_t)layer * 1024 * 2816, DFF, 0, 1); ph_resid<true>(lds, WSB(WS_HB), WSB(WS_WDN) + (size_t)layer * 1024 * 2816, DFF, 0); }
            SEAM(cb + 4);
        }
    }
    if (IN(40)) REP(262144) ph_final(KA);
#undef IN
#undef SEAM
}

#ifndef DBG_PH_HI
#define DBG_PH_HI NPH
#endif
#ifndef MK_PER_PHASE
#define MK_PER_PHASE 0
#endif
extern "C" void kernel_launch(void* const* d_in, const int* in_sizes, int n_in, void* d_out, int out_size, void* d_ws, size_t ws_size, hipStream_t stream) {
    static int grid = 0;
    if (grid == 0) {
        if (n_in != N_IN || (size_t)out_size != O_END || ws_size < WS_END) { fprintf(stderr, "kernel_launch: unexpected shapes (n_in %d, out %d, ws %zu; need %d, %zu, %zu)\n", n_in, out_size, ws_size, (int)N_IN, (size_t)O_END, (size_t)WS_END); grid = -1; return; }
        int dev = 0, cus = 0, per_cu = 0;
        if (hipGetDevice(&dev) != hipSuccess || hipDeviceGetAttribute(&cus, hipDeviceAttributeMultiprocessorCount, dev) != hipSuccess) { grid = -1; return; }
        if (hipFuncSetAttribute((const void*)fwd_kernel, hipFuncAttributeMaxDynamicSharedMemorySize, LDS_BYTES) != hipSuccess) { fprintf(stderr, "kernel_launch: hipFuncSetAttribute failed\n"); grid = -1; return; }
        if (hipOccupancyMaxActiveBlocksPerMultiprocessor(&per_cu, (const void*)fwd_kernel, NWAVES * 64, LDS_BYTES) != hipSuccess || per_cu < 1) { fprintf(stderr, "kernel_launch: occupancy query reports %d\n", per_cu); }
        (void)hipGetLastError();
        grid = cus;
    }
    if (grid < 0) return;
    if (hipMemsetAsync((char*)d_ws + WS_CTL, 0, CTL_ZERO_BYTES, stream) != hipSuccess) return;
    KArgs a{};
    for (int i = 0; i < N_IN; ++i) a.in[i] = (const float*)d_in[i];
    a.out = (float*)d_out; a.ws = (unsigned char*)d_ws;
#if MK_PER_PHASE
    for (int p = 0; p < NPH; ++p) { a.ph_lo = p; a.ph_hi = p + 1; hipLaunchKernelGGL(fwd_kernel, dim3(grid), dim3(NWAVES * 64), LDS_BYTES, stream, a); }
#else
    a.ph_lo = 0; a.ph_hi = DBG_PH_HI; hipLaunchKernelGGL(fwd_kernel, dim3(grid), dim3(NWAVES * 64), LDS_BYTES, stream, a);
#endif
}
```

```cpp
#include <hip/hip_runtime.h>
#include <cstdint>
#include <cstdio>
#include <cmath>

constexpr int D = 1024, MP = 32768, MS = 512, MT = MP + MS, SEQ = 4096, NBP = 8, NBS = 32, DSEQ = 16, PAST = 2048, NMEM = 256;
constexpr int DFF = 2816, KPAD = 2112;
constexpr float EPS = 1e-6f, LOG2E = 1.4426950408889634f;
constexpr float C2_FOX = 0.125f * LOG2E, C2_MLA = 0.10206207261596575f * LOG2E, C2_X = 0.0625f * LOG2E;

constexpr size_t O_Y = 0;
constexpr size_t O_FKP = (size_t)MT * D;
constexpr size_t O_FVP = O_FKP + (size_t)2 * MP * 1024;
constexpr size_t O_FLP = O_FVP + (size_t)2 * MP * 1024;
constexpr size_t O_MCP = O_FLP + (size_t)2 * MP * 16;
constexpr size_t O_MRP = O_MCP + (size_t)2 * MP * 256;
constexpr size_t O_MKP = O_MRP + (size_t)2 * MP * 32;
constexpr size_t O_MVP = O_MKP + (size_t)4 * 2048 * 1024;
constexpr size_t O_FKS = O_MVP + (size_t)4 * 2048 * 1024;
constexpr size_t O_FVS = O_FKS + (size_t)2 * MS * 1024;
constexpr size_t O_FLS = O_FVS + (size_t)2 * MS * 1024;
constexpr size_t O_MCS = O_FLS + (size_t)2 * MS * 16;
constexpr size_t O_MRS = O_MCS + (size_t)2 * MS * 256;
constexpr size_t O_END = O_MRS + (size_t)2 * MS * 32;

enum { I_XP = 0, I_XS, I_MEM, I_CFK, I_CFV, I_CFL, I_CCKV, I_CKR, I_CMK, I_CMV, I_GMIX, I_GCROSS, I_GMEM, I_GFFN, I_GFINAL,
       I_WFI, I_BFF, I_WFO, I_WMA, I_GMQ, I_GMKV, I_WMQB, I_WMKVB, I_WMO, I_WXQ, I_WXKV, I_WXO, I_WGU, I_WDN, N_IN };


constexpr size_t al256(size_t x) { return (x + 255) & ~(size_t)255; }
constexpr size_t WS_CTL = 0, CTL_ZERO_BYTES = 1u << 20;
constexpr size_t WS_WFI = 2u << 20;
constexpr size_t WS_WFO = WS_WFI + (size_t)2 * 4352 * 1024 * 2;
constexpr size_t WS_WMA = WS_WFO + (size_t)2 * 1024 * 1024 * 2;
constexpr size_t WS_WMQ = WS_WMA + (size_t)2 * 768 * 1024 * 2;
constexpr size_t WS_WMKV = WS_WMQ + (size_t)2 * 1536 * 384 * 2;
constexpr size_t WS_WMKVR = WS_WMKV + (size_t)2 * 2048 * 256 * 2;
constexpr size_t WS_WKN = WS_WMKVR + (size_t)2 * 2048 * 256 * 2;
constexpr size_t WS_WMO = WS_WKN + (size_t)2 * 256 * 2048 * 2;
constexpr size_t WS_WXQ = WS_WMO + (size_t)2 * 1024 * 1024 * 2;
constexpr size_t WS_WXO = WS_WXQ + (size_t)4 * 1024 * 1024 * 2;
constexpr size_t WS_WXKV = WS_WXO + (size_t)4 * 1024 * 1024 * 2;
constexpr size_t WS_WGU = WS_WXKV + (size_t)4 * 2048 * 1024 * 2;
constexpr size_t WS_WDN = WS_WGU + (size_t)4 * 5632 * 1024 * 2;
constexpr size_t WS_WFF = WS_WDN + (size_t)4 * 1024 * 2816 * 2;
constexpr size_t WS_ROPC = WS_WFF + (size_t)2 * 16 * 1024 * 4;
constexpr size_t WS_ROPS = WS_ROPC + (size_t)4096 * 16 * 4;
constexpr size_t WS_XB = WS_ROPS + (size_t)4096 * 16 * 4;
constexpr size_t WS_SSQ = WS_XB + (size_t)MT * 1024 * 2;
constexpr size_t WS_R1 = al256(WS_SSQ + (size_t)MT * 16 * 4);
constexpr size_t SZ_ACT = (size_t)MT * 1024 * 2;
constexpr size_t WS_QF = WS_R1, WS_KF = WS_R1 + SZ_ACT, WS_VF = WS_R1 + 2 * SZ_ACT, WS_GF = WS_R1 + 3 * SZ_ACT;
constexpr size_t WS_QM = WS_R1, WS_KVM = al256(WS_R1 + (size_t)MT * 1536 * 2);
static_assert(WS_KVM + (size_t)MP * 2048 * 2 <= WS_R1 + 4 * SZ_ACT, "MLA overlay fits");
constexpr size_t WS_OM = WS_R1 + 4 * SZ_ACT;
constexpr size_t WS_LFR = WS_OM + SZ_ACT;
constexpr size_t WS_CB = WS_LFR + (size_t)MT * 16 * 4;
constexpr size_t WS_CBS = WS_CB + (size_t)8 * 16 * 4096 * 4;
constexpr size_t WS_CKVU = al256(WS_CBS + (size_t)32 * 16 * 2080 * 4);
constexpr size_t WS_CKVUB = WS_CKVU + (size_t)MT * 256 * 4;
constexpr size_t WS_SSQKV = WS_CKVUB + (size_t)MT * 256 * 2;
constexpr size_t WS_CQ = WS_SSQKV + (size_t)MT * 4 * 4;
constexpr size_t WS_SSQQ = WS_CQ + (size_t)MT * 384 * 2;
constexpr size_t WS_KRB = WS_SSQQ + (size_t)MT * 8 * 4;
constexpr size_t WS_QA = al256(WS_KRB + (size_t)MT * 32 * 2);
constexpr size_t WS_PART = al256(WS_QA + (size_t)288 * 256 * 288 * 2);
constexpr size_t WS_QX = al256(WS_PART + (size_t)32 * 9 * 256 * 264 * 4);
constexpr size_t WS_MB = WS_QX + SZ_ACT;
constexpr size_t WS_MKB = WS_MB + (size_t)2048 * 1024 * 2;
constexpr size_t WS_MVB = WS_MKB + (size_t)4 * 2048 * 1024 * 2;
constexpr size_t WS_HB = WS_MVB + (size_t)4 * 2048 * 1024 * 2;
constexpr size_t WS_END = WS_HB + (size_t)MT * DFF * 2;
constexpr int CW_BAR = 4096;

namespace pg8 {
#define PG8_LAS __attribute__((address_space(3)))
typedef unsigned short bf16_t;
typedef short bf16x8 __attribute__((ext_vector_type(8)));
typedef float f32x4 __attribute__((ext_vector_type(4)));
typedef unsigned u32x4 __attribute__((ext_vector_type(4)));
constexpr int BM = 256, BK = 64, HALF = 128, HTB = HALF * BK * 2  , STAGE_BYTES = 8 * HTB, NXCD = 8, WGM = 8;

__host__ __device__ __forceinline__ int lds_byte(int r, int c) { const int st = (r >> 4) * 2 + (c >> 5), rr = r & 15, cc = c & 31, ob = rr * 64 + cc * 2; return st * 1024 + (ob ^ (((ob >> 9) & 1) << 5)); }
__host__ __device__ __forceinline__ void stage_rc(int b, int& R, int& C) { const int st = b / 1024, sb = b % 1024, swz = sb ^ (((sb >> 9) & 1) << 5); R = (st >> 1) * 16 + swz / 64; C = (st & 1) * 32 + (swz % 64) / 2; }
__host__ __device__ __forceinline__ int perm32(int rho) { const int n = rho >> 4, i = rho & 15; return 8 * (i >> 2) + 4 * n + (i & 3); }

struct Unit { int pm, pn; };
struct Gemm { const bf16_t* A; const bf16_t* Bt; int M, N, K; };

struct StaticOrder {
    int nM, nN, nwg, G, c;
    __host__ __device__ void init(int M, int N, int G_, int c_) { nM = M / BM; nN = N / BM; nwg = nM * nN; G = G_; c = c_; }
    __host__ __device__ bool next(int i, Unit& u) const {
        const long L = (long)i * G + c; if (L >= nwg) return false;
        int wgid = (int)L; { const int q = nwg / NXCD, r = nwg % NXCD, xcd = wgid % NXCD, off = wgid / NXCD; wgid = (xcd < r ? xcd * (q + 1) : r * (q + 1) + (xcd - r) * q) + off; }
        const int nig = WGM * nN, gid = wgid / nig, fm = gid * WGM, gsz = (nM - fm) < WGM ? (nM - fm) : WGM;
        u.pm = fm + ((wgid % nig) % gsz); u.pn = (wgid % nig) / gsz; return true;
    }
    __device__ __forceinline__ void a_ready(const Unit&) const {}
    __device__ __forceinline__ void done(const Unit&) const {}
};

typedef unsigned u32x2 __attribute__((ext_vector_type(2)));
typedef float f32x2v __attribute__((ext_vector_type(2)));
typedef __bf16 bf16x2_t __attribute__((ext_vector_type(2)));
__device__ __forceinline__ unsigned pk_bf16(float lo, float hi) { f32x2v v = {lo, hi}; bf16x2_t b = __builtin_convertvector(v, bf16x2_t); return __builtin_bit_cast(unsigned, b); }
__device__ __forceinline__ u32x2 pk4(f32x4 v) { u32x2 w; w.x = pk_bf16(v[0], v[1]); w.y = pk_bf16(v[2], v[3]); return w; }
__device__ __forceinline__ float dot4(f32x4 v) { return (v[0] * v[0] + v[1] * v[1]) + (v[2] * v[2] + v[3] * v[3]); }
__device__ __forceinline__ float sigm(float z) { return __builtin_amdgcn_rcpf(1.0f + __builtin_amdgcn_exp2f(-z * LOG2E)); }
#define EPI_FENCE() asm volatile("" ::: "memory")
__device__ __forceinline__ int pg8_tid() { int t = threadIdx.x; asm volatile("" : "+v"(t)); return t; }

struct RowScale { const float* p; int stride; int ngrp; float inv_n;
    __device__ __forceinline__ float get(int row, int fq) const {
        float s = 0.f; if (fq < ngrp) { const f32x4 v = *(const f32x4*)(p + (size_t)row * stride + 4 * fq); s = (v[0] + v[1]) + (v[2] + v[3]); }
        s += __shfl_xor(s, 16); s += __shfl_xor(s, 32); return rsqrtf(s * inv_n + EPS); }
    __device__ __forceinline__ void get8(int row0, int fq, float (&r)[2][4]) const {
        float s[2][4];
#pragma unroll
        for (int ai = 0; ai < 2; ++ai)
#pragma unroll
            for (int m = 0; m < 4; ++m) { s[ai][m] = 0.f; if (fq < ngrp) { const f32x4 v = *(const f32x4*)(p + (size_t)(row0 + ai * HALF + m * 16) * stride + 4 * fq); s[ai][m] = (v[0] + v[1]) + (v[2] + v[3]); } }
#pragma unroll
        for (int ai = 0; ai < 2; ++ai)
#pragma unroll
            for (int m = 0; m < 4; ++m) { float t = s[ai][m]; t += __shfl_xor(t, 16); t += __shfl_xor(t, 32); r[ai][m] = rsqrtf(t * inv_n + EPS); }
    } };
__device__ __forceinline__ int row_pos(int row) { return row < MP ? (row & (SEQ - 1)) : PAST + ((row - MP) & (DSEQ - 1)); }

struct EpiFoxIn { static constexpr bool PERM = false, AFTER_DRAIN = false;
    RowScale rs; unsigned char* ws; float* out; const float* bff; int L;
    __device__ __forceinline__ void operator()(const f32x4 (&acc)[2][2][4][2], const Unit& u, int wr, int wc, int, int) const { const int lane_ = pg8_tid() & 63, fr = lane_ & 15, fq = lane_ >> 4; float rsv[2][4]; rs.get8(u.pm * BM + wr * 64 + fr, fq, rsv);
        const int typ = u.pn >> 2, colt = (u.pn & 3) * 256 + wc * 32 + 4 * fq;
        bf16_t* QF = (bf16_t*)(ws + WS_QF); float* kp = out + O_FKP + (size_t)L * MP * 1024; float* ks = out + O_FKS + (size_t)L * MS * 1024;
#pragma unroll
        for (int ai = 0; ai < 2; ++ai)
#pragma unroll
            for (int m = 0; m < 4; ++m) { const int row = u.pm * BM + ai * HALF + wr * 64 + m * 16 + fr; float r = rsv[ai][m];
                if (typ == 0) { r *= C2_FOX;
#pragma unroll
                    for (int bj = 0; bj < 2; ++bj)
#pragma unroll
                        for (int n = 0; n < 2; ++n) *(u32x2*)(QF + (size_t)row * 1024 + colt + bj * HALF + n * 16) = pk4(acc[ai][bj][m][n] * r);
                } else if (typ == 3) {
#pragma unroll
                    for (int bj = 0; bj < 2; ++bj)
#pragma unroll
                        for (int n = 0; n < 2; ++n) { f32x4 v = acc[ai][bj][m][n] * r; v[0] = sigm(v[0]); v[1] = sigm(v[1]); v[2] = sigm(v[2]); v[3] = sigm(v[3]);
                            *(u32x2*)(QF + 3 * (SZ_ACT / 2) + (size_t)row * 1024 + colt + bj * HALF + n * 16) = pk4(v); }
                } else if (typ == 4) {
                    if (wc == 0) { const f32x4 bb = *(const f32x4*)(bff + 4 * fq); f32x4 lf;
#pragma unroll
                        for (int i = 0; i < 4; ++i) { const float z = acc[ai][0][m][0][i] * r + bb[i]; lf[i] = fminf(z, 0.f) - log1pf(expf(-fabsf(z))); }
                        *(f32x4*)((float*)(ws + WS_LFR) + (size_t)row * 16 + 4 * fq) = lf;
                        float* F = (row < MP) ? out + O_FLP + ((size_t)L * MP + row) * 16 : out + O_FLS + ((size_t)L * MS + (row - MP)) * 16;
                        *(f32x4*)(F + 4 * fq) = lf; }
                } else { bf16_t* B = QF + (size_t)typ * (SZ_ACT / 2);
                    float* F = (row < MP) ? kp + (size_t)(typ - 1) * 2 * MP * 1024 + (size_t)row * 1024 : ks + (size_t)(typ - 1) * 2 * MS * 1024 + (size_t)(row - MP) * 1024;
#pragma unroll
                    for (int bj = 0; bj < 2; ++bj)
#pragma unroll
                        for (int n = 0; n < 2; ++n) { const f32x4 v = acc[ai][bj][m][n] * r; const int c = colt + bj * HALF + n * 16;
                            *(f32x4*)(F + c) = v; *(u32x2*)(B + (size_t)row * 1024 + c) = pk4(v); }
                }
                if (m & 1) EPI_FENCE(); }
    }
};
struct EpiResid { static constexpr bool PERM = true, AFTER_DRAIN = false;
    const float* xin_p; const float* xin_s; int first; bf16_t* xb; float* ssq;
    __device__ __forceinline__ void operator()(const f32x4 (&acc)[2][2][4][2], const Unit& u, int wr, int wc, int, int) const { const int lane_ = pg8_tid() & 63, fr = lane_ & 15, fq = lane_ >> 4;
        const int col0 = u.pn * BM + wc * 32 + 8 * fq;
        if (first) {
#pragma unroll
        for (int ai = 0; ai < 2; ++ai) {
            f32x4 xo[4][2][2];
#pragma unroll
            for (int m = 0; m < 4; ++m) { const int row = u.pm * BM + ai * HALF + wr * 64 + m * 16 + fr;
                const float* xi = (row < MP) ? xin_p + (size_t)row * 1024 : xin_s + (size_t)(row - MP) * 1024;
#pragma unroll
                for (int bj = 0; bj < 2; ++bj)
#pragma unroll
                    for (int n = 0; n < 2; ++n) xo[m][bj][n] = *(const f32x4*)(xi + col0 + bj * HALF + n * 4); }
#pragma unroll
            for (int m = 0; m < 4; ++m) { const int row = u.pm * BM + ai * HALF + wr * 64 + m * 16 + fr; float sq = 0.f;
#pragma unroll
                for (int bj = 0; bj < 2; ++bj) { const int c = col0 + bj * HALF; const f32x4 x0 = xo[m][bj][0] + acc[ai][bj][m][0], x1 = xo[m][bj][1] + acc[ai][bj][m][1];
                    sq += dot4(x0) + dot4(x1);
                    const u32x2 w0 = pk4(x0), w1 = pk4(x1); *(u32x4*)(xb + (size_t)row * 1024 + c) = (u32x4){w0.x, w0.y, w1.x, w1.y}; }
                sq += __shfl_xor(sq, 16); sq += __shfl_xor(sq, 32);
                if (fq == 0) ssq[(size_t)row * 16 + u.pn * 4 + wc] = sq; }
            EPI_FENCE(); }
        } else {
            u32x4 raw[2][4][2];
#pragma unroll
            for (int ai = 0; ai < 2; ++ai)
#pragma unroll
                for (int m = 0; m < 4; ++m) { const int row = u.pm * BM + ai * HALF + wr * 64 + m * 16 + fr;
#pragma unroll
                    for (int bj = 0; bj < 2; ++bj) raw[ai][m][bj] = *(const u32x4*)(xb + (size_t)row * 1024 + col0 + bj * HALF); }
            EPI_FENCE();
#pragma unroll
            for (int ai = 0; ai < 2; ++ai) {
#pragma unroll
                for (int m = 0; m < 4; ++m) { const int row = u.pm * BM + ai * HALF + wr * 64 + m * 16 + fr; float sq = 0.f;
#pragma unroll
                    for (int bj = 0; bj < 2; ++bj) { const int c = col0 + bj * HALF; const u32x4 w = raw[ai][m][bj];
                        const f32x4 x0 = (f32x4){__builtin_bit_cast(float, w.x << 16), __builtin_bit_cast(float, w.x & 0xffff0000u), __builtin_bit_cast(float, w.y << 16), __builtin_bit_cast(float, w.y & 0xffff0000u)} + acc[ai][bj][m][0];
                        const f32x4 x1 = (f32x4){__builtin_bit_cast(float, w.z << 16), __builtin_bit_cast(float, w.z & 0xffff0000u), __builtin_bit_cast(float, w.w << 16), __builtin_bit_cast(float, w.w & 0xffff0000u)} + acc[ai][bj][m][1];
                        sq += dot4(x0) + dot4(x1);
                        const u32x2 w0 = pk4(x0), w1 = pk4(x1); *(u32x4*)(xb + (size_t)row * 1024 + c) = (u32x4){w0.x, w0.y, w1.x, w1.y}; }
                    sq += __shfl_xor(sq, 16); sq += __shfl_xor(sq, 32);
                    if (fq == 0) ssq[(size_t)row * 16 + u.pn * 4 + wc] = sq; }
                EPI_FENCE(); } }
    }
};
struct EpiScaleBf16 { static constexpr bool PERM = true, AFTER_DRAIN = false;
    RowScale rs; bf16_t* O; int ldc; float scale;
    __device__ __forceinline__ void operator()(const f32x4 (&acc)[2][2][4][2], const Unit& u, int wr, int wc, int, int) const { const int lane_ = pg8_tid() & 63, fr = lane_ & 15, fq = lane_ >> 4; float rsv[2][4]; rs.get8(u.pm * BM + wr * 64 + fr, fq, rsv);
        const int col0 = u.pn * BM + wc * 32 + 8 * fq;
#pragma unroll
        for (int ai = 0; ai < 2; ++ai)
#pragma unroll
            for (int m = 0; m < 4; ++m) { const int row = u.pm * BM + ai * HALF + wr * 64 + m * 16 + fr; const float r = rsv[ai][m] * scale;
#pragma unroll
                for (int bj = 0; bj < 2; ++bj) { const u32x2 w0 = pk4(acc[ai][bj][m][0] * r), w1 = pk4(acc[ai][bj][m][1] * r);
                    *(u32x4*)(O + (size_t)row * ldc + col0 + bj * HALF) = (u32x4){w0.x, w0.y, w1.x, w1.y}; }
                if (m & 1) EPI_FENCE(); }
    }
};
struct EpiSwiglu { static constexpr bool PERM = true, AFTER_DRAIN = false;
    RowScale rs; bf16_t* HB;
    __device__ __forceinline__ void operator()(const f32x4 (&acc)[2][2][4][2], const Unit& u, int wr, int wc, int, int) const { const int lane_ = pg8_tid() & 63, fr = lane_ & 15, fq = lane_ >> 4; float rsv[2][4]; rs.get8(u.pm * BM + wr * 64 + fr, fq, rsv);
        const int col0 = u.pn * HALF + wc * 32 + 8 * fq;
        const bool blk = u.pm < MP / BM; const int rstr = blk ? 128 : DFF * 2;
        const size_t hb0 = blk ? ((size_t)(u.pm * (DFF / 64) + (col0 >> 6)) * 32768 + (size_t)(col0 & 63) * 2) : ((size_t)u.pm * BM * DFF + col0) * 2;
#pragma unroll
        for (int ai = 0; ai < 2; ++ai)
#pragma unroll
            for (int m = 0; m < 4; ++m) { const int row = u.pm * BM + ai * HALF + wr * 64 + m * 16 + fr; const float r = rsv[ai][m]; u32x4 w;
#pragma unroll
                for (int n = 0; n < 2; ++n) { const f32x4 g = acc[ai][0][m][n] * r, uu = acc[ai][1][m][n] * r; f32x4 h;
#pragma unroll
                    for (int i = 0; i < 4; ++i) h[i] = g[i] * sigm(g[i]) * uu[i];
                    const u32x2 hw = pk4(h); if (n == 0) { w.x = hw.x; w.y = hw.y; } else { w.z = hw.x; w.w = hw.y; } }
                *(u32x4*)((char*)HB + hb0 + (size_t)(row - u.pm * BM) * rstr) = w;
                if (m & 1) EPI_FENCE(); }
    }
};
struct EpiMlaA { static constexpr bool PERM = false, AFTER_DRAIN = false;
    RowScale rs; float* ckvu; bf16_t* ckvub; float* ssqkv; bf16_t* cq; float* ssqq; bf16_t* krb; float *mrp, *mrs; const float *ropc, *rops;
    __device__ __forceinline__ void operator()(const f32x4 (&acc)[2][2][4][2], const Unit& u, int wr, int wc, int, int) const { const int lane_ = pg8_tid() & 63, fr = lane_ & 15, fq = lane_ >> 4; float rsv[2][4]; rs.get8(u.pm * BM + wr * 64 + fr, fq, rsv);
        const int cw = wc * 32 + 4 * fq;
#pragma unroll
        for (int ai = 0; ai < 2; ++ai)
#pragma unroll
            for (int m = 0; m < 4; ++m) { const int row = u.pm * BM + ai * HALF + wr * 64 + m * 16 + fr; const float r = rsv[ai][m];
                if (u.pn == 0) { float sq = 0.f;
#pragma unroll
                    for (int bj = 0; bj < 2; ++bj)
#pragma unroll
                        for (int n = 0; n < 2; ++n) { const int c = cw + bj * HALF + n * 16; const f32x4 v = acc[ai][bj][m][n] * r;
                            *(f32x4*)(ckvu + (size_t)row * 256 + c) = v; *(u32x2*)(ckvub + (size_t)row * 256 + c) = pk4(v); sq += dot4(v); }
                    sq += __shfl_xor(sq, 16); sq += __shfl_xor(sq, 32); if (fq == 0) ssqkv[(size_t)row * 4 + wc] = sq;
                } else if (u.pn == 1) { float sq = 0.f;
#pragma unroll
                    for (int bj = 0; bj < 2; ++bj)
#pragma unroll
                        for (int n = 0; n < 2; ++n) { const int c = cw + bj * HALF + n * 16; const f32x4 v = acc[ai][bj][m][n] * r;
                            *(u32x2*)(cq + (size_t)row * 384 + c) = pk4(v); sq += dot4(v); }
                    sq += __shfl_xor(sq, 16); sq += __shfl_xor(sq, 32); if (fq == 0) ssqq[(size_t)row * 8 + wc] = sq;
                } else { float sq = 0.f;
#pragma unroll
                    for (int n = 0; n < 2; ++n) { const int c = 256 + cw + n * 16; const f32x4 v = acc[ai][0][m][n] * r;
                        *(u32x2*)(cq + (size_t)row * 384 + c) = pk4(v); sq += dot4(v); }
                    sq += __shfl_xor(sq, 16); sq += __shfl_xor(sq, 32); if (fq == 0) ssqq[(size_t)row * 8 + 4 + wc] = sq;
                    if (wc == 0) { const int pos = row_pos(row); const f32x4 cs = *(const f32x4*)(ropc + pos * 16 + 4 * fq), sn = *(const f32x4*)(rops + pos * 16 + 4 * fq);
                        const f32x4 x1 = acc[ai][1][m][0] * r, x2 = acc[ai][1][m][1] * r; const f32x4 o1 = x1 * cs - x2 * sn, o2 = x1 * sn + x2 * cs;
                        *(u32x2*)(krb + (size_t)row * 32 + 4 * fq) = pk4(o1); *(u32x2*)(krb + (size_t)row * 32 + 16 + 4 * fq) = pk4(o2);
                        float* F = (row < MP) ? mrp + (size_t)row * 32 : mrs + (size_t)(row - MP) * 32;
                        *(f32x4*)(F + 4 * fq) = o1; *(f32x4*)(F + 16 + 4 * fq) = o2; }
                }
                if (m & 1) EPI_FENCE(); }
    }
};
struct EpiMlaQ { static constexpr bool PERM = false, AFTER_DRAIN = false;
    RowScale rs; bf16_t* QM; const float *ropc, *rops;
    __device__ __forceinline__ void operator()(const f32x4 (&acc)[2][2][4][2], const Unit& u, int wr, int wc, int, int) const { const int lane_ = pg8_tid() & 63, fr = lane_ & 15, fq = lane_ >> 4; float rsv[2][4]; rs.get8(u.pm * BM + wr * 64 + fr, fq, rsv);
#pragma unroll
        for (int ai = 0; ai < 2; ++ai)
#pragma unroll
            for (int m = 0; m < 4; ++m) { const int row = u.pm * BM + ai * HALF + wr * 64 + m * 16 + fr; const float r = rsv[ai][m] * C2_MLA;
                const int pos = row_pos(row);
#pragma unroll
                for (int bj = 0; bj < 2; ++bj) { const int g32 = u.pn * 8 + bj * 4 + wc; const int c = g32 * 32 + 4 * fq; bf16_t* o = QM + (size_t)row * 1536 + c;
                    if ((g32 % 3) == 2) { const f32x4 cs = *(const f32x4*)(ropc + pos * 16 + 4 * fq), sn = *(const f32x4*)(rops + pos * 16 + 4 * fq);
                        const f32x4 x1 = acc[ai][bj][m][0] * r, x2 = acc[ai][bj][m][1] * r;
                        *(u32x2*)(o) = pk4(x1 * cs - x2 * sn); *(u32x2*)(o + 16) = pk4(x1 * sn + x2 * cs);
                    } else { *(u32x2*)(o) = pk4(acc[ai][bj][m][0] * r); *(u32x2*)(o + 16) = pk4(acc[ai][bj][m][1] * r); } }
                EPI_FENCE(); }
    }
};
struct EpiNull { static constexpr bool PERM = true, AFTER_DRAIN = false;
    __device__ __forceinline__ void operator()(const f32x4 (&acc)[2][2][4][2], const Unit&, int, int, int, int) const {
#pragma unroll
        for (int ai = 0; ai < 2; ++ai)
#pragma unroll
            for (int bj = 0; bj < 2; ++bj)
#pragma unroll
                for (int m = 0; m < 4; ++m)
#pragma unroll
                    for (int n = 0; n < 2; ++n) asm volatile("" :: "v"(acc[ai][bj][m][n])); }
};
struct EpiMemKV { static constexpr bool PERM = false, AFTER_DRAIN = false;
    float* outk; float* outv; bf16_t* MKB; bf16_t* MVB;
    __device__ __forceinline__ void operator()(const f32x4 (&acc)[2][2][4][2], const Unit& u, int wr, int wc, int, int) const { const int lane_ = pg8_tid() & 63, fr = lane_ & 15, fq = lane_ >> 4;
        const int l = u.pn >> 3, cw0 = (u.pn & 7) * 256; const bool isv = cw0 >= 1024; const int cbase = (cw0 & 1023) + wc * 32 + 4 * fq;
#pragma unroll
        for (int ai = 0; ai < 2; ++ai)
#pragma unroll
            for (int m = 0; m < 4; ++m) { const int row = u.pm * BM + ai * HALF + wr * 64 + m * 16 + fr; const int b = row >> 8, nn = row & 255;
#pragma unroll
                for (int bj = 0; bj < 2; ++bj)
#pragma unroll
                    for (int n = 0; n < 2; ++n) { const int c = cbase + bj * HALF + n * 16; const f32x4 v = acc[ai][bj][m][n]; const size_t o = ((size_t)l * 2048 + row) * 1024 + c;
                        if (!isv) { *(f32x4*)(outk + o) = v; *(u32x2*)(MKB + o) = pk4(v); } else { *(f32x4*)(outv + o) = v; *(u32x2*)(MVB + o) = pk4(v); } }
                if (m & 1) EPI_FENCE(); }
    }
};

template <class Epi, class Sched, bool ALIGN_EPI = false, bool SP2 = false, bool ABLK = false>
__device__ __forceinline__ void gemm_phase(PG8_LAS unsigned char* lds, const Gemm g, const Sched& S, const Epi& E) {
    const int tid = pg8_tid(), wid = __builtin_amdgcn_readfirstlane(tid >> 6), lane = tid & 63, wr = wid >> 2, wc = wid & 3, fr = lane & 15, fq = lane >> 4;
    const int K = g.K, nt = K / BK;
    unsigned voffA[2], voffB[2];
#pragma unroll
    for (int i = 0; i < 2; ++i) { int R, C; stage_rc(tid * 16 + i * 8192, R, C); const int Rb = Epi::PERM ? ((R & ~31) + perm32(R & 31)) : R;
        voffA[i] = ABLK ? (unsigned)(R * BK + C) * 2u : (unsigned)(R * K + C) * 2u; voffB[i] = (unsigned)(Rb * K + C) * 2u; }
    const size_t kstep = (size_t)(BK * 2);
    const size_t hstep = (size_t)HALF * K * 2;
    const size_t tstep = 2 * hstep;
    const size_t kstepA = ABLK ? (size_t)BM * BK * 2 : kstep, hstepA = ABLK ? (size_t)HALF * BK * 2 : hstep, tstepA = ABLK ? (size_t)nt * BM * BK * 2 : tstep;
    const unsigned ldsw = (unsigned)wid * 1024u;
    const int aoff = lds_byte(wr * 64 + fr, fq * 8), boff = lds_byte(wc * 32 + fr, fq * 8);
#define PG8_SA(b, h) (((b) * 2 + (h)) * HTB)
#define PG8_SB(b, h) ((4 + (b) * 2 + (h)) * HTB)
#define PG8_STAGE(bufoff, gbase, voff) do { _Pragma("unroll") for (int _i = 0; _i < 2; ++_i) \
        __builtin_amdgcn_global_load_lds((const unsigned*)((const char*)(gbase) + (voff)[_i]), (PG8_LAS unsigned*)(lds + (bufoff) + ldsw + _i * 8192), 16, 0, 0); } while (0)
#define PG8_LDA(dst, b, h) do { _Pragma("unroll") for (int m = 0; m < 4; ++m) _Pragma("unroll") for (int k = 0; k < 2; ++k) dst[m][k] = *(const PG8_LAS bf16x8*)(lds + PG8_SA(b, h) + aoff + m * 2048 + k * 1024); } while (0)
#define PG8_LDB(dst, b, h) do { _Pragma("unroll") for (int n = 0; n < 2; ++n) _Pragma("unroll") for (int k = 0; k < 2; ++k) dst[n][k] = *(const PG8_LAS bf16x8*)(lds + PG8_SB(b, h) + boff + n * 2048 + k * 1024); } while (0)
#define PG8_MMA(ai, bj, At, Bt) do { __builtin_amdgcn_s_setprio(1); _Pragma("unroll") for (int m = 0; m < 4; ++m) _Pragma("unroll") for (int n = 0; n < 2; ++n) _Pragma("unroll") for (int k = 0; k < 2; ++k) \
        acc[ai][bj][m][n] = __builtin_amdgcn_mfma_f32_16x16x32_bf16(Bt[n][k], At[m][k], acc[ai][bj][m][n], 0, 0, 0); __builtin_amdgcn_s_setprio(0); } while (0)
#define PG8_WAIT_V(n) asm volatile("s_waitcnt vmcnt(" #n ")" ::: "memory")
#define PG8_WAIT_L(n) asm volatile("s_waitcnt lgkmcnt(" #n ")" ::: "memory")
#define PG8_BAR __builtin_amdgcn_s_barrier()
#define PG8_SCHED __builtin_amdgcn_sched_barrier(0)
    Unit cur, nxt; int ui = 0;
    if (!S.next(0, cur)) return;
    f32x4 acc[2][2][4][2];
#pragma unroll
    for (int a = 0; a < 2; ++a)
#pragma unroll
        for (int b = 0; b < 2; ++b)
#pragma unroll
            for (int m = 0; m < 4; ++m)
#pragma unroll
                for (int n = 0; n < 2; ++n) acc[a][b][m][n] = (f32x4){0.f, 0.f, 0.f, 0.f};
    bf16x8 At[4][2], B0[2][2], B1[2][2];
    const char* cA = (const char*)g.A + (size_t)cur.pm * tstepA; const char* cB = (const char*)g.Bt + (size_t)cur.pn * tstep;
    S.a_ready(cur);
    if constexpr (SP2) {
        PG8_STAGE(PG8_SB(0, 0), cB, voffB); PG8_STAGE(PG8_SB(0, 1), cB + hstep, voffB); PG8_STAGE(PG8_SA(0, 0), cA, voffA); PG8_STAGE(PG8_SA(0, 1), cA + hstepA, voffA);
        if (wr == 1) PG8_BAR;
        PG8_WAIT_V(2); PG8_BAR;
        PG8_STAGE(PG8_SB(1, 0), cB + kstep, voffB); PG8_STAGE(PG8_SA(1, 0), cA + kstepA, voffA); PG8_STAGE(PG8_SB(1, 1), cB + hstep + kstep, voffB);
        PG8_WAIT_V(6); PG8_BAR;
    } else {
        PG8_STAGE(PG8_SB(0, 0), cB, voffB); PG8_STAGE(PG8_SA(0, 0), cA, voffA); PG8_STAGE(PG8_SB(0, 1), cB + hstep, voffB); PG8_STAGE(PG8_SA(0, 1), cA + hstepA, voffA);
        if (wr == 1) PG8_BAR;
        PG8_WAIT_V(4); PG8_BAR;
        PG8_STAGE(PG8_SB(1, 0), cB + kstep, voffB); PG8_STAGE(PG8_SA(1, 0), cA + kstepA, voffA); PG8_STAGE(PG8_SB(1, 1), cB + hstep + kstep, voffB);
        PG8_WAIT_V(6); PG8_BAR;
    }
    for (;;) {
        const bool has_next = S.next(ui + 1, nxt);
        const char* nA = has_next ? (const char*)g.A + (size_t)nxt.pm * tstepA : cA; const char* nB = has_next ? (const char*)g.Bt + (size_t)nxt.pn * tstep : cB;
        for (int t = 0; t < nt; t += 2) {
            const bool last = (t == nt - 2);
            const char* a1 = cA + (size_t)(t + 1) * kstepA;
            const char* a2 = last ? nA : cA + (size_t)(t + 2) * kstepA; const char* b2 = last ? nB : cB + (size_t)(t + 2) * kstep;
            const char* a3 = a2 + kstepA; const char* b3 = b2 + kstep;
            if (last && has_next) S.a_ready(nxt);
            if constexpr (SP2) {
            PG8_LDB(B0, 0, 0); PG8_LDB(B1, 0, 1); PG8_SCHED; PG8_LDA(At, 0, 0); PG8_STAGE(PG8_SA(1, 1), a1 + hstepA, voffA);
            PG8_WAIT_V(8); PG8_WAIT_L(0); PG8_BAR; PG8_MMA(0, 0, At, B0); PG8_MMA(0, 1, At, B1); PG8_BAR; PG8_SCHED;
            PG8_LDA(At, 0, 1); PG8_STAGE(PG8_SB(0, 0), b2, voffB); PG8_STAGE(PG8_SB(0, 1), b2 + hstep, voffB); PG8_STAGE(PG8_SA(0, 0), a2, voffA);
            PG8_WAIT_V(8); PG8_WAIT_L(0); PG8_BAR; PG8_MMA(1, 0, At, B0); PG8_MMA(1, 1, At, B1); PG8_BAR; PG8_SCHED;
            PG8_LDB(B0, 1, 0); PG8_LDB(B1, 1, 1); PG8_SCHED; PG8_LDA(At, 1, 0); PG8_STAGE(PG8_SA(0, 1), a2 + hstepA, voffA);
            PG8_WAIT_V(8); PG8_WAIT_L(0); PG8_BAR; PG8_MMA(0, 0, At, B0); PG8_MMA(0, 1, At, B1); PG8_BAR; PG8_SCHED;
            PG8_LDA(At, 1, 1); PG8_STAGE(PG8_SB(1, 0), b3, voffB); PG8_STAGE(PG8_SB(1, 1), b3 + hstep, voffB); PG8_STAGE(PG8_SA(1, 0), a3, voffA);
            PG8_WAIT_V(8); PG8_WAIT_L(0); PG8_BAR; PG8_MMA(1, 0, At, B0); PG8_MMA(1, 1, At, B1); PG8_BAR; PG8_SCHED;
            } else {
            PG8_LDB(B0, 0, 0); PG8_SCHED; PG8_LDA(At, 0, 0); PG8_STAGE(PG8_SA(1, 1), a1 + hstepA, voffA);
            PG8_WAIT_L(8); PG8_BAR; PG8_WAIT_L(0); PG8_MMA(0, 0, At, B0); PG8_BAR; PG8_SCHED;
            PG8_LDB(B1, 0, 1); PG8_STAGE(PG8_SB(0, 0), b2, voffB);
            PG8_BAR; PG8_WAIT_L(0); PG8_MMA(0, 1, At, B1); PG8_BAR;
            PG8_LDA(At, 0, 1); PG8_STAGE(PG8_SA(0, 0), a2, voffA);
            PG8_BAR; PG8_WAIT_L(0); PG8_MMA(1, 0, At, B0); PG8_BAR; PG8_SCHED;
            PG8_STAGE(PG8_SB(0, 1), b2 + hstep, voffB);
            PG8_WAIT_V(6); PG8_BAR; PG8_MMA(1, 1, At, B1); PG8_BAR;
            PG8_LDB(B0, 1, 0); PG8_SCHED; PG8_LDA(At, 1, 0); PG8_STAGE(PG8_SA(0, 1), a2 + hstepA, voffA);
            PG8_WAIT_L(8); PG8_BAR; PG8_WAIT_L(0); PG8_MMA(0, 0, At, B0); PG8_BAR; PG8_SCHED;
            PG8_LDB(B1, 1, 1); PG8_STAGE(PG8_SB(1, 0), b3, voffB);
            PG8_BAR; PG8_WAIT_L(0); PG8_MMA(0, 1, At, B1); PG8_BAR;
            PG8_LDA(At, 1, 1); PG8_STAGE(PG8_SA(1, 0), a3, voffA);
            PG8_BAR; PG8_WAIT_L(0); PG8_MMA(1, 0, At, B0); PG8_BAR; PG8_SCHED;
            PG8_STAGE(PG8_SB(1, 1), b3 + hstep, voffB);
            PG8_WAIT_V(6); PG8_BAR; PG8_MMA(1, 1, At, B1); PG8_BAR;
            }
        }
        if constexpr (ALIGN_EPI) { if (wr == 0) PG8_BAR; }
        if constexpr (!Epi::AFTER_DRAIN) { E(acc, cur, wr, wc, fr, fq); S.done(cur); }
        if (!has_next) break;
#pragma unroll
        for (int a = 0; a < 2; ++a)
#pragma unroll
            for (int b = 0; b < 2; ++b)
#pragma unroll
                for (int m = 0; m < 4; ++m)
#pragma unroll
                    for (int n = 0; n < 2; ++n) acc[a][b][m][n] = (f32x4){0.f, 0.f, 0.f, 0.f};
        cur = nxt; cA = nA; cB = nB; ++ui;
        if constexpr (ALIGN_EPI) { if (wr == 1) PG8_BAR; }
    }
    PG8_WAIT_V(0);
    if constexpr (!ALIGN_EPI) { if (wr == 0) PG8_BAR; }
    PG8_BAR;
    if constexpr (Epi::AFTER_DRAIN) { E.fused(acc, cur, wr, wc, fr, fq, lds, wid, lane); S.done(cur); }
#undef PG8_SA
#undef PG8_SB
#undef PG8_STAGE
#undef PG8_LDA
#undef PG8_LDB
#undef PG8_MMA
#undef PG8_WAIT_V
#undef PG8_WAIT_L
#undef PG8_BAR
#undef PG8_SCHED
}
}

#define GAS __attribute__((address_space(1)))
#define LAS __attribute__((address_space(3)))
typedef unsigned short bf16;
typedef float f32x4 __attribute__((ext_vector_type(4)));
typedef float f32x16 __attribute__((ext_vector_type(16)));
typedef short bf16x8 __attribute__((ext_vector_type(8)));
typedef short s16x4 __attribute__((ext_vector_type(4)));
typedef unsigned u32x4 __attribute__((ext_vector_type(4)));
typedef unsigned u32x2 __attribute__((ext_vector_type(2)));
typedef GAS unsigned gu32;
#define RLX_AGENT __ATOMIC_RELAXED, __HIP_MEMORY_SCOPE_AGENT
#define LDS_WAIT() asm volatile("s_waitcnt lgkmcnt(0)" ::: "memory")
#define VM_WAIT() asm volatile("s_waitcnt vmcnt(0)" ::: "memory")
__device__ __forceinline__ unsigned pk2(float lo, float hi) { return pg8::pk_bf16(lo, hi); }
__device__ __forceinline__ float bf2f(unsigned short b) { return __builtin_bit_cast(float, (unsigned)b << 16); }
__device__ __forceinline__ float ex2(float x) { return __builtin_amdgcn_exp2f(x); }
__device__ __forceinline__ float wave_sum(float v) {
#pragma unroll
    for (int o = 1; o < 64; o <<= 1) v += __shfl_xor(v, o);
    return v;
}

namespace fa {
constexpr int KSLOT = 12288, VSLOT = 8192;
constexpr int L_K = 0, L_V = 2 * KSLOT, L_WS = L_V + 2 * VSLOT, L_OST = L_WS + 8 * 64 * 4, L_BYTES = L_OST + 8 * 32 * 64 * 4;
constexpr int L_WS2 = L_V + 3 * VSLOT, L_CB2 = L_WS2 + 8 * 128 * 4, L_OST2 = L_CB2 + 512, L_QR2 = L_OST2 + 8 * 4096, L_BYTES2 = L_QR2 + 8 * 4096;
__device__ __forceinline__ int crow(int r, int hi) { return (r & 3) + 8 * (r >> 2) + 4 * hi; }
__device__ __forceinline__ void glds16(const void* gsrc, unsigned lds_dst) { unsigned keep;
    asm volatile("s_mov_b32 %0, m0\n\ts_mov_b32 m0, %2\n\ts_nop 0\n\tglobal_load_lds_dwordx4 %1, off\n\ts_mov_b32 m0, %0" : "=&s"(keep) : "v"(gsrc), "s"(lds_dst) : "memory"); }
#define FA_WAIT_BAR() asm volatile("s_waitcnt vmcnt(0) lgkmcnt(0)\n\ts_barrier" ::: "memory")
#define FA_SBAR() __builtin_amdgcn_sched_barrier(0)
template <int ND0> __device__ __forceinline__ void qkt(f32x16& p0, f32x16& p1, const LAS char* kp, const bf16x8* qr) {
    p0 = f32x16{}; p1 = f32x16{};
#pragma unroll
    for (int d0 = 0; d0 < ND0; ++d0) {
        const bf16x8 b0 = *(const LAS bf16x8*)(kp + d0 * 2048);
        const bf16x8 b1 = *(const LAS bf16x8*)(kp + d0 * 2048 + 512);
        p0 = __builtin_amdgcn_mfma_f32_32x32x16_bf16(b0, qr[d0], p0, 0, 0, 0); p1 = __builtin_amdgcn_mfma_f32_32x32x16_bf16(b1, qr[d0], p1, 0, 0, 0); }
}
__device__ __forceinline__ float max3f(float a, float b, float c) { float r; asm("v_max3_f32 %0, %1, %2, %3" : "=v"(r) : "v"(a), "v"(b), "v"(c)); return r; }
__device__ __forceinline__ float max2f(float a, float b) { float r; asm("v_max_f32_e32 %0, %1, %2" : "=v"(r) : "v"(a), "v"(b)); return r; }
__device__ __forceinline__ float rowmax_a(const f32x16& p0, const f32x16& p1) {
    float a = max3f(p0[0], p0[1], p1[0]), b = max3f(p0[2], p0[3], p1[1]); a = max3f(a, p1[2], p1[3]);
#pragma unroll
    for (int r = 4; r < 16; r += 4) { a = max3f(a, p0[r], p0[r + 1]); b = max3f(b, p0[r + 2], p0[r + 3]); a = max3f(a, p1[r], p1[r + 1]); b = max3f(b, p1[r + 2], p1[r + 3]); }
    const float m = max2f(a, b);
    auto rr = __builtin_amdgcn_permlane32_swap(__float_as_uint(m), __float_as_uint(m), false, false);
    return max2f(__uint_as_float(rr[0]), __uint_as_float(rr[1]));
}
__device__ __forceinline__ float rowmax(const f32x16& p0, const f32x16& p1) {
    float a = __builtin_fmaxf(p0[0], p1[0]);
#pragma unroll
    for (int r = 1; r < 16; ++r) a = __builtin_fmaxf(a, __builtin_fmaxf(p0[r], p1[r]));
    auto rr = __builtin_amdgcn_permlane32_swap(__float_as_uint(a), __float_as_uint(a), false, false);
    return __builtin_fmaxf(__uint_as_float(rr[0]), __uint_as_float(rr[1]));
}
__device__ __forceinline__ void pv(f32x16* o, int vb, bf16x8 pa0, bf16x8 pa1, bf16x8 pa2, bf16x8 pa3) {
#pragma unroll
    for (int d0 = 0; d0 < 2; ++d0) { s16x4 lo[4], hi[4];
#pragma unroll
        for (int ks = 0; ks < 4; ++ks) {
            asm volatile("ds_read_b64_tr_b16 %0,%1 offset:%c2" : "=&v"(lo[ks]) : "v"(vb), "i"(d0 * 4096 + ks * 1024) : "memory");
            asm volatile("ds_read_b64_tr_b16 %0,%1 offset:%c2" : "=&v"(hi[ks]) : "v"(vb), "i"(d0 * 4096 + ks * 1024 + 512) : "memory"); }
        asm volatile("s_waitcnt lgkmcnt(0)" ::: "memory"); FA_SBAR();
#define FA_PK(k) (bf16x8){lo[k][0], lo[k][1], lo[k][2], lo[k][3], hi[k][0], hi[k][1], hi[k][2], hi[k][3]}
        o[d0] = __builtin_amdgcn_mfma_f32_32x32x16_bf16(pa0, FA_PK(0), o[d0], 0, 0, 0);
        o[d0] = __builtin_amdgcn_mfma_f32_32x32x16_bf16(pa1, FA_PK(1), o[d0], 0, 0, 0);
        o[d0] = __builtin_amdgcn_mfma_f32_32x32x16_bf16(pa2, FA_PK(2), o[d0], 0, 0, 0);
        o[d0] = __builtin_amdgcn_mfma_f32_32x32x16_bf16(pa3, FA_PK(3), o[d0], 0, 0, 0);
#undef FA_PK
    }
}
struct Args { const bf16* Q; int qpitch, qcol; const bf16* K; int kpitch, kcol; const bf16* K2; const bf16* V; int vpitch, vcol; bf16* O; int ocol; const bf16* G; const float* CB; };
template <int MODE> __device__ __forceinline__ void unit(const Args& A, long rowbase, int qb, LAS char* lds, unsigned lds0) {
    constexpr int ND0 = MODE ? 6 : 4;
    const int tid = pg8::pg8_tid(), lane = tid & 63, r32 = lane & 31, hi = lane >> 5; const int wid = __builtin_amdgcn_readfirstlane(tid >> 6);
    const int q0 = qb * 256, NT = q0 / 64 + 4, nt_w = MODE ? (q0 / 64 + (wid >> 1) + 1) : NT;
    const bf16* Qw = A.Q + (rowbase + q0 + wid * 32 + r32) * A.qpitch + A.qcol + hi * 8;
    bf16x8 qr[ND0];
#pragma unroll
    for (int d0 = 0; d0 < ND0; ++d0) qr[d0] = *(const bf16x8*)(Qw + d0 * 16);
    const bf16* ksrc = A.K + (rowbase + lane) * A.kpitch + A.kcol + wid * 8;
    const bf16* ksrc2 = MODE ? A.K2 + (rowbase + lane) * 32 + (wid & 3) * 8 : nullptr;
    const bf16* vsrc = A.V + (rowbase + 16 * (wid & 3) + (lane >> 2)) * A.vpitch + A.vcol + (wid >> 2) * 32 + (lane & 3) * 8;
#define FA_DMA(t, slot) do { \
        glds16(ksrc + (long)(t) * 64 * A.kpitch, (unsigned)__builtin_amdgcn_readfirstlane(lds0 + L_K + (slot) * KSLOT + wid * 1024)); \
        if (MODE && wid < 4) glds16(ksrc2 + (long)(t) * 64 * 32, (unsigned)__builtin_amdgcn_readfirstlane(lds0 + L_K + (slot) * KSLOT + (8 + wid) * 1024)); \
        glds16(vsrc + (long)(t) * 64 * A.vpitch, (unsigned)__builtin_amdgcn_readfirstlane(lds0 + L_V + (slot) * VSLOT + wid * 1024)); } while (0)
    LAS float* wsf = (LAS float*)(lds + L_WS) + wid * 64;
    const int vb0 = (int)(lds0 + L_V) + ((lane >> 4) & 1) * 32 + (lane & 3) * 8 + (4 * hi + ((lane & 15) >> 2)) * 64;
    float m = -1e30f, l = 0.f; f32x16 o[2]; o[0] = f32x16{}; o[1] = f32x16{};
    FA_DMA(0, 0);
    for (int t = 0; t < NT; ++t) {
        FA_WAIT_BAR();
        if (t + 1 < NT) FA_DMA(t + 1, (t + 1) & 1);
        if (t < nt_w) {
            const int slot = t & 1;
            f32x16 p0, p1; qkt<ND0>(p0, p1, lds + L_K + slot * KSLOT + hi * 1024 + r32 * 16, qr);
            if (MODE == 0) {
                const float* cb = A.CB + t * 64 + 4 * hi;
#pragma unroll
                for (int g4 = 0; g4 < 4; ++g4) { const f32x4 b0 = *(const f32x4*)(cb + 8 * g4), b1 = *(const f32x4*)(cb + 32 + 8 * g4);
#pragma unroll
                    for (int i = 0; i < 4; ++i) { p0[4 * g4 + i] += b0[i]; p1[4 * g4 + i] += b1[i]; } }
                const int jb = t - (NT - 4);
                if (jb >= 0) { const int qrel = wid * 32 + r32, kb = 64 * jb + 4 * hi;
#pragma unroll
                    for (int r = 0; r < 16; ++r) { const int kv = kb + (r & 3) + 8 * (r >> 2); if (kv > qrel) p0[r] = -INFINITY; if (kv + 32 > qrel) p1[r] = -INFINITY; } }
            }
            const float rm = rowmax(p0, p1);
            const float mn = __builtin_fmaxf(m, rm), alpha = ex2(m - mn); m = mn;
            float sacc = 0.f;
#pragma unroll
            for (int r = 0; r < 16; ++r) { p0[r] = ex2(p0[r] - mn); p1[r] = ex2(p1[r] - mn); sacc += p0[r] + p1[r]; }
            l = l * alpha + sacc;
            if (hi == 0) wsf[r32] = alpha;
#pragma unroll
            for (int r = 0; r < 16; ++r) { const float a = wsf[crow(r, hi)]; o[0][r] *= a; o[1][r] *= a; }
            u32x4 pw0, pw1, pw2, pw3;
            pw0 = (u32x4){pk2(p0[0], p0[1]), pk2(p0[2], p0[3]), pk2(p0[4], p0[5]), pk2(p0[6], p0[7])};
            pw1 = (u32x4){pk2(p0[8], p0[9]), pk2(p0[10], p0[11]), pk2(p0[12], p0[13]), pk2(p0[14], p0[15])};
            pw2 = (u32x4){pk2(p1[0], p1[1]), pk2(p1[2], p1[3]), pk2(p1[4], p1[5]), pk2(p1[6], p1[7])};
            pw3 = (u32x4){pk2(p1[8], p1[9]), pk2(p1[10], p1[11]), pk2(p1[12], p1[13]), pk2(p1[14], p1[15])};
            FA_SBAR();
            pv(o, vb0 + slot * VSLOT, __builtin_bit_cast(bf16x8, pw0), __builtin_bit_cast(bf16x8, pw1), __builtin_bit_cast(bf16x8, pw2), __builtin_bit_cast(bf16x8, pw3));
        }
    }
    { auto rr = __builtin_amdgcn_permlane32_swap(__float_as_uint(l), __float_as_uint(l), false, false); l = __uint_as_float(rr[0]) + __uint_as_float(rr[1]); }
    if (hi == 0) wsf[32 + r32] = l;
    LAS float* stg = (LAS float*)(lds + L_OST) + wid * 2048;
#pragma unroll
    for (int r = 0; r < 16; ++r) { const int orow = crow(r, hi); const float rl = __builtin_amdgcn_rcpf(wsf[32 + orow]);
        stg[orow * 64 + r32] = o[0][r] * rl; stg[orow * 64 + 32 + r32] = o[1][r] * rl; }
    LDS_WAIT();
#pragma unroll
    for (int i = 0; i < 4; ++i) { const int row = i * 8 + (lane >> 3), ch = lane & 7; const long grow = rowbase + q0 + wid * 32 + row;
        f32x4 a = *(const LAS f32x4*)(stg + row * 64 + ch * 8), b = *(const LAS f32x4*)(stg + row * 64 + ch * 8 + 4);
        if (MODE == 0) { const u32x4 g = *(const u32x4*)(A.G + grow * 1024 + A.ocol + ch * 8);
            a[0] *= __uint_as_float(g.x << 16); a[1] *= __uint_as_float(g.x & 0xffff0000u); a[2] *= __uint_as_float(g.y << 16); a[3] *= __uint_as_float(g.y & 0xffff0000u);
            b[0] *= __uint_as_float(g.z << 16); b[1] *= __uint_as_float(g.z & 0xffff0000u); b[2] *= __uint_as_float(g.w << 16); b[3] *= __uint_as_float(g.w & 0xffff0000u); }
        const u32x4 w = (u32x4){pk2(a[0], a[1]), pk2(a[2], a[3]), pk2(b[0], b[1]), pk2(b[2], b[3])};
        *(u32x4*)(A.O + grow * 1024 + A.ocol + ch * 8) = w; }
    asm volatile("s_waitcnt lgkmcnt(0)\n\ts_barrier" ::: "memory");
#undef FA_DMA
}

#ifndef FA_STAG_FOX
#define FA_STAG_FOX 1
#endif
#ifndef FA_STAG_MLA
#define FA_STAG_MLA 1
#endif
#ifndef FA_PROBE_VALU
#define FA_PROBE_VALU 0
#endif
__device__ __forceinline__ void glds4(const void* gsrc, unsigned lds_dst) { unsigned keep;
    asm volatile("s_mov_b32 %0, m0\n\ts_mov_b32 m0, %2\n\ts_nop 0\n\tglobal_load_lds_dword %1, off\n\ts_mov_b32 m0, %0" : "=&s"(keep) : "v"(gsrc), "s"(lds_dst) : "memory"); }
__device__ __forceinline__ s16x4 vtr(const LAS char* p) { typedef short v4i16_t __attribute__((ext_vector_type(4))); return __builtin_bit_cast(s16x4, __builtin_amdgcn_ds_read_tr16_b64_v4i16((LAS v4i16_t*)p)); }
template <int MODE, bool DIAG> __device__ __forceinline__ void tile_qs(const LAS char* kp, const bf16x8 (&qr)[2][4], const LAS char* qrl, const LAS float* cbl, int r32, int hi,
                                                                     float (&m)[2], float (&l)[2], f32x16 (&o)[2][2], LAS float* wsf, u32x4 (&pw)[2][4]) {
    constexpr int ND0 = MODE ? 6 : 4;
    f32x16 p[2][2];
    if (MODE == 0) {
#pragma unroll
        for (int g4 = 0; g4 < 4; ++g4) { const f32x4 b0 = *(const LAS f32x4*)(cbl + 4 * hi + 8 * g4), b1 = *(const LAS f32x4*)(cbl + 32 + 4 * hi + 8 * g4);
#pragma unroll
            for (int i = 0; i < 4; ++i) { p[0][0][4 * g4 + i] = b0[i]; p[0][1][4 * g4 + i] = b1[i]; } }
        p[1][0] = p[0][0]; p[1][1] = p[0][1];
    } else {
#pragma unroll
        for (int b2 = 0; b2 < 2; ++b2) { p[b2][0] = f32x16{}; p[b2][1] = f32x16{}; }
    }
    bf16x8 qx[2][2];
    if (MODE) {
#pragma unroll
        for (int b2 = 0; b2 < 2; ++b2) { qx[b2][0] = *(const LAS bf16x8*)(qrl + (b2 * 2) * 1024); qx[b2][1] = *(const LAS bf16x8*)(qrl + (b2 * 2 + 1) * 1024); } }
#pragma unroll
    for (int d0 = 0; d0 < ND0; ++d0) { const bf16x8 k0 = *(const LAS bf16x8*)(kp + d0 * 2048), k1 = *(const LAS bf16x8*)(kp + d0 * 2048 + 512);
#pragma unroll
        for (int b2 = 0; b2 < 2; ++b2) { const bf16x8 qv = (d0 < 4) ? qr[b2][d0 & 3] : qx[b2][d0 & 1];
            p[b2][0] = __builtin_amdgcn_mfma_f32_32x32x16_bf16(k0, qv, p[b2][0], 0, 0, 0); p[b2][1] = __builtin_amdgcn_mfma_f32_32x32x16_bf16(k1, qv, p[b2][1], 0, 0, 0); } }
    if (MODE == 0 && DIAG) {
#pragma unroll
        for (int b2 = 0; b2 < 2; ++b2) { const int qrel = 32 * b2 + r32;
#pragma unroll
            for (int r = 0; r < 16; ++r) { const int kv = 4 * hi + (r & 3) + 8 * (r >> 2); if (kv > qrel) p[b2][0][r] = -INFINITY; if (kv + 32 > qrel) p[b2][1][r] = -INFINITY; } } }
    asm volatile("s_nop 15\n\ts_nop 7" : "+v"(p[0][0]), "+v"(p[0][1]), "+v"(p[1][0]), "+v"(p[1][1]));
#if FA_PROBE_VALU
    { float dd[8];
#pragma unroll
      for (int i = 0; i < 8; ++i) dd[i] = m[0] + (float)i;
#pragma unroll
      for (int k = 0; k < FA_PROBE_VALU; ++k)
#pragma unroll
        for (int i = 0; i < 8; ++i) dd[i] = ex2(dd[i]);
#pragma unroll
      for (int i = 0; i < 8; ++i) asm volatile("" :: "v"(dd[i])); }
#endif
#pragma unroll
    for (int b2 = 0; b2 < 2; ++b2) {
        const float rm = rowmax_a(p[b2][0], p[b2][1]);
        const float mn = max2f(m[b2], rm); float alpha = m[b2] - mn; asm("v_exp_f32 %0, %0\n\ts_nop 0" : "+v"(alpha)); m[b2] = mn;
        float sa0 = 0.f, sa1 = 0.f;
#pragma unroll
        for (int r = 0; r < 16; r += 2) { float a = p[b2][0][r] - mn, b = p[b2][1][r] - mn, c = p[b2][0][r + 1] - mn, d = p[b2][1][r + 1] - mn;
            asm("v_exp_f32 %0, %0\n\tv_exp_f32 %1, %1\n\tv_exp_f32 %2, %2\n\tv_exp_f32 %3, %3\n\tv_add_f32 %4, %4, %0\n\tv_add_f32 %5, %5, %1\n\tv_add_f32 %4, %4, %2\n\tv_add_f32 %5, %5, %3"
                : "+v"(a), "+v"(b), "+v"(c), "+v"(d), "+v"(sa0), "+v"(sa1));
            p[b2][0][r] = a; p[b2][1][r] = b; p[b2][0][r + 1] = c; p[b2][1][r + 1] = d; }
        l[b2] = l[b2] * alpha + (sa0 + sa1);
#pragma unroll
        for (int r = 0; r < 16; ++r) { float t0 = o[b2][0][r], t1 = o[b2][1][r]; asm("v_mul_f32 %0, %0, %1" : "+v"(t0) : "v"(alpha)); asm("v_mul_f32 %0, %0, %1" : "+v"(t1) : "v"(alpha)); o[b2][0][r] = t0; o[b2][1][r] = t1; }
        pw[b2][0] = (u32x4){pk2(p[b2][0][0], p[b2][0][1]), pk2(p[b2][0][2], p[b2][0][3]), pk2(p[b2][0][4], p[b2][0][5]), pk2(p[b2][0][6], p[b2][0][7])};
        pw[b2][1] = (u32x4){pk2(p[b2][0][8], p[b2][0][9]), pk2(p[b2][0][10], p[b2][0][11]), pk2(p[b2][0][12], p[b2][0][13]), pk2(p[b2][0][14], p[b2][0][15])};
        pw[b2][2] = (u32x4){pk2(p[b2][1][0], p[b2][1][1]), pk2(p[b2][1][2], p[b2][1][3]), pk2(p[b2][1][4], p[b2][1][5]), pk2(p[b2][1][6], p[b2][1][7])};
        pw[b2][3] = (u32x4){pk2(p[b2][1][8], p[b2][1][9]), pk2(p[b2][1][10], p[b2][1][11]), pk2(p[b2][1][12], p[b2][1][13]), pk2(p[b2][1][14], p[b2][1][15])};
    }
    asm volatile("s_nop 1" : "+v"(o[0][0]), "+v"(o[0][1]), "+v"(o[1][0]), "+v"(o[1][1]));
}
__device__ __forceinline__ void tile_pv(const LAS char* vp, f32x16 (&o)[2][2], const u32x4 (&pw)[2][4]) {
#pragma unroll
    for (int d0 = 0; d0 < 2; ++d0)
#pragma unroll
        for (int ks = 0; ks < 4; ++ks) { const s16x4 lo = vtr(vp + d0 * 4096 + ks * 1024), hi4 = vtr(vp + d0 * 4096 + ks * 1024 + 512);
            const bf16x8 vf = (bf16x8){lo[0], lo[1], lo[2], lo[3], hi4[0], hi4[1], hi4[2], hi4[3]};
#pragma unroll
            for (int b2 = 0; b2 < 2; ++b2) o[b2][d0] = __builtin_amdgcn_mfma_f32_32x32x16_bf16(vf, __builtin_bit_cast(bf16x8, pw[b2][ks]), o[b2][d0], 0, 0, 0); }
}
template <int MODE> __device__ __forceinline__ void unit2(const Args& A, long rowbase, int qb, LAS char* lds, unsigned lds0) {
    constexpr int ND0 = MODE ? 6 : 4;
    const int tid = pg8::pg8_tid(), lane = tid & 63, r32 = lane & 31, hi = lane >> 5; const int wid = __builtin_amdgcn_readfirstlane(tid >> 6);
    const int q0 = qb * 512, NT = q0 / 64 + 8, nt_w = q0 / 64 + wid + 1;
    bf16x8 qr[2][4];
    LAS char* qrl = lds + L_QR2 + wid * 4096 + lane * 16;
#pragma unroll
    for (int b2 = 0; b2 < 2; ++b2) { const bf16* Qw = A.Q + (rowbase + q0 + wid * 64 + b2 * 32 + r32) * A.qpitch + A.qcol + hi * 8;
#pragma unroll
        for (int d0 = 0; d0 < 4; ++d0) qr[b2][d0] = *(const bf16x8*)(Qw + d0 * 16);
        if (MODE) { *(LAS bf16x8*)(qrl + (b2 * 2) * 1024) = *(const bf16x8*)(Qw + 64); *(LAS bf16x8*)(qrl + (b2 * 2 + 1) * 1024) = *(const bf16x8*)(Qw + 80); } }
    const int koff = lane * A.kpitch + A.kcol + wid * 8, k2off = lane * 32 + (wid & 3) * 8, voff = (16 * (wid & 3) + (lane >> 2)) * A.vpitch + A.vcol + (wid >> 2) * 32 + (lane & 3) * 8;
    const bf16* Kb = A.K + rowbase * A.kpitch; const bf16* K2b = MODE ? A.K2 + rowbase * 32 : nullptr; const bf16* Vb = A.V + rowbase * A.vpitch;
#define FA_DMA(t, slot) do { \
        int ko_ = koff, k2o_ = k2off, vo_ = voff; asm volatile("" : "+v"(ko_), "+v"(k2o_), "+v"(vo_)); \
        glds16(Kb + (long)(t) * 64 * A.kpitch + ko_, (unsigned)__builtin_amdgcn_readfirstlane(lds0 + L_K + (slot) * KSLOT + wid * 1024)); \
        if (MODE && wid < 4) glds16(K2b + (long)(t) * 64 * 32 + k2o_, (unsigned)__builtin_amdgcn_readfirstlane(lds0 + L_K + (slot) * KSLOT + (8 + wid) * 1024)); \
        glds16(Vb + (long)(t) * 64 * A.vpitch + vo_, (unsigned)__builtin_amdgcn_readfirstlane(lds0 + L_V + ((t) % 3) * VSLOT + wid * 1024)); \
        if (!MODE && wid == 4) glds4(A.CB + (t) * 64 + lane, (unsigned)__builtin_amdgcn_readfirstlane(lds0 + L_CB2 + (slot) * 256)); } while (0)
    LAS float* wsf = (LAS float*)(lds + L_WS2) + wid * 128;
    const LAS char* kp0 = lds + L_K + hi * 1024 + r32 * 16;
    const LAS char* vp0 = lds + L_V + ((lane >> 4) & 1) * 32 + (lane & 3) * 8 + (4 * hi + ((lane & 15) >> 2)) * 64;
    float m[2] = {-1e30f, -1e30f}, l[2] = {0.f, 0.f}; f32x16 o[2][2];
#pragma unroll
    for (int b2 = 0; b2 < 2; ++b2) { o[b2][0] = f32x16{}; o[b2][1] = f32x16{}; }
    FA_DMA(0, 0);
    u32x4 pw[2][4];
#define FA_STEP_HEAD(t) FA_WAIT_BAR(); if ((t) + 1 < NT) FA_DMA((t) + 1, ((t) + 1) & 1); const int slot = (t) & 1; const LAS float* cbl = (const LAS float*)(lds + L_CB2 + slot * 256)
    if (wid < 4 || !(MODE ? FA_STAG_MLA : FA_STAG_FOX)) {
        int t = 0;
        for (; t < nt_w - 1; ++t) { FA_STEP_HEAD(t); tile_qs<MODE, false>(kp0 + slot * KSLOT, qr, qrl, cbl, r32, hi, m, l, o, wsf, pw); tile_pv(vp0 + (t % 3) * VSLOT, o, pw); }
        { FA_STEP_HEAD(t); tile_qs<MODE, true>(kp0 + slot * KSLOT, qr, qrl, cbl, r32, hi, m, l, o, wsf, pw); tile_pv(vp0 + (t % 3) * VSLOT, o, pw); ++t; }
        for (; t < NT; ++t) { FA_STEP_HEAD(t); (void)slot; (void)cbl; }
    } else {
        int t = 0;
        if (nt_w > 1) { FA_STEP_HEAD(0); tile_qs<MODE, false>(kp0 + slot * KSLOT, qr, qrl, cbl, r32, hi, m, l, o, wsf, pw); t = 1;
            for (; t < nt_w - 1; ++t) { FA_STEP_HEAD(t); tile_pv(vp0 + ((t - 1) % 3) * VSLOT, o, pw); FA_SBAR(); tile_qs<MODE, false>(kp0 + slot * KSLOT, qr, qrl, cbl, r32, hi, m, l, o, wsf, pw); }
            { FA_STEP_HEAD(t); tile_pv(vp0 + ((t - 1) % 3) * VSLOT, o, pw); FA_SBAR(); tile_qs<MODE, true>(kp0 + slot * KSLOT, qr, qrl, cbl, r32, hi, m, l, o, wsf, pw); ++t; }
        } else { FA_STEP_HEAD(0); tile_qs<MODE, true>(kp0 + slot * KSLOT, qr, qrl, cbl, r32, hi, m, l, o, wsf, pw); t = 1; }
        if (t < NT) { FA_STEP_HEAD(t); (void)slot; (void)cbl; tile_pv(vp0 + ((t - 1) % 3) * VSLOT, o, pw); ++t;
            for (; t < NT; ++t) { FA_STEP_HEAD(t); (void)slot; (void)cbl; } }
        else tile_pv(vp0 + ((NT - 1) % 3) * VSLOT, o, pw);
    }
#undef FA_STEP_HEAD
#pragma unroll
    for (int b2 = 0; b2 < 2; ++b2) {
        float lb = l[b2];
        { auto rr = __builtin_amdgcn_permlane32_swap(__float_as_uint(lb), __float_as_uint(lb), false, false); lb = __uint_as_float(rr[0]) + __uint_as_float(rr[1]); }
        const float rl = __builtin_amdgcn_rcpf(lb); const long grow = rowbase + q0 + wid * 64 + b2 * 32 + r32;
#pragma unroll
        for (int d0 = 0; d0 < 2; ++d0)
#pragma unroll
            for (int g4 = 0; g4 < 4; ++g4) { const int dc = A.ocol + 32 * d0 + 8 * g4 + 4 * hi;
                f32x4 v = (f32x4){o[b2][d0][4 * g4], o[b2][d0][4 * g4 + 1], o[b2][d0][4 * g4 + 2], o[b2][d0][4 * g4 + 3]} * rl;
                if (MODE == 0) { const u32x2 g = *(const u32x2*)(A.G + grow * 1024 + dc);
                    v[0] *= __uint_as_float(g.x << 16); v[1] *= __uint_as_float(g.x & 0xffff0000u); v[2] *= __uint_as_float(g.y << 16); v[3] *= __uint_as_float(g.y & 0xffff0000u); }
                *(u32x2*)(A.O + grow * 1024 + dc) = (u32x2){pk2(v[0], v[1]), pk2(v[2], v[3])}; }
    }
    asm volatile("s_waitcnt lgkmcnt(0)\n\ts_barrier" ::: "memory");
#undef FA_DMA
}
}

namespace a16 {
__device__ __forceinline__ f32x4 mfma16(bf16x8 a, bf16x8 b, f32x4 c) { return __builtin_amdgcn_mfma_f32_16x16x32_bf16(a, b, c, 0, 0, 0); }
template <int NQK, int NDB, class KL, class VL, class SF>
__device__ __forceinline__ void steps(int s0, int s1, const bf16x8 (&qf)[NQK], KL kload, VL vload, SF sfix, float& m, float& l, f32x4 (&o)[NDB], int lane) {
    const int g = lane >> 4;
    for (int s = s0; s < s1; ++s) {
        f32x4 sA = {0.f, 0.f, 0.f, 0.f}, sB = {0.f, 0.f, 0.f, 0.f};
#pragma unroll
        for (int d0 = 0; d0 < NQK; ++d0) { sA = mfma16(kload(s, 0, d0), qf[d0], sA); sB = mfma16(kload(s, 1, d0), qf[d0], sB); }
        sfix(s, sA, sB);
        float mx = __builtin_fmaxf(__builtin_fmaxf(__builtin_fmaxf(sA[0], sA[1]), __builtin_fmaxf(sA[2], sA[3])), __builtin_fmaxf(__builtin_fmaxf(sB[0], sB[1]), __builtin_fmaxf(sB[2], sB[3])));
        mx = __builtin_fmaxf(mx, __shfl_xor(mx, 16)); mx = __builtin_fmaxf(mx, __shfl_xor(mx, 32));
        const float mn = __builtin_fmaxf(m, mx), alpha = ex2(m - mn); m = mn;
        f32x4 pA, pB;
#pragma unroll
        for (int r = 0; r < 4; ++r) { pA[r] = ex2(sA[r] - mn); pB[r] = ex2(sB[r] - mn); }
        float ps = ((pA[0] + pA[1]) + (pA[2] + pA[3])) + ((pB[0] + pB[1]) + (pB[2] + pB[3]));
        ps += __shfl_xor(ps, 16); ps += __shfl_xor(ps, 32);
        l = l * alpha + ps;
        const float a0 = __shfl(alpha, 4 * g), a1 = __shfl(alpha, 4 * g + 1), a2 = __shfl(alpha, 4 * g + 2), a3 = __shfl(alpha, 4 * g + 3);
#pragma unroll
        for (int db = 0; db < NDB; ++db) { o[db][0] *= a0; o[db][1] *= a1; o[db][2] *= a2; o[db][3] *= a3; }
        const u32x4 pw = (u32x4){pk2(pA[0], pA[1]), pk2(pA[2], pA[3]), pk2(pB[0], pB[1]), pk2(pB[2], pB[3])};
        const bf16x8 pf = __builtin_bit_cast(bf16x8, pw);
#pragma unroll
        for (int db = 0; db < NDB; ++db) o[db] = mfma16(pf, vload(s, db), o[db]);
    }
}
__device__ __forceinline__ bf16x8 cvt8(f32x4 a, f32x4 b) { const u32x4 w = (u32x4){pk2(a[0], a[1]), pk2(a[2], a[3]), pk2(b[0], b[1]), pk2(b[2], b[3])}; return __builtin_bit_cast(bf16x8, w); }
__device__ __forceinline__ bf16x8 join8(u32x2 a, u32x2 b) { const u32x4 w = (u32x4){a.x, a.y, b.x, b.y}; return __builtin_bit_cast(bf16x8, w); }
}


namespace xa {
constexpr int TSZ = 16384, L_T = 0, L_WS = 2 * TSZ, L_OST = L_WS + 8 * 64 * 4, L_BYTES = L_OST + 8 * 2048;
#define XA_WAIT_BAR() asm volatile("s_waitcnt vmcnt(0) lgkmcnt(0)\n\ts_barrier" ::: "memory")
template <typename T> __device__ __forceinline__ const T* src_of(const T* Kh, const T* Vh, int pitch, int i, int ci) {
    return (i < 8) ? Kh + (size_t)(32 * i + (ci & 31)) * pitch + (ci >> 5) * 8 : Vh + (size_t)(ci >> 2) * pitch + 32 * (i - 8) + (ci & 3) * 8; }
template <bool F32SRC> __device__ __forceinline__ void unit(const void* Kh_, const void* Vh_, int pitch, const bf16* Q, bf16* O, size_t row0, int hcol, int nvalid_w0, bool only_w0, LAS char* lds, unsigned lds0) {
    const int tid = pg8::pg8_tid(), lane = tid & 63, r32 = lane & 31, hi = lane >> 5; const int wid = __builtin_amdgcn_readfirstlane(tid >> 6);
    const bool active = !only_w0 || wid == 0; const int nvalid = only_w0 ? (wid == 0 ? nvalid_w0 : 0) : 32;
    bf16x8 qr[16];
    { const bf16* Qw = Q + (row0 + wid * 32 + r32) * 1024 + hcol + hi * 8;
#pragma unroll
      for (int d0 = 0; d0 < 16; ++d0) qr[d0] = active ? *(const bf16x8*)(Qw + d0 * 16) : (bf16x8){0, 0, 0, 0, 0, 0, 0, 0}; }
    LAS float* wsf = (LAS float*)(lds + L_WS) + wid * 64;
    f32x4 st[2][2];
#define XA_ISSUE(i) do { if (F32SRC) { _Pragma("unroll") for (int c2 = 0; c2 < 2; ++c2) { const float* s = src_of<float>((const float*)Kh_, (const float*)Vh_, pitch, (i), tid + 512 * c2); st[c2][0] = *(const f32x4*)s; st[c2][1] = *(const f32x4*)(s + 4); } } \
        else { _Pragma("unroll") for (int c2 = 0; c2 < 2; ++c2) fa::glds16(src_of<bf16>((const bf16*)Kh_, (const bf16*)Vh_, pitch, (i), (2 * wid + c2) * 64 + lane), (unsigned)__builtin_amdgcn_readfirstlane(lds0 + L_T + ((i) & 1) * TSZ + (2 * wid + c2) * 1024)); } } while (0)
#define XA_COMMIT(i) do { if (F32SRC) { _Pragma("unroll") for (int c2 = 0; c2 < 2; ++c2) *(LAS u32x4*)(lds + L_T + ((i) & 1) * TSZ + (tid + 512 * c2) * 16) = \
        (u32x4){pk2(st[c2][0][0], st[c2][0][1]), pk2(st[c2][0][2], st[c2][0][3]), pk2(st[c2][1][0], st[c2][1][1]), pk2(st[c2][1][2], st[c2][1][3])}; } } while (0)
    XA_ISSUE(0); XA_COMMIT(0);
    f32x16 S[8];
#pragma unroll
    for (int t = 0; t < 8; ++t) {
        XA_WAIT_BAR(); XA_ISSUE(t + 1);
        const LAS char* kp = lds + L_T + (t & 1) * TSZ + hi * 512 + r32 * 16;
        S[t] = f32x16{};
#pragma unroll
        for (int d0 = 0; d0 < 16; ++d0) S[t] = __builtin_amdgcn_mfma_f32_32x32x16_bf16(*(const LAS bf16x8*)(kp + d0 * 1024), qr[d0], S[t], 0, 0, 0);
        XA_COMMIT(t + 1);
    }
    float mx = S[0][0];
#pragma unroll
    for (int t = 0; t < 8; ++t)
#pragma unroll
        for (int r = 0; r < 16; ++r) mx = __builtin_fmaxf(mx, S[t][r]);
    { auto rr = __builtin_amdgcn_permlane32_swap(__float_as_uint(mx), __float_as_uint(mx), false, false); mx = __builtin_fmaxf(__uint_as_float(rr[0]), __uint_as_float(rr[1])); }
    float l = 0.f; u32x4 pw[16];
#pragma unroll
    for (int t = 0; t < 8; ++t) {
#pragma unroll
        for (int r = 0; r < 16; ++r) { S[t][r] = ex2(S[t][r] - mx); l += S[t][r]; }
        pw[2 * t] = (u32x4){pk2(S[t][0], S[t][1]), pk2(S[t][2], S[t][3]), pk2(S[t][4], S[t][5]), pk2(S[t][6], S[t][7])};
        pw[2 * t + 1] = (u32x4){pk2(S[t][8], S[t][9]), pk2(S[t][10], S[t][11]), pk2(S[t][12], S[t][13]), pk2(S[t][14], S[t][15])}; }
    { auto rr = __builtin_amdgcn_permlane32_swap(__float_as_uint(l), __float_as_uint(l), false, false); l = __uint_as_float(rr[0]) + __uint_as_float(rr[1]); }
    if (hi == 0) wsf[r32] = l;
    float rli[16];
#pragma unroll
    for (int r = 0; r < 16; ++r) rli[r] = __builtin_amdgcn_rcpf(wsf[fa::crow(r, hi)]);
    const int vbl = (int)(lds0 + L_T) + ((lane >> 4) & 1) * 32 + (lane & 3) * 8 + (4 * hi + ((lane & 15) >> 2)) * 64;
    LAS bf16* stg = (LAS bf16*)(lds + L_OST) + wid * 1024;
#pragma unroll
    for (int db = 0; db < 8; ++db) {
        XA_WAIT_BAR(); if (db < 7) XA_ISSUE(8 + db + 1);
        const int vb = vbl + (db & 1) * TSZ;
        f32x16 o = f32x16{};
#pragma unroll
        for (int k4 = 0; k4 < 4; ++k4) { s16x4 vlo[4], vhi[4];
#pragma unroll
            for (int kk = 0; kk < 4; ++kk) {
                asm volatile("ds_read_b64_tr_b16 %0,%1 offset:%c2" : "=&v"(vlo[kk]) : "v"(vb), "i"((k4 * 4 + kk) * 1024) : "memory");
                asm volatile("ds_read_b64_tr_b16 %0,%1 offset:%c2" : "=&v"(vhi[kk]) : "v"(vb), "i"((k4 * 4 + kk) * 1024 + 512) : "memory"); }
            asm volatile("s_waitcnt lgkmcnt(0)" ::: "memory"); __builtin_amdgcn_sched_barrier(0);
#pragma unroll
            for (int kk = 0; kk < 4; ++kk) o = __builtin_amdgcn_mfma_f32_32x32x16_bf16(__builtin_bit_cast(bf16x8, pw[k4 * 4 + kk]),
                (bf16x8){vlo[kk][0], vlo[kk][1], vlo[kk][2], vlo[kk][3], vhi[kk][0], vhi[kk][1], vhi[kk][2], vhi[kk][3]}, o, 0, 0, 0); }
        if (db < 7) XA_COMMIT(8 + db + 1);
#pragma unroll
        for (int r = 0; r < 16; ++r) stg[fa::crow(r, hi) * 32 + r32] = (bf16)(pk2(o[r] * rli[r], 0.f) & 0xffffu);
        LDS_WAIT();
#pragma unroll
        for (int ps = 0; ps < 2; ++ps) { const int row = ps * 16 + (lane >> 2), ch = lane & 3;
            const u32x4 v = *(const LAS u32x4*)(stg + row * 32 + ch * 8);
            if (row < nvalid) *(u32x4*)(O + (row0 + wid * 32 + row) * 1024 + hcol + 32 * db + ch * 8) = v; }
        LDS_WAIT();
    }
    asm volatile("s_waitcnt lgkmcnt(0)\n\ts_barrier" ::: "memory");
#undef XA_ISSUE
#undef XA_COMMIT
}
}

namespace ms {
constexpr int KSZ = 18432, L_T = 0, L_WS = 2 * KSZ, L_OST = L_WS + 8 * 64 * 4, L_BYTES = L_OST + 8 * 4096;
constexpr int PROW = 264;
#define MS_WAIT_BAR() asm volatile("s_waitcnt lgkmcnt(0)\n\ts_barrier" ::: "memory")
__device__ __forceinline__ const float* ms_ksrc(const float* ckvb, const float* krb, int key, int c) {
    const size_t o0 = (size_t)key * 256 + c * 8, o1 = (size_t)key * 32 + (c - 32) * 8; const bool lat = c < 32; return (lat ? ckvb : krb) + (lat ? o0 : o1); }
template <int NK> __device__ __forceinline__ void unit(const float* ckvb, const float* krb, int kclamp, const bf16* QA, float* P, LAS char* lds, unsigned lds0) {
    const int tid = pg8::pg8_tid(), lane = tid & 63, r32 = lane & 31, hi = lane >> 5; const int wid = __builtin_amdgcn_readfirstlane(tid >> 6);
    const bf16* Qw = QA + (size_t)(wid * 32 + r32) * 288 + hi * 8;
    f32x4 st[2][3][2];
#define MS_SRC(i, ci) (((i) < 8) ? ms_ksrc(ckvb, krb, min(32 * (i) + ((ci) & 31), kclamp), (ci) >> 5) \
                                  : ckvb + (size_t)min((ci) >> 2, kclamp) * 256 + 32 * ((i) - 8) + ((ci) & 3) * 8)
#define MS_NCH(i) (((i) < 8) ? 1152 : 1024)
#define MS_ISSUE(i, set) do { _Pragma("unroll") for (int c2 = 0; c2 < 3; ++c2) { const int ci = min(tid + 512 * c2, MS_NCH(i) - 1); const float* s = MS_SRC(i, ci); st[(set) & 1][c2][0] = *(const f32x4*)s; st[(set) & 1][c2][1] = *(const f32x4*)(s + 4); } } while (0)
#define MS_COMMIT(i, slot) do { _Pragma("unroll") for (int c2 = 0; c2 < 3; ++c2) { const int ci = min(tid + 512 * c2, MS_NCH(i) - 1); *(LAS u32x4*)(lds + L_T + ((slot) & 1) * KSZ + ci * 16) = \
        (u32x4){pk2(st[(slot) & 1][c2][0][0], st[(slot) & 1][c2][0][1]), pk2(st[(slot) & 1][c2][0][2], st[(slot) & 1][c2][0][3]), pk2(st[(slot) & 1][c2][1][0], st[(slot) & 1][c2][1][1]), pk2(st[(slot) & 1][c2][1][2], st[(slot) & 1][c2][1][3])}; } } while (0)
    constexpr int FIRSTV = 8;
#define MS_TILE(q) (((q) < NK) ? (q) : FIRSTV + (q) - NK)
    MS_ISSUE(MS_TILE(0), 0); MS_COMMIT(MS_TILE(0), 0); MS_ISSUE(MS_TILE(1), 1);
    f32x16 S[NK];
#pragma unroll
    for (int t = 0; t < NK; ++t) {
        MS_WAIT_BAR(); MS_ISSUE(MS_TILE(t + 2), t + 2);
        const LAS char* kp = lds + L_T + (t & 1) * KSZ + hi * 512 + r32 * 16;
        S[t] = f32x16{}; const bf16* Qt = Qw; asm volatile("" : "+v"(Qt));
#pragma unroll
        for (int d0 = 0; d0 < 18; ++d0) { S[t] = __builtin_amdgcn_mfma_f32_32x32x16_bf16(*(const LAS bf16x8*)(kp + d0 * 1024), *(const bf16x8*)(Qt + d0 * 16), S[t], 0, 0, 0);
            if (d0 % 6 == 5) __builtin_amdgcn_sched_barrier(0); }
        MS_COMMIT(MS_TILE(t + 1), t + 1);
    }
    constexpr int VS0 = (NK & 1);
    if (NK == 1) {
#pragma unroll
        for (int r = 8; r < 16; ++r) S[0][r] = -INFINITY; }
    float mx = S[0][0];
#pragma unroll
    for (int t = 0; t < NK; ++t)
#pragma unroll
        for (int r = 0; r < 16; ++r) mx = __builtin_fmaxf(mx, S[t][r]);
    { auto rr = __builtin_amdgcn_permlane32_swap(__float_as_uint(mx), __float_as_uint(mx), false, false); mx = __builtin_fmaxf(__uint_as_float(rr[0]), __uint_as_float(rr[1])); }
    float l = 0.f; u32x4 pw[2 * NK];
#pragma unroll
    for (int t = 0; t < NK; ++t) {
#pragma unroll
        for (int r = 0; r < 16; ++r) { S[t][r] = ex2(S[t][r] - mx); l += S[t][r]; }
        pw[2 * t] = (u32x4){pk2(S[t][0], S[t][1]), pk2(S[t][2], S[t][3]), pk2(S[t][4], S[t][5]), pk2(S[t][6], S[t][7])};
        pw[2 * t + 1] = (u32x4){pk2(S[t][8], S[t][9]), pk2(S[t][10], S[t][11]), pk2(S[t][12], S[t][13]), pk2(S[t][14], S[t][15])}; }
    { auto rr = __builtin_amdgcn_permlane32_swap(__float_as_uint(l), __float_as_uint(l), false, false); l = __uint_as_float(rr[0]) + __uint_as_float(rr[1]); }
    float* Pw = P + (size_t)(wid * 32) * PROW;
    if (hi == 0) { Pw[(size_t)r32 * PROW + 256] = mx; Pw[(size_t)r32 * PROW + 257] = l; }
    LAS float* stg = (LAS float*)(lds + L_OST) + wid * 1024;
#pragma unroll
    for (int db = 0; db < 8; ++db) {
        MS_WAIT_BAR(); if (db < 6) MS_ISSUE(FIRSTV + db + 2, NK + db + 2);
        const int vb = (int)(lds0 + L_T) + ((VS0 + db) & 1) * KSZ + ((lane >> 4) & 1) * 32 + (lane & 3) * 8 + (4 * hi + ((lane & 15) >> 2)) * 64;
        f32x16 o = f32x16{};
#pragma unroll
        for (int ks = 0; ks < 2 * NK; ++ks) { s16x4 vlo, vhi;
            asm volatile("ds_read_b64_tr_b16 %0,%1 offset:%c2" : "=&v"(vlo) : "v"(vb), "i"(ks * 1024) : "memory");
            asm volatile("ds_read_b64_tr_b16 %0,%1 offset:%c2" : "=&v"(vhi) : "v"(vb), "i"(ks * 1024 + 512) : "memory");
            asm volatile("s_waitcnt lgkmcnt(0)" ::: "memory"); __builtin_amdgcn_sched_barrier(0);
            o = __builtin_amdgcn_mfma_f32_32x32x16_bf16(__builtin_bit_cast(bf16x8, pw[ks]), (bf16x8){vlo[0], vlo[1], vlo[2], vlo[3], vhi[0], vhi[1], vhi[2], vhi[3]}, o, 0, 0, 0); }
#pragma unroll
        for (int r = 0; r < 16; ++r) stg[fa::crow(r, hi) * 32 + r32] = o[r];
        LDS_WAIT();
        { const int row = lane >> 1, cq = (lane & 1) * 16; float* dst = Pw + (size_t)row * PROW + 32 * db + cq;
#pragma unroll
          for (int k = 0; k < 4; ++k) *(f32x4*)(dst + 4 * k) = *(const LAS f32x4*)(stg + row * 32 + cq + 4 * k); }
        if (db < 7) MS_COMMIT(FIRSTV + db + 1, NK + db + 1);
        LDS_WAIT();
    }
    asm volatile("s_waitcnt lgkmcnt(0)\n\ts_barrier" ::: "memory");
#undef MS_SRC
#undef MS_ISSUE
#undef MS_COMMIT
#undef MS_NCH
#undef MS_TILE
}
}

constexpr int RING_OFF = 0, RING_BYTES = 131072;
constexpr int LDSCTL_OFF = RING_BYTES, MISC_OFF = LDSCTL_OFF + 320;
constexpr int LDS_BYTES = 147456;
constexpr int NWAVES = 8;
static_assert(fa::L_BYTES2 <= RING_BYTES && xa::L_BYTES <= RING_BYTES && ms::L_BYTES <= RING_BYTES, "attention LDS");

struct KArgs { const float* in[N_IN]; float* out; unsigned char* ws; int ph_lo, ph_hi; };
static_assert(sizeof(KArgs) == N_IN * 8 + 24, "KArgs has no padding");
typedef const __attribute__((address_space(4))) KArgs* KAP;
#define KA ((KAP)__builtin_amdgcn_kernarg_segment_ptr())

#define XB_TMO      128
#define XB_XCNT(j)  (256  + 64 * (j))
#define XB_XSUB(j)  (1280 + 64 * (j))
#define XB_XGEN(j)  (2304 + 64 * (j))
#define XB_TOP      3328
#define XB_TOPGEN   3392
#define XCD_BAR_WORDS 3456
#define XB_SPIN_CAP (1u << 18)

__device__ __forceinline__ unsigned xb_ld(unsigned* p)              { return __hip_atomic_load(p, __ATOMIC_RELAXED, __HIP_MEMORY_SCOPE_AGENT); }
__device__ __forceinline__ unsigned xb_add(unsigned* p, unsigned v) { return __hip_atomic_fetch_add(p, v, __ATOMIC_RELAXED, __HIP_MEMORY_SCOPE_AGENT); }
__device__ __forceinline__ unsigned xb_xcc_id() { return (unsigned)__builtin_amdgcn_s_getreg((3 << 11) | 20) & 0xFu; }
#define XB_SPIN(cond, bar) do { unsigned _sp = 0; while (cond) { __builtin_amdgcn_s_sleep(1); \
    if ((++_sp & 255u) == 0u) { if (xb_ld(&(bar)[XB_TMO])) break; if (_sp > XB_SPIN_CAP) { atomicAdd(&(bar)[XB_TMO], 1u); break; } } } } while (0)

struct XcdBarrier {
    unsigned* bar; unsigned x;
    volatile LAS unsigned* st;
};

__device__ __forceinline__ XcdBarrier xcd_barrier_post(unsigned* bar, volatile LAS unsigned* st) {
    XcdBarrier b; b.bar = bar; b.x = xb_xcc_id(); b.st = st;
    if (threadIdx.x == 0) (void)xb_add(&bar[XB_XCNT(b.x)], 1u);
    return b;
}
__device__ __forceinline__ void xcd_barrier_complete(unsigned* bar, unsigned x, unsigned& nloc, unsigned& nx) {
    const unsigned G = gridDim.x * gridDim.y * gridDim.z;
    unsigned sum, cnt, mine, sp = 0u;
    for (;;) {
        sum = 0u; cnt = 0u; mine = 0u;
#pragma unroll
        for (unsigned j = 0; j < 16; ++j) { const unsigned c = xb_ld(&bar[XB_XCNT(j)]); sum += c; cnt += (c > 0u) ? 1u : 0u; mine = (j == x) ? c : mine; }
        if (sum == G) break;
        __builtin_amdgcn_s_sleep(1);
        if ((++sp & 255u) == 0u) { if (xb_ld(&bar[XB_TMO])) break; if (sp > XB_SPIN_CAP) { atomicAdd(&bar[XB_TMO], 1u); break; } }
    }
    nloc = mine > 0u ? mine : 1u; nx = cnt > 0u ? cnt : 1u;
}

__device__ __forceinline__ void xcd_barrier(const XcdBarrier& b) {
    asm volatile("s_waitcnt vmcnt(0)" ::: "memory");
    __syncthreads();
    if (threadIdx.x == 0) {
        unsigned* bar = b.bar;
        __builtin_amdgcn_s_waitcnt(0);
        unsigned nloc = b.st[0], nx = b.st[1];
        if (nloc == 0u) { xcd_barrier_complete(bar, b.x, nloc, nx); b.st[0] = nloc; b.st[1] = nx; }
        const unsigned old = xb_add(&bar[XB_XSUB(b.x)], 1u);
        const unsigned gen = old / nloc;
        if (old + 1u == (gen + 1u) * nloc) {
            __builtin_amdgcn_fence(__ATOMIC_RELEASE, "agent");
            asm volatile("s_waitcnt vmcnt(0)" ::: "memory");
            const unsigned og = xb_add(&bar[XB_TOP], 1u);
            const unsigned tg = og / nx;
            if (og + 1u == (tg + 1u) * nx) xb_add(&bar[XB_TOPGEN], 1u);
            else XB_SPIN(xb_ld(&bar[XB_TOPGEN]) == tg, bar);
            __builtin_amdgcn_fence(__ATOMIC_ACQUIRE, "agent");
            xb_add(&bar[XB_XGEN(b.x)], 1u);
            asm volatile("s_waitcnt vmcnt(0)" ::: "memory");
        } else {
            XB_SPIN(xb_ld(&bar[XB_XGEN(b.x)]) == gen, bar);
            __builtin_amdgcn_fence(__ATOMIC_ACQUIRE, "agent");
            asm volatile("s_waitcnt vmcnt(0)" ::: "memory");
        }
    }
    __syncthreads();
}

struct Seg { const float* W; int ldw, c0, ncols, K; bf16* T; int ldt, r0; const float* g; };
__device__ __forceinline__ Seg get_seg(KAP a, unsigned char* ws, int idx) {
    Seg s; s.g = nullptr; s.r0 = 0; s.c0 = 0; s.ldw = 1024; s.ncols = 1024; s.K = 1024; s.ldt = 1024; s.W = nullptr; s.T = nullptr;
    if (idx < 4) { const int j = idx & 1; s.W = a->in[I_WFI] + (size_t)j * 1024 * 4112; s.ldw = 4112; s.T = (bf16*)(ws + WS_WFI) + (size_t)j * 4352 * 1024; s.g = a->in[I_GMIX] + (size_t)(2 * j) * 1024;
        if (idx < 2) { s.c0 = 0; s.ncols = 3072; s.r0 = 0; } else { s.c0 = 3088; s.ncols = 1024; s.r0 = 3072; } }
    else if (idx < 6) { const int j = idx - 4; s.W = a->in[I_WFO] + (size_t)j * 1024 * 1024; s.T = (bf16*)(ws + WS_WFO) + (size_t)j * 1024 * 1024; }
    else if (idx < 12) { const int e = idx - 6, j = e / 3, part = e % 3; s.W = a->in[I_WMA] + (size_t)j * 1024 * 672; s.ldw = 672; s.T = (bf16*)(ws + WS_WMA) + (size_t)j * 768 * 1024; s.g = a->in[I_GMIX] + (size_t)(2 * j + 1) * 1024;
        if (part == 0) { s.c0 = 384; s.ncols = 256; s.r0 = 0; } else if (part == 1) { s.c0 = 0; s.ncols = 384; s.r0 = 256; } else { s.c0 = 640; s.ncols = 32; s.r0 = 640; } }
    else if (idx < 14) { const int j = idx - 12; s.W = a->in[I_WMQB] + (size_t)j * 384 * 1536; s.ldw = 1536; s.ncols = 1536; s.K = 384; s.T = (bf16*)(ws + WS_WMQ) + (size_t)j * 1536 * 384; s.ldt = 384; s.g = a->in[I_GMQ] + (size_t)j * 384; }
    else if (idx < 18) { const int j = idx & 1; const bool raw = idx >= 16; s.W = a->in[I_WMKVB] + (size_t)j * 256 * 2048; s.ldw = 2048; s.ncols = 2048; s.K = 256; s.ldt = 256;
        s.T = (bf16*)(ws + (raw ? WS_WMKVR : WS_WMKV)) + (size_t)j * 2048 * 256; s.g = raw ? nullptr : a->in[I_GMKV] + (size_t)j * 256; }
    else if (idx < 20) { const int j = idx - 18; s.W = a->in[I_WMO] + (size_t)j * 1024 * 1024; s.T = (bf16*)(ws + WS_WMO) + (size_t)j * 1024 * 1024; }
    else if (idx < 24) { const int i = idx - 20; s.W = a->in[I_WXQ] + (size_t)i * 1024 * 1024; s.T = (bf16*)(ws + WS_WXQ) + (size_t)i * 1024 * 1024; s.g = a->in[I_GCROSS] + (size_t)i * 1024; }
    else if (idx < 28) { const int i = idx - 24; s.W = a->in[I_WXO] + (size_t)i * 1024 * 1024; s.T = (bf16*)(ws + WS_WXO) + (size_t)i * 1024 * 1024; }
    else if (idx < 32) { const int i = idx - 28; s.W = a->in[I_WXKV] + (size_t)i * 1024 * 2048; s.ldw = 2048; s.ncols = 2048; s.T = (bf16*)(ws + WS_WXKV) + (size_t)i * 2048 * 1024; s.g = a->in[I_GMEM] + (size_t)i * 1024; }
    else if (idx < 36) { const int i = idx - 32; s.W = a->in[I_WDN] + (size_t)i * 2816 * 1024; s.K = 2816; s.T = (bf16*)(ws + WS_WDN) + (size_t)i * 1024 * 2816; s.ldt = 2816; }
    else if (idx < 212) { const int e = idx - 36, i = e / 44, t = e % 44, pn = t >> 1, half = t & 1; s.W = a->in[I_WGU] + (size_t)i * 1024 * 5632; s.ldw = 5632; s.c0 = half * 2816 + 128 * pn; s.ncols = 128;
        s.T = (bf16*)(ws + WS_WGU) + (size_t)i * 5632 * 1024; s.r0 = 256 * pn + 128 * half; s.g = a->in[I_GFFN] + (size_t)i * 1024; }
    else { const int j = idx - 212; s.W = a->in[I_WFI] + (size_t)j * 1024 * 4112; s.ldw = 4112; s.c0 = 3072; s.ncols = 32; s.T = (bf16*)(ws + WS_WFI) + (size_t)j * 4352 * 1024; s.r0 = 4096; s.g = a->in[I_GMIX] + (size_t)(2 * j) * 1024; }
    return s;
}
constexpr int NSEG = 214;
__device__ __forceinline__ void tr_load(const Seg& s, int item, int lane, float (&v)[32]) {
    const int nnb = s.ncols / 32, kb = item / nnb, nb = item % nnb; const float* p = s.W + (size_t)(64 * kb + (lane >> 5)) * s.ldw + s.c0 + 32 * nb + (lane & 31);
#pragma unroll
    for (int i = 0; i < 32; ++i) v[i] = p[(size_t)(2 * i) * s.ldw];
}
__device__ __forceinline__ void tr_store(const Seg& s, int item, int lane, const float (&v)[32], LAS float* scr) {
    const int nnb = s.ncols / 32, kb = item / nnb, nb = item % nnb, k0 = 64 * kb, n0 = 32 * nb;
#pragma unroll
    for (int i = 0; i < 32; ++i) scr[(2 * i + (lane >> 5)) * 33 + (lane & 31)] = v[i];
    LDS_WAIT(); asm volatile("" ::: "memory");
    const int c = lane & 7; f32x4 g0 = (f32x4){1.f, 1.f, 1.f, 1.f}, g1 = g0;
    if (s.g) { g0 = *(const f32x4*)(s.g + k0 + 8 * c); g1 = *(const f32x4*)(s.g + k0 + 8 * c + 4); }
#pragma unroll
    for (int j = 0; j < 4; ++j) { const int n = (lane >> 3) + 8 * j; const LAS float* p = scr + (8 * c) * 33 + n;
        u32x4 o; o.x = pk2(p[0 * 33] * g0[0], p[1 * 33] * g0[1]); o.y = pk2(p[2 * 33] * g0[2], p[3 * 33] * g0[3]); o.z = pk2(p[4 * 33] * g1[0], p[5 * 33] * g1[1]); o.w = pk2(p[6 * 33] * g1[2], p[7 * 33] * g1[3]);
        *(u32x4*)(s.T + (size_t)(s.r0 + n0 + n) * s.ldt + k0 + 8 * c) = o; }
    LDS_WAIT(); asm volatile("" ::: "memory");
}
__device__ __forceinline__ void cvt_blocks(const float* src, bf16* dst, int nblk, int blk, size_t dstride, int gtid, int nthr) {
    const long total = (long)nblk * blk / 8;
    for (long v = gtid; v < total; v += nthr) { const long e = v * 8; const int b = (int)(e / blk), o = (int)(e % blk);
        const f32x4 x = *(const f32x4*)(src + e), y = *(const f32x4*)(src + e + 4);
        *(u32x4*)(dst + (size_t)b * dstride + o) = (u32x4){pk2(x[0], x[1]), pk2(x[2], x[3]), pk2(y[0], y[1]), pk2(y[2], y[3])}; }
}
__device__ __forceinline__ void p0_prologue(KAP a, LAS unsigned char* lds, int gw, int NGW, int wave, int lane, int pmask) {
    unsigned char* ws = a->ws; const int gtid = gw * 64 + lane, nthr = NGW * 64;
    LAS float* scr = (LAS float*)(lds + RING_OFF + wave * 16384);
#undef P0_PARTS
#define P0_PARTS pmask
    if (P0_PARTS & 1) {
        int total = 0;
        for (int sg = 0; sg < NSEG; ++sg) { const Seg s = get_seg(a, ws, sg); total += (s.K / 64) * (s.ncols / 32); }
        int sg = 0, base = 0; Seg sc = get_seg(a, ws, 0); int nit = (sc.K / 64) * (sc.ncols / 32);
#define P0_ADVANCE(gi) while ((gi) >= base + nit) { base += nit; ++sg; sc = get_seg(a, ws, sg); nit = (sc.K / 64) * (sc.ncols / 32); }
        float va[32], vb[32]; Seg sa = sc, sb = sc; int ia = 0, ib = 0;
        int gi = gw;
        if (gi < total) { P0_ADVANCE(gi); sa = sc; ia = gi - base; tr_load(sa, ia, lane, va); }
        while (gi < total) {
            int gn = gi + NGW;
            if (gn < total) { P0_ADVANCE(gn); sb = sc; ib = gn - base; tr_load(sb, ib, lane, vb); }
            tr_store(sa, ia, lane, va, scr);
            gi = gn; if (gi >= total) break;
            gn = gi + NGW;
            if (gn < total) { P0_ADVANCE(gn); sa = sc; ia = gn - base; tr_load(sa, ia, lane, va); }
            tr_store(sb, ib, lane, vb, scr);
            gi = gn;
        }
#undef P0_ADVANCE
    }
    if (P0_PARTS & 2) {
    cvt_blocks(a->in[I_WMKVB], (bf16*)(ws + WS_WKN), 1, 2 * 256 * 2048, 0, gtid, nthr); }
    if (P0_PARTS & 4) { const u32x4 z = (u32x4){0u, 0u, 0u, 0u};
      for (int v = gtid; v < 2 * 224 * 128; v += nthr) { const int j = v / (224 * 128), r = v % (224 * 128); *(u32x4*)((bf16*)(ws + WS_WFI) + ((size_t)j * 4352 + 4128) * 1024 + (size_t)r * 8) = z; }
      for (int v = gtid; v < 2 * 96 * 128; v += nthr) { const int j = v / (96 * 128), r = v % (96 * 128); *(u32x4*)((bf16*)(ws + WS_WMA) + ((size_t)j * 768 + 672) * 1024 + (size_t)r * 8) = z; }
    }
    if (P0_PARTS & 16) for (int v = gtid; v < 4096 * 16; v += nthr) { const int pos = v >> 4, c = v & 15; const double inv = pow(10000.0, -(double)c / 16.0), ang = (double)pos * inv;
        ((float*)(ws + WS_ROPC))[v] = (float)cos(ang); ((float*)(ws + WS_ROPS))[v] = (float)sin(ang); }
    if (P0_PARTS & 32) for (int row = gw; row < MT; row += NGW) { const float* xr = (row < MP) ? a->in[I_XP] + (size_t)row * 1024 : a->in[I_XS] + (size_t)(row - MP) * 1024;
        float sq = 0.f; bf16* o = (bf16*)(ws + WS_XB) + (size_t)row * 1024;
#pragma unroll
        for (int j = 0; j < 4; ++j) { const f32x4 v = *(const f32x4*)(xr + 256 * j + 4 * lane); sq += pg8::dot4(v); *(u32x2*)(o + 256 * j + 4 * lane) = pg8::pk4(v); }
        sq = wave_sum(sq);
        if (lane < 16) ((float*)(ws + WS_SSQ))[(size_t)row * 16 + lane] = (lane == 0) ? sq : 0.f; }
    if (P0_PARTS & 64) for (int row = gw; row < 2048; row += NGW) { const float* xr = a->in[I_MEM] + (size_t)row * 1024; f32x4 v[4]; float sq = 0.f;
#pragma unroll
        for (int j = 0; j < 4; ++j) { v[j] = *(const f32x4*)(xr + 256 * j + 4 * lane); sq += pg8::dot4(v[j]); }
        const float r = rsqrtf(wave_sum(sq) * (1.0f / 1024.0f) + EPS); bf16* o = (bf16*)(ws + WS_MB) + (size_t)row * 1024;
#pragma unroll
        for (int j = 0; j < 4; ++j) *(u32x2*)(o + 256 * j + 4 * lane) = pg8::pk4(v[j] * r); }
}

__device__ __forceinline__ float ssq_rstd16(const float* ssq, int row) {
    const f32x4 a = *(const f32x4*)(ssq + (size_t)row * 16), b = *(const f32x4*)(ssq + (size_t)row * 16 + 4), c = *(const f32x4*)(ssq + (size_t)row * 16 + 8), d = *(const f32x4*)(ssq + (size_t)row * 16 + 12);
    const float s = ((a[0] + a[1]) + (a[2] + a[3])) + ((b[0] + b[1]) + (b[2] + b[3])) + ((c[0] + c[1]) + (c[2] + c[3])) + ((d[0] + d[1]) + (d[2] + d[3]));
    return rsqrtf(s * (1.0f / 1024.0f) + EPS);
}
__device__ __forceinline__ void cum_local_prompt(KAP a, int bh, LAS float* red, int wave, int lane) {
    unsigned char* ws = a->ws; const float* lfr = (const float*)(ws + WS_LFR); const int b = bh >> 4, h = bh & 15; float* cb = (float*)(ws + WS_CB) + (size_t)bh * 4096;
    float v[8];
#pragma unroll
    for (int k = 0; k < 8; ++k) v[k] = lfr[((size_t)b * 4096 + 512 * wave + 64 * k + lane) * 16 + h];
    float carry = 0.f;
#pragma unroll
    for (int k = 0; k < 8; ++k) {
#pragma unroll
        for (int o = 1; o < 64; o <<= 1) { const float y = __shfl_up(v[k], o); if (lane >= o) v[k] += y; }
        v[k] += carry; carry = __shfl(v[k], 63); }
    if (lane == 0) red[wave] = carry;
    __syncthreads();
    float off = 0.f;
#pragma unroll
    for (int w = 0; w < 7; ++w) off += (w < wave) ? red[w] : 0.f;
#pragma unroll
    for (int k = 0; k < 8; ++k) cb[512 * wave + 64 * k + lane] = -(v[k] + off) * LOG2E;
    VM_WAIT(); __syncthreads();
}
__device__ __forceinline__ void cum_local_sample(KAP a, int L, int pair, LAS float* red, int wave, int lane) {
    unsigned char* ws = a->ws; const float* lfr = (const float*)(ws + WS_LFR); const int bs = pair >> 4, h = pair & 15;
    const float* lfc = a->in[I_CFL] + (size_t)L * 32 * 2048 * 16; float* cb = (float*)(ws + WS_CBS) + (size_t)pair * 2080;
    float x[4], v[4];
#pragma unroll
    for (int k = 0; k < 4; ++k) x[k] = lfc[((size_t)bs * 2048 + 256 * wave + 64 * k + lane) * 16 + h];
    float carry = 0.f;
#pragma unroll
    for (int k = 3; k >= 0; --k) { float t = x[k];
#pragma unroll
        for (int o = 1; o < 64; o <<= 1) { const float y = __shfl_down(t, o); if (lane + o < 64) t += y; }
        v[k] = carry + t - x[k]; carry += __shfl(t, 0); }
    if (lane == 0) red[wave] = carry;
    __syncthreads();
    float off = 0.f;
#pragma unroll
    for (int w = 1; w < 8; ++w) off += (w > wave) ? red[w] : 0.f;
#pragma unroll
    for (int k = 0; k < 4; ++k) cb[256 * wave + 64 * k + lane] = (v[k] + off) * LOG2E;
    if (wave == 0) { float t = (lane < 16) ? lfr[((size_t)MP + bs * 16 + lane) * 16 + h] : 0.f;
#pragma unroll
        for (int o = 1; o < 16; o <<= 1) { const float y = __shfl_up(t, o); if (lane >= o) t += y; }
        if (lane < 32) cb[2048 + lane] = (lane < 16) ? -t * LOG2E : 0.f; }
    VM_WAIT(); __syncthreads();
}
__device__ __forceinline__ void ckv_fixup(KAP a, int L, int gw, int NGW, int lane) {
    unsigned char* ws = a->ws; const f32x4 g = *(const f32x4*)(a->in[I_GMKV] + (size_t)L * 256 + 4 * lane);
    for (int row0 = gw; row0 < MT; row0 += 4 * NGW) { f32x4 s4[4], v[4];
#pragma unroll
        for (int i = 0; i < 4; ++i) { const int row = (row0 + i * NGW < MT) ? row0 + i * NGW : row0; s4[i] = *(const f32x4*)((const float*)(ws + WS_SSQKV) + (size_t)row * 4);
            v[i] = *(const f32x4*)((const float*)(ws + WS_CKVU) + (size_t)row * 256 + 4 * lane); }
#pragma unroll
        for (int i = 0; i < 4; ++i) { const int row = row0 + i * NGW; if (row < MT) { const float r = rsqrtf(((s4[i][0] + s4[i][1]) + (s4[i][2] + s4[i][3])) * (1.0f / 256.0f) + EPS); const f32x4 o = v[i] * r * g;
            if (row < MP) *(f32x4*)(a->out + O_MCP + ((size_t)L * MP + row) * 256 + 4 * lane) = o;
            else *(f32x4*)(a->out + O_MCS + ((size_t)L * MS + (row - MP)) * 256 + 4 * lane) = o; } } }
}
__device__ __forceinline__ void final_phase(KAP a, int gw, int NGW, int lane) {
    f32x4 g[4];
#pragma unroll
    for (int j = 0; j < 4; ++j) g[j] = *(const f32x4*)(a->in[I_GFINAL] + 256 * j + 4 * lane);
    for (int row0 = gw; row0 < MT; row0 += 4 * NGW) { float r[4]; u32x2 w[4][4];
#pragma unroll
        for (int i = 0; i < 4; ++i) { const int row = (row0 + i * NGW < MT) ? row0 + i * NGW : row0; r[i] = ssq_rstd16((const float*)(a->ws + WS_SSQ), row); const bf16* x = (const bf16*)(a->ws + WS_XB) + (size_t)row * 1024;
#pragma unroll
            for (int j = 0; j < 4; ++j) w[i][j] = *(const u32x2*)(x + 256 * j + 4 * lane); }
#pragma unroll
        for (int i = 0; i < 4; ++i) { const int row = row0 + i * NGW; if (row < MT) { float* y = a->out + (size_t)row * 1024;
#pragma unroll
            for (int j = 0; j < 4; ++j) { const f32x4 xv = (f32x4){__builtin_bit_cast(float, w[i][j].x << 16), __builtin_bit_cast(float, w[i][j].x & 0xffff0000u), __builtin_bit_cast(float, w[i][j].y << 16), __builtin_bit_cast(float, w[i][j].y & 0xffff0000u)};
                *(f32x4*)(y + 256 * j + 4 * lane) = xv * r[i] * g[j]; } } } }
}

__device__ __forceinline__ void foxs_item(KAP a, int L, int it, LAS unsigned char* lds, int wid, int lane) {
    unsigned char* ws = a->ws; const int pair = it * 2 + (wid >> 2), b = pair >> 4, h = pair & 15, sp = wid & 3, g = lane >> 4, li = lane & 15;
    const float* ck = a->in[I_CFK] + (size_t)L * 32 * 2048 * 1024 + ((size_t)b * 2048 * 16 + h) * 64;
    const float* cv = a->in[I_CFV] + (size_t)L * 32 * 2048 * 1024 + ((size_t)b * 2048 * 16 + h) * 64;
    const float* cbs = (const float*)(ws + WS_CBS) + (size_t)pair * 2080;
    const bf16* QF = (const bf16*)(ws + WS_QF); const bf16* KF = (const bf16*)(ws + WS_KF); const bf16* VF = (const bf16*)(ws + WS_VF);
    const size_t srow = (size_t)MP + b * 16;
    bf16x8 qf[2];
#pragma unroll
    for (int d0 = 0; d0 < 2; ++d0) qf[d0] = *(const bf16x8*)(QF + (srow + li) * 1024 + h * 64 + 32 * d0 + 8 * g);
    float m = -1e30f, l = 0.f; f32x4 o[4];
#pragma unroll
    for (int db = 0; db < 4; ++db) o[db] = (f32x4){0.f, 0.f, 0.f, 0.f};
    const int kv0 = 512 * sp;
    auto kl = [&](int s, int blk, int d0) -> bf16x8 { const float* p = ck + (size_t)(kv0 + 32 * s + 16 * blk + li) * 1024 + 32 * d0 + 8 * g; return a16::cvt8(*(const f32x4*)p, *(const f32x4*)(p + 4)); };
    auto vl = [&](int s, int db) -> bf16x8 { const float* p = cv + (size_t)(kv0 + 32 * s + 4 * g) * 1024 + 16 * db + li;
        const f32x4 x = (f32x4){p[0], p[1024], p[2048], p[3072]}, y = (f32x4){p[16 * 1024], p[17 * 1024], p[18 * 1024], p[19 * 1024]}; return a16::cvt8(x, y); };
    auto sf = [&](int s, f32x4& sA, f32x4& sB) { const float* p = cbs + kv0 + 32 * s + 4 * g; sA += *(const f32x4*)p; sB += *(const f32x4*)(p + 16); };
    {
        auto kraw = [&](int s, f32x4 (&kr)[8]) {
#pragma unroll
            for (int blk = 0; blk < 2; ++blk)
#pragma unroll
                for (int d0 = 0; d0 < 2; ++d0) { const float* p = ck + (size_t)(kv0 + 32 * s + 16 * blk + li) * 1024 + 32 * d0 + 8 * g; kr[(blk * 2 + d0) * 2] = *(const f32x4*)p; kr[(blk * 2 + d0) * 2 + 1] = *(const f32x4*)(p + 4); } };
        auto vraw = [&](int s, f32x4 (&vr)[8]) {
#pragma unroll
            for (int db = 0; db < 4; ++db) { const float* p = cv + (size_t)(kv0 + 32 * s + 4 * g) * 1024 + 16 * db + li;
                vr[2 * db] = (f32x4){p[0], p[1024], p[2048], p[3072]}; vr[2 * db + 1] = (f32x4){p[16 * 1024], p[17 * 1024], p[18 * 1024], p[19 * 1024]}; } };
        auto step = [&](int s, const f32x4 (&kc)[8], const f32x4 (&vc)[8]) {
            f32x4 sA = {0.f, 0.f, 0.f, 0.f}, sB = {0.f, 0.f, 0.f, 0.f};
#pragma unroll
            for (int d0 = 0; d0 < 2; ++d0) { sA = a16::mfma16(a16::cvt8(kc[d0 * 2], kc[d0 * 2 + 1]), qf[d0], sA); sB = a16::mfma16(a16::cvt8(kc[(2 + d0) * 2], kc[(2 + d0) * 2 + 1]), qf[d0], sB); }
            sf(s, sA, sB);
            float mx = __builtin_fmaxf(__builtin_fmaxf(__builtin_fmaxf(sA[0], sA[1]), __builtin_fmaxf(sA[2], sA[3])), __builtin_fmaxf(__builtin_fmaxf(sB[0], sB[1]), __builtin_fmaxf(sB[2], sB[3])));
            mx = __builtin_fmaxf(mx, __shfl_xor(mx, 16)); mx = __builtin_fmaxf(mx, __shfl_xor(mx, 32));
            const float mn = __builtin_fmaxf(m, mx), alpha = ex2(m - mn); m = mn;
            f32x4 pA, pB;
#pragma unroll
            for (int r = 0; r < 4; ++r) { pA[r] = ex2(sA[r] - mn); pB[r] = ex2(sB[r] - mn); }
            float ps = ((pA[0] + pA[1]) + (pA[2] + pA[3])) + ((pB[0] + pB[1]) + (pB[2] + pB[3]));
            ps += __shfl_xor(ps, 16); ps += __shfl_xor(ps, 32);
            l = l * alpha + ps;
            const float a0 = __shfl(alpha, 4 * g), a1 = __shfl(alpha, 4 * g + 1), a2 = __shfl(alpha, 4 * g + 2), a3 = __shfl(alpha, 4 * g + 3);
#pragma unroll
            for (int db = 0; db < 4; ++db) { o[db][0] *= a0; o[db][1] *= a1; o[db][2] *= a2; o[db][3] *= a3; }
            const u32x4 pw = (u32x4){pk2(pA[0], pA[1]), pk2(pA[2], pA[3]), pk2(pB[0], pB[1]), pk2(pB[2], pB[3])};
            const bf16x8 pf = __builtin_bit_cast(bf16x8, pw);
#pragma unroll
            for (int db = 0; db < 4; ++db) o[db] = a16::mfma16(pf, a16::cvt8(vc[2 * db], vc[2 * db + 1]), o[db]); };
        f32x4 ka[8], va[8], kb[8], vb[8]; kraw(0, ka); vraw(0, va);
#pragma unroll 1
        for (int s = 0; s < 16; s += 2) {
            kraw(s + 1, kb); vraw(s + 1, vb);
            step(s, ka, va);
            const int sn = (s < 14) ? s + 2 : 15; kraw(sn, ka); vraw(sn, va);
            step(s + 1, kb, vb);
        }
    }
    if (sp == 3) {
        auto kl2 = [&](int, int blk, int d0) -> bf16x8 { bf16x8 z = {0, 0, 0, 0, 0, 0, 0, 0}; if (blk == 0) z = *(const bf16x8*)(KF + (srow + li) * 1024 + h * 64 + 32 * d0 + 8 * g); return z; };
        auto vl2 = [&](int, int db) -> bf16x8 { const bf16* p = VF + (srow + 4 * g) * 1024 + h * 64 + 16 * db + li;
            const u32x4 w = (u32x4){(unsigned)p[0] | ((unsigned)p[1024] << 16), (unsigned)p[2048] | ((unsigned)p[3072] << 16), 0u, 0u}; return __builtin_bit_cast(bf16x8, w); };
        auto sf2 = [&](int, f32x4& sA, f32x4& sB) { const f32x4 bb = *(const f32x4*)(cbs + 2048 + 4 * g);
#pragma unroll
            for (int r = 0; r < 4; ++r) { sA[r] = (4 * g + r > li) ? -INFINITY : sA[r] + bb[r]; sB[r] = -INFINITY; } };
        a16::steps<2, 4>(0, 1, qf, kl2, vl2, sf2, m, l, o, lane);
    }
    LAS float* PO = (LAS float*)(lds + RING_OFF) + wid * 1024; LAS float* PM = (LAS float*)(lds + RING_OFF + 32768) + wid * 32;
#pragma unroll
    for (int db = 0; db < 4; ++db)
#pragma unroll
        for (int r = 0; r < 4; ++r) PO[(4 * g + r) * 64 + 16 * db + li] = o[db][r];
    if (g == 0) { PM[li] = m; PM[16 + li] = l; }
    __syncthreads();
    {
        const int w0 = (wid >> 2) * 4, db = wid & 3; const bf16* GF = (const bf16*)(ws + WS_GF); bf16* OF = (bf16*)(ws + WS_OM);
#pragma unroll
        for (int r = 0; r < 4; ++r) { const int q = 4 * g + r; float mm = -1e30f;
#pragma unroll
            for (int s2 = 0; s2 < 4; ++s2) mm = __builtin_fmaxf(mm, ((LAS float*)(lds + RING_OFF + 32768) + (w0 + s2) * 32)[q]);
            float num = 0.f, den = 0.f;
#pragma unroll
            for (int s2 = 0; s2 < 4; ++s2) { LAS float* pm = (LAS float*)(lds + RING_OFF + 32768) + (w0 + s2) * 32; const float wgt = ex2(pm[q] - mm);
                num += wgt * ((LAS float*)(lds + RING_OFF) + (w0 + s2) * 1024)[q * 64 + 16 * db + li]; den += wgt * pm[16 + q]; }
            const size_t idx = (srow + q) * 1024 + h * 64 + 16 * db + li;
            OF[idx] = (bf16)(pk2(num / den * bf2f(GF[idx]), 0.f) & 0xffffu); }
    }
    __syncthreads();
}
__device__ __forceinline__ void mlas_qprime(KAP a, int L, int it, LAS unsigned char* lds, int wid, int lane) {
    unsigned char* ws = a->ws; const int b = (it < 256) ? (it >> 3) : (it - 256), c = (it < 256) ? (it & 7) : 8, g = lane >> 4, li = lane & 15;
    const bf16* QM = (const bf16*)(ws + WS_QM); const bf16* WKN = (const bf16*)(ws + WS_WKN) + (size_t)L * 256 * 2048;
    bf16* QA = (bf16*)(ws + WS_QA) + (size_t)it * 256 * 288;
    LAS bf16* scr = (LAS bf16*)(lds + RING_OFF + wid * 9216);
    for (int hh = 0; hh < 2; ++hh) { const int h = 2 * wid + hh; const bf16* qrow = QM + ((size_t)MP + b * 16 + li) * 1536 + h * 96; bf16* qa = QA + (size_t)(wid * 32 + hh * 16) * 288;
        const bf16x8 qn0 = *(const bf16x8*)(qrow + 8 * g), qn1 = *(const bf16x8*)(qrow + 32 + 8 * g);
#pragma unroll
        for (int cb = 0; cb < 16; ++cb) { const bf16* wp = WKN + (size_t)(16 * cb + li) * 2048 + h * 128 + 8 * g;
            f32x4 acc = a16::mfma16(qn0, *(const bf16x8*)wp, (f32x4){0.f, 0.f, 0.f, 0.f}); acc = a16::mfma16(qn1, *(const bf16x8*)(wp + 32), acc);
#pragma unroll
            for (int r = 0; r < 4; ++r) scr[(4 * g + r) * 288 + 16 * cb + li] = (bf16)(pk2(acc[r], 0.f) & 0xffffu); }
        *(LAS bf16x8*)(scr + li * 288 + 256 + 8 * g) = *(const bf16x8*)(qrow + 64 + 8 * g);
        LDS_WAIT();
#pragma unroll
        for (int j = 0; j < 9; ++j) *(u32x4*)(qa + (size_t)(lane + 64 * j) * 8) = *(const LAS u32x4*)(scr + (lane + 64 * j) * 8);
        LDS_WAIT(); }
    VM_WAIT(); __syncthreads();
}
__device__ __forceinline__ void mlas_attn(KAP a, int L, int it, int qa_it, LAS unsigned char* lds, unsigned lds0) {
    unsigned char* ws = a->ws; const int b = (it < 256) ? (it >> 3) : (it - 256), c = (it < 256) ? (it & 7) : 8; const bf16* QA = (const bf16*)(ws + WS_QA) + (size_t)qa_it * 256 * 288;
    float* P = (float*)(ws + WS_PART) + ((size_t)(b * 9 + c) * 256) * ms::PROW;
    if (c < 8) { const size_t jb = (size_t)L * 32 + b;
        ms::unit<8>(a->in[I_CCKV] + (jb * 2048 + 256 * c) * 256, a->in[I_CKR] + (jb * 2048 + 256 * c) * 32, 255, QA, P, (LAS char*)(lds + RING_OFF), lds0 + RING_OFF);
    } else { const size_t ro = (size_t)L * MS + b * 16;
        ms::unit<1>(a->out + O_MCS + ro * 256, a->out + O_MRS + ro * 32, 15, QA, P, (LAS char*)(lds + RING_OFF), lds0 + RING_OFF); }
}
__device__ __forceinline__ void mlas_combine(KAP a, int L, LAS unsigned char* lds, int vcu, int G, int wid, int lane) {
    unsigned char* ws = a->ws; const int grp = wid >> 2, k = wid & 3; LAS bf16* scr = (LAS bf16*)(lds + RING_OFF + grp * 8192);
    const bf16* WV = (const bf16*)(ws + WS_WMKVR) + (size_t)L * 2048 * 256; bf16* OM = (bf16*)(ws + WS_OM); const int g = lane >> 4, li = lane & 15;
    for (int e0 = vcu * 2; e0 < 512; e0 += G * 2) { const int e = e0 + grp, b = e >> 4, h = e & 15; const int q = lane >> 2, cg = 64 * k + (lane & 3) * 16;
        const float* P0 = (const float*)(ws + WS_PART) + ((size_t)(b * 9) * 256 + (h >> 1) * 32 + (h & 1) * 16 + q) * ms::PROW; constexpr size_t CS = (size_t)256 * ms::PROW;
        float pm[9], pl[9], mm = -1e30f;
#pragma unroll
        for (int c = 0; c < 9; ++c) { pm[c] = P0[c * CS + 256]; pl[c] = P0[c * CS + 257]; }
        f32x4 pv[4][9];
#pragma unroll
        for (int j = 0; j < 4; ++j)
#pragma unroll
            for (int c = 0; c < 9; ++c) pv[j][c] = *(const f32x4*)(P0 + c * CS + cg + 4 * j);
#pragma unroll
        for (int c = 0; c < 9; ++c) mm = __builtin_fmaxf(mm, pm[c]);
        float wgt[9], den = 0.f;
#pragma unroll
        for (int c = 0; c < 9; ++c) { wgt[c] = ex2(pm[c] - mm); den += wgt[c] * pl[c]; }
        const float id = 1.0f / den;
#pragma unroll
        for (int j = 0; j < 4; ++j) { f32x4 acc = (f32x4){0.f, 0.f, 0.f, 0.f};
#pragma unroll
            for (int c = 0; c < 9; ++c) acc += pv[j][c] * wgt[c];
            *(LAS u32x2*)(scr + q * 256 + cg + 4 * j) = pg8::pk4(acc * id); }
        __syncthreads();
        bf16x8 af[8];
#pragma unroll
        for (int d0 = 0; d0 < 8; ++d0) af[d0] = *(const LAS bf16x8*)(scr + li * 256 + 32 * d0 + 8 * g);
        { const int db = k; f32x4 acc = (f32x4){0.f, 0.f, 0.f, 0.f}; const bf16* wp = WV + (size_t)(h * 128 + 64 + 16 * db + li) * 256 + 8 * g;
#pragma unroll
            for (int d0 = 0; d0 < 8; ++d0) acc = a16::mfma16(af[d0], *(const bf16x8*)(wp + 32 * d0), acc);
            bf16* O = OM + ((size_t)MP + b * 16 + 4 * g) * 1024 + h * 64 + 16 * db + li; const unsigned w0 = pk2(acc[0], acc[1]), w1 = pk2(acc[2], acc[3]);
            O[0] = (bf16)(w0 & 0xffffu); O[1024] = (bf16)(w0 >> 16); O[2048] = (bf16)(w1 & 0xffffu); O[3072] = (bf16)(w1 >> 16); }
        __syncthreads();
    }
}
typedef float f32x2v_t __attribute__((ext_vector_type(2)));
template <int K, class F> __device__ __forceinline__ void thin_tiles(const bf16* A, const bf16* Bt, LAS unsigned char* lds, int vcu, int G, int wave, int lane, F epi) {
    const int g = lane >> 4, li = lane & 15; constexpr int nks = K / 256;
    LAS float* part = (LAS float*)(lds + RING_OFF);
#pragma unroll 1
    for (int tt = vcu; tt < 256; tt += G) { const int rb = tt & 31, cgp = tt >> 5;
        const bf16* ap = A + (size_t)(MP + 16 * rb + li) * K + wave * (K / 8) + 8 * g; const bf16* bp = Bt + (size_t)(128 * cgp + li) * K + wave * (K / 8) + 8 * g;
        f32x4 acc[8];
#pragma unroll
        for (int nb = 0; nb < 8; ++nb) acc[nb] = (f32x4){0.f, 0.f, 0.f, 0.f};
#pragma unroll
        for (int s0 = 0; s0 < nks; s0 += 4) { bf16x8 a[4], b[4][8]; const bf16x8 z = {0, 0, 0, 0, 0, 0, 0, 0};
#pragma unroll
            for (int u = 0; u < 4; ++u) { const bool on = s0 + u < nks; a[u] = on ? *(const bf16x8*)(ap + 32 * (s0 + u)) : z;
#pragma unroll
                for (int nb = 0; nb < 8; ++nb) b[u][nb] = on ? *(const bf16x8*)(bp + (size_t)nb * 16 * K + 32 * (s0 + u)) : z; }
#pragma unroll
            for (int u = 0; u < 4; ++u) if (s0 + u < nks)
#pragma unroll
                for (int nb = 0; nb < 8; ++nb) acc[nb] = a16::mfma16(a[u], b[u][nb], acc[nb]); }
#pragma unroll
        for (int nb = 0; nb < 8; ++nb)
#pragma unroll
            for (int r = 0; r < 4; ++r) part[wave * 2048 + (4 * g + r) * 128 + 16 * nb + li] = acc[nb][r];
        __syncthreads();
        const int e = (2 * wave + (lane >> 5)) * 128 + 4 * (lane & 31); f32x4 sv = (f32x4){0.f, 0.f, 0.f, 0.f};
#pragma unroll
        for (int w = 0; w < 8; ++w) sv += *(const LAS f32x4*)(part + w * 2048 + e);
        epi(MP + 16 * rb + 2 * wave + (lane >> 5), 128 * cgp + 4 * (lane & 31), sv);
        __syncthreads(); }
}
template <int K> __device__ __forceinline__ void thin_resid(KAP a, const bf16* A, const bf16* Bt, int first, LAS unsigned char* lds, int vcu, int G, int wave, int lane) {
    unsigned char* ws = a->ws; const float* xs = a->in[I_XS] - (size_t)MP * 1024; bf16* XB = (bf16*)(ws + WS_XB); float* SSQ = (float*)(ws + WS_SSQ);
    thin_tiles<K>(A, Bt, lds, vcu, G, wave, lane, [&](int row, int col, f32x4 v) {
        const size_t o = (size_t)row * 1024 + col; f32x4 x;
        if (first) x = *(const f32x4*)(xs + o);
        else { const u32x2 w = *(const u32x2*)(XB + o); x = (f32x4){__builtin_bit_cast(float, w.x << 16), __builtin_bit_cast(float, w.x & 0xffff0000u), __builtin_bit_cast(float, w.y << 16), __builtin_bit_cast(float, w.y & 0xffff0000u)}; }
        x += v; *(u32x2*)(XB + o) = (u32x2){pk2(x[0], x[1]), pk2(x[2], x[3])};
        float sq = (x[0] * x[0] + x[1] * x[1]) + (x[2] * x[2] + x[3] * x[3]); sq += __shfl_xor(sq, 1); sq += __shfl_xor(sq, 2); sq += __shfl_xor(sq, 4); sq += __shfl_xor(sq, 8);
        if ((lane & 15) == 0) SSQ[(size_t)row * 16 + (col >> 6)] = sq; });
}
__device__ __forceinline__ void thin_xq(KAP a, const bf16* Bt, LAS unsigned char* lds, int vcu, int G, int wave, int lane) {
    unsigned char* ws = a->ws; const bf16* XB = (const bf16*)(ws + WS_XB); bf16* QX = (bf16*)(ws + WS_QX); const float* SSQ = (const float*)(ws + WS_SSQ);
    thin_tiles<1024>(XB, Bt, lds, vcu, G, wave, lane, [&](int row, int col, f32x4 v) {
        const float rs = ssq_rstd16(SSQ, row) * C2_X; *(u32x2*)(QX + (size_t)row * 1024 + col) = (u32x2){pk2(v[0] * rs, v[1] * rs), pk2(v[2] * rs, v[3] * rs)}; });
}
#ifndef DBG_DOUBLE
#define DBG_DOUBLE 0
#endif

constexpr int NPH = 41;
struct Ctx { int lane, wave, G, bx, vcu, gw, NGW; };
__device__ __forceinline__ Ctx mk_ctx() { Ctx c; const int tid = pg8::pg8_tid(); c.lane = tid & 63; c.wave = __builtin_amdgcn_readfirstlane(tid >> 6); int G_ = gridDim.x, bx_ = blockIdx.x; asm volatile("" : "+s"(G_), "+s"(bx_)); c.G = G_; c.bx = bx_;
    c.vcu = (c.G % 8 == 0) ? (c.bx % 8) * (c.G / 8) + c.bx / 8 : c.bx; c.gw = c.vcu * NWAVES + c.wave; c.NGW = c.G * NWAVES; return c; }
#define RSX(ws) pg8::RowScale{(const float*)((ws) + WS_SSQ), 16, 4, 1.0f / 1024.0f}
#define PHASE __device__ __noinline__ void
#define FATPH __device__ __forceinline__ void
__device__ __forceinline__ unsigned char* ws_ptr() { GAS unsigned char* w = (GAS unsigned char*)KA->ws; asm volatile("" : "+s"(w)); return (unsigned char*)w; }
#define WSB(off) ((const bf16*)(ws_ptr() + (off)))
__device__ __forceinline__ const float* in_ptr(int i) { GAS const float* w = (GAS const float*)KA->in[i]; asm volatile("" : "+s"(w)); return (const float*)w; }
__device__ __forceinline__ float* out_ptr() { GAS float* w = (GAS float*)KA->out; asm volatile("" : "+s"(w)); return (float*)w; }

FATPH ph_prologue(KAP a, LAS unsigned char* lds, int pmask) { const Ctx c = mk_ctx(); p0_prologue(a, lds, c.gw, c.NGW, c.wave, c.lane, pmask); __syncthreads(); }
FATPH ph_memkv(LAS unsigned char* lds) { const Ctx c = mk_ctx(); unsigned char* ws = ws_ptr(); float* out = out_ptr();
    pg8::Gemm g{WSB(WS_MB), WSB(WS_WXKV), 2048, 8192, 1024}; pg8::StaticOrder S; S.init(2048, 8192, c.G, c.bx);
    pg8::EpiMemKV E{out + O_MKP, out + O_MVP, (bf16*)(ws + WS_MKB), (bf16*)(ws + WS_MVB)};
    pg8::gemm_phase<pg8::EpiMemKV, pg8::StaticOrder, true, true>(lds + RING_OFF, g, S, E); }
FATPH ph_fox_in(LAS unsigned char* lds, int L) { const Ctx c = mk_ctx(); unsigned char* ws = ws_ptr(); float* out = out_ptr();
    pg8::Gemm g{WSB(WS_XB), WSB(WS_WFI) + (size_t)L * 4352 * 1024, MT, 4352, 1024}; pg8::StaticOrder S; S.init(MT, 4352, c.G, c.bx);
    pg8::EpiFoxIn E{RSX(ws), ws, out, in_ptr(I_BFF) + L * 16, L};
    pg8::gemm_phase<pg8::EpiFoxIn, pg8::StaticOrder, true, true>(lds + RING_OFF, g, S, E); }
FATPH ph_fox_sample(KAP a, LAS unsigned char* lds, int L) { const Ctx c = mk_ctx(); LAS float* red = (LAS float*)(lds + RING_OFF + 65536);
    for (int it = c.vcu; it < 256; it += c.G) { cum_local_sample(a, L, 2 * it, red, c.wave, c.lane); cum_local_sample(a, L, 2 * it + 1, red, c.wave, c.lane); foxs_item(a, L, it, lds, c.wave, c.lane); } }
__device__ __forceinline__ void unit2_of(int e, int& bh, int& qb) { bh = e >> 3; const int k = e & 7, s = (k >> 2) & 1, ii = k & 3, j = 2 * s + (ii >> 1); qb = (ii & 1) ? 7 - j : j; }
__device__ __forceinline__ void unit_of(int e, int& bh, int& qb) { bh = e >> 4; const int k = e & 15, s = (k >> 3) & 1, ii = k & 7, j = 2 * (ii >> 1) + s; qb = (ii & 1) ? 15 - j : j; }
FATPH ph_fox_attn(LAS unsigned char* lds, unsigned lds0) { const Ctx c = mk_ctx(); unsigned char* ws = ws_ptr();
    for (int e0 = c.vcu * 4; e0 < 1024; e0 += c.G * 4) {
        __syncthreads(); cum_local_prompt(KA, e0 >> 3, (LAS float*)(lds + RING_OFF + 65536), c.wave, c.lane);
        for (int i = 0; i < 4; ++i) { int bh, qb; unit2_of(e0 + i, bh, qb); const int b = bh >> 4, h = bh & 15;
            fa::Args A{WSB(WS_QF), 1024, h * 64, WSB(WS_KF), 1024, h * 64, nullptr, WSB(WS_VF), 1024, h * 64, (bf16*)(ws + WS_OM), h * 64,
                       WSB(WS_GF), (const float*)(ws + WS_CB) + (size_t)bh * 4096};
            fa::unit2<0>(A, (long)b * 4096, qb, (LAS char*)(lds + RING_OFF), lds0 + RING_OFF); } } }
FATPH ph_fox_mix(KAP a, LAS unsigned char* lds, unsigned lds0, int L) { const Ctx c = mk_ctx(); unsigned char* ws = ws_ptr(); LAS float* red = (LAS float*)(lds + RING_OFF + 65536);
    const int pos = (c.vcu >> 1) % 5;
    for (int e0 = c.vcu * 4, it = c.vcu; e0 < 1024 || it < 256; e0 += c.G * 4, it += c.G) {
        if (e0 < 1024) { __syncthreads(); cum_local_prompt(a, e0 >> 3, red, c.wave, c.lane); }
#pragma unroll 1
        for (int i = 0; i < 5; ++i) {
            if (i == pos && it < 256) { const Ctx c2 = mk_ctx(); int itv = it; asm volatile("" : "+s"(itv));
                __syncthreads(); cum_local_sample(a, L, 2 * itv, red, c2.wave, c2.lane); cum_local_sample(a, L, 2 * itv + 1, red, c2.wave, c2.lane); foxs_item(a, L, itv, lds, c2.wave, c2.lane); __syncthreads(); }
            if (i < 4 && e0 < 1024) { int ev = e0 + i; asm volatile("" : "+s"(ev)); int bh, qb; unit2_of(ev, bh, qb); const int b = bh >> 4, h = bh & 15;
                fa::Args A{WSB(WS_QF), 1024, h * 64, WSB(WS_KF), 1024, h * 64, nullptr, WSB(WS_VF), 1024, h * 64, (bf16*)(ws + WS_OM), h * 64,
                           WSB(WS_GF), (const float*)(ws + WS_CB) + (size_t)bh * 4096};
                fa::unit2<0>(A, (long)b * 4096, qb, (LAS char*)(lds + RING_OFF), lds0 + RING_OFF); } } } }
template <bool ABLK = false>
FATPH ph_resid(LAS unsigned char* lds, const bf16* A, const bf16* Bt, int K, int first, int dummy = 0) { const Ctx c = mk_ctx(); unsigned char* ws = ws_ptr();
    pg8::Gemm g{A, Bt, MP, 1024, K}; pg8::StaticOrder S; S.init(MP, 1024, c.G, c.bx);
    pg8::EpiResid E{KA->in[I_XP], KA->in[I_XS], first, dummy ? (bf16*)(ws + WS_R1 + (size_t)MT * 4096) : (bf16*)(ws + WS_XB), dummy ? (float*)(ws + WS_R1 + (size_t)MT * 6144) : (float*)(ws + WS_SSQ)};
    pg8::gemm_phase<pg8::EpiResid, pg8::StaticOrder, true, true, ABLK>(lds + RING_OFF, g, S, E); }
FATPH ph_scale_gemm(LAS unsigned char* lds, const bf16* A, const bf16* Bt, int M, int N, int K, const float* ssq, int stride, int ngrp, float inv_n, bf16* O, float scale) { const Ctx c = mk_ctx();
    pg8::Gemm g{A, Bt, M, N, K}; pg8::StaticOrder S; S.init(M, N, c.G, c.bx);
    pg8::EpiScaleBf16 E{pg8::RowScale{ssq, stride, ngrp, inv_n}, O, N, scale};
    pg8::gemm_phase<pg8::EpiScaleBf16, pg8::StaticOrder, true, true>(lds + RING_OFF, g, S, E); }
FATPH ph_cross(LAS unsigned char* lds, unsigned lds0, int layer) { const Ctx c = mk_ctx(); unsigned char* ws = ws_ptr();
    const bf16* QX = WSB(WS_QX); bf16* OX = (bf16*)(ws + WS_OM);
    const bool bal = (c.G == 256); const int nu = bal ? (c.vcu < 128 ? 1 : 3) : 2, ub = bal ? (c.vcu < 128 ? c.vcu : 128 + 3 * (c.vcu - 128)) : c.vcu * 2;
    for (int u0 = ub; u0 < 512; u0 += (bal ? 512 : c.G * 2))
        for (int i = 0; i < nu; ++i) { const int u = u0 + i, bh = u >> 4, qb = u & 15, b = bh >> 2, h = bh & 3; const size_t ko = ((size_t)layer * 2048 + b * 256) * 1024 + h * 256;
            xa::unit<false>(WSB(WS_MKB) + ko, WSB(WS_MVB) + ko, 1024, QX, OX, (size_t)b * 4096 + qb * 256, h * 256, 32, false, (LAS char*)(lds + RING_OFF), lds0 + RING_OFF); }
    for (int e = c.vcu; e < 128; e += c.G) { const int bs = e >> 2, h = e & 3; const size_t ko = ((size_t)(layer * 32 + bs) * 256) * 1024 + h * 256;
        xa::unit<true>(in_ptr(I_CMK) + ko, in_ptr(I_CMV) + ko, 1024, QX, OX, (size_t)MP + bs * 16, h * 256, 16, true, (LAS char*)(lds + RING_OFF), lds0 + RING_OFF); } }
FATPH ph_gu(LAS unsigned char* lds, int layer) { const Ctx c = mk_ctx(); unsigned char* ws = ws_ptr();
    pg8::Gemm g{WSB(WS_XB), WSB(WS_WGU) + (size_t)layer * 5632 * 1024, MT, 5632, 1024}; pg8::StaticOrder S; S.init(MT, 5632, c.G, c.bx);
    pg8::EpiSwiglu E{RSX(ws), (bf16*)(ws + WS_HB)}; pg8::gemm_phase<pg8::EpiSwiglu, pg8::StaticOrder, true, true>(lds + RING_OFF, g, S, E); }
FATPH ph_gu_null(LAS unsigned char* lds, int layer) { const Ctx c = mk_ctx();
    pg8::Gemm g{WSB(WS_XB), WSB(WS_WGU) + (size_t)layer * 5632 * 1024, MT, 5632, 1024}; pg8::StaticOrder S; S.init(MT, 5632, c.G, c.bx);
    pg8::EpiNull E{}; pg8::gemm_phase<pg8::EpiNull, pg8::StaticOrder, true, true>(lds + RING_OFF, g, S, E); }
FATPH ph_mla_a(LAS unsigned char* lds, int L) { const Ctx c = mk_ctx(); unsigned char* ws = ws_ptr(); float* out = out_ptr();
    pg8::Gemm g{WSB(WS_XB), WSB(WS_WMA) + (size_t)L * 768 * 1024, MT, 768, 1024}; pg8::StaticOrder S; S.init(MT, 768, c.G, c.bx);
    pg8::EpiMlaA E{RSX(ws), (float*)(ws + WS_CKVU), (bf16*)(ws + WS_CKVUB), (float*)(ws + WS_SSQKV), (bf16*)(ws + WS_CQ), (float*)(ws + WS_SSQQ), (bf16*)(ws + WS_KRB),
                   out + O_MRP + (size_t)L * MP * 32, out + O_MRS + (size_t)L * MS * 32, (const float*)(ws + WS_ROPC), (const float*)(ws + WS_ROPS)};
    pg8::gemm_phase<pg8::EpiMlaA, pg8::StaticOrder, true, true>(lds + RING_OFF, g, S, E); }
PHASE ph_fixup(KAP a, int L) { const Ctx c = mk_ctx(); ckv_fixup(a, L, c.gw, c.NGW, c.lane); }
FATPH ph_mla_q(LAS unsigned char* lds, int L, int kq) { const Ctx c = mk_ctx(); unsigned char* ws = ws_ptr();
    pg8::Gemm g{WSB(WS_CQ), WSB(WS_WMQ) + (size_t)L * 1536 * 384, MT, 1536, kq}; pg8::StaticOrder S; S.init(MT, 1536, c.G, c.bx);
    pg8::EpiMlaQ E{pg8::RowScale{(const float*)(ws + WS_SSQQ), 8, 2, 1.0f / 384.0f}, (bf16*)(ws + WS_QM), (const float*)(ws + WS_ROPC), (const float*)(ws + WS_ROPS)};
    pg8::gemm_phase<pg8::EpiMlaQ, pg8::StaticOrder, true, false>(lds + RING_OFF, g, S, E); }
PHASE ph_mla_qprime(KAP a, LAS unsigned char* lds, int L, int it) { const Ctx c = mk_ctx(); mlas_qprime(a, L, it, lds, c.wave, c.lane); }
FATPH ph_mla_sample(LAS unsigned char* lds, unsigned lds0, int L) { const Ctx c = mk_ctx(); for (int it = c.vcu; it < 256; it += c.G) { ph_mla_qprime(KA, lds, L, it); mlas_attn(KA, L, it, it, lds, lds0);
        if ((it & 7) == ((it >> 3) & 7)) mlas_attn(KA, L, 256 + (it >> 3), it, lds, lds0); } __syncthreads(); }
FATPH ph_mla_attn(LAS unsigned char* lds, unsigned lds0) { const Ctx c = mk_ctx(); unsigned char* ws = ws_ptr();
    for (int e0 = c.vcu * 4; e0 < 1024; e0 += c.G * 4)
        for (int i = 0; i < 4; ++i) { int bh, qb; unit2_of(e0 + i, bh, qb); const int b = bh >> 4, h = bh & 15;
            fa::Args A{WSB(WS_QM), 1536, h * 96, WSB(WS_KVM), 2048, h * 128, WSB(WS_KRB), WSB(WS_KVM), 2048, h * 128 + 64, (bf16*)(ws + WS_OM), h * 64,
                       nullptr, nullptr};
            fa::unit2<1>(A, (long)b * 4096, qb, (LAS char*)(lds + RING_OFF), lds0 + RING_OFF); } }
FATPH ph_mla_comb(LAS unsigned char* lds, int L) { const Ctx c = mk_ctx(); mlas_combine(KA, L, lds, c.vcu, c.G, c.wave, c.lane); }
template <int K> FATPH ph_thin_resid(KAP a, LAS unsigned char* lds, const bf16* A, const bf16* Bt, int first) { const Ctx c = mk_ctx(); thin_resid<K>(a, A, Bt, first, lds, c.vcu, c.G, c.wave, c.lane); }
FATPH ph_thin_xq(KAP a, LAS unsigned char* lds, const bf16* Bt) { const Ctx c = mk_ctx(); thin_xq(a, Bt, lds, c.vcu, c.G, c.wave, c.lane); }
PHASE ph_final(KAP a) { const Ctx c = mk_ctx(); final_phase(a, c.gw, c.NGW, c.lane); }
PHASE ph_grid_bar(GAS unsigned* barw, unsigned x, volatile LAS unsigned* st) { XcdBarrier b; b.bar = (unsigned*)barw; b.x = x; b.st = st; xcd_barrier(b); }

__global__ void __launch_bounds__(NWAVES * 64, 2) fwd_kernel(KArgs args) {
    extern __shared__ __attribute__((aligned(16))) unsigned char lds_raw[];
    LAS unsigned char* lds = (LAS unsigned char*)lds_raw;
    volatile LAS unsigned* MISC = (volatile LAS unsigned*)(lds + MISC_OFF);
    const int tid = threadIdx.x;
    const unsigned lds0 = (unsigned)(uintptr_t)lds_raw;
    for (int u = tid; u < (LDS_BYTES - LDSCTL_OFF) / 4; u += NWAVES * 64) ((LAS unsigned*)(lds + LDSCTL_OFF))[u] = 0u;
    __syncthreads();
    const XcdBarrier bar = xcd_barrier_post((unsigned*)(args.ws + WS_CTL) + CW_BAR, MISC + 8);
    const int lo = args.ph_lo, hi = args.ph_hi;
#ifndef DBG_DOUBLE
#define DBG_DOUBLE 0
#endif
#ifndef DBG_P0_AGAIN
#define DBG_P0_AGAIN 0
#endif
#define REP(bit) for (int rep_ = 0; rep_ < ((DBG_DOUBLE & (bit)) ? 2 : 1); ++rep_)
#define IN(k) (lo <= (k) && (k) < hi)
#define SEAM(k) do { if (IN(k) && IN((k) + 1)) { REP(256) ph_grid_bar((GAS unsigned*)bar.bar, bar.x, bar.st); } } while (0)
    if (IN(0)) { ph_prologue(KA, lds, 0x7f); if (DBG_P0_AGAIN) ph_prologue(KA, lds, DBG_P0_AGAIN); }
    SEAM(0);
    if (IN(1)) REP(65536) ph_memkv(lds);
    SEAM(1);
    for (int L = 0; L < 2; ++L) {
        const int pb = 2 + 19 * L;
        if (IN(pb)) { REP(8) ph_fox_in(lds, L); }
        SEAM(pb);
        if (IN(pb + 2)) { if (DBG_DOUBLE & 96) { REP(64) ph_fox_sample(KA, lds, L); REP(32) ph_fox_attn(lds, lds0); } else ph_fox_mix(KA, lds, lds0, L); }
        SEAM(pb + 2);
        if (IN(pb + 3)) { ph_thin_resid<1024>(KA, lds, WSB(WS_OM), WSB(WS_WFO) + (size_t)L * 1024 * 1024, L == 0); if (DBG_DOUBLE & 512) ph_resid(lds, WSB(WS_OM), WSB(WS_WFO) + (size_t)L * 1024 * 1024, 1024, L == 0, 1); ph_resid(lds, WSB(WS_OM), WSB(WS_WFO) + (size_t)L * 1024 * 1024, 1024, L == 0); }
        SEAM(pb + 3);
        for (int sub = 0; sub < 2; ++sub) {
            const int layer = 2 * L + sub, cb = pb + 4 + 10 * sub;
            if (sub == 1) {
                if (IN(pb + 9)) REP(32768) ph_mla_a(lds, L);
                SEAM(pb + 9);
                if (IN(pb + 10)) { ph_fixup(KA, L); REP(32768) ph_mla_q(lds, L, 384);
                    REP(32768)
                    ph_scale_gemm(lds, WSB(WS_CKVUB), WSB(WS_WMKV) + (size_t)L * 2048 * 256, MP, 2048, 256, (const float*)(ws_ptr() + WS_SSQKV), 4, 1, 1.0f / 256.0f, (bf16*)(ws_ptr() + WS_KVM), 1.0f); }
                SEAM(pb + 10);
                if (IN(pb + 11)) { REP(128) ph_mla_sample(lds, lds0, L); REP(32) ph_mla_attn(lds, lds0); }
                SEAM(pb + 11);
                if (IN(pb + 12)) REP(16) ph_mla_comb(lds, L);
                SEAM(pb + 12);
                if (IN(pb + 13)) { ph_thin_resid<1024>(KA, lds, WSB(WS_OM), WSB(WS_WMO) + (size_t)L * 1024 * 1024, 0); if (DBG_DOUBLE & 512) ph_resid(lds, WSB(WS_OM), WSB(WS_WMO) + (size_t)L * 1024 * 1024, 1024, 0, 1); ph_resid(lds, WSB(WS_OM), WSB(WS_WMO) + (size_t)L * 1024 * 1024, 1024, 0); }
                SEAM(pb + 13);
            }
            if (IN(cb)) { REP(131072) ph_thin_xq(KA, lds, WSB(WS_WXQ) + (size_t)layer * 1024 * 1024); REP(16384) ph_scale_gemm(lds, WSB(WS_XB), WSB(WS_WXQ) + (size_t)layer * 1024 * 1024, MP, 1024, 1024, (const float*)(ws_ptr() + WS_SSQ), 16, 4, 1.0f / 1024.0f, (bf16*)(ws_ptr() + WS_QX), C2_X); }
            SEAM(cb);
            if (IN(cb + 1)) REP(2) ph_cross(lds, lds0, layer);
            SEAM(cb + 1);
            if (IN(cb + 2)) { ph_thin_resid<1024>(KA, lds, WSB(WS_OM), WSB(WS_WXO) + (size_t)layer * 1024 * 1024, 0); if (DBG_DOUBLE & 4096) ph_resid(lds, WSB(WS_OM), WSB(WS_WXO) + (size_t)layer * 1024 * 1024, 1024, 0, 1); ph_resid(lds, WSB(WS_OM), WSB(WS_WXO) + (size_t)layer * 1024 * 1024, 1024, 0); }
            SEAM(cb + 2);
            if (IN(cb + 3)) { if (DBG_DOUBLE & 1024) ph_gu_null(lds, layer); REP(8) ph_gu(lds, layer); }
            SEAM(cb + 3);
            if (IN(cb + 4)) { ph_thin_resid<DFF>(KA, lds, WSB(WS_HB), WSB(WS_WDN) + (size_t)layer * 1024 * 2816, 0); if (DBG_DOUBLE & 2048) ph_resid<true>(lds, WSB(WS_HB), WSB(WS_WDN) + (size_t)layer * 1024 * 2816, DFF, 0, 1); ph_resid<true>(lds, WSB(WS_HB), WSB(WS_WDN) + (size_t)layer * 1024 * 2816, DFF, 0); }
            SEAM(cb + 4);
        }
    }
    if (IN(40)) REP(262144) ph_final(KA);
#undef IN
#undef SEAM
}

#ifndef DBG_PH_HI
#define DBG_PH_HI NPH
#endif
#ifndef MK_PER_PHASE
#define MK_PER_PHASE 0
#endif
extern "C" void kernel_launch(void* const* d_in, const int* in_sizes, int n_in, void* d_out, int out_size, void* d_ws, size_t ws_size, hipStream_t stream) {
    static int grid = 0;
    if (grid == 0) {
        if (n_in != N_IN || (size_t)out_size != O_END || ws_size < WS_END) { fprintf(stderr, "kernel_launch: unexpected shapes (n_in %d, out %d, ws %zu; need %d, %zu, %zu)\n", n_in, out_size, ws_size, (int)N_IN, (size_t)O_END, (size_t)WS_END); grid = -1; return; }
        int dev = 0, cus = 0, per_cu = 0;
        if (hipGetDevice(&dev) != hipSuccess || hipDeviceGetAttribute(&cus, hipDeviceAttributeMultiprocessorCount, dev) != hipSuccess) { grid = -1; return; }
        if (hipFuncSetAttribute((const void*)fwd_kernel, hipFuncAttributeMaxDynamicSharedMemorySize, LDS_BYTES) != hipSuccess) { fprintf(stderr, "kernel_launch: hipFuncSetAttribute failed\n"); grid = -1; return; }
        if (hipOccupancyMaxActiveBlocksPerMultiprocessor(&per_cu, (const void*)fwd_kernel, NWAVES * 64, LDS_BYTES) != hipSuccess || per_cu < 1) { fprintf(stderr, "kernel_launch: occupancy query reports %d\n", per_cu); }
        (void)hipGetLastError();
        grid = cus;
    }
    if (grid < 0) return;
    if (hipMemsetAsync((char*)d_ws + WS_CTL, 0, CTL_ZERO_BYTES, stream) != hipSuccess) return;
    KArgs a{};
    for (int i = 0; i < N_IN; ++i) a.in[i] = (const float*)d_in[i];
    a.out = (float*)d_out; a.ws = (unsigned char*)d_ws;
#if MK_PER_PHASE
    for (int p = 0; p < NPH; ++p) { a.ph_lo = p; a.ph_hi = p + 1; hipLaunchKernelGGL(fwd_kernel, dim3(grid), dim3(NWAVES * 64), LDS_BYTES, stream, a); }
#else
    a.ph_lo = 0; a.ph_hi = DBG_PH_HI; hipLaunchKernelGGL(fwd_kernel, dim3(grid), dim3(NWAVES * 64), LDS_BYTES, stream, a);
#endif
}
```

```cpp
#include <hip/hip_runtime.h>
#include <cstdint>
#include <cstdio>
#include <cmath>

constexpr int D = 1024, MP = 32768, MS = 512, MT = MP + MS, SEQ = 4096, NBP = 8, NBS = 32, DSEQ = 16, PAST = 2048, NMEM = 256;
constexpr int DFF = 2816, KPAD = 2112;
constexpr float EPS = 1e-6f, LOG2E = 1.4426950408889634f;
constexpr float C2_FOX = 0.125f * LOG2E, C2_MLA = 0.10206207261596575f * LOG2E, C2_X = 0.0625f * LOG2E;

constexpr size_t O_Y = 0;
constexpr size_t O_FKP = (size_t)MT * D;
constexpr size_t O_FVP = O_FKP + (size_t)2 * MP * 1024;
constexpr size_t O_FLP = O_FVP + (size_t)2 * MP * 1024;
constexpr size_t O_MCP = O_FLP + (size_t)2 * MP * 16;
constexpr size_t O_MRP = O_MCP + (size_t)2 * MP * 256;
constexpr size_t O_MKP = O_MRP + (size_t)2 * MP * 32;
constexpr size_t O_MVP = O_MKP + (size_t)4 * 2048 * 1024;
constexpr size_t O_FKS = O_MVP + (size_t)4 * 2048 * 1024;
constexpr size_t O_FVS = O_FKS + (size_t)2 * MS * 1024;
constexpr size_t O_FLS = O_FVS + (size_t)2 * MS * 1024;
constexpr size_t O_MCS = O_FLS + (size_t)2 * MS * 16;
constexpr size_t O_MRS = O_MCS + (size_t)2 * MS * 256;
constexpr size_t O_END = O_MRS + (size_t)2 * MS * 32;

enum { I_XP = 0, I_XS, I_MEM, I_CFK, I_CFV, I_CFL, I_CCKV, I_CKR, I_CMK, I_CMV, I_GMIX, I_GCROSS, I_GMEM, I_GFFN, I_GFINAL,
       I_WFI, I_BFF, I_WFO, I_WMA, I_GMQ, I_GMKV, I_WMQB, I_WMKVB, I_WMO, I_WXQ, I_WXKV, I_WXO, I_WGU, I_WDN, N_IN };


constexpr size_t al256(size_t x) { return (x + 255) & ~(size_t)255; }
constexpr size_t WS_CTL = 0, CTL_ZERO_BYTES = 1u << 20;
constexpr size_t WS_WFI = 2u << 20;
constexpr size_t WS_WFO = WS_WFI + (size_t)2 * 4352 * 1024 * 2;
constexpr size_t WS_WMA = WS_WFO + (size_t)2 * 1024 * 1024 * 2;
constexpr size_t WS_WMQ = WS_WMA + (size_t)2 * 768 * 1024 * 2;
constexpr size_t WS_WMKV = WS_WMQ + (size_t)2 * 1536 * 384 * 2;
constexpr size_t WS_WMKVR = WS_WMKV + (size_t)2 * 2048 * 256 * 2;
constexpr size_t WS_WKN = WS_WMKVR + (size_t)2 * 2048 * 256 * 2;
constexpr size_t WS_WMO = WS_WKN + (size_t)2 * 256 * 2048 * 2;
constexpr size_t WS_WXQ = WS_WMO + (size_t)2 * 1024 * 1024 * 2;
constexpr size_t WS_WXO = WS_WXQ + (size_t)4 * 1024 * 1024 * 2;
constexpr size_t WS_WXKV = WS_WXO + (size_t)4 * 1024 * 1024 * 2;
constexpr size_t WS_WGU = WS_WXKV + (size_t)4 * 2048 * 1024 * 2;
constexpr size_t WS_WDN = WS_WGU + (size_t)4 * 5632 * 1024 * 2;
constexpr size_t WS_WFF = WS_WDN + (size_t)4 * 1024 * 2816 * 2;
constexpr size_t WS_ROPC = WS_WFF + (size_t)2 * 16 * 1024 * 4;
constexpr size_t WS_ROPS = WS_ROPC + (size_t)4096 * 16 * 4;
constexpr size_t WS_XB = WS_ROPS + (size_t)4096 * 16 * 4;
constexpr size_t WS_SSQ = WS_XB + (size_t)MT * 1024 * 2;
constexpr size_t WS_R1 = al256(WS_SSQ + (size_t)MT * 16 * 4);
constexpr size_t SZ_ACT = (size_t)MT * 1024 * 2;
constexpr size_t WS_QF = WS_R1, WS_KF = WS_R1 + SZ_ACT, WS_VF = WS_R1 + 2 * SZ_ACT, WS_GF = WS_R1 + 3 * SZ_ACT;
constexpr size_t WS_QM = WS_R1, WS_KVM = al256(WS_R1 + (size_t)MT * 1536 * 2);
static_assert(WS_KVM + (size_t)MP * 2048 * 2 <= WS_R1 + 4 * SZ_ACT, "MLA overlay fits");
constexpr size_t WS_OM = WS_R1 + 4 * SZ_ACT;
constexpr size_t WS_LFR = WS_OM + SZ_ACT;
constexpr size_t WS_CB = WS_LFR + (size_t)MT * 16 * 4;
constexpr size_t WS_CBS = WS_CB + (size_t)8 * 16 * 4096 * 4;
constexpr size_t WS_CKVU = al256(WS_CBS + (size_t)32 * 16 * 2080 * 4);
constexpr size_t WS_CKVUB = WS_CKVU + (size_t)MT * 256 * 4;
constexpr size_t WS_SSQKV = WS_CKVUB + (size_t)MT * 256 * 2;
constexpr size_t WS_CQ = WS_SSQKV + (size_t)MT * 4 * 4;
constexpr size_t WS_SSQQ = WS_CQ + (size_t)MT * 384 * 2;
constexpr size_t WS_KRB = WS_SSQQ + (size_t)MT * 8 * 4;
constexpr size_t WS_QA = al256(WS_KRB + (size_t)MT * 32 * 2);
constexpr size_t WS_PART = al256(WS_QA + (size_t)288 * 256 * 288 * 2);
constexpr size_t WS_QX = al256(WS_PART + (size_t)32 * 9 * 256 * 264 * 4);
constexpr size_t WS_MB = WS_QX + SZ_ACT;
constexpr size_t WS_MKB = WS_MB + (size_t)2048 * 1024 * 2;
constexpr size_t WS_MVB = WS_MKB + (size_t)4 * 2048 * 1024 * 2;
constexpr size_t WS_HB = WS_MVB + (size_t)4 * 2048 * 1024 * 2;
constexpr size_t WS_END = WS_HB + (size_t)MT * DFF * 2;
constexpr int CW_BAR = 4096;

namespace pg8 {
#define PG8_LAS __attribute__((address_space(3)))
typedef unsigned short bf16_t;
typedef short bf16x8 __attribute__((ext_vector_type(8)));
typedef float f32x4 __attribute__((ext_vector_type(4)));
typedef unsigned u32x4 __attribute__((ext_vector_type(4)));
constexpr int BM = 256, BK = 64, HALF = 128, HTB = HALF * BK * 2  , STAGE_BYTES = 8 * HTB, NXCD = 8, WGM = 8;

__host__ __device__ __forceinline__ int lds_byte(int r, int c) { const int st = (r >> 4) * 2 + (c >> 5), rr = r & 15, cc = c & 31, ob = rr * 64 + cc * 2; return st * 1024 + (ob ^ (((ob >> 9) & 1) << 5)); }
__host__ __device__ __forceinline__ void stage_rc(int b, int& R, int& C) { const int st = b / 1024, sb = b % 1024, swz = sb ^ (((sb >> 9) & 1) << 5); R = (st >> 1) * 16 + swz / 64; C = (st & 1) * 32 + (swz % 64) / 2; }
__host__ __device__ __forceinline__ int perm32(int rho) { const int n = rho >> 4, i = rho & 15; return 8 * (i >> 2) + 4 * n + (i & 3); }

struct Unit { int pm, pn; };
struct Gemm { const bf16_t* A; const bf16_t* Bt; int M, N, K; };

struct StaticOrder {
    int nM, nN, nwg, G, c;
    __host__ __device__ void init(int M, int N, int G_, int c_) { nM = M / BM; nN = N / BM; nwg = nM * nN; G = G_; c = c_; }
    __host__ __device__ bool next(int i, Unit& u) const {
        const long L = (long)i * G + c; if (L >= nwg) return false;
        int wgid = (int)L; { const int q = nwg / NXCD, r = nwg % NXCD, xcd = wgid % NXCD, off = wgid / NXCD; wgid = (xcd < r ? xcd * (q + 1) : r * (q + 1) + (xcd - r) * q) + off; }
        const int nig = WGM * nN, gid = wgid / nig, fm = gid * WGM, gsz = (nM - fm) < WGM ? (nM - fm) : WGM;
        u.pm = fm + ((wgid % nig) % gsz); u.pn = (wgid % nig) / gsz; return true;
    }
    __device__ __forceinline__ void a_ready(const Unit&) const {}
    __device__ __forceinline__ void done(const Unit&) const {}
};

typedef unsigned u32x2 __attribute__((ext_vector_type(2)));
typedef float f32x2v __attribute__((ext_vector_type(2)));
typedef __bf16 bf16x2_t __attribute__((ext_vector_type(2)));
__device__ __forceinline__ unsigned pk_bf16(float lo, float hi) { f32x2v v = {lo, hi}; bf16x2_t b = __builtin_convertvector(v, bf16x2_t); return __builtin_bit_cast(unsigned, b); }
__device__ __forceinline__ u32x2 pk4(f32x4 v) { u32x2 w; w.x = pk_bf16(v[0], v[1]); w.y = pk_bf16(v[2], v[3]); return w; }
__device__ __forceinline__ float dot4(f32x4 v) { return (v[0] * v[0] + v[1] * v[1]) + (v[2] * v[2] + v[3] * v[3]); }
__device__ __forceinline__ float sigm(float z) { return __builtin_amdgcn_rcpf(1.0f + __builtin_amdgcn_exp2f(-z * LOG2E)); }
#define EPI_FENCE() asm volatile("" ::: "memory")
__device__ __forceinline__ int pg8_tid() { int t = threadIdx.x; asm volatile("" : "+v"(t)); return t; }

struct RowScale { const float* p; int stride; int ngrp; float inv_n;
    __device__ __forceinline__ float get(int row, int fq) const {
        float s = 0.f; if (fq < ngrp) { const f32x4 v = *(const f32x4*)(p + (size_t)row * stride + 4 * fq); s = (v[0] + v[1]) + (v[2] + v[3]); }
        s += __shfl_xor(s, 16); s += __shfl_xor(s, 32); return rsqrtf(s * inv_n + EPS); }
    __device__ __forceinline__ void get8(int row0, int fq, float (&r)[2][4]) const {
        float s[2][4];
#pragma unroll
        for (int ai = 0; ai < 2; ++ai)
#pragma unroll
            for (int m = 0; m < 4; ++m) { s[ai][m] = 0.f; if (fq < ngrp) { const f32x4 v = *(const f32x4*)(p + (size_t)(row0 + ai * HALF + m * 16) * stride + 4 * fq); s[ai][m] = (v[0] + v[1]) + (v[2] + v[3]); } }
#pragma unroll
        for (int ai = 0; ai < 2; ++ai)
#pragma unroll
            for (int m = 0; m < 4; ++m) { float t = s[ai][m]; t += __shfl_xor(t, 16); t += __shfl_xor(t, 32); r[ai][m] = rsqrtf(t * inv_n + EPS); }
    } };
__device__ __forceinline__ int row_pos(int row) { return row < MP ? (row & (SEQ - 1)) : PAST + ((row - MP) & (DSEQ - 1)); }

struct EpiFoxIn { static constexpr bool PERM = false, AFTER_DRAIN = false;
    RowScale rs; unsigned char* ws; float* out; const float* bff; int L;
    __device__ __forceinline__ void operator()(const f32x4 (&acc)[2][2][4][2], const Unit& u, int wr, int wc, int, int) const { const int lane_ = pg8_tid() & 63, fr = lane_ & 15, fq = lane_ >> 4; float rsv[2][4]; rs.get8(u.pm * BM + wr * 64 + fr, fq, rsv);
        const int typ = u.pn >> 2, colt = (u.pn & 3) * 256 + wc * 32 + 4 * fq;
        bf16_t* QF = (bf16_t*)(ws + WS_QF); float* kp = out + O_FKP + (size_t)L * MP * 1024; float* ks = out + O_FKS + (size_t)L * MS * 1024;
#pragma unroll
        for (int ai = 0; ai < 2; ++ai)
#pragma unroll
            for (int m = 0; m < 4; ++m) { const int row = u.pm * BM + ai * HALF + wr * 64 + m * 16 + fr; float r = rsv[ai][m];
                if (typ == 0) { r *= C2_FOX;
#pragma unroll
                    for (int bj = 0; bj < 2; ++bj)
#pragma unroll
                        for (int n = 0; n < 2; ++n) *(u32x2*)(QF + (size_t)row * 1024 + colt + bj * HALF + n * 16) = pk4(acc[ai][bj][m][n] * r);
                } else if (typ == 3) {
#pragma unroll
                    for (int bj = 0; bj < 2; ++bj)
#pragma unroll
                        for (int n = 0; n < 2; ++n) { f32x4 v = acc[ai][bj][m][n] * r; v[0] = sigm(v[0]); v[1] = sigm(v[1]); v[2] = sigm(v[2]); v[3] = sigm(v[3]);
                            *(u32x2*)(QF + 3 * (SZ_ACT / 2) + (size_t)row * 1024 + colt + bj * HALF + n * 16) = pk4(v); }
                } else if (typ == 4) {
                    if (wc == 0) { const f32x4 bb = *(const f32x4*)(bff + 4 * fq); f32x4 lf;
#pragma unroll
                        for (int i = 0; i < 4; ++i) { const float z = acc[ai][0][m][0][i] * r + bb[i]; lf[i] = fminf(z, 0.f) - log1pf(expf(-fabsf(z))); }
                        *(f32x4*)((float*)(ws + WS_LFR) + (size_t)row * 16 + 4 * fq) = lf;
                        float* F = (row < MP) ? out + O_FLP + ((size_t)L * MP + row) * 16 : out + O_FLS + ((size_t)L * MS + (row - MP)) * 16;
                        *(f32x4*)(F + 4 * fq) = lf; }
                } else { bf16_t* B = QF + (size_t)typ * (SZ_ACT / 2);
                    float* F = (row < MP) ? kp + (size_t)(typ - 1) * 2 * MP * 1024 + (size_t)row * 1024 : ks + (size_t)(typ - 1) * 2 * MS * 1024 + (size_t)(row - MP) * 1024;
#pragma unroll
                    for (int bj = 0; bj < 2; ++bj)
#pragma unroll
                        for (int n = 0; n < 2; ++n) { const f32x4 v = acc[ai][bj][m][n] * r; const int c = colt + bj * HALF + n * 16;
                            *(f32x4*)(F + c) = v; *(u32x2*)(B + (size_t)row * 1024 + c) = pk4(v); }
                }
                if (m & 1) EPI_FENCE(); }
    }
};
struct EpiResid { static constexpr bool PERM = true, AFTER_DRAIN = false;
    const float* xin_p; const float* xin_s; int first; bf16_t* xb; float* ssq;
    __device__ __forceinline__ void operator()(const f32x4 (&acc)[2][2][4][2], const Unit& u, int wr, int wc, int, int) const { const int lane_ = pg8_tid() & 63, fr = lane_ & 15, fq = lane_ >> 4;
        const int col0 = u.pn * BM + wc * 32 + 8 * fq;
        if (first) {
#pragma unroll
        for (int ai = 0; ai < 2; ++ai) {
            f32x4 xo[4][2][2];
#pragma unroll
            for (int m = 0; m < 4; ++m) { const int row = u.pm * BM + ai * HALF + wr * 64 + m * 16 + fr;
                const float* xi = (row < MP) ? xin_p + (size_t)row * 1024 : xin_s + (size_t)(row - MP) * 1024;
#pragma unroll
                for (int bj = 0; bj < 2; ++bj)
#pragma unroll
                    for (int n = 0; n < 2; ++n) xo[m][bj][n] = *(const f32x4*)(xi + col0 + bj * HALF + n * 4); }
#pragma unroll
            for (int m = 0; m < 4; ++m) { const int row = u.pm * BM + ai * HALF + wr * 64 + m * 16 + fr; float sq = 0.f;
#pragma unroll
                for (int bj = 0; bj < 2; ++bj) { const int c = col0 + bj * HALF; const f32x4 x0 = xo[m][bj][0] + acc[ai][bj][m][0], x1 = xo[m][bj][1] + acc[ai][bj][m][1];
                    sq += dot4(x0) + dot4(x1);
                    const u32x2 w0 = pk4(x0), w1 = pk4(x1); *(u32x4*)(xb + (size_t)row * 1024 + c) = (u32x4){w0.x, w0.y, w1.x, w1.y}; }
                sq += __shfl_xor(sq, 16); sq += __shfl_xor(sq, 32);
                if (fq == 0) ssq[(size_t)row * 16 + u.pn * 4 + wc] = sq; }
            EPI_FENCE(); }
        } else {
            u32x4 raw[2][4][2];
#pragma unroll
            for (int ai = 0; ai < 2; ++ai)
#pragma unroll
                for (int m = 0; m < 4; ++m) { const int row = u.pm * BM + ai * HALF + wr * 64 + m * 16 + fr;
#pragma unroll
                    for (int bj = 0; bj < 2; ++bj) raw[ai][m][bj] = *(const u32x4*)(xb + (size_t)row * 1024 + col0 + bj * HALF); }
            EPI_FENCE();
#pragma unroll
            for (int ai = 0; ai < 2; ++ai) {
#pragma unroll
                for (int m = 0; m < 4; ++m) { const int row = u.pm * BM + ai * HALF + wr * 64 + m * 16 + fr; float sq = 0.f;
#pragma unroll
                    for (int bj = 0; bj < 2; ++bj) { const int c = col0 + bj * HALF; const u32x4 w = raw[ai][m][bj];
                        const f32x4 x0 = (f32x4){__builtin_bit_cast(float, w.x << 16), __builtin_bit_cast(float, w.x & 0xffff0000u), __builtin_bit_cast(float, w.y << 16), __builtin_bit_cast(float, w.y & 0xffff0000u)} + acc[ai][bj][m][0];
                        const f32x4 x1 = (f32x4){__builtin_bit_cast(float, w.z << 16), __builtin_bit_cast(float, w.z & 0xffff0000u), __builtin_bit_cast(float, w.w << 16), __builtin_bit_cast(float, w.w & 0xffff0000u)} + acc[ai][bj][m][1];
                        sq += dot4(x0) + dot4(x1);
                        const u32x2 w0 = pk4(x0), w1 = pk4(x1); *(u32x4*)(xb + (size_t)row * 1024 + c) = (u32x4){w0.x, w0.y, w1.x, w1.y}; }
                    sq += __shfl_xor(sq, 16); sq += __shfl_xor(sq, 32);
                    if (fq == 0) ssq[(size_t)row * 16 + u.pn * 4 + wc] = sq; }
                EPI_FENCE(); } }
    }
};
struct EpiScaleBf16 { static constexpr bool PERM = true, AFTER_DRAIN = false;
    RowScale rs; bf16_t* O; int ldc; float scale;
    __device__ __forceinline__ void operator()(const f32x4 (&acc)[2][2][4][2], const Unit& u, int wr, int wc, int, int) const { const int lane_ = pg8_tid() & 63, fr = lane_ & 15, fq = lane_ >> 4; float rsv[2][4]; rs.get8(u.pm * BM + wr * 64 + fr, fq, rsv);
        const int col0 = u.pn * BM + wc * 32 + 8 * fq;
#pragma unroll
        for (int ai = 0; ai < 2; ++ai)
#pragma unroll
            for (int m = 0; m < 4; ++m) { const int row = u.pm * BM + ai * HALF + wr * 64 + m * 16 + fr; const float r = rsv[ai][m] * scale;
#pragma unroll
                for (int bj = 0; bj < 2; ++bj) { const u32x2 w0 = pk4(acc[ai][bj][m][0] * r), w1 = pk4(acc[ai][bj][m][1] * r);
                    *(u32x4*)(O + (size_t)row * ldc + col0 + bj * HALF) = (u32x4){w0.x, w0.y, w1.x, w1.y}; }
                if (m & 1) EPI_FENCE(); }
    }
};
struct EpiSwiglu { static constexpr bool PERM = true, AFTER_DRAIN = false;
    RowScale rs; bf16_t* HB;
    __device__ __forceinline__ void operator()(const f32x4 (&acc)[2][2][4][2], const Unit& u, int wr, int wc, int, int) const { const int lane_ = pg8_tid() & 63, fr = lane_ & 15, fq = lane_ >> 4; float rsv[2][4]; rs.get8(u.pm * BM + wr * 64 + fr, fq, rsv);
        const int col0 = u.pn * HALF + wc * 32 + 8 * fq;
        const bool blk = u.pm < MP / BM; const int rstr = blk ? 128 : DFF * 2;
        const size_t hb0 = blk ? ((size_t)(u.pm * (DFF / 64) + (col0 >> 6)) * 32768 + (size_t)(col0 & 63) * 2) : ((size_t)u.pm * BM * DFF + col0) * 2;
#pragma unroll
        for (int ai = 0; ai < 2; ++ai)
#pragma unroll
            for (int m = 0; m < 4; ++m) { const int row = u.pm * BM + ai * HALF + wr * 64 + m * 16 + fr; const float r = rsv[ai][m]; u32x4 w;
#pragma unroll
                for (int n = 0; n < 2; ++n) { const f32x4 g = acc[ai][0][m][n] * r, uu = acc[ai][1][m][n] * r; f32x4 h;
#pragma unroll
                    for (int i = 0; i < 4; ++i) h[i] = g[i] * sigm(g[i]) * uu[i];
                    const u32x2 hw = pk4(h); if (n == 0) { w.x = hw.x; w.y = hw.y; } else { w.z = hw.x; w.w = hw.y; } }
                *(u32x4*)((char*)HB + hb0 + (size_t)(row - u.pm * BM) * rstr) = w;
                if (m & 1) EPI_FENCE(); }
    }
};
struct EpiMlaA { static constexpr bool PERM = false, AFTER_DRAIN = false;
    RowScale rs; float* ckvu; bf16_t* ckvub; float* ssqkv; bf16_t* cq; float* ssqq; bf16_t* krb; float *mrp, *mrs; const float *ropc, *rops;
    __device__ __forceinline__ void operator()(const f32x4 (&acc)[2][2][4][2], const Unit& u, int wr, int wc, int, int) const { const int lane_ = pg8_tid() & 63, fr = lane_ & 15, fq = lane_ >> 4; float rsv[2][4]; rs.get8(u.pm * BM + wr * 64 + fr, fq, rsv);
        const int cw = wc * 32 + 4 * fq;
#pragma unroll
        for (int ai = 0; ai < 2; ++ai)
#pragma unroll
            for (int m = 0; m < 4; ++m) { const int row = u.pm * BM + ai * HALF + wr * 64 + m * 16 + fr; const float r = rsv[ai][m];
                if (u.pn == 0) { float sq = 0.f;
#pragma unroll
                    for (int bj = 0; bj < 2; ++bj)
#pragma unroll
                        for (int n = 0; n < 2; ++n) { const int c = cw + bj * HALF + n * 16; const f32x4 v = acc[ai][bj][m][n] * r;
                            *(f32x4*)(ckvu + (size_t)row * 256 + c) = v; *(u32x2*)(ckvub + (size_t)row * 256 + c) = pk4(v); sq += dot4(v); }
                    sq += __shfl_xor(sq, 16); sq += __shfl_xor(sq, 32); if (fq == 0) ssqkv[(size_t)row * 4 + wc] = sq;
                } else if (u.pn == 1) { float sq = 0.f;
#pragma unroll
                    for (int bj = 0; bj < 2; ++bj)
#pragma unroll
                        for (int n = 0; n < 2; ++n) { const int c = cw + bj * HALF + n * 16; const f32x4 v = acc[ai][bj][m][n] * r;
                            *(u32x2*)(cq + (size_t)row * 384 + c) = pk4(v); sq += dot4(v); }
                    sq += __shfl_xor(sq, 16); sq += __shfl_xor(sq, 32); if (fq == 0) ssqq[(size_t)row * 8 + wc] = sq;
                } else { float sq = 0.f;
#pragma unroll
                    for (int n = 0; n < 2; ++n) { const int c = 256 + cw + n * 16; const f32x4 v = acc[ai][0][m][n] * r;
                        *(u32x2*)(cq + (size_t)row * 384 + c) = pk4(v); sq += dot4(v); }
                    sq += __shfl_xor(sq, 16); sq += __shfl_xor(sq, 32); if (fq == 0) ssqq[(size_t)row * 8 + 4 + wc] = sq;
                    if (wc == 0) { const int pos = row_pos(row); const f32x4 cs = *(const f32x4*)(ropc + pos * 16 + 4 * fq), sn = *(const f32x4*)(rops + pos * 16 + 4 * fq);
                        const f32x4 x1 = acc[ai][1][m][0] * r, x2 = acc[ai][1][m][1] * r; const f32x4 o1 = x1 * cs - x2 * sn, o2 = x1 * sn + x2 * cs;
                        *(u32x2*)(krb + (size_t)row * 32 + 4 * fq) = pk4(o1); *(u32x2*)(krb + (size_t)row * 32 + 16 + 4 * fq) = pk4(o2);
                        float* F = (row < MP) ? mrp + (size_t)row * 32 : mrs + (size_t)(row - MP) * 32;
                        *(f32x4*)(F + 4 * fq) = o1; *(f32x4*)(F + 16 + 4 * fq) = o2; }
                }
                if (m & 1) EPI_FENCE(); }
    }
};
struct EpiMlaQ { static constexpr bool PERM = false, AFTER_DRAIN = false;
    RowScale rs; bf16_t* QM; const float *ropc, *rops;
    __device__ __forceinline__ void operator()(const f32x4 (&acc)[2][2][4][2], const Unit& u, int wr, int wc, int, int) const { const int lane_ = pg8_tid() & 63, fr = lane_ & 15, fq = lane_ >> 4; float rsv[2][4]; rs.get8(u.pm * BM + wr * 64 + fr, fq, rsv);
#pragma unroll
        for (int ai = 0; ai < 2; ++ai)
#pragma unroll
            for (int m = 0; m < 4; ++m) { const int row = u.pm * BM + ai * HALF + wr * 64 + m * 16 + fr; const float r = rsv[ai][m] * C2_MLA;
                const int pos = row_pos(row);
#pragma unroll
                for (int bj = 0; bj < 2; ++bj) { const int g32 = u.pn * 8 + bj * 4 + wc; const int c = g32 * 32 + 4 * fq; bf16_t* o = QM + (size_t)row * 1536 + c;
                    if ((g32 % 3) == 2) { const f32x4 cs = *(const f32x4*)(ropc + pos * 16 + 4 * fq), sn = *(const f32x4*)(rops + pos * 16 + 4 * fq);
                        const f32x4 x1 = acc[ai][bj][m][0] * r, x2 = acc[ai][bj][m][1] * r;
                        *(u32x2*)(o) = pk4(x1 * cs - x2 * sn); *(u32x2*)(o + 16) = pk4(x1 * sn + x2 * cs);
                    } else { *(u32x2*)(o) = pk4(acc[ai][bj][m][0] * r); *(u32x2*)(o + 16) = pk4(acc[ai][bj][m][1] * r); } }
                EPI_FENCE(); }
    }
};
struct EpiNull { static constexpr bool PERM = true, AFTER_DRAIN = false;
    __device__ __forceinline__ void operator()(const f32x4 (&acc)[2][2][4][2], const Unit&, int, int, int, int) const {
#pragma unroll
        for (int ai = 0; ai < 2; ++ai)
#pragma unroll
            for (int bj = 0; bj < 2; ++bj)
#pragma unroll
                for (int m = 0; m < 4; ++m)
#pragma unroll
                    for (int n = 0; n < 2; ++n) asm volatile("" :: "v"(acc[ai][bj][m][n])); }
};
struct EpiMemKV { static constexpr bool PERM = false, AFTER_DRAIN = false;
    float* outk; float* outv; bf16_t* MKB; bf16_t* MVB;
    __device__ __forceinline__ void operator()(const f32x4 (&acc)[2][2][4][2], const Unit& u, int wr, int wc, int, int) const { const int lane_ = pg8_tid() & 63, fr = lane_ & 15, fq = lane_ >> 4;
        const int l = u.pn >> 3, cw0 = (u.pn & 7) * 256; const bool isv = cw0 >= 1024; const int cbase = (cw0 & 1023) + wc * 32 + 4 * fq;
#pragma unroll
        for (int ai = 0; ai < 2; ++ai)
#pragma unroll
            for (int m = 0; m < 4; ++m) { const int row = u.pm * BM + ai * HALF + wr * 64 + m * 16 + fr; const int b = row >> 8, nn = row & 255;
#pragma unroll
                for (int bj = 0; bj < 2; ++bj)
#pragma unroll
                    for (int n = 0; n < 2; ++n) { const int c = cbase + bj * HALF + n * 16; const f32x4 v = acc[ai][bj][m][n]; const size_t o = ((size_t)l * 2048 + row) * 1024 + c;
                        if (!isv) { *(f32x4*)(outk + o) = v; *(u32x2*)(MKB + o) = pk4(v); } else { *(f32x4*)(outv + o) = v; *(u32x2*)(MVB + o) = pk4(v); } }
                if (m & 1) EPI_FENCE(); }
    }
};

template <class Epi, class Sched, bool ALIGN_EPI = false, bool SP2 = false, bool ABLK = false>
__device__ __forceinline__ void gemm_phase(PG8_LAS unsigned char* lds, const Gemm g, const Sched& S, const Epi& E) {
    const int tid = pg8_tid(), wid = __builtin_amdgcn_readfirstlane(tid >> 6), lane = tid & 63, wr = wid >> 2, wc = wid & 3, fr = lane & 15, fq = lane >> 4;
    const int K = g.K, nt = K / BK;
    unsigned voffA[2], voffB[2];
#pragma unroll
    for (int i = 0; i < 2; ++i) { int R, C; stage_rc(tid * 16 + i * 8192, R, C); const int Rb = Epi::PERM ? ((R & ~31) + perm32(R & 31)) : R;
        voffA[i] = ABLK ? (unsigned)(R * BK + C) * 2u : (unsigned)(R * K + C) * 2u; voffB[i] = (unsigned)(Rb * K + C) * 2u; }
    const size_t kstep = (size_t)(BK * 2);
    const size_t hstep = (size_t)HALF * K * 2;
    const size_t tstep = 2 * hstep;
    const size_t kstepA = ABLK ? (size_t)BM * BK * 2 : kstep, hstepA = ABLK ? (size_t)HALF * BK * 2 : hstep, tstepA = ABLK ? (size_t)nt * BM * BK * 2 : tstep;
    const unsigned ldsw = (unsigned)wid * 1024u;
    const int aoff = lds_byte(wr * 64 + fr, fq * 8), boff = lds_byte(wc * 32 + fr, fq * 8);
#define PG8_SA(b, h) (((b) * 2 + (h)) * HTB)
#define PG8_SB(b, h) ((4 + (b) * 2 + (h)) * HTB)
#define PG8_STAGE(bufoff, gbase, voff) do { _Pragma("unroll") for (int _i = 0; _i < 2; ++_i) \
        __builtin_amdgcn_global_load_lds((const unsigned*)((const char*)(gbase) + (voff)[_i]), (PG8_LAS unsigned*)(lds + (bufoff) + ldsw + _i * 8192), 16, 0, 0); } while (0)
#define PG8_LDA(dst, b, h) do { _Pragma("unroll") for (int m = 0; m < 4; ++m) _Pragma("unroll") for (int k = 0; k < 2; ++k) dst[m][k] = *(const PG8_LAS bf16x8*)(lds + PG8_SA(b, h) + aoff + m * 2048 + k * 1024); } while (0)
#define PG8_LDB(dst, b, h) do { _Pragma("unroll") for (int n = 0; n < 2; ++n) _Pragma("unroll") for (int k = 0; k < 2; ++k) dst[n][k] = *(const PG8_LAS bf16x8*)(lds + PG8_SB(b, h) + boff + n * 2048 + k * 1024); } while (0)
#define PG8_MMA(ai, bj, At, Bt) do { __builtin_amdgcn_s_setprio(1); _Pragma("unroll") for (int m = 0; m < 4; ++m) _Pragma("unroll") for (int n = 0; n < 2; ++n) _Pragma("unroll") for (int k = 0; k < 2; ++k) \
        acc[ai][bj][m][n] = __builtin_amdgcn_mfma_f32_16x16x32_bf16(Bt[n][k], At[m][k], acc[ai][bj][m][n], 0, 0, 0); __builtin_amdgcn_s_setprio(0); } while (0)
#define PG8_WAIT_V(n) asm volatile("s_waitcnt vmcnt(" #n ")" ::: "memory")
#define PG8_WAIT_L(n) asm volatile("s_waitcnt lgkmcnt(" #n ")" ::: "memory")
#define PG8_BAR __builtin_amdgcn_s_barrier()
#define PG8_SCHED __builtin_amdgcn_sched_barrier(0)
    Unit cur, nxt; int ui = 0;
    if (!S.next(0, cur)) return;
    f32x4 acc[2][2][4][2];
#pragma unroll
    for (int a = 0; a < 2; ++a)
#pragma unroll
        for (int b = 0; b < 2; ++b)
#pragma unroll
            for (int m = 0; m < 4; ++m)
#pragma unroll
                for (int n = 0; n < 2; ++n) acc[a][b][m][n] = (f32x4){0.f, 0.f, 0.f, 0.f};
    bf16x8 At[4][2], B0[2][2], B1[2][2];
    const char* cA = (const char*)g.A + (size_t)cur.pm * tstepA; const char* cB = (const char*)g.Bt + (size_t)cur.pn * tstep;
    S.a_ready(cur);
    if constexpr (SP2) {
        PG8_STAGE(PG8_SB(0, 0), cB, voffB); PG8_STAGE(PG8_SB(0, 1), cB + hstep, voffB); PG8_STAGE(PG8_SA(0, 0), cA, voffA); PG8_STAGE(PG8_SA(0, 1), cA + hstepA, voffA);
        if (wr == 1) PG8_BAR;
        PG8_WAIT_V(2); PG8_BAR;
        PG8_STAGE(PG8_SB(1, 0), cB + kstep, voffB); PG8_STAGE(PG8_SA(1, 0), cA + kstepA, voffA); PG8_STAGE(PG8_SB(1, 1), cB + hstep + kstep, voffB);
        PG8_WAIT_V(6); PG8_BAR;
    } else {
        PG8_STAGE(PG8_SB(0, 0), cB, voffB); PG8_STAGE(PG8_SA(0, 0), cA, voffA); PG8_STAGE(PG8_SB(0, 1), cB + hstep, voffB); PG8_STAGE(PG8_SA(0, 1), cA + hstepA, voffA);
        if (wr == 1) PG8_BAR;
        PG8_WAIT_V(4); PG8_BAR;
        PG8_STAGE(PG8_SB(1, 0), cB + kstep, voffB); PG8_STAGE(PG8_SA(1, 0), cA + kstepA, voffA); PG8_STAGE(PG8_SB(1, 1), cB + hstep + kstep, voffB);
        PG8_WAIT_V(6); PG8_BAR;
    }
    for (;;) {
        const bool has_next = S.next(ui + 1, nxt);
        const char* nA = has_next ? (const char*)g.A + (size_t)nxt.pm * tstepA : cA; const char* nB = has_next ? (const char*)g.Bt + (size_t)nxt.pn * tstep : cB;
        for (int t = 0; t < nt; t += 2) {
            const bool last = (t == nt - 2);
            const char* a1 = cA + (size_t)(t + 1) * kstepA;
            const char* a2 = last ? nA : cA + (size_t)(t + 2) * kstepA; const char* b2 = last ? nB : cB + (size_t)(t + 2) * kstep;
            const char* a3 = a2 + kstepA; const char* b3 = b2 + kstep;
            if (last && has_next) S.a_ready(nxt);
            if constexpr (SP2) {
            PG8_LDB(B0, 0, 0); PG8_LDB(B1, 0, 1); PG8_SCHED; PG8_LDA(At, 0, 0); PG8_STAGE(PG8_SA(1, 1), a1 + hstepA, voffA);
            PG8_WAIT_V(8); PG8_WAIT_L(0); PG8_BAR; PG8_MMA(0, 0, At, B0); PG8_MMA(0, 1, At, B1); PG8_BAR; PG8_SCHED;
            PG8_LDA(At, 0, 1); PG8_STAGE(PG8_SB(0, 0), b2, voffB); PG8_STAGE(PG8_SB(0, 1), b2 + hstep, voffB); PG8_STAGE(PG8_SA(0, 0), a2, voffA);
            PG8_WAIT_V(8); PG8_WAIT_L(0); PG8_BAR; PG8_MMA(1, 0, At, B0); PG8_MMA(1, 1, At, B1); PG8_BAR; PG8_SCHED;
            PG8_LDB(B0, 1, 0); PG8_LDB(B1, 1, 1); PG8_SCHED; PG8_LDA(At, 1, 0); PG8_STAGE(PG8_SA(0, 1), a2 + hstepA, voffA);
            PG8_WAIT_V(8); PG8_WAIT_L(0); PG8_BAR; PG8_MMA(0, 0, At, B0); PG8_MMA(0, 1, At, B1); PG8_BAR; PG8_SCHED;
            PG8_LDA(At, 1, 1); PG8_STAGE(PG8_SB(1, 0), b3, voffB); PG8_STAGE(PG8_SB(1, 1), b3 + hstep, voffB); PG8_STAGE(PG8_SA(1, 0), a3, voffA);
            PG8_WAIT_V(8); PG8_WAIT_L(0); PG8_BAR; PG8_MMA(1, 0, At, B0); PG8_MMA(1, 1, At, B1); PG8_BAR; PG8_SCHED;
            } else {
            PG8_LDB(B0, 0, 0); PG8_SCHED; PG8_LDA(At, 0, 0); PG8_STAGE(PG8_SA(1, 1), a1 + hstepA, voffA);
            PG8_WAIT_L(8); PG8_BAR; PG8_WAIT_L(0); PG8_MMA(0, 0, At, B0); PG8_BAR; PG8_SCHED;
            PG8_LDB(B1, 0, 1); PG8_STAGE(PG8_SB(0, 0), b2, voffB);
            PG8_BAR; PG8_WAIT_L(0); PG8_MMA(0, 1, At, B1); PG8_BAR;
            PG8_LDA(At, 0, 1); PG8_STAGE(PG8_SA(0, 0), a2, voffA);
            PG8_BAR; PG8_WAIT_L(0); PG8_MMA(1, 0, At, B0); PG8_BAR; PG8_SCHED;
            PG8_STAGE(PG8_SB(0, 1), b2 + hstep, voffB);
            PG8_WAIT_V(6); PG8_BAR; PG8_MMA(1, 1, At, B1); PG8_BAR;
            PG8_LDB(B0, 1, 0); PG8_SCHED; PG8_LDA(At, 1, 0); PG8_STAGE(PG8_SA(0, 1), a2 + hstepA, voffA);
            PG8_WAIT_L(8); PG8_BAR; PG8_WAIT_L(0); PG8_MMA(0, 0, At, B0); PG8_BAR; PG8_SCHED;
            PG8_LDB(B1, 1, 1); PG8_STAGE(PG8_SB(1, 0), b3, voffB);
            PG8_BAR; PG8_WAIT_L(0); PG8_MMA(0, 1, At, B1); PG8_BAR;
            PG8_LDA(At, 1, 1); PG8_STAGE(PG8_SA(1, 0), a3, voffA);
            PG8_BAR; PG8_WAIT_L(0); PG8_MMA(1, 0, At, B0); PG8_BAR; PG8_SCHED;
            PG8_STAGE(PG8_SB(1, 1), b3 + hstep, voffB);
            PG8_WAIT_V(6); PG8_BAR; PG8_MMA(1, 1, At, B1); PG8_BAR;
            }
        }
        if constexpr (ALIGN_EPI) { if (wr == 0) PG8_BAR; }
        if constexpr (!Epi::AFTER_DRAIN) { E(acc, cur, wr, wc, fr, fq); S.done(cur); }
        if (!has_next) break;
#pragma unroll
        for (int a = 0; a < 2; ++a)
#pragma unroll
            for (int b = 0; b < 2; ++b)
#pragma unroll
                for (int m = 0; m < 4; ++m)
#pragma unroll
                    for (int n = 0; n < 2; ++n) acc[a][b][m][n] = (f32x4){0.f, 0.f, 0.f, 0.f};
        cur = nxt; cA = nA; cB = nB; ++ui;
        if constexpr (ALIGN_EPI) { if (wr == 1) PG8_BAR; }
    }
    PG8_WAIT_V(0);
    if constexpr (!ALIGN_EPI) { if (wr == 0) PG8_BAR; }
    PG8_BAR;
    if constexpr (Epi::AFTER_DRAIN) { E.fused(acc, cur, wr, wc, fr, fq, lds, wid, lane); S.done(cur); }
#undef PG8_SA
#undef PG8_SB
#undef PG8_STAGE
#undef PG8_LDA
#undef PG8_LDB
#undef PG8_MMA
#undef PG8_WAIT_V
#undef PG8_WAIT_L
#undef PG8_BAR
#undef PG8_SCHED
}
}

#define GAS __attribute__((address_space(1)))
#define LAS __attribute__((address_space(3)))
typedef unsigned short bf16;
typedef float f32x4 __attribute__((ext_vector_type(4)));
typedef float f32x16 __attribute__((ext_vector_type(16)));
typedef short bf16x8 __attribute__((ext_vector_type(8)));
typedef short s16x4 __attribute__((ext_vector_type(4)));
typedef unsigned u32x4 __attribute__((ext_vector_type(4)));
typedef unsigned u32x2 __attribute__((ext_vector_type(2)));
typedef GAS unsigned gu32;
#define RLX_AGENT __ATOMIC_RELAXED, __HIP_MEMORY_SCOPE_AGENT
#define LDS_WAIT() asm volatile("s_waitcnt lgkmcnt(0)" ::: "memory")
#define VM_WAIT() asm volatile("s_waitcnt vmcnt(0)" ::: "memory")
__device__ __forceinline__ unsigned pk2(float lo, float hi) { return pg8::pk_bf16(lo, hi); }
__device__ __forceinline__ float bf2f(unsigned short b) { return __builtin_bit_cast(float, (unsigned)b << 16); }
__device__ __forceinline__ float ex2(float x) { return __builtin_amdgcn_exp2f(x); }
__device__ __forceinline__ float wave_sum(float v) {
#pragma unroll
    for (int o = 1; o < 64; o <<= 1) v += __shfl_xor(v, o);
    return v;
}

namespace fa {
constexpr int KSLOT = 12288, VSLOT = 8192;
constexpr int L_K = 0, L_V = 2 * KSLOT, L_WS = L_V + 2 * VSLOT, L_OST = L_WS + 8 * 64 * 4, L_BYTES = L_OST + 8 * 32 * 64 * 4;
constexpr int L_WS2 = L_V + 3 * VSLOT, L_CB2 = L_WS2 + 8 * 128 * 4, L_OST2 = L_CB2 + 512, L_QR2 = L_OST2 + 8 * 4096, L_BYTES2 = L_QR2 + 8 * 4096;
__device__ __forceinline__ int crow(int r, int hi) { return (r & 3) + 8 * (r >> 2) + 4 * hi; }
__device__ __forceinline__ void glds16(const void* gsrc, unsigned lds_dst) { unsigned keep;
    asm volatile("s_mov_b32 %0, m0\n\ts_mov_b32 m0, %2\n\ts_nop 0\n\tglobal_load_lds_dwordx4 %1, off\n\ts_mov_b32 m0, %0" : "=&s"(keep) : "v"(gsrc), "s"(lds_dst) : "memory"); }
#define FA_WAIT_BAR() asm volatile("s_waitcnt vmcnt(0) lgkmcnt(0)\n\ts_barrier" ::: "memory")
#define FA_SBAR() __builtin_amdgcn_sched_barrier(0)
template <int ND0> __device__ __forceinline__ void qkt(f32x16& p0, f32x16& p1, const LAS char* kp, const bf16x8* qr) {
    p0 = f32x16{}; p1 = f32x16{};
#pragma unroll
    for (int d0 = 0; d0 < ND0; ++d0) {
        const bf16x8 b0 = *(const LAS bf16x8*)(kp + d0 * 2048);
        const bf16x8 b1 = *(const LAS bf16x8*)(kp + d0 * 2048 + 512);
        p0 = __builtin_amdgcn_mfma_f32_32x32x16_bf16(b0, qr[d0], p0, 0, 0, 0); p1 = __builtin_amdgcn_mfma_f32_32x32x16_bf16(b1, qr[d0], p1, 0, 0, 0); }
}
__device__ __forceinline__ float max3f(float a, float b, float c) { float r; asm("v_max3_f32 %0, %1, %2, %3" : "=v"(r) : "v"(a), "v"(b), "v"(c)); return r; }
__device__ __forceinline__ float max2f(float a, float b) { float r; asm("v_max_f32_e32 %0, %1, %2" : "=v"(r) : "v"(a), "v"(b)); return r; }
__device__ __forceinline__ float rowmax_a(const f32x16& p0, const f32x16& p1) {
    float a = max3f(p0[0], p0[1], p1[0]), b = max3f(p0[2], p0[3], p1[1]); a = max3f(a, p1[2], p1[3]);
#pragma unroll
    for (int r = 4; r < 16; r += 4) { a = max3f(a, p0[r], p0[r + 1]); b = max3f(b, p0[r + 2], p0[r + 3]); a = max3f(a, p1[r], p1[r + 1]); b = max3f(b, p1[r + 2], p1[r + 3]); }
    const float m = max2f(a, b);
    auto rr = __builtin_amdgcn_permlane32_swap(__float_as_uint(m), __float_as_uint(m), false, false);
    return max2f(__uint_as_float(rr[0]), __uint_as_float(rr[1]));
}
__device__ __forceinline__ float rowmax(const f32x16& p0, const f32x16& p1) {
    float a = __builtin_fmaxf(p0[0], p1[0]);
#pragma unroll
    for (int r = 1; r < 16; ++r) a = __builtin_fmaxf(a, __builtin_fmaxf(p0[r], p1[r]));
    auto rr = __builtin_amdgcn_permlane32_swap(__float_as_uint(a), __float_as_uint(a), false, false);
    return __builtin_fmaxf(__uint_as_float(rr[0]), __uint_as_float(rr[1]));
}
__device__ __forceinline__ void pv(f32x16* o, int vb, bf16x8 pa0, bf16x8 pa1, bf16x8 pa2, bf16x8 pa3) {
#pragma unroll
    for (int d0 = 0; d0 < 2; ++d0) { s16x4 lo[4], hi[4];
#pragma unroll
        for (int ks = 0; ks < 4; ++ks) {
            asm volatile("ds_read_b64_tr_b16 %0,%1 offset:%c2" : "=&v"(lo[ks]) : "v"(vb), "i"(d0 * 4096 + ks * 1024) : "memory");
            asm volatile("ds_read_b64_tr_b16 %0,%1 offset:%c2" : "=&v"(hi[ks]) : "v"(vb), "i"(d0 * 4096 + ks * 1024 + 512) : "memory"); }
        asm volatile("s_waitcnt lgkmcnt(0)" ::: "memory"); FA_SBAR();
#define FA_PK(k) (bf16x8){lo[k][0], lo[k][1], lo[k][2], lo[k][3], hi[k][0], hi[k][1], hi[k][2], hi[k][3]}
        o[d0] = __builtin_amdgcn_mfma_f32_32x32x16_bf16(pa0, FA_PK(0), o[d0], 0, 0, 0);
        o[d0] = __builtin_amdgcn_mfma_f32_32x32x16_bf16(pa1, FA_PK(1), o[d0], 0, 0, 0);
        o[d0] = __builtin_amdgcn_mfma_f32_32x32x16_bf16(pa2, FA_PK(2), o[d0], 0, 0, 0);
        o[d0] = __builtin_amdgcn_mfma_f32_32x32x16_bf16(pa3, FA_PK(3), o[d0], 0, 0, 0);
#undef FA_PK
    }
}
struct Args { const bf16* Q; int qpitch, qcol; const bf16* K; int kpitch, kcol; const bf16* K2; const bf16* V; int vpitch, vcol; bf16* O; int ocol; const bf16* G; const float* CB; };
template <int MODE> __device__ __forceinline__ void unit(const Args& A, long rowbase, int qb, LAS char* lds, unsigned lds0) {
    constexpr int ND0 = MODE ? 6 : 4;
    const int tid = pg8::pg8_tid(), lane = tid & 63, r32 = lane & 31, hi = lane >> 5; const int wid = __builtin_amdgcn_readfirstlane(tid >> 6);
    const int q0 = qb * 256, NT = q0 / 64 + 4, nt_w = MODE ? (q0 / 64 + (wid >> 1) + 1) : NT;
    const bf16* Qw = A.Q + (rowbase + q0 + wid * 32 + r32) * A.qpitch + A.qcol + hi * 8;
    bf16x8 qr[ND0];
#pragma unroll
    for (int d0 = 0; d0 < ND0; ++d0) qr[d0] = *(const bf16x8*)(Qw + d0 * 16);
    const bf16* ksrc = A.K + (rowbase + lane) * A.kpitch + A.kcol + wid * 8;
    const bf16* ksrc2 = MODE ? A.K2 + (rowbase + lane) * 32 + (wid & 3) * 8 : nullptr;
    const bf16* vsrc = A.V + (rowbase + 16 * (wid & 3) + (lane >> 2)) * A.vpitch + A.vcol + (wid >> 2) * 32 + (lane & 3) * 8;
#define FA_DMA(t, slot) do { \
        glds16(ksrc + (long)(t) * 64 * A.kpitch, (unsigned)__builtin_amdgcn_readfirstlane(lds0 + L_K + (slot) * KSLOT + wid * 1024)); \
        if (MODE && wid < 4) glds16(ksrc2 + (long)(t) * 64 * 32, (unsigned)__builtin_amdgcn_readfirstlane(lds0 + L_K + (slot) * KSLOT + (8 + wid) * 1024)); \
        glds16(vsrc + (long)(t) * 64 * A.vpitch, (unsigned)__builtin_amdgcn_readfirstlane(lds0 + L_V + (slot) * VSLOT + wid * 1024)); } while (0)
    LAS float* wsf = (LAS float*)(lds + L_WS) + wid * 64;
    const int vb0 = (int)(lds0 + L_V) + ((lane >> 4) & 1) * 32 + (lane & 3) * 8 + (4 * hi + ((lane & 15) >> 2)) * 64;
    float m = -1e30f, l = 0.f; f32x16 o[2]; o[0] = f32x16{}; o[1] = f32x16{};
    FA_DMA(0, 0);
    for (int t = 0; t < NT; ++t) {
        FA_WAIT_BAR();
        if (t + 1 < NT) FA_DMA(t + 1, (t + 1) & 1);
        if (t < nt_w) {
            const int slot = t & 1;
            f32x16 p0, p1; qkt<ND0>(p0, p1, lds + L_K + slot * KSLOT + hi * 1024 + r32 * 16, qr);
            if (MODE == 0) {
                const float* cb = A.CB + t * 64 + 4 * hi;
#pragma unroll
                for (int g4 = 0; g4 < 4; ++g4) { const f32x4 b0 = *(const f32x4*)(cb + 8 * g4), b1 = *(const f32x4*)(cb + 32 + 8 * g4);
#pragma unroll
                    for (int i = 0; i < 4; ++i) { p0[4 * g4 + i] += b0[i]; p1[4 * g4 + i] += b1[i]; } }
                const int jb = t - (NT - 4);
                if (jb >= 0) { const int qrel = wid * 32 + r32, kb = 64 * jb + 4 * hi;
#pragma unroll
                    for (int r = 0; r < 16; ++r) { const int kv = kb + (r & 3) + 8 * (r >> 2); if (kv > qrel) p0[r] = -INFINITY; if (kv + 32 > qrel) p1[r] = -INFINITY; } }
            }
            const float rm = rowmax(p0, p1);
            const float mn = __builtin_fmaxf(m, rm), alpha = ex2(m - mn); m = mn;
            float sacc = 0.f;
#pragma unroll
            for (int r = 0; r < 16; ++r) { p0[r] = ex2(p0[r] - mn); p1[r] = ex2(p1[r] - mn); sacc += p0[r] + p1[r]; }
            l = l * alpha + sacc;
            if (hi == 0) wsf[r32] = alpha;
#pragma unroll
            for (int r = 0; r < 16; ++r) { const float a = wsf[crow(r, hi)]; o[0][r] *= a; o[1][r] *= a; }
            u32x4 pw0, pw1, pw2, pw3;
            pw0 = (u32x4){pk2(p0[0], p0[1]), pk2(p0[2], p0[3]), pk2(p0[4], p0[5]), pk2(p0[6], p0[7])};
            pw1 = (u32x4){pk2(p0[8], p0[9]), pk2(p0[10], p0[11]), pk2(p0[12], p0[13]), pk2(p0[14], p0[15])};
            pw2 = (u32x4){pk2(p1[0], p1[1]), pk2(p1[2], p1[3]), pk2(p1[4], p1[5]), pk2(p1[6], p1[7])};
            pw3 = (u32x4){pk2(p1[8], p1[9]), pk2(p1[10], p1[11]), pk2(p1[12], p1[13]), pk2(p1[14], p1[15])};
            FA_SBAR();
            pv(o, vb0 + slot * VSLOT, __builtin_bit_cast(bf16x8, pw0), __builtin_bit_cast(bf16x8, pw1), __builtin_bit_cast(bf16x8, pw2), __builtin_bit_cast(bf16x8, pw3));
        }
    }
    { auto rr = __builtin_amdgcn_permlane32_swap(__float_as_uint(l), __float_as_uint(l), false, false); l = __uint_as_float(rr[0]) + __uint_as_float(rr[1]); }
    if (hi == 0) wsf[32 + r32] = l;
    LAS float* stg = (LAS float*)(lds + L_OST) + wid * 2048;
#pragma unroll
    for (int r = 0; r < 16; ++r) { const int orow = crow(r, hi); const float rl = __builtin_amdgcn_rcpf(wsf[32 + orow]);
        stg[orow * 64 + r32] = o[0][r] * rl; stg[orow * 64 + 32 + r32] = o[1][r] * rl; }
    LDS_WAIT();
#pragma unroll
    for (int i = 0; i < 4; ++i) { const int row = i * 8 + (lane >> 3), ch = lane & 7; const long grow = rowbase + q0 + wid * 32 + row;
        f32x4 a = *(const LAS f32x4*)(stg + row * 64 + ch * 8), b = *(const LAS f32x4*)(stg + row * 64 + ch * 8 + 4);
        if (MODE == 0) { const u32x4 g = *(const u32x4*)(A.G + grow * 1024 + A.ocol + ch * 8);
            a[0] *= __uint_as_float(g.x << 16); a[1] *= __uint_as_float(g.x & 0xffff0000u); a[2] *= __uint_as_float(g.y << 16); a[3] *= __uint_as_float(g.y & 0xffff0000u);
            b[0] *= __uint_as_float(g.z << 16); b[1] *= __uint_as_float(g.z & 0xffff0000u); b[2] *= __uint_as_float(g.w << 16); b[3] *= __uint_as_float(g.w & 0xffff0000u); }
        const u32x4 w = (u32x4){pk2(a[0], a[1]), pk2(a[2], a[3]), pk2(b[0], b[1]), pk2(b[2], b[3])};
        *(u32x4*)(A.O + grow * 1024 + A.ocol + ch * 8) = w; }
    asm volatile("s_waitcnt lgkmcnt(0)\n\ts_barrier" ::: "memory");
#undef FA_DMA
}

#ifndef FA_STAG_FOX
#define FA_STAG_FOX 1
#endif
#ifndef FA_STAG_MLA
#define FA_STAG_MLA 1
#endif
#ifndef FA_PROBE_VALU
#define FA_PROBE_VALU 0
#endif
__device__ __forceinline__ void glds4(const void* gsrc, unsigned lds_dst) { unsigned keep;
    asm volatile("s_mov_b32 %0, m0\n\ts_mov_b32 m0, %2\n\ts_nop 0\n\tglobal_load_lds_dword %1, off\n\ts_mov_b32 m0, %0" : "=&s"(keep) : "v"(gsrc), "s"(lds_dst) : "memory"); }
__device__ __forceinline__ s16x4 vtr(const LAS char* p) { typedef short v4i16_t __attribute__((ext_vector_type(4))); return __builtin_bit_cast(s16x4, __builtin_amdgcn_ds_read_tr16_b64_v4i16((LAS v4i16_t*)p)); }
template <int MODE, bool DIAG> __device__ __forceinline__ void tile_qs(const LAS char* kp, const bf16x8 (&qr)[2][4], const LAS char* qrl, const LAS float* cbl, int r32, int hi,
                                                                     float (&m)[2], float (&l)[2], f32x16 (&o)[2][2], LAS float* wsf, u32x4 (&pw)[2][4]) {
    constexpr int ND0 = MODE ? 6 : 4;
    f32x16 p[2][2];
    if (MODE == 0) {
#pragma unroll
        for (int g4 = 0; g4 < 4; ++g4) { const f32x4 b0 = *(const LAS f32x4*)(cbl + 4 * hi + 8 * g4), b1 = *(const LAS f32x4*)(cbl + 32 + 4 * hi + 8 * g4);
#pragma unroll
            for (int i = 0; i < 4; ++i) { p[0][0][4 * g4 + i] = b0[i]; p[0][1][4 * g4 + i] = b1[i]; } }
        p[1][0] = p[0][0]; p[1][1] = p[0][1];
    } else {
#pragma unroll
        for (int b2 = 0; b2 < 2; ++b2) { p[b2][0] = f32x16{}; p[b2][1] = f32x16{}; }
    }
    bf16x8 qx[2][2];
    if (MODE) {
#pragma unroll
        for (int b2 = 0; b2 < 2; ++b2) { qx[b2][0] = *(const LAS bf16x8*)(qrl + (b2 * 2) * 1024); qx[b2][1] = *(const LAS bf16x8*)(qrl + (b2 * 2 + 1) * 1024); } }
#pragma unroll
    for (int d0 = 0; d0 < ND0; ++d0) { const bf16x8 k0 = *(const LAS bf16x8*)(kp + d0 * 2048), k1 = *(const LAS bf16x8*)(kp + d0 * 2048 + 512);
#pragma unroll
        for (int b2 = 0; b2 < 2; ++b2) { const bf16x8 qv = (d0 < 4) ? qr[b2][d0 & 3] : qx[b2][d0 & 1];
            p[b2][0] = __builtin_amdgcn_mfma_f32_32x32x16_bf16(k0, qv, p[b2][0], 0, 0, 0); p[b2][1] = __builtin_amdgcn_mfma_f32_32x32x16_bf16(k1, qv, p[b2][1], 0, 0, 0); } }
    if (MODE == 0 && DIAG) {
#pragma unroll
        for (int b2 = 0; b2 < 2; ++b2) { const int qrel = 32 * b2 + r32;
#pragma unroll
            for (int r = 0; r < 16; ++r) { const int kv = 4 * hi + (r & 3) + 8 * (r >> 2); if (kv > qrel) p[b2][0][r] = -INFINITY; if (kv + 32 > qrel) p[b2][1][r] = -INFINITY; } } }
    asm volatile("s_nop 15\n\ts_nop 7" : "+v"(p[0][0]), "+v"(p[0][1]), "+v"(p[1][0]), "+v"(p[1][1]));
#if FA_PROBE_VALU
    { float dd[8];
#pragma unroll
      for (int i = 0; i < 8; ++i) dd[i] = m[0] + (float)i;
#pragma unroll
      for (int k = 0; k < FA_PROBE_VALU; ++k)
#pragma unroll
        for (int i = 0; i < 8; ++i) dd[i] = ex2(dd[i]);
#pragma unroll
      for (int i = 0; i < 8; ++i) asm volatile("" :: "v"(dd[i])); }
#endif
#pragma unroll
    for (int b2 = 0; b2 < 2; ++b2) {
        const float rm = rowmax_a(p[b2][0], p[b2][1]);
        const float mn = max2f(m[b2], rm); float alpha = m[b2] - mn; asm("v_exp_f32 %0, %0\n\ts_nop 0" : "+v"(alpha)); m[b2] = mn;
        float sa0 = 0.f, sa1 = 0.f;
#pragma unroll
        for (int r = 0; r < 16; r += 2) { float a = p[b2][0][r] - mn, b = p[b2][1][r] - mn, c = p[b2][0][r + 1] - mn, d = p[b2][1][r + 1] - mn;
            asm("v_exp_f32 %0, %0\n\tv_exp_f32 %1, %1\n\tv_exp_f32 %2, %2\n\tv_exp_f32 %3, %3\n\tv_add_f32 %4, %4, %0\n\tv_add_f32 %5, %5, %1\n\tv_add_f32 %4, %4, %2\n\tv_add_f32 %5, %5, %3"
                : "+v"(a), "+v"(b), "+v"(c), "+v"(d), "+v"(sa0), "+v"(sa1));
            p[b2][0][r] = a; p[b2][1][r] = b; p[b2][0][r + 1] = c; p[b2][1][r + 1] = d; }
        l[b2] = l[b2] * alpha + (sa0 + sa1);
#pragma unroll
        for (int r = 0; r < 16; ++r) { float t0 = o[b2][0][r], t1 = o[b2][1][r]; asm("v_mul_f32 %0, %0, %1" : "+v"(t0) : "v"(alpha)); asm("v_mul_f32 %0, %0, %1" : "+v"(t1) : "v"(alpha)); o[b2][0][r] = t0; o[b2][1][r] = t1; }
        pw[b2][0] = (u32x4){pk2(p[b2][0][0], p[b2][0][1]), pk2(p[b2][0][2], p[b2][0][3]), pk2(p[b2][0][4], p[b2][0][5]), pk2(p[b2][0][6], p[b2][0][7])};
        pw[b2][1] = (u32x4){pk2(p[b2][0][8], p[b2][0][9]), pk2(p[b2][0][10], p[b2][0][11]), pk2(p[b2][0][12], p[b2][0][13]), pk2(p[b2][0][14], p[b2][0][15])};
        pw[b2][2] = (u32x4){pk2(p[b2][1][0], p[b2][1][1]), pk2(p[b2][1][2], p[b2][1][3]), pk2(p[b2][1][4], p[b2][1][5]), pk2(p[b2][1][6], p[b2][1][7])};
        pw[b2][3] = (u32x4){pk2(p[b2][1][8], p[b2][1][9]), pk2(p[b2][1][10], p[b2][1][11]), pk2(p[b2][1][12], p[b2][1][13]), pk2(p[b2][1][14], p[b2][1][15])};
    }
    asm volatile("s_nop 1" : "+v"(o[0][0]), "+v"(o[0][1]), "+v"(o[1][0]), "+v"(o[1][1]));
}
__device__ __forceinline__ void tile_pv(const LAS char* vp, f32x16 (&o)[2][2], const u32x4 (&pw)[2][4]) {
#pragma unroll
    for (int d0 = 0; d0 < 2; ++d0)
#pragma unroll
        for (int ks = 0; ks < 4; ++ks) { const s16x4 lo = vtr(vp + d0 * 4096 + ks * 1024), hi4 = vtr(vp + d0 * 4096 + ks * 1024 + 512);
            const bf16x8 vf = (bf16x8){lo[0], lo[1], lo[2], lo[3], hi4[0], hi4[1], hi4[2], hi4[3]};
#pragma unroll
            for (int b2 = 0; b2 < 2; ++b2) o[b2][d0] = __builtin_amdgcn_mfma_f32_32x32x16_bf16(vf, __builtin_bit_cast(bf16x8, pw[b2][ks]), o[b2][d0], 0, 0, 0); }
}
template <int MODE> __device__ __forceinline__ void unit2(const Args& A, long rowbase, int qb, LAS char* lds, unsigned lds0) {
    constexpr int ND0 = MODE ? 6 : 4;
    const int tid = pg8::pg8_tid(), lane = tid & 63, r32 = lane & 31, hi = lane >> 5; const int wid = __builtin_amdgcn_readfirstlane(tid >> 6);
    const int q0 = qb * 512, NT = q0 / 64 + 8, nt_w = q0 / 64 + wid + 1;
    bf16x8 qr[2][4];
    LAS char* qrl = lds + L_QR2 + wid * 4096 + lane * 16;
#pragma unroll
    for (int b2 = 0; b2 < 2; ++b2) { const bf16* Qw = A.Q + (rowbase + q0 + wid * 64 + b2 * 32 + r32) * A.qpitch + A.qcol + hi * 8;
#pragma unroll
        for (int d0 = 0; d0 < 4; ++d0) qr[b2][d0] = *(const bf16x8*)(Qw + d0 * 16);
        if (MODE) { *(LAS bf16x8*)(qrl + (b2 * 2) * 1024) = *(const bf16x8*)(Qw + 64); *(LAS bf16x8*)(qrl + (b2 * 2 + 1) * 1024) = *(const bf16x8*)(Qw + 80); } }
    const int koff = lane * A.kpitch + A.kcol + wid * 8, k2off = lane * 32 + (wid & 3) * 8, voff = (16 * (wid & 3) + (lane >> 2)) * A.vpitch + A.vcol + (wid >> 2) * 32 + (lane & 3) * 8;
    const bf16* Kb = A.K + rowbase * A.kpitch; const bf16* K2b = MODE ? A.K2 + rowbase * 32 : nullptr; const bf16* Vb = A.V + rowbase * A.vpitch;
#define FA_DMA(t, slot) do { \
        int ko_ = koff, k2o_ = k2off, vo_ = voff; asm volatile("" : "+v"(ko_), "+v"(k2o_), "+v"(vo_)); \
        glds16(Kb + (long)(t) * 64 * A.kpitch + ko_, (unsigned)__builtin_amdgcn_readfirstlane(lds0 + L_K + (slot) * KSLOT + wid * 1024)); \
        if (MODE && wid < 4) glds16(K2b + (long)(t) * 64 * 32 + k2o_, (unsigned)__builtin_amdgcn_readfirstlane(lds0 + L_K + (slot) * KSLOT + (8 + wid) * 1024)); \
        glds16(Vb + (long)(t) * 64 * A.vpitch + vo_, (unsigned)__builtin_amdgcn_readfirstlane(lds0 + L_V + ((t) % 3) * VSLOT + wid * 1024)); \
        if (!MODE && wid == 4) glds4(A.CB + (t) * 64 + lane, (unsigned)__builtin_amdgcn_readfirstlane(lds0 + L_CB2 + (slot) * 256)); } while (0)
    LAS float* wsf = (LAS float*)(lds + L_WS2) + wid * 128;
    const LAS char* kp0 = lds + L_K + hi * 1024 + r32 * 16;
    const LAS char* vp0 = lds + L_V + ((lane >> 4) & 1) * 32 + (lane & 3) * 8 + (4 * hi + ((lane & 15) >> 2)) * 64;
    float m[2] = {-1e30f, -1e30f}, l[2] = {0.f, 0.f}; f32x16 o[2][2];
#pragma unroll
    for (int b2 = 0; b2 < 2; ++b2) { o[b2][0] = f32x16{}; o[b2][1] = f32x16{}; }
    FA_DMA(0, 0);
    u32x4 pw[2][4];
#define FA_STEP_HEAD(t) FA_WAIT_BAR(); if ((t) + 1 < NT) FA_DMA((t) + 1, ((t) + 1) & 1); const int slot = (t) & 1; const LAS float* cbl = (const LAS float*)(lds + L_CB2 + slot * 256)
    if (wid < 4 || !(MODE ? FA_STAG_MLA : FA_STAG_FOX)) {
        int t = 0;
        for (; t < nt_w - 1; ++t) { FA_STEP_HEAD(t); tile_qs<MODE, false>(kp0 + slot * KSLOT, qr, qrl, cbl, r32, hi, m, l, o, wsf, pw); tile_pv(vp0 + (t % 3) * VSLOT, o, pw); }
        { FA_STEP_HEAD(t); tile_qs<MODE, true>(kp0 + slot * KSLOT, qr, qrl, cbl, r32, hi, m, l, o, wsf, pw); tile_pv(vp0 + (t % 3) * VSLOT, o, pw); ++t; }
        for (; t < NT; ++t) { FA_STEP_HEAD(t); (void)slot; (void)cbl; }
    } else {
        int t = 0;
        if (nt_w > 1) { FA_STEP_HEAD(0); tile_qs<MODE, false>(kp0 + slot * KSLOT, qr, qrl, cbl, r32, hi, m, l, o, wsf, pw); t = 1;
            for (; t < nt_w - 1; ++t) { FA_STEP_HEAD(t); tile_pv(vp0 + ((t - 1) % 3) * VSLOT, o, pw); FA_SBAR(); tile_qs<MODE, false>(kp0 + slot * KSLOT, qr, qrl, cbl, r32, hi, m, l, o, wsf, pw); }
            { FA_STEP_HEAD(t); tile_pv(vp0 + ((t - 1) % 3) * VSLOT, o, pw); FA_SBAR(); tile_qs<MODE, true>(kp0 + slot * KSLOT, qr, qrl, cbl, r32, hi, m, l, o, wsf, pw); ++t; }
        } else { FA_STEP_HEAD(0); tile_qs<MODE, true>(kp0 + slot * KSLOT, qr, qrl, cbl, r32, hi, m, l, o, wsf, pw); t = 1; }
        if (t < NT) { FA_STEP_HEAD(t); (void)slot; (void)cbl; tile_pv(vp0 + ((t - 1) % 3) * VSLOT, o, pw); ++t;
            for (; t < NT; ++t) { FA_STEP_HEAD(t); (void)slot; (void)cbl; } }
        else tile_pv(vp0 + ((NT - 1) % 3) * VSLOT, o, pw);
    }
#undef FA_STEP_HEAD
#pragma unroll
    for (int b2 = 0; b2 < 2; ++b2) {
        float lb = l[b2];
        { auto rr = __builtin_amdgcn_permlane32_swap(__float_as_uint(lb), __float_as_uint(lb), false, false); lb = __uint_as_float(rr[0]) + __uint_as_float(rr[1]); }
        const float rl = __builtin_amdgcn_rcpf(lb); const long grow = rowbase + q0 + wid * 64 + b2 * 32 + r32;
#pragma unroll
        for (int d0 = 0; d0 < 2; ++d0)
#pragma unroll
            for (int g4 = 0; g4 < 4; ++g4) { const int dc = A.ocol + 32 * d0 + 8 * g4 + 4 * hi;
                f32x4 v = (f32x4){o[b2][d0][4 * g4], o[b2][d0][4 * g4 + 1], o[b2][d0][4 * g4 + 2], o[b2][d0][4 * g4 + 3]} * rl;
                if (MODE == 0) { const u32x2 g = *(const u32x2*)(A.G + grow * 1024 + dc);
                    v[0] *= __uint_as_float(g.x << 16); v[1] *= __uint_as_float(g.x & 0xffff0000u); v[2] *= __uint_as_float(g.y << 16); v[3] *= __uint_as_float(g.y & 0xffff0000u); }
                *(u32x2*)(A.O + grow * 1024 + dc) = (u32x2){pk2(v[0], v[1]), pk2(v[2], v[3])}; }
    }
    asm volatile("s_waitcnt lgkmcnt(0)\n\ts_barrier" ::: "memory");
#undef FA_DMA
}
}

namespace a16 {
__device__ __forceinline__ f32x4 mfma16(bf16x8 a, bf16x8 b, f32x4 c) { return __builtin_amdgcn_mfma_f32_16x16x32_bf16(a, b, c, 0, 0, 0); }
template <int NQK, int NDB, class KL, class VL, class SF>
__device__ __forceinline__ void steps(int s0, int s1, const bf16x8 (&qf)[NQK], KL kload, VL vload, SF sfix, float& m, float& l, f32x4 (&o)[NDB], int lane) {
    const int g = lane >> 4;
    for (int s = s0; s < s1; ++s) {
        f32x4 sA = {0.f, 0.f, 0.f, 0.f}, sB = {0.f, 0.f, 0.f, 0.f};
#pragma unroll
        for (int d0 = 0; d0 < NQK; ++d0) { sA = mfma16(kload(s, 0, d0), qf[d0], sA); sB = mfma16(kload(s, 1, d0), qf[d0], sB); }
        sfix(s, sA, sB);
        float mx = __builtin_fmaxf(__builtin_fmaxf(__builtin_fmaxf(sA[0], sA[1]), __builtin_fmaxf(sA[2], sA[3])), __builtin_fmaxf(__builtin_fmaxf(sB[0], sB[1]), __builtin_fmaxf(sB[2], sB[3])));
        mx = __builtin_fmaxf(mx, __shfl_xor(mx, 16)); mx = __builtin_fmaxf(mx, __shfl_xor(mx, 32));
        const float mn = __builtin_fmaxf(m, mx), alpha = ex2(m - mn); m = mn;
        f32x4 pA, pB;
#pragma unroll
        for (int r = 0; r < 4; ++r) { pA[r] = ex2(sA[r] - mn); pB[r] = ex2(sB[r] - mn); }
        float ps = ((pA[0] + pA[1]) + (pA[2] + pA[3])) + ((pB[0] + pB[1]) + (pB[2] + pB[3]));
        ps += __shfl_xor(ps, 16); ps += __shfl_xor(ps, 32);
        l = l * alpha + ps;
        const float a0 = __shfl(alpha, 4 * g), a1 = __shfl(alpha, 4 * g + 1), a2 = __shfl(alpha, 4 * g + 2), a3 = __shfl(alpha, 4 * g + 3);
#pragma unroll
        for (int db = 0; db < NDB; ++db) { o[db][0] *= a0; o[db][1] *= a1; o[db][2] *= a2; o[db][3] *= a3; }
        const u32x4 pw = (u32x4){pk2(pA[0], pA[1]), pk2(pA[2], pA[3]), pk2(pB[0], pB[1]), pk2(pB[2], pB[3])};
        const bf16x8 pf = __builtin_bit_cast(bf16x8, pw);
#pragma unroll
        for (int db = 0; db < NDB; ++db) o[db] = mfma16(pf, vload(s, db), o[db]);
    }
}
__device__ __forceinline__ bf16x8 cvt8(f32x4 a, f32x4 b) { const u32x4 w = (u32x4){pk2(a[0], a[1]), pk2(a[2], a[3]), pk2(b[0], b[1]), pk2(b[2], b[3])}; return __builtin_bit_cast(bf16x8, w); }
__device__ __forceinline__ bf16x8 join8(u32x2 a, u32x2 b) { const u32x4 w = (u32x4){a.x, a.y, b.x, b.y}; return __builtin_bit_cast(bf16x8, w); }
}


namespace xa {
constexpr int TSZ = 16384, L_T = 0, L_WS = 2 * TSZ, L_OST = L_WS + 8 * 64 * 4, L_BYTES = L_OST + 8 * 2048;
#define XA_WAIT_BAR() asm volatile("s_waitcnt vmcnt(0) lgkmcnt(0)\n\ts_barrier" ::: "memory")
template <typename T> __device__ __forceinline__ const T* src_of(const T* Kh, const T* Vh, int pitch, int i, int ci) {
    return (i < 8) ? Kh + (size_t)(32 * i + (ci & 31)) * pitch + (ci >> 5) * 8 : Vh + (size_t)(ci >> 2) * pitch + 32 * (i - 8) + (ci & 3) * 8; }
template <bool F32SRC> __device__ __forceinline__ void unit(const void* Kh_, const void* Vh_, int pitch, const bf16* Q, bf16* O, size_t row0, int hcol, int nvalid_w0, bool only_w0, LAS char* lds, unsigned lds0) {
    const int tid = pg8::pg8_tid(), lane = tid & 63, r32 = lane & 31, hi = lane >> 5; const int wid = __builtin_amdgcn_readfirstlane(tid >> 6);
    const bool active = !only_w0 || wid == 0; const int nvalid = only_w0 ? (wid == 0 ? nvalid_w0 : 0) : 32;
    bf16x8 qr[16];
    { const bf16* Qw = Q + (row0 + wid * 32 + r32) * 1024 + hcol + hi * 8;
#pragma unroll
      for (int d0 = 0; d0 < 16; ++d0) qr[d0] = active ? *(const bf16x8*)(Qw + d0 * 16) : (bf16x8){0, 0, 0, 0, 0, 0, 0, 0}; }
    LAS float* wsf = (LAS float*)(lds + L_WS) + wid * 64;
    f32x4 st[2][2];
#define XA_ISSUE(i) do { if (F32SRC) { _Pragma("unroll") for (int c2 = 0; c2 < 2; ++c2) { const float* s = src_of<float>((const float*)Kh_, (const float*)Vh_, pitch, (i), tid + 512 * c2); st[c2][0] = *(const f32x4*)s; st[c2][1] = *(const f32x4*)(s + 4); } } \
        else { _Pragma("unroll") for (int c2 = 0; c2 < 2; ++c2) fa::glds16(src_of<bf16>((const bf16*)Kh_, (const bf16*)Vh_, pitch, (i), (2 * wid + c2) * 64 + lane), (unsigned)__builtin_amdgcn_readfirstlane(lds0 + L_T + ((i) & 1) * TSZ + (2 * wid + c2) * 1024)); } } while (0)
#define XA_COMMIT(i) do { if (F32SRC) { _Pragma("unroll") for (int c2 = 0; c2 < 2; ++c2) *(LAS u32x4*)(lds + L_T + ((i) & 1) * TSZ + (tid + 512 * c2) * 16) = \
        (u32x4){pk2(st[c2][0][0], st[c2][0][1]), pk2(st[c2][0][2], st[c2][0][3]), pk2(st[c2][1][0], st[c2][1][1]), pk2(st[c2][1][2], st[c2][1][3])}; } } while (0)
    XA_ISSUE(0); XA_COMMIT(0);
    f32x16 S[8];
#pragma unroll
    for (int t = 0; t < 8; ++t) {
        XA_WAIT_BAR(); XA_ISSUE(t + 1);
        const LAS char* kp = lds + L_T + (t & 1) * TSZ + hi * 512 + r32 * 16;
        S[t] = f32x16{};
#pragma unroll
        for (int d0 = 0; d0 < 16; ++d0) S[t] = __builtin_amdgcn_mfma_f32_32x32x16_bf16(*(const LAS bf16x8*)(kp + d0 * 1024), qr[d0], S[t], 0, 0, 0);
        XA_COMMIT(t + 1);
    }
    float mx = S[0][0];
#pragma unroll
    for (int t = 0; t < 8; ++t)
#pragma unroll
        for (int r = 0; r < 16; ++r) mx = __builtin_fmaxf(mx, S[t][r]);
    { auto rr = __builtin_amdgcn_permlane32_swap(__float_as_uint(mx), __float_as_uint(mx), false, false); mx = __builtin_fmaxf(__uint_as_float(rr[0]), __uint_as_float(rr[1])); }
    float l = 0.f; u32x4 pw[16];
#pragma unroll
    for (int t = 0; t < 8; ++t) {
#pragma unroll
        for (int r = 0; r < 16; ++r) { S[t][r] = ex2(S[t][r] - mx); l += S[t][r]; }
        pw[2 * t] = (u32x4){pk2(S[t][0], S[t][1]), pk2(S[t][2], S[t][3]), pk2(S[t][4], S[t][5]), pk2(S[t][6], S[t][7])};
        pw[2 * t + 1] = (u32x4){pk2(S[t][8], S[t][9]), pk2(S[t][10], S[t][11]), pk2(S[t][12], S[t][13]), pk2(S[t][14], S[t][15])}; }
    { auto rr = __builtin_amdgcn_permlane32_swap(__float_as_uint(l), __float_as_uint(l), false, false); l = __uint_as_float(rr[0]) + __uint_as_float(rr[1]); }
    if (hi == 0) wsf[r32] = l;
    float rli[16];
#pragma unroll
    for (int r = 0; r < 16; ++r) rli[r] = __builtin_amdgcn_rcpf(wsf[fa::crow(r, hi)]);
    const int vbl = (int)(lds0 + L_T) + ((lane >> 4) & 1) * 32 + (lane & 3) * 8 + (4 * hi + ((lane & 15) >> 2)) * 64;
    LAS bf16* stg = (LAS bf16*)(lds + L_OST) + wid * 1024;
#pragma unroll
    for (int db = 0; db < 8; ++db) {
        XA_WAIT_BAR(); if (db < 7) XA_ISSUE(8 + db + 1);
        const int vb = vbl + (db & 1) * TSZ;
        f32x16 o = f32x16{};
#pragma unroll
        for (int k4 = 0; k4 < 4; ++k4) { s16x4 vlo[4], vhi[4];
#pragma unroll
            for (int kk = 0; kk < 4; ++kk) {
                asm volatile("ds_read_b64_tr_b16 %0,%1 offset:%c2" : "=&v"(vlo[kk]) : "v"(vb), "i"((k4 * 4 + kk) * 1024) : "memory");
                asm volatile("ds_read_b64_tr_b16 %0,%1 offset:%c2" : "=&v"(vhi[kk]) : "v"(vb), "i"((k4 * 4 + kk) * 1024 + 512) : "memory"); }
            asm volatile("s_waitcnt lgkmcnt(0)" ::: "memory"); __builtin_amdgcn_sched_barrier(0);
#pragma unroll
            for (int kk = 0; kk < 4; ++kk) o = __builtin_amdgcn_mfma_f32_32x32x16_bf16(__builtin_bit_cast(bf16x8, pw[k4 * 4 + kk]),
                (bf16x8){vlo[kk][0], vlo[kk][1], vlo[kk][2], vlo[kk][3], vhi[kk][0], vhi[kk][1], vhi[kk][2], vhi[kk][3]}, o, 0, 0, 0); }
        if (db < 7) XA_COMMIT(8 + db + 1);
#pragma unroll
        for (int r = 0; r < 16; ++r) stg[fa::crow(r, hi) * 32 + r32] = (bf16)(pk2(o[r] * rli[r], 0.f) & 0xffffu);
        LDS_WAIT();
#pragma unroll
        for (int ps = 0; ps < 2; ++ps) { const int row = ps * 16 + (lane >> 2), ch = lane & 3;
            const u32x4 v = *(const LAS u32x4*)(stg + row * 32 + ch * 8);
            if (row < nvalid) *(u32x4*)(O + (row0 + wid * 32 + row) * 1024 + hcol + 32 * db + ch * 8) = v; }
        LDS_WAIT();
    }
    asm volatile("s_waitcnt lgkmcnt(0)\n\ts_barrier" ::: "memory");
#undef XA_ISSUE
#undef XA_COMMIT
}
}

namespace ms {
constexpr int KSZ = 18432, L_T = 0, L_WS = 2 * KSZ, L_OST = L_WS + 8 * 64 * 4, L_BYTES = L_OST + 8 * 4096;
constexpr int PROW = 264;
#define MS_WAIT_BAR() asm volatile("s_waitcnt lgkmcnt(0)\n\ts_barrier" ::: "memory")
__device__ __forceinline__ const float* ms_ksrc(const float* ckvb, const float* krb, int key, int c) {
    const size_t o0 = (size_t)key * 256 + c * 8, o1 = (size_t)key * 32 + (c - 32) * 8; const bool lat = c < 32; return (lat ? ckvb : krb) + (lat ? o0 : o1); }
template <int NK> __device__ __forceinline__ void unit(const float* ckvb, const float* krb, int kclamp, const bf16* QA, float* P, LAS char* lds, unsigned lds0) {
    const int tid = pg8::pg8_tid(), lane = tid & 63, r32 = lane & 31, hi = lane >> 5; const int wid = __builtin_amdgcn_readfirstlane(tid >> 6);
    const bf16* Qw = QA + (size_t)(wid * 32 + r32) * 288 + hi * 8;
    f32x4 st[2][3][2];
#define MS_SRC(i, ci) (((i) < 8) ? ms_ksrc(ckvb, krb, min(32 * (i) + ((ci) & 31), kclamp), (ci) >> 5) \
                                  : ckvb + (size_t)min((ci) >> 2, kclamp) * 256 + 32 * ((i) - 8) + ((ci) & 3) * 8)
#define MS_NCH(i) (((i) < 8) ? 1152 : 1024)
#define MS_ISSUE(i, set) do { _Pragma("unroll") for (int c2 = 0; c2 < 3; ++c2) { const int ci = min(tid + 512 * c2, MS_NCH(i) - 1); const float* s = MS_SRC(i, ci); st[(set) & 1][c2][0] = *(const f32x4*)s; st[(set) & 1][c2][1] = *(const f32x4*)(s + 4); } } while (0)
#define MS_COMMIT(i, slot) do { _Pragma("unroll") for (int c2 = 0; c2 < 3; ++c2) { const int ci = min(tid + 512 * c2, MS_NCH(i) - 1); *(LAS u32x4*)(lds + L_T + ((slot) & 1) * KSZ + ci * 16) = \
        (u32x4){pk2(st[(slot) & 1][c2][0][0], st[(slot) & 1][c2][0][1]), pk2(st[(slot) & 1][c2][0][2], st[(slot) & 1][c2][0][3]), pk2(st[(slot) & 1][c2][1][0], st[(slot) & 1][c2][1][1]), pk2(st[(slot) & 1][c2][1][2], st[(slot) & 1][c2][1][3])}; } } while (0)
    constexpr int FIRSTV = 8;
#define MS_TILE(q) (((q) < NK) ? (q) : FIRSTV + (q) - NK)
    MS_ISSUE(MS_TILE(0), 0); MS_COMMIT(MS_TILE(0), 0); MS_ISSUE(MS_TILE(1), 1);
    f32x16 S[NK];
#pragma unroll
    for (int t = 0; t < NK; ++t) {
        MS_WAIT_BAR(); MS_ISSUE(MS_TILE(t + 2), t + 2);
        const LAS char* kp = lds + L_T + (t & 1) * KSZ + hi * 512 + r32 * 16;
        S[t] = f32x16{}; const bf16* Qt = Qw; asm volatile("" : "+v"(Qt));
#pragma unroll
        for (int d0 = 0; d0 < 18; ++d0) { S[t] = __builtin_amdgcn_mfma_f32_32x32x16_bf16(*(const LAS bf16x8*)(kp + d0 * 1024), *(const bf16x8*)(Qt + d0 * 16), S[t], 0, 0, 0);
            if (d0 % 6 == 5) __builtin_amdgcn_sched_barrier(0); }
        MS_COMMIT(MS_TILE(t + 1), t + 1);
    }
    constexpr int VS0 = (NK & 1);
    if (NK == 1) {
#pragma unroll
        for (int r = 8; r < 16; ++r) S[0][r] = -INFINITY; }
    float mx = S[0][0];
#pragma unroll
    for (int t = 0; t < NK; ++t)
#pragma unroll
        for (int r = 0; r < 16; ++r) mx = __builtin_fmaxf(mx, S[t][r]);
    { auto rr = __builtin_amdgcn_permlane32_swap(__float_as_uint(mx), __float_as_uint(mx), false, false); mx = __builtin_fmaxf(__uint_as_float(rr[0]), __uint_as_float(rr[1])); }
    float l = 0.f; u32x4 pw[2 * NK];
#pragma unroll
    for (int t = 0; t < NK; ++t) {
#pragma unroll
        for (int r = 0; r < 16; ++r) { S[t][r] = ex2(S[t][r] - mx); l += S[t][r]; }
        pw[2 * t] = (u32x4){pk2(S[t][0], S[t][1]), pk2(S[t][2], S[t][3]), pk2(S[t][4], S[t][5]), pk2(S[t][6], S[t][7])};
        pw[2 * t + 1] = (u32x4){pk2(S[t][8], S[t][9]), pk2(S[t][10], S[t][11]), pk2(S[t][12], S[t][13]), pk2(S[t][14], S[t][15])}; }
    { auto rr = __builtin_amdgcn_permlane32_swap(__float_as_uint(l), __float_as_uint(l), false, false); l = __uint_as_float(rr[0]) + __uint_as_float(rr[1]); }
    float* Pw = P + (size_t)(wid * 32) * PROW;
    if (hi == 0) { Pw[(size_t)r32 * PROW + 256] = mx; Pw[(size_t)r32 * PROW + 257] = l; }
    LAS float* stg = (LAS float*)(lds + L_OST) + wid * 1024;
#pragma unroll
    for (int db = 0; db < 8; ++db) {
        MS_WAIT_BAR(); if (db < 6) MS_ISSUE(FIRSTV + db + 2, NK + db + 2);
        const int vb = (int)(lds0 + L_T) + ((VS0 + db) & 1) * KSZ + ((lane >> 4) & 1) * 32 + (lane & 3) * 8 + (4 * hi + ((lane & 15) >> 2)) * 64;
        f32x16 o = f32x16{};
#pragma unroll
        for (int k0 = 0; k0 < 2 * NK; k0 += 8) {
            constexpr int KB = (2 * NK < 8) ? 2 * NK : 8; s16x4 vlo[KB], vhi[KB];
#pragma unroll
            for (int kk = 0; kk < KB; ++kk) {
                asm volatile("ds_read_b64_tr_b16 %0,%1 offset:%c2" : "=&v"(vlo[kk]) : "v"(vb), "i"((k0 + kk) * 1024) : "memory");
                asm volatile("ds_read_b64_tr_b16 %0,%1 offset:%c2" : "=&v"(vhi[kk]) : "v"(vb), "i"((k0 + kk) * 1024 + 512) : "memory"); }
            asm volatile("s_waitcnt lgkmcnt(0)" ::: "memory"); __builtin_amdgcn_sched_barrier(0);
#pragma unroll
            for (int kk = 0; kk < KB; ++kk)
                o = __builtin_amdgcn_mfma_f32_32x32x16_bf16(__builtin_bit_cast(bf16x8, pw[k0 + kk]), (bf16x8){vlo[kk][0], vlo[kk][1], vlo[kk][2], vlo[kk][3], vhi[kk][0], vhi[kk][1], vhi[kk][2], vhi[kk][3]}, o, 0, 0, 0); }
#pragma unroll
        for (int r = 0; r < 16; ++r) stg[fa::crow(r, hi) * 32 + r32] = o[r];
        LDS_WAIT();
        { const int row = lane >> 1, cq = (lane & 1) * 16; float* dst = Pw + (size_t)row * PROW + 32 * db + cq;
#pragma unroll
          for (int k = 0; k < 4; ++k) *(f32x4*)(dst + 4 * k) = *(const LAS f32x4*)(stg + row * 32 + cq + 4 * k); }
        if (db < 7) MS_COMMIT(FIRSTV + db + 1, NK + db + 1);
        LDS_WAIT();
    }
    asm volatile("s_waitcnt lgkmcnt(0)\n\ts_barrier" ::: "memory");
#undef MS_SRC
#undef MS_ISSUE
#undef MS_COMMIT
#undef MS_NCH
#undef MS_TILE
}
}

constexpr int RING_OFF = 0, RING_BYTES = 131072;
constexpr int LDSCTL_OFF = RING_BYTES, MISC_OFF = LDSCTL_OFF + 320;
constexpr int LDS_BYTES = 147456;
constexpr int NWAVES = 8;
static_assert(fa::L_BYTES2 <= RING_BYTES && xa::L_BYTES <= RING_BYTES && ms::L_BYTES <= RING_BYTES, "attention LDS");

struct KArgs { const float* in[N_IN]; float* out; unsigned char* ws; int ph_lo, ph_hi; };
static_assert(sizeof(KArgs) == N_IN * 8 + 24, "KArgs has no padding");
typedef const __attribute__((address_space(4))) KArgs* KAP;
#define KA ((KAP)__builtin_amdgcn_kernarg_segment_ptr())

#define XB_TMO      128
#define XB_XCNT(j)  (256  + 64 * (j))
#define XB_XSUB(j)  (1280 + 64 * (j))
#define XB_XGEN(j)  (2304 + 64 * (j))
#define XB_TOP      3328
#define XB_TOPGEN   3392
#define XCD_BAR_WORDS 3456
#define XB_SPIN_CAP (1u << 18)

__device__ __forceinline__ unsigned xb_ld(unsigned* p)              { return __hip_atomic_load(p, __ATOMIC_RELAXED, __HIP_MEMORY_SCOPE_AGENT); }
__device__ __forceinline__ unsigned xb_add(unsigned* p, unsigned v) { return __hip_atomic_fetch_add(p, v, __ATOMIC_RELAXED, __HIP_MEMORY_SCOPE_AGENT); }
__device__ __forceinline__ unsigned xb_xcc_id() { return (unsigned)__builtin_amdgcn_s_getreg((3 << 11) | 20) & 0xFu; }
#define XB_SPIN(cond, bar) do { unsigned _sp = 0; while (cond) { __builtin_amdgcn_s_sleep(1); \
    if ((++_sp & 255u) == 0u) { if (xb_ld(&(bar)[XB_TMO])) break; if (_sp > XB_SPIN_CAP) { atomicAdd(&(bar)[XB_TMO], 1u); break; } } } } while (0)

struct XcdBarrier {
    unsigned* bar; unsigned x;
    volatile LAS unsigned* st;
};

__device__ __forceinline__ XcdBarrier xcd_barrier_post(unsigned* bar, volatile LAS unsigned* st) {
    XcdBarrier b; b.bar = bar; b.x = xb_xcc_id(); b.st = st;
    if (threadIdx.x == 0) (void)xb_add(&bar[XB_XCNT(b.x)], 1u);
    return b;
}
__device__ __forceinline__ void xcd_barrier_complete(unsigned* bar, unsigned x, unsigned& nloc, unsigned& nx) {
    const unsigned G = gridDim.x * gridDim.y * gridDim.z;
    unsigned sum, cnt, mine, sp = 0u;
    for (;;) {
        sum = 0u; cnt = 0u; mine = 0u;
#pragma unroll
        for (unsigned j = 0; j < 16; ++j) { const unsigned c = xb_ld(&bar[XB_XCNT(j)]); sum += c; cnt += (c > 0u) ? 1u : 0u; mine = (j == x) ? c : mine; }
        if (sum == G) break;
        __builtin_amdgcn_s_sleep(1);
        if ((++sp & 255u) == 0u) { if (xb_ld(&bar[XB_TMO])) break; if (sp > XB_SPIN_CAP) { atomicAdd(&bar[XB_TMO], 1u); break; } }
    }
    nloc = mine > 0u ? mine : 1u; nx = cnt > 0u ? cnt : 1u;
}

__device__ __forceinline__ void xcd_barrier(const XcdBarrier& b) {
    asm volatile("s_waitcnt vmcnt(0)" ::: "memory");
    __syncthreads();
    if (threadIdx.x == 0) {
        unsigned* bar = b.bar;
        __builtin_amdgcn_s_waitcnt(0);
        unsigned nloc = b.st[0], nx = b.st[1];
        if (nloc == 0u) { xcd_barrier_complete(bar, b.x, nloc, nx); b.st[0] = nloc; b.st[1] = nx; }
        const unsigned old = xb_add(&bar[XB_XSUB(b.x)], 1u);
        const unsigned gen = old / nloc;
        if (old + 1u == (gen + 1u) * nloc) {
            __builtin_amdgcn_fence(__ATOMIC_RELEASE, "agent");
            asm volatile("s_waitcnt vmcnt(0)" ::: "memory");
            const unsigned og = xb_add(&bar[XB_TOP], 1u);
            const unsigned tg = og / nx;
            if (og + 1u == (tg + 1u) * nx) xb_add(&bar[XB_TOPGEN], 1u);
            else XB_SPIN(xb_ld(&bar[XB_TOPGEN]) == tg, bar);
            __builtin_amdgcn_fence(__ATOMIC_ACQUIRE, "agent");
            xb_add(&bar[XB_XGEN(b.x)], 1u);
            asm volatile("s_waitcnt vmcnt(0)" ::: "memory");
        } else {
            XB_SPIN(xb_ld(&bar[XB_XGEN(b.x)]) == gen, bar);
            __builtin_amdgcn_fence(__ATOMIC_ACQUIRE, "agent");
            asm volatile("s_waitcnt vmcnt(0)" ::: "memory");
        }
    }
    __syncthreads();
}

struct Seg { const float* W; int ldw, c0, ncols, K; bf16* T; int ldt, r0; const float* g; };
__device__ __forceinline__ Seg get_seg(KAP a, unsigned char* ws, int idx) {
    Seg s; s.g = nullptr; s.r0 = 0; s.c0 = 0; s.ldw = 1024; s.ncols = 1024; s.K = 1024; s.ldt = 1024; s.W = nullptr; s.T = nullptr;
    if (idx < 4) { const int j = idx & 1; s.W = a->in[I_WFI] + (size_t)j * 1024 * 4112; s.ldw = 4112; s.T = (bf16*)(ws + WS_WFI) + (size_t)j * 4352 * 1024; s.g = a->in[I_GMIX] + (size_t)(2 * j) * 1024;
        if (idx < 2) { s.c0 = 0; s.ncols = 3072; s.r0 = 0; } else { s.c0 = 3088; s.ncols = 1024; s.r0 = 3072; } }
    else if (idx < 6) { const int j = idx - 4; s.W = a->in[I_WFO] + (size_t)j * 1024 * 1024; s.T = (bf16*)(ws + WS_WFO) + (size_t)j * 1024 * 1024; }
    else if (idx < 12) { const int e = idx - 6, j = e / 3, part = e % 3; s.W = a->in[I_WMA] + (size_t)j * 1024 * 672; s.ldw = 672; s.T = (bf16*)(ws + WS_WMA) + (size_t)j * 768 * 1024; s.g = a->in[I_GMIX] + (size_t)(2 * j + 1) * 1024;
        if (part == 0) { s.c0 = 384; s.ncols = 256; s.r0 = 0; } else if (part == 1) { s.c0 = 0; s.ncols = 384; s.r0 = 256; } else { s.c0 = 640; s.ncols = 32; s.r0 = 640; } }
    else if (idx < 14) { const int j = idx - 12; s.W = a->in[I_WMQB] + (size_t)j * 384 * 1536; s.ldw = 1536; s.ncols = 1536; s.K = 384; s.T = (bf16*)(ws + WS_WMQ) + (size_t)j * 1536 * 384; s.ldt = 384; s.g = a->in[I_GMQ] + (size_t)j * 384; }
    else if (idx < 18) { const int j = idx & 1; const bool raw = idx >= 16; s.W = a->in[I_WMKVB] + (size_t)j * 256 * 2048; s.ldw = 2048; s.ncols = 2048; s.K = 256; s.ldt = 256;
        s.T = (bf16*)(ws + (raw ? WS_WMKVR : WS_WMKV)) + (size_t)j * 2048 * 256; s.g = raw ? nullptr : a->in[I_GMKV] + (size_t)j * 256; }
    else if (idx < 20) { const int j = idx - 18; s.W = a->in[I_WMO] + (size_t)j * 1024 * 1024; s.T = (bf16*)(ws + WS_WMO) + (size_t)j * 1024 * 1024; }
    else if (idx < 24) { const int i = idx - 20; s.W = a->in[I_WXQ] + (size_t)i * 1024 * 1024; s.T = (bf16*)(ws + WS_WXQ) + (size_t)i * 1024 * 1024; s.g = a->in[I_GCROSS] + (size_t)i * 1024; }
    else if (idx < 28) { const int i = idx - 24; s.W = a->in[I_WXO] + (size_t)i * 1024 * 1024; s.T = (bf16*)(ws + WS_WXO) + (size_t)i * 1024 * 1024; }
    else if (idx < 32) { const int i = idx - 28; s.W = a->in[I_WXKV] + (size_t)i * 1024 * 2048; s.ldw = 2048; s.ncols = 2048; s.T = (bf16*)(ws + WS_WXKV) + (size_t)i * 2048 * 1024; s.g = a->in[I_GMEM] + (size_t)i * 1024; }
    else if (idx < 36) { const int i = idx - 32; s.W = a->in[I_WDN] + (size_t)i * 2816 * 1024; s.K = 2816; s.T = (bf16*)(ws + WS_WDN) + (size_t)i * 1024 * 2816; s.ldt = 2816; }
    else if (idx < 212) { const int e = idx - 36, i = e / 44, t = e % 44, pn = t >> 1, half = t & 1; s.W = a->in[I_WGU] + (size_t)i * 1024 * 5632; s.ldw = 5632; s.c0 = half * 2816 + 128 * pn; s.ncols = 128;
        s.T = (bf16*)(ws + WS_WGU) + (size_t)i * 5632 * 1024; s.r0 = 256 * pn + 128 * half; s.g = a->in[I_GFFN] + (size_t)i * 1024; }
    else { const int j = idx - 212; s.W = a->in[I_WFI] + (size_t)j * 1024 * 4112; s.ldw = 4112; s.c0 = 3072; s.ncols = 32; s.T = (bf16*)(ws + WS_WFI) + (size_t)j * 4352 * 1024; s.r0 = 4096; s.g = a->in[I_GMIX] + (size_t)(2 * j) * 1024; }
    return s;
}
constexpr int NSEG = 214;
__device__ __forceinline__ void tr_load(const Seg& s, int item, int lane, float (&v)[32]) {
    const int nnb = s.ncols / 32, kb = item / nnb, nb = item % nnb; const float* p = s.W + (size_t)(64 * kb + (lane >> 5)) * s.ldw + s.c0 + 32 * nb + (lane & 31);
#pragma unroll
    for (int i = 0; i < 32; ++i) v[i] = p[(size_t)(2 * i) * s.ldw];
}
__device__ __forceinline__ void tr_store(const Seg& s, int item, int lane, const float (&v)[32], LAS float* scr) {
    const int nnb = s.ncols / 32, kb = item / nnb, nb = item % nnb, k0 = 64 * kb, n0 = 32 * nb;
#pragma unroll
    for (int i = 0; i < 32; ++i) scr[(2 * i + (lane >> 5)) * 33 + (lane & 31)] = v[i];
    LDS_WAIT(); asm volatile("" ::: "memory");
    const int c = lane & 7; f32x4 g0 = (f32x4){1.f, 1.f, 1.f, 1.f}, g1 = g0;
    if (s.g) { g0 = *(const f32x4*)(s.g + k0 + 8 * c); g1 = *(const f32x4*)(s.g + k0 + 8 * c + 4); }
#pragma unroll
    for (int j = 0; j < 4; ++j) { const int n = (lane >> 3) + 8 * j; const LAS float* p = scr + (8 * c) * 33 + n;
        u32x4 o; o.x = pk2(p[0 * 33] * g0[0], p[1 * 33] * g0[1]); o.y = pk2(p[2 * 33] * g0[2], p[3 * 33] * g0[3]); o.z = pk2(p[4 * 33] * g1[0], p[5 * 33] * g1[1]); o.w = pk2(p[6 * 33] * g1[2], p[7 * 33] * g1[3]);
        *(u32x4*)(s.T + (size_t)(s.r0 + n0 + n) * s.ldt + k0 + 8 * c) = o; }
    LDS_WAIT(); asm volatile("" ::: "memory");
}
__device__ __forceinline__ void cvt_blocks(const float* src, bf16* dst, int nblk, int blk, size_t dstride, int gtid, int nthr) {
    const long total = (long)nblk * blk / 8;
    for (long v = gtid; v < total; v += nthr) { const long e = v * 8; const int b = (int)(e / blk), o = (int)(e % blk);
        const f32x4 x = *(const f32x4*)(src + e), y = *(const f32x4*)(src + e + 4);
        *(u32x4*)(dst + (size_t)b * dstride + o) = (u32x4){pk2(x[0], x[1]), pk2(x[2], x[3]), pk2(y[0], y[1]), pk2(y[2], y[3])}; }
}
__device__ __forceinline__ void p0_prologue(KAP a, LAS unsigned char* lds, int gw, int NGW, int wave, int lane, int pmask) {
    unsigned char* ws = a->ws; const int gtid = gw * 64 + lane, nthr = NGW * 64;
    LAS float* scr = (LAS float*)(lds + RING_OFF + wave * 16384);
#undef P0_PARTS
#define P0_PARTS pmask
    if (P0_PARTS & 1) {
        int total = 0;
        for (int sg = 0; sg < NSEG; ++sg) { const Seg s = get_seg(a, ws, sg); total += (s.K / 64) * (s.ncols / 32); }
        int sg = 0, base = 0; Seg sc = get_seg(a, ws, 0); int nit = (sc.K / 64) * (sc.ncols / 32);
#define P0_ADVANCE(gi) while ((gi) >= base + nit) { base += nit; ++sg; sc = get_seg(a, ws, sg); nit = (sc.K / 64) * (sc.ncols / 32); }
        float va[32], vb[32]; Seg sa = sc, sb = sc; int ia = 0, ib = 0;
        int gi = gw;
        if (gi < total) { P0_ADVANCE(gi); sa = sc; ia = gi - base; tr_load(sa, ia, lane, va); }
        while (gi < total) {
            int gn = gi + NGW;
            if (gn < total) { P0_ADVANCE(gn); sb = sc; ib = gn - base; tr_load(sb, ib, lane, vb); }
            tr_store(sa, ia, lane, va, scr);
            gi = gn; if (gi >= total) break;
            gn = gi + NGW;
            if (gn < total) { P0_ADVANCE(gn); sa = sc; ia = gn - base; tr_load(sa, ia, lane, va); }
            tr_store(sb, ib, lane, vb, scr);
            gi = gn;
        }
#undef P0_ADVANCE
    }
    if (P0_PARTS & 2) {
    cvt_blocks(a->in[I_WMKVB], (bf16*)(ws + WS_WKN), 1, 2 * 256 * 2048, 0, gtid, nthr); }
    if (P0_PARTS & 4) { const u32x4 z = (u32x4){0u, 0u, 0u, 0u};
      for (int v = gtid; v < 2 * 224 * 128; v += nthr) { const int j = v / (224 * 128), r = v % (224 * 128); *(u32x4*)((bf16*)(ws + WS_WFI) + ((size_t)j * 4352 + 4128) * 1024 + (size_t)r * 8) = z; }
      for (int v = gtid; v < 2 * 96 * 128; v += nthr) { const int j = v / (96 * 128), r = v % (96 * 128); *(u32x4*)((bf16*)(ws + WS_WMA) + ((size_t)j * 768 + 672) * 1024 + (size_t)r * 8) = z; }
    }
    if (P0_PARTS & 16) for (int v = gtid; v < 4096 * 16; v += nthr) { const int pos = v >> 4, c = v & 15; const double inv = pow(10000.0, -(double)c / 16.0), ang = (double)pos * inv;
        ((float*)(ws + WS_ROPC))[v] = (float)cos(ang); ((float*)(ws + WS_ROPS))[v] = (float)sin(ang); }
    if (P0_PARTS & 32) for (int row = gw; row < MT; row += NGW) { const float* xr = (row < MP) ? a->in[I_XP] + (size_t)row * 1024 : a->in[I_XS] + (size_t)(row - MP) * 1024;
        float sq = 0.f; bf16* o = (bf16*)(ws + WS_XB) + (size_t)row * 1024;
#pragma unroll
        for (int j = 0; j < 4; ++j) { const f32x4 v = *(const f32x4*)(xr + 256 * j + 4 * lane); sq += pg8::dot4(v); *(u32x2*)(o + 256 * j + 4 * lane) = pg8::pk4(v); }
        sq = wave_sum(sq);
        if (lane < 16) ((float*)(ws + WS_SSQ))[(size_t)row * 16 + lane] = (lane == 0) ? sq : 0.f; }
    if (P0_PARTS & 64) for (int row = gw; row < 2048; row += NGW) { const float* xr = a->in[I_MEM] + (size_t)row * 1024; f32x4 v[4]; float sq = 0.f;
#pragma unroll
        for (int j = 0; j < 4; ++j) { v[j] = *(const f32x4*)(xr + 256 * j + 4 * lane); sq += pg8::dot4(v[j]); }
        const float r = rsqrtf(wave_sum(sq) * (1.0f / 1024.0f) + EPS); bf16* o = (bf16*)(ws + WS_MB) + (size_t)row * 1024;
#pragma unroll
        for (int j = 0; j < 4; ++j) *(u32x2*)(o + 256 * j + 4 * lane) = pg8::pk4(v[j] * r); }
}

__device__ __forceinline__ float ssq_rstd16(const float* ssq, int row) {
    const f32x4 a = *(const f32x4*)(ssq + (size_t)row * 16), b = *(const f32x4*)(ssq + (size_t)row * 16 + 4), c = *(const f32x4*)(ssq + (size_t)row * 16 + 8), d = *(const f32x4*)(ssq + (size_t)row * 16 + 12);
    const float s = ((a[0] + a[1]) + (a[2] + a[3])) + ((b[0] + b[1]) + (b[2] + b[3])) + ((c[0] + c[1]) + (c[2] + c[3])) + ((d[0] + d[1]) + (d[2] + d[3]));
    return rsqrtf(s * (1.0f / 1024.0f) + EPS);
}
__device__ __forceinline__ void cum_local_prompt(KAP a, int bh, LAS float* red, int wave, int lane) {
    unsigned char* ws = a->ws; const float* lfr = (const float*)(ws + WS_LFR); const int b = bh >> 4, h = bh & 15; float* cb = (float*)(ws + WS_CB) + (size_t)bh * 4096;
    float v[8];
#pragma unroll
    for (int k = 0; k < 8; ++k) v[k] = lfr[((size_t)b * 4096 + 512 * wave + 64 * k + lane) * 16 + h];
    float carry = 0.f;
#pragma unroll
    for (int k = 0; k < 8; ++k) {
#pragma unroll
        for (int o = 1; o < 64; o <<= 1) { const float y = __shfl_up(v[k], o); if (lane >= o) v[k] += y; }
        v[k] += carry; carry = __shfl(v[k], 63); }
    if (lane == 0) red[wave] = carry;
    __syncthreads();
    float off = 0.f;
#pragma unroll
    for (int w = 0; w < 7; ++w) off += (w < wave) ? red[w] : 0.f;
#pragma unroll
    for (int k = 0; k < 8; ++k) cb[512 * wave + 64 * k + lane] = -(v[k] + off) * LOG2E;
    VM_WAIT(); __syncthreads();
}
__device__ __forceinline__ void cum_local_sample(KAP a, int L, int pair, LAS float* red, int wave, int lane) {
    unsigned char* ws = a->ws; const float* lfr = (const float*)(ws + WS_LFR); const int bs = pair >> 4, h = pair & 15;
    const float* lfc = a->in[I_CFL] + (size_t)L * 32 * 2048 * 16; float* cb = (float*)(ws + WS_CBS) + (size_t)pair * 2080;
    float x[4], v[4];
#pragma unroll
    for (int k = 0; k < 4; ++k) x[k] = lfc[((size_t)bs * 2048 + 256 * wave + 64 * k + lane) * 16 + h];
    float carry = 0.f;
#pragma unroll
    for (int k = 3; k >= 0; --k) { float t = x[k];
#pragma unroll
        for (int o = 1; o < 64; o <<= 1) { const float y = __shfl_down(t, o); if (lane + o < 64) t += y; }
        v[k] = carry + t - x[k]; carry += __shfl(t, 0); }
    if (lane == 0) red[wave] = carry;
    __syncthreads();
    float off = 0.f;
#pragma unroll
    for (int w = 1; w < 8; ++w) off += (w > wave) ? red[w] : 0.f;
#pragma unroll
    for (int k = 0; k < 4; ++k) cb[256 * wave + 64 * k + lane] = (v[k] + off) * LOG2E;
    if (wave == 0) { float t = (lane < 16) ? lfr[((size_t)MP + bs * 16 + lane) * 16 + h] : 0.f;
#pragma unroll
        for (int o = 1; o < 16; o <<= 1) { const float y = __shfl_up(t, o); if (lane >= o) t += y; }
        if (lane < 32) cb[2048 + lane] = (lane < 16) ? -t * LOG2E : 0.f; }
    VM_WAIT(); __syncthreads();
}
__device__ __forceinline__ void ckv_fixup(KAP a, int L, int gw, int NGW, int lane) {
    unsigned char* ws = a->ws; const f32x4 g = *(const f32x4*)(a->in[I_GMKV] + (size_t)L * 256 + 4 * lane);
    for (int row0 = gw; row0 < MT; row0 += 4 * NGW) { f32x4 s4[4], v[4];
#pragma unroll
        for (int i = 0; i < 4; ++i) { const int row = (row0 + i * NGW < MT) ? row0 + i * NGW : row0; s4[i] = *(const f32x4*)((const float*)(ws + WS_SSQKV) + (size_t)row * 4);
            v[i] = *(const f32x4*)((const float*)(ws + WS_CKVU) + (size_t)row * 256 + 4 * lane); }
#pragma unroll
        for (int i = 0; i < 4; ++i) { const int row = row0 + i * NGW; if (row < MT) { const float r = rsqrtf(((s4[i][0] + s4[i][1]) + (s4[i][2] + s4[i][3])) * (1.0f / 256.0f) + EPS); const f32x4 o = v[i] * r * g;
            if (row < MP) *(f32x4*)(a->out + O_MCP + ((size_t)L * MP + row) * 256 + 4 * lane) = o;
            else *(f32x4*)(a->out + O_MCS + ((size_t)L * MS + (row - MP)) * 256 + 4 * lane) = o; } } }
}
__device__ __forceinline__ void final_phase(KAP a, int gw, int NGW, int lane) {
    f32x4 g[4];
#pragma unroll
    for (int j = 0; j < 4; ++j) g[j] = *(const f32x4*)(a->in[I_GFINAL] + 256 * j + 4 * lane);
    for (int row0 = gw; row0 < MT; row0 += 4 * NGW) { float r[4]; u32x2 w[4][4];
#pragma unroll
        for (int i = 0; i < 4; ++i) { const int row = (row0 + i * NGW < MT) ? row0 + i * NGW : row0; r[i] = ssq_rstd16((const float*)(a->ws + WS_SSQ), row); const bf16* x = (const bf16*)(a->ws + WS_XB) + (size_t)row * 1024;
#pragma unroll
            for (int j = 0; j < 4; ++j) w[i][j] = *(const u32x2*)(x + 256 * j + 4 * lane); }
#pragma unroll
        for (int i = 0; i < 4; ++i) { const int row = row0 + i * NGW; if (row < MT) { float* y = a->out + (size_t)row * 1024;
#pragma unroll
            for (int j = 0; j < 4; ++j) { const f32x4 xv = (f32x4){__builtin_bit_cast(float, w[i][j].x << 16), __builtin_bit_cast(float, w[i][j].x & 0xffff0000u), __builtin_bit_cast(float, w[i][j].y << 16), __builtin_bit_cast(float, w[i][j].y & 0xffff0000u)};
                *(f32x4*)(y + 256 * j + 4 * lane) = xv * r[i] * g[j]; } } } }
}

__device__ __forceinline__ void foxs_item(KAP a, int L, int it, LAS unsigned char* lds, int wid, int lane) {
    unsigned char* ws = a->ws; const int pair = it * 2 + (wid >> 2), b = pair >> 4, h = pair & 15, sp = wid & 3, g = lane >> 4, li = lane & 15;
    const float* ck = a->in[I_CFK] + (size_t)L * 32 * 2048 * 1024 + ((size_t)b * 2048 * 16 + h) * 64;
    const float* cv = a->in[I_CFV] + (size_t)L * 32 * 2048 * 1024 + ((size_t)b * 2048 * 16 + h) * 64;
    const float* cbs = (const float*)(ws + WS_CBS) + (size_t)pair * 2080;
    const bf16* QF = (const bf16*)(ws + WS_QF); const bf16* KF = (const bf16*)(ws + WS_KF); const bf16* VF = (const bf16*)(ws + WS_VF);
    const size_t srow = (size_t)MP + b * 16;
    bf16x8 qf[2];
#pragma unroll
    for (int d0 = 0; d0 < 2; ++d0) qf[d0] = *(const bf16x8*)(QF + (srow + li) * 1024 + h * 64 + 32 * d0 + 8 * g);
    float m = -1e30f, l = 0.f; f32x4 o[4];
#pragma unroll
    for (int db = 0; db < 4; ++db) o[db] = (f32x4){0.f, 0.f, 0.f, 0.f};
    const int kv0 = 512 * sp;
    auto kl = [&](int s, int blk, int d0) -> bf16x8 { const float* p = ck + (size_t)(kv0 + 32 * s + 16 * blk + li) * 1024 + 32 * d0 + 8 * g; return a16::cvt8(*(const f32x4*)p, *(const f32x4*)(p + 4)); };
    auto vl = [&](int s, int db) -> bf16x8 { const float* p = cv + (size_t)(kv0 + 32 * s + 4 * g) * 1024 + 16 * db + li;
        const f32x4 x = (f32x4){p[0], p[1024], p[2048], p[3072]}, y = (f32x4){p[16 * 1024], p[17 * 1024], p[18 * 1024], p[19 * 1024]}; return a16::cvt8(x, y); };
    auto sf = [&](int s, f32x4& sA, f32x4& sB) { const float* p = cbs + kv0 + 32 * s + 4 * g; sA += *(const f32x4*)p; sB += *(const f32x4*)(p + 16); };
    {
        auto kraw = [&](int s, f32x4 (&kr)[8]) {
#pragma unroll
            for (int blk = 0; blk < 2; ++blk)
#pragma unroll
                for (int d0 = 0; d0 < 2; ++d0) { const float* p = ck + (size_t)(kv0 + 32 * s + 16 * blk + li) * 1024 + 32 * d0 + 8 * g; kr[(blk * 2 + d0) * 2] = *(const f32x4*)p; kr[(blk * 2 + d0) * 2 + 1] = *(const f32x4*)(p + 4); } };
        auto vraw = [&](int s, f32x4 (&vr)[8]) {
#pragma unroll
            for (int db = 0; db < 4; ++db) { const float* p = cv + (size_t)(kv0 + 32 * s + 4 * g) * 1024 + 16 * db + li;
                vr[2 * db] = (f32x4){p[0], p[1024], p[2048], p[3072]}; vr[2 * db + 1] = (f32x4){p[16 * 1024], p[17 * 1024], p[18 * 1024], p[19 * 1024]}; } };
        auto step = [&](int s, const f32x4 (&kc)[8], const f32x4 (&vc)[8]) {
            f32x4 sA = {0.f, 0.f, 0.f, 0.f}, sB = {0.f, 0.f, 0.f, 0.f};
#pragma unroll
            for (int d0 = 0; d0 < 2; ++d0) { sA = a16::mfma16(a16::cvt8(kc[d0 * 2], kc[d0 * 2 + 1]), qf[d0], sA); sB = a16::mfma16(a16::cvt8(kc[(2 + d0) * 2], kc[(2 + d0) * 2 + 1]), qf[d0], sB); }
            sf(s, sA, sB);
            float mx = __builtin_fmaxf(__builtin_fmaxf(__builtin_fmaxf(sA[0], sA[1]), __builtin_fmaxf(sA[2], sA[3])), __builtin_fmaxf(__builtin_fmaxf(sB[0], sB[1]), __builtin_fmaxf(sB[2], sB[3])));
            mx = __builtin_fmaxf(mx, __shfl_xor(mx, 16)); mx = __builtin_fmaxf(mx, __shfl_xor(mx, 32));
            const float mn = __builtin_fmaxf(m, mx), alpha = ex2(m - mn); m = mn;
            f32x4 pA, pB;
#pragma unroll
            for (int r = 0; r < 4; ++r) { pA[r] = ex2(sA[r] - mn); pB[r] = ex2(sB[r] - mn); }
            float ps = ((pA[0] + pA[1]) + (pA[2] + pA[3])) + ((pB[0] + pB[1]) + (pB[2] + pB[3]));
            ps += __shfl_xor(ps, 16); ps += __shfl_xor(ps, 32);
            l = l * alpha + ps;
            const float a0 = __shfl(alpha, 4 * g), a1 = __shfl(alpha, 4 * g + 1), a2 = __shfl(alpha, 4 * g + 2), a3 = __shfl(alpha, 4 * g + 3);
#pragma unroll
            for (int db = 0; db < 4; ++db) { o[db][0] *= a0; o[db][1] *= a1; o[db][2] *= a2; o[db][3] *= a3; }
            const u32x4 pw = (u32x4){pk2(pA[0], pA[1]), pk2(pA[2], pA[3]), pk2(pB[0], pB[1]), pk2(pB[2], pB[3])};
            const bf16x8 pf = __builtin_bit_cast(bf16x8, pw);
#pragma unroll
            for (int db = 0; db < 4; ++db) o[db] = a16::mfma16(pf, a16::cvt8(vc[2 * db], vc[2 * db + 1]), o[db]); };
        f32x4 ka[8], va[8], kb[8], vb[8]; kraw(0, ka); vraw(0, va);
#pragma unroll 1
        for (int s = 0; s < 16; s += 2) {
            kraw(s + 1, kb); vraw(s + 1, vb);
            step(s, ka, va);
            const int sn = (s < 14) ? s + 2 : 15; kraw(sn, ka); vraw(sn, va);
            step(s + 1, kb, vb);
        }
    }
    if (sp == 3) {
        auto kl2 = [&](int, int blk, int d0) -> bf16x8 { bf16x8 z = {0, 0, 0, 0, 0, 0, 0, 0}; if (blk == 0) z = *(const bf16x8*)(KF + (srow + li) * 1024 + h * 64 + 32 * d0 + 8 * g); return z; };
        auto vl2 = [&](int, int db) -> bf16x8 { const bf16* p = VF + (srow + 4 * g) * 1024 + h * 64 + 16 * db + li;
            const u32x4 w = (u32x4){(unsigned)p[0] | ((unsigned)p[1024] << 16), (unsigned)p[2048] | ((unsigned)p[3072] << 16), 0u, 0u}; return __builtin_bit_cast(bf16x8, w); };
        auto sf2 = [&](int, f32x4& sA, f32x4& sB) { const f32x4 bb = *(const f32x4*)(cbs + 2048 + 4 * g);
#pragma unroll
            for (int r = 0; r < 4; ++r) { sA[r] = (4 * g + r > li) ? -INFINITY : sA[r] + bb[r]; sB[r] = -INFINITY; } };
        a16::steps<2, 4>(0, 1, qf, kl2, vl2, sf2, m, l, o, lane);
    }
    LAS float* PO = (LAS float*)(lds + RING_OFF) + wid * 1024; LAS float* PM = (LAS float*)(lds + RING_OFF + 32768) + wid * 32;
#pragma unroll
    for (int db = 0; db < 4; ++db)
#pragma unroll
        for (int r = 0; r < 4; ++r) PO[(4 * g + r) * 64 + 16 * db + li] = o[db][r];
    if (g == 0) { PM[li] = m; PM[16 + li] = l; }
    __syncthreads();
    {
        const int w0 = (wid >> 2) * 4, db = wid & 3; const bf16* GF = (const bf16*)(ws + WS_GF); bf16* OF = (bf16*)(ws + WS_OM);
#pragma unroll
        for (int r = 0; r < 4; ++r) { const int q = 4 * g + r; float mm = -1e30f;
#pragma unroll
            for (int s2 = 0; s2 < 4; ++s2) mm = __builtin_fmaxf(mm, ((LAS float*)(lds + RING_OFF + 32768) + (w0 + s2) * 32)[q]);
            float num = 0.f, den = 0.f;
#pragma unroll
            for (int s2 = 0; s2 < 4; ++s2) { LAS float* pm = (LAS float*)(lds + RING_OFF + 32768) + (w0 + s2) * 32; const float wgt = ex2(pm[q] - mm);
                num += wgt * ((LAS float*)(lds + RING_OFF) + (w0 + s2) * 1024)[q * 64 + 16 * db + li]; den += wgt * pm[16 + q]; }
            const size_t idx = (srow + q) * 1024 + h * 64 + 16 * db + li;
            OF[idx] = (bf16)(pk2(num / den * bf2f(GF[idx]), 0.f) & 0xffffu); }
    }
    __syncthreads();
}
__device__ __forceinline__ void mlas_qprime(KAP a, int L, int it, LAS unsigned char* lds, int wid, int lane) {
    unsigned char* ws = a->ws; const int b = (it < 256) ? (it >> 3) : (it - 256), c = (it < 256) ? (it & 7) : 8, g = lane >> 4, li = lane & 15;
    const bf16* QM = (const bf16*)(ws + WS_QM); const bf16* WKN = (const bf16*)(ws + WS_WKN) + (size_t)L * 256 * 2048;
    bf16* QA = (bf16*)(ws + WS_QA) + (size_t)it * 256 * 288;
    LAS bf16* scr = (LAS bf16*)(lds + RING_OFF + wid * 9216);
    for (int hh = 0; hh < 2; ++hh) { const int h = 2 * wid + hh; const bf16* qrow = QM + ((size_t)MP + b * 16 + li) * 1536 + h * 96; bf16* qa = QA + (size_t)(wid * 32 + hh * 16) * 288;
        const bf16x8 qn0 = *(const bf16x8*)(qrow + 8 * g), qn1 = *(const bf16x8*)(qrow + 32 + 8 * g);
#pragma unroll
        for (int cb = 0; cb < 16; ++cb) { const bf16* wp = WKN + (size_t)(16 * cb + li) * 2048 + h * 128 + 8 * g;
            f32x4 acc = a16::mfma16(qn0, *(const bf16x8*)wp, (f32x4){0.f, 0.f, 0.f, 0.f}); acc = a16::mfma16(qn1, *(const bf16x8*)(wp + 32), acc);
#pragma unroll
            for (int r = 0; r < 4; ++r) scr[(4 * g + r) * 288 + 16 * cb + li] = (bf16)(pk2(acc[r], 0.f) & 0xffffu); }
        *(LAS bf16x8*)(scr + li * 288 + 256 + 8 * g) = *(const bf16x8*)(qrow + 64 + 8 * g);
        LDS_WAIT();
#pragma unroll
        for (int j = 0; j < 9; ++j) *(u32x4*)(qa + (size_t)(lane + 64 * j) * 8) = *(const LAS u32x4*)(scr + (lane + 64 * j) * 8);
        LDS_WAIT(); }
    VM_WAIT(); __syncthreads();
}
__device__ __forceinline__ void mlas_attn(KAP a, int L, int it, int qa_it, LAS unsigned char* lds, unsigned lds0) {
    unsigned char* ws = a->ws; const int b = (it < 256) ? (it >> 3) : (it - 256), c = (it < 256) ? (it & 7) : 8; const bf16* QA = (const bf16*)(ws + WS_QA) + (size_t)qa_it * 256 * 288;
    float* P = (float*)(ws + WS_PART) + ((size_t)(b * 9 + c) * 256) * ms::PROW;
    if (c < 8) { const size_t jb = (size_t)L * 32 + b;
        ms::unit<8>(a->in[I_CCKV] + (jb * 2048 + 256 * c) * 256, a->in[I_CKR] + (jb * 2048 + 256 * c) * 32, 255, QA, P, (LAS char*)(lds + RING_OFF), lds0 + RING_OFF);
    } else { const size_t ro = (size_t)L * MS + b * 16;
        ms::unit<1>(a->out + O_MCS + ro * 256, a->out + O_MRS + ro * 32, 15, QA, P, (LAS char*)(lds + RING_OFF), lds0 + RING_OFF); }
}
__device__ __forceinline__ void mlas_combine(KAP a, int L, LAS unsigned char* lds, int vcu, int G, int wid, int lane) {
    unsigned char* ws = a->ws; const int grp = wid >> 2, k = wid & 3; LAS bf16* scr = (LAS bf16*)(lds + RING_OFF + grp * 8192);
    const bf16* WV = (const bf16*)(ws + WS_WMKVR) + (size_t)L * 2048 * 256; bf16* OM = (bf16*)(ws + WS_OM); const int g = lane >> 4, li = lane & 15;
    for (int e0 = vcu * 2; e0 < 512; e0 += G * 2) { const int e = e0 + grp, b = e >> 4, h = e & 15; const int q = lane >> 2, cg = 64 * k + (lane & 3) * 16;
        const float* P0 = (const float*)(ws + WS_PART) + ((size_t)(b * 9) * 256 + (h >> 1) * 32 + (h & 1) * 16 + q) * ms::PROW; constexpr size_t CS = (size_t)256 * ms::PROW;
        float pm[9], pl[9], mm = -1e30f;
#pragma unroll
        for (int c = 0; c < 9; ++c) { pm[c] = P0[c * CS + 256]; pl[c] = P0[c * CS + 257]; }
        f32x4 pv[4][9];
#pragma unroll
        for (int j = 0; j < 4; ++j)
#pragma unroll
            for (int c = 0; c < 9; ++c) pv[j][c] = *(const f32x4*)(P0 + c * CS + cg + 4 * j);
#pragma unroll
        for (int c = 0; c < 9; ++c) mm = __builtin_fmaxf(mm, pm[c]);
        float wgt[9], den = 0.f;
#pragma unroll
        for (int c = 0; c < 9; ++c) { wgt[c] = ex2(pm[c] - mm); den += wgt[c] * pl[c]; }
        const float id = 1.0f / den;
#pragma unroll
        for (int j = 0; j < 4; ++j) { f32x4 acc = (f32x4){0.f, 0.f, 0.f, 0.f};
#pragma unroll
            for (int c = 0; c < 9; ++c) acc += pv[j][c] * wgt[c];
            *(LAS u32x2*)(scr + q * 256 + cg + 4 * j) = pg8::pk4(acc * id); }
        __syncthreads();
        bf16x8 af[8];
#pragma unroll
        for (int d0 = 0; d0 < 8; ++d0) af[d0] = *(const LAS bf16x8*)(scr + li * 256 + 32 * d0 + 8 * g);
        { const int db = k; f32x4 acc = (f32x4){0.f, 0.f, 0.f, 0.f}; const bf16* wp = WV + (size_t)(h * 128 + 64 + 16 * db + li) * 256 + 8 * g;
#pragma unroll
            for (int d0 = 0; d0 < 8; ++d0) acc = a16::mfma16(af[d0], *(const bf16x8*)(wp + 32 * d0), acc);
            bf16* O = OM + ((size_t)MP + b * 16 + 4 * g) * 1024 + h * 64 + 16 * db + li; const unsigned w0 = pk2(acc[0], acc[1]), w1 = pk2(acc[2], acc[3]);
            O[0] = (bf16)(w0 & 0xffffu); O[1024] = (bf16)(w0 >> 16); O[2048] = (bf16)(w1 & 0xffffu); O[3072] = (bf16)(w1 >> 16); }
        __syncthreads();
    }
}
typedef float f32x2v_t __attribute__((ext_vector_type(2)));
template <int K, class F> __device__ __forceinline__ void thin_tiles(const bf16* A, const bf16* Bt, LAS unsigned char* lds, int vcu, int G, int wave, int lane, F epi) {
    const int g = lane >> 4, li = lane & 15; constexpr int nks = K / 256;
    LAS float* part = (LAS float*)(lds + RING_OFF);
#pragma unroll 1
    for (int tt = vcu; tt < 256; tt += G) { const int rb = tt & 31, cgp = tt >> 5;
        const bf16* ap = A + (size_t)(MP + 16 * rb + li) * K + wave * (K / 8) + 8 * g; const bf16* bp = Bt + (size_t)(128 * cgp + li) * K + wave * (K / 8) + 8 * g;
        f32x4 acc[8];
#pragma unroll
        for (int nb = 0; nb < 8; ++nb) acc[nb] = (f32x4){0.f, 0.f, 0.f, 0.f};
#pragma unroll
        for (int s0 = 0; s0 < nks; s0 += 4) { bf16x8 a[4], b[4][8]; const bf16x8 z = {0, 0, 0, 0, 0, 0, 0, 0};
#pragma unroll
            for (int u = 0; u < 4; ++u) { const bool on = s0 + u < nks; a[u] = on ? *(const bf16x8*)(ap + 32 * (s0 + u)) : z;
#pragma unroll
                for (int nb = 0; nb < 8; ++nb) b[u][nb] = on ? *(const bf16x8*)(bp + (size_t)nb * 16 * K + 32 * (s0 + u)) : z; }
#pragma unroll
            for (int u = 0; u < 4; ++u) if (s0 + u < nks)
#pragma unroll
                for (int nb = 0; nb < 8; ++nb) acc[nb] = a16::mfma16(a[u], b[u][nb], acc[nb]); }
#pragma unroll
        for (int nb = 0; nb < 8; ++nb)
#pragma unroll
            for (int r = 0; r < 4; ++r) part[wave * 2048 + (4 * g + r) * 128 + 16 * nb + li] = acc[nb][r];
        __syncthreads();
        const int e = (2 * wave + (lane >> 5)) * 128 + 4 * (lane & 31); f32x4 sv = (f32x4){0.f, 0.f, 0.f, 0.f};
#pragma unroll
        for (int w = 0; w < 8; ++w) sv += *(const LAS f32x4*)(part + w * 2048 + e);
        epi(MP + 16 * rb + 2 * wave + (lane >> 5), 128 * cgp + 4 * (lane & 31), sv);
        __syncthreads(); }
}
template <int K> __device__ __forceinline__ void thin_resid(KAP a, const bf16* A, const bf16* Bt, int first, LAS unsigned char* lds, int vcu, int G, int wave, int lane) {
    unsigned char* ws = a->ws; const float* xs = a->in[I_XS] - (size_t)MP * 1024; bf16* XB = (bf16*)(ws + WS_XB); float* SSQ = (float*)(ws + WS_SSQ);
    thin_tiles<K>(A, Bt, lds, vcu, G, wave, lane, [&](int row, int col, f32x4 v) {
        const size_t o = (size_t)row * 1024 + col; f32x4 x;
        if (first) x = *(const f32x4*)(xs + o);
        else { const u32x2 w = *(const u32x2*)(XB + o); x = (f32x4){__builtin_bit_cast(float, w.x << 16), __builtin_bit_cast(float, w.x & 0xffff0000u), __builtin_bit_cast(float, w.y << 16), __builtin_bit_cast(float, w.y & 0xffff0000u)}; }
        x += v; *(u32x2*)(XB + o) = (u32x2){pk2(x[0], x[1]), pk2(x[2], x[3])};
        float sq = (x[0] * x[0] + x[1] * x[1]) + (x[2] * x[2] + x[3] * x[3]); sq += __shfl_xor(sq, 1); sq += __shfl_xor(sq, 2); sq += __shfl_xor(sq, 4); sq += __shfl_xor(sq, 8);
        if ((lane & 15) == 0) SSQ[(size_t)row * 16 + (col >> 6)] = sq; });
}
__device__ __forceinline__ void thin_xq(KAP a, const bf16* Bt, LAS unsigned char* lds, int vcu, int G, int wave, int lane) {
    unsigned char* ws = a->ws; const bf16* XB = (const bf16*)(ws + WS_XB); bf16* QX = (bf16*)(ws + WS_QX); const float* SSQ = (const float*)(ws + WS_SSQ);
    thin_tiles<1024>(XB, Bt, lds, vcu, G, wave, lane, [&](int row, int col, f32x4 v) {
        const float rs = ssq_rstd16(SSQ, row) * C2_X; *(u32x2*)(QX + (size_t)row * 1024 + col) = (u32x2){pk2(v[0] * rs, v[1] * rs), pk2(v[2] * rs, v[3] * rs)}; });
}
#ifndef DBG_DOUBLE
#define DBG_DOUBLE 0
#endif

constexpr int NPH = 41;
struct Ctx { int lane, wave, G, bx, vcu, gw, NGW; };
__device__ __forceinline__ Ctx mk_ctx() { Ctx c; const int tid = pg8::pg8_tid(); c.lane = tid & 63; c.wave = __builtin_amdgcn_readfirstlane(tid >> 6); int G_ = gridDim.x, bx_ = blockIdx.x; asm volatile("" : "+s"(G_), "+s"(bx_)); c.G = G_; c.bx = bx_;
    c.vcu = (c.G % 8 == 0) ? (c.bx % 8) * (c.G / 8) + c.bx / 8 : c.bx; c.gw = c.vcu * NWAVES + c.wave; c.NGW = c.G * NWAVES; return c; }
#define RSX(ws) pg8::RowScale{(const float*)((ws) + WS_SSQ), 16, 4, 1.0f / 1024.0f}
#define PHASE __device__ __noinline__ void
#define FATPH __device__ __forceinline__ void
__device__ __forceinline__ unsigned char* ws_ptr() { GAS unsigned char* w = (GAS unsigned char*)KA->ws; asm volatile("" : "+s"(w)); return (unsigned char*)w; }
#define WSB(off) ((const bf16*)(ws_ptr() + (off)))
__device__ __forceinline__ const float* in_ptr(int i) { GAS const float* w = (GAS const float*)KA->in[i]; asm volatile("" : "+s"(w)); return (const float*)w; }
__device__ __forceinline__ float* out_ptr() { GAS float* w = (GAS float*)KA->out; asm volatile("" : "+s"(w)); return (float*)w; }

FATPH ph_prologue(KAP a, LAS unsigned char* lds, int pmask) { const Ctx c = mk_ctx(); p0_prologue(a, lds, c.gw, c.NGW, c.wave, c.lane, pmask); __syncthreads(); }
FATPH ph_memkv(LAS unsigned char* lds) { const Ctx c = mk_ctx(); unsigned char* ws = ws_ptr(); float* out = out_ptr();
    pg8::Gemm g{WSB(WS_MB), WSB(WS_WXKV), 2048, 8192, 1024}; pg8::StaticOrder S; S.init(2048, 8192, c.G, c.bx);
    pg8::EpiMemKV E{out + O_MKP, out + O_MVP, (bf16*)(ws + WS_MKB), (bf16*)(ws + WS_MVB)};
    pg8::gemm_phase<pg8::EpiMemKV, pg8::StaticOrder, true, true>(lds + RING_OFF, g, S, E); }
FATPH ph_fox_in(LAS unsigned char* lds, int L) { const Ctx c = mk_ctx(); unsigned char* ws = ws_ptr(); float* out = out_ptr();
    pg8::Gemm g{WSB(WS_XB), WSB(WS_WFI) + (size_t)L * 4352 * 1024, MT, 4352, 1024}; pg8::StaticOrder S; S.init(MT, 4352, c.G, c.bx);
    pg8::EpiFoxIn E{RSX(ws), ws, out, in_ptr(I_BFF) + L * 16, L};
    pg8::gemm_phase<pg8::EpiFoxIn, pg8::StaticOrder, true, true>(lds + RING_OFF, g, S, E); }
FATPH ph_fox_sample(KAP a, LAS unsigned char* lds, int L) { const Ctx c = mk_ctx(); LAS float* red = (LAS float*)(lds + RING_OFF + 65536);
    for (int it = c.vcu; it < 256; it += c.G) { cum_local_sample(a, L, 2 * it, red, c.wave, c.lane); cum_local_sample(a, L, 2 * it + 1, red, c.wave, c.lane); foxs_item(a, L, it, lds, c.wave, c.lane); } }
__device__ __forceinline__ void unit2_of(int e, int& bh, int& qb) { bh = e >> 3; const int k = e & 7, s = (k >> 2) & 1, ii = k & 3, j = 2 * s + (ii >> 1); qb = (ii & 1) ? 7 - j : j; }
__device__ __forceinline__ void unit_of(int e, int& bh, int& qb) { bh = e >> 4; const int k = e & 15, s = (k >> 3) & 1, ii = k & 7, j = 2 * (ii >> 1) + s; qb = (ii & 1) ? 15 - j : j; }
FATPH ph_fox_attn(LAS unsigned char* lds, unsigned lds0) { const Ctx c = mk_ctx(); unsigned char* ws = ws_ptr();
    for (int e0 = c.vcu * 4; e0 < 1024; e0 += c.G * 4) {
        __syncthreads(); cum_local_prompt(KA, e0 >> 3, (LAS float*)(lds + RING_OFF + 65536), c.wave, c.lane);
        for (int i = 0; i < 4; ++i) { int bh, qb; unit2_of(e0 + i, bh, qb); const int b = bh >> 4, h = bh & 15;
            fa::Args A{WSB(WS_QF), 1024, h * 64, WSB(WS_KF), 1024, h * 64, nullptr, WSB(WS_VF), 1024, h * 64, (bf16*)(ws + WS_OM), h * 64,
                       WSB(WS_GF), (const float*)(ws + WS_CB) + (size_t)bh * 4096};
            fa::unit2<0>(A, (long)b * 4096, qb, (LAS char*)(lds + RING_OFF), lds0 + RING_OFF); } } }
FATPH ph_fox_mix(KAP a, LAS unsigned char* lds, unsigned lds0, int L) { const Ctx c = mk_ctx(); unsigned char* ws = ws_ptr(); LAS float* red = (LAS float*)(lds + RING_OFF + 65536);
    const int pos = (c.vcu >> 1) % 5;
    for (int e0 = c.vcu * 4, it = c.vcu; e0 < 1024 || it < 256; e0 += c.G * 4, it += c.G) {
        if (e0 < 1024) { __syncthreads(); cum_local_prompt(a, e0 >> 3, red, c.wave, c.lane); }
#pragma unroll 1
        for (int i = 0; i < 5; ++i) {
            if (i == pos && it < 256) { const Ctx c2 = mk_ctx(); int itv = it; asm volatile("" : "+s"(itv));
                __syncthreads(); cum_local_sample(a, L, 2 * itv, red, c2.wave, c2.lane); cum_local_sample(a, L, 2 * itv + 1, red, c2.wave, c2.lane); foxs_item(a, L, itv, lds, c2.wave, c2.lane); __syncthreads(); }
            if (i < 4 && e0 < 1024) { int ev = e0 + i; asm volatile("" : "+s"(ev)); int bh, qb; unit2_of(ev, bh, qb); const int b = bh >> 4, h = bh & 15;
                fa::Args A{WSB(WS_QF), 1024, h * 64, WSB(WS_KF), 1024, h * 64, nullptr, WSB(WS_VF), 1024, h * 64, (bf16*)(ws + WS_OM), h * 64,
                           WSB(WS_GF), (const float*)(ws + WS_CB) + (size_t)bh * 4096};
                fa::unit2<0>(A, (long)b * 4096, qb, (LAS char*)(lds + RING_OFF), lds0 + RING_OFF); } } } }
template <bool ABLK = false>
FATPH ph_resid(LAS unsigned char* lds, const bf16* A, const bf16* Bt, int K, int first, int dummy = 0) { const Ctx c = mk_ctx(); unsigned char* ws = ws_ptr();
    pg8::Gemm g{A, Bt, MP, 1024, K}; pg8::StaticOrder S; S.init(MP, 1024, c.G, c.bx);
    pg8::EpiResid E{KA->in[I_XP], KA->in[I_XS], first, dummy ? (bf16*)(ws + WS_R1 + (size_t)MT * 4096) : (bf16*)(ws + WS_XB), dummy ? (float*)(ws + WS_R1 + (size_t)MT * 6144) : (float*)(ws + WS_SSQ)};
    pg8::gemm_phase<pg8::EpiResid, pg8::StaticOrder, true, true, ABLK>(lds + RING_OFF, g, S, E); }
FATPH ph_scale_gemm(LAS unsigned char* lds, const bf16* A, const bf16* Bt, int M, int N, int K, const float* ssq, int stride, int ngrp, float inv_n, bf16* O, float scale) { const Ctx c = mk_ctx();
    pg8::Gemm g{A, Bt, M, N, K}; pg8::StaticOrder S; S.init(M, N, c.G, c.bx);
    pg8::EpiScaleBf16 E{pg8::RowScale{ssq, stride, ngrp, inv_n}, O, N, scale};
    pg8::gemm_phase<pg8::EpiScaleBf16, pg8::StaticOrder, true, true>(lds + RING_OFF, g, S, E); }
FATPH ph_cross(LAS unsigned char* lds, unsigned lds0, int layer) { const Ctx c = mk_ctx(); unsigned char* ws = ws_ptr();
    const bf16* QX = WSB(WS_QX); bf16* OX = (bf16*)(ws + WS_OM);
    const bool bal = (c.G == 256); const int nu = bal ? (c.vcu < 128 ? 1 : 3) : 2, ub = bal ? (c.vcu < 128 ? c.vcu : 128 + 3 * (c.vcu - 128)) : c.vcu * 2;
    for (int u0 = ub; u0 < 512; u0 += (bal ? 512 : c.G * 2))
        for (int i = 0; i < nu; ++i) { const int u = u0 + i, bh = u >> 4, qb = u & 15, b = bh >> 2, h = bh & 3; const size_t ko = ((size_t)layer * 2048 + b * 256) * 1024 + h * 256;
            xa::unit<false>(WSB(WS_MKB) + ko, WSB(WS_MVB) + ko, 1024, QX, OX, (size_t)b * 4096 + qb * 256, h * 256, 32, false, (LAS char*)(lds + RING_OFF), lds0 + RING_OFF); }
    for (int e = c.vcu; e < 128; e += c.G) { const int bs = e >> 2, h = e & 3; const size_t ko = ((size_t)(layer * 32 + bs) * 256) * 1024 + h * 256;
        xa::unit<true>(in_ptr(I_CMK) + ko, in_ptr(I_CMV) + ko, 1024, QX, OX, (size_t)MP + bs * 16, h * 256, 16, true, (LAS char*)(lds + RING_OFF), lds0 + RING_OFF); } }
FATPH ph_gu(LAS unsigned char* lds, int layer) { const Ctx c = mk_ctx(); unsigned char* ws = ws_ptr();
    pg8::Gemm g{WSB(WS_XB), WSB(WS_WGU) + (size_t)layer * 5632 * 1024, MT, 5632, 1024}; pg8::StaticOrder S; S.init(MT, 5632, c.G, c.bx);
    pg8::EpiSwiglu E{RSX(ws), (bf16*)(ws + WS_HB)}; pg8::gemm_phase<pg8::EpiSwiglu, pg8::StaticOrder, true, true>(lds + RING_OFF, g, S, E); }
FATPH ph_gu_null(LAS unsigned char* lds, int layer) { const Ctx c = mk_ctx();
    pg8::Gemm g{WSB(WS_XB), WSB(WS_WGU) + (size_t)layer * 5632 * 1024, MT, 5632, 1024}; pg8::StaticOrder S; S.init(MT, 5632, c.G, c.bx);
    pg8::EpiNull E{}; pg8::gemm_phase<pg8::EpiNull, pg8::StaticOrder, true, true>(lds + RING_OFF, g, S, E); }
FATPH ph_mla_a(LAS unsigned char* lds, int L) { const Ctx c = mk_ctx(); unsigned char* ws = ws_ptr(); float* out = out_ptr();
    pg8::Gemm g{WSB(WS_XB), WSB(WS_WMA) + (size_t)L * 768 * 1024, MT, 768, 1024}; pg8::StaticOrder S; S.init(MT, 768, c.G, c.bx);
    pg8::EpiMlaA E{RSX(ws), (float*)(ws + WS_CKVU), (bf16*)(ws + WS_CKVUB), (float*)(ws + WS_SSQKV), (bf16*)(ws + WS_CQ), (float*)(ws + WS_SSQQ), (bf16*)(ws + WS_KRB),
                   out + O_MRP + (size_t)L * MP * 32, out + O_MRS + (size_t)L * MS * 32, (const float*)(ws + WS_ROPC), (const float*)(ws + WS_ROPS)};
    pg8::gemm_phase<pg8::EpiMlaA, pg8::StaticOrder, true, true>(lds + RING_OFF, g, S, E); }
PHASE ph_fixup(KAP a, int L) { const Ctx c = mk_ctx(); ckv_fixup(a, L, c.gw, c.NGW, c.lane); }
FATPH ph_mla_q(LAS unsigned char* lds, int L, int kq) { const Ctx c = mk_ctx(); unsigned char* ws = ws_ptr();
    pg8::Gemm g{WSB(WS_CQ), WSB(WS_WMQ) + (size_t)L * 1536 * 384, MT, 1536, kq}; pg8::StaticOrder S; S.init(MT, 1536, c.G, c.bx);
    pg8::EpiMlaQ E{pg8::RowScale{(const float*)(ws + WS_SSQQ), 8, 2, 1.0f / 384.0f}, (bf16*)(ws + WS_QM), (const float*)(ws + WS_ROPC), (const float*)(ws + WS_ROPS)};
    pg8::gemm_phase<pg8::EpiMlaQ, pg8::StaticOrder, true, false>(lds + RING_OFF, g, S, E); }
PHASE ph_mla_qprime(KAP a, LAS unsigned char* lds, int L, int it) { const Ctx c = mk_ctx(); mlas_qprime(a, L, it, lds, c.wave, c.lane); }
FATPH ph_mla_sample(LAS unsigned char* lds, unsigned lds0, int L) { const Ctx c = mk_ctx(); for (int it = c.vcu; it < 256; it += c.G) { ph_mla_qprime(KA, lds, L, it); mlas_attn(KA, L, it, it, lds, lds0);
        if ((it & 7) == ((it >> 3) & 7)) mlas_attn(KA, L, 256 + (it >> 3), it, lds, lds0); } __syncthreads(); }
FATPH ph_mla_attn(LAS unsigned char* lds, unsigned lds0) { const Ctx c = mk_ctx(); unsigned char* ws = ws_ptr();
    for (int e0 = c.vcu * 4; e0 < 1024; e0 += c.G * 4)
        for (int i = 0; i < 4; ++i) { int bh, qb; unit2_of(e0 + i, bh, qb); const int b = bh >> 4, h = bh & 15;
            fa::Args A{WSB(WS_QM), 1536, h * 96, WSB(WS_KVM), 2048, h * 128, WSB(WS_KRB), WSB(WS_KVM), 2048, h * 128 + 64, (bf16*)(ws + WS_OM), h * 64,
                       nullptr, nullptr};
            fa::unit2<1>(A, (long)b * 4096, qb, (LAS char*)(lds + RING_OFF), lds0 + RING_OFF); } }
FATPH ph_mla_comb(LAS unsigned char* lds, int L) { const Ctx c = mk_ctx(); mlas_combine(KA, L, lds, c.vcu, c.G, c.wave, c.lane); }
template <int K> FATPH ph_thin_resid(KAP a, LAS unsigned char* lds, const bf16* A, const bf16* Bt, int first) { const Ctx c = mk_ctx(); thin_resid<K>(a, A, Bt, first, lds, c.vcu, c.G, c.wave, c.lane); }
FATPH ph_thin_xq(KAP a, LAS unsigned char* lds, const bf16* Bt) { const Ctx c = mk_ctx(); thin_xq(a, Bt, lds, c.vcu, c.G, c.wave, c.lane); }
PHASE ph_final(KAP a) { const Ctx c = mk_ctx(); final_phase(a, c.gw, c.NGW, c.lane); }
PHASE ph_grid_bar(GAS unsigned* barw, unsigned x, volatile LAS unsigned* st) { XcdBarrier b; b.bar = (unsigned*)barw; b.x = x; b.st = st; xcd_barrier(b); }

__global__ void __launch_bounds__(NWAVES * 64, 2) fwd_kernel(KArgs args) {
    extern __shared__ __attribute__((aligned(16))) unsigned char lds_raw[];
    LAS unsigned char* lds = (LAS unsigned char*)lds_raw;
    volatile LAS unsigned* MISC = (volatile LAS unsigned*)(lds + MISC_OFF);
    const int tid = threadIdx.x;
    const unsigned lds0 = (unsigned)(uintptr_t)lds_raw;
    for (int u = tid; u < (LDS_BYTES - LDSCTL_OFF) / 4; u += NWAVES * 64) ((LAS unsigned*)(lds + LDSCTL_OFF))[u] = 0u;
    __syncthreads();
    const XcdBarrier bar = xcd_barrier_post((unsigned*)(args.ws + WS_CTL) + CW_BAR, MISC + 8);
    const int lo = args.ph_lo, hi = args.ph_hi;
#ifndef DBG_DOUBLE
#define DBG_DOUBLE 0
#endif
#ifndef DBG_P0_AGAIN
#define DBG_P0_AGAIN 0
#endif
#define REP(bit) for (int rep_ = 0; rep_ < ((DBG_DOUBLE & (bit)) ? 2 : 1); ++rep_)
#define IN(k) (lo <= (k) && (k) < hi)
#define SEAM(k) do { if (IN(k) && IN((k) + 1)) { REP(256) ph_grid_bar((GAS unsigned*)bar.bar, bar.x, bar.st); } } while (0)
    if (IN(0)) { ph_prologue(KA, lds, 0x7f); if (DBG_P0_AGAIN) ph_prologue(KA, lds, DBG_P0_AGAIN); }
    SEAM(0);
    if (IN(1)) REP(65536) ph_memkv(lds);
    SEAM(1);
    for (int L = 0; L < 2; ++L) {
        const int pb = 2 + 19 * L;
        if (IN(pb)) { REP(8) ph_fox_in(lds, L); }
        SEAM(pb);
        if (IN(pb + 2)) { if (DBG_DOUBLE & 96) { REP(64) ph_fox_sample(KA, lds, L); REP(32) ph_fox_attn(lds, lds0); } else ph_fox_mix(KA, lds, lds0, L); }
        SEAM(pb + 2);
        if (IN(pb + 3)) { ph_thin_resid<1024>(KA, lds, WSB(WS_OM), WSB(WS_WFO) + (size_t)L * 1024 * 1024, L == 0); if (DBG_DOUBLE & 512) ph_resid(lds, WSB(WS_OM), WSB(WS_WFO) + (size_t)L * 1024 * 1024, 1024, L == 0, 1); ph_resid(lds, WSB(WS_OM), WSB(WS_WFO) + (size_t)L * 1024 * 1024, 1024, L == 0); }
        SEAM(pb + 3);
        for (int sub = 0; sub < 2; ++sub) {
            const int layer = 2 * L + sub, cb = pb + 4 + 10 * sub;
            if (sub == 1) {
                if (IN(pb + 9)) REP(32768) ph_mla_a(lds, L);
                SEAM(pb + 9);
                if (IN(pb + 10)) { ph_fixup(KA, L); REP(32768) ph_mla_q(lds, L, 384);
                    REP(32768)
                    ph_scale_gemm(lds, WSB(WS_CKVUB), WSB(WS_WMKV) + (size_t)L * 2048 * 256, MP, 2048, 256, (const float*)(ws_ptr() + WS_SSQKV), 4, 1, 1.0f / 256.0f, (bf16*)(ws_ptr() + WS_KVM), 1.0f); }
                SEAM(pb + 10);
                if (IN(pb + 11)) { REP(128) ph_mla_sample(lds, lds0, L); REP(32) ph_mla_attn(lds, lds0); }
                SEAM(pb + 11);
                if (IN(pb + 12)) REP(16) ph_mla_comb(lds, L);
                SEAM(pb + 12);
                if (IN(pb + 13)) { ph_thin_resid<1024>(KA, lds, WSB(WS_OM), WSB(WS_WMO) + (size_t)L * 1024 * 1024, 0); if (DBG_DOUBLE & 512) ph_resid(lds, WSB(WS_OM), WSB(WS_WMO) + (size_t)L * 1024 * 1024, 1024, 0, 1); ph_resid(lds, WSB(WS_OM), WSB(WS_WMO) + (size_t)L * 1024 * 1024, 1024, 0); }
                SEAM(pb + 13);
            }
            if (IN(cb)) { REP(131072) ph_thin_xq(KA, lds, WSB(WS_WXQ) + (size_t)layer * 1024 * 1024); REP(16384) ph_scale_gemm(lds, WSB(WS_XB), WSB(WS_WXQ) + (size_t)layer * 1024 * 1024, MP, 1024, 1024, (const float*)(ws_ptr() + WS_SSQ), 16, 4, 1.0f / 1024.0f, (bf16*)(ws_ptr() + WS_QX), C2_X); }
            SEAM(cb);
            if (IN(cb + 1)) REP(2) ph_cross(lds, lds0, layer);
            SEAM(cb + 1);
            if (IN(cb + 2)) { ph_thin_resid<1024>(KA, lds, WSB(WS_OM), WSB(WS_WXO) + (size_t)layer * 1024 * 1024, 0); if (DBG_DOUBLE & 4096) ph_resid(lds, WSB(WS_OM), WSB(WS_WXO) + (size_t)layer * 1024 * 1024, 1024, 0, 1); ph_resid(lds, WSB(WS_OM), WSB(WS_WXO) + (size_t)layer * 1024 * 1024, 1024, 0); }
            SEAM(cb + 2);
            if (IN(cb + 3)) { if (DBG_DOUBLE & 1024) ph_gu_null(lds, layer); REP(8) ph_gu(lds, layer); }
            SEAM(cb + 3);
            if (IN(cb + 4)) { ph_thin_resid<DFF>(KA, lds, WSB(WS_HB), WSB(WS_WDN) + (size_t)layer * 1024 * 2816, 0); if (DBG_DOUBLE & 2048) ph_resid<true>(lds, WSB(WS_HB), WSB(WS_WDN) + (size_t)layer * 1024 * 2816, DFF, 0, 1); ph_resid<true>(lds, WSB(WS_HB), WSB(WS_WDN) + (size_t)layer * 1024 * 2816, DFF, 0); }
            SEAM(cb + 4);
        }
    }
    if (IN(40)) REP(262144) ph_final(KA);
#undef IN
#undef SEAM
}

#ifndef DBG_PH_HI
#define DBG_PH_HI NPH
#endif
#ifndef MK_PER_PHASE
#define MK_PER_PHASE 0
#endif
extern "C" void kernel_launch(void* const* d_in, const int* in_sizes, int n_in, void* d_out, int out_size, void* d_ws, size_t ws_size, hipStream_t stream) {
    static int grid = 0;
    if (grid == 0) {
        if (n_in != N_IN || (size_t)out_size != O_END || ws_size < WS_END) { fprintf(stderr, "kernel_launch: unexpected shapes (n_in %d, out %d, ws %zu; need %d, %zu, %zu)\n", n_in, out_size, ws_size, (int)N_IN, (size_t)O_END, (size_t)WS_END); grid = -1; return; }
        int dev = 0, cus = 0, per_cu = 0;
        if (hipGetDevice(&dev) != hipSuccess || hipDeviceGetAttribute(&cus, hipDeviceAttributeMultiprocessorCount, dev) != hipSuccess) { grid = -1; return; }
        if (hipFuncSetAttribute((const void*)fwd_kernel, hipFuncAttributeMaxDynamicSharedMemorySize, LDS_BYTES) != hipSuccess) { fprintf(stderr, "kernel_launch: hipFuncSetAttribute failed\n"); grid = -1; return; }
        if (hipOccupancyMaxActiveBlocksPerMultiprocessor(&per_cu, (const void*)fwd_kernel, NWAVES * 64, LDS_BYTES) != hipSuccess || per_cu < 1) { fprintf(stderr, "kernel_launch: occupancy query reports %d\n", per_cu); }
        (void)hipGetLastError();
        grid = cus;
    }
    if (grid < 0) return;
    if (hipMemsetAsync((char*)d_ws + WS_CTL, 0, CTL_ZERO_BYTES, stream) != hipSuccess) return;
    KArgs a{};
    for (int i = 0; i < N_IN; ++i) a.in[i] = (const float*)d_in[i];
    a.out = (float*)d_out; a.ws = (unsigned char*)d_ws;
#if MK_PER_PHASE
    for (int p = 0; p < NPH; ++p) { a.ph_lo = p; a.ph_hi = p + 1; hipLaunchKernelGGL(fwd_kernel, dim3(grid), dim3(NWAVES * 64), LDS_BYTES, stream, a); }
#else
    a.ph_lo = 0; a.ph_hi = DBG_PH_HI; hipLaunchKernelGGL(fwd_kernel, dim3(grid), dim3(NWAVES * 64), LDS_BYTES, stream, a);
#endif
}
```

```cpp
#include <hip/hip_runtime.h>
#include <cstdint>
#include <cstdio>
#include <cmath>

constexpr int D = 1024, MP = 32768, MS = 512, MT = MP + MS, SEQ = 4096, NBP = 8, NBS = 32, DSEQ = 16, PAST = 2048, NMEM = 256;
constexpr int DFF = 2816, KPAD = 2112;
constexpr float EPS = 1e-6f, LOG2E = 1.4426950408889634f;
constexpr float C2_FOX = 0.125f * LOG2E, C2_MLA = 0.10206207261596575f * LOG2E, C2_X = 0.0625f * LOG2E;

constexpr size_t O_Y = 0;
constexpr size_t O_FKP = (size_t)MT * D;
constexpr size_t O_FVP = O_FKP + (size_t)2 * MP * 1024;
constexpr size_t O_FLP = O_FVP + (size_t)2 * MP * 1024;
constexpr size_t O_MCP = O_FLP + (size_t)2 * MP * 16;
constexpr size_t O_MRP = O_MCP + (size_t)2 * MP * 256;
constexpr size_t O_MKP = O_MRP + (size_t)2 * MP * 32;
constexpr size_t O_MVP = O_MKP + (size_t)4 * 2048 * 1024;
constexpr size_t O_FKS = O_MVP + (size_t)4 * 2048 * 1024;
constexpr size_t O_FVS = O_FKS + (size_t)2 * MS * 1024;
constexpr size_t O_FLS = O_FVS + (size_t)2 * MS * 1024;
constexpr size_t O_MCS = O_FLS + (size_t)2 * MS * 16;
constexpr size_t O_MRS = O_MCS + (size_t)2 * MS * 256;
constexpr size_t O_END = O_MRS + (size_t)2 * MS * 32;

enum { I_XP = 0, I_XS, I_MEM, I_CFK, I_CFV, I_CFL, I_CCKV, I_CKR, I_CMK, I_CMV, I_GMIX, I_GCROSS, I_GMEM, I_GFFN, I_GFINAL,
       I_WFI, I_BFF, I_WFO, I_WMA, I_GMQ, I_GMKV, I_WMQB, I_WMKVB, I_WMO, I_WXQ, I_WXKV, I_WXO, I_WGU, I_WDN, N_IN };


constexpr size_t al256(size_t x) { return (x + 255) & ~(size_t)255; }
constexpr size_t WS_CTL = 0, CTL_ZERO_BYTES = 1u << 20;
constexpr size_t WS_WFI = 2u << 20;
constexpr size_t WS_WFO = WS_WFI + (size_t)2 * 4352 * 1024 * 2;
constexpr size_t WS_WMA = WS_WFO + (size_t)2 * 1024 * 1024 * 2;
constexpr size_t WS_WMQ = WS_WMA + (size_t)2 * 768 * 1024 * 2;
constexpr size_t WS_WMKV = WS_WMQ + (size_t)2 * 1536 * 384 * 2;
constexpr size_t WS_WMKVR = WS_WMKV + (size_t)2 * 2048 * 256 * 2;
constexpr size_t WS_WKN = WS_WMKVR + (size_t)2 * 2048 * 256 * 2;
constexpr size_t WS_WMO = WS_WKN + (size_t)2 * 256 * 2048 * 2;
constexpr size_t WS_WXQ = WS_WMO + (size_t)2 * 1024 * 1024 * 2;
constexpr size_t WS_WXO = WS_WXQ + (size_t)4 * 1024 * 1024 * 2;
constexpr size_t WS_WXKV = WS_WXO + (size_t)4 * 1024 * 1024 * 2;
constexpr size_t WS_WGU = WS_WXKV + (size_t)4 * 2048 * 1024 * 2;
constexpr size_t WS_WDN = WS_WGU + (size_t)4 * 5632 * 1024 * 2;
constexpr size_t WS_WFF = WS_WDN + (size_t)4 * 1024 * 2816 * 2;
constexpr size_t WS_ROPC = WS_WFF + (size_t)2 * 16 * 1024 * 4;
constexpr size_t WS_ROPS = WS_ROPC + (size_t)4096 * 16 * 4;
constexpr size_t WS_XB = WS_ROPS + (size_t)4096 * 16 * 4;
constexpr size_t WS_SSQ = WS_XB + (size_t)MT * 1024 * 2;
constexpr size_t WS_R1 = al256(WS_SSQ + (size_t)MT * 16 * 4);
constexpr size_t SZ_ACT = (size_t)MT * 1024 * 2;
constexpr size_t WS_QF = WS_R1, WS_KF = WS_R1 + SZ_ACT, WS_VF = WS_R1 + 2 * SZ_ACT, WS_GF = WS_R1 + 3 * SZ_ACT;
constexpr size_t WS_QM = WS_R1, WS_KVM = al256(WS_R1 + (size_t)MT * 1536 * 2);
static_assert(WS_KVM + (size_t)MP * 2048 * 2 <= WS_R1 + 4 * SZ_ACT, "MLA overlay fits");
constexpr size_t WS_OM = WS_R1 + 4 * SZ_ACT;
constexpr size_t WS_LFR = WS_OM + SZ_ACT;
constexpr size_t WS_CB = WS_LFR + (size_t)MT * 16 * 4;
constexpr size_t WS_CBS = WS_CB + (size_t)8 * 16 * 4096 * 4;
constexpr size_t WS_CKVU = al256(WS_CBS + (size_t)32 * 16 * 2080 * 4);
constexpr size_t WS_CKVUB = WS_CKVU + (size_t)MT * 256 * 4;
constexpr size_t WS_SSQKV = WS_CKVUB + (size_t)MT * 256 * 2;
constexpr size_t WS_CQ = WS_SSQKV + (size_t)MT * 4 * 4;
constexpr size_t WS_SSQQ = WS_CQ + (size_t)MT * 384 * 2;
constexpr size_t WS_KRB = WS_SSQQ + (size_t)MT * 8 * 4;
constexpr size_t WS_QA = al256(WS_KRB + (size_t)MT * 32 * 2);
constexpr size_t WS_PART = al256(WS_QA + (size_t)288 * 256 * 288 * 2);
constexpr size_t WS_QX = al256(WS_PART + (size_t)32 * 9 * 256 * 264 * 4);
constexpr size_t WS_MB = WS_QX + SZ_ACT;
constexpr size_t WS_MKB = WS_MB + (size_t)2048 * 1024 * 2;
constexpr size_t WS_MVB = WS_MKB + (size_t)4 * 2048 * 1024 * 2;
constexpr size_t WS_HB = WS_MVB + (size_t)4 * 2048 * 1024 * 2;
constexpr size_t WS_END = WS_HB + (size_t)MT * DFF * 2;
constexpr int CW_BAR = 4096;

namespace pg8 {
#define PG8_LAS __attribute__((address_space(3)))
typedef unsigned short bf16_t;
typedef short bf16x8 __attribute__((ext_vector_type(8)));
typedef float f32x4 __attribute__((ext_vector_type(4)));
typedef unsigned u32x4 __attribute__((ext_vector_type(4)));
constexpr int BM = 256, BK = 64, HALF = 128, HTB = HALF * BK * 2  , STAGE_BYTES = 8 * HTB, NXCD = 8, WGM = 8;

__host__ __device__ __forceinline__ int lds_byte(int r, int c) { const int st = (r >> 4) * 2 + (c >> 5), rr = r & 15, cc = c & 31, ob = rr * 64 + cc * 2; return st * 1024 + (ob ^ (((ob >> 9) & 1) << 5)); }
__host__ __device__ __forceinline__ void stage_rc(int b, int& R, int& C) { const int st = b / 1024, sb = b % 1024, swz = sb ^ (((sb >> 9) & 1) << 5); R = (st >> 1) * 16 + swz / 64; C = (st & 1) * 32 + (swz % 64) / 2; }
__host__ __device__ __forceinline__ int perm32(int rho) { const int n = rho >> 4, i = rho & 15; return 8 * (i >> 2) + 4 * n + (i & 3); }

struct Unit { int pm, pn; };
struct Gemm { const bf16_t* A; const bf16_t* Bt; int M, N, K; };

struct StaticOrder {
    int nM, nN, nwg, G, c;
    __host__ __device__ void init(int M, int N, int G_, int c_) { nM = M / BM; nN = N / BM; nwg = nM * nN; G = G_; c = c_; }
    __host__ __device__ bool next(int i, Unit& u) const {
        const long L = (long)i * G + c; if (L >= nwg) return false;
        int wgid = (int)L; { const int q = nwg / NXCD, r = nwg % NXCD, xcd = wgid % NXCD, off = wgid / NXCD; wgid = (xcd < r ? xcd * (q + 1) : r * (q + 1) + (xcd - r) * q) + off; }
        const int nig = WGM * nN, gid = wgid / nig, fm = gid * WGM, gsz = (nM - fm) < WGM ? (nM - fm) : WGM;
        u.pm = fm + ((wgid % nig) % gsz); u.pn = (wgid % nig) / gsz; return true;
    }
    __device__ __forceinline__ void a_ready(const Unit&) const {}
    __device__ __forceinline__ void done(const Unit&) const {}
};

typedef unsigned u32x2 __attribute__((ext_vector_type(2)));
typedef float f32x2v __attribute__((ext_vector_type(2)));
typedef __bf16 bf16x2_t __attribute__((ext_vector_type(2)));
__device__ __forceinline__ unsigned pk_bf16(float lo, float hi) { f32x2v v = {lo, hi}; bf16x2_t b = __builtin_convertvector(v, bf16x2_t); return __builtin_bit_cast(unsigned, b); }
__device__ __forceinline__ u32x2 pk4(f32x4 v) { u32x2 w; w.x = pk_bf16(v[0], v[1]); w.y = pk_bf16(v[2], v[3]); return w; }
__device__ __forceinline__ float dot4(f32x4 v) { return (v[0] * v[0] + v[1] * v[1]) + (v[2] * v[2] + v[3] * v[3]); }
__device__ __forceinline__ float sigm(float z) { return __builtin_amdgcn_rcpf(1.0f + __builtin_amdgcn_exp2f(-z * LOG2E)); }
#define EPI_FENCE() asm volatile("" ::: "memory")
__device__ __forceinline__ int pg8_tid() { int t = threadIdx.x; asm volatile("" : "+v"(t)); return t; }

struct RowScale { const float* p; int stride; int ngrp; float inv_n;
    __device__ __forceinline__ float get(int row, int fq) const {
        float s = 0.f; if (fq < ngrp) { const f32x4 v = *(const f32x4*)(p + (size_t)row * stride + 4 * fq); s = (v[0] + v[1]) + (v[2] + v[3]); }
        s += __shfl_xor(s, 16); s += __shfl_xor(s, 32); return rsqrtf(s * inv_n + EPS); }
    __device__ __forceinline__ void get8(int row0, int fq, float (&r)[2][4]) const {
        float s[2][4];
#pragma unroll
        for (int ai = 0; ai < 2; ++ai)
#pragma unroll
            for (int m = 0; m < 4; ++m) { s[ai][m] = 0.f; if (fq < ngrp) { const f32x4 v = *(const f32x4*)(p + (size_t)(row0 + ai * HALF + m * 16) * stride + 4 * fq); s[ai][m] = (v[0] + v[1]) + (v[2] + v[3]); } }
#pragma unroll
        for (int ai = 0; ai < 2; ++ai)
#pragma unroll
            for (int m = 0; m < 4; ++m) { float t = s[ai][m]; t += __shfl_xor(t, 16); t += __shfl_xor(t, 32); r[ai][m] = rsqrtf(t * inv_n + EPS); }
    } };
__device__ __forceinline__ int row_pos(int row) { return row < MP ? (row & (SEQ - 1)) : PAST + ((row - MP) & (DSEQ - 1)); }

struct EpiFoxIn { static constexpr bool PERM = false, AFTER_DRAIN = false;
    RowScale rs; unsigned char* ws; float* out; const float* bff; int L;
    __device__ __forceinline__ void operator()(const f32x4 (&acc)[2][2][4][2], const Unit& u, int wr, int wc, int, int) const { const int lane_ = pg8_tid() & 63, fr = lane_ & 15, fq = lane_ >> 4; float rsv[2][4]; rs.get8(u.pm * BM + wr * 64 + fr, fq, rsv);
        const int typ = u.pn >> 2, colt = (u.pn & 3) * 256 + wc * 32 + 4 * fq;
        bf16_t* QF = (bf16_t*)(ws + WS_QF); float* kp = out + O_FKP + (size_t)L * MP * 1024; float* ks = out + O_FKS + (size_t)L * MS * 1024;
#pragma unroll
        for (int ai = 0; ai < 2; ++ai)
#pragma unroll
            for (int m = 0; m < 4; ++m) { const int row = u.pm * BM + ai * HALF + wr * 64 + m * 16 + fr; float r = rsv[ai][m];
                if (typ == 0) { r *= C2_FOX;
#pragma unroll
                    for (int bj = 0; bj < 2; ++bj)
#pragma unroll
                        for (int n = 0; n < 2; ++n) *(u32x2*)(QF + (size_t)row * 1024 + colt + bj * HALF + n * 16) = pk4(acc[ai][bj][m][n] * r);
                } else if (typ == 3) {
#pragma unroll
                    for (int bj = 0; bj < 2; ++bj)
#pragma unroll
                        for (int n = 0; n < 2; ++n) { f32x4 v = acc[ai][bj][m][n] * r; v[0] = sigm(v[0]); v[1] = sigm(v[1]); v[2] = sigm(v[2]); v[3] = sigm(v[3]);
                            *(u32x2*)(QF + 3 * (SZ_ACT / 2) + (size_t)row * 1024 + colt + bj * HALF + n * 16) = pk4(v); }
                } else if (typ == 4) {
                    if (wc == 0) { const f32x4 bb = *(const f32x4*)(bff + 4 * fq); f32x4 lf;
#pragma unroll
                        for (int i = 0; i < 4; ++i) { const float z = acc[ai][0][m][0][i] * r + bb[i]; lf[i] = fminf(z, 0.f) - log1pf(expf(-fabsf(z))); }
                        *(f32x4*)((float*)(ws + WS_LFR) + (size_t)row * 16 + 4 * fq) = lf;
                        float* F = (row < MP) ? out + O_FLP + ((size_t)L * MP + row) * 16 : out + O_FLS + ((size_t)L * MS + (row - MP)) * 16;
                        *(f32x4*)(F + 4 * fq) = lf; }
                } else { bf16_t* B = QF + (size_t)typ * (SZ_ACT / 2);
                    float* F = (row < MP) ? kp + (size_t)(typ - 1) * 2 * MP * 1024 + (size_t)row * 1024 : ks + (size_t)(typ - 1) * 2 * MS * 1024 + (size_t)(row - MP) * 1024;
#pragma unroll
                    for (int bj = 0; bj < 2; ++bj)
#pragma unroll
                        for (int n = 0; n < 2; ++n) { const f32x4 v = acc[ai][bj][m][n] * r; const int c = colt + bj * HALF + n * 16;
                            *(f32x4*)(F + c) = v; *(u32x2*)(B + (size_t)row * 1024 + c) = pk4(v); }
                }
                if (m & 1) EPI_FENCE(); }
    }
};
struct EpiResid { static constexpr bool PERM = true, AFTER_DRAIN = false;
    const float* xin_p; const float* xin_s; int first; bf16_t* xb; float* ssq;
    __device__ __forceinline__ void operator()(const f32x4 (&acc)[2][2][4][2], const Unit& u, int wr, int wc, int, int) const { const int lane_ = pg8_tid() & 63, fr = lane_ & 15, fq = lane_ >> 4;
        const int col0 = u.pn * BM + wc * 32 + 8 * fq;
        if (first) {
#pragma unroll
        for (int ai = 0; ai < 2; ++ai) {
            f32x4 xo[4][2][2];
#pragma unroll
            for (int m = 0; m < 4; ++m) { const int row = u.pm * BM + ai * HALF + wr * 64 + m * 16 + fr;
                const float* xi = (row < MP) ? xin_p + (size_t)row * 1024 : xin_s + (size_t)(row - MP) * 1024;
#pragma unroll
                for (int bj = 0; bj < 2; ++bj)
#pragma unroll
                    for (int n = 0; n < 2; ++n) xo[m][bj][n] = *(const f32x4*)(xi + col0 + bj * HALF + n * 4); }
#pragma unroll
            for (int m = 0; m < 4; ++m) { const int row = u.pm * BM + ai * HALF + wr * 64 + m * 16 + fr; float sq = 0.f;
#pragma unroll
                for (int bj = 0; bj < 2; ++bj) { const int c = col0 + bj * HALF; const f32x4 x0 = xo[m][bj][0] + acc[ai][bj][m][0], x1 = xo[m][bj][1] + acc[ai][bj][m][1];
                    sq += dot4(x0) + dot4(x1);
                    const u32x2 w0 = pk4(x0), w1 = pk4(x1); *(u32x4*)(xb + (size_t)row * 1024 + c) = (u32x4){w0.x, w0.y, w1.x, w1.y}; }
                sq += __shfl_xor(sq, 16); sq += __shfl_xor(sq, 32);
                if (fq == 0) ssq[(size_t)row * 16 + u.pn * 4 + wc] = sq; }
            EPI_FENCE(); }
        } else {
            u32x4 raw[2][4][2];
#pragma unroll
            for (int ai = 0; ai < 2; ++ai)
#pragma unroll
                for (int m = 0; m < 4; ++m) { const int row = u.pm * BM + ai * HALF + wr * 64 + m * 16 + fr;
#pragma unroll
                    for (int bj = 0; bj < 2; ++bj) raw[ai][m][bj] = *(const u32x4*)(xb + (size_t)row * 1024 + col0 + bj * HALF); }
            EPI_FENCE();
#pragma unroll
            for (int ai = 0; ai < 2; ++ai) {
#pragma unroll
                for (int m = 0; m < 4; ++m) { const int row = u.pm * BM + ai * HALF + wr * 64 + m * 16 + fr; float sq = 0.f;
#pragma unroll
                    for (int bj = 0; bj < 2; ++bj) { const int c = col0 + bj * HALF; const u32x4 w = raw[ai][m][bj];
                        const f32x4 x0 = (f32x4){__builtin_bit_cast(float, w.x << 16), __builtin_bit_cast(float, w.x & 0xffff0000u), __builtin_bit_cast(float, w.y << 16), __builtin_bit_cast(float, w.y & 0xffff0000u)} + acc[ai][bj][m][0];
                        const f32x4 x1 = (f32x4){__builtin_bit_cast(float, w.z << 16), __builtin_bit_cast(float, w.z & 0xffff0000u), __builtin_bit_cast(float, w.w << 16), __builtin_bit_cast(float, w.w & 0xffff0000u)} + acc[ai][bj][m][1];
                        sq += dot4(x0) + dot4(x1);
                        const u32x2 w0 = pk4(x0), w1 = pk4(x1); *(u32x4*)(xb + (size_t)row * 1024 + c) = (u32x4){w0.x, w0.y, w1.x, w1.y}; }
                    sq += __shfl_xor(sq, 16); sq += __shfl_xor(sq, 32);
                    if (fq == 0) ssq[(size_t)row * 16 + u.pn * 4 + wc] = sq; }
                EPI_FENCE(); } }
    }
};
struct EpiScaleBf16 { static constexpr bool PERM = true, AFTER_DRAIN = false;
    RowScale rs; bf16_t* O; int ldc; float scale;
    __device__ __forceinline__ void operator()(const f32x4 (&acc)[2][2][4][2], const Unit& u, int wr, int wc, int, int) const { const int lane_ = pg8_tid() & 63, fr = lane_ & 15, fq = lane_ >> 4; float rsv[2][4]; rs.get8(u.pm * BM + wr * 64 + fr, fq, rsv);
        const int col0 = u.pn * BM + wc * 32 + 8 * fq;
#pragma unroll
        for (int ai = 0; ai < 2; ++ai)
#pragma unroll
            for (int m = 0; m < 4; ++m) { const int row = u.pm * BM + ai * HALF + wr * 64 + m * 16 + fr; const float r = rsv[ai][m] * scale;
#pragma unroll
                for (int bj = 0; bj < 2; ++bj) { const u32x2 w0 = pk4(acc[ai][bj][m][0] * r), w1 = pk4(acc[ai][bj][m][1] * r);
                    *(u32x4*)(O + (size_t)row * ldc + col0 + bj * HALF) = (u32x4){w0.x, w0.y, w1.x, w1.y}; }
                if (m & 1) EPI_FENCE(); }
    }
};
struct EpiSwiglu { static constexpr bool PERM = true, AFTER_DRAIN = false;
    RowScale rs; bf16_t* HB;
    __device__ __forceinline__ void operator()(const f32x4 (&acc)[2][2][4][2], const Unit& u, int wr, int wc, int, int) const { const int lane_ = pg8_tid() & 63, fr = lane_ & 15, fq = lane_ >> 4; float rsv[2][4]; rs.get8(u.pm * BM + wr * 64 + fr, fq, rsv);
        const int col0 = u.pn * HALF + wc * 32 + 8 * fq;
        const bool blk = u.pm < MP / BM; const int rstr = blk ? 128 : DFF * 2;
        const size_t hb0 = blk ? ((size_t)(u.pm * (DFF / 64) + (col0 >> 6)) * 32768 + (size_t)(col0 & 63) * 2) : ((size_t)u.pm * BM * DFF + col0) * 2;
#pragma unroll
        for (int ai = 0; ai < 2; ++ai)
#pragma unroll
            for (int m = 0; m < 4; ++m) { const int row = u.pm * BM + ai * HALF + wr * 64 + m * 16 + fr; const float r = rsv[ai][m]; u32x4 w;
#pragma unroll
                for (int n = 0; n < 2; ++n) { const f32x4 g = acc[ai][0][m][n] * r, uu = acc[ai][1][m][n] * r; f32x4 h;
#pragma unroll
                    for (int i = 0; i < 4; ++i) h[i] = g[i] * sigm(g[i]) * uu[i];
                    const u32x2 hw = pk4(h); if (n == 0) { w.x = hw.x; w.y = hw.y; } else { w.z = hw.x; w.w = hw.y; } }
                *(u32x4*)((char*)HB + hb0 + (size_t)(row - u.pm * BM) * rstr) = w;
                if (m & 1) EPI_FENCE(); }
    }
};
struct EpiMlaA { static constexpr bool PERM = false, AFTER_DRAIN = false;
    RowScale rs; float* ckvu; bf16_t* ckvub; float* ssqkv; bf16_t* cq; float* ssqq; bf16_t* krb; float *mrp, *mrs; const float *ropc, *rops;
    __device__ __forceinline__ void operator()(const f32x4 (&acc)[2][2][4][2], const Unit& u, int wr, int wc, int, int) const { const int lane_ = pg8_tid() & 63, fr = lane_ & 15, fq = lane_ >> 4; float rsv[2][4]; rs.get8(u.pm * BM + wr * 64 + fr, fq, rsv);
        const int cw = wc * 32 + 4 * fq;
#pragma unroll
        for (int ai = 0; ai < 2; ++ai)
#pragma unroll
            for (int m = 0; m < 4; ++m) { const int row = u.pm * BM + ai * HALF + wr * 64 + m * 16 + fr; const float r = rsv[ai][m];
                if (u.pn == 0) { float sq = 0.f;
#pragma unroll
                    for (int bj = 0; bj < 2; ++bj)
#pragma unroll
                        for (int n = 0; n < 2; ++n) { const int c = cw + bj * HALF + n * 16; const f32x4 v = acc[ai][bj][m][n] * r;
                            *(f32x4*)(ckvu + (size_t)row * 256 + c) = v; *(u32x2*)(ckvub + (size_t)row * 256 + c) = pk4(v); sq += dot4(v); }
                    sq += __shfl_xor(sq, 16); sq += __shfl_xor(sq, 32); if (fq == 0) ssqkv[(size_t)row * 4 + wc] = sq;
                } else if (u.pn == 1) { float sq = 0.f;
#pragma unroll
                    for (int bj = 0; bj < 2; ++bj)
#pragma unroll
                        for (int n = 0; n < 2; ++n) { const int c = cw + bj * HALF + n * 16; const f32x4 v = acc[ai][bj][m][n] * r;
                            *(u32x2*)(cq + (size_t)row * 384 + c) = pk4(v); sq += dot4(v); }
                    sq += __shfl_xor(sq, 16); sq += __shfl_xor(sq, 32); if (fq == 0) ssqq[(size_t)row * 8 + wc] = sq;
                } else { float sq = 0.f;
#pragma unroll
                    for (int n = 0; n < 2; ++n) { const int c = 256 + cw + n * 16; const f32x4 v = acc[ai][0][m][n] * r;
                        *(u32x2*)(cq + (size_t)row * 384 + c) = pk4(v); sq += dot4(v); }
                    sq += __shfl_xor(sq, 16); sq += __shfl_xor(sq, 32); if (fq == 0) ssqq[(size_t)row * 8 + 4 + wc] = sq;
                    if (wc == 0) { const int pos = row_pos(row); const f32x4 cs = *(const f32x4*)(ropc + pos * 16 + 4 * fq), sn = *(const f32x4*)(rops + pos * 16 + 4 * fq);
                        const f32x4 x1 = acc[ai][1][m][0] * r, x2 = acc[ai][1][m][1] * r; const f32x4 o1 = x1 * cs - x2 * sn, o2 = x1 * sn + x2 * cs;
                        *(u32x2*)(krb + (size_t)row * 32 + 4 * fq) = pk4(o1); *(u32x2*)(krb + (size_t)row * 32 + 16 + 4 * fq) = pk4(o2);
                        float* F = (row < MP) ? mrp + (size_t)row * 32 : mrs + (size_t)(row - MP) * 32;
                        *(f32x4*)(F + 4 * fq) = o1; *(f32x4*)(F + 16 + 4 * fq) = o2; }
                }
                if (m & 1) EPI_FENCE(); }
    }
};
struct EpiMlaQ { static constexpr bool PERM = false, AFTER_DRAIN = false;
    RowScale rs; bf16_t* QM; const float *ropc, *rops;
    __device__ __forceinline__ void operator()(const f32x4 (&acc)[2][2][4][2], const Unit& u, int wr, int wc, int, int) const { const int lane_ = pg8_tid() & 63, fr = lane_ & 15, fq = lane_ >> 4; float rsv[2][4]; rs.get8(u.pm * BM + wr * 64 + fr, fq, rsv);
#pragma unroll
        for (int ai = 0; ai < 2; ++ai)
#pragma unroll
            for (int m = 0; m < 4; ++m) { const int row = u.pm * BM + ai * HALF + wr * 64 + m * 16 + fr; const float r = rsv[ai][m] * C2_MLA;
                const int pos = row_pos(row);
#pragma unroll
                for (int bj = 0; bj < 2; ++bj) { const int g32 = u.pn * 8 + bj * 4 + wc; const int c = g32 * 32 + 4 * fq; bf16_t* o = QM + (size_t)row * 1536 + c;
                    if ((g32 % 3) == 2) { const f32x4 cs = *(const f32x4*)(ropc + pos * 16 + 4 * fq), sn = *(const f32x4*)(rops + pos * 16 + 4 * fq);
                        const f32x4 x1 = acc[ai][bj][m][0] * r, x2 = acc[ai][bj][m][1] * r;
                        *(u32x2*)(o) = pk4(x1 * cs - x2 * sn); *(u32x2*)(o + 16) = pk4(x1 * sn + x2 * cs);
                    } else { *(u32x2*)(o) = pk4(acc[ai][bj][m][0] * r); *(u32x2*)(o + 16) = pk4(acc[ai][bj][m][1] * r); } }
                EPI_FENCE(); }
    }
};
struct EpiNull { static constexpr bool PERM = true, AFTER_DRAIN = false;
    __device__ __forceinline__ void operator()(const f32x4 (&acc)[2][2][4][2], const Unit&, int, int, int, int) const {
#pragma unroll
        for (int ai = 0; ai < 2; ++ai)
#pragma unroll
            for (int bj = 0; bj < 2; ++bj)
#pragma unroll
                for (int m = 0; m < 4; ++m)
#pragma unroll
                    for (int n = 0; n < 2; ++n) asm volatile("" :: "v"(acc[ai][bj][m][n])); }
};
struct EpiMemKV { static constexpr bool PERM = false, AFTER_DRAIN = false;
    float* outk; float* outv; bf16_t* MKB; bf16_t* MVB;
    __device__ __forceinline__ void operator()(const f32x4 (&acc)[2][2][4][2], const Unit& u, int wr, int wc, int, int) const { const int lane_ = pg8_tid() & 63, fr = lane_ & 15, fq = lane_ >> 4;
        const int l = u.pn >> 3, cw0 = (u.pn & 7) * 256; const bool isv = cw0 >= 1024; const int cbase = (cw0 & 1023) + wc * 32 + 4 * fq;
#pragma unroll
        for (int ai = 0; ai < 2; ++ai)
#pragma unroll
            for (int m = 0; m < 4; ++m) { const int row = u.pm * BM + ai * HALF + wr * 64 + m * 16 + fr; const int b = row >> 8, nn = row & 255;
#pragma unroll
                for (int bj = 0; bj < 2; ++bj)
#pragma unroll
                    for (int n = 0; n < 2; ++n) { const int c = cbase + bj * HALF + n * 16; const f32x4 v = acc[ai][bj][m][n]; const size_t o = ((size_t)l * 2048 + row) * 1024 + c;
                        if (!isv) { *(f32x4*)(outk + o) = v; *(u32x2*)(MKB + o) = pk4(v); } else { *(f32x4*)(outv + o) = v; *(u32x2*)(MVB + o) = pk4(v); } }
                if (m & 1) EPI_FENCE(); }
    }
};

template <class Epi, class Sched, bool ALIGN_EPI = false, bool SP2 = false, bool ABLK = false>
__device__ __forceinline__ void gemm_phase(PG8_LAS unsigned char* lds, const Gemm g, const Sched& S, const Epi& E) {
    const int tid = pg8_tid(), wid = __builtin_amdgcn_readfirstlane(tid >> 6), lane = tid & 63, wr = wid >> 2, wc = wid & 3, fr = lane & 15, fq = lane >> 4;
    const int K = g.K, nt = K / BK;
    unsigned voffA[2], voffB[2];
#pragma unroll
    for (int i = 0; i < 2; ++i) { int R, C; stage_rc(tid * 16 + i * 8192, R, C); const int Rb = Epi::PERM ? ((R & ~31) + perm32(R & 31)) : R;
        voffA[i] = ABLK ? (unsigned)(R * BK + C) * 2u : (unsigned)(R * K + C) * 2u; voffB[i] = (unsigned)(Rb * K + C) * 2u; }
    const size_t kstep = (size_t)(BK * 2);
    const size_t hstep = (size_t)HALF * K * 2;
    const size_t tstep = 2 * hstep;
    const size_t kstepA = ABLK ? (size_t)BM * BK * 2 : kstep, hstepA = ABLK ? (size_t)HALF * BK * 2 : hstep, tstepA = ABLK ? (size_t)nt * BM * BK * 2 : tstep;
    const unsigned ldsw = (unsigned)wid * 1024u;
    const int aoff = lds_byte(wr * 64 + fr, fq * 8), boff = lds_byte(wc * 32 + fr, fq * 8);
#define PG8_SA(b, h) (((b) * 2 + (h)) * HTB)
#define PG8_SB(b, h) ((4 + (b) * 2 + (h)) * HTB)
#define PG8_STAGE(bufoff, gbase, voff) do { _Pragma("unroll") for (int _i = 0; _i < 2; ++_i) \
        __builtin_amdgcn_global_load_lds((const unsigned*)((const char*)(gbase) + (voff)[_i]), (PG8_LAS unsigned*)(lds + (bufoff) + ldsw + _i * 8192), 16, 0, 0); } while (0)
#define PG8_LDA(dst, b, h) do { _Pragma("unroll") for (int m = 0; m < 4; ++m) _Pragma("unroll") for (int k = 0; k < 2; ++k) dst[m][k] = *(const PG8_LAS bf16x8*)(lds + PG8_SA(b, h) + aoff + m * 2048 + k * 1024); } while (0)
#define PG8_LDB(dst, b, h) do { _Pragma("unroll") for (int n = 0; n < 2; ++n) _Pragma("unroll") for (int k = 0; k < 2; ++k) dst[n][k] = *(const PG8_LAS bf16x8*)(lds + PG8_SB(b, h) + boff + n * 2048 + k * 1024); } while (0)
#define PG8_MMA(ai, bj, At, Bt) do { __builtin_amdgcn_s_setprio(1); _Pragma("unroll") for (int m = 0; m < 4; ++m) _Pragma("unroll") for (int n = 0; n < 2; ++n) _Pragma("unroll") for (int k = 0; k < 2; ++k) \
        acc[ai][bj][m][n] = __builtin_amdgcn_mfma_f32_16x16x32_bf16(Bt[n][k], At[m][k], acc[ai][bj][m][n], 0, 0, 0); __builtin_amdgcn_s_setprio(0); } while (0)
#define PG8_WAIT_V(n) asm volatile("s_waitcnt vmcnt(" #n ")" ::: "memory")
#define PG8_WAIT_L(n) asm volatile("s_waitcnt lgkmcnt(" #n ")" ::: "memory")
#define PG8_BAR __builtin_amdgcn_s_barrier()
#define PG8_SCHED __builtin_amdgcn_sched_barrier(0)
    Unit cur, nxt; int ui = 0;
    if (!S.next(0, cur)) return;
    f32x4 acc[2][2][4][2];
#pragma unroll
    for (int a = 0; a < 2; ++a)
#pragma unroll
        for (int b = 0; b < 2; ++b)
#pragma unroll
            for (int m = 0; m < 4; ++m)
#pragma unroll
                for (int n = 0; n < 2; ++n) acc[a][b][m][n] = (f32x4){0.f, 0.f, 0.f, 0.f};
    bf16x8 At[4][2], B0[2][2], B1[2][2];
    const char* cA = (const char*)g.A + (size_t)cur.pm * tstepA; const char* cB = (const char*)g.Bt + (size_t)cur.pn * tstep;
    S.a_ready(cur);
    if constexpr (SP2) {
        PG8_STAGE(PG8_SB(0, 0), cB, voffB); PG8_STAGE(PG8_SB(0, 1), cB + hstep, voffB); PG8_STAGE(PG8_SA(0, 0), cA, voffA); PG8_STAGE(PG8_SA(0, 1), cA + hstepA, voffA);
        if (wr == 1) PG8_BAR;
        PG8_WAIT_V(2); PG8_BAR;
        PG8_STAGE(PG8_SB(1, 0), cB + kstep, voffB); PG8_STAGE(PG8_SA(1, 0), cA + kstepA, voffA); PG8_STAGE(PG8_SB(1, 1), cB + hstep + kstep, voffB);
        PG8_WAIT_V(6); PG8_BAR;
    } else {
        PG8_STAGE(PG8_SB(0, 0), cB, voffB); PG8_STAGE(PG8_SA(0, 0), cA, voffA); PG8_STAGE(PG8_SB(0, 1), cB + hstep, voffB); PG8_STAGE(PG8_SA(0, 1), cA + hstepA, voffA);
        if (wr == 1) PG8_BAR;
        PG8_WAIT_V(4); PG8_BAR;
        PG8_STAGE(PG8_SB(1, 0), cB + kstep, voffB); PG8_STAGE(PG8_SA(1, 0), cA + kstepA, voffA); PG8_STAGE(PG8_SB(1, 1), cB + hstep + kstep, voffB);
        PG8_WAIT_V(6); PG8_BAR;
    }
    for (;;) {
        const bool has_next = S.next(ui + 1, nxt);
        const char* nA = has_next ? (const char*)g.A + (size_t)nxt.pm * tstepA : cA; const char* nB = has_next ? (const char*)g.Bt + (size_t)nxt.pn * tstep : cB;
        for (int t = 0; t < nt; t += 2) {
            const bool last = (t == nt - 2);
            const char* a1 = cA + (size_t)(t + 1) * kstepA;
            const char* a2 = last ? nA : cA + (size_t)(t + 2) * kstepA; const char* b2 = last ? nB : cB + (size_t)(t + 2) * kstep;
            const char* a3 = a2 + kstepA; const char* b3 = b2 + kstep;
            if (last && has_next) S.a_ready(nxt);
            if constexpr (SP2) {
            PG8_LDB(B0, 0, 0); PG8_LDB(B1, 0, 1); PG8_SCHED; PG8_LDA(At, 0, 0); PG8_STAGE(PG8_SA(1, 1), a1 + hstepA, voffA);
            PG8_WAIT_V(8); PG8_WAIT_L(0); PG8_BAR; PG8_MMA(0, 0, At, B0); PG8_MMA(0, 1, At, B1); PG8_BAR; PG8_SCHED;
            PG8_LDA(At, 0, 1); PG8_STAGE(PG8_SB(0, 0), b2, voffB); PG8_STAGE(PG8_SB(0, 1), b2 + hstep, voffB); PG8_STAGE(PG8_SA(0, 0), a2, voffA);
            PG8_WAIT_V(8); PG8_WAIT_L(0); PG8_BAR; PG8_MMA(1, 0, At, B0); PG8_MMA(1, 1, At, B1); PG8_BAR; PG8_SCHED;
            PG8_LDB(B0, 1, 0); PG8_LDB(B1, 1, 1); PG8_SCHED; PG8_LDA(At, 1, 0); PG8_STAGE(PG8_SA(0, 1), a2 + hstepA, voffA);
            PG8_WAIT_V(8); PG8_WAIT_L(0); PG8_BAR; PG8_MMA(0, 0, At, B0); PG8_MMA(0, 1, At, B1); PG8_BAR; PG8_SCHED;
            PG8_LDA(At, 1, 1); PG8_STAGE(PG8_SB(1, 0), b3, voffB); PG8_STAGE(PG8_SB(1, 1), b3 + hstep, voffB); PG8_STAGE(PG8_SA(1, 0), a3, voffA);
            PG8_WAIT_V(8); PG8_WAIT_L(0); PG8_BAR; PG8_MMA(1, 0, At, B0); PG8_MMA(1, 1, At, B1); PG8_BAR; PG8_SCHED;
            } else {
            PG8_LDB(B0, 0, 0); PG8_SCHED; PG8_LDA(At, 0, 0); PG8_STAGE(PG8_SA(1, 1), a1 + hstepA, voffA);
            PG8_WAIT_L(8); PG8_BAR; PG8_WAIT_L(0); PG8_MMA(0, 0, At, B0); PG8_BAR; PG8_SCHED;
            PG8_LDB(B1, 0, 1); PG8_STAGE(PG8_SB(0, 0), b2, voffB);
            PG8_BAR; PG8_WAIT_L(0); PG8_MMA(0, 1, At, B1); PG8_BAR;
            PG8_LDA(At, 0, 1); PG8_STAGE(PG8_SA(0, 0), a2, voffA);
            PG8_BAR; PG8_WAIT_L(0); PG8_MMA(1, 0, At, B0); PG8_BAR; PG8_SCHED;
            PG8_STAGE(PG8_SB(0, 1), b2 + hstep, voffB);
            PG8_WAIT_V(6); PG8_BAR; PG8_MMA(1, 1, At, B1); PG8_BAR;
            PG8_LDB(B0, 1, 0); PG8_SCHED; PG8_LDA(At, 1, 0); PG8_STAGE(PG8_SA(0, 1), a2 + hstepA, voffA);
            PG8_WAIT_L(8); PG8_BAR; PG8_WAIT_L(0); PG8_MMA(0, 0, At, B0); PG8_BAR; PG8_SCHED;
            PG8_LDB(B1, 1, 1); PG8_STAGE(PG8_SB(1, 0), b3, voffB);
            PG8_BAR; PG8_WAIT_L(0); PG8_MMA(0, 1, At, B1); PG8_BAR;
            PG8_LDA(At, 1, 1); PG8_STAGE(PG8_SA(1, 0), a3, voffA);
            PG8_BAR; PG8_WAIT_L(0); PG8_MMA(1, 0, At, B0); PG8_BAR; PG8_SCHED;
            PG8_STAGE(PG8_SB(1, 1), b3 + hstep, voffB);
            PG8_WAIT_V(6); PG8_BAR; PG8_MMA(1, 1, At, B1); PG8_BAR;
            }
        }
        if constexpr (ALIGN_EPI) { if (wr == 0) PG8_BAR; }
        if constexpr (!Epi::AFTER_DRAIN) { E(acc, cur, wr, wc, fr, fq); S.done(cur); }
        if (!has_next) break;
#pragma unroll
        for (int a = 0; a < 2; ++a)
#pragma unroll
            for (int b = 0; b < 2; ++b)
#pragma unroll
                for (int m = 0; m < 4; ++m)
#pragma unroll
                    for (int n = 0; n < 2; ++n) acc[a][b][m][n] = (f32x4){0.f, 0.f, 0.f, 0.f};
        cur = nxt; cA = nA; cB = nB; ++ui;
        if constexpr (ALIGN_EPI) { if (wr == 1) PG8_BAR; }
    }
    PG8_WAIT_V(0);
    if constexpr (!ALIGN_EPI) { if (wr == 0) PG8_BAR; }
    PG8_BAR;
    if constexpr (Epi::AFTER_DRAIN) { E.fused(acc, cur, wr, wc, fr, fq, lds, wid, lane); S.done(cur); }
#undef PG8_SA
#undef PG8_SB
#undef PG8_STAGE
#undef PG8_LDA
#undef PG8_LDB
#undef PG8_MMA
#undef PG8_WAIT_V
#undef PG8_WAIT_L
#undef PG8_BAR
#undef PG8_SCHED
}
}

#define GAS __attribute__((address_space(1)))
#define LAS __attribute__((address_space(3)))
typedef unsigned short bf16;
typedef float f32x4 __attribute__((ext_vector_type(4)));
typedef float f32x16 __attribute__((ext_vector_type(16)));
typedef short bf16x8 __attribute__((ext_vector_type(8)));
typedef short s16x4 __attribute__((ext_vector_type(4)));
typedef unsigned u32x4 __attribute__((ext_vector_type(4)));
typedef unsigned u32x2 __attribute__((ext_vector_type(2)));
typedef GAS unsigned gu32;
#define RLX_AGENT __ATOMIC_RELAXED, __HIP_MEMORY_SCOPE_AGENT
#define LDS_WAIT() asm volatile("s_waitcnt lgkmcnt(0)" ::: "memory")
#define VM_WAIT() asm volatile("s_waitcnt vmcnt(0)" ::: "memory")
__device__ __forceinline__ unsigned pk2(float lo, float hi) { return pg8::pk_bf16(lo, hi); }
__device__ __forceinline__ float bf2f(unsigned short b) { return __builtin_bit_cast(float, (unsigned)b << 16); }
__device__ __forceinline__ float ex2(float x) { return __builtin_amdgcn_exp2f(x); }
__device__ __forceinline__ float wave_sum(float v) {
#pragma unroll
    for (int o = 1; o < 64; o <<= 1) v += __shfl_xor(v, o);
    return v;
}

namespace fa {
constexpr int KSLOT = 12288, VSLOT = 8192;
constexpr int L_K = 0, L_V = 2 * KSLOT, L_WS = L_V + 2 * VSLOT, L_OST = L_WS + 8 * 64 * 4, L_BYTES = L_OST + 8 * 32 * 64 * 4;
constexpr int L_WS2 = L_V + 3 * VSLOT, L_CB2 = L_WS2 + 8 * 128 * 4, L_OST2 = L_CB2 + 512, L_QR2 = L_OST2 + 8 * 4096, L_BYTES2 = L_QR2 + 8 * 4096;
__device__ __forceinline__ int crow(int r, int hi) { return (r & 3) + 8 * (r >> 2) + 4 * hi; }
__device__ __forceinline__ void glds16(const void* gsrc, unsigned lds_dst) { unsigned keep;
    asm volatile("s_mov_b32 %0, m0\n\ts_mov_b32 m0, %2\n\ts_nop 0\n\tglobal_load_lds_dwordx4 %1, off\n\ts_mov_b32 m0, %0" : "=&s"(keep) : "v"(gsrc), "s"(lds_dst) : "memory"); }
#define FA_WAIT_BAR() asm volatile("s_waitcnt vmcnt(0) lgkmcnt(0)\n\ts_barrier" ::: "memory")
#define FA_SBAR() __builtin_amdgcn_sched_barrier(0)
template <int ND0> __device__ __forceinline__ void qkt(f32x16& p0, f32x16& p1, const LAS char* kp, const bf16x8* qr) {
    p0 = f32x16{}; p1 = f32x16{};
#pragma unroll
    for (int d0 = 0; d0 < ND0; ++d0) {
        const bf16x8 b0 = *(const LAS bf16x8*)(kp + d0 * 2048);
        const bf16x8 b1 = *(const LAS bf16x8*)(kp + d0 * 2048 + 512);
        p0 = __builtin_amdgcn_mfma_f32_32x32x16_bf16(b0, qr[d0], p0, 0, 0, 0); p1 = __builtin_amdgcn_mfma_f32_32x32x16_bf16(b1, qr[d0], p1, 0, 0, 0); }
}
__device__ __forceinline__ float max3f(float a, float b, float c) { float r; asm("v_max3_f32 %0, %1, %2, %3" : "=v"(r) : "v"(a), "v"(b), "v"(c)); return r; }
__device__ __forceinline__ float max2f(float a, float b) { float r; asm("v_max_f32_e32 %0, %1, %2" : "=v"(r) : "v"(a), "v"(b)); return r; }
__device__ __forceinline__ float rowmax_a(const f32x16& p0, const f32x16& p1) {
    float a = max3f(p0[0], p0[1], p1[0]), b = max3f(p0[2], p0[3], p1[1]); a = max3f(a, p1[2], p1[3]);
#pragma unroll
    for (int r = 4; r < 16; r += 4) { a = max3f(a, p0[r], p0[r + 1]); b = max3f(b, p0[r + 2], p0[r + 3]); a = max3f(a, p1[r], p1[r + 1]); b = max3f(b, p1[r + 2], p1[r + 3]); }
    const float m = max2f(a, b);
    auto rr = __builtin_amdgcn_permlane32_swap(__float_as_uint(m), __float_as_uint(m), false, false);
    return max2f(__uint_as_float(rr[0]), __uint_as_float(rr[1]));
}
__device__ __forceinline__ float rowmax(const f32x16& p0, const f32x16& p1) {
    float a = __builtin_fmaxf(p0[0], p1[0]);
#pragma unroll
    for (int r = 1; r < 16; ++r) a = __builtin_fmaxf(a, __builtin_fmaxf(p0[r], p1[r]));
    auto rr = __builtin_amdgcn_permlane32_swap(__float_as_uint(a), __float_as_uint(a), false, false);
    return __builtin_fmaxf(__uint_as_float(rr[0]), __uint_as_float(rr[1]));
}
__device__ __forceinline__ void pv(f32x16* o, int vb, bf16x8 pa0, bf16x8 pa1, bf16x8 pa2, bf16x8 pa3) {
#pragma unroll
    for (int d0 = 0; d0 < 2; ++d0) { s16x4 lo[4], hi[4];
#pragma unroll
        for (int ks = 0; ks < 4; ++ks) {
            asm volatile("ds_read_b64_tr_b16 %0,%1 offset:%c2" : "=&v"(lo[ks]) : "v"(vb), "i"(d0 * 4096 + ks * 1024) : "memory");
            asm volatile("ds_read_b64_tr_b16 %0,%1 offset:%c2" : "=&v"(hi[ks]) : "v"(vb), "i"(d0 * 4096 + ks * 1024 + 512) : "memory"); }
        asm volatile("s_waitcnt lgkmcnt(0)" ::: "memory"); FA_SBAR();
#define FA_PK(k) (bf16x8){lo[k][0], lo[k][1], lo[k][2], lo[k][3], hi[k][0], hi[k][1], hi[k][2], hi[k][3]}
        o[d0] = __builtin_amdgcn_mfma_f32_32x32x16_bf16(pa0, FA_PK(0), o[d0], 0, 0, 0);
        o[d0] = __builtin_amdgcn_mfma_f32_32x32x16_bf16(pa1, FA_PK(1), o[d0], 0, 0, 0);
        o[d0] = __builtin_amdgcn_mfma_f32_32x32x16_bf16(pa2, FA_PK(2), o[d0], 0, 0, 0);
        o[d0] = __builtin_amdgcn_mfma_f32_32x32x16_bf16(pa3, FA_PK(3), o[d0], 0, 0, 0);
#undef FA_PK
    }
}
struct Args { const bf16* Q; int qpitch, qcol; const bf16* K; int kpitch, kcol; const bf16* K2; const bf16* V; int vpitch, vcol; bf16* O; int ocol; const bf16* G; const float* CB; };
template <int MODE> __device__ __forceinline__ void unit(const Args& A, long rowbase, int qb, LAS char* lds, unsigned lds0) {
    constexpr int ND0 = MODE ? 6 : 4;
    const int tid = pg8::pg8_tid(), lane = tid & 63, r32 = lane & 31, hi = lane >> 5; const int wid = __builtin_amdgcn_readfirstlane(tid >> 6);
    const int q0 = qb * 256, NT = q0 / 64 + 4, nt_w = MODE ? (q0 / 64 + (wid >> 1) + 1) : NT;
    const bf16* Qw = A.Q + (rowbase + q0 + wid * 32 + r32) * A.qpitch + A.qcol + hi * 8;
    bf16x8 qr[ND0];
#pragma unroll
    for (int d0 = 0; d0 < ND0; ++d0) qr[d0] = *(const bf16x8*)(Qw + d0 * 16);
    const bf16* ksrc = A.K + (rowbase + lane) * A.kpitch + A.kcol + wid * 8;
    const bf16* ksrc2 = MODE ? A.K2 + (rowbase + lane) * 32 + (wid & 3) * 8 : nullptr;
    const bf16* vsrc = A.V + (rowbase + 16 * (wid & 3) + (lane >> 2)) * A.vpitch + A.vcol + (wid >> 2) * 32 + (lane & 3) * 8;
#define FA_DMA(t, slot) do { \
        glds16(ksrc + (long)(t) * 64 * A.kpitch, (unsigned)__builtin_amdgcn_readfirstlane(lds0 + L_K + (slot) * KSLOT + wid * 1024)); \
        if (MODE && wid < 4) glds16(ksrc2 + (long)(t) * 64 * 32, (unsigned)__builtin_amdgcn_readfirstlane(lds0 + L_K + (slot) * KSLOT + (8 + wid) * 1024)); \
        glds16(vsrc + (long)(t) * 64 * A.vpitch, (unsigned)__builtin_amdgcn_readfirstlane(lds0 + L_V + (slot) * VSLOT + wid * 1024)); } while (0)
    LAS float* wsf = (LAS float*)(lds + L_WS) + wid * 64;
    const int vb0 = (int)(lds0 + L_V) + ((lane >> 4) & 1) * 32 + (lane & 3) * 8 + (4 * hi + ((lane & 15) >> 2)) * 64;
    float m = -1e30f, l = 0.f; f32x16 o[2]; o[0] = f32x16{}; o[1] = f32x16{};
    FA_DMA(0, 0);
    for (int t = 0; t < NT; ++t) {
        FA_WAIT_BAR();
        if (t + 1 < NT) FA_DMA(t + 1, (t + 1) & 1);
        if (t < nt_w) {
            const int slot = t & 1;
            f32x16 p0, p1; qkt<ND0>(p0, p1, lds + L_K + slot * KSLOT + hi * 1024 + r32 * 16, qr);
            if (MODE == 0) {
                const float* cb = A.CB + t * 64 + 4 * hi;
#pragma unroll
                for (int g4 = 0; g4 < 4; ++g4) { const f32x4 b0 = *(const f32x4*)(cb + 8 * g4), b1 = *(const f32x4*)(cb + 32 + 8 * g4);
#pragma unroll
                    for (int i = 0; i < 4; ++i) { p0[4 * g4 + i] += b0[i]; p1[4 * g4 + i] += b1[i]; } }
                const int jb = t - (NT - 4);
                if (jb >= 0) { const int qrel = wid * 32 + r32, kb = 64 * jb + 4 * hi;
#pragma unroll
                    for (int r = 0; r < 16; ++r) { const int kv = kb + (r & 3) + 8 * (r >> 2); if (kv > qrel) p0[r] = -INFINITY; if (kv + 32 > qrel) p1[r] = -INFINITY; } }
            }
            const float rm = rowmax(p0, p1);
            const float mn = __builtin_fmaxf(m, rm), alpha = ex2(m - mn); m = mn;
            float sacc = 0.f;
#pragma unroll
            for (int r = 0; r < 16; ++r) { p0[r] = ex2(p0[r] - mn); p1[r] = ex2(p1[r] - mn); sacc += p0[r] + p1[r]; }
            l = l * alpha + sacc;
            if (hi == 0) wsf[r32] = alpha;
#pragma unroll
            for (int r = 0; r < 16; ++r) { const float a = wsf[crow(r, hi)]; o[0][r] *= a; o[1][r] *= a; }
            u32x4 pw0, pw1, pw2, pw3;
            pw0 = (u32x4){pk2(p0[0], p0[1]), pk2(p0[2], p0[3]), pk2(p0[4], p0[5]), pk2(p0[6], p0[7])};
            pw1 = (u32x4){pk2(p0[8], p0[9]), pk2(p0[10], p0[11]), pk2(p0[12], p0[13]), pk2(p0[14], p0[15])};
            pw2 = (u32x4){pk2(p1[0], p1[1]), pk2(p1[2], p1[3]), pk2(p1[4], p1[5]), pk2(p1[6], p1[7])};
            pw3 = (u32x4){pk2(p1[8], p1[9]), pk2(p1[10], p1[11]), pk2(p1[12], p1[13]), pk2(p1[14], p1[15])};
            FA_SBAR();
            pv(o, vb0 + slot * VSLOT, __builtin_bit_cast(bf16x8, pw0), __builtin_bit_cast(bf16x8, pw1), __builtin_bit_cast(bf16x8, pw2), __builtin_bit_cast(bf16x8, pw3));
        }
    }
    { auto rr = __builtin_amdgcn_permlane32_swap(__float_as_uint(l), __float_as_uint(l), false, false); l = __uint_as_float(rr[0]) + __uint_as_float(rr[1]); }
    if (hi == 0) wsf[32 + r32] = l;
    LAS float* stg = (LAS float*)(lds + L_OST) + wid * 2048;
#pragma unroll
    for (int r = 0; r < 16; ++r) { const int orow = crow(r, hi); const float rl = __builtin_amdgcn_rcpf(wsf[32 + orow]);
        stg[orow * 64 + r32] = o[0][r] * rl; stg[orow * 64 + 32 + r32] = o[1][r] * rl; }
    LDS_WAIT();
#pragma unroll
    for (int i = 0; i < 4; ++i) { const int row = i * 8 + (lane >> 3), ch = lane & 7; const long grow = rowbase + q0 + wid * 32 + row;
        f32x4 a = *(const LAS f32x4*)(stg + row * 64 + ch * 8), b = *(const LAS f32x4*)(stg + row * 64 + ch * 8 + 4);
        if (MODE == 0) { const u32x4 g = *(const u32x4*)(A.G + grow * 1024 + A.ocol + ch * 8);
            a[0] *= __uint_as_float(g.x << 16); a[1] *= __uint_as_float(g.x & 0xffff0000u); a[2] *= __uint_as_float(g.y << 16); a[3] *= __uint_as_float(g.y & 0xffff0000u);
            b[0] *= __uint_as_float(g.z << 16); b[1] *= __uint_as_float(g.z & 0xffff0000u); b[2] *= __uint_as_float(g.w << 16); b[3] *= __uint_as_float(g.w & 0xffff0000u); }
        const u32x4 w = (u32x4){pk2(a[0], a[1]), pk2(a[2], a[3]), pk2(b[0], b[1]), pk2(b[2], b[3])};
        *(u32x4*)(A.O + grow * 1024 + A.ocol + ch * 8) = w; }
    asm volatile("s_waitcnt lgkmcnt(0)\n\ts_barrier" ::: "memory");
#undef FA_DMA
}

#ifndef FA_STAG_FOX
#define FA_STAG_FOX 1
#endif
#ifndef FA_STAG_MLA
#define FA_STAG_MLA 1
#endif
#ifndef FA_PROBE_VALU
#define FA_PROBE_VALU 0
#endif
__device__ __forceinline__ void glds4(const void* gsrc, unsigned lds_dst) { unsigned keep;
    asm volatile("s_mov_b32 %0, m0\n\ts_mov_b32 m0, %2\n\ts_nop 0\n\tglobal_load_lds_dword %1, off\n\ts_mov_b32 m0, %0" : "=&s"(keep) : "v"(gsrc), "s"(lds_dst) : "memory"); }
__device__ __forceinline__ s16x4 vtr(const LAS char* p) { typedef short v4i16_t __attribute__((ext_vector_type(4))); return __builtin_bit_cast(s16x4, __builtin_amdgcn_ds_read_tr16_b64_v4i16((LAS v4i16_t*)p)); }
template <int MODE, bool DIAG> __device__ __forceinline__ void tile_qs(const LAS char* kp, const bf16x8 (&qr)[2][4], const LAS char* qrl, const LAS float* cbl, int r32, int hi,
                                                                     float (&m)[2], float (&l)[2], f32x16 (&o)[2][2], LAS float* wsf, u32x4 (&pw)[2][4]) {
    constexpr int ND0 = MODE ? 6 : 4;
    f32x16 p[2][2];
    if (MODE == 0) {
#pragma unroll
        for (int g4 = 0; g4 < 4; ++g4) { const f32x4 b0 = *(const LAS f32x4*)(cbl + 4 * hi + 8 * g4), b1 = *(const LAS f32x4*)(cbl + 32 + 4 * hi + 8 * g4);
#pragma unroll
            for (int i = 0; i < 4; ++i) { p[0][0][4 * g4 + i] = b0[i]; p[0][1][4 * g4 + i] = b1[i]; } }
        p[1][0] = p[0][0]; p[1][1] = p[0][1];
    } else {
#pragma unroll
        for (int b2 = 0; b2 < 2; ++b2) { p[b2][0] = f32x16{}; p[b2][1] = f32x16{}; }
    }
    bf16x8 qx[2][2];
    if (MODE) {
#pragma unroll
        for (int b2 = 0; b2 < 2; ++b2) { qx[b2][0] = *(const LAS bf16x8*)(qrl + (b2 * 2) * 1024); qx[b2][1] = *(const LAS bf16x8*)(qrl + (b2 * 2 + 1) * 1024); } }
#pragma unroll
    for (int d0 = 0; d0 < ND0; ++d0) { const bf16x8 k0 = *(const LAS bf16x8*)(kp + d0 * 2048), k1 = *(const LAS bf16x8*)(kp + d0 * 2048 + 512);
#pragma unroll
        for (int b2 = 0; b2 < 2; ++b2) { const bf16x8 qv = (d0 < 4) ? qr[b2][d0 & 3] : qx[b2][d0 & 1];
            p[b2][0] = __builtin_amdgcn_mfma_f32_32x32x16_bf16(k0, qv, p[b2][0], 0, 0, 0); p[b2][1] = __builtin_amdgcn_mfma_f32_32x32x16_bf16(k1, qv, p[b2][1], 0, 0, 0); } }
    if (MODE == 0 && DIAG) {
#pragma unroll
        for (int b2 = 0; b2 < 2; ++b2) { const int qrel = 32 * b2 + r32;
#pragma unroll
            for (int r = 0; r < 16; ++r) { const int kv = 4 * hi + (r & 3) + 8 * (r >> 2); if (kv > qrel) p[b2][0][r] = -INFINITY; if (kv + 32 > qrel) p[b2][1][r] = -INFINITY; } } }
    asm volatile("s_nop 15\n\ts_nop 7" : "+v"(p[0][0]), "+v"(p[0][1]), "+v"(p[1][0]), "+v"(p[1][1]));
#if FA_PROBE_VALU
    { float dd[8];
#pragma unroll
      for (int i = 0; i < 8; ++i) dd[i] = m[0] + (float)i;
#pragma unroll
      for (int k = 0; k < FA_PROBE_VALU; ++k)
#pragma unroll
        for (int i = 0; i < 8; ++i) dd[i] = ex2(dd[i]);
#pragma unroll
      for (int i = 0; i < 8; ++i) asm volatile("" :: "v"(dd[i])); }
#endif
#pragma unroll
    for (int b2 = 0; b2 < 2; ++b2) {
        const float rm = rowmax_a(p[b2][0], p[b2][1]);
        const float mn = max2f(m[b2], rm); float alpha = m[b2] - mn; asm("v_exp_f32 %0, %0\n\ts_nop 0" : "+v"(alpha)); m[b2] = mn;
        float sa0 = 0.f, sa1 = 0.f;
#pragma unroll
        for (int r = 0; r < 16; r += 2) { float a = p[b2][0][r] - mn, b = p[b2][1][r] - mn, c = p[b2][0][r + 1] - mn, d = p[b2][1][r + 1] - mn;
            asm("v_exp_f32 %0, %0\n\tv_exp_f32 %1, %1\n\tv_exp_f32 %2, %2\n\tv_exp_f32 %3, %3\n\tv_add_f32 %4, %4, %0\n\tv_add_f32 %5, %5, %1\n\tv_add_f32 %4, %4, %2\n\tv_add_f32 %5, %5, %3"
                : "+v"(a), "+v"(b), "+v"(c), "+v"(d), "+v"(sa0), "+v"(sa1));
            p[b2][0][r] = a; p[b2][1][r] = b; p[b2][0][r + 1] = c; p[b2][1][r + 1] = d; }
        l[b2] = l[b2] * alpha + (sa0 + sa1);
#pragma unroll
        for (int r = 0; r < 16; ++r) { float t0 = o[b2][0][r], t1 = o[b2][1][r]; asm("v_mul_f32 %0, %0, %1" : "+v"(t0) : "v"(alpha)); asm("v_mul_f32 %0, %0, %1" : "+v"(t1) : "v"(alpha)); o[b2][0][r] = t0; o[b2][1][r] = t1; }
        pw[b2][0] = (u32x4){pk2(p[b2][0][0], p[b2][0][1]), pk2(p[b2][0][2], p[b2][0][3]), pk2(p[b2][0][4], p[b2][0][5]), pk2(p[b2][0][6], p[b2][0][7])};
        pw[b2][1] = (u32x4){pk2(p[b2][0][8], p[b2][0][9]), pk2(p[b2][0][10], p[b2][0][11]), pk2(p[b2][0][12], p[b2][0][13]), pk2(p[b2][0][14], p[b2][0][15])};
        pw[b2][2] = (u32x4){pk2(p[b2][1][0], p[b2][1][1]), pk2(p[b2][1][2], p[b2][1][3]), pk2(p[b2][1][4], p[b2][1][5]), pk2(p[b2][1][6], p[b2][1][7])};
        pw[b2][3] = (u32x4){pk2(p[b2][1][8], p[b2][1][9]), pk2(p[b2][1][10], p[b2][1][11]), pk2(p[b2][1][12], p[b2][1][13]), pk2(p[b2][1][14], p[b2][1][15])};
    }
    asm volatile("s_nop 1" : "+v"(o[0][0]), "+v"(o[0][1]), "+v"(o[1][0]), "+v"(o[1][1]));
}
__device__ __forceinline__ void tile_pv(const LAS char* vp, f32x16 (&o)[2][2], const u32x4 (&pw)[2][4]) {
#pragma unroll
    for (int d0 = 0; d0 < 2; ++d0)
#pragma unroll
        for (int ks = 0; ks < 4; ++ks) { const s16x4 lo = vtr(vp + d0 * 4096 + ks * 1024), hi4 = vtr(vp + d0 * 4096 + ks * 1024 + 512);
            const bf16x8 vf = (bf16x8){lo[0], lo[1], lo[2], lo[3], hi4[0], hi4[1], hi4[2], hi4[3]};
#pragma unroll
            for (int b2 = 0; b2 < 2; ++b2) o[b2][d0] = __builtin_amdgcn_mfma_f32_32x32x16_bf16(vf, __builtin_bit_cast(bf16x8, pw[b2][ks]), o[b2][d0], 0, 0, 0); }
}
template <int MODE> __device__ __forceinline__ void unit2(const Args& A, long rowbase, int qb, LAS char* lds, unsigned lds0) {
    constexpr int ND0 = MODE ? 6 : 4;
    const int tid = pg8::pg8_tid(), lane = tid & 63, r32 = lane & 31, hi = lane >> 5; const int wid = __builtin_amdgcn_readfirstlane(tid >> 6);
    const int q0 = qb * 512, NT = q0 / 64 + 8, nt_w = q0 / 64 + wid + 1;
    bf16x8 qr[2][4];
    LAS char* qrl = lds + L_QR2 + wid * 4096 + lane * 16;
#pragma unroll
    for (int b2 = 0; b2 < 2; ++b2) { const bf16* Qw = A.Q + (rowbase + q0 + wid * 64 + b2 * 32 + r32) * A.qpitch + A.qcol + hi * 8;
#pragma unroll
        for (int d0 = 0; d0 < 4; ++d0) qr[b2][d0] = *(const bf16x8*)(Qw + d0 * 16);
        if (MODE) { *(LAS bf16x8*)(qrl + (b2 * 2) * 1024) = *(const bf16x8*)(Qw + 64); *(LAS bf16x8*)(qrl + (b2 * 2 + 1) * 1024) = *(const bf16x8*)(Qw + 80); } }
    const int koff = lane * A.kpitch + A.kcol + wid * 8, k2off = lane * 32 + (wid & 3) * 8, voff = (16 * (wid & 3) + (lane >> 2)) * A.vpitch + A.vcol + (wid >> 2) * 32 + (lane & 3) * 8;
    const bf16* Kb = A.K + rowbase * A.kpitch; const bf16* K2b = MODE ? A.K2 + rowbase * 32 : nullptr; const bf16* Vb = A.V + rowbase * A.vpitch;
#define FA_DMA(t, slot) do { \
        int ko_ = koff, k2o_ = k2off, vo_ = voff; asm volatile("" : "+v"(ko_), "+v"(k2o_), "+v"(vo_)); \
        glds16(Kb + (long)(t) * 64 * A.kpitch + ko_, (unsigned)__builtin_amdgcn_readfirstlane(lds0 + L_K + (slot) * KSLOT + wid * 1024)); \
        if (MODE && wid < 4) glds16(K2b + (long)(t) * 64 * 32 + k2o_, (unsigned)__builtin_amdgcn_readfirstlane(lds0 + L_K + (slot) * KSLOT + (8 + wid) * 1024)); \
        glds16(Vb + (long)(t) * 64 * A.vpitch + vo_, (unsigned)__builtin_amdgcn_readfirstlane(lds0 + L_V + ((t) % 3) * VSLOT + wid * 1024)); \
        if (!MODE && wid == 4) glds4(A.CB + (t) * 64 + lane, (unsigned)__builtin_amdgcn_readfirstlane(lds0 + L_CB2 + (slot) * 256)); } while (0)
    LAS float* wsf = (LAS float*)(lds + L_WS2) + wid * 128;
    const LAS char* kp0 = lds + L_K + hi * 1024 + r32 * 16;
    const LAS char* vp0 = lds + L_V + ((lane >> 4) & 1) * 32 + (lane & 3) * 8 + (4 * hi + ((lane & 15) >> 2)) * 64;
    float m[2] = {-1e30f, -1e30f}, l[2] = {0.f, 0.f}; f32x16 o[2][2];
#pragma unroll
    for (int b2 = 0; b2 < 2; ++b2) { o[b2][0] = f32x16{}; o[b2][1] = f32x16{}; }
    FA_DMA(0, 0);
    u32x4 pw[2][4];
#define FA_STEP_HEAD(t) FA_WAIT_BAR(); if ((t) + 1 < NT) FA_DMA((t) + 1, ((t) + 1) & 1); const int slot = (t) & 1; const LAS float* cbl = (const LAS float*)(lds + L_CB2 + slot * 256)
    if (wid < 4 || !(MODE ? FA_STAG_MLA : FA_STAG_FOX)) {
        int t = 0;
        for (; t < nt_w - 1; ++t) { FA_STEP_HEAD(t); tile_qs<MODE, false>(kp0 + slot * KSLOT, qr, qrl, cbl, r32, hi, m, l, o, wsf, pw); tile_pv(vp0 + (t % 3) * VSLOT, o, pw); }
        { FA_STEP_HEAD(t); tile_qs<MODE, true>(kp0 + slot * KSLOT, qr, qrl, cbl, r32, hi, m, l, o, wsf, pw); tile_pv(vp0 + (t % 3) * VSLOT, o, pw); ++t; }
        for (; t < NT; ++t) { FA_STEP_HEAD(t); (void)slot; (void)cbl; }
    } else {
        int t = 0;
        if (nt_w > 1) { FA_STEP_HEAD(0); tile_qs<MODE, false>(kp0 + slot * KSLOT, qr, qrl, cbl, r32, hi, m, l, o, wsf, pw); t = 1;
            for (; t < nt_w - 1; ++t) { FA_STEP_HEAD(t); tile_pv(vp0 + ((t - 1) % 3) * VSLOT, o, pw); FA_SBAR(); tile_qs<MODE, false>(kp0 + slot * KSLOT, qr, qrl, cbl, r32, hi, m, l, o, wsf, pw); }
            { FA_STEP_HEAD(t); tile_pv(vp0 + ((t - 1) % 3) * VSLOT, o, pw); FA_SBAR(); tile_qs<MODE, true>(kp0 + slot * KSLOT, qr, qrl, cbl, r32, hi, m, l, o, wsf, pw); ++t; }
        } else { FA_STEP_HEAD(0); tile_qs<MODE, true>(kp0 + slot * KSLOT, qr, qrl, cbl, r32, hi, m, l, o, wsf, pw); t = 1; }
        if (t < NT) { FA_STEP_HEAD(t); (void)slot; (void)cbl; tile_pv(vp0 + ((t - 1) % 3) * VSLOT, o, pw); ++t;
            for (; t < NT; ++t) { FA_STEP_HEAD(t); (void)slot; (void)cbl; } }
        else tile_pv(vp0 + ((NT - 1) % 3) * VSLOT, o, pw);
    }
#undef FA_STEP_HEAD
#pragma unroll
    for (int b2 = 0; b2 < 2; ++b2) {
        float lb = l[b2];
        { auto rr = __builtin_amdgcn_permlane32_swap(__float_as_uint(lb), __float_as_uint(lb), false, false); lb = __uint_as_float(rr[0]) + __uint_as_float(rr[1]); }
        const float rl = __builtin_amdgcn_rcpf(lb); const long grow = rowbase + q0 + wid * 64 + b2 * 32 + r32;
#pragma unroll
        for (int d0 = 0; d0 < 2; ++d0)
#pragma unroll
            for (int g4 = 0; g4 < 4; ++g4) { const int dc = A.ocol + 32 * d0 + 8 * g4 + 4 * hi;
                f32x4 v = (f32x4){o[b2][d0][4 * g4], o[b2][d0][4 * g4 + 1], o[b2][d0][4 * g4 + 2], o[b2][d0][4 * g4 + 3]} * rl;
                if (MODE == 0) { const u32x2 g = *(const u32x2*)(A.G + grow * 1024 + dc);
                    v[0] *= __uint_as_float(g.x << 16); v[1] *= __uint_as_float(g.x & 0xffff0000u); v[2] *= __uint_as_float(g.y << 16); v[3] *= __uint_as_float(g.y & 0xffff0000u); }
                *(u32x2*)(A.O + grow * 1024 + dc) = (u32x2){pk2(v[0], v[1]), pk2(v[2], v[3])}; }
    }
    asm volatile("s_waitcnt lgkmcnt(0)\n\ts_barrier" ::: "memory");
#undef FA_DMA
}
}

namespace a16 {
__device__ __forceinline__ f32x4 mfma16(bf16x8 a, bf16x8 b, f32x4 c) { return __builtin_amdgcn_mfma_f32_16x16x32_bf16(a, b, c, 0, 0, 0); }
template <int NQK, int NDB, class KL, class VL, class SF>
__device__ __forceinline__ void steps(int s0, int s1, const bf16x8 (&qf)[NQK], KL kload, VL vload, SF sfix, float& m, float& l, f32x4 (&o)[NDB], int lane) {
    const int g = lane >> 4;
    for (int s = s0; s < s1; ++s) {
        f32x4 sA = {0.f, 0.f, 0.f, 0.f}, sB = {0.f, 0.f, 0.f, 0.f};
#pragma unroll
        for (int d0 = 0; d0 < NQK; ++d0) { sA = mfma16(kload(s, 0, d0), qf[d0], sA); sB = mfma16(kload(s, 1, d0), qf[d0], sB); }
        sfix(s, sA, sB);
        float mx = __builtin_fmaxf(__builtin_fmaxf(__builtin_fmaxf(sA[0], sA[1]), __builtin_fmaxf(sA[2], sA[3])), __builtin_fmaxf(__builtin_fmaxf(sB[0], sB[1]), __builtin_fmaxf(sB[2], sB[3])));
        mx = __builtin_fmaxf(mx, __shfl_xor(mx, 16)); mx = __builtin_fmaxf(mx, __shfl_xor(mx, 32));
        const float mn = __builtin_fmaxf(m, mx), alpha = ex2(m - mn); m = mn;
        f32x4 pA, pB;
#pragma unroll
        for (int r = 0; r < 4; ++r) { pA[r] = ex2(sA[r] - mn); pB[r] = ex2(sB[r] - mn); }
        float ps = ((pA[0] + pA[1]) + (pA[2] + pA[3])) + ((pB[0] + pB[1]) + (pB[2] + pB[3]));
        ps += __shfl_xor(ps, 16); ps += __shfl_xor(ps, 32);
        l = l * alpha + ps;
        const float a0 = __shfl(alpha, 4 * g), a1 = __shfl(alpha, 4 * g + 1), a2 = __shfl(alpha, 4 * g + 2), a3 = __shfl(alpha, 4 * g + 3);
#pragma unroll
        for (int db = 0; db < NDB; ++db) { o[db][0] *= a0; o[db][1] *= a1; o[db][2] *= a2; o[db][3] *= a3; }
        const u32x4 pw = (u32x4){pk2(pA[0], pA[1]), pk2(pA[2], pA[3]), pk2(pB[0], pB[1]), pk2(pB[2], pB[3])};
        const bf16x8 pf = __builtin_bit_cast(bf16x8, pw);
#pragma unroll
        for (int db = 0; db < NDB; ++db) o[db] = mfma16(pf, vload(s, db), o[db]);
    }
}
__device__ __forceinline__ bf16x8 cvt8(f32x4 a, f32x4 b) { const u32x4 w = (u32x4){pk2(a[0], a[1]), pk2(a[2], a[3]), pk2(b[0], b[1]), pk2(b[2], b[3])}; return __builtin_bit_cast(bf16x8, w); }
__device__ __forceinline__ bf16x8 join8(u32x2 a, u32x2 b) { const u32x4 w = (u32x4){a.x, a.y, b.x, b.y}; return __builtin_bit_cast(bf16x8, w); }
}


namespace xa {
constexpr int TSZ = 16384, L_T = 0, L_WS = 2 * TSZ, L_OST = L_WS + 8 * 64 * 4, L_BYTES = L_OST + 8 * 2048;
#define XA_WAIT_BAR() asm volatile("s_waitcnt vmcnt(0) lgkmcnt(0)\n\ts_barrier" ::: "memory")
template <typename T> __device__ __forceinline__ const T* src_of(const T* Kh, const T* Vh, int pitch, int i, int ci) {
    return (i < 8) ? Kh + (size_t)(32 * i + (ci & 31)) * pitch + (ci >> 5) * 8 : Vh + (size_t)(ci >> 2) * pitch + 32 * (i - 8) + (ci & 3) * 8; }
template <bool F32SRC> __device__ __forceinline__ void unit(const void* Kh_, const void* Vh_, int pitch, const bf16* Q, bf16* O, size_t row0, int hcol, int nvalid_w0, bool only_w0, LAS char* lds, unsigned lds0) {
    const int tid = pg8::pg8_tid(), lane = tid & 63, r32 = lane & 31, hi = lane >> 5; const int wid = __builtin_amdgcn_readfirstlane(tid >> 6);
    const bool active = !only_w0 || wid == 0; const int nvalid = only_w0 ? (wid == 0 ? nvalid_w0 : 0) : 32;
    bf16x8 qr[16];
    { const bf16* Qw = Q + (row0 + wid * 32 + r32) * 1024 + hcol + hi * 8;
#pragma unroll
      for (int d0 = 0; d0 < 16; ++d0) qr[d0] = active ? *(const bf16x8*)(Qw + d0 * 16) : (bf16x8){0, 0, 0, 0, 0, 0, 0, 0}; }
    LAS float* wsf = (LAS float*)(lds + L_WS) + wid * 64;
    f32x4 st[2][2];
#define XA_ISSUE(i) do { if (F32SRC) { _Pragma("unroll") for (int c2 = 0; c2 < 2; ++c2) { const float* s = src_of<float>((const float*)Kh_, (const float*)Vh_, pitch, (i), tid + 512 * c2); st[c2][0] = *(const f32x4*)s; st[c2][1] = *(const f32x4*)(s + 4); } } \
        else { _Pragma("unroll") for (int c2 = 0; c2 < 2; ++c2) fa::glds16(src_of<bf16>((const bf16*)Kh_, (const bf16*)Vh_, pitch, (i), (2 * wid + c2) * 64 + lane), (unsigned)__builtin_amdgcn_readfirstlane(lds0 + L_T + ((i) & 1) * TSZ + (2 * wid + c2) * 1024)); } } while (0)
#define XA_COMMIT(i) do { if (F32SRC) { _Pragma("unroll") for (int c2 = 0; c2 < 2; ++c2) *(LAS u32x4*)(lds + L_T + ((i) & 1) * TSZ + (tid + 512 * c2) * 16) = \
        (u32x4){pk2(st[c2][0][0], st[c2][0][1]), pk2(st[c2][0][2], st[c2][0][3]), pk2(st[c2][1][0], st[c2][1][1]), pk2(st[c2][1][2], st[c2][1][3])}; } } while (0)
    XA_ISSUE(0); XA_COMMIT(0);
    f32x16 S[8];
#pragma unroll
    for (int t = 0; t < 8; ++t) {
        XA_WAIT_BAR(); XA_ISSUE(t + 1);
        const LAS char* kp = lds + L_T + (t & 1) * TSZ + hi * 512 + r32 * 16;
        S[t] = f32x16{};
#pragma unroll
        for (int d0 = 0; d0 < 16; ++d0) S[t] = __builtin_amdgcn_mfma_f32_32x32x16_bf16(*(const LAS bf16x8*)(kp + d0 * 1024), qr[d0], S[t], 0, 0, 0);
        XA_COMMIT(t + 1);
    }
    float mx = S[0][0];
#pragma unroll
    for (int t = 0; t < 8; ++t)
#pragma unroll
        for (int r = 0; r < 16; ++r) mx = __builtin_fmaxf(mx, S[t][r]);
    { auto rr = __builtin_amdgcn_permlane32_swap(__float_as_uint(mx), __float_as_uint(mx), false, false); mx = __builtin_fmaxf(__uint_as_float(rr[0]), __uint_as_float(rr[1])); }
    float l = 0.f; u32x4 pw[16];
#pragma unroll
    for (int t = 0; t < 8; ++t) {
#pragma unroll
        for (int r = 0; r < 16; ++r) { S[t][r] = ex2(S[t][r] - mx); l += S[t][r]; }
        pw[2 * t] = (u32x4){pk2(S[t][0], S[t][1]), pk2(S[t][2], S[t][3]), pk2(S[t][4], S[t][5]), pk2(S[t][6], S[t][7])};
        pw[2 * t + 1] = (u32x4){pk2(S[t][8], S[t][9]), pk2(S[t][10], S[t][11]), pk2(S[t][12], S[t][13]), pk2(S[t][14], S[t][15])}; }
    { auto rr = __builtin_amdgcn_permlane32_swap(__float_as_uint(l), __float_as_uint(l), false, false); l = __uint_as_float(rr[0]) + __uint_as_float(rr[1]); }
    if (hi == 0) wsf[r32] = l;
    float rli[16];
#pragma unroll
    for (int r = 0; r < 16; ++r) rli[r] = __builtin_amdgcn_rcpf(wsf[fa::crow(r, hi)]);
    const int vbl = (int)(lds0 + L_T) + ((lane >> 4) & 1) * 32 + (lane & 3) * 8 + (4 * hi + ((lane & 15) >> 2)) * 64;
    LAS bf16* stg = (LAS bf16*)(lds + L_OST) + wid * 1024;
#pragma unroll
    for (int db = 0; db < 8; ++db) {
        XA_WAIT_BAR(); if (db < 7) XA_ISSUE(8 + db + 1);
        const int vb = vbl + (db & 1) * TSZ;
        f32x16 o = f32x16{};
#pragma unroll
        for (int k4 = 0; k4 < 4; ++k4) { s16x4 vlo[4], vhi[4];
#pragma unroll
            for (int kk = 0; kk < 4; ++kk) {
                asm volatile("ds_read_b64_tr_b16 %0,%1 offset:%c2" : "=&v"(vlo[kk]) : "v"(vb), "i"((k4 * 4 + kk) * 1024) : "memory");
                asm volatile("ds_read_b64_tr_b16 %0,%1 offset:%c2" : "=&v"(vhi[kk]) : "v"(vb), "i"((k4 * 4 + kk) * 1024 + 512) : "memory"); }
            asm volatile("s_waitcnt lgkmcnt(0)" ::: "memory"); __builtin_amdgcn_sched_barrier(0);
#pragma unroll
            for (int kk = 0; kk < 4; ++kk) o = __builtin_amdgcn_mfma_f32_32x32x16_bf16(__builtin_bit_cast(bf16x8, pw[k4 * 4 + kk]),
                (bf16x8){vlo[kk][0], vlo[kk][1], vlo[kk][2], vlo[kk][3], vhi[kk][0], vhi[kk][1], vhi[kk][2], vhi[kk][3]}, o, 0, 0, 0); }
        if (db < 7) XA_COMMIT(8 + db + 1);
#pragma unroll
        for (int r = 0; r < 16; ++r) stg[fa::crow(r, hi) * 32 + r32] = (bf16)(pk2(o[r] * rli[r], 0.f) & 0xffffu);
        LDS_WAIT();
#pragma unroll
        for (int ps = 0; ps < 2; ++ps) { const int row = ps * 16 + (lane >> 2), ch = lane & 3;
            const u32x4 v = *(const LAS u32x4*)(stg + row * 32 + ch * 8);
            if (row < nvalid) *(u32x4*)(O + (row0 + wid * 32 + row) * 1024 + hcol + 32 * db + ch * 8) = v; }
        LDS_WAIT();
    }
    asm volatile("s_waitcnt lgkmcnt(0)\n\ts_barrier" ::: "memory");
#undef XA_ISSUE
#undef XA_COMMIT
}
}

namespace ms {
constexpr int KSZ = 18432, L_T = 0, L_WS = 2 * KSZ, L_OST = L_WS + 8 * 64 * 4, L_BYTES = L_OST + 8 * 4096;
constexpr int PROW = 264;
#define MS_WAIT_BAR() asm volatile("s_waitcnt lgkmcnt(0)\n\ts_barrier" ::: "memory")
__device__ __forceinline__ const float* ms_ksrc(const float* ckvb, const float* krb, int key, int c) {
    const size_t o0 = (size_t)key * 256 + c * 8, o1 = (size_t)key * 32 + (c - 32) * 8; const bool lat = c < 32; return (lat ? ckvb : krb) + (lat ? o0 : o1); }
template <int NK> __device__ __forceinline__ void unit(const float* ckvb, const float* krb, int kclamp, const bf16* QA, float* P, LAS char* lds, unsigned lds0) {
    const int tid = pg8::pg8_tid(), lane = tid & 63, r32 = lane & 31, hi = lane >> 5; const int wid = __builtin_amdgcn_readfirstlane(tid >> 6);
    const bf16* Qw = QA + (size_t)(wid * 32 + r32) * 288 + hi * 8;
    f32x4 st[2][3][2];
#define MS_SRC(i, ci) (((i) < 8) ? ms_ksrc(ckvb, krb, min(32 * (i) + ((ci) & 31), kclamp), (ci) >> 5) \
                                  : ckvb + (size_t)min((ci) >> 2, kclamp) * 256 + 32 * ((i) - 8) + ((ci) & 3) * 8)
#define MS_NCH(i) (((i) < 8) ? 1152 : 1024)
#define MS_ISSUE(i, set) do { _Pragma("unroll") for (int c2 = 0; c2 < 3; ++c2) { const int ci = min(tid + 512 * c2, MS_NCH(i) - 1); const float* s = MS_SRC(i, ci); st[(set) & 1][c2][0] = *(const f32x4*)s; st[(set) & 1][c2][1] = *(const f32x4*)(s + 4); } } while (0)
#define MS_COMMIT(i, slot) do { _Pragma("unroll") for (int c2 = 0; c2 < 3; ++c2) { const int ci = min(tid + 512 * c2, MS_NCH(i) - 1); *(LAS u32x4*)(lds + L_T + ((slot) & 1) * KSZ + ci * 16) = \
        (u32x4){pk2(st[(slot) & 1][c2][0][0], st[(slot) & 1][c2][0][1]), pk2(st[(slot) & 1][c2][0][2], st[(slot) & 1][c2][0][3]), pk2(st[(slot) & 1][c2][1][0], st[(slot) & 1][c2][1][1]), pk2(st[(slot) & 1][c2][1][2], st[(slot) & 1][c2][1][3])}; } } while (0)
    constexpr int FIRSTV = 8;
#define MS_TILE(q) (((q) < NK) ? (q) : FIRSTV + (q) - NK)
    MS_ISSUE(MS_TILE(0), 0); MS_COMMIT(MS_TILE(0), 0); MS_ISSUE(MS_TILE(1), 1);
    f32x16 S[NK];
    bf16x8 q0[6];
#pragma unroll
    for (int i = 0; i < 6; ++i) q0[i] = *(const bf16x8*)(Qw + i * 16);
#pragma unroll
    for (int t = 0; t < NK; ++t) {
        MS_WAIT_BAR();
        const LAS char* kp = lds + L_T + (t & 1) * KSZ + hi * 512 + r32 * 16;
        S[t] = f32x16{}; const bf16* Qt = Qw; asm volatile("" : "+v"(Qt));
#pragma unroll
        for (int i = 0; i < 6; ++i) S[t] = __builtin_amdgcn_mfma_f32_32x32x16_bf16(*(const LAS bf16x8*)(kp + i * 1024), q0[i], S[t], 0, 0, 0);
        __builtin_amdgcn_sched_barrier(0);
        { bf16x8 q1[6];
#pragma unroll
          for (int i = 0; i < 6; ++i) q1[i] = *(const bf16x8*)(Qt + (6 + i) * 16);
#pragma unroll
          for (int i = 0; i < 6; ++i) S[t] = __builtin_amdgcn_mfma_f32_32x32x16_bf16(*(const LAS bf16x8*)(kp + (6 + i) * 1024), q1[i], S[t], 0, 0, 0); }
        __builtin_amdgcn_sched_barrier(0);
        { bf16x8 q2[6];
#pragma unroll
          for (int i = 0; i < 6; ++i) q2[i] = *(const bf16x8*)(Qt + (12 + i) * 16);
          __builtin_amdgcn_sched_barrier(0);
          MS_ISSUE(MS_TILE(t + 2), t + 2);
          __builtin_amdgcn_sched_barrier(0);
#pragma unroll
          for (int i = 0; i < 6; ++i) S[t] = __builtin_amdgcn_mfma_f32_32x32x16_bf16(*(const LAS bf16x8*)(kp + (12 + i) * 1024), q2[i], S[t], 0, 0, 0); }
        MS_COMMIT(MS_TILE(t + 1), t + 1);
    }
    constexpr int VS0 = (NK & 1);
    if (NK == 1) {
#pragma unroll
        for (int r = 8; r < 16; ++r) S[0][r] = -INFINITY; }
    float mx = S[0][0];
#pragma unroll
    for (int t = 0; t < NK; ++t)
#pragma unroll
        for (int r = 0; r < 16; ++r) mx = __builtin_fmaxf(mx, S[t][r]);
    { auto rr = __builtin_amdgcn_permlane32_swap(__float_as_uint(mx), __float_as_uint(mx), false, false); mx = __builtin_fmaxf(__uint_as_float(rr[0]), __uint_as_float(rr[1])); }
    float l = 0.f; u32x4 pw[2 * NK];
#pragma unroll
    for (int t = 0; t < NK; ++t) {
#pragma unroll
        for (int r = 0; r < 16; ++r) { S[t][r] = ex2(S[t][r] - mx); l += S[t][r]; }
        pw[2 * t] = (u32x4){pk2(S[t][0], S[t][1]), pk2(S[t][2], S[t][3]), pk2(S[t][4], S[t][5]), pk2(S[t][6], S[t][7])};
        pw[2 * t + 1] = (u32x4){pk2(S[t][8], S[t][9]), pk2(S[t][10], S[t][11]), pk2(S[t][12], S[t][13]), pk2(S[t][14], S[t][15])}; }
    { auto rr = __builtin_amdgcn_permlane32_swap(__float_as_uint(l), __float_as_uint(l), false, false); l = __uint_as_float(rr[0]) + __uint_as_float(rr[1]); }
    float* Pw = P + (size_t)(wid * 32) * PROW;
    if (hi == 0) { Pw[(size_t)r32 * PROW + 256] = mx; Pw[(size_t)r32 * PROW + 257] = l; }
    LAS float* stg = (LAS float*)(lds + L_OST) + wid * 1024;
#pragma unroll
    for (int db = 0; db < 8; ++db) {
        MS_WAIT_BAR(); if (db < 6) MS_ISSUE(FIRSTV + db + 2, NK + db + 2);
        const int vb = (int)(lds0 + L_T) + ((VS0 + db) & 1) * KSZ + ((lane >> 4) & 1) * 32 + (lane & 3) * 8 + (4 * hi + ((lane & 15) >> 2)) * 64;
        f32x16 o = f32x16{};
#pragma unroll
        for (int k0 = 0; k0 < 2 * NK; k0 += 8) {
            constexpr int KB = (2 * NK < 8) ? 2 * NK : 8; s16x4 vlo[KB], vhi[KB];
#pragma unroll
            for (int kk = 0; kk < KB; ++kk) {
                asm volatile("ds_read_b64_tr_b16 %0,%1 offset:%c2" : "=&v"(vlo[kk]) : "v"(vb), "i"((k0 + kk) * 1024) : "memory");
                asm volatile("ds_read_b64_tr_b16 %0,%1 offset:%c2" : "=&v"(vhi[kk]) : "v"(vb), "i"((k0 + kk) * 1024 + 512) : "memory"); }
            asm volatile("s_waitcnt lgkmcnt(0)" ::: "memory"); __builtin_amdgcn_sched_barrier(0);
#pragma unroll
            for (int kk = 0; kk < KB; ++kk)
                o = __builtin_amdgcn_mfma_f32_32x32x16_bf16(__builtin_bit_cast(bf16x8, pw[k0 + kk]), (bf16x8){vlo[kk][0], vlo[kk][1], vlo[kk][2], vlo[kk][3], vhi[kk][0], vhi[kk][1], vhi[kk][2], vhi[kk][3]}, o, 0, 0, 0); }
#pragma unroll
        for (int r = 0; r < 16; ++r) stg[fa::crow(r, hi) * 32 + r32] = o[r];
        LDS_WAIT();
        { const int row = lane >> 1, cq = (lane & 1) * 16; float* dst = Pw + (size_t)row * PROW + 32 * db + cq;
#pragma unroll
          for (int k = 0; k < 4; ++k) *(f32x4*)(dst + 4 * k) = *(const LAS f32x4*)(stg + row * 32 + cq + 4 * k); }
        if (db < 7) MS_COMMIT(FIRSTV + db + 1, NK + db + 1);
        LDS_WAIT();
    }
    asm volatile("s_waitcnt lgkmcnt(0)\n\ts_barrier" ::: "memory");
#undef MS_SRC
#undef MS_ISSUE
#undef MS_COMMIT
#undef MS_NCH
#undef MS_TILE
}
}

constexpr int RING_OFF = 0, RING_BYTES = 131072;
constexpr int LDSCTL_OFF = RING_BYTES, MISC_OFF = LDSCTL_OFF + 320;
constexpr int LDS_BYTES = 147456;
constexpr int NWAVES = 8;
static_assert(fa::L_BYTES2 <= RING_BYTES && xa::L_BYTES <= RING_BYTES && ms::L_BYTES <= RING_BYTES, "attention LDS");

struct KArgs { const float* in[N_IN]; float* out; unsigned char* ws; int ph_lo, ph_hi; };
static_assert(sizeof(KArgs) == N_IN * 8 + 24, "KArgs has no padding");
typedef const __attribute__((address_space(4))) KArgs* KAP;
#define KA ((KAP)__builtin_amdgcn_kernarg_segment_ptr())

#define XB_TMO      128
#define XB_XCNT(j)  (256  + 64 * (j))
#define XB_XSUB(j)  (1280 + 64 * (j))
#define XB_XGEN(j)  (2304 + 64 * (j))
#define XB_TOP      3328
#define XB_TOPGEN   3392
#define XCD_BAR_WORDS 3456
#define XB_SPIN_CAP (1u << 18)

__device__ __forceinline__ unsigned xb_ld(unsigned* p)              { return __hip_atomic_load(p, __ATOMIC_RELAXED, __HIP_MEMORY_SCOPE_AGENT); }
__device__ __forceinline__ unsigned xb_add(unsigned* p, unsigned v) { return __hip_atomic_fetch_add(p, v, __ATOMIC_RELAXED, __HIP_MEMORY_SCOPE_AGENT); }
__device__ __forceinline__ unsigned xb_xcc_id() { return (unsigned)__builtin_amdgcn_s_getreg((3 << 11) | 20) & 0xFu; }
#define XB_SPIN(cond, bar) do { unsigned _sp = 0; while (cond) { __builtin_amdgcn_s_sleep(1); \
    if ((++_sp & 255u) == 0u) { if (xb_ld(&(bar)[XB_TMO])) break; if (_sp > XB_SPIN_CAP) { atomicAdd(&(bar)[XB_TMO], 1u); break; } } } } while (0)

struct XcdBarrier {
    unsigned* bar; unsigned x;
    volatile LAS unsigned* st;
};

__device__ __forceinline__ XcdBarrier xcd_barrier_post(unsigned* bar, volatile LAS unsigned* st) {
    XcdBarrier b; b.bar = bar; b.x = xb_xcc_id(); b.st = st;
    if (threadIdx.x == 0) (void)xb_add(&bar[XB_XCNT(b.x)], 1u);
    return b;
}
__device__ __forceinline__ void xcd_barrier_complete(unsigned* bar, unsigned x, unsigned& nloc, unsigned& nx) {
    const unsigned G = gridDim.x * gridDim.y * gridDim.z;
    unsigned sum, cnt, mine, sp = 0u;
    for (;;) {
        sum = 0u; cnt = 0u; mine = 0u;
#pragma unroll
        for (unsigned j = 0; j < 16; ++j) { const unsigned c = xb_ld(&bar[XB_XCNT(j)]); sum += c; cnt += (c > 0u) ? 1u : 0u; mine = (j == x) ? c : mine; }
        if (sum == G) break;
        __builtin_amdgcn_s_sleep(1);
        if ((++sp & 255u) == 0u) { if (xb_ld(&bar[XB_TMO])) break; if (sp > XB_SPIN_CAP) { atomicAdd(&bar[XB_TMO], 1u); break; } }
    }
    nloc = mine > 0u ? mine : 1u; nx = cnt > 0u ? cnt : 1u;
}

__device__ __forceinline__ void xcd_barrier(const XcdBarrier& b) {
    asm volatile("s_waitcnt vmcnt(0)" ::: "memory");
    __syncthreads();
    if (threadIdx.x == 0) {
        unsigned* bar = b.bar;
        __builtin_amdgcn_s_waitcnt(0);
        unsigned nloc = b.st[0], nx = b.st[1];
        if (nloc == 0u) { xcd_barrier_complete(bar, b.x, nloc, nx); b.st[0] = nloc; b.st[1] = nx; }
        const unsigned old = xb_add(&bar[XB_XSUB(b.x)], 1u);
        const unsigned gen = old / nloc;
        if (old + 1u == (gen + 1u) * nloc) {
            __builtin_amdgcn_fence(__ATOMIC_RELEASE, "agent");
            asm volatile("s_waitcnt vmcnt(0)" ::: "memory");
            const unsigned og = xb_add(&bar[XB_TOP], 1u);
            const unsigned tg = og / nx;
            if (og + 1u == (tg + 1u) * nx) xb_add(&bar[XB_TOPGEN], 1u);
            else XB_SPIN(xb_ld(&bar[XB_TOPGEN]) == tg, bar);
            __builtin_amdgcn_fence(__ATOMIC_ACQUIRE, "agent");
            xb_add(&bar[XB_XGEN(b.x)], 1u);
            asm volatile("s_waitcnt vmcnt(0)" ::: "memory");
        } else {
            XB_SPIN(xb_ld(&bar[XB_XGEN(b.x)]) == gen, bar);
            __builtin_amdgcn_fence(__ATOMIC_ACQUIRE, "agent");
            asm volatile("s_waitcnt vmcnt(0)" ::: "memory");
        }
    }
    __syncthreads();
}

struct Seg { const float* W; int ldw, c0, ncols, K; bf16* T; int ldt, r0; const float* g; };
__device__ __forceinline__ Seg get_seg(KAP a, unsigned char* ws, int idx) {
    Seg s; s.g = nullptr; s.r0 = 0; s.c0 = 0; s.ldw = 1024; s.ncols = 1024; s.K = 1024; s.ldt = 1024; s.W = nullptr; s.T = nullptr;
    if (idx < 4) { const int j = idx & 1; s.W = a->in[I_WFI] + (size_t)j * 1024 * 4112; s.ldw = 4112; s.T = (bf16*)(ws + WS_WFI) + (size_t)j * 4352 * 1024; s.g = a->in[I_GMIX] + (size_t)(2 * j) * 1024;
        if (idx < 2) { s.c0 = 0; s.ncols = 3072; s.r0 = 0; } else { s.c0 = 3088; s.ncols = 1024; s.r0 = 3072; } }
    else if (idx < 6) { const int j = idx - 4; s.W = a->in[I_WFO] + (size_t)j * 1024 * 1024; s.T = (bf16*)(ws + WS_WFO) + (size_t)j * 1024 * 1024; }
    else if (idx < 12) { const int e = idx - 6, j = e / 3, part = e % 3; s.W = a->in[I_WMA] + (size_t)j * 1024 * 672; s.ldw = 672; s.T = (bf16*)(ws + WS_WMA) + (size_t)j * 768 * 1024; s.g = a->in[I_GMIX] + (size_t)(2 * j + 1) * 1024;
        if (part == 0) { s.c0 = 384; s.ncols = 256; s.r0 = 0; } else if (part == 1) { s.c0 = 0; s.ncols = 384; s.r0 = 256; } else { s.c0 = 640; s.ncols = 32; s.r0 = 640; } }
    else if (idx < 14) { const int j = idx - 12; s.W = a->in[I_WMQB] + (size_t)j * 384 * 1536; s.ldw = 1536; s.ncols = 1536; s.K = 384; s.T = (bf16*)(ws + WS_WMQ) + (size_t)j * 1536 * 384; s.ldt = 384; s.g = a->in[I_GMQ] + (size_t)j * 384; }
    else if (idx < 18) { const int j = idx & 1; const bool raw = idx >= 16; s.W = a->in[I_WMKVB] + (size_t)j * 256 * 2048; s.ldw = 2048; s.ncols = 2048; s.K = 256; s.ldt = 256;
        s.T = (bf16*)(ws + (raw ? WS_WMKVR : WS_WMKV)) + (size_t)j * 2048 * 256; s.g = raw ? nullptr : a->in[I_GMKV] + (size_t)j * 256; }
    else if (idx < 20) { const int j = idx - 18; s.W = a->in[I_WMO] + (size_t)j * 1024 * 1024; s.T = (bf16*)(ws + WS_WMO) + (size_t)j * 1024 * 1024; }
    else if (idx < 24) { const int i = idx - 20; s.W = a->in[I_WXQ] + (size_t)i * 1024 * 1024; s.T = (bf16*)(ws + WS_WXQ) + (size_t)i * 1024 * 1024; s.g = a->in[I_GCROSS] + (size_t)i * 1024; }
    else if (idx < 28) { const int i = idx - 24; s.W = a->in[I_WXO] + (size_t)i * 1024 * 1024; s.T = (bf16*)(ws + WS_WXO) + (size_t)i * 1024 * 1024; }
    else if (idx < 32) { const int i = idx - 28; s.W = a->in[I_WXKV] + (size_t)i * 1024 * 2048; s.ldw = 2048; s.ncols = 2048; s.T = (bf16*)(ws + WS_WXKV) + (size_t)i * 2048 * 1024; s.g = a->in[I_GMEM] + (size_t)i * 1024; }
    else if (idx < 36) { const int i = idx - 32; s.W = a->in[I_WDN] + (size_t)i * 2816 * 1024; s.K = 2816; s.T = (bf16*)(ws + WS_WDN) + (size_t)i * 1024 * 2816; s.ldt = 2816; }
    else if (idx < 212) { const int e = idx - 36, i = e / 44, t = e % 44, pn = t >> 1, half = t & 1; s.W = a->in[I_WGU] + (size_t)i * 1024 * 5632; s.ldw = 5632; s.c0 = half * 2816 + 128 * pn; s.ncols = 128;
        s.T = (bf16*)(ws + WS_WGU) + (size_t)i * 5632 * 1024; s.r0 = 256 * pn + 128 * half; s.g = a->in[I_GFFN] + (size_t)i * 1024; }
    else { const int j = idx - 212; s.W = a->in[I_WFI] + (size_t)j * 1024 * 4112; s.ldw = 4112; s.c0 = 3072; s.ncols = 32; s.T = (bf16*)(ws + WS_WFI) + (size_t)j * 4352 * 1024; s.r0 = 4096; s.g = a->in[I_GMIX] + (size_t)(2 * j) * 1024; }
    return s;
}
constexpr int NSEG = 214;
__device__ __forceinline__ void tr_load(const Seg& s, int item, int lane, float (&v)[32]) {
    const int nnb = s.ncols / 32, kb = item / nnb, nb = item % nnb; const float* p = s.W + (size_t)(64 * kb + (lane >> 5)) * s.ldw + s.c0 + 32 * nb + (lane & 31);
#pragma unroll
    for (int i = 0; i < 32; ++i) v[i] = p[(size_t)(2 * i) * s.ldw];
}
__device__ __forceinline__ void tr_store(const Seg& s, int item, int lane, const float (&v)[32], LAS float* scr) {
    const int nnb = s.ncols / 32, kb = item / nnb, nb = item % nnb, k0 = 64 * kb, n0 = 32 * nb;
#pragma unroll
    for (int i = 0; i < 32; ++i) scr[(2 * i + (lane >> 5)) * 33 + (lane & 31)] = v[i];
    LDS_WAIT(); asm volatile("" ::: "memory");
    const int c = lane & 7; f32x4 g0 = (f32x4){1.f, 1.f, 1.f, 1.f}, g1 = g0;
    if (s.g) { g0 = *(const f32x4*)(s.g + k0 + 8 * c); g1 = *(const f32x4*)(s.g + k0 + 8 * c + 4); }
#pragma unroll
    for (int j = 0; j < 4; ++j) { const int n = (lane >> 3) + 8 * j; const LAS float* p = scr + (8 * c) * 33 + n;
        u32x4 o; o.x = pk2(p[0 * 33] * g0[0], p[1 * 33] * g0[1]); o.y = pk2(p[2 * 33] * g0[2], p[3 * 33] * g0[3]); o.z = pk2(p[4 * 33] * g1[0], p[5 * 33] * g1[1]); o.w = pk2(p[6 * 33] * g1[2], p[7 * 33] * g1[3]);
        *(u32x4*)(s.T + (size_t)(s.r0 + n0 + n) * s.ldt + k0 + 8 * c) = o; }
    LDS_WAIT(); asm volatile("" ::: "memory");
}
__device__ __forceinline__ void cvt_blocks(const float* src, bf16* dst, int nblk, int blk, size_t dstride, int gtid, int nthr) {
    const long total = (long)nblk * blk / 8;
    for (long v = gtid; v < total; v += nthr) { const long e = v * 8; const int b = (int)(e / blk), o = (int)(e % blk);
        const f32x4 x = *(const f32x4*)(src + e), y = *(const f32x4*)(src + e + 4);
        *(u32x4*)(dst + (size_t)b * dstride + o) = (u32x4){pk2(x[0], x[1]), pk2(x[2], x[3]), pk2(y[0], y[1]), pk2(y[2], y[3])}; }
}
__device__ __forceinline__ void p0_prologue(KAP a, LAS unsigned char* lds, int gw, int NGW, int wave, int lane, int pmask) {
    unsigned char* ws = a->ws; const int gtid = gw * 64 + lane, nthr = NGW * 64;
    LAS float* scr = (LAS float*)(lds + RING_OFF + wave * 16384);
#undef P0_PARTS
#define P0_PARTS pmask
    if (P0_PARTS & 1) {
        int total = 0;
        for (int sg = 0; sg < NSEG; ++sg) { const Seg s = get_seg(a, ws, sg); total += (s.K / 64) * (s.ncols / 32); }
        int sg = 0, base = 0; Seg sc = get_seg(a, ws, 0); int nit = (sc.K / 64) * (sc.ncols / 32);
#define P0_ADVANCE(gi) while ((gi) >= base + nit) { base += nit; ++sg; sc = get_seg(a, ws, sg); nit = (sc.K / 64) * (sc.ncols / 32); }
        float va[32], vb[32]; Seg sa = sc, sb = sc; int ia = 0, ib = 0;
        int gi = gw;
        if (gi < total) { P0_ADVANCE(gi); sa = sc; ia = gi - base; tr_load(sa, ia, lane, va); }
        while (gi < total) {
            int gn = gi + NGW;
            if (gn < total) { P0_ADVANCE(gn); sb = sc; ib = gn - base; tr_load(sb, ib, lane, vb); }
            tr_store(sa, ia, lane, va, scr);
            gi = gn; if (gi >= total) break;
            gn = gi + NGW;
            if (gn < total) { P0_ADVANCE(gn); sa = sc; ia = gn - base; tr_load(sa, ia, lane, va); }
            tr_store(sb, ib, lane, vb, scr);
            gi = gn;
        }
#undef P0_ADVANCE
    }
    if (P0_PARTS & 2) {
    cvt_blocks(a->in[I_WMKVB], (bf16*)(ws + WS_WKN), 1, 2 * 256 * 2048, 0, gtid, nthr); }
    if (P0_PARTS & 4) { const u32x4 z = (u32x4){0u, 0u, 0u, 0u};
      for (int v = gtid; v < 2 * 224 * 128; v += nthr) { const int j = v / (224 * 128), r = v % (224 * 128); *(u32x4*)((bf16*)(ws + WS_WFI) + ((size_t)j * 4352 + 4128) * 1024 + (size_t)r * 8) = z; }
      for (int v = gtid; v < 2 * 96 * 128; v += nthr) { const int j = v / (96 * 128), r = v % (96 * 128); *(u32x4*)((bf16*)(ws + WS_WMA) + ((size_t)j * 768 + 672) * 1024 + (size_t)r * 8) = z; }
    }
    if (P0_PARTS & 16) for (int v = gtid; v < 4096 * 16; v += nthr) { const int pos = v >> 4, c = v & 15; const double inv = pow(10000.0, -(double)c / 16.0), ang = (double)pos * inv;
        ((float*)(ws + WS_ROPC))[v] = (float)cos(ang); ((float*)(ws + WS_ROPS))[v] = (float)sin(ang); }
    if (P0_PARTS & 32) for (int row = gw; row < MT; row += NGW) { const float* xr = (row < MP) ? a->in[I_XP] + (size_t)row * 1024 : a->in[I_XS] + (size_t)(row - MP) * 1024;
        float sq = 0.f; bf16* o = (bf16*)(ws + WS_XB) + (size_t)row * 1024;
#pragma unroll
        for (int j = 0; j < 4; ++j) { const f32x4 v = *(const f32x4*)(xr + 256 * j + 4 * lane); sq += pg8::dot4(v); *(u32x2*)(o + 256 * j + 4 * lane) = pg8::pk4(v); }
        sq = wave_sum(sq);
        if (lane < 16) ((float*)(ws + WS_SSQ))[(size_t)row * 16 + lane] = (lane == 0) ? sq : 0.f; }
    if (P0_PARTS & 64) for (int row = gw; row < 2048; row += NGW) { const float* xr = a->in[I_MEM] + (size_t)row * 1024; f32x4 v[4]; float sq = 0.f;
#pragma unroll
        for (int j = 0; j < 4; ++j) { v[j] = *(const f32x4*)(xr + 256 * j + 4 * lane); sq += pg8::dot4(v[j]); }
        const float r = rsqrtf(wave_sum(sq) * (1.0f / 1024.0f) + EPS); bf16* o = (bf16*)(ws + WS_MB) + (size_t)row * 1024;
#pragma unroll
        for (int j = 0; j < 4; ++j) *(u32x2*)(o + 256 * j + 4 * lane) = pg8::pk4(v[j] * r); }
}

__device__ __forceinline__ float ssq_rstd16(const float* ssq, int row) {
    const f32x4 a = *(const f32x4*)(ssq + (size_t)row * 16), b = *(const f32x4*)(ssq + (size_t)row * 16 + 4), c = *(const f32x4*)(ssq + (size_t)row * 16 + 8), d = *(const f32x4*)(ssq + (size_t)row * 16 + 12);
    const float s = ((a[0] + a[1]) + (a[2] + a[3])) + ((b[0] + b[1]) + (b[2] + b[3])) + ((c[0] + c[1]) + (c[2] + c[3])) + ((d[0] + d[1]) + (d[2] + d[3]));
    return rsqrtf(s * (1.0f / 1024.0f) + EPS);
}
__device__ __forceinline__ void cum_local_prompt(KAP a, int bh, LAS float* red, int wave, int lane) {
    unsigned char* ws = a->ws; const float* lfr = (const float*)(ws + WS_LFR); const int b = bh >> 4, h = bh & 15; float* cb = (float*)(ws + WS_CB) + (size_t)bh * 4096;
    float v[8];
#pragma unroll
    for (int k = 0; k < 8; ++k) v[k] = lfr[((size_t)b * 4096 + 512 * wave + 64 * k + lane) * 16 + h];
    float carry = 0.f;
#pragma unroll
    for (int k = 0; k < 8; ++k) {
#pragma unroll
        for (int o = 1; o < 64; o <<= 1) { const float y = __shfl_up(v[k], o); if (lane >= o) v[k] += y; }
        v[k] += carry; carry = __shfl(v[k], 63); }
    if (lane == 0) red[wave] = carry;
    __syncthreads();
    float off = 0.f;
#pragma unroll
    for (int w = 0; w < 7; ++w) off += (w < wave) ? red[w] : 0.f;
#pragma unroll
    for (int k = 0; k < 8; ++k) cb[512 * wave + 64 * k + lane] = -(v[k] + off) * LOG2E;
    VM_WAIT(); __syncthreads();
}
__device__ __forceinline__ void cum_local_sample(KAP a, int L, int pair, LAS float* red, int wave, int lane) {
    unsigned char* ws = a->ws; const float* lfr = (const float*)(ws + WS_LFR); const int bs = pair >> 4, h = pair & 15;
    const float* lfc = a->in[I_CFL] + (size_t)L * 32 * 2048 * 16; float* cb = (float*)(ws + WS_CBS) + (size_t)pair * 2080;
    float x[4], v[4];
#pragma unroll
    for (int k = 0; k < 4; ++k) x[k] = lfc[((size_t)bs * 2048 + 256 * wave + 64 * k + lane) * 16 + h];
    float carry = 0.f;
#pragma unroll
    for (int k = 3; k >= 0; --k) { float t = x[k];
#pragma unroll
        for (int o = 1; o < 64; o <<= 1) { const float y = __shfl_down(t, o); if (lane + o < 64) t += y; }
        v[k] = carry + t - x[k]; carry += __shfl(t, 0); }
    if (lane == 0) red[wave] = carry;
    __syncthreads();
    float off = 0.f;
#pragma unroll
    for (int w = 1; w < 8; ++w) off += (w > wave) ? red[w] : 0.f;
#pragma unroll
    for (int k = 0; k < 4; ++k) cb[256 * wave + 64 * k + lane] = (v[k] + off) * LOG2E;
    if (wave == 0) { float t = (lane < 16) ? lfr[((size_t)MP + bs * 16 + lane) * 16 + h] : 0.f;
#pragma unroll
        for (int o = 1; o < 16; o <<= 1) { const float y = __shfl_up(t, o); if (lane >= o) t += y; }
        if (lane < 32) cb[2048 + lane] = (lane < 16) ? -t * LOG2E : 0.f; }
    VM_WAIT(); __syncthreads();
}
__device__ __forceinline__ void ckv_fixup(KAP a, int L, int gw, int NGW, int lane) {
    unsigned char* ws = a->ws; const f32x4 g = *(const f32x4*)(a->in[I_GMKV] + (size_t)L * 256 + 4 * lane);
    for (int row0 = gw; row0 < MT; row0 += 4 * NGW) { f32x4 s4[4], v[4];
#pragma unroll
        for (int i = 0; i < 4; ++i) { const int row = (row0 + i * NGW < MT) ? row0 + i * NGW : row0; s4[i] = *(const f32x4*)((const float*)(ws + WS_SSQKV) + (size_t)row * 4);
            v[i] = *(const f32x4*)((const float*)(ws + WS_CKVU) + (size_t)row * 256 + 4 * lane); }
#pragma unroll
        for (int i = 0; i < 4; ++i) { const int row = row0 + i * NGW; if (row < MT) { const float r = rsqrtf(((s4[i][0] + s4[i][1]) + (s4[i][2] + s4[i][3])) * (1.0f / 256.0f) + EPS); const f32x4 o = v[i] * r * g;
            if (row < MP) *(f32x4*)(a->out + O_MCP + ((size_t)L * MP + row) * 256 + 4 * lane) = o;
            else *(f32x4*)(a->out + O_MCS + ((size_t)L * MS + (row - MP)) * 256 + 4 * lane) = o; } } }
}
__device__ __forceinline__ void final_phase(KAP a, int gw, int NGW, int lane) {
    f32x4 g[4];
#pragma unroll
    for (int j = 0; j < 4; ++j) g[j] = *(const f32x4*)(a->in[I_GFINAL] + 256 * j + 4 * lane);
    for (int row0 = gw; row0 < MT; row0 += 4 * NGW) { float r[4]; u32x2 w[4][4];
#pragma unroll
        for (int i = 0; i < 4; ++i) { const int row = (row0 + i * NGW < MT) ? row0 + i * NGW : row0; r[i] = ssq_rstd16((const float*)(a->ws + WS_SSQ), row); const bf16* x = (const bf16*)(a->ws + WS_XB) + (size_t)row * 1024;
#pragma unroll
            for (int j = 0; j < 4; ++j) w[i][j] = *(const u32x2*)(x + 256 * j + 4 * lane); }
#pragma unroll
        for (int i = 0; i < 4; ++i) { const int row = row0 + i * NGW; if (row < MT) { float* y = a->out + (size_t)row * 1024;
#pragma unroll
            for (int j = 0; j < 4; ++j) { const f32x4 xv = (f32x4){__builtin_bit_cast(float, w[i][j].x << 16), __builtin_bit_cast(float, w[i][j].x & 0xffff0000u), __builtin_bit_cast(float, w[i][j].y << 16), __builtin_bit_cast(float, w[i][j].y & 0xffff0000u)};
                *(f32x4*)(y + 256 * j + 4 * lane) = xv * r[i] * g[j]; } } } }
}

__device__ __forceinline__ void foxs_item(KAP a, int L, int it, LAS unsigned char* lds, int wid, int lane) {
    unsigned char* ws = a->ws; const int pair = it * 2 + (wid >> 2), b = pair >> 4, h = pair & 15, sp = wid & 3, g = lane >> 4, li = lane & 15;
    const float* ck = a->in[I_CFK] + (size_t)L * 32 * 2048 * 1024 + ((size_t)b * 2048 * 16 + h) * 64;
    const float* cv = a->in[I_CFV] + (size_t)L * 32 * 2048 * 1024 + ((size_t)b * 2048 * 16 + h) * 64;
    const float* cbs = (const float*)(ws + WS_CBS) + (size_t)pair * 2080;
    const bf16* QF = (const bf16*)(ws + WS_QF); const bf16* KF = (const bf16*)(ws + WS_KF); const bf16* VF = (const bf16*)(ws + WS_VF);
    const size_t srow = (size_t)MP + b * 16;
    bf16x8 qf[2];
#pragma unroll
    for (int d0 = 0; d0 < 2; ++d0) qf[d0] = *(const bf16x8*)(QF + (srow + li) * 1024 + h * 64 + 32 * d0 + 8 * g);
    float m = -1e30f, l = 0.f; f32x4 o[4];
#pragma unroll
    for (int db = 0; db < 4; ++db) o[db] = (f32x4){0.f, 0.f, 0.f, 0.f};
    const int kv0 = 512 * sp;
    auto kl = [&](int s, int blk, int d0) -> bf16x8 { const float* p = ck + (size_t)(kv0 + 32 * s + 16 * blk + li) * 1024 + 32 * d0 + 8 * g; return a16::cvt8(*(const f32x4*)p, *(const f32x4*)(p + 4)); };
    auto vl = [&](int s, int db) -> bf16x8 { const float* p = cv + (size_t)(kv0 + 32 * s + 4 * g) * 1024 + 16 * db + li;
        const f32x4 x = (f32x4){p[0], p[1024], p[2048], p[3072]}, y = (f32x4){p[16 * 1024], p[17 * 1024], p[18 * 1024], p[19 * 1024]}; return a16::cvt8(x, y); };
    auto sf = [&](int s, f32x4& sA, f32x4& sB) { const float* p = cbs + kv0 + 32 * s + 4 * g; sA += *(const f32x4*)p; sB += *(const f32x4*)(p + 16); };
    {
        auto kraw = [&](int s, f32x4 (&kr)[8]) {
#pragma unroll
            for (int blk = 0; blk < 2; ++blk)
#pragma unroll
                for (int d0 = 0; d0 < 2; ++d0) { const float* p = ck + (size_t)(kv0 + 32 * s + 16 * blk + li) * 1024 + 32 * d0 + 8 * g; kr[(blk * 2 + d0) * 2] = *(const f32x4*)p; kr[(blk * 2 + d0) * 2 + 1] = *(const f32x4*)(p + 4); } };
        auto vraw = [&](int s, f32x4 (&vr)[8]) {
#pragma unroll
            for (int db = 0; db < 4; ++db) { const float* p = cv + (size_t)(kv0 + 32 * s + 4 * g) * 1024 + 16 * db + li;
                vr[2 * db] = (f32x4){p[0], p[1024], p[2048], p[3072]}; vr[2 * db + 1] = (f32x4){p[16 * 1024], p[17 * 1024], p[18 * 1024], p[19 * 1024]}; } };
        auto step = [&](int s, const f32x4 (&kc)[8], const f32x4 (&vc)[8]) {
            f32x4 sA = {0.f, 0.f, 0.f, 0.f}, sB = {0.f, 0.f, 0.f, 0.f};
#pragma unroll
            for (int d0 = 0; d0 < 2; ++d0) { sA = a16::mfma16(a16::cvt8(kc[d0 * 2], kc[d0 * 2 + 1]), qf[d0], sA); sB = a16::mfma16(a16::cvt8(kc[(2 + d0) * 2], kc[(2 + d0) * 2 + 1]), qf[d0], sB); }
            sf(s, sA, sB);
            float mx = __builtin_fmaxf(__builtin_fmaxf(__builtin_fmaxf(sA[0], sA[1]), __builtin_fmaxf(sA[2], sA[3])), __builtin_fmaxf(__builtin_fmaxf(sB[0], sB[1]), __builtin_fmaxf(sB[2], sB[3])));
            mx = __builtin_fmaxf(mx, __shfl_xor(mx, 16)); mx = __builtin_fmaxf(mx, __shfl_xor(mx, 32));
            const float mn = __builtin_fmaxf(m, mx), alpha = ex2(m - mn); m = mn;
            f32x4 pA, pB;
#pragma unroll
            for (int r = 0; r < 4; ++r) { pA[r] = ex2(sA[r] - mn); pB[r] = ex2(sB[r] - mn); }
            float ps = ((pA[0] + pA[1]) + (pA[2] + pA[3])) + ((pB[0] + pB[1]) + (pB[2] + pB[3]));
            ps += __shfl_xor(ps, 16); ps += __shfl_xor(ps, 32);
            l = l * alpha + ps;
            const float a0 = __shfl(alpha, 4 * g), a1 = __shfl(alpha, 4 * g + 1), a2 = __shfl(alpha, 4 * g + 2), a3 = __shfl(alpha, 4 * g + 3);
#pragma unroll
            for (int db = 0; db < 4; ++db) { o[db][0] *= a0; o[db][1] *= a1; o[db][2] *= a2; o[db][3] *= a3; }
            const u32x4 pw = (u32x4){pk2(pA[0], pA[1]), pk2(pA[2], pA[3]), pk2(pB[0], pB[1]), pk2(pB[2], pB[3])};
            const bf16x8 pf = __builtin_bit_cast(bf16x8, pw);
#pragma unroll
            for (int db = 0; db < 4; ++db) o[db] = a16::mfma16(pf, a16::cvt8(vc[2 * db], vc[2 * db + 1]), o[db]); };
        f32x4 ka[8], va[8], kb[8], vb[8]; kraw(0, ka); vraw(0, va);
#pragma unroll 1
        for (int s = 0; s < 16; s += 2) {
            kraw(s + 1, kb); vraw(s + 1, vb);
            step(s, ka, va);
            const int sn = (s < 14) ? s + 2 : 15; kraw(sn, ka); vraw(sn, va);
            step(s + 1, kb, vb);
        }
    }
    if (sp == 3) {
        auto kl2 = [&](int, int blk, int d0) -> bf16x8 { bf16x8 z = {0, 0, 0, 0, 0, 0, 0, 0}; if (blk == 0) z = *(const bf16x8*)(KF + (srow + li) * 1024 + h * 64 + 32 * d0 + 8 * g); return z; };
        auto vl2 = [&](int, int db) -> bf16x8 { const bf16* p = VF + (srow + 4 * g) * 1024 + h * 64 + 16 * db + li;
            const u32x4 w = (u32x4){(unsigned)p[0] | ((unsigned)p[1024] << 16), (unsigned)p[2048] | ((unsigned)p[3072] << 16), 0u, 0u}; return __builtin_bit_cast(bf16x8, w); };
        auto sf2 = [&](int, f32x4& sA, f32x4& sB) { const f32x4 bb = *(const f32x4*)(cbs + 2048 + 4 * g);
#pragma unroll
            for (int r = 0; r < 4; ++r) { sA[r] = (4 * g + r > li) ? -INFINITY : sA[r] + bb[r]; sB[r] = -INFINITY; } };
        a16::steps<2, 4>(0, 1, qf, kl2, vl2, sf2, m, l, o, lane);
    }
    LAS float* PO = (LAS float*)(lds + RING_OFF) + wid * 1024; LAS float* PM = (LAS float*)(lds + RING_OFF + 32768) + wid * 32;
#pragma unroll
    for (int db = 0; db < 4; ++db)
#pragma unroll
        for (int r = 0; r < 4; ++r) PO[(4 * g + r) * 64 + 16 * db + li] = o[db][r];
    if (g == 0) { PM[li] = m; PM[16 + li] = l; }
    __syncthreads();
    {
        const int w0 = (wid >> 2) * 4, db = wid & 3; const bf16* GF = (const bf16*)(ws + WS_GF); bf16* OF = (bf16*)(ws + WS_OM);
#pragma unroll
        for (int r = 0; r < 4; ++r) { const int q = 4 * g + r; float mm = -1e30f;
#pragma unroll
            for (int s2 = 0; s2 < 4; ++s2) mm = __builtin_fmaxf(mm, ((LAS float*)(lds + RING_OFF + 32768) + (w0 + s2) * 32)[q]);
            float num = 0.f, den = 0.f;
#pragma unroll
            for (int s2 = 0; s2 < 4; ++s2) { LAS float* pm = (LAS float*)(lds + RING_OFF + 32768) + (w0 + s2) * 32; const float wgt = ex2(pm[q] - mm);
                num += wgt * ((LAS float*)(lds + RING_OFF) + (w0 + s2) * 1024)[q * 64 + 16 * db + li]; den += wgt * pm[16 + q]; }
            const size_t idx = (srow + q) * 1024 + h * 64 + 16 * db + li;
            OF[idx] = (bf16)(pk2(num / den * bf2f(GF[idx]), 0.f) & 0xffffu); }
    }
    __syncthreads();
}
__device__ __forceinline__ void mlas_qprime(KAP a, int L, int it, LAS unsigned char* lds, int wid, int lane) {
    unsigned char* ws = a->ws; const int b = (it < 256) ? (it >> 3) : (it - 256), c = (it < 256) ? (it & 7) : 8, g = lane >> 4, li = lane & 15;
    const bf16* QM = (const bf16*)(ws + WS_QM); const bf16* WKN = (const bf16*)(ws + WS_WKN) + (size_t)L * 256 * 2048;
    bf16* QA = (bf16*)(ws + WS_QA) + (size_t)it * 256 * 288;
    LAS bf16* scr = (LAS bf16*)(lds + RING_OFF + wid * 9216);
    for (int hh = 0; hh < 2; ++hh) { const int h = 2 * wid + hh; const bf16* qrow = QM + ((size_t)MP + b * 16 + li) * 1536 + h * 96; bf16* qa = QA + (size_t)(wid * 32 + hh * 16) * 288;
        const bf16x8 qn0 = *(const bf16x8*)(qrow + 8 * g), qn1 = *(const bf16x8*)(qrow + 32 + 8 * g);
#pragma unroll
        for (int cb = 0; cb < 16; ++cb) { const bf16* wp = WKN + (size_t)(16 * cb + li) * 2048 + h * 128 + 8 * g;
            f32x4 acc = a16::mfma16(qn0, *(const bf16x8*)wp, (f32x4){0.f, 0.f, 0.f, 0.f}); acc = a16::mfma16(qn1, *(const bf16x8*)(wp + 32), acc);
#pragma unroll
            for (int r = 0; r < 4; ++r) scr[(4 * g + r) * 288 + 16 * cb + li] = (bf16)(pk2(acc[r], 0.f) & 0xffffu); }
        *(LAS bf16x8*)(scr + li * 288 + 256 + 8 * g) = *(const bf16x8*)(qrow + 64 + 8 * g);
        LDS_WAIT();
#pragma unroll
        for (int j = 0; j < 9; ++j) *(u32x4*)(qa + (size_t)(lane + 64 * j) * 8) = *(const LAS u32x4*)(scr + (lane + 64 * j) * 8);
        LDS_WAIT(); }
    VM_WAIT(); __syncthreads();
}
__device__ __forceinline__ void mlas_attn(KAP a, int L, int it, int qa_it, LAS unsigned char* lds, unsigned lds0) {
    unsigned char* ws = a->ws; const int b = (it < 256) ? (it >> 3) : (it - 256), c = (it < 256) ? (it & 7) : 8; const bf16* QA = (const bf16*)(ws + WS_QA) + (size_t)qa_it * 256 * 288;
    float* P = (float*)(ws + WS_PART) + ((size_t)(b * 9 + c) * 256) * ms::PROW;
    if (c < 8) { const size_t jb = (size_t)L * 32 + b;
        ms::unit<8>(a->in[I_CCKV] + (jb * 2048 + 256 * c) * 256, a->in[I_CKR] + (jb * 2048 + 256 * c) * 32, 255, QA, P, (LAS char*)(lds + RING_OFF), lds0 + RING_OFF);
    } else { const size_t ro = (size_t)L * MS + b * 16;
        ms::unit<1>(a->out + O_MCS + ro * 256, a->out + O_MRS + ro * 32, 15, QA, P, (LAS char*)(lds + RING_OFF), lds0 + RING_OFF); }
}
__device__ __forceinline__ void mlas_combine(KAP a, int L, LAS unsigned char* lds, int vcu, int G, int wid, int lane) {
    unsigned char* ws = a->ws; const int grp = wid >> 2, k = wid & 3; LAS bf16* scr = (LAS bf16*)(lds + RING_OFF + grp * 8192);
    const bf16* WV = (const bf16*)(ws + WS_WMKVR) + (size_t)L * 2048 * 256; bf16* OM = (bf16*)(ws + WS_OM); const int g = lane >> 4, li = lane & 15;
    for (int e0 = vcu * 2; e0 < 512; e0 += G * 2) { const int e = e0 + grp, b = e >> 4, h = e & 15; const int q = lane >> 2, cg = 64 * k + (lane & 3) * 16;
        const float* P0 = (const float*)(ws + WS_PART) + ((size_t)(b * 9) * 256 + (h >> 1) * 32 + (h & 1) * 16 + q) * ms::PROW; constexpr size_t CS = (size_t)256 * ms::PROW;
        float pm[9], pl[9], mm = -1e30f;
#pragma unroll
        for (int c = 0; c < 9; ++c) { pm[c] = P0[c * CS + 256]; pl[c] = P0[c * CS + 257]; }
        f32x4 pv[4][9];
#pragma unroll
        for (int j = 0; j < 4; ++j)
#pragma unroll
            for (int c = 0; c < 9; ++c) pv[j][c] = *(const f32x4*)(P0 + c * CS + cg + 4 * j);
#pragma unroll
        for (int c = 0; c < 9; ++c) mm = __builtin_fmaxf(mm, pm[c]);
        float wgt[9], den = 0.f;
#pragma unroll
        for (int c = 0; c < 9; ++c) { wgt[c] = ex2(pm[c] - mm); den += wgt[c] * pl[c]; }
        const float id = 1.0f / den;
#pragma unroll
        for (int j = 0; j < 4; ++j) { f32x4 acc = (f32x4){0.f, 0.f, 0.f, 0.f};
#pragma unroll
            for (int c = 0; c < 9; ++c) acc += pv[j][c] * wgt[c];
            *(LAS u32x2*)(scr + q * 256 + cg + 4 * j) = pg8::pk4(acc * id); }
        __syncthreads();
        bf16x8 af[8];
#pragma unroll
        for (int d0 = 0; d0 < 8; ++d0) af[d0] = *(const LAS bf16x8*)(scr + li * 256 + 32 * d0 + 8 * g);
        { const int db = k; f32x4 acc = (f32x4){0.f, 0.f, 0.f, 0.f}; const bf16* wp = WV + (size_t)(h * 128 + 64 + 16 * db + li) * 256 + 8 * g;
#pragma unroll
            for (int d0 = 0; d0 < 8; ++d0) acc = a16::mfma16(af[d0], *(const bf16x8*)(wp + 32 * d0), acc);
            bf16* O = OM + ((size_t)MP + b * 16 + 4 * g) * 1024 + h * 64 + 16 * db + li; const unsigned w0 = pk2(acc[0], acc[1]), w1 = pk2(acc[2], acc[3]);
            O[0] = (bf16)(w0 & 0xffffu); O[1024] = (bf16)(w0 >> 16); O[2048] = (bf16)(w1 & 0xffffu); O[3072] = (bf16)(w1 >> 16); }
        __syncthreads();
    }
}
typedef float f32x2v_t __attribute__((ext_vector_type(2)));
template <int K, class F> __device__ __forceinline__ void thin_tiles(const bf16* A, const bf16* Bt, LAS unsigned char* lds, int vcu, int G, int wave, int lane, F epi) {
    const int g = lane >> 4, li = lane & 15; constexpr int nks = K / 256;
    LAS float* part = (LAS float*)(lds + RING_OFF);
#pragma unroll 1
    for (int tt = vcu; tt < 256; tt += G) { const int rb = tt & 31, cgp = tt >> 5;
        const bf16* ap = A + (size_t)(MP + 16 * rb + li) * K + wave * (K / 8) + 8 * g; const bf16* bp = Bt + (size_t)(128 * cgp + li) * K + wave * (K / 8) + 8 * g;
        f32x4 acc[8];
#pragma unroll
        for (int nb = 0; nb < 8; ++nb) acc[nb] = (f32x4){0.f, 0.f, 0.f, 0.f};
#pragma unroll
        for (int s0 = 0; s0 < nks; s0 += 4) { bf16x8 a[4], b[4][8]; const bf16x8 z = {0, 0, 0, 0, 0, 0, 0, 0};
#pragma unroll
            for (int u = 0; u < 4; ++u) { const bool on = s0 + u < nks; a[u] = on ? *(const bf16x8*)(ap + 32 * (s0 + u)) : z;
#pragma unroll
                for (int nb = 0; nb < 8; ++nb) b[u][nb] = on ? *(const bf16x8*)(bp + (size_t)nb * 16 * K + 32 * (s0 + u)) : z; }
#pragma unroll
            for (int u = 0; u < 4; ++u) if (s0 + u < nks)
#pragma unroll
                for (int nb = 0; nb < 8; ++nb) acc[nb] = a16::mfma16(a[u], b[u][nb], acc[nb]); }
#pragma unroll
        for (int nb = 0; nb < 8; ++nb)
#pragma unroll
            for (int r = 0; r < 4; ++r) part[wave * 2048 + (4 * g + r) * 128 + 16 * nb + li] = acc[nb][r];
        __syncthreads();
        const int e = (2 * wave + (lane >> 5)) * 128 + 4 * (lane & 31); f32x4 sv = (f32x4){0.f, 0.f, 0.f, 0.f};
#pragma unroll
        for (int w = 0; w < 8; ++w) sv += *(const LAS f32x4*)(part + w * 2048 + e);
        epi(MP + 16 * rb + 2 * wave + (lane >> 5), 128 * cgp + 4 * (lane & 31), sv);
        __syncthreads(); }
}
template <int K> __device__ __forceinline__ void thin_resid(KAP a, const bf16* A, const bf16* Bt, int first, LAS unsigned char* lds, int vcu, int G, int wave, int lane) {
    unsigned char* ws = a->ws; const float* xs = a->in[I_XS] - (size_t)MP * 1024; bf16* XB = (bf16*)(ws + WS_XB); float* SSQ = (float*)(ws + WS_SSQ);
    thin_tiles<K>(A, Bt, lds, vcu, G, wave, lane, [&](int row, int col, f32x4 v) {
        const size_t o = (size_t)row * 1024 + col; f32x4 x;
        if (first) x = *(const f32x4*)(xs + o);
        else { const u32x2 w = *(const u32x2*)(XB + o); x = (f32x4){__builtin_bit_cast(float, w.x << 16), __builtin_bit_cast(float, w.x & 0xffff0000u), __builtin_bit_cast(float, w.y << 16), __builtin_bit_cast(float, w.y & 0xffff0000u)}; }
        x += v; *(u32x2*)(XB + o) = (u32x2){pk2(x[0], x[1]), pk2(x[2], x[3])};
        float sq = (x[0] * x[0] + x[1] * x[1]) + (x[2] * x[2] + x[3] * x[3]); sq += __shfl_xor(sq, 1); sq += __shfl_xor(sq, 2); sq += __shfl_xor(sq, 4); sq += __shfl_xor(sq, 8);
        if ((lane & 15) == 0) SSQ[(size_t)row * 16 + (col >> 6)] = sq; });
}
__device__ __forceinline__ void thin_xq(KAP a, const bf16* Bt, LAS unsigned char* lds, int vcu, int G, int wave, int lane) {
    unsigned char* ws = a->ws; const bf16* XB = (const bf16*)(ws + WS_XB); bf16* QX = (bf16*)(ws + WS_QX); const float* SSQ = (const float*)(ws + WS_SSQ);
    thin_tiles<1024>(XB, Bt, lds, vcu, G, wave, lane, [&](int row, int col, f32x4 v) {
        const float rs = ssq_rstd16(SSQ, row) * C2_X; *(u32x2*)(QX + (size_t)row * 1024 + col) = (u32x2){pk2(v[0] * rs, v[1] * rs), pk2(v[2] * rs, v[3] * rs)}; });
}
#ifndef DBG_DOUBLE
#define DBG_DOUBLE 0
#endif

constexpr int NPH = 41;
struct Ctx { int lane, wave, G, bx, vcu, gw, NGW; };
__device__ __forceinline__ Ctx mk_ctx() { Ctx c; const int tid = pg8::pg8_tid(); c.lane = tid & 63; c.wave = __builtin_amdgcn_readfirstlane(tid >> 6); int G_ = gridDim.x, bx_ = blockIdx.x; asm volatile("" : "+s"(G_), "+s"(bx_)); c.G = G_; c.bx = bx_;
    c.vcu = (c.G % 8 == 0) ? (c.bx % 8) * (c.G / 8) + c.bx / 8 : c.bx; c.gw = c.vcu * NWAVES + c.wave; c.NGW = c.G * NWAVES; return c; }
#define RSX(ws) pg8::RowScale{(const float*)((ws) + WS_SSQ), 16, 4, 1.0f / 1024.0f}
#define PHASE __device__ __noinline__ void
#define FATPH __device__ __forceinline__ void
__device__ __forceinline__ unsigned char* ws_ptr() { GAS unsigned char* w = (GAS unsigned char*)KA->ws; asm volatile("" : "+s"(w)); return (unsigned char*)w; }
#define WSB(off) ((const bf16*)(ws_ptr() + (off)))
__device__ __forceinline__ const float* in_ptr(int i) { GAS const float* w = (GAS const float*)KA->in[i]; asm volatile("" : "+s"(w)); return (const float*)w; }
__device__ __forceinline__ float* out_ptr() { GAS float* w = (GAS float*)KA->out; asm volatile("" : "+s"(w)); return (float*)w; }

FATPH ph_prologue(KAP a, LAS unsigned char* lds, int pmask) { const Ctx c = mk_ctx(); p0_prologue(a, lds, c.gw, c.NGW, c.wave, c.lane, pmask); __syncthreads(); }
FATPH ph_memkv(LAS unsigned char* lds) { const Ctx c = mk_ctx(); unsigned char* ws = ws_ptr(); float* out = out_ptr();
    pg8::Gemm g{WSB(WS_MB), WSB(WS_WXKV), 2048, 8192, 1024}; pg8::StaticOrder S; S.init(2048, 8192, c.G, c.bx);
    pg8::EpiMemKV E{out + O_MKP, out + O_MVP, (bf16*)(ws + WS_MKB), (bf16*)(ws + WS_MVB)};
    pg8::gemm_phase<pg8::EpiMemKV, pg8::StaticOrder, true, true>(lds + RING_OFF, g, S, E); }
FATPH ph_fox_in(LAS unsigned char* lds, int L) { const Ctx c = mk_ctx(); unsigned char* ws = ws_ptr(); float* out = out_ptr();
    pg8::Gemm g{WSB(WS_XB), WSB(WS_WFI) + (size_t)L * 4352 * 1024, MT, 4352, 1024}; pg8::StaticOrder S; S.init(MT, 4352, c.G, c.bx);
    pg8::EpiFoxIn E{RSX(ws), ws, out, in_ptr(I_BFF) + L * 16, L};
    pg8::gemm_phase<pg8::EpiFoxIn, pg8::StaticOrder, true, true>(lds + RING_OFF, g, S, E); }
FATPH ph_fox_sample(KAP a, LAS unsigned char* lds, int L) { const Ctx c = mk_ctx(); LAS float* red = (LAS float*)(lds + RING_OFF + 65536);
    for (int it = c.vcu; it < 256; it += c.G) { cum_local_sample(a, L, 2 * it, red, c.wave, c.lane); cum_local_sample(a, L, 2 * it + 1, red, c.wave, c.lane); foxs_item(a, L, it, lds, c.wave, c.lane); } }
__device__ __forceinline__ void unit2_of(int e, int& bh, int& qb) { bh = e >> 3; const int k = e & 7, s = (k >> 2) & 1, ii = k & 3, j = 2 * s + (ii >> 1); qb = (ii & 1) ? 7 - j : j; }
__device__ __forceinline__ void unit_of(int e, int& bh, int& qb) { bh = e >> 4; const int k = e & 15, s = (k >> 3) & 1, ii = k & 7, j = 2 * (ii >> 1) + s; qb = (ii & 1) ? 15 - j : j; }
FATPH ph_fox_attn(LAS unsigned char* lds, unsigned lds0) { const Ctx c = mk_ctx(); unsigned char* ws = ws_ptr();
    for (int e0 = c.vcu * 4; e0 < 1024; e0 += c.G * 4) {
        __syncthreads(); cum_local_prompt(KA, e0 >> 3, (LAS float*)(lds + RING_OFF + 65536), c.wave, c.lane);
        for (int i = 0; i < 4; ++i) { int bh, qb; unit2_of(e0 + i, bh, qb); const int b = bh >> 4, h = bh & 15;
            fa::Args A{WSB(WS_QF), 1024, h * 64, WSB(WS_KF), 1024, h * 64, nullptr, WSB(WS_VF), 1024, h * 64, (bf16*)(ws + WS_OM), h * 64,
                       WSB(WS_GF), (const float*)(ws + WS_CB) + (size_t)bh * 4096};
            fa::unit2<0>(A, (long)b * 4096, qb, (LAS char*)(lds + RING_OFF), lds0 + RING_OFF); } } }
FATPH ph_fox_mix(KAP a, LAS unsigned char* lds, unsigned lds0, int L) { const Ctx c = mk_ctx(); unsigned char* ws = ws_ptr(); LAS float* red = (LAS float*)(lds + RING_OFF + 65536);
    const int pos = (c.vcu >> 1) % 5;
    for (int e0 = c.vcu * 4, it = c.vcu; e0 < 1024 || it < 256; e0 += c.G * 4, it += c.G) {
        if (e0 < 1024) { __syncthreads(); cum_local_prompt(a, e0 >> 3, red, c.wave, c.lane); }
#pragma unroll 1
        for (int i = 0; i < 5; ++i) {
            if (i == pos && it < 256) { const Ctx c2 = mk_ctx(); int itv = it; asm volatile("" : "+s"(itv));
                __syncthreads(); cum_local_sample(a, L, 2 * itv, red, c2.wave, c2.lane); cum_local_sample(a, L, 2 * itv + 1, red, c2.wave, c2.lane); foxs_item(a, L, itv, lds, c2.wave, c2.lane); __syncthreads(); }
            if (i < 4 && e0 < 1024) { int ev = e0 + i; asm volatile("" : "+s"(ev)); int bh, qb; unit2_of(ev, bh, qb); const int b = bh >> 4, h = bh & 15;
                fa::Args A{WSB(WS_QF), 1024, h * 64, WSB(WS_KF), 1024, h * 64, nullptr, WSB(WS_VF), 1024, h * 64, (bf16*)(ws + WS_OM), h * 64,
                           WSB(WS_GF), (const float*)(ws + WS_CB) + (size_t)bh * 4096};
                fa::unit2<0>(A, (long)b * 4096, qb, (LAS char*)(lds + RING_OFF), lds0 + RING_OFF); } } } }
template <bool ABLK = false>
FATPH ph_resid(LAS unsigned char* lds, const bf16* A, const bf16* Bt, int K, int first, int dummy = 0) { const Ctx c = mk_ctx(); unsigned char* ws = ws_ptr();
    pg8::Gemm g{A, Bt, MP, 1024, K}; pg8::StaticOrder S; S.init(MP, 1024, c.G, c.bx);
    pg8::EpiResid E{KA->in[I_XP], KA->in[I_XS], first, dummy ? (bf16*)(ws + WS_R1 + (size_t)MT * 4096) : (bf16*)(ws + WS_XB), dummy ? (float*)(ws + WS_R1 + (size_t)MT * 6144) : (float*)(ws + WS_SSQ)};
    pg8::gemm_phase<pg8::EpiResid, pg8::StaticOrder, true, true, ABLK>(lds + RING_OFF, g, S, E); }
FATPH ph_scale_gemm(LAS unsigned char* lds, const bf16* A, const bf16* Bt, int M, int N, int K, const float* ssq, int stride, int ngrp, float inv_n, bf16* O, float scale) { const Ctx c = mk_ctx();
    pg8::Gemm g{A, Bt, M, N, K}; pg8::StaticOrder S; S.init(M, N, c.G, c.bx);
    pg8::EpiScaleBf16 E{pg8::RowScale{ssq, stride, ngrp, inv_n}, O, N, scale};
    pg8::gemm_phase<pg8::EpiScaleBf16, pg8::StaticOrder, true, true>(lds + RING_OFF, g, S, E); }
FATPH ph_cross(LAS unsigned char* lds, unsigned lds0, int layer) { const Ctx c = mk_ctx(); unsigned char* ws = ws_ptr();
    const bf16* QX = WSB(WS_QX); bf16* OX = (bf16*)(ws + WS_OM);
    const bool bal = (c.G == 256); const int nu = bal ? (c.vcu < 128 ? 1 : 3) : 2, ub = bal ? (c.vcu < 128 ? c.vcu : 128 + 3 * (c.vcu - 128)) : c.vcu * 2;
    for (int u0 = ub; u0 < 512; u0 += (bal ? 512 : c.G * 2))
        for (int i = 0; i < nu; ++i) { const int u = u0 + i, bh = u >> 4, qb = u & 15, b = bh >> 2, h = bh & 3; const size_t ko = ((size_t)layer * 2048 + b * 256) * 1024 + h * 256;
            xa::unit<false>(WSB(WS_MKB) + ko, WSB(WS_MVB) + ko, 1024, QX, OX, (size_t)b * 4096 + qb * 256, h * 256, 32, false, (LAS char*)(lds + RING_OFF), lds0 + RING_OFF); }
    for (int e = c.vcu; e < 128; e += c.G) { const int bs = e >> 2, h = e & 3; const size_t ko = ((size_t)(layer * 32 + bs) * 256) * 1024 + h * 256;
        xa::unit<true>(in_ptr(I_CMK) + ko, in_ptr(I_CMV) + ko, 1024, QX, OX, (size_t)MP + bs * 16, h * 256, 16, true, (LAS char*)(lds + RING_OFF), lds0 + RING_OFF); } }
FATPH ph_gu(LAS unsigned char* lds, int layer) { const Ctx c = mk_ctx(); unsigned char* ws = ws_ptr();
    pg8::Gemm g{WSB(WS_XB), WSB(WS_WGU) + (size_t)layer * 5632 * 1024, MT, 5632, 1024}; pg8::StaticOrder S; S.init(MT, 5632, c.G, c.bx);
    pg8::EpiSwiglu E{RSX(ws), (bf16*)(ws + WS_HB)}; pg8::gemm_phase<pg8::EpiSwiglu, pg8::StaticOrder, true, true>(lds + RING_OFF, g, S, E); }
FATPH ph_gu_null(LAS unsigned char* lds, int layer) { const Ctx c = mk_ctx();
    pg8::Gemm g{WSB(WS_XB), WSB(WS_WGU) + (size_t)layer * 5632 * 1024, MT, 5632, 1024}; pg8::StaticOrder S; S.init(MT, 5632, c.G, c.bx);
    pg8::EpiNull E{}; pg8::gemm_phase<pg8::EpiNull, pg8::StaticOrder, true, true>(lds + RING_OFF, g, S, E); }
FATPH ph_mla_a(LAS unsigned char* lds, int L) { const Ctx c = mk_ctx(); unsigned char* ws = ws_ptr(); float* out = out_ptr();
    pg8::Gemm g{WSB(WS_XB), WSB(WS_WMA) + (size_t)L * 768 * 1024, MT, 768, 1024}; pg8::StaticOrder S; S.init(MT, 768, c.G, c.bx);
    pg8::EpiMlaA E{RSX(ws), (float*)(ws + WS_CKVU), (bf16*)(ws + WS_CKVUB), (float*)(ws + WS_SSQKV), (bf16*)(ws + WS_CQ), (float*)(ws + WS_SSQQ), (bf16*)(ws + WS_KRB),
                   out + O_MRP + (size_t)L * MP * 32, out + O_MRS + (size_t)L * MS * 32, (const float*)(ws + WS_ROPC), (const float*)(ws + WS_ROPS)};
    pg8::gemm_phase<pg8::EpiMlaA, pg8::StaticOrder, true, true>(lds + RING_OFF, g, S, E); }
PHASE ph_fixup(KAP a, int L) { const Ctx c = mk_ctx(); ckv_fixup(a, L, c.gw, c.NGW, c.lane); }
FATPH ph_mla_q(LAS unsigned char* lds, int L, int kq) { const Ctx c = mk_ctx(); unsigned char* ws = ws_ptr();
    pg8::Gemm g{WSB(WS_CQ), WSB(WS_WMQ) + (size_t)L * 1536 * 384, MT, 1536, kq}; pg8::StaticOrder S; S.init(MT, 1536, c.G, c.bx);
    pg8::EpiMlaQ E{pg8::RowScale{(const float*)(ws + WS_SSQQ), 8, 2, 1.0f / 384.0f}, (bf16*)(ws + WS_QM), (const float*)(ws + WS_ROPC), (const float*)(ws + WS_ROPS)};
    pg8::gemm_phase<pg8::EpiMlaQ, pg8::StaticOrder, true, false>(lds + RING_OFF, g, S, E); }
PHASE ph_mla_qprime(KAP a, LAS unsigned char* lds, int L, int it) { const Ctx c = mk_ctx(); mlas_qprime(a, L, it, lds, c.wave, c.lane); }
FATPH ph_mla_sample(LAS unsigned char* lds, unsigned lds0, int L) { const Ctx c = mk_ctx(); for (int it = c.vcu; it < 256; it += c.G) { ph_mla_qprime(KA, lds, L, it); if (DBG_DOUBLE & 1048576) ph_mla_qprime(KA, lds, L, it); mlas_attn(KA, L, it, it, lds, lds0);
        if ((it & 7) == ((it >> 3) & 7)) mlas_attn(KA, L, 256 + (it >> 3), it, lds, lds0); } __syncthreads(); }
FATPH ph_mla_attn(LAS unsigned char* lds, unsigned lds0) { const Ctx c = mk_ctx(); unsigned char* ws = ws_ptr();
    for (int e0 = c.vcu * 4; e0 < 1024; e0 += c.G * 4)
        for (int i = 0; i < 4; ++i) { int bh, qb; unit2_of(e0 + i, bh, qb); const int b = bh >> 4, h = bh & 15;
            fa::Args A{WSB(WS_QM), 1536, h * 96, WSB(WS_KVM), 2048, h * 128, WSB(WS_KRB), WSB(WS_KVM), 2048, h * 128 + 64, (bf16*)(ws + WS_OM), h * 64,
                       nullptr, nullptr};
            fa::unit2<1>(A, (long)b * 4096, qb, (LAS char*)(lds + RING_OFF), lds0 + RING_OFF); } }
FATPH ph_mla_comb(LAS unsigned char* lds, int L) { const Ctx c = mk_ctx(); mlas_combine(KA, L, lds, c.vcu, c.G, c.wave, c.lane); }
template <int K> FATPH ph_thin_resid(KAP a, LAS unsigned char* lds, const bf16* A, const bf16* Bt, int first) { const Ctx c = mk_ctx(); thin_resid<K>(a, A, Bt, first, lds, c.vcu, c.G, c.wave, c.lane); }
FATPH ph_thin_xq(KAP a, LAS unsigned char* lds, const bf16* Bt) { const Ctx c = mk_ctx(); thin_xq(a, Bt, lds, c.vcu, c.G, c.wave, c.lane); }
PHASE ph_final(KAP a) { const Ctx c = mk_ctx(); final_phase(a, c.gw, c.NGW, c.lane); }
PHASE ph_grid_bar(GAS unsigned* barw, unsigned x, volatile LAS unsigned* st) { XcdBarrier b; b.bar = (unsigned*)barw; b.x = x; b.st = st; xcd_barrier(b); }

__global__ void __launch_bounds__(NWAVES * 64, 2) fwd_kernel(KArgs args) {
    extern __shared__ __attribute__((aligned(16))) unsigned char lds_raw[];
    LAS unsigned char* lds = (LAS unsigned char*)lds_raw;
    volatile LAS unsigned* MISC = (volatile LAS unsigned*)(lds + MISC_OFF);
    const int tid = threadIdx.x;
    const unsigned lds0 = (unsigned)(uintptr_t)lds_raw;
    for (int u = tid; u < (LDS_BYTES - LDSCTL_OFF) / 4; u += NWAVES * 64) ((LAS unsigned*)(lds + LDSCTL_OFF))[u] = 0u;
    __syncthreads();
    const XcdBarrier bar = xcd_barrier_post((unsigned*)(args.ws + WS_CTL) + CW_BAR, MISC + 8);
    const int lo = args.ph_lo, hi = args.ph_hi;
#ifndef DBG_DOUBLE
#define DBG_DOUBLE 0
#endif
#ifndef DBG_P0_AGAIN
#define DBG_P0_AGAIN 0
#endif
#define REP(bit) for (int rep_ = 0; rep_ < ((DBG_DOUBLE & (bit)) ? 2 : 1); ++rep_)
#define IN(k) (lo <= (k) && (k) < hi)
#define SEAM(k) do { if (IN(k) && IN((k) + 1)) { REP(256) ph_grid_bar((GAS unsigned*)bar.bar, bar.x, bar.st); } } while (0)
    if (IN(0)) { ph_prologue(KA, lds, 0x7f); if (DBG_P0_AGAIN) ph_prologue(KA, lds, DBG_P0_AGAIN); }
    SEAM(0);
    if (IN(1)) REP(65536) ph_memkv(lds);
    SEAM(1);
    for (int L = 0; L < 2; ++L) {
        const int pb = 2 + 19 * L;
        if (IN(pb)) { REP(8) ph_fox_in(lds, L); }
        SEAM(pb);
        if (IN(pb + 2)) { if (DBG_DOUBLE & 96) { REP(64) ph_fox_sample(KA, lds, L); REP(32) ph_fox_attn(lds, lds0); } else ph_fox_mix(KA, lds, lds0, L); }
        SEAM(pb + 2);
        if (IN(pb + 3)) { ph_thin_resid<1024>(KA, lds, WSB(WS_OM), WSB(WS_WFO) + (size_t)L * 1024 * 1024, L == 0); if (DBG_DOUBLE & 512) ph_resid(lds, WSB(WS_OM), WSB(WS_WFO) + (size_t)L * 1024 * 1024, 1024, L == 0, 1); ph_resid(lds, WSB(WS_OM), WSB(WS_WFO) + (size_t)L * 1024 * 1024, 1024, L == 0); }
        SEAM(pb + 3);
        for (int sub = 0; sub < 2; ++sub) {
            const int layer = 2 * L + sub, cb = pb + 4 + 10 * sub;
            if (sub == 1) {
                if (IN(pb + 9)) REP(32768) ph_mla_a(lds, L);
                SEAM(pb + 9);
                if (IN(pb + 10)) { ph_fixup(KA, L); REP(32768) ph_mla_q(lds, L, 384);
                    REP(32768)
                    ph_scale_gemm(lds, WSB(WS_CKVUB), WSB(WS_WMKV) + (size_t)L * 2048 * 256, MP, 2048, 256, (const float*)(ws_ptr() + WS_SSQKV), 4, 1, 1.0f / 256.0f, (bf16*)(ws_ptr() + WS_KVM), 1.0f); }
                SEAM(pb + 10);
                if (IN(pb + 11)) { REP(128) ph_mla_sample(lds, lds0, L); REP(32) ph_mla_attn(lds, lds0); }
                SEAM(pb + 11);
                if (IN(pb + 12)) REP(16) ph_mla_comb(lds, L);
                SEAM(pb + 12);
                if (IN(pb + 13)) { ph_thin_resid<1024>(KA, lds, WSB(WS_OM), WSB(WS_WMO) + (size_t)L * 1024 * 1024, 0); if (DBG_DOUBLE & 512) ph_resid(lds, WSB(WS_OM), WSB(WS_WMO) + (size_t)L * 1024 * 1024, 1024, 0, 1); ph_resid(lds, WSB(WS_OM), WSB(WS_WMO) + (size_t)L * 1024 * 1024, 1024, 0); }
                SEAM(pb + 13);
            }
            if (IN(cb)) { REP(131072) ph_thin_xq(KA, lds, WSB(WS_WXQ) + (size_t)layer * 1024 * 1024); REP(16384) ph_scale_gemm(lds, WSB(WS_XB), WSB(WS_WXQ) + (size_t)layer * 1024 * 1024, MP, 1024, 1024, (const float*)(ws_ptr() + WS_SSQ), 16, 4, 1.0f / 1024.0f, (bf16*)(ws_ptr() + WS_QX), C2_X); }
            SEAM(cb);
            if (IN(cb + 1)) REP(2) ph_cross(lds, lds0, layer);
            SEAM(cb + 1);
            if (IN(cb + 2)) { ph_thin_resid<1024>(KA, lds, WSB(WS_OM), WSB(WS_WXO) + (size_t)layer * 1024 * 1024, 0); if (DBG_DOUBLE & 4096) ph_resid(lds, WSB(WS_OM), WSB(WS_WXO) + (size_t)layer * 1024 * 1024, 1024, 0, 1); ph_resid(lds, WSB(WS_OM), WSB(WS_WXO) + (size_t)layer * 1024 * 1024, 1024, 0); }
            SEAM(cb + 2);
            if (IN(cb + 3)) { if (DBG_DOUBLE & 1024) ph_gu_null(lds, layer); REP(8) ph_gu(lds, layer); }
            SEAM(cb + 3);
            if (IN(cb + 4)) { ph_thin_resid<DFF>(KA, lds, WSB(WS_HB), WSB(WS_WDN) + (size_t)layer * 1024 * 2816, 0); if (DBG_DOUBLE & 2048) ph_resid<true>(lds, WSB(WS_HB), WSB(WS_WDN) + (size_t)layer * 1024 * 2816, DFF, 0, 1); ph_resid<true>(lds, WSB(WS_HB), WSB(WS_WDN) + (size_t)layer * 1024 * 2816, DFF, 0); }
            SEAM(cb + 4);
        }
    }
    if (IN(40)) REP(262144) ph_final(KA);
#undef IN
#undef SEAM
}

#ifndef DBG_PH_HI
#define DBG_PH_HI NPH
#endif
#ifndef MK_PER_PHASE
#define MK_PER_PHASE 0
#endif
extern "C" void kernel_launch(void* const* d_in, const int* in_sizes, int n_in, void* d_out, int out_size, void* d_ws, size_t ws_size, hipStream_t stream) {
    static int grid = 0;
    if (grid == 0) {
        if (n_in != N_IN || (size_t)out_size != O_END || ws_size < WS_END) { fprintf(stderr, "kernel_launch: unexpected shapes (n_in %d, out %d, ws %zu; need %d, %zu, %zu)\n", n_in, out_size, ws_size, (int)N_IN, (size_t)O_END, (size_t)WS_END); grid = -1; return; }
        int dev = 0, cus = 0, per_cu = 0;
        if (hipGetDevice(&dev) != hipSuccess || hipDeviceGetAttribute(&cus, hipDeviceAttributeMultiprocessorCount, dev) != hipSuccess) { grid = -1; return; }
        if (hipFuncSetAttribute((const void*)fwd_kernel, hipFuncAttributeMaxDynamicSharedMemorySize, LDS_BYTES) != hipSuccess) { fprintf(stderr, "kernel_launch: hipFuncSetAttribute failed\n"); grid = -1; return; }
        if (hipOccupancyMaxActiveBlocksPerMultiprocessor(&per_cu, (const void*)fwd_kernel, NWAVES * 64, LDS_BYTES) != hipSuccess || per_cu < 1) { fprintf(stderr, "kernel_launch: occupancy query reports %d\n", per_cu); }
        (void)hipGetLastError();
        grid = cus;
    }
    if (grid < 0) return;
    if (hipMemsetAsync((char*)d_ws + WS_CTL, 0, CTL_ZERO_BYTES, stream) != hipSuccess) return;
    KArgs a{};
    for (int i = 0; i < N_IN; ++i) a.in[i] = (const float*)d_in[i];
    a.out = (float*)d_out; a.ws = (unsigned char*)d_ws;
#if MK_PER_PHASE
    for (int p = 0; p < NPH; ++p) { a.ph_lo = p; a.ph_hi = p + 1; hipLaunchKernelGGL(fwd_kernel, dim3(grid), dim3(NWAVES * 64), LDS_BYTES, stream, a); }
#else
    a.ph_lo = 0; a.ph_hi = DBG_PH_HI; hipLaunchKernelGGL(fwd_kernel, dim3(grid), dim3(NWAVES * 64), LDS_BYTES, stream, a);
#endif
}
```
